# Optimizing an MI355X kernel written in HIP

```python
import math
import jax, jax.numpy as jnp
from jax import lax
import numpy as np

D_MODEL = 1024
BATCH = 8
SEQ = 4096
DEPTH = 1

SSM_WIDTH = D_MODEL // 2
SSM_GROUP = 16
SSM_GROUPS = SSM_WIDTH // SSM_GROUP
SSM_STATE = 64
DT_MIN = 1e-3
DT_MAX = 1e-1
ATTN_HEADS = 8
ATTN_KV_HEADS = 2
HEAD_DIM = 64
ATTN_WIDTH = ATTN_HEADS * HEAD_DIM
IDX_HEADS = 8
IDX_DIM = 32
TOPK_MAX = 256
Q_BLOCK = 128
ROPE_THETA = 10000.0
NEG_BIG = -1e30
PEER_HEADS = 8
PEER_KEYS = 128
PEER_EXPERTS = PEER_KEYS * PEER_KEYS
PEER_KEY_DIM = 128
PEER_TOPK = 16
PEER_CHUNK = 128
NORM_EPS = 1e-6

IN_SPLITS = (SSM_WIDTH, ATTN_WIDTH, ATTN_KV_HEADS * HEAD_DIM, ATTN_KV_HEADS * HEAD_DIM,
             IDX_HEADS * IDX_DIM, IDX_DIM, IDX_HEADS, D_MODEL, D_MODEL)
IN_WIDTH = sum(IN_SPLITS)

kernel_name = "hybrid_s5_dsa_peer_block"


def rmsnorm(x, g):
    xf = x.astype(jnp.float32)
    y = xf * lax.rsqrt(jnp.mean(xf * xf, axis=-1, keepdims=True) + NORM_EPS)
    return (y * g.astype(jnp.float32)).astype(x.dtype)


def rope_tables(seq, dim):
    pos = jnp.arange(seq, dtype=jnp.float32)
    inv = ROPE_THETA ** (-jnp.arange(0, dim, 2, dtype=jnp.float32) / dim)
    ang = pos[:, None] * inv[None, :]
    return jnp.cos(ang), jnp.sin(ang)


def apply_rope(x, cos, sin):
    half = x.shape[-1] // 2
    shape = (cos.shape[0],) + (1,) * (x.ndim - 3) + (half,)
    c = cos.reshape(shape)
    s = sin.reshape(shape)
    xf = x.astype(jnp.float32)
    x1, x2 = xf[..., :half], xf[..., half:]
    return jnp.concatenate([x1 * c - x2 * s, x2 * c + x1 * s], axis=-1).astype(x.dtype)


def s5_branch(u, a_re, a_im, log_dt, b_re, b_im, c_re, c_im, d_skip, w_glu):
    bsz, seq, _ = u.shape
    f32 = jnp.float32
    uf = u.astype(f32).reshape(bsz, seq, SSM_GROUPS, SSM_GROUP)
    lam = lax.complex(a_re.astype(f32), a_im.astype(f32))
    dt = jnp.exp(log_dt.astype(f32))[:, None]
    a_bar = jnp.exp(lam * dt)
    b = lax.complex(b_re.astype(f32), b_im.astype(f32))
    b_bar = ((a_bar - 1.0) / lam)[..., None] * b
    bu = jnp.einsum('gpc,bsgc->bsgp', b_bar, uf)
    a_seq = jnp.broadcast_to(a_bar, bu.shape)

    def combine(left, right):
        a1, s1 = left
        a2, s2 = right
        return a2 * a1, a2 * s1 + s2

    _, states = lax.associative_scan(combine, (a_seq, bu), axis=1)
    c = lax.complex(c_re.astype(f32), c_im.astype(f32))
    y = jnp.real(jnp.einsum('gcp,bsgp->bsgc', c, states))
    y = y + d_skip.astype(f32).reshape(SSM_GROUPS, SSM_GROUP) * uf
    y = jax.nn.gelu(y.reshape(bsz, seq, SSM_WIDTH))
    y = y * jax.nn.sigmoid(y @ w_glu.astype(f32))
    return y.astype(u.dtype)


def dsa_branch(q, k, v, qi, ki, wi):
    bsz, seq = q.shape[0], q.shape[1]
    topk = min(TOPK_MAX, seq // 4)
    nb = seq // Q_BLOCK
    grp = ATTN_HEADS // ATTN_KV_HEADS
    f32 = jnp.float32
    kf = ki.astype(f32)
    idx_scale = (IDX_HEADS ** -0.5) * (IDX_DIM ** -0.5)
    s_pos = jnp.arange(seq)

    def to_blocks(t):
        return t.reshape((bsz, nb, Q_BLOCK) + t.shape[2:]).swapaxes(0, 1)

    def one_block(args):
        qb, qib, wib, blk = args
        t_pos = blk * Q_BLOCK + jnp.arange(Q_BLOCK)
        rel = jax.nn.relu(jnp.einsum('bthd,bsd->bths', qib.astype(f32), kf))
        score = jnp.einsum('bths,bth->bts', rel, wib.astype(f32)) * idx_scale
        causal = s_pos[None, :] <= t_pos[:, None]
        score = jnp.where(causal[None], score, NEG_BIG)
        _, sel = lax.top_k(score, topk)
        valid = sel <= t_pos[None, :, None]
        kg = jax.vmap(lambda kk, ii: kk[ii])(k, sel)
        vg = jax.vmap(lambda vv, ii: vv[ii])(v, sel)
        qg = qb.reshape(bsz, Q_BLOCK, ATTN_KV_HEADS, grp, HEAD_DIM).astype(f32)
        logits = jnp.einsum('btngd,btknd->btngk', qg, kg.astype(f32)) * (HEAD_DIM ** -0.5)
        logits = jnp.where(valid[:, :, None, None, :], logits, NEG_BIG)
        p = jax.nn.softmax(logits, axis=-1)
        o = jnp.einsum('btngk,btknd->btngd', p, vg.astype(f32))
        return o.reshape(bsz, Q_BLOCK, ATTN_WIDTH).astype(qb.dtype)

    out = lax.map(one_block, (to_blocks(q), to_blocks(qi), to_blocks(wi), jnp.arange(nb)))
    return out.swapaxes(0, 1).reshape(bsz, seq, ATTN_WIDTH)


def peer_ffn(x, w_q, sub_k1, sub_k2, u_tab, v_tab):
    bsz, seq, d = x.shape
    f32 = jnp.float32
    q = (x @ w_q).astype(f32).reshape(bsz, seq, PEER_HEADS, 2, PEER_KEY_DIM)
    s1 = jnp.einsum('bshd,hnd->bshn', q[..., 0, :], sub_k1.astype(f32))
    s2 = jnp.einsum('bshd,hnd->bshn', q[..., 1, :], sub_k2.astype(f32))
    v1, i1 = lax.top_k(s1, PEER_TOPK)
    v2, i2 = lax.top_k(s2, PEER_TOPK)
    cand_s = (v1[..., :, None] + v2[..., None, :]).reshape(bsz, seq, PEER_HEADS, PEER_TOPK * PEER_TOPK)
    cand_i = (i1[..., :, None] * PEER_KEYS + i2[..., None, :]).reshape(bsz, seq, PEER_HEADS, PEER_TOPK * PEER_TOPK)
    top_s, pos = lax.top_k(cand_s, PEER_TOPK)
    experts = jnp.take_along_axis(cand_i, pos, axis=-1)
    gates = jax.nn.softmax(top_s, axis=-1)
    n_tok = bsz * seq
    n_chunks = n_tok // PEER_CHUNK
    n_sel = PEER_HEADS * PEER_TOPK
    xc_all = x.reshape(n_chunks, PEER_CHUNK, d)
    ec_all = experts.reshape(n_chunks, PEER_CHUNK, n_sel)
    gc_all = gates.reshape(n_chunks, PEER_CHUNK, n_sel)

    def chunk(args):
        xc, ec, gc = args
        u = u_tab[ec].astype(f32)
        act = jax.nn.gelu(jnp.einsum('ced,cd->ce', u, xc.astype(f32))) * gc
        return jnp.einsum('ce,ced->cd', act, v_tab[ec].astype(f32)).astype(x.dtype)

    out = lax.map(chunk, (xc_all, ec_all, gc_all))
    return out.reshape(bsz, seq, d)


def setup_inputs(seed: int = 0) -> dict:
    key = jax.random.key(seed)
    ks = jax.random.split(key, 24)
    f32 = jnp.float32
    L, D, G, P, N = DEPTH, D_MODEL, SSM_GROUPS, SSM_STATE, SSM_GROUP
    nrm = lambda k, shape, s: jax.random.normal(k, shape, f32) * s
    x = jax.random.normal(ks[0], (BATCH, SEQ, D), f32)
    norm1_g = 1.0 + nrm(ks[1], (L, D), 0.02)
    w_in = nrm(ks[2], (L, D, IN_WIDTH), D ** -0.5)
    a_re = -0.5 * (1.0 + nrm(ks[3], (L, G, P), 0.01))
    a_im = jnp.broadcast_to(math.pi * jnp.arange(P, dtype=f32), (L, G, P)) + nrm(ks[4], (L, G, P), 0.01)
    log_dt = jax.random.uniform(ks[5], (L, G), f32, math.log(DT_MIN), math.log(DT_MAX))
    b_re = nrm(ks[6], (L, G, P, N), (2.0 * N) ** -0.5)
    b_im = nrm(ks[7], (L, G, P, N), (2.0 * N) ** -0.5)
    c_re = nrm(ks[8], (L, G, N, P), P ** -0.5)
    c_im = nrm(ks[9], (L, G, N, P), P ** -0.5)
    d_skip = nrm(ks[10], (L, SSM_WIDTH), 1.0)
    w_glu = nrm(ks[11], (L, SSM_WIDTH, SSM_WIDTH), SSM_WIDTH ** -0.5)
    w_ssm_up = nrm(ks[12], (L, SSM_WIDTH, D), SSM_WIDTH ** -0.5)
    w_attn_up = nrm(ks[13], (L, ATTN_WIDTH, D), ATTN_WIDTH ** -0.5)
    w_out = nrm(ks[14], (L, D, D), D ** -0.5)
    norm2_g = 1.0 + nrm(ks[15], (L, D), 0.02)
    peer_wq = nrm(ks[16], (L, D, PEER_HEADS * 2 * PEER_KEY_DIM), D ** -0.5)
    peer_k1 = nrm(ks[17], (L, PEER_HEADS, PEER_KEYS, PEER_KEY_DIM), PEER_KEY_DIM ** -0.5)
    peer_k2 = nrm(ks[18], (L, PEER_HEADS, PEER_KEYS, PEER_KEY_DIM), PEER_KEY_DIM ** -0.5)
    peer_u = nrm(ks[19], (L, PEER_EXPERTS, D), D ** -0.5)
    peer_v = nrm(ks[20], (L, PEER_EXPERTS, D), PEER_HEADS ** -0.5)
    norm_f_g = 1.0 + nrm(ks[21], (D,), 0.02)
    return {"x": x, "norm1_g": norm1_g, "w_in": w_in, "a_re": a_re, "a_im": a_im,
            "log_dt": log_dt, "b_re": b_re, "b_im": b_im, "c_re": c_re, "c_im": c_im,
            "d_skip": d_skip, "w_glu": w_glu, "w_ssm_up": w_ssm_up, "w_attn_up": w_attn_up,
            "w_out": w_out, "norm2_g": norm2_g, "peer_wq": peer_wq, "peer_k1": peer_k1,
            "peer_k2": peer_k2, "peer_u": peer_u, "peer_v": peer_v, "norm_f_g": norm_f_g}


def reference(x, norm1_g, w_in, a_re, a_im, log_dt, b_re, b_im, c_re, c_im, d_skip, w_glu,
              w_ssm_up, w_attn_up, w_out, norm2_g, peer_wq, peer_k1, peer_k2, peer_u, peer_v,
              norm_f_g):
    bsz, seq, _ = x.shape
    cos_a, sin_a = rope_tables(seq, HEAD_DIM)
    cos_i, sin_i = rope_tables(seq, IDX_DIM)
    offsets = np.cumsum(IN_SPLITS)[:-1].tolist()
    h = x
    for layer in range(DEPTH):
        xn = rmsnorm(h, norm1_g[layer])
        proj = xn @ w_in[layer]
        u, q, k, v, qi, ki, wi, g_ssm, g_attn = jnp.split(proj, offsets, axis=-1)
        y_ssm = s5_branch(u, a_re[layer], a_im[layer], log_dt[layer], b_re[layer], b_im[layer],
                          c_re[layer], c_im[layer], d_skip[layer], w_glu[layer])
        q = apply_rope(q.reshape(bsz, seq, ATTN_HEADS, HEAD_DIM), cos_a, sin_a)
        k = apply_rope(k.reshape(bsz, seq, ATTN_KV_HEADS, HEAD_DIM), cos_a, sin_a)
        v = v.reshape(bsz, seq, ATTN_KV_HEADS, HEAD_DIM)
        qi = apply_rope(qi.reshape(bsz, seq, IDX_HEADS, IDX_DIM), cos_i, sin_i)
        ki = apply_rope(ki, cos_i, sin_i)
        y_attn = dsa_branch(q, k, v, qi, ki, wi)
        merged = (jax.nn.sigmoid(g_ssm) * (y_ssm @ w_ssm_up[layer])
                  + jax.nn.sigmoid(g_attn) * (y_attn @ w_attn_up[layer]))
        h = h + merged @ w_out[layer]
        hn = rmsnorm(h, norm2_g[layer])
        h = h + peer_ffn(hn, peer_wq[layer], peer_k1[layer], peer_k2[layer], peer_u[layer], peer_v[layer])
    return rmsnorm(h, norm_f_g)
```

```cpp
#include <hip/hip_runtime.h>
#include <stdint.h>

typedef unsigned short bf16_t;
typedef short bf16x8 __attribute__((ext_vector_type(8)));
typedef float f32x4 __attribute__((ext_vector_type(4)));
typedef unsigned u32x4 __attribute__((ext_vector_type(4)));

#define NT 256
constexpr int DM = 1024, NB = 8, SEQ = 4096, MTOK = NB * SEQ;
constexpr int SSM_W = 512, SSM_G = 32, SSM_N = 16, SSM_P = 64;
constexpr int IN_W = 3624, IN_WP = 3712;
constexpr int TOPK = 256;
constexpr int PEER_H = 8, PEER_KEYS = 128, PEER_KD = 128, PEER_TOPK = 16;
constexpr float NORM_EPS = 1e-6f;
constexpr size_t MiB = 1u << 20;

constexpr size_t WS_WINT = 1, WS_WGLUT = 9, WS_WSUPT = 10, WS_WAUPT = 11, WS_WOUTT = 12, WS_WCT = 14;
constexpr size_t WS_ROPEA = 18, WS_ROPEI = 19, WS_SSMT = 20;
constexpr size_t WS_UTAB = 24, WS_VTAB = 56;
constexpr size_t WS_R1 = 88;
constexpr size_t WS_U = 152, WS_Q = 184, WS_K = 216, WS_V = 224, WS_QI = 232, WS_KI = 264, WS_WI = 268;
constexpr size_t WS_SGS = 270, WS_SGA = 334, WS_YG = 398, WS_YSSM = 430, WS_YATT = 462;
constexpr size_t WS_SCORES = 152;

struct Params {
    const float *x, *norm1_g, *w_in, *a_re, *a_im, *log_dt, *b_re, *b_im, *c_re, *c_im, *d_skip, *w_glu, *w_ssm_up,
        *w_attn_up, *w_out, *norm2_g, *peer_wq, *peer_k1, *peer_k2, *peer_u, *peer_v, *norm_f_g;
    float* out;
    unsigned char* ws;
    double inv64[32];
    double inv32[16];
};

#define WSP(T, off) ((T*)(p.ws + (size_t)(off) * MiB))

__device__ __forceinline__ unsigned f2bf(float f) {
    unsigned u = __builtin_bit_cast(unsigned, f);
    return (u + 0x7fffu + ((u >> 16) & 1u)) >> 16;
}
__device__ __forceinline__ float bf2f(unsigned b) { return __builtin_bit_cast(float, b << 16); }
__device__ __forceinline__ float sigmoidf_(float x) { return 1.f / (1.f + __expf(-x)); }
__device__ __forceinline__ float gelu_tanh(float x) {
    float z = 0.7978845608028654f * (x + 0.044715f * x * x * x);
    float e = __expf(2.f * z);
    float t = 1.f - 2.f / (e + 1.f);
    return 0.5f * x * (1.f + t);
}
__device__ __forceinline__ float wave_sum(float v) {
#pragma unroll
    for (int o = 32; o >= 1; o >>= 1) v += __shfl_xor(v, o);
    return v;
}

__device__ __forceinline__ void sincos_d(double x, double& s, double& c) {
    const double TWO_OVER_PI = 0.63661977236758134308;
    const double PIO2_HI = 1.57079632679489655800e+00, PIO2_LO = 6.12323399573676603587e-17;
    double kd = rint(x * TWO_OVER_PI);
    double r = fma(-kd, PIO2_HI, x);
    r = fma(-kd, PIO2_LO, r);
    long long k = (long long)kd;
    double r2 = r * r;
    double sp = r * (1.0 + r2 * (-1.0 / 6 + r2 * (1.0 / 120 + r2 * (-1.0 / 5040 + r2 * (1.0 / 362880 + r2 * (-1.0 / 39916800 + r2 * (1.0 / 6227020800.0)))))));
    double cp = 1.0 + r2 * (-0.5 + r2 * (1.0 / 24 + r2 * (-1.0 / 720 + r2 * (1.0 / 40320 + r2 * (-1.0 / 3628800 + r2 * (1.0 / 479001600.0 + r2 * (-1.0 / 87178291200.0)))))));
    int q = (int)(k & 3);
    double ss = (q & 1) ? cp : sp, cc = (q & 1) ? sp : cp;
    if (q == 1) cc = -cc;
    if (q == 2) { ss = -ss; cc = -cc; }
    if (q == 3) ss = -ss;
    s = ss; c = cc;
}

__device__ __forceinline__ int winmap(int n) {
    if (n < 1576) return n;
    if (n < 1600) return -1;
    if (n < 3648) return n - 24;
    return -1;
}
template <int MODE>
__device__ __forceinline__ void prep_transpose(const float* __restrict__ W, int K, int N, bf16_t* WT, int Nout, size_t gtid, size_t gsize) {
    size_t total = (size_t)Nout * K;
    for (size_t i = gtid; i < total; i += gsize) {
        int n = (int)(i / K), k = (int)(i % K);
        int src = MODE == 1 ? winmap(n) : n;
        WT[i] = src >= 0 ? (bf16_t)f2bf(W[(size_t)k * N + src]) : (bf16_t)0;
    }
}

__device__ __forceinline__ void rmsnorm_rows_bf16(const float* __restrict__ X, const float* __restrict__ g, bf16_t* O, int gwave, int nwaves, int lane) {
    for (int row = gwave; row < MTOK; row += nwaves) {
        const float* xr = X + (size_t)row * DM;
        float v[16];
        float ss = 0.f;
#pragma unroll
        for (int c = 0; c < 2; ++c) {
            f32x4 a = *(const f32x4*)(xr + c * 512 + lane * 8);
            f32x4 b = *(const f32x4*)(xr + c * 512 + lane * 8 + 4);
#pragma unroll
            for (int i = 0; i < 4; ++i) { v[c * 8 + i] = a[i]; v[c * 8 + 4 + i] = b[i]; }
        }
#pragma unroll
        for (int i = 0; i < 16; ++i) ss += v[i] * v[i];
        ss = wave_sum(ss);
        float sc = rsqrtf(ss * (1.f / DM) + NORM_EPS);
#pragma unroll
        for (int c = 0; c < 2; ++c) {
            f32x4 ga = *(const f32x4*)(g + c * 512 + lane * 8);
            f32x4 gb = *(const f32x4*)(g + c * 512 + lane * 8 + 4);
            u32x4 w;
            w.x = f2bf(v[c * 8 + 0] * sc * ga[0]) | (f2bf(v[c * 8 + 1] * sc * ga[1]) << 16);
            w.y = f2bf(v[c * 8 + 2] * sc * ga[2]) | (f2bf(v[c * 8 + 3] * sc * ga[3]) << 16);
            w.z = f2bf(v[c * 8 + 4] * sc * gb[0]) | (f2bf(v[c * 8 + 5] * sc * gb[1]) << 16);
            w.w = f2bf(v[c * 8 + 6] * sc * gb[2]) | (f2bf(v[c * 8 + 7] * sc * gb[3]) << 16);
            *(u32x4*)(O + (size_t)row * DM + c * 512 + lane * 8) = w;
        }
    }
}

__device__ void phase_prep(const Params& p) {
    const size_t gtid = (size_t)blockIdx.x * NT + threadIdx.x, gsize = (size_t)gridDim.x * NT;
    prep_transpose<1>(p.w_in, 1024, IN_W, WSP(bf16_t, WS_WINT), IN_WP, gtid, gsize);
    prep_transpose<0>(p.w_glu, 512, 512, WSP(bf16_t, WS_WGLUT), 512, gtid, gsize);
    prep_transpose<0>(p.w_ssm_up, 512, 1024, WSP(bf16_t, WS_WSUPT), 1024, gtid, gsize);
    prep_transpose<0>(p.w_attn_up, 512, 1024, WSP(bf16_t, WS_WAUPT), 1024, gtid, gsize);
    prep_transpose<0>(p.w_out, 1024, 1024, WSP(bf16_t, WS_WOUTT), 1024, gtid, gsize);
    {
        bf16_t* wct = WSP(bf16_t, WS_WCT);
        for (size_t i = gtid; i < (size_t)2048 * 1024; i += gsize) {
            int n = (int)(i >> 10), k = (int)(i & 1023);
            int h = n >> 8, half = (n >> 7) & 1, kk = n & 127;
            const float* keyrow = (half ? p.peer_k2 : p.peer_k1) + ((size_t)h * 128 + kk) * 128;
            const float* wrow = p.peer_wq + (size_t)k * 2048 + h * 256 + half * 128;
            float acc = 0.f;
            for (int d = 0; d < 128; d += 4) {
                f32x4 a = *(const f32x4*)(keyrow + d), b = *(const f32x4*)(wrow + d);
                acc += a[0] * b[0] + a[1] * b[1] + a[2] * b[2] + a[3] * b[3];
            }
            wct[i] = (bf16_t)f2bf(acc);
        }
    }
    {
        const size_t n4 = (size_t)16384 * 1024 / 4;
        uint2* ut = WSP(uint2, WS_UTAB); uint2* vt = WSP(uint2, WS_VTAB);
        for (size_t i = gtid; i < n4; i += gsize) {
            f32x4 a = ((const f32x4*)p.peer_u)[i];
            ut[i] = make_uint2(f2bf(a[0]) | (f2bf(a[1]) << 16), f2bf(a[2]) | (f2bf(a[3]) << 16));
            f32x4 b = ((const f32x4*)p.peer_v)[i];
            vt[i] = make_uint2(f2bf(b[0]) | (f2bf(b[1]) << 16), f2bf(b[2]) | (f2bf(b[3]) << 16));
        }
    }
    {
        float2* ra = WSP(float2, WS_ROPEA); float2* ri = WSP(float2, WS_ROPEI);
        for (size_t i = gtid; i < (size_t)SEQ * 32; i += gsize) {
            int pos = (int)(i >> 5), f = (int)(i & 31);
            double s, c; sincos_d((double)pos * p.inv64[f], s, c);
            ra[i] = make_float2((float)c, (float)s);
        }
        for (size_t i = gtid; i < (size_t)SEQ * 16; i += gsize) {
            int pos = (int)(i >> 4), f = (int)(i & 15);
            double s, c; sincos_d((double)pos * p.inv32[f], s, c);
            ri[i] = make_float2((float)c, (float)s);
        }
    }
    {
        float2* abar = WSP(float2, WS_SSMT);
        float2* bbar = abar + SSM_G * SSM_P;
        for (size_t i = gtid; i < (size_t)SSM_G * SSM_P; i += gsize) {
            int g = (int)(i / SSM_P);
            double are = p.a_re[i], aim = p.a_im[i];
            double dt = exp((double)p.log_dt[g]);
            double s, c; sincos_d(aim * dt, s, c);
            double mag = exp(are * dt);
            double abr = mag * c, abi = mag * s;
            abar[i] = make_float2((float)abr, (float)abi);
            double nr = abr - 1.0, ni = abi;
            double den = are * are + aim * aim;
            double qr = (nr * are + ni * aim) / den, qi = (ni * are - nr * aim) / den;
            for (int cch = 0; cch < SSM_N; ++cch) {
                double br = p.b_re[i * SSM_N + cch], bi = p.b_im[i * SSM_N + cch];
                bbar[i * SSM_N + cch] = make_float2((float)(qr * br - qi * bi), (float)(qr * bi + qi * br));
            }
        }
    }
    {
        int lane = threadIdx.x & 63, wave = threadIdx.x >> 6;
        rmsnorm_rows_bf16(p.x, p.norm1_g, WSP(bf16_t, WS_R1), blockIdx.x * (NT / 64) + wave, gridDim.x * (NT / 64), lane);
    }
}

template <class Epi>
__device__ __forceinline__ void gemm_phase(const bf16_t* __restrict__ A, int lda, const bf16_t* __restrict__ Bt, int ldb, int M, int N, int K, const Epi& epi) {
    const int wave = threadIdx.x >> 6, lane = threadIdx.x & 63;
    const int wr = wave >> 1, wc = wave & 1;
    const int tilesN = N / 128, ntiles = (M / 128) * tilesN;
    for (int tile = blockIdx.x; tile < ntiles; tile += gridDim.x) {
        const int tm = tile / tilesN, tn = tile % tilesN;
        const int m0 = tm * 128 + wr * 64, n0 = tn * 128 + wc * 64;
        f32x4 acc[4][4];
#pragma unroll
        for (int i = 0; i < 4; ++i)
#pragma unroll
            for (int j = 0; j < 4; ++j) acc[i][j] = (f32x4){0.f, 0.f, 0.f, 0.f};
        const bf16_t* ap = A + (size_t)(m0 + (lane & 15)) * lda + 8 * (lane >> 4);
        const bf16_t* bp = Bt + (size_t)(n0 + (lane & 15)) * ldb + 8 * (lane >> 4);
#pragma unroll 2
        for (int k0 = 0; k0 < K; k0 += 32) {
            bf16x8 a[4], b[4];
#pragma unroll
            for (int i = 0; i < 4; ++i) a[i] = *(const bf16x8*)(ap + (size_t)i * 16 * lda + k0);
#pragma unroll
            for (int j = 0; j < 4; ++j) b[j] = *(const bf16x8*)(bp + (size_t)j * 16 * ldb + k0);
#pragma unroll
            for (int i = 0; i < 4; ++i)
#pragma unroll
                for (int j = 0; j < 4; ++j) acc[i][j] = __builtin_amdgcn_mfma_f32_16x16x32_bf16(a[i], b[j], acc[i][j], 0, 0, 0);
        }
        epi(acc, m0, n0, lane);
    }
}

struct EpiInProj {
    bf16_t *u, *q, *k, *v, *sgs, *sga;
    float *qi, *ki, *wi;
    const float2 *ropeA, *ropeI;
    __device__ __forceinline__ void operator()(const f32x4 (&acc)[4][4], int m0, int n0, int lane) const {
        const int cl = lane & 15, rq = (lane >> 4) * 4;
#pragma unroll
        for (int i = 0; i < 4; ++i)
#pragma unroll
            for (int r = 0; r < 4; ++r) {
                const int row = m0 + 16 * i + rq + r;
                const int pos = row & (SEQ - 1);
                if (n0 < 512) {
#pragma unroll
                    for (int j = 0; j < 4; ++j) u[(size_t)row * 512 + n0 + 16 * j + cl] = (bf16_t)f2bf(acc[i][j][r]);
                } else if (n0 < 1152) {
                    bf16_t* dst = n0 < 1024 ? q + (size_t)row * 512 + (n0 - 512) : k + (size_t)row * 128 + (n0 - 1024);
#pragma unroll
                    for (int j = 0; j < 2; ++j) {
                        float2 cs = ropeA[pos * 32 + 16 * j + cl];
                        float x1 = acc[i][j][r], x2 = acc[i][j + 2][r];
                        dst[16 * j + cl] = (bf16_t)f2bf(x1 * cs.x - x2 * cs.y);
                        dst[32 + 16 * j + cl] = (bf16_t)f2bf(x2 * cs.x + x1 * cs.y);
                    }
                } else if (n0 < 1280) {
#pragma unroll
                    for (int j = 0; j < 4; ++j) v[(size_t)row * 128 + (n0 - 1152) + 16 * j + cl] = (bf16_t)f2bf(acc[i][j][r]);
                } else if (n0 < 1536) {
                    float2 cs = ropeI[pos * 16 + cl];
                    float* dst = qi + (size_t)row * 256 + (n0 - 1280);
#pragma unroll
                    for (int j = 0; j < 4; j += 2) {
                        float x1 = acc[i][j][r], x2 = acc[i][j + 1][r];
                        dst[16 * j + cl] = x1 * cs.x - x2 * cs.y;
                        dst[16 * j + 16 + cl] = x2 * cs.x + x1 * cs.y;
                    }
                } else if (n0 == 1536) {
                    float2 cs = ropeI[pos * 16 + cl];
                    float x1 = acc[i][0][r], x2 = acc[i][1][r];
                    ki[(size_t)row * 32 + cl] = x1 * cs.x - x2 * cs.y;
                    ki[(size_t)row * 32 + 16 + cl] = x2 * cs.x + x1 * cs.y;
                    if (cl < 8) wi[(size_t)row * 8 + cl] = acc[i][2][r];
                } else if (n0 < 2624) {
#pragma unroll
                    for (int j = 0; j < 4; ++j) sgs[(size_t)row * 1024 + (n0 - 1600) + 16 * j + cl] = (bf16_t)f2bf(sigmoidf_(acc[i][j][r]));
                } else if (n0 < 3648) {
#pragma unroll
                    for (int j = 0; j < 4; ++j) sga[(size_t)row * 1024 + (n0 - 2624) + 16 * j + cl] = (bf16_t)f2bf(sigmoidf_(acc[i][j][r]));
                }
            }
    }
};

struct EpiGlu {
    const bf16_t* y; bf16_t* o;
    __device__ __forceinline__ void operator()(const f32x4 (&acc)[4][4], int m0, int n0, int lane) const {
        const int cl = lane & 15, rq = (lane >> 4) * 4;
#pragma unroll
        for (int i = 0; i < 4; ++i)
#pragma unroll
            for (int r = 0; r < 4; ++r)
#pragma unroll
                for (int j = 0; j < 4; ++j) {
                    size_t idx = (size_t)(m0 + 16 * i + rq + r) * 512 + n0 + 16 * j + cl;
                    o[idx] = (bf16_t)f2bf(bf2f(y[idx]) * sigmoidf_(acc[i][j][r]));
                }
    }
};
struct EpiMerge1 {
    const bf16_t* g; float* t;
    __device__ __forceinline__ void operator()(const f32x4 (&acc)[4][4], int m0, int n0, int lane) const {
        const int cl = lane & 15, rq = (lane >> 4) * 4;
#pragma unroll
        for (int i = 0; i < 4; ++i)
#pragma unroll
            for (int r = 0; r < 4; ++r)
#pragma unroll
                for (int j = 0; j < 4; ++j) {
                    size_t idx = (size_t)(m0 + 16 * i + rq + r) * 1024 + n0 + 16 * j + cl;
                    t[idx] = bf2f(g[idx]) * acc[i][j][r];
                }
    }
};
struct EpiMerge2 {
    const bf16_t* g; const float* t; bf16_t* o;
    __device__ __forceinline__ void operator()(const f32x4 (&acc)[4][4], int m0, int n0, int lane) const {
        const int cl = lane & 15, rq = (lane >> 4) * 4;
#pragma unroll
        for (int i = 0; i < 4; ++i)
#pragma unroll
            for (int r = 0; r < 4; ++r)
#pragma unroll
                for (int j = 0; j < 4; ++j) {
                    size_t idx = (size_t)(m0 + 16 * i + rq + r) * 1024 + n0 + 16 * j + cl;
                    o[idx] = (bf16_t)f2bf(t[idx] + bf2f(g[idx]) * acc[i][j][r]);
                }
    }
};
struct EpiResid {
    const float* x; float* h;
    __device__ __forceinline__ void operator()(const f32x4 (&acc)[4][4], int m0, int n0, int lane) const {
        const int cl = lane & 15, rq = (lane >> 4) * 4;
#pragma unroll
        for (int i = 0; i < 4; ++i)
#pragma unroll
            for (int r = 0; r < 4; ++r)
#pragma unroll
                for (int j = 0; j < 4; ++j) {
                    size_t idx = (size_t)(m0 + 16 * i + rq + r) * 1024 + n0 + 16 * j + cl;
                    h[idx] = x[idx] + acc[i][j][r];
                }
    }
};
struct EpiF32 {
    float* o; int ldc;
    __device__ __forceinline__ void operator()(const f32x4 (&acc)[4][4], int m0, int n0, int lane) const {
        const int cl = lane & 15, rq = (lane >> 4) * 4;
#pragma unroll
        for (int i = 0; i < 4; ++i)
#pragma unroll
            for (int r = 0; r < 4; ++r)
#pragma unroll
                for (int j = 0; j < 4; ++j) o[(size_t)(m0 + 16 * i + rq + r) * ldc + n0 + 16 * j + cl] = acc[i][j][r];
    }
};

__device__ void phase_ssm(const Params& p, unsigned char* smem) {
    const int wave = threadIdx.x >> 6, lane = threadIdx.x & 63;
    float* us = (float*)smem + wave * (64 * 16);
    const float2* abar_t = WSP(float2, WS_SSMT);
    const float2* bbar_t = abar_t + SSM_G * SSM_P;
    const bf16_t* u = WSP(bf16_t, WS_U);
    bf16_t* yg = WSP(bf16_t, WS_YG);
    for (int item = wave * gridDim.x + blockIdx.x; item < NB * SSM_G; item += (NT / 64) * gridDim.x) {
        const int b = item / SSM_G, g = item % SSM_G;
        const float2 ab = abar_t[g * SSM_P + lane];
        float br[16], bi[16], cr[16], ci[16];
#pragma unroll
        for (int c = 0; c < 16; ++c) {
            float2 t = bbar_t[(g * SSM_P + lane) * SSM_N + c];
            br[c] = t.x; bi[c] = t.y;
            cr[c] = p.c_re[((size_t)g * SSM_N + c) * SSM_P + lane];
            ci[c] = p.c_im[((size_t)g * SSM_N + c) * SSM_P + lane];
        }
        const int myc = ((lane >> 5) & 1) * 8 + ((lane >> 4) & 1) * 4 + ((lane >> 3) & 1) * 2 + ((lane >> 2) & 1);
        const float dsk = p.d_skip[g * SSM_N + myc];
        float xr = 0.f, xi = 0.f;
        for (int t0 = 0; t0 < SEQ; t0 += 64) {
            {
                const bf16_t* ur = u + ((size_t)(b * SEQ + t0 + lane)) * SSM_W + g * SSM_N;
                u32x4 w0 = *(const u32x4*)ur, w1 = *(const u32x4*)(ur + 8);
                float* d = us + lane * 16;
                d[0] = bf2f(w0.x & 0xffff); d[1] = bf2f(w0.x >> 16); d[2] = bf2f(w0.y & 0xffff); d[3] = bf2f(w0.y >> 16);
                d[4] = bf2f(w0.z & 0xffff); d[5] = bf2f(w0.z >> 16); d[6] = bf2f(w0.w & 0xffff); d[7] = bf2f(w0.w >> 16);
                d[8] = bf2f(w1.x & 0xffff); d[9] = bf2f(w1.x >> 16); d[10] = bf2f(w1.y & 0xffff); d[11] = bf2f(w1.y >> 16);
                d[12] = bf2f(w1.z & 0xffff); d[13] = bf2f(w1.z >> 16); d[14] = bf2f(w1.w & 0xffff); d[15] = bf2f(w1.w >> 16);
            }
            __builtin_amdgcn_s_waitcnt(0);
            __builtin_amdgcn_wave_barrier();
            for (int tt = 0; tt < 64; ++tt) {
                float uu[16];
#pragma unroll
                for (int c4 = 0; c4 < 4; ++c4) {
                    f32x4 t = *(const f32x4*)(us + tt * 16 + c4 * 4);
                    uu[c4 * 4] = t[0]; uu[c4 * 4 + 1] = t[1]; uu[c4 * 4 + 2] = t[2]; uu[c4 * 4 + 3] = t[3];
                }
                float bur = 0.f, bui = 0.f;
#pragma unroll
                for (int c = 0; c < 16; ++c) { bur += br[c] * uu[c]; bui += bi[c] * uu[c]; }
                float nxr = ab.x * xr - ab.y * xi + bur;
                float nxi = ab.x * xi + ab.y * xr + bui;
                xr = nxr; xi = nxi;
                float z[16];
#pragma unroll
                for (int c = 0; c < 16; ++c) z[c] = cr[c] * xr - ci[c] * xi;
                float w8[8], w4[4], w2[2], w1;
                const bool h5 = lane & 32, h4 = lane & 16, h3 = lane & 8, h2 = lane & 4;
#pragma unroll
                for (int i = 0; i < 8; ++i) { float mine = h5 ? z[8 + i] : z[i], oth = h5 ? z[i] : z[8 + i]; w8[i] = mine + __shfl_xor(oth, 32); }
#pragma unroll
                for (int i = 0; i < 4; ++i) { float mine = h4 ? w8[4 + i] : w8[i], oth = h4 ? w8[i] : w8[4 + i]; w4[i] = mine + __shfl_xor(oth, 16); }
#pragma unroll
                for (int i = 0; i < 2; ++i) { float mine = h3 ? w4[2 + i] : w4[i], oth = h3 ? w4[i] : w4[2 + i]; w2[i] = mine + __shfl_xor(oth, 8); }
                { float mine = h2 ? w2[1] : w2[0], oth = h2 ? w2[0] : w2[1]; w1 = mine + __shfl_xor(oth, 4); }
                w1 += __shfl_xor(w1, 2);
                w1 += __shfl_xor(w1, 1);
                float um = 0.f;
#pragma unroll
                for (int c = 0; c < 16; ++c) um = (c == myc) ? uu[c] : um;
                float y = gelu_tanh(w1 + dsk * um);
                if ((lane & 3) == 0) yg[((size_t)(b * SEQ + t0 + tt)) * SSM_W + g * SSM_N + myc] = (bf16_t)f2bf(y);
            }
            __builtin_amdgcn_wave_barrier();
        }
    }
}

__device__ __forceinline__ unsigned fkey(float f) {
    unsigned u = __builtin_bit_cast(unsigned, f);
    return (u & 0x80000000u) ? ~u : (u | 0x80000000u);
}
__device__ void phase_attn(const Params& p, unsigned char* smem) {
    float* sc = (float*)smem;
    float* qis = sc + 4096;
    float* wis = qis + 256;
    float* qs = wis + 16;
    float* pl = qs + 512;
    int* sel = (int*)(pl + 2048);
    unsigned* hist = (unsigned*)(sel + 256);
    int* scanA = (int*)(hist + 256);
    int* scanB = scanA + 256;
    int* misc = scanB + 256;
    const int tid = threadIdx.x;
    const float* qi = WSP(float, WS_QI); const float* ki = WSP(float, WS_KI); const float* wi = WSP(float, WS_WI);
    const bf16_t* q = WSP(bf16_t, WS_Q); const bf16_t* kk = WSP(bf16_t, WS_K); const bf16_t* vv = WSP(bf16_t, WS_V);
    bf16_t* yatt = WSP(bf16_t, WS_YATT);
    const float idx_scale = 0.35355339059327373f * 0.17677669529663687f;
    for (int row = blockIdx.x; row < MTOK; row += gridDim.x) {
        const int b = row / SEQ, t = row % SEQ, nvalid = t + 1;
        __syncthreads();
        qis[tid] = qi[(size_t)row * 256 + tid];
        if (tid < 8) wis[tid] = wi[(size_t)row * 8 + tid];
        qs[tid] = bf2f(q[(size_t)row * 512 + tid]);
        qs[tid + 256] = bf2f(q[(size_t)row * 512 + 256 + tid]);
        __syncthreads();
        for (int s = tid; s < nvalid; s += NT) {
            const float* kr = ki + ((size_t)b * SEQ + s) * 32;
            float kv[32];
#pragma unroll
            for (int d4 = 0; d4 < 8; ++d4) { f32x4 tt = *(const f32x4*)(kr + d4 * 4); kv[d4 * 4] = tt[0]; kv[d4 * 4 + 1] = tt[1]; kv[d4 * 4 + 2] = tt[2]; kv[d4 * 4 + 3] = tt[3]; }
            float a = 0.f;
#pragma unroll
            for (int h = 0; h < 8; ++h) {
                float d = 0.f;
#pragma unroll
                for (int dd = 0; dd < 32; ++dd) d += qis[h * 32 + dd] * kv[dd];
                a += wis[h] * fmaxf(d, 0.f);
            }
            sc[s] = a * idx_scale;
        }
        __syncthreads();
        int nsel;
        if (nvalid <= TOPK) {
            nsel = nvalid;
            if (tid < nvalid) sel[tid] = tid;
        } else {
            nsel = TOPK;
            unsigned prefix = 0, mask = 0; int need = TOPK;
            for (int pass = 0; pass < 4; ++pass) {
                const int shift = 24 - 8 * pass;
                hist[tid] = 0;
                __syncthreads();
                for (int s = tid; s < nvalid; s += NT) {
                    unsigned key = fkey(sc[s]);
                    if ((key & mask) == prefix) atomicAdd(&hist[(key >> shift) & 255], 1u);
                }
                __syncthreads();
                if (tid == 0) {
                    int cum = 0, bin = 255;
                    for (; bin > 0; --bin) { if (cum + (int)hist[bin] >= need) break; cum += hist[bin]; }
                    misc[0] = bin; misc[1] = need - cum;
                }
                __syncthreads();
                prefix |= (unsigned)misc[0] << shift; mask |= 0xFFu << shift; need = misc[1];
                __syncthreads();
            }
            const int base = tid * 16;
            int cg = 0, ce = 0;
            for (int i = 0; i < 16; ++i) { int s = base + i; if (s < nvalid) { unsigned key = fkey(sc[s]); cg += key > prefix; ce += key == prefix; } }
            scanA[tid] = ce;
            __syncthreads();
            if (tid == 0) { int run = 0; for (int i = 0; i < NT; ++i) { int v = scanA[i]; scanA[i] = run; run += v; } }
            __syncthreads();
            const int preE = scanA[tid];
            int takeE = need - preE; takeE = takeE < 0 ? 0 : (takeE > ce ? ce : takeE);
            scanB[tid] = cg + takeE;
            __syncthreads();
            if (tid == 0) { int run = 0; for (int i = 0; i < NT; ++i) { int v = scanB[i]; scanB[i] = run; run += v; } }
            __syncthreads();
            int off = scanB[tid], te = 0;
            for (int i = 0; i < 16; ++i) {
                int s = base + i;
                if (s < nvalid) {
                    unsigned key = fkey(sc[s]);
                    bool take = key > prefix;
                    if (key == prefix) { take = te < takeE; ++te; }
                    if (take) { if (off < TOPK) sel[off] = s; ++off; }
                }
            }
        }
        __syncthreads();
        if (tid < nsel) {
            const bf16_t* kr = kk + ((size_t)b * SEQ + sel[tid]) * 128;
#pragma unroll
            for (int n = 0; n < 2; ++n) {
                float kf[64];
#pragma unroll
                for (int d8 = 0; d8 < 8; ++d8) {
                    u32x4 w = *(const u32x4*)(kr + n * 64 + d8 * 8);
                    kf[d8 * 8 + 0] = bf2f(w.x & 0xffff); kf[d8 * 8 + 1] = bf2f(w.x >> 16);
                    kf[d8 * 8 + 2] = bf2f(w.y & 0xffff); kf[d8 * 8 + 3] = bf2f(w.y >> 16);
                    kf[d8 * 8 + 4] = bf2f(w.z & 0xffff); kf[d8 * 8 + 5] = bf2f(w.z >> 16);
                    kf[d8 * 8 + 6] = bf2f(w.w & 0xffff); kf[d8 * 8 + 7] = bf2f(w.w >> 16);
                }
#pragma unroll
                for (int hh = 0; hh < 4; ++hh) {
                    const int h = n * 4 + hh;
                    float d = 0.f;
#pragma unroll
                    for (int dd = 0; dd < 64; ++dd) d += qs[h * 64 + dd] * kf[dd];
                    pl[h * 256 + tid] = d * 0.125f;
                }
            }
        } else {
#pragma unroll
            for (int h = 0; h < 8; ++h) pl[h * 256 + tid] = -1e30f;
        }
        __syncthreads();
        {
            const int h = tid >> 5, l32 = tid & 31;
            float vals[8]; float mx = -3e38f;
#pragma unroll
            for (int i = 0; i < 8; ++i) { vals[i] = pl[h * 256 + l32 + 32 * i]; mx = fmaxf(mx, vals[i]); }
#pragma unroll
            for (int o = 16; o >= 1; o >>= 1) mx = fmaxf(mx, __shfl_xor(mx, o));
            float sm = 0.f;
#pragma unroll
            for (int i = 0; i < 8; ++i) { vals[i] = __expf(vals[i] - mx); sm += vals[i]; }
#pragma unroll
            for (int o = 16; o >= 1; o >>= 1) sm += __shfl_xor(sm, o);
            float inv = 1.f / sm;
#pragma unroll
            for (int i = 0; i < 8; ++i) pl[h * 256 + l32 + 32 * i] = vals[i] * inv;
        }
        __syncthreads();
#pragma unroll
        for (int o2 = 0; o2 < 2; ++o2) {
            const int oi = tid + 256 * o2, h = oi >> 6, d = oi & 63, n = h >> 2;
            float a = 0.f;
            for (int j = 0; j < nsel; ++j) a += pl[h * 256 + j] * bf2f(vv[((size_t)b * SEQ + sel[j]) * 128 + n * 64 + d]);
            yatt[(size_t)row * 512 + oi] = (bf16_t)f2bf(a);
        }
    }
}

__device__ void phase_norm2(const Params& p) {
    int lane = threadIdx.x & 63, wave = threadIdx.x >> 6;
    rmsnorm_rows_bf16(p.out, p.norm2_g, WSP(bf16_t, WS_R1), blockIdx.x * (NT / 64) + wave, gridDim.x * (NT / 64), lane);
}

__device__ void phase_peer(const Params& p, unsigned char* smem) {
    const int wave = threadIdx.x >> 6, lane = threadIdx.x & 63;
    float* wsm = (float*)smem + wave * 1024;
    float* sc = wsm;
    float* v1s = wsm + 256; int* i1s = (int*)(wsm + 272); float* v2s = wsm + 288; int* i2s = (int*)(wsm + 304);
    float* tops = wsm + 320;
    int* tope = (int*)(wsm + 336);
    int* eid = (int*)(wsm + 384);
    float* egate = wsm + 512;
    const float* scores = WSP(float, WS_SCORES);
    const bf16_t* hn = WSP(bf16_t, WS_R1);
    const bf16_t* ut = WSP(bf16_t, WS_UTAB); const bf16_t* vt = WSP(bf16_t, WS_VTAB);
    const int nwaves = gridDim.x * (NT / 64);
    int ca = 0, cb = 0;
    {
        int rem = lane; bool found = false;
#pragma unroll
        for (int a = 0; a < 16; ++a) { int cnt = 16 / (a + 1); if (!found) { if (rem < cnt) { ca = a; cb = rem; found = true; } else rem -= cnt; } }
    }
    for (int row = blockIdx.x * (NT / 64) + wave; row < MTOK; row += nwaves) {
        for (int h = 0; h < PEER_H; ++h) {
            const float* sp = scores + (size_t)row * 2048 + h * 256;
            float a0 = sp[lane], a1 = sp[lane + 64], b0 = sp[128 + lane], b1 = sp[192 + lane];
            __builtin_amdgcn_wave_barrier();
            sc[lane] = a0; sc[lane + 64] = a1; sc[128 + lane] = b0; sc[192 + lane] = b1;
            __builtin_amdgcn_s_waitcnt(0);
            __builtin_amdgcn_wave_barrier();
            int ra0 = 0, ra1 = 0, rb0 = 0, rb1 = 0;
            for (int j = 0; j < 64; ++j) {
                float x = sc[j], y = sc[j + 64], z = sc[128 + j], w = sc[192 + j];
                ra0 += (x > a0) || (x == a0 && j < lane); ra0 += (y > a0);
                ra1 += (x >= a1); ra1 += (y > a1) || (y == a1 && j < lane);
                rb0 += (z > b0) || (z == b0 && j < lane); rb0 += (w > b0);
                rb1 += (z >= b1); rb1 += (w > b1) || (w == b1 && j < lane);
            }
            if (ra0 < 16) { v1s[ra0] = a0; i1s[ra0] = lane; }
            if (ra1 < 16) { v1s[ra1] = a1; i1s[ra1] = lane + 64; }
            if (rb0 < 16) { v2s[rb0] = b0; i2s[rb0] = lane; }
            if (rb1 < 16) { v2s[rb1] = b1; i2s[rb1] = lane + 64; }
            __builtin_amdgcn_s_waitcnt(0);
            __builtin_amdgcn_wave_barrier();
            float cv = -3e38f; int cpos = 1 << 20;
            if (lane < 50) { cv = v1s[ca] + v2s[cb]; cpos = ca * 16 + cb; }
            int rk = 0;
            for (int j = 0; j < 50; ++j) {
                float x = __shfl(cv, j); int px = __shfl(cpos, j);
                rk += (x > cv) || (x == cv && px < cpos);
            }
            if (lane < 50 && rk < 16) { tops[rk] = cv; tope[rk] = i1s[ca] * PEER_KEYS + i2s[cb]; }
            __builtin_amdgcn_s_waitcnt(0);
            __builtin_amdgcn_wave_barrier();
            if (lane < 16) {
                float s = tops[lane];
                float mx = s;
#pragma unroll
                for (int o = 8; o >= 1; o >>= 1) mx = fmaxf(mx, __shfl_xor(mx, o, 16));
                float e = __expf(s - mx), sm = e;
#pragma unroll
                for (int o = 8; o >= 1; o >>= 1) sm += __shfl_xor(sm, o, 16);
                eid[h * 16 + lane] = tope[lane];
                egate[h * 16 + lane] = e / sm;
            }
            __builtin_amdgcn_s_waitcnt(0);
            __builtin_amdgcn_wave_barrier();
        }
        float xv[16], acc[16];
        {
            const bf16_t* hr = hn + (size_t)row * DM;
#pragma unroll
            for (int c = 0; c < 2; ++c) {
                u32x4 w = *(const u32x4*)(hr + c * 512 + lane * 8);
                xv[c * 8 + 0] = bf2f(w.x & 0xffff); xv[c * 8 + 1] = bf2f(w.x >> 16); xv[c * 8 + 2] = bf2f(w.y & 0xffff); xv[c * 8 + 3] = bf2f(w.y >> 16);
                xv[c * 8 + 4] = bf2f(w.z & 0xffff); xv[c * 8 + 5] = bf2f(w.z >> 16); xv[c * 8 + 6] = bf2f(w.w & 0xffff); xv[c * 8 + 7] = bf2f(w.w >> 16);
            }
#pragma unroll
            for (int i = 0; i < 16; ++i) acc[i] = 0.f;
        }
        for (int e0 = 0; e0 < 128; e0 += 4) {
            u32x4 uw[4][2];
#pragma unroll
            for (int e = 0; e < 4; ++e) {
                const bf16_t* ur = ut + (size_t)eid[e0 + e] * DM;
                uw[e][0] = *(const u32x4*)(ur + lane * 8); uw[e][1] = *(const u32x4*)(ur + 512 + lane * 8);
            }
            u32x4 vw[4][2];
#pragma unroll
            for (int e = 0; e < 4; ++e) {
                const bf16_t* vr = vt + (size_t)eid[e0 + e] * DM;
                vw[e][0] = *(const u32x4*)(vr + lane * 8); vw[e][1] = *(const u32x4*)(vr + 512 + lane * 8);
            }
            float act[4];
#pragma unroll
            for (int e = 0; e < 4; ++e) {
                float d = 0.f;
#pragma unroll
                for (int c = 0; c < 2; ++c) {
                    u32x4 w = uw[e][c];
                    d += xv[c * 8 + 0] * bf2f(w.x & 0xffff) + xv[c * 8 + 1] * bf2f(w.x >> 16) + xv[c * 8 + 2] * bf2f(w.y & 0xffff) + xv[c * 8 + 3] * bf2f(w.y >> 16)
                       + xv[c * 8 + 4] * bf2f(w.z & 0xffff) + xv[c * 8 + 5] * bf2f(w.z >> 16) + xv[c * 8 + 6] * bf2f(w.w & 0xffff) + xv[c * 8 + 7] * bf2f(w.w >> 16);
                }
                d = wave_sum(d);
                act[e] = gelu_tanh(d) * egate[e0 + e];
            }
#pragma unroll
            for (int e = 0; e < 4; ++e)
#pragma unroll
                for (int c = 0; c < 2; ++c) {
                    u32x4 w = vw[e][c];
                    acc[c * 8 + 0] += act[e] * bf2f(w.x & 0xffff); acc[c * 8 + 1] += act[e] * bf2f(w.x >> 16);
                    acc[c * 8 + 2] += act[e] * bf2f(w.y & 0xffff); acc[c * 8 + 3] += act[e] * bf2f(w.y >> 16);
                    acc[c * 8 + 4] += act[e] * bf2f(w.z & 0xffff); acc[c * 8 + 5] += act[e] * bf2f(w.z >> 16);
                    acc[c * 8 + 6] += act[e] * bf2f(w.w & 0xffff); acc[c * 8 + 7] += act[e] * bf2f(w.w >> 16);
                }
        }
        float* hr = p.out + (size_t)row * DM;
        float ss = 0.f;
#pragma unroll
        for (int c = 0; c < 2; ++c) {
            f32x4 a = *(const f32x4*)(hr + c * 512 + lane * 8), b = *(const f32x4*)(hr + c * 512 + lane * 8 + 4);
#pragma unroll
            for (int i = 0; i < 4; ++i) { acc[c * 8 + i] += a[i]; acc[c * 8 + 4 + i] += b[i]; }
        }
#pragma unroll
        for (int i = 0; i < 16; ++i) ss += acc[i] * acc[i];
        ss = wave_sum(ss);
        const float scl = rsqrtf(ss * (1.f / DM) + NORM_EPS);
#pragma unroll
        for (int c = 0; c < 2; ++c) {
            f32x4 ga = *(const f32x4*)(p.norm_f_g + c * 512 + lane * 8), gb = *(const f32x4*)(p.norm_f_g + c * 512 + lane * 8 + 4);
            f32x4 oa, ob;
#pragma unroll
            for (int i = 0; i < 4; ++i) { oa[i] = acc[c * 8 + i] * scl * ga[i]; ob[i] = acc[c * 8 + 4 + i] * scl * gb[i]; }
            *(f32x4*)(hr + c * 512 + lane * 8) = oa; *(f32x4*)(hr + c * 512 + lane * 8 + 4) = ob;
        }
    }
}

constexpr int SMEM_BYTES = 40960;

template <int PH>
__device__ __forceinline__ void run_phase(const Params& p, unsigned char* smem) {
    if constexpr (PH == 0) phase_prep(p);
    if constexpr (PH == 1) {
        EpiInProj e{WSP(bf16_t, WS_U), WSP(bf16_t, WS_Q), WSP(bf16_t, WS_K), WSP(bf16_t, WS_V), WSP(bf16_t, WS_SGS), WSP(bf16_t, WS_SGA),
                    WSP(float, WS_QI), WSP(float, WS_KI), WSP(float, WS_WI), WSP(float2, WS_ROPEA), WSP(float2, WS_ROPEI)};
        gemm_phase(WSP(bf16_t, WS_R1), 1024, WSP(bf16_t, WS_WINT), 1024, MTOK, IN_WP, 1024, e);
    }
    if constexpr (PH == 2) phase_ssm(p, smem);
    if constexpr (PH == 3) phase_attn(p, smem);
    if constexpr (PH == 4) {
        EpiGlu e{WSP(bf16_t, WS_YG), WSP(bf16_t, WS_YSSM)};
        gemm_phase(WSP(bf16_t, WS_YG), 512, WSP(bf16_t, WS_WGLUT), 512, MTOK, 512, 512, e);
    }
    if constexpr (PH == 5) {
        EpiMerge1 e{WSP(bf16_t, WS_SGS), p.out};
        gemm_phase(WSP(bf16_t, WS_YSSM), 512, WSP(bf16_t, WS_WSUPT), 512, MTOK, 1024, 512, e);
    }
    if constexpr (PH == 6) {
        EpiMerge2 e{WSP(bf16_t, WS_SGA), p.out, WSP(bf16_t, WS_R1)};
        gemm_phase(WSP(bf16_t, WS_YATT), 512, WSP(bf16_t, WS_WAUPT), 512, MTOK, 1024, 512, e);
    }
    if constexpr (PH == 7) {
        EpiResid e{p.x, p.out};
        gemm_phase(WSP(bf16_t, WS_R1), 1024, WSP(bf16_t, WS_WOUTT), 1024, MTOK, 1024, 1024, e);
    }
    if constexpr (PH == 8) phase_norm2(p);
    if constexpr (PH == 9) {
        EpiF32 e{WSP(float, WS_SCORES), 2048};
        gemm_phase(WSP(bf16_t, WS_R1), 1024, WSP(bf16_t, WS_WCT), 1024, MTOK, 2048, 1024, e);
    }
    if constexpr (PH == 10) phase_peer(p, smem);
}

template <int PH>
__global__ void __launch_bounds__(NT) k_phase(Params p) {
    __shared__ __attribute__((aligned(16))) unsigned char smem[SMEM_BYTES];
    run_phase<PH>(p, smem);
}

template <int PH>
static void launch_phase(const Params& p, int grid, hipStream_t stream) {
    hipLaunchKernelGGL(k_phase<PH>, dim3(grid), dim3(NT), 0, stream, p);
}

extern "C" void kernel_launch(void* const* d_in, const int* in_sizes, int n_in, void* d_out, int out_size, void* d_ws, size_t ws_size,
                              hipStream_t stream) {
    Params p{};
    const float** pp = (const float**)&p;
    for (int i = 0; i < 22; ++i) pp[i] = (const float*)d_in[i];
    p.out = (float*)d_out;
    p.ws = (unsigned char*)d_ws;
    for (int f = 0; f < 32; ++f) p.inv64[f] = pow(10000.0, -(double)(2 * f) / 64.0);
    for (int f = 0; f < 16; ++f) p.inv32[f] = pow(10000.0, -(double)(2 * f) / 32.0);
    const int grid = 256 * 4;
    launch_phase<0>(p, grid, stream);
    launch_phase<1>(p, grid, stream);
    launch_phase<2>(p, grid, stream);
    launch_phase<3>(p, grid, stream);
    launch_phase<4>(p, grid, stream);
    launch_phase<5>(p, grid, stream);
    launch_phase<6>(p, grid, stream);
    launch_phase<7>(p, grid, stream);
    launch_phase<8>(p, grid, stream);
    launch_phase<9>(p, grid, stream);
    launch_phase<10>(p, grid, stream);
}
```

```cpp
#include <hip/hip_runtime.h>
#include <cstdio>
#include <cstdint>
#include <cmath>
#define GAS __attribute__((address_space(1)))
#define LAS __attribute__((address_space(3)))
namespace pg8 {
#define PG8_LAS __attribute__((address_space(3)))
typedef unsigned short bf16_t;
typedef short bf16x8 __attribute__((ext_vector_type(8)));
typedef float f32x4 __attribute__((ext_vector_type(4)));
typedef unsigned u32x4 __attribute__((ext_vector_type(4)));
constexpr int BM = 256, BK = 64, HALF = 128, HTB = HALF * BK * 2  , STAGE_BYTES = 8 * HTB, NXCD = 8, WGM = 8;

__host__ __device__ __forceinline__ int lds_byte(int r, int c) { const int st = (r >> 4) * 2 + (c >> 5), rr = r & 15, cc = c & 31, ob = rr * 64 + cc * 2; return st * 1024 + (ob ^ (((ob >> 9) & 1) << 5)); }
__host__ __device__ __forceinline__ void stage_rc(int b, int& R, int& C) { const int st = b / 1024, sb = b % 1024, swz = sb ^ (((sb >> 9) & 1) << 5); R = (st >> 1) * 16 + swz / 64; C = (st & 1) * 32 + (swz % 64) / 2; }
__host__ __device__ __forceinline__ int perm32(int rho) { const int n = rho >> 4, i = rho & 15; return 8 * (i >> 2) + 4 * n + (i & 3); }

struct Unit { int pm, pn, sel; };
struct Gemm { const bf16_t* A; const bf16_t* Bt; int M, N, K; const bf16_t* A2; const bf16_t* Bt2; };

struct StaticOrder {
    int nM, nN, nwg, G, c;
    __host__ __device__ void init(int M, int N, int G_, int c_) { nM = M / BM; nN = N / BM; nwg = nM * nN; G = G_; c = c_; }
    __host__ __device__ bool next(int i, Unit& u) const {
        const long L = (long)i * G + c; if (L >= nwg) return false;
        int wgid = (int)L; { const int q = nwg / NXCD, r = nwg % NXCD, xcd = wgid % NXCD, off = wgid / NXCD; wgid = (xcd < r ? xcd * (q + 1) : r * (q + 1) + (xcd - r) * q) + off; }
        const int nig = WGM * nN, gid = wgid / nig, fm = gid * WGM, gsz = (nM - fm) < WGM ? (nM - fm) : WGM;
        u.pm = fm + ((wgid % nig) % gsz); u.pn = (wgid % nig) / gsz; u.sel = 0; return true;
    }
    __device__ __forceinline__ void a_ready(const Unit&) const {}
    __device__ __forceinline__ void done(const Unit&) const {}
};
struct ChainOrder {
    StaticOrder b;
    __host__ __device__ void init(int M, int N, int G_, int c_) { b.init(M, N, G_, c_); }
    __host__ __device__ bool next(int i, Unit& u) const { if (!b.next(i >> 1, u)) return false; u.sel = i & 1; return true; }
    __device__ __forceinline__ void a_ready(const Unit&) const {}
    __device__ __forceinline__ void done(const Unit&) const {}
};
__device__ __forceinline__ unsigned cvt_pk_bf16(float lo, float hi) { unsigned r; asm volatile("v_cvt_pk_bf16_f32 %0, %1, %2" : "=v"(r) : "v"(lo), "v"(hi)); return r; }
template <class Epi, class Sched, bool ALIGN_EPI = false, bool SP2 = false>
__device__ __forceinline__ void gemm_phase(PG8_LAS unsigned char* lds, const Gemm g, const Sched& S, const Epi& E) {
    int tid_l = threadIdx.x; asm volatile("" : "+v"(tid_l));
    const int tid = tid_l, wid = __builtin_amdgcn_readfirstlane(tid >> 6), lane = tid & 63, wr = wid >> 2, wc = wid & 3, fr = lane & 15, fq = lane >> 4;
    const int K = g.K, nt = K / BK;
    unsigned voffA[2], voffB[2];
#pragma unroll
    for (int i = 0; i < 2; ++i) { int R, C; stage_rc(tid * 16 + i * 8192, R, C); const int Rb = Epi::PERM ? ((R & ~31) + perm32(R & 31)) : R;
        voffA[i] = (unsigned)(R * K + C) * 2u; voffB[i] = (unsigned)(Rb * K + C) * 2u; }
    const size_t kstep = (size_t)(BK * 2);
    const size_t hstep = (size_t)HALF * K * 2;
    const size_t tstep = 2 * hstep;
    const unsigned ldsw = (unsigned)wid * 1024u;
    const int aoff = lds_byte(wr * 64 + fr, fq * 8), boff = lds_byte(wc * 32 + fr, fq * 8);
#define PG8_SA(b, h) (((b) * 2 + (h)) * HTB)
#define PG8_SB(b, h) ((4 + (b) * 2 + (h)) * HTB)
#define PG8_STAGE(bufoff, gbase, voff) do { _Pragma("unroll") for (int _i = 0; _i < 2; ++_i) \
        __builtin_amdgcn_global_load_lds((const unsigned*)((const char*)(gbase) + (voff)[_i]), (PG8_LAS unsigned*)(lds + (bufoff) + ldsw + _i * 8192), 16, 0, 0); } while (0)
#define PG8_LDA(dst, b, h) do { _Pragma("unroll") for (int m = 0; m < 4; ++m) _Pragma("unroll") for (int k = 0; k < 2; ++k) dst[m][k] = *(const PG8_LAS bf16x8*)(lds + PG8_SA(b, h) + aoff + m * 2048 + k * 1024); } while (0)
#define PG8_LDB(dst, b, h) do { _Pragma("unroll") for (int n = 0; n < 2; ++n) _Pragma("unroll") for (int k = 0; k < 2; ++k) dst[n][k] = *(const PG8_LAS bf16x8*)(lds + PG8_SB(b, h) + boff + n * 2048 + k * 1024); } while (0)
#define PG8_MMA(ai, bj, At, Bt) do { __builtin_amdgcn_s_setprio(1); _Pragma("unroll") for (int m = 0; m < 4; ++m) _Pragma("unroll") for (int n = 0; n < 2; ++n) _Pragma("unroll") for (int k = 0; k < 2; ++k) \
        acc[ai][bj][m][n] = __builtin_amdgcn_mfma_f32_16x16x32_bf16(Bt[n][k], At[m][k], acc[ai][bj][m][n], 0, 0, 0); __builtin_amdgcn_s_setprio(0); } while (0)
#define PG8_WAIT_V(n) asm volatile("s_waitcnt vmcnt(" #n ")" ::: "memory")
#define PG8_WAIT_L(n) asm volatile("s_waitcnt lgkmcnt(" #n ")" ::: "memory")
#define PG8_BAR __builtin_amdgcn_s_barrier()
#define PG8_SCHED __builtin_amdgcn_sched_barrier(0)
    Unit cur, nxt; int ui = 0;
    if (!S.next(0, cur)) return;
    f32x4 acc[2][2][4][2];
#pragma unroll
    for (int a = 0; a < 2; ++a)
#pragma unroll
        for (int b = 0; b < 2; ++b)
#pragma unroll
            for (int m = 0; m < 4; ++m)
#pragma unroll
                for (int n = 0; n < 2; ++n) acc[a][b][m][n] = (f32x4){0.f, 0.f, 0.f, 0.f};
    bf16x8 At[4][2], B0[2][2], B1[2][2];
    const char* cA = (const char*)(cur.sel ? g.A2 : g.A) + (size_t)cur.pm * tstep; const char* cB = (const char*)(cur.sel ? g.Bt2 : g.Bt) + (size_t)cur.pn * tstep;
    S.a_ready(cur);
    if constexpr (SP2) {
        PG8_STAGE(PG8_SB(0, 0), cB, voffB); PG8_STAGE(PG8_SB(0, 1), cB + hstep, voffB); PG8_STAGE(PG8_SA(0, 0), cA, voffA); PG8_STAGE(PG8_SA(0, 1), cA + hstep, voffA);
        if (wr == 1) PG8_BAR;
        PG8_WAIT_V(2); PG8_BAR;
        PG8_STAGE(PG8_SB(1, 0), cB + kstep, voffB); PG8_STAGE(PG8_SA(1, 0), cA + kstep, voffA); PG8_STAGE(PG8_SB(1, 1), cB + hstep + kstep, voffB);
        PG8_WAIT_V(6); PG8_BAR;
    } else {
        PG8_STAGE(PG8_SB(0, 0), cB, voffB); PG8_STAGE(PG8_SA(0, 0), cA, voffA); PG8_STAGE(PG8_SB(0, 1), cB + hstep, voffB); PG8_STAGE(PG8_SA(0, 1), cA + hstep, voffA);
        if (wr == 1) PG8_BAR;
        PG8_WAIT_V(4); PG8_BAR;
        PG8_STAGE(PG8_SB(1, 0), cB + kstep, voffB); PG8_STAGE(PG8_SA(1, 0), cA + kstep, voffA); PG8_STAGE(PG8_SB(1, 1), cB + hstep + kstep, voffB);
        PG8_WAIT_V(6); PG8_BAR;
    }
    for (;;) {
        const bool has_next = S.next(ui + 1, nxt);
        const char* nA = has_next ? (const char*)(nxt.sel ? g.A2 : g.A) + (size_t)nxt.pm * tstep : cA; const char* nB = has_next ? (const char*)(nxt.sel ? g.Bt2 : g.Bt) + (size_t)nxt.pn * tstep : cB;
        for (int t = 0; t < nt; t += 2) {
            const bool last = (t == nt - 2);
            const char* a1 = cA + (size_t)(t + 1) * kstep;
            const char* a2 = last ? nA : cA + (size_t)(t + 2) * kstep; const char* b2 = last ? nB : cB + (size_t)(t + 2) * kstep;
            const char* a3 = a2 + kstep; const char* b3 = b2 + kstep;
            if (last && has_next) S.a_ready(nxt);
            if constexpr (SP2) {
            PG8_LDB(B0, 0, 0); PG8_LDB(B1, 0, 1); PG8_SCHED; PG8_LDA(At, 0, 0); PG8_STAGE(PG8_SA(1, 1), a1 + hstep, voffA);
            PG8_WAIT_V(8); PG8_WAIT_L(0); PG8_BAR; PG8_MMA(0, 0, At, B0); PG8_MMA(0, 1, At, B1); PG8_BAR; PG8_SCHED;
            PG8_LDA(At, 0, 1); PG8_STAGE(PG8_SB(0, 0), b2, voffB); PG8_STAGE(PG8_SB(0, 1), b2 + hstep, voffB); PG8_STAGE(PG8_SA(0, 0), a2, voffA);
            PG8_WAIT_V(8); PG8_WAIT_L(0); PG8_BAR; PG8_MMA(1, 0, At, B0); PG8_MMA(1, 1, At, B1); PG8_BAR; PG8_SCHED;
            PG8_LDB(B0, 1, 0); PG8_LDB(B1, 1, 1); PG8_SCHED; PG8_LDA(At, 1, 0); PG8_STAGE(PG8_SA(0, 1), a2 + hstep, voffA);
            PG8_WAIT_V(8); PG8_WAIT_L(0); PG8_BAR; PG8_MMA(0, 0, At, B0); PG8_MMA(0, 1, At, B1); PG8_BAR; PG8_SCHED;
            PG8_LDA(At, 1, 1); PG8_STAGE(PG8_SB(1, 0), b3, voffB); PG8_STAGE(PG8_SB(1, 1), b3 + hstep, voffB); PG8_STAGE(PG8_SA(1, 0), a3, voffA);
            PG8_WAIT_V(8); PG8_WAIT_L(0); PG8_BAR; PG8_MMA(1, 0, At, B0); PG8_MMA(1, 1, At, B1); PG8_BAR; PG8_SCHED;
            } else {
            PG8_LDB(B0, 0, 0); PG8_SCHED; PG8_LDA(At, 0, 0); PG8_STAGE(PG8_SA(1, 1), a1 + hstep, voffA);
            PG8_WAIT_L(8); PG8_BAR; PG8_WAIT_L(0); PG8_MMA(0, 0, At, B0); PG8_BAR; PG8_SCHED;
            PG8_LDB(B1, 0, 1); PG8_STAGE(PG8_SB(0, 0), b2, voffB);
            PG8_BAR; PG8_WAIT_L(0); PG8_MMA(0, 1, At, B1); PG8_BAR;
            PG8_LDA(At, 0, 1); PG8_STAGE(PG8_SA(0, 0), a2, voffA);
            PG8_BAR; PG8_WAIT_L(0); PG8_MMA(1, 0, At, B0); PG8_BAR; PG8_SCHED;
            PG8_STAGE(PG8_SB(0, 1), b2 + hstep, voffB);
            PG8_WAIT_V(6); PG8_BAR; PG8_MMA(1, 1, At, B1); PG8_BAR;
            PG8_LDB(B0, 1, 0); PG8_SCHED; PG8_LDA(At, 1, 0); PG8_STAGE(PG8_SA(0, 1), a2 + hstep, voffA);
            PG8_WAIT_L(8); PG8_BAR; PG8_WAIT_L(0); PG8_MMA(0, 0, At, B0); PG8_BAR; PG8_SCHED;
            PG8_LDB(B1, 1, 1); PG8_STAGE(PG8_SB(1, 0), b3, voffB);
            PG8_BAR; PG8_WAIT_L(0); PG8_MMA(0, 1, At, B1); PG8_BAR;
            PG8_LDA(At, 1, 1); PG8_STAGE(PG8_SA(1, 0), a3, voffA);
            PG8_BAR; PG8_WAIT_L(0); PG8_MMA(1, 0, At, B0); PG8_BAR; PG8_SCHED;
            PG8_STAGE(PG8_SB(1, 1), b3 + hstep, voffB);
            PG8_WAIT_V(6); PG8_BAR; PG8_MMA(1, 1, At, B1); PG8_BAR;
            }
        }
        if constexpr (ALIGN_EPI) { if (wr == 0) PG8_BAR; }
        if constexpr (!Epi::AFTER_DRAIN) { E(acc, cur, wr, wc, fr, fq); S.done(cur); }
        if (!has_next) break;
        if (!(Epi::CHAIN && cur.sel == 0))
#pragma unroll
        for (int a = 0; a < 2; ++a)
#pragma unroll
            for (int b = 0; b < 2; ++b)
#pragma unroll
                for (int m = 0; m < 4; ++m)
#pragma unroll
                    for (int n = 0; n < 2; ++n) acc[a][b][m][n] = (f32x4){0.f, 0.f, 0.f, 0.f};
        cur = nxt; cA = nA; cB = nB; ++ui;
        if constexpr (ALIGN_EPI) { if (wr == 1) PG8_BAR; }
    }
    PG8_WAIT_V(0);
    if constexpr (!ALIGN_EPI) { if (wr == 0) PG8_BAR; }
    PG8_BAR;
    if constexpr (Epi::AFTER_DRAIN) { E.fused(acc, cur, wr, wc, fr, fq, lds, wid, lane); S.done(cur); }
#undef PG8_SA
#undef PG8_SB
#undef PG8_STAGE
#undef PG8_LDA
#undef PG8_LDB
#undef PG8_MMA
#undef PG8_WAIT_V
#undef PG8_WAIT_L
#undef PG8_BAR
#undef PG8_SCHED
}
}
#define XB_TMO      128
#define XB_XCNT(j)  (256  + 64 * (j))
#define XB_XSUB(j)  (1280 + 64 * (j))
#define XB_XGEN(j)  (2304 + 64 * (j))
#define XB_TOP      3328
#define XB_TOPGEN   3392
#define XCD_BAR_WORDS 3456
#define XB_SPIN_CAP (1u << 18)

__device__ __forceinline__ unsigned xb_ld(unsigned* p)              { return __hip_atomic_load(p, __ATOMIC_RELAXED, __HIP_MEMORY_SCOPE_AGENT); }
__device__ __forceinline__ unsigned xb_add(unsigned* p, unsigned v) { return __hip_atomic_fetch_add(p, v, __ATOMIC_RELAXED, __HIP_MEMORY_SCOPE_AGENT); }
__device__ __forceinline__ unsigned xb_xcc_id() { return (unsigned)__builtin_amdgcn_s_getreg((3 << 11) | 20) & 0xFu; }
#define XB_SPIN(cond, bar) do { unsigned _sp = 0; while (cond) { __builtin_amdgcn_s_sleep(1); \
    if ((++_sp & 255u) == 0u) { if (xb_ld(&(bar)[XB_TMO])) break; if (_sp > XB_SPIN_CAP) { atomicAdd(&(bar)[XB_TMO], 1u); break; } } } } while (0)

struct XcdBarrier {
    unsigned* bar; unsigned x;
    volatile LAS unsigned* st;
};

__device__ __forceinline__ XcdBarrier xcd_barrier_post(unsigned* bar, volatile LAS unsigned* st) {
    XcdBarrier b; b.bar = bar; b.x = xb_xcc_id(); b.st = st;
    if (threadIdx.x == 0) (void)xb_add(&bar[XB_XCNT(b.x)], 1u);
    return b;
}
__device__ __forceinline__ void xcd_barrier_complete(unsigned* bar, unsigned x, unsigned& nloc, unsigned& nx) {
    const unsigned G = gridDim.x * gridDim.y * gridDim.z;
    unsigned sum, cnt, mine, sp = 0u;
    for (;;) {
        sum = 0u; cnt = 0u; mine = 0u;
#pragma unroll
        for (unsigned j = 0; j < 16; ++j) { const unsigned c = xb_ld(&bar[XB_XCNT(j)]); sum += c; cnt += (c > 0u) ? 1u : 0u; mine = (j == x) ? c : mine; }
        if (sum == G) break;
        __builtin_amdgcn_s_sleep(1);
        if ((++sp & 255u) == 0u) { if (xb_ld(&bar[XB_TMO])) break; if (sp > XB_SPIN_CAP) { atomicAdd(&bar[XB_TMO], 1u); break; } }
    }
    nloc = mine > 0u ? mine : 1u; nx = cnt > 0u ? cnt : 1u;
}

__device__ __forceinline__ void xcd_barrier(const XcdBarrier& b) {
    asm volatile("s_waitcnt vmcnt(0)" ::: "memory");
    __syncthreads();
    if (threadIdx.x == 0) {
        unsigned* bar = b.bar;
        __builtin_amdgcn_s_waitcnt(0);
        unsigned nloc = b.st[0], nx = b.st[1];
        if (nloc == 0u) { xcd_barrier_complete(bar, b.x, nloc, nx); b.st[0] = nloc; b.st[1] = nx; }
        const unsigned old = xb_add(&bar[XB_XSUB(b.x)], 1u);
        const unsigned gen = old / nloc;
        if (old + 1u == (gen + 1u) * nloc) {
            __builtin_amdgcn_fence(__ATOMIC_RELEASE, "agent");
            asm volatile("s_waitcnt vmcnt(0)" ::: "memory");
            const unsigned og = xb_add(&bar[XB_TOP], 1u);
            const unsigned tg = og / nx;
            if (og + 1u == (tg + 1u) * nx) xb_add(&bar[XB_TOPGEN], 1u);
            else XB_SPIN(xb_ld(&bar[XB_TOPGEN]) == tg, bar);
            __builtin_amdgcn_fence(__ATOMIC_ACQUIRE, "agent");
            xb_add(&bar[XB_XGEN(b.x)], 1u);
            asm volatile("s_waitcnt vmcnt(0)" ::: "memory");
        } else {
            XB_SPIN(xb_ld(&bar[XB_XGEN(b.x)]) == gen, bar);
            __builtin_amdgcn_fence(__ATOMIC_ACQUIRE, "agent");
            asm volatile("s_waitcnt vmcnt(0)" ::: "memory");
        }
    }
    __syncthreads();
}

typedef unsigned short bf16_t;
typedef short bf16x8 __attribute__((ext_vector_type(8)));
typedef float f32x4 __attribute__((ext_vector_type(4)));
typedef unsigned u32x4 __attribute__((ext_vector_type(4)));
using pg8::cvt_pk_bf16;

constexpr int NWAVES = 8, NT = NWAVES * 64;
constexpr int DM = 1024, NB = 8, SEQ = 4096, MTOK = NB * SEQ;
constexpr int SSM_W = 512, SSM_G = 32, SSM_N = 16, SSM_P = 64;
constexpr int IN_W = 3624, IN_WP = 3840;
constexpr int TOPK = 256;
constexpr int PEER_H = 8, PEER_KEYS = 128;
constexpr float NORM_EPS = 1e-6f;
constexpr size_t MiB = 1u << 20;
constexpr int LDS_BYTES = 163840, RING_BYTES = 131072, LDSCTL_OFF = LDS_BYTES - 1024, MISC_OFF = LDSCTL_OFF + 320;
constexpr int CW_BAR = 4096;
constexpr size_t CTL_ZERO_BYTES = 65536;

constexpr size_t WS_WINT = 1, WS_WGLUT = 9, WS_WSUPT = 10, WS_WAUPT = 11, WS_WOUTT = 12, WS_WCT = 14;
constexpr size_t WS_ROPEA = 18, WS_ROPEI = 19, WS_KT = 20, WS_A64 = 21, WS_SSMT = 22, WS_W1T = 254, WS_W3T = 262;
constexpr size_t WS_UTAB = 24, WS_VTAB = 56, WS_USC = 44, WS_VSC = 45;
#if !defined(PEER_FP6) && !defined(PEER_OLD)
#define PEER_FP6 1
#endif
#ifndef PEER_FP6
#define PEER_FP6 0
#endif
#ifndef PEER_U6
#define PEER_U6 PEER_FP6
#endif
#ifndef PEER_V6
#define PEER_V6 PEER_FP6
#endif
#ifndef PEER_FP8
#define PEER_FP8 1
#endif
constexpr size_t WS_R1 = 88;
constexpr size_t WS_U = 152, WS_Q = 184, WS_K = 216, WS_V = 224, WS_QI = 232, WS_KI = 248, WS_WI = 250;
constexpr size_t WS_SGS = 270, WS_SGA = 334, WS_YG = 398, WS_YSSM = 430, WS_YATT = 462, WS_RSS = 494;
constexpr size_t WS_T1 = 152;
constexpr size_t WS_SCORES = 88;
constexpr size_t WS_HG = 398;

struct Params {
    const float *x, *norm1_g, *w_in, *a_re, *a_im, *log_dt, *b_re, *b_im, *c_re, *c_im, *d_skip, *w_glu, *w_ssm_up,
        *w_attn_up, *w_out, *norm2_g, *peer_wq, *peer_k1, *peer_k2, *peer_u, *peer_v, *norm_f_g;
    float* out;
    unsigned char* ws;
    double inv64[32];
    double inv32[16];
};
#define WSP(T, off) ((T*)(p.ws + (size_t)(off) * MiB))

__device__ __forceinline__ unsigned f2bf(float f) {
    unsigned u = __builtin_bit_cast(unsigned, f);
    return (u + 0x7fffu + ((u >> 16) & 1u)) >> 16;
}
__device__ __forceinline__ float bf2f(unsigned b) { return __builtin_bit_cast(float, b << 16); }
__device__ __forceinline__ float bflo(unsigned w) { return __builtin_bit_cast(float, w << 16); }
__device__ __forceinline__ float bfhi(unsigned w) { return __builtin_bit_cast(float, w & 0xffff0000u); }
__device__ __forceinline__ float sigmoidf_(float x) { return 1.f / (1.f + __expf(-x)); }
__device__ __forceinline__ float gelu_tanh(float x) {
    float z = 0.7978845608028654f * (x + 0.044715f * x * x * x);
    float e = __expf(2.f * z);
    float t = 1.f - 2.f / (e + 1.f);
    return 0.5f * x * (1.f + t);
}
template <int CTRL, int RM = 0xf, int BM = 0xf, bool BC = true>
__device__ __forceinline__ float dppf(float old, float src) { return __builtin_bit_cast(float, __builtin_amdgcn_update_dpp(__builtin_bit_cast(int, old), __builtin_bit_cast(int, src), CTRL, RM, BM, BC)); }
template <int CTRL, int RM = 0xf, int BM = 0xf, bool BC = true>
__device__ __forceinline__ int dppi(int old, int src) { return __builtin_amdgcn_update_dpp(old, src, CTRL, RM, BM, BC); }
__device__ __forceinline__ float wave_sum(float v) {
    v += dppf<0x111>(0.f, v); v += dppf<0x112>(0.f, v); v += dppf<0x114>(0.f, v); v += dppf<0x118>(0.f, v);
    v += dppf<0x142, 0xa, 0xf, false>(0.f, v); v += dppf<0x143, 0xc, 0xf, false>(0.f, v);
    return __builtin_bit_cast(float, __builtin_amdgcn_readlane(__builtin_bit_cast(int, v), 63));
}
__device__ __forceinline__ float wave_max(float v) {
    v = fmaxf(v, dppf<0x111, 0xf, 0xf, false>(v, v)); v = fmaxf(v, dppf<0x112, 0xf, 0xf, false>(v, v)); v = fmaxf(v, dppf<0x114, 0xf, 0xf, false>(v, v)); v = fmaxf(v, dppf<0x118, 0xf, 0xf, false>(v, v));
    v = fmaxf(v, dppf<0x142, 0xa, 0xf, false>(v, v)); v = fmaxf(v, dppf<0x143, 0xc, 0xf, false>(v, v));
    return __builtin_bit_cast(float, __builtin_amdgcn_readlane(__builtin_bit_cast(int, v), 63));
}
__device__ __forceinline__ int wave_incl_scan(int v) {
    v += dppi<0x111>(0, v); v += dppi<0x112>(0, v); v += dppi<0x114>(0, v); v += dppi<0x118>(0, v);
    v += dppi<0x142, 0xa, 0xf, false>(0, v); v += dppi<0x143, 0xc, 0xf, false>(0, v);
    return v;
}
__device__ __forceinline__ u32x4 pack8(f32x4 a, f32x4 b) {
    u32x4 w; w.x = cvt_pk_bf16(a[0], a[1]); w.y = cvt_pk_bf16(a[2], a[3]); w.z = cvt_pk_bf16(b[0], b[1]); w.w = cvt_pk_bf16(b[2], b[3]);
    return w;
}
__device__ __forceinline__ uint2 pack8_fp8(f32x4 a, f32x4 b) {
    int w0 = __builtin_amdgcn_cvt_pk_fp8_f32(a[0], a[1], 0, false); w0 = __builtin_amdgcn_cvt_pk_fp8_f32(a[2], a[3], w0, true);
    int w1 = __builtin_amdgcn_cvt_pk_fp8_f32(b[0], b[1], 0, false); w1 = __builtin_amdgcn_cvt_pk_fp8_f32(b[2], b[3], w1, true);
    return make_uint2((unsigned)w0, (unsigned)w1);
}
typedef float f32x2_t __attribute__((ext_vector_type(2)));
__device__ __forceinline__ void unpack8_fp8(uint2 w, f32x4& a, f32x4& b) {
    const f32x2_t p0 = __builtin_amdgcn_cvt_pk_f32_fp8((int)w.x, false), p1 = __builtin_amdgcn_cvt_pk_f32_fp8((int)w.x, true);
    const f32x2_t p2 = __builtin_amdgcn_cvt_pk_f32_fp8((int)w.y, false), p3 = __builtin_amdgcn_cvt_pk_f32_fp8((int)w.y, true);
    a = (f32x4){p0[0], p0[1], p1[0], p1[1]}; b = (f32x4){p2[0], p2[1], p3[0], p3[1]};
}
__device__ __forceinline__ void unpack8(u32x4 w, f32x4& a, f32x4& b) {
    a[0] = bflo(w.x); a[1] = bfhi(w.x); a[2] = bflo(w.y); a[3] = bfhi(w.y);
    b[0] = bflo(w.z); b[1] = bfhi(w.z); b[2] = bflo(w.w); b[3] = bfhi(w.w);
}

template <class T> __device__ __forceinline__ T ldws(const unsigned char* ws, unsigned off) { return *(const T*)(ws + off); }
__device__ __forceinline__ void sincos_d(double x, double& s, double& c) {
    const double TWO_OVER_PI = 0.63661977236758134308;
    const double PIO2_HI = 1.57079632679489655800e+00, PIO2_LO = 6.12323399573676603587e-17;
    double kd = rint(x * TWO_OVER_PI);
    double r = fma(-kd, PIO2_HI, x);
    r = fma(-kd, PIO2_LO, r);
    long long k = (long long)kd;
    double r2 = r * r;
    double sp = r * (1.0 + r2 * (-1.0 / 6 + r2 * (1.0 / 120 + r2 * (-1.0 / 5040 + r2 * (1.0 / 362880 + r2 * (-1.0 / 39916800 + r2 * (1.0 / 6227020800.0)))))));
    double cp = 1.0 + r2 * (-0.5 + r2 * (1.0 / 24 + r2 * (-1.0 / 720 + r2 * (1.0 / 40320 + r2 * (-1.0 / 3628800 + r2 * (1.0 / 479001600.0 + r2 * (-1.0 / 87178291200.0)))))));
    int q = (int)(k & 3);
    double ss = (q & 1) ? cp : sp, cc = (q & 1) ? sp : cp;
    if (q == 1) cc = -cc;
    if (q == 2) { ss = -ss; cc = -cc; }
    if (q == 3) ss = -ss;
    s = ss; c = cc;
}

__device__ __forceinline__ int winsrc(int v) {
    if (v < 512) return v;
    if (v < 1152) { const int b = v < 1024 ? 512 : 1024; int w = v - b; const int hd = w >> 6; w &= 63; const int i = w >> 3, jj = w & 7;
        return b + hd * 64 + (jj < 4 ? 4 * i + jj : 32 + 4 * i + (jj - 4)); }
    if (v < 1280) return v;
    if (v < 1568) { int w = v - 1280; const int hd = w >> 5; w &= 31; const int i = w >> 3, jj = w & 7;
        return 1280 + hd * 32 + (jj < 4 ? 4 * i + jj : 16 + 4 * i + (jj - 4)); }
    if (v < 1576) return v;
    if (v < 1792) return -1;
    if (v < 2816) return 1576 + (v - 1792);
    return 2600 + (v - 2816);
}
template <bool MAP>
__device__ __forceinline__ void transpose_item(const float* __restrict__ W, int K, int N, bf16_t* WT, int Nout, float* scr, int item, int lane) {
    const int nblk = Nout / 32, kb = item / nblk, nb = item % nblk, k0 = 64 * kb, n0 = 32 * nb;
    const int src = MAP ? winsrc(n0 + (lane & 31)) : n0 + (lane & 31);
#pragma unroll 8
    for (int i = 0; i < 32; ++i) { const int kk = 2 * i + (lane >> 5); scr[kk * 33 + (lane & 31)] = src >= 0 ? W[(size_t)(k0 + kk) * N + src] : 0.f; }
    asm volatile("s_waitcnt lgkmcnt(0)" ::: "memory");
    const int c = lane & 7;
#pragma unroll
    for (int j = 0; j < 4; ++j) {
        const int n = (lane >> 3) + 8 * j; const float* s = scr + (8 * c) * 33 + n;
        u32x4 o; o.x = cvt_pk_bf16(s[0 * 33], s[1 * 33]); o.y = cvt_pk_bf16(s[2 * 33], s[3 * 33]); o.z = cvt_pk_bf16(s[4 * 33], s[5 * 33]); o.w = cvt_pk_bf16(s[6 * 33], s[7 * 33]);
        *(u32x4*)(WT + (size_t)(n0 + n) * K + k0 + 8 * c) = o;
    }
    asm volatile("s_waitcnt lgkmcnt(0)" ::: "memory");
}


__device__ __forceinline__ unsigned fp6_code(float y) {
    const float a = fabsf(y);
    unsigned c;
    if (a < 1.f) c = (unsigned)(a * 8.f + 0.5f);
    else { c = ((__float_as_uint(a) + 0x00080000u) >> 20) - 1008u; c = c > 31u ? 31u : c; }
    return c | (y < 0.f ? 32u : 0u);
}
__device__ __forceinline__ void fp6_pack16(const unsigned (&c)[16], unsigned& w0, unsigned& w1, unsigned& w2) {
    w0 = c[0] | (c[1] << 6) | (c[2] << 12) | (c[3] << 18) | (c[4] << 24) | (c[5] << 30);
    w1 = (c[5] >> 2) | (c[6] << 4) | (c[7] << 10) | (c[8] << 16) | (c[9] << 22) | (c[10] << 28);
    w2 = (c[10] >> 4) | (c[11] << 2) | (c[12] << 8) | (c[13] << 14) | (c[14] << 20) | (c[15] << 26);
}
__device__ __forceinline__ void peer_table_row(const Params& p, int r, int lane, unsigned char* stage) {
    unsigned char* ut = WSP(unsigned char, WS_UTAB); unsigned char* vt = WSP(unsigned char, WS_VTAB);
    float* usc = WSP(float, WS_USC); float* vsc = WSP(float, WS_VSC);
    const int tb = r >> 14, e = r & 16383;
    const float* src = (tb ? p.peer_v : p.peer_u) + (size_t)e * DM;
    const bool six = tb ? (PEER_V6 != 0) : (PEER_U6 == 1);
    const bool nat16 = six && tb == 0;
    const int o0 = nat16 ? lane * 16 : lane * 8, o1 = nat16 ? lane * 16 + 8 : 512 + lane * 8;
    const f32x4 a0 = *(const f32x4*)(src + o0), a1 = *(const f32x4*)(src + o0 + 4), a2 = *(const f32x4*)(src + o1), a3 = *(const f32x4*)(src + o1 + 4);
    float m = 0.f;
#pragma unroll
    for (int i = 0; i < 4; ++i) m = fmaxf(m, fmaxf(fmaxf(fabsf(a0[i]), fabsf(a1[i])), fmaxf(fabsf(a2[i]), fabsf(a3[i]))));
    m = wave_max(m);
    if (six) {
        const float sc = m > 0.f ? 7.5f / m : 1.f;
        unsigned cd[16];
#pragma unroll
        for (int i = 0; i < 4; ++i) { cd[i] = fp6_code(a0[i] * sc); cd[4 + i] = fp6_code(a1[i] * sc); cd[8 + i] = fp6_code(a2[i] * sc); cd[12 + i] = fp6_code(a3[i] * sc); }
        unsigned w0, w1, w2; fp6_pack16(cd, w0, w1, w2);
        if (tb) { unsigned* dst = (unsigned*)(vt + (size_t)e * 768 + lane * 12); dst[0] = w0; dst[1] = w1; dst[2] = w2; }
        else {
            unsigned* st = (unsigned*)(stage + lane * 12); st[0] = w0; st[1] = w1; st[2] = w2;
            __builtin_amdgcn_s_waitcnt(0xC07F); __builtin_amdgcn_wave_barrier();
            if (lane < 48) {
                const int k3 = lane >> 3, h = (lane >> 2) & 1, q = lane & 3;
                *(u32x4*)(ut + (size_t)e * 768 + lane * 16) = *(const u32x4*)(stage + h * 384 + q * 96 + k3 * 16);
            }
            __builtin_amdgcn_s_waitcnt(0xC07F); __builtin_amdgcn_wave_barrier();
        }
        if (lane == 0) (tb ? vsc : usc)[e] = 1.f / sc;
    } else {
        const float sc = m > 0.f ? 224.f / m : 1.f;
        const uint2 w01 = pack8_fp8(a0 * sc, a1 * sc), w23 = pack8_fp8(a2 * sc, a3 * sc);
        if (tb == 0) {
            *(uint2*)(ut + (size_t)e * 1024 + lane * 8) = w01; *(uint2*)(ut + (size_t)e * 1024 + 512 + lane * 8) = w23;
            if (lane == 0) usc[e] = 1.f / sc;
        } else {
            *(u32x4*)(vt + (size_t)e * 1024 + lane * 16) = (u32x4){w01.x, w01.y, w23.x, w23.y};
            if (lane == 0) vsc[e] = 1.f / sc;
        }
    }
}
template <int PART>
__device__ __forceinline__ void phase_prep(const Params& p, unsigned char* smem, int vcu, int G) {
    int tid = threadIdx.x; asm volatile("" : "+v"(tid)); const int lane = tid & 63, wave = tid >> 6;
    const int gw = vcu * NWAVES + wave, NGW = G * NWAVES;
    const size_t gtid = (size_t)vcu * NT + tid, gsize = (size_t)G * NT;
    float* scr = (float*)smem + wave * 4096;
#pragma unroll 1
    for (int ord = 0; ord < 2; ++ord) {
    if ((ord == 0) != ((wave & 1) != 0)) {
    {
        constexpr int I_IN = 16 * (IN_WP / 32), I_GLU = 8 * 16, I_SUP = 8 * 32, I_AUP = 8 * 32, I_OUT = 16 * 32;
        constexpr int NITEMS = I_IN + I_GLU + I_SUP + I_AUP + I_OUT;
        for (int it = (PART == 0 ? gw : NITEMS); it < NITEMS; it += NGW) {
            int r = it;
            if (r < I_IN) { transpose_item<true>(p.w_in, 1024, IN_W, WSP(bf16_t, WS_WINT), IN_WP, scr, r, lane); continue; } r -= I_IN;
            if (r < I_GLU) { transpose_item<false>(p.w_glu, 512, 512, WSP(bf16_t, WS_WGLUT), 512, scr, r, lane); continue; } r -= I_GLU;
            if (r < I_SUP) { transpose_item<false>(p.w_ssm_up, 512, 1024, WSP(bf16_t, WS_WSUPT), 1024, scr, r, lane); continue; } r -= I_SUP;
            if (r < I_AUP) { transpose_item<false>(p.w_attn_up, 512, 1024, WSP(bf16_t, WS_WAUPT), 1024, scr, r, lane); continue; } r -= I_AUP;
            transpose_item<false>(p.w_out, 1024, 1024, WSP(bf16_t, WS_WOUTT), 1024, scr, r, lane);
        }
    }
    if (PART == 0) {
    {
        bf16_t* wct = WSP(bf16_t, WS_WCT);
        for (int it = gw; it < 16 * 8 * 64; it += NGW) {
            const int hh = it >> 9, kt = (it >> 6) & 7, ct = it & 63;
            const int h = hh >> 1, half = hh & 1;
            const float* ap = (half ? p.peer_k2 : p.peer_k1) + ((size_t)h * 128 + kt * 16 + (lane & 15)) * 128 + (lane >> 4);
            const float* bp = p.peer_wq + (size_t)(ct * 16 + (lane & 15)) * 2048 + h * 256 + half * 128 + (lane >> 4);
            f32x4 acc = {0.f, 0.f, 0.f, 0.f};
#pragma unroll 8
            for (int d0 = 0; d0 < 128; d0 += 4) acc = __builtin_amdgcn_mfma_f32_16x16x4f32(ap[d0], bp[d0], acc, 0, 0, 0);
            const float g2k = p.norm2_g[ct * 16 + (lane & 15)];
#pragma unroll
            for (int r = 0; r < 4; ++r) wct[(size_t)(hh * 128 + kt * 16 + 4 * (lane >> 4) + r) * 1024 + ct * 16 + (lane & 15)] = (bf16_t)f2bf(acc[r] * g2k);
        }
    }
#if !PEER_FP8
    {
        const size_t n8 = (size_t)16384 * 1024 / 8;
        u32x4* ut = WSP(u32x4, WS_UTAB); u32x4* vt = WSP(u32x4, WS_VTAB);
        for (size_t i = gtid; i < n8; i += gsize) {
            f32x4 a = ((const f32x4*)p.peer_u)[2 * i], b = ((const f32x4*)p.peer_u)[2 * i + 1];
            ut[i] = pack8(a, b);
            f32x4 c = ((const f32x4*)p.peer_v)[2 * i], d = ((const f32x4*)p.peer_v)[2 * i + 1];
            vt[i] = pack8(c, d);
        }
    }
#endif
    }
    if (PART == 0) {
    {
        float2* ra = WSP(float2, WS_ROPEA); float2* ri = WSP(float2, WS_ROPEI);
        for (size_t i = gtid; i < (size_t)SEQ * 32; i += gsize) {
            int pos = (int)(i >> 5), f = (int)(i & 31);
            double s, c; sincos_d((double)pos * p.inv64[f], s, c);
            ra[i] = make_float2((float)c, (float)s);
        }
        for (size_t i = gtid; i < (size_t)SEQ * 16; i += gsize) {
            int pos = (int)(i >> 4), f = (int)(i & 15);
            double s, c; sincos_d((double)pos * p.inv32[f], s, c);
            ri[i] = make_float2((float)c, (float)s);
        }
    }
    }
    {
    if (PART == 0) {
        float2* abar = WSP(float2, WS_SSMT);
        float2* bbar = abar + SSM_G * SSM_P;
        for (size_t i = gtid; i < (size_t)SSM_G * SSM_P; i += gsize) {
            int g = (int)(i / SSM_P);
            double are = p.a_re[i], aim = p.a_im[i];
            double dt = exp((double)p.log_dt[g]);
            double s, c; sincos_d(aim * dt, s, c);
            double mag = exp(are * dt);
            double abr = mag * c, abi = mag * s;
            abar[i] = make_float2((float)abr, (float)abi);
            double nr = abr - 1.0, ni = abi;
            double den = are * are + aim * aim;
            double qr = (nr * are + ni * aim) / den, qi = (ni * are - nr * aim) / den;
            for (int cch = 0; cch < SSM_N; ++cch) {
                double br = p.b_re[i * SSM_N + cch], bi = p.b_im[i * SSM_N + cch];
                bbar[i * SSM_N + cch] = make_float2((float)(qr * br - qi * bi), (float)(qr * bi + qi * br));
            }
        }
    }

    {
        bf16_t* kt = WSP(bf16_t, WS_KT);
        float* zb = (float*)smem + wave * 4096;
        for (int pair = (PART == 0 ? gw : SSM_G * 64); pair < SSM_G * 64; pair += NGW) {
            const int g = pair >> 6, l = pair & 63;
            {
                const int pp = lane; const size_t i = (size_t)g * SSM_P + pp;
                const double are = p.a_re[i], aim = p.a_im[i], dt = exp((double)p.log_dt[g]);
                double s1, c1; sincos_d(aim * dt, s1, c1); const double m1 = exp(are * dt);
                const double nr = m1 * c1 - 1.0, ni = m1 * s1, den = are * are + aim * aim;
                const double qr = (nr * are + ni * aim) / den, qi_ = (ni * are - nr * aim) / den;
                double sl, cl; sincos_d(aim * dt * l, sl, cl); const double ml = exp(are * dt * l);
                const double zr = ml * cl, zi = ml * sl;
                const double zqr = zr * qr - zi * qi_, zqi = zr * qi_ + zi * qr;
#pragma unroll
                for (int ci = 0; ci < 16; ++ci) {
                    const double br = p.b_re[i * SSM_N + ci], bi = p.b_im[i * SSM_N + ci];
                    *(float2*)(zb + 2 * (pp * 16 + ci)) = make_float2((float)(zqr * br - zqi * bi), (float)(zqr * bi + zqi * br));
                }
            }
            __builtin_amdgcn_s_waitcnt(0xC07F);
            __builtin_amdgcn_wave_barrier();
#pragma unroll 1
            for (int q4 = 0; q4 < 4; ++q4) {
                const int ent = q4 * 64 + lane, co = ent >> 4, ci = ent & 15;
                float acc = 0.f;
                for (int pp = 0; pp < 64; ++pp) {
                    const float cr = p.c_re[((size_t)g * SSM_N + co) * SSM_P + pp], cim = p.c_im[((size_t)g * SSM_N + co) * SSM_P + pp];
                    const float2 z = *(const float2*)(zb + 2 * (pp * 16 + ci));
                    acc += cr * z.x - cim * z.y;
                }
                if (l == 0 && co == ci) acc += p.d_skip[g * SSM_N + co];
                kt[(((size_t)g * 64 + l) * 2 + (ci >> 3)) * 128 + co * 8 + (ci & 7)] = (bf16_t)f2bf(acc);
            }
            __builtin_amdgcn_wave_barrier();
        }
        bf16_t* w1t = WSP(bf16_t, WS_W1T); bf16_t* w3t = WSP(bf16_t, WS_W3T); float2* a64 = WSP(float2, WS_A64);
        for (size_t it = (PART == 1 ? gtid : (size_t)SSM_G * SSM_P * 64); it < (size_t)SSM_G * SSM_P * 64; it += gsize) {
            const int e = (int)(it & 63), pp = (int)((it >> 6) & 63), g = (int)(it >> 12);
            const size_t i = (size_t)g * SSM_P + pp;
            const double are = p.a_re[i], aim = p.a_im[i], dt = exp((double)p.log_dt[g]);
            double s1, c1; sincos_d(aim * dt, s1, c1); const double m1 = exp(are * dt);
            const double nr = m1 * c1 - 1.0, ni = m1 * s1, den = are * are + aim * aim;
            const double qr = (nr * are + ni * aim) / den, qi_ = (ni * are - nr * aim) / den;
            {
                const int l = 63 - e; double sl, cl; sincos_d(aim * dt * l, sl, cl); const double ml = exp(are * dt * l);
                const double zr = ml * cl, zi = ml * sl, wr_ = zr * qr - zi * qi_, wi_ = zr * qi_ + zi * qr;
                unsigned re_w[8], im_w[8];
#pragma unroll
                for (int c2 = 0; c2 < 8; ++c2) {
                    const double br0 = p.b_re[i * SSM_N + 2 * c2], bi0 = p.b_im[i * SSM_N + 2 * c2], br1 = p.b_re[i * SSM_N + 2 * c2 + 1], bi1 = p.b_im[i * SSM_N + 2 * c2 + 1];
                    re_w[c2] = f2bf((float)(wr_ * br0 - wi_ * bi0)) | (f2bf((float)(wr_ * br1 - wi_ * bi1)) << 16);
                    im_w[c2] = f2bf((float)(wr_ * bi0 + wi_ * br0)) | (f2bf((float)(wr_ * bi1 + wi_ * br1)) << 16);
                }
                u32x4* d0 = (u32x4*)(w1t + ((size_t)g * 128 + 2 * pp) * 1024 + e * 16);
                d0[0] = (u32x4){re_w[0], re_w[1], re_w[2], re_w[3]}; d0[1] = (u32x4){re_w[4], re_w[5], re_w[6], re_w[7]};
                u32x4* d1 = (u32x4*)(w1t + ((size_t)g * 128 + 2 * pp + 1) * 1024 + e * 16);
                d1[0] = (u32x4){im_w[0], im_w[1], im_w[2], im_w[3]}; d1[1] = (u32x4){im_w[4], im_w[5], im_w[6], im_w[7]};
            }
            {
                const int l = e + 1; double sl, cl; sincos_d(aim * dt * l, sl, cl); const double ml = exp(are * dt * l);
                const double zr = ml * cl, zi = ml * sl;
                for (int co = 0; co < 16; ++co) {
                    const double cr = p.c_re[((size_t)g * SSM_N + co) * SSM_P + pp], cim = p.c_im[((size_t)g * SSM_N + co) * SSM_P + pp];
                    const unsigned w = f2bf((float)(cr * zr - cim * zi)) | (f2bf((float)(-(cr * zi + cim * zr))) << 16);
                    *(unsigned*)(w3t + (((size_t)g * 64 + e) * 16 + co) * 128 + 2 * pp) = w;
                }
            }
            if (e == 0) { double sl, cl; sincos_d(aim * dt * 64, sl, cl); const double ml = exp(are * dt * 64); a64[i] = make_float2((float)(ml * cl), (float)(ml * sl)); }
        }
    }
    }
    } else {
    if (PART == 0) {
    {
        bf16_t* O = WSP(bf16_t, WS_R1);
        for (int row = gw; row < MTOK; row += NGW) {
            const float* xr = p.x + (size_t)row * DM;
            f32x4 v[4]; float ss = 0.f;
#pragma unroll
            for (int c = 0; c < 2; ++c) {
                v[2 * c] = *(const f32x4*)(xr + c * 512 + lane * 8); v[2 * c + 1] = *(const f32x4*)(xr + c * 512 + lane * 8 + 4);
            }
#pragma unroll
            for (int i = 0; i < 4; ++i) ss += v[i][0] * v[i][0] + v[i][1] * v[i][1] + v[i][2] * v[i][2] + v[i][3] * v[i][3];
            ss = wave_sum(ss);
            const float sc = rsqrtf(ss * (1.f / DM) + NORM_EPS);
#pragma unroll
            for (int c = 0; c < 2; ++c) {
                f32x4 ga = *(const f32x4*)(p.norm1_g + c * 512 + lane * 8), gb = *(const f32x4*)(p.norm1_g + c * 512 + lane * 8 + 4);
                *(u32x4*)(O + (size_t)row * DM + c * 512 + lane * 8) = pack8(v[2 * c] * sc * ga, v[2 * c + 1] * sc * gb);
            }
        }
    }
    }
    }
    }
}

#define EPI_ARGS const f32x4 (&acc)[2][2][4][2], const pg8::Unit& u, int wr_, int wc_, int fr_, int fq_
#define EPI_COORDS int t_ = threadIdx.x; asm volatile("" : "+v"(t_)); const int wid_ = __builtin_amdgcn_readfirstlane(t_ >> 6); \
    const int wr = wid_ >> 2, wc = wid_ & 3, fr = t_ & 15, fq = (t_ >> 4) & 3; (void)wr_; (void)wc_; (void)fr_; (void)fq_;
#define EPI_LOOP(...) \
    _Pragma("unroll") for (int ai = 0; ai < 2; ++ai) _Pragma("unroll") for (int m = 0; m < 4; ++m) { \
        const int row = u.pm * 256 + ai * 128 + wr * 64 + m * 16 + fr; \
        _Pragma("unroll") for (int bj = 0; bj < 2; ++bj) { const int vc = bj * 128 + wc * 32 + fq * 8; const f32x4 a0 = acc[ai][bj][m][0], a1 = acc[ai][bj][m][1]; __VA_ARGS__ } }

struct EpiInProj {
    static constexpr bool PERM = true, AFTER_DRAIN = false, CHAIN = false;
    bf16_t *u_, *q, *k, *v, *qi, *ki, *sgs, *sga; float* wi; const float2 *ropeA, *ropeI;
    __device__ __forceinline__ void rope_store(bf16_t* dst, const float2* cs, f32x4 a0, f32x4 a1) const {
        const f32x4 c01 = *(const f32x4*)cs, c23 = *(const f32x4*)(cs + 2);
        f32x4 r1, r2;
        r1[0] = a0[0] * c01[0] - a1[0] * c01[1]; r2[0] = a1[0] * c01[0] + a0[0] * c01[1];
        r1[1] = a0[1] * c01[2] - a1[1] * c01[3]; r2[1] = a1[1] * c01[2] + a0[1] * c01[3];
        r1[2] = a0[2] * c23[0] - a1[2] * c23[1]; r2[2] = a1[2] * c23[0] + a0[2] * c23[1];
        r1[3] = a0[3] * c23[2] - a1[3] * c23[3]; r2[3] = a1[3] * c23[2] + a0[3] * c23[3];
        *(u32x4*)dst = pack8(r1, r2);
    }
    __device__ __forceinline__ void rope_store8(unsigned char* dst, const float2* cs, f32x4 a0, f32x4 a1) const {
        const f32x4 c01 = *(const f32x4*)cs, c23 = *(const f32x4*)(cs + 2);
        f32x4 r1, r2;
        r1[0] = a0[0] * c01[0] - a1[0] * c01[1]; r2[0] = a1[0] * c01[0] + a0[0] * c01[1];
        r1[1] = a0[1] * c01[2] - a1[1] * c01[3]; r2[1] = a1[1] * c01[2] + a0[1] * c01[3];
        r1[2] = a0[2] * c23[0] - a1[2] * c23[1]; r2[2] = a1[2] * c23[0] + a0[2] * c23[1];
        r1[3] = a0[3] * c23[2] - a1[3] * c23[3]; r2[3] = a1[3] * c23[2] + a0[3] * c23[3];
        *(uint2*)dst = pack8_fp8(r1 * 16.f, r2 * 16.f);
    }
    __device__ __forceinline__ void operator()(EPI_ARGS) const {
        EPI_COORDS
        const int pn = u.pn;
        if (pn < 2) {
            EPI_LOOP({ *(u32x4*)(u_ + (size_t)row * 512 + pn * 256 + vc) = pack8(a0, a1); })
        } else if (pn < 4) {
            EPI_LOOP({ rope_store(q + (size_t)row * 512 + (pn - 2) * 256 + vc, ropeA + (row & (SEQ - 1)) * 32 + ((wc & 1) * 4 + fq) * 4, a0, a1); })
        } else if (pn == 4) {
            EPI_LOOP({ if (bj == 0) rope_store8((unsigned char*)k + (size_t)row * 128 + vc, ropeA + (row & (SEQ - 1)) * 32 + ((wc & 1) * 4 + fq) * 4, a0, a1);
                       else *(uint2*)((unsigned char*)v + (size_t)row * 128 + (vc - 128)) = pack8_fp8(a0 * 16.f, a1 * 16.f); })
        } else if (pn == 5) {
            EPI_LOOP({ rope_store(qi + (size_t)row * 256 + vc, ropeI + (row & (SEQ - 1)) * 16 + fq * 4, a0, a1); })
        } else if (pn == 6) {
            EPI_LOOP({ if (bj == 0) { if (wc == 0) rope_store(ki + (size_t)row * 32 + fq * 8, ropeI + (row & (SEQ - 1)) * 16 + fq * 4, a0, a1);
                                      else if (wc == 1 && fq == 0) { *(f32x4*)(wi + (size_t)row * 8) = a0; *(f32x4*)(wi + (size_t)row * 8 + 4) = a1; } } })
        } else if (pn < 11) {
            EPI_LOOP({ f32x4 s0, s1;
                       _Pragma("unroll") for (int j = 0; j < 4; ++j) { s0[j] = sigmoidf_(a0[j]); s1[j] = sigmoidf_(a1[j]); }
                       *(u32x4*)(sgs + (size_t)row * 1024 + (pn - 7) * 256 + vc) = pack8(s0, s1); })
        } else {
            EPI_LOOP({ f32x4 s0, s1;
                       _Pragma("unroll") for (int j = 0; j < 4; ++j) { s0[j] = sigmoidf_(a0[j]); s1[j] = sigmoidf_(a1[j]); }
                       *(u32x4*)(sga + (size_t)row * 1024 + (pn - 11) * 256 + vc) = pack8(s0, s1); })
        }
    }
};
struct EpiGlu {
    static constexpr bool PERM = true, AFTER_DRAIN = false, CHAIN = false;
    const bf16_t* y; bf16_t* o;
    __device__ __forceinline__ void operator()(EPI_ARGS) const {
        EPI_COORDS
        EPI_LOOP({ const size_t idx = (size_t)row * 512 + u.pn * 256 + vc; f32x4 y0, y1; unpack8(*(const u32x4*)(y + idx), y0, y1);
                   _Pragma("unroll") for (int j = 0; j < 4; ++j) { y0[j] *= sigmoidf_(a0[j]); y1[j] *= sigmoidf_(a1[j]); }
                   *(u32x4*)(o + idx) = pack8(y0, y1); })
    }
};
struct EpiMerge1 {
    static constexpr bool PERM = true, AFTER_DRAIN = false, CHAIN = false;
    const bf16_t* g; bf16_t* t;
    __device__ __forceinline__ void operator()(EPI_ARGS) const {
        EPI_COORDS
        EPI_LOOP({ const size_t idx = (size_t)row * 1024 + u.pn * 256 + vc; f32x4 g0, g1; unpack8(*(const u32x4*)(g + idx), g0, g1);
                   *(u32x4*)(t + idx) = pack8(g0 * a0, g1 * a1); })
    }
};
struct EpiMerge2 {
    static constexpr bool PERM = true, AFTER_DRAIN = false, CHAIN = false;
    const bf16_t* g; const bf16_t* t; bf16_t* o;
    __device__ __forceinline__ void operator()(EPI_ARGS) const {
        EPI_COORDS
        EPI_LOOP({ const size_t idx = (size_t)row * 1024 + u.pn * 256 + vc; f32x4 g0, g1, t0, t1; unpack8(*(const u32x4*)(g + idx), g0, g1); unpack8(*(const u32x4*)(t + idx), t0, t1);
                   *(u32x4*)(o + idx) = pack8(t0 + g0 * a0, t1 + g1 * a1); })
    }
};
struct EpiMergeChain {
    static constexpr bool PERM = true, AFTER_DRAIN = false, CHAIN = true;
    const bf16_t* gs; const bf16_t* ga; bf16_t* o;
    __device__ __forceinline__ void operator()(f32x4 (&acc)[2][2][4][2], const pg8::Unit& u, int wr_, int wc_, int fr_, int fq_) const {
        EPI_COORDS
#pragma unroll
        for (int ai = 0; ai < 2; ++ai)
#pragma unroll
            for (int m = 0; m < 4; ++m) {
                const int row = u.pm * 256 + ai * 128 + wr * 64 + m * 16 + fr;
#pragma unroll
                for (int bj = 0; bj < 2; ++bj) {
                    const size_t idx = (size_t)row * 1024 + u.pn * 256 + bj * 128 + wc * 32 + fq * 8;
                    f32x4 a0, a1; unpack8(*(const u32x4*)(ga + idx), a0, a1);
                    if (u.sel == 0) {
                        f32x4 s0, s1; unpack8(*(const u32x4*)(gs + idx), s0, s1);
#pragma unroll
                        for (int j = 0; j < 4; ++j) { acc[ai][bj][m][0][j] *= s0[j] * __builtin_amdgcn_rcpf(a0[j]); acc[ai][bj][m][1][j] *= s1[j] * __builtin_amdgcn_rcpf(a1[j]); }
                    } else {
                        *(u32x4*)(o + idx) = pack8(acc[ai][bj][m][0] * a0, acc[ai][bj][m][1] * a1);
                    }
                }
            }
    }
};
struct EpiOut {
    static constexpr bool PERM = true, AFTER_DRAIN = false, CHAIN = false;
    const float* x; bf16_t* hb; float* rss;
    __device__ __forceinline__ void operator()(EPI_ARGS) const {
        EPI_COORDS
#pragma unroll
        for (int ai = 0; ai < 2; ++ai)
#pragma unroll
            for (int m = 0; m < 4; ++m) {
                const int row = u.pm * 256 + ai * 128 + wr * 64 + m * 16 + fr;
                float ss = 0.f;
#pragma unroll
                for (int bj = 0; bj < 2; ++bj) {
                    const int col = u.pn * 256 + bj * 128 + wc * 32 + fq * 8;
                    const size_t idx = (size_t)row * 1024 + col;
                    const f32x4 h0 = *(const f32x4*)(x + idx) + acc[ai][bj][m][0], h1 = *(const f32x4*)(x + idx + 4) + acc[ai][bj][m][1];
                    ss += h0[0] * h0[0] + h0[1] * h0[1] + h0[2] * h0[2] + h0[3] * h0[3] + h1[0] * h1[0] + h1[1] * h1[1] + h1[2] * h1[2] + h1[3] * h1[3];
                    *(u32x4*)(hb + idx) = pack8(h0, h1);
                }
                ss += __shfl_xor(ss, 16); ss += __shfl_xor(ss, 32);
                if (fq == 0) rss[(size_t)row * 16 + u.pn * 4 + wc] = ss;
            }
    }
};
typedef _Float16 f16x8 __attribute__((ext_vector_type(8)));
struct EpiScores {
    static constexpr bool PERM = true, AFTER_DRAIN = false, CHAIN = false;
    _Float16* o;
    __device__ __forceinline__ void operator()(EPI_ARGS) const {
        EPI_COORDS
        EPI_LOOP({ const size_t idx = (size_t)row * 2048 + u.pn * 256 + vc;
                   f16x8 hv = {(_Float16)a0[0], (_Float16)a0[1], (_Float16)a0[2], (_Float16)a0[3], (_Float16)a1[0], (_Float16)a1[1], (_Float16)a1[2], (_Float16)a1[3]};
                   *(f16x8*)(o + idx) = hv; })
    }
};

template <class Epi>
__device__ __forceinline__ void run_gemm_chain(LAS unsigned char* lds, const bf16_t* A, const bf16_t* Bt, const bf16_t* A2, const bf16_t* Bt2, int M, int N, int K, int G, const Epi& E) {
    pg8::Gemm g{A, Bt, M, N, K, A2, Bt2}; pg8::ChainOrder S; S.init(M, N, G, (int)blockIdx.x);
    pg8::gemm_phase<Epi, pg8::ChainOrder, true, true>(lds, g, S, E);
}
template <class Epi>
__device__ __forceinline__ void run_gemm(LAS unsigned char* lds, const bf16_t* A, const bf16_t* Bt, int M, int N, int K, int G, const Epi& E) {
    pg8::Gemm g{A, Bt, M, N, K}; pg8::StaticOrder S; S.init(M, N, G, (int)blockIdx.x);
    pg8::gemm_phase<Epi, pg8::StaticOrder, true, true>(lds, g, S, E);
}

__device__ __forceinline__ void ssm_item(const Params& p, float* us, bf16_t* yg, int item, int lane) {
    const float2* abar_t = WSP(float2, WS_SSMT);
    const float2* bbar_t = abar_t + SSM_G * SSM_P;
    const bf16_t* u = WSP(bf16_t, WS_U);
    const int b = item / SSM_G, g = item % SSM_G;
    const float2 ab = abar_t[g * SSM_P + lane];
    float br[16], bi[16], cr[16], ci[16];
#pragma unroll
    for (int c = 0; c < 16; ++c) {
        float2 t = bbar_t[(g * SSM_P + lane) * SSM_N + c];
        br[c] = t.x; bi[c] = t.y;
        cr[c] = p.c_re[((size_t)g * SSM_N + c) * SSM_P + lane];
        ci[c] = p.c_im[((size_t)g * SSM_N + c) * SSM_P + lane];
    }
    const int myc = ((lane >> 5) & 1) * 8 + ((lane >> 4) & 1) * 4 + ((lane >> 3) & 1) * 2 + ((lane >> 2) & 1);
    const float dsk = p.d_skip[g * SSM_N + myc];
    float xr = 0.f, xi = 0.f;
    for (int t0 = 0; t0 < SEQ; t0 += 64) {
        {
            const bf16_t* ur = u + ((size_t)(b * SEQ + t0 + lane)) * SSM_W + g * SSM_N;
            f32x4 f0, f1, f2, f3; unpack8(*(const u32x4*)ur, f0, f1); unpack8(*(const u32x4*)(ur + 8), f2, f3);
            float* d = us + lane * 16;
            *(f32x4*)d = f0; *(f32x4*)(d + 4) = f1; *(f32x4*)(d + 8) = f2; *(f32x4*)(d + 12) = f3;
        }
        __builtin_amdgcn_s_waitcnt(0);
        __builtin_amdgcn_wave_barrier();
        for (int tt = 0; tt < 64; ++tt) {
            float uu[16];
#pragma unroll
            for (int c4 = 0; c4 < 4; ++c4) {
                f32x4 t = *(const f32x4*)(us + tt * 16 + c4 * 4);
                uu[c4 * 4] = t[0]; uu[c4 * 4 + 1] = t[1]; uu[c4 * 4 + 2] = t[2]; uu[c4 * 4 + 3] = t[3];
            }
            float bur = 0.f, bui = 0.f;
#pragma unroll
            for (int c = 0; c < 16; ++c) { bur += br[c] * uu[c]; bui += bi[c] * uu[c]; }
            float nxr = ab.x * xr - ab.y * xi + bur;
            float nxi = ab.x * xi + ab.y * xr + bui;
            xr = nxr; xi = nxi;
            float z[16];
#pragma unroll
            for (int c = 0; c < 16; ++c) z[c] = cr[c] * xr - ci[c] * xi;
            float w8[8], w4[4], w2[2], w1;
            const bool h5 = lane & 32, h4 = lane & 16, h3 = lane & 8, h2 = lane & 4;
#pragma unroll
            for (int i = 0; i < 8; ++i) { float mine = h5 ? z[8 + i] : z[i], oth = h5 ? z[i] : z[8 + i]; w8[i] = mine + __shfl_xor(oth, 32); }
#pragma unroll
            for (int i = 0; i < 4; ++i) { float mine = h4 ? w8[4 + i] : w8[i], oth = h4 ? w8[i] : w8[4 + i]; w4[i] = mine + __shfl_xor(oth, 16); }
#pragma unroll
            for (int i = 0; i < 2; ++i) { float mine = h3 ? w4[2 + i] : w4[i], oth = h3 ? w4[i] : w4[2 + i]; w2[i] = mine + __shfl_xor(oth, 8); }
            { float mine = h2 ? w2[1] : w2[0], oth = h2 ? w2[0] : w2[1]; w1 = mine + __shfl_xor(oth, 4); }
            w1 += __shfl_xor(w1, 2);
            w1 += __shfl_xor(w1, 1);
            float um = 0.f;
#pragma unroll
            for (int c = 0; c < 16; ++c) um = (c == myc) ? uu[c] : um;
            float y = gelu_tanh(w1 + dsk * um);
            if ((lane & 3) == 0) yg[((size_t)(b * SEQ + t0 + tt)) * SSM_W + g * SSM_N + myc] = (bf16_t)f2bf(y);
        }
        __builtin_amdgcn_wave_barrier();
    }
}


__device__ __forceinline__ void ssm_fast_item(const Params& p, unsigned char* smem, unsigned yg_off, int item, int lane_in, int wave) {
    const unsigned char* W = p.ws;
    constexpr unsigned O_U = WS_U << 20, O_W1T = WS_W1T << 20, O_W3T = WS_W3T << 20;
    const int b = item >> 5, g = item & 31;
    int lane = lane_in; asm volatile("" : "+v"(lane));
    const int gq = lane >> 4, c = lane & 15, rg = wave & 3, hf = wave >> 2;
    bf16_t* Kl = (bf16_t*)smem; float* Sl = (float*)(smem + 32768); bf16_t* Xb = (bf16_t*)(smem + 65536);
    __syncthreads();
    {
        const u32x4* src = (const u32x4*)(WSP(bf16_t, WS_KT) + (size_t)g * 64 * 256); u32x4* dst = (u32x4*)smem;
        for (int i = wave * 64 + lane; i < 2048; i += NT) dst[i] = src[i];
    }
    bf16x8 A[32];
#pragma unroll
    for (int ks = 0; ks < 32; ++ks)
        A[ks] = ldws<bf16x8>(W, O_U + ((unsigned)(b * SEQ + (16 * rg + c) * 64 + 2 * ks + (gq >> 1)) * 512u + g * 16 + 8 * (gq & 1)) * 2u);
#pragma unroll 1
    for (int nt = 0; nt < 4; ++nt) {
        f32x4 acc = {0.f, 0.f, 0.f, 0.f};
        const unsigned wb = O_W1T + ((unsigned)(g * 128 + (4 * hf + nt) * 16 + c) * 1024u + 8 * gq) * 2u;
#pragma unroll
        for (int ks = 0; ks < 32; ++ks) acc = __builtin_amdgcn_mfma_f32_16x16x32_bf16(A[ks], ldws<bf16x8>(W, wb + ks * 64), acc, 0, 0, 0);
#pragma unroll
        for (int r = 0; r < 4; ++r) Sl[(16 * rg + 4 * gq + r) * 128 + (4 * hf + nt) * 16 + c] = acc[r];
    }
    __syncthreads();
    if (wave == 0) {
        const float2 a = WSP(float2, WS_A64)[g * SSM_P + lane];
        float xr = 0.f, xi = 0.f;
        for (int ch = 0; ch < 64; ++ch) {
            *(unsigned*)(Xb + ch * 128 + 2 * lane) = f2bf(xr) | (f2bf(xi) << 16);
            const float2 sv = *(const float2*)(Sl + ch * 128 + 2 * lane);
            const float nr = a.x * xr - a.y * xi + sv.x, ni = a.x * xi + a.y * xr + sv.y;
            xr = nr; xi = ni;
        }
    }
    __syncthreads();
    bf16x8 Xa[4];
#pragma unroll
    for (int k2 = 0; k2 < 4; ++k2) Xa[k2] = *(const bf16x8*)(Xb + (16 * rg + c) * 128 + 32 * k2 + 8 * gq);
    bf16_t* yg = (bf16_t*)(p.ws + yg_off);
    const int gh = gq >> 1;
    const bf16_t* kl_lane = Kl + (gq & 1) * 128 + c * 8;
    bf16x8 w3[4];
    {
        const unsigned wb0 = O_W3T + ((unsigned)((g * 64 + hf) * 16 + c) * 128u + 8 * gq) * 2u;
#pragma unroll
        for (int k2 = 0; k2 < 4; ++k2) w3[k2] = ldws<bf16x8>(W, wb0 + k2 * 64);
    }
#pragma unroll 1
    for (int tq = 0; tq < 32; ++tq) {
        const int tp = 2 * tq + hf;
        f32x4 acc = {0.f, 0.f, 0.f, 0.f};
#pragma unroll
        for (int k2 = 0; k2 < 4; ++k2) acc = __builtin_amdgcn_mfma_f32_16x16x32_bf16(Xa[k2], w3[k2], acc, 0, 0, 0);
        {
            const int tn = tq < 31 ? tp + 2 : tp;
            const unsigned wb = O_W3T + ((unsigned)((g * 64 + tn) * 16 + c) * 128u + 8 * gq) * 2u;
#pragma unroll
            for (int k2 = 0; k2 < 4; ++k2) w3[k2] = ldws<bf16x8>(W, wb + k2 * 64);
        }
#pragma unroll
        for (int ks = 0; ks < 32; ++ks) {
            if (ks <= tq) {
                const int l = tp - 2 * ks - gh;
                bf16x8 kb = *(const bf16x8*)(kl_lane + (l < 0 ? 0 : l) * 256);
                if (l < 0) kb = (bf16x8){0, 0, 0, 0, 0, 0, 0, 0};
                acc = __builtin_amdgcn_mfma_f32_16x16x32_bf16(A[ks], kb, acc, 0, 0, 0);
            }
        }
#pragma unroll
        for (int r = 0; r < 4; ++r)
            yg[((size_t)(b * SEQ + (16 * rg + 4 * gq + r) * 64 + tp)) * SSM_W + g * SSM_N + c] = (bf16_t)f2bf(gelu_tanh(acc[r]));
    }
}

__device__ __forceinline__ unsigned fkey(float f) {
    unsigned u = __builtin_bit_cast(unsigned, f);
    return (u & 0x80000000u) ? ~u : (u | 0x80000000u);
}
__device__ __forceinline__ void phase_attn(const Params& p, unsigned char* smem, bf16_t* yatt, int vcu, int G) {
    float* sc = (float*)smem;
    float* qis = sc + 4096;
    float* wis = qis + 256;
    float* qs = wis + 16;
    float* pl = qs + 512;
    int* sel = (int*)(pl + 2048);
    unsigned* hist = (unsigned*)(sel + 256);
    int* scanA = (int*)(hist + 256);
    int* scanB = scanA + 512;
    int* misc = scanB + 512;
    int tid = threadIdx.x; asm volatile("" : "+v"(tid));
    const bf16_t* qi = WSP(bf16_t, WS_QI); const bf16_t* ki = WSP(bf16_t, WS_KI); const float* wi = WSP(float, WS_WI);
    const bf16_t* q = WSP(bf16_t, WS_Q); const bf16_t* kk = WSP(bf16_t, WS_K); const bf16_t* vv = WSP(bf16_t, WS_V);
    for (int row = vcu; row < MTOK; row += G) {
        const int b = row / SEQ, t = row % SEQ, nvalid = t + 1;
        __syncthreads();
        if (tid < 256) qis[tid] = bf2f(qi[(size_t)row * 256 + tid]);
        if (tid < 8) wis[tid] = wi[(size_t)row * 8 + tid];
        qs[tid] = bf2f(q[(size_t)row * 512 + tid]);
        __syncthreads();
        for (int s = tid; s < nvalid; s += NT) {
            const bf16_t* kr = ki + ((size_t)b * SEQ + s) * 32;
            float kv[32];
#pragma unroll
            for (int d8 = 0; d8 < 4; ++d8) {
                f32x4 a, bb; unpack8(*(const u32x4*)(kr + d8 * 8), a, bb);
                kv[d8 * 8] = a[0]; kv[d8 * 8 + 1] = a[1]; kv[d8 * 8 + 2] = a[2]; kv[d8 * 8 + 3] = a[3];
                kv[d8 * 8 + 4] = bb[0]; kv[d8 * 8 + 5] = bb[1]; kv[d8 * 8 + 6] = bb[2]; kv[d8 * 8 + 7] = bb[3];
            }
            float a = 0.f;
#pragma unroll
            for (int h = 0; h < 8; ++h) {
                float d = 0.f;
#pragma unroll
                for (int dd = 0; dd < 32; ++dd) d += qis[h * 32 + dd] * kv[dd];
                a += wis[h] * fmaxf(d, 0.f);
            }
#ifdef PROBE_ATTN
            sc[s] = (float)(_Float16)a;
#else
            sc[s] = a;
#endif
        }
        __syncthreads();
        int nsel;
        if (nvalid <= TOPK) {
            nsel = nvalid;
            if (tid < nvalid) sel[tid] = tid;
        } else {
            nsel = TOPK;
            unsigned prefix = 0, mask = 0; int need = TOPK;
            for (int pass = 0; pass < 4; ++pass) {
                const int shift = 24 - 8 * pass;
                if (tid < 256) hist[tid] = 0;
                __syncthreads();
                for (int s = tid; s < nvalid; s += NT) {
                    unsigned key = fkey(sc[s]);
                    if ((key & mask) == prefix) atomicAdd(&hist[(key >> shift) & 255], 1u);
                }
                __syncthreads();
                if (tid == 0) {
                    int cum = 0, bin = 255;
                    for (; bin > 0; --bin) { if (cum + (int)hist[bin] >= need) break; cum += hist[bin]; }
                    misc[0] = bin; misc[1] = need - cum;
                }
                __syncthreads();
                prefix |= (unsigned)misc[0] << shift; mask |= 0xFFu << shift; need = misc[1];
                __syncthreads();
            }
            const int base = tid * 8;
            int cg = 0, ce = 0;
            for (int i = 0; i < 8; ++i) { int s = base + i; if (s < nvalid) { unsigned key = fkey(sc[s]); cg += key > prefix; ce += key == prefix; } }
            scanA[tid] = ce;
            __syncthreads();
            if (tid == 0) { int run = 0; for (int i = 0; i < NT; ++i) { int v = scanA[i]; scanA[i] = run; run += v; } }
            __syncthreads();
            const int preE = scanA[tid];
            int takeE = need - preE; takeE = takeE < 0 ? 0 : (takeE > ce ? ce : takeE);
            scanB[tid] = cg + takeE;
            __syncthreads();
            if (tid == 0) { int run = 0; for (int i = 0; i < NT; ++i) { int v = scanB[i]; scanB[i] = run; run += v; } }
            __syncthreads();
            int off = scanB[tid], te = 0;
            for (int i = 0; i < 8; ++i) {
                int s = base + i;
                if (s < nvalid) {
                    unsigned key = fkey(sc[s]);
                    bool take = key > prefix;
                    if (key == prefix) { take = te < takeE; ++te; }
                    if (take) { if (off < TOPK) sel[off] = s; ++off; }
                }
            }
        }
        __syncthreads();
        {
            const int j = tid & 255, n = tid >> 8;
            if (j < nsel) {
                const unsigned char* kr = (const unsigned char*)kk + ((size_t)b * SEQ + sel[j]) * 128 + n * 64;
                float kf[64];
#pragma unroll
                for (int d8 = 0; d8 < 8; ++d8) {
                    f32x4 a, bb; unpack8_fp8(*(const uint2*)(kr + d8 * 8), a, bb); a *= (1.f / 16.f); bb *= (1.f / 16.f);
                    kf[d8 * 8] = a[0]; kf[d8 * 8 + 1] = a[1]; kf[d8 * 8 + 2] = a[2]; kf[d8 * 8 + 3] = a[3];
                    kf[d8 * 8 + 4] = bb[0]; kf[d8 * 8 + 5] = bb[1]; kf[d8 * 8 + 6] = bb[2]; kf[d8 * 8 + 7] = bb[3];
                }
#pragma unroll
                for (int hh = 0; hh < 4; ++hh) {
                    const int h = n * 4 + hh;
                    float d = 0.f;
#pragma unroll
                    for (int dd = 0; dd < 64; ++dd) d += qs[h * 64 + dd] * kf[dd];
                    pl[h * 256 + j] = d * 0.125f;
                }
            } else {
#pragma unroll
                for (int hh = 0; hh < 4; ++hh) pl[(n * 4 + hh) * 256 + j] = -1e30f;
            }
        }
        __syncthreads();
        {
            const int h = tid >> 6, l = tid & 63;
            float vals[4]; float mx = -3e38f;
#pragma unroll
            for (int i = 0; i < 4; ++i) { vals[i] = pl[h * 256 + l + 64 * i]; mx = fmaxf(mx, vals[i]); }
#pragma unroll
            for (int o = 32; o >= 1; o >>= 1) mx = fmaxf(mx, __shfl_xor(mx, o));
            float sm = 0.f;
#pragma unroll
            for (int i = 0; i < 4; ++i) { vals[i] = __expf(vals[i] - mx); sm += vals[i]; }
            sm = wave_sum(sm);
            float inv = 1.f / sm;
#pragma unroll
            for (int i = 0; i < 4; ++i) pl[h * 256 + l + 64 * i] = vals[i] * inv;
        }
        __syncthreads();
        {
            const int h = tid >> 6, d = tid & 63, n = h >> 2;
            float a = 0.f;
            for (int j = 0; j < nsel; ++j) {
                const unsigned wv = *(const unsigned*)((const unsigned char*)vv + ((size_t)b * SEQ + sel[j]) * 128 + n * 64 + (d & ~3));
                const f32x2_t pv0 = __builtin_amdgcn_cvt_pk_f32_fp8((int)wv, false), pv1 = __builtin_amdgcn_cvt_pk_f32_fp8((int)wv, true);
                const float vsel = (d & 2) ? ((d & 1) ? pv1[1] : pv1[0]) : ((d & 1) ? pv0[1] : pv0[0]);
                const int pq = __builtin_amdgcn_cvt_pk_fp8_f32(pl[h * 256 + j] * 256.f, 0.f, 0, false);
                const f32x2_t pd = __builtin_amdgcn_cvt_pk_f32_fp8(pq, false);
                a += pd[0] * vsel * (1.f / 4096.f);
            }
            yatt[(size_t)row * 512 + tid] = (bf16_t)f2bf(a);
        }
    }
}


typedef short v4i16_t __attribute__((ext_vector_type(4)));
constexpr int DSA_KSTR = 8200, DSA_SEL_OFF = 16 * DSA_KSTR, DSA_NSEL_OFF = DSA_SEL_OFF + 8192, DSA_HIST_OFF = DSA_NSEL_OFF + 256, DSA_VST = 5120;
__device__ __forceinline__ int mbcnt64(unsigned long long m) { return __builtin_amdgcn_mbcnt_hi((unsigned)(m >> 32), __builtin_amdgcn_mbcnt_lo((unsigned)m, 0u)); }

__device__ __forceinline__ void dsa_item(const Params& p, unsigned char* smem, unsigned yatt_off, int b, int tt, int lane_in, int wave) {
    const unsigned char* W = p.ws;
    constexpr unsigned O_QI = WS_QI << 20, O_KI = WS_KI << 20, O_WI = WS_WI << 20, O_Q = WS_Q << 20, O_K = WS_K << 20, O_V = WS_V << 20;
    const int t0 = tt * 16;
    __syncthreads();
#ifndef DSA_RA
#define DSA_RA 1
#endif
#ifndef DSA_RB
#define DSA_RB 1
#endif
#ifndef DSA_RC
#define DSA_RC 1
#endif
    _Pragma("unroll 1") for (int ra_ = 0; ra_ < DSA_RA; ++ra_) {
        int lane = lane_in; asm volatile("" : "+v"(lane));
        const int g = lane >> 4, c = lane & 15;
        const unsigned qrow = (unsigned)(b * SEQ + t0 + c);
        bf16x8 qf[8]; float wv[8];
#pragma unroll
        for (int h = 0; h < 8; ++h) { qf[h] = ldws<bf16x8>(W, O_QI + qrow * 512u + h * 64 + 16 * g); wv[h] = ldws<float>(W, O_WI + qrow * 32u + h * 4); }
        bf16x8 kf_next = ldws<bf16x8>(W, O_KI + (unsigned)(b * SEQ + (wave <= tt ? wave : tt) * 16 + c) * 64u + 16 * g);
#pragma unroll 1
        for (int kt = wave; kt <= tt; kt += NWAVES) {
            const bf16x8 kf = kf_next;
            { const int kn = kt + NWAVES <= tt ? kt + NWAVES : tt; kf_next = ldws<bf16x8>(W, O_KI + (unsigned)(b * SEQ + kn * 16 + c) * 64u + 16 * g); }
            f32x4 s = {0.f, 0.f, 0.f, 0.f};
#pragma unroll
            for (int h = 0; h < 8; ++h) {
                const f32x4 d = __builtin_amdgcn_mfma_f32_16x16x32_bf16(kf, qf[h], (f32x4){0.f, 0.f, 0.f, 0.f}, 0, 0, 0);
#pragma unroll
                for (int r = 0; r < 4; ++r) { const float dv = d[r]; const int ri = __float_as_int(dv); s[r] += wv[h] * __int_as_float(ri > 0 ? ri : 0); }
            }
            const bool diag = (kt == tt);
            unsigned kw[4];
#pragma unroll
            for (int r = 0; r < 4; ++r) {
                const _Float16 hv = (_Float16)s[r];
                const unsigned hb = (unsigned)__builtin_bit_cast(unsigned short, hv);
                const unsigned key = (hb & 0x8000u) ? (~hb & 0xffffu) : (hb | 0x8000u);
                const bool valid = !(diag && 4 * g + r > c);
                kw[r] = valid ? key : 0u;
                if (valid && ra_ == 0) atomicAdd((unsigned*)(smem + DSA_HIST_OFF) + c * 256 + (key >> 8), 1u);
            }
            *(uint2*)(smem + c * DSA_KSTR + (kt * 16 + 4 * g) * 2) = make_uint2(kw[0] | (kw[1] << 16), kw[2] | (kw[3] << 16));
        }
    }
    __syncthreads();
    unsigned short* selall = (unsigned short*)(smem + DSA_SEL_OFF);
    int* nselarr = (int*)(smem + DSA_NSEL_OFF);
#pragma unroll 1
    for (int rr = 0; rr < 2 * DSA_RB; ++rr) {
        int lane = lane_in; asm volatile("" : "+v"(lane));
        const int tl = wave * 2 + (rr & 1), nvalid = t0 + tl + 1;
        unsigned short* selrow = selall + tl * 256;
        if (nvalid <= TOPK) {
            for (int j = lane; j < TOPK; j += 64) selrow[j] = (unsigned short)(j < nvalid ? j : 0);
            if (lane == 0) nselarr[tl] = nvalid;
        } else {
            unsigned kk[64];
#pragma unroll
            for (int i = 0; i < 16; ++i) {
                const uint2 w = *(const uint2*)(smem + tl * DSA_KSTR + (i * 64 + lane) * 8);
                const int s0 = (i * 64 + lane) * 4;
                kk[4 * i + 0] = s0 + 0 < nvalid ? (w.x & 0xffffu) : 0u; kk[4 * i + 1] = s0 + 1 < nvalid ? (w.x >> 16) : 0u;
                kk[4 * i + 2] = s0 + 2 < nvalid ? (w.y & 0xffffu) : 0u; kk[4 * i + 3] = s0 + 3 < nvalid ? (w.y >> 16) : 0u;
            }
            unsigned* hist = (unsigned*)(smem + DSA_HIST_OFF) + tl * 256;
            const int ni = (nvalid + 255) >> 8;
            unsigned Bsel = 0u; int cabove = 0, nties = 0;
#pragma unroll 1
            for (int pass = 0; pass < 2; ++pass) {
                if (pass == 1) {
#pragma unroll
                    for (int i = 0; i < 16; ++i) {
                        if (i < ni) {
#pragma unroll
                            for (int e = 0; e < 4; ++e) { const unsigned k = kk[4 * i + e]; if ((k >> 8) == Bsel) atomicAdd(&hist[k & 255u], 1u); }
                        }
                    }
                    __builtin_amdgcn_s_waitcnt(0xC07F);
                    __builtin_amdgcn_wave_barrier();
                }
                const uint4 hv = *(const uint4*)(hist + 4 * lane);
                const int ls = (int)(hv.x + hv.y + hv.z + hv.w);
                const int pre_ = wave_incl_scan(ls);
                const int suf = __builtin_amdgcn_readlane(pre_, 63) - pre_ + ls;
                const int needp = TOPK - cabove;
                const int above = suf - ls;
                const bool mine = (above < needp) && (suf >= needp);
                int bsel_l = 0, ca_l = 0, hsel_l = 0;
                {
                    int cacc = above;
                    const int h3 = (int)hv.w, h2 = (int)hv.z, h1 = (int)hv.y, h0 = (int)hv.x;
                    if (cacc + h3 >= needp) { bsel_l = 3; ca_l = cacc; hsel_l = h3; }
                    else { cacc += h3; if (cacc + h2 >= needp) { bsel_l = 2; ca_l = cacc; hsel_l = h2; }
                        else { cacc += h2; if (cacc + h1 >= needp) { bsel_l = 1; ca_l = cacc; hsel_l = h1; } else { cacc += h1; bsel_l = 0; ca_l = cacc; hsel_l = h0; } } }
                }
                const unsigned long long mm = __ballot(mine);
                const int src = mm ? (int)__builtin_ctzll(mm) : 0;
                const int bb = __shfl(4 * lane + bsel_l, src), ca = __shfl(ca_l, src);
                nties = __shfl(hsel_l, src);
                if (pass == 0) {
                    Bsel = (unsigned)bb; cabove = ca;
                    __builtin_amdgcn_wave_barrier();
                    hist[lane] = 0u; hist[lane + 64] = 0u; hist[lane + 128] = 0u; hist[lane + 192] = 0u;
                    __builtin_amdgcn_s_waitcnt(0xC07F);
                    __builtin_amdgcn_wave_barrier();
                } else { Bsel = (Bsel << 8) | (unsigned)bb; cabove += ca; }
            }
            const unsigned T = Bsel;
            const int need = TOPK - cabove;
            if (nties == need) {
                int cntl = 0;
#pragma unroll
                for (int i = 0; i < 16; ++i) if (i < ni) {
#pragma unroll
                    for (int e = 0; e < 4; ++e) cntl += (kk[4 * i + e] >= T) ? 1 : 0;
                }
                const int pre = wave_incl_scan(cntl);
                int pos = pre - cntl;
#pragma unroll
                for (int i = 0; i < 16; ++i) if (i < ni) {
#pragma unroll
                    for (int e = 0; e < 4; ++e) { if (kk[4 * i + e] >= T) { if (pos < TOPK) selrow[pos] = (unsigned short)((i * 64 + lane) * 4 + e); ++pos; } }
                }
            } else {
                int tiebase = 0, sbase = 0;
#pragma unroll
                for (int i = 0; i < 16; ++i) {
                    int below = 0, tot = 0;
#pragma unroll
                    for (int e = 0; e < 4; ++e) { const unsigned long long m = __ballot(kk[4 * i + e] == T); below += mbcnt64(m); tot += __builtin_popcountll(m); }
                    int own = 0; bool take[4];
#pragma unroll
                    for (int e = 0; e < 4; ++e) { const bool tie = kk[4 * i + e] == T; take[e] = (kk[4 * i + e] > T) || (tie && (tiebase + below + own < need)); own += tie ? 1 : 0; }
                    tiebase += tot;
                    int belowS = 0, totS = 0;
#pragma unroll
                    for (int e = 0; e < 4; ++e) { const unsigned long long m = __ballot(take[e]); belowS += mbcnt64(m); totS += __builtin_popcountll(m); }
                    int ownS = 0;
#pragma unroll
                    for (int e = 0; e < 4; ++e) { if (take[e]) { const int pos = sbase + belowS + ownS; if (pos < TOPK) selrow[pos] = (unsigned short)((i * 64 + lane) * 4 + e); } ownS += take[e] ? 1 : 0; }
                    sbase += totS;
                }
            }
            if (lane == 0) nselarr[tl] = TOPK;
        }
        {
            unsigned* hz = (unsigned*)(smem + DSA_HIST_OFF) + tl * 256;
            hz[lane] = 0u; hz[lane + 64] = 0u; hz[lane + 128] = 0u; hz[lane + 192] = 0u;
        }
    }
    __builtin_amdgcn_s_waitcnt(0xC07F); __builtin_amdgcn_wave_barrier();
#pragma unroll 1
    for (int rn_ = 0; rn_ < 4 * DSA_RC; ++rn_) {
        const int rn = rn_ & 3;
        int lane = lane_in; asm volatile("" : "+v"(lane));
        const int g = lane >> 4, c = lane & 15;
        const int rr = rn >> 1, n = rn & 1;
        unsigned char* vst = smem + (2 * wave) * DSA_KSTR;
        const int tl = wave * 2 + rr;
        const unsigned rowg = (unsigned)(b * SEQ + t0 + tl);
        const int nselg = nselarr[tl] - 4 * g;
        const unsigned short* selrow = selall + tl * 256;
        const unsigned kvb = O_K + (unsigned)(b * SEQ) * 128u + n * 64 + 16 * g;
        const unsigned vvb = O_V + (unsigned)(b * SEQ) * 128u + n * 64 + (lane & 3) * 16;
        long qha = 0, qhb = 0, qla = 0, qlb = 0;
        if (c < 4) {
            const unsigned qo = O_Q + rowg * 1024u + (n * 4 + c) * 128 + 32 * g;
            f32x4 q0, q1, q2, q3; unpack8(ldws<u32x4>(W, qo), q0, q1); unpack8(ldws<u32x4>(W, qo + 16), q2, q3);
            q0 *= 16.f; q1 *= 16.f; q2 *= 16.f; q3 *= 16.f;
            const uint2 ha = pack8_fp8(q0, q1), hb = pack8_fp8(q2, q3);
            f32x4 d0, d1, d2, d3; unpack8_fp8(ha, d0, d1); unpack8_fp8(hb, d2, d3);
            const uint2 la = pack8_fp8(q0 - d0, q1 - d1), lb = pack8_fp8(q2 - d2, q3 - d3);
            qha = (long)(((unsigned long long)ha.y << 32) | ha.x); qhb = (long)(((unsigned long long)hb.y << 32) | hb.x);
            qla = (long)(((unsigned long long)la.y << 32) | la.x); qlb = (long)(((unsigned long long)lb.y << 32) | lb.x);
        }
        f32x4 S[16];
#pragma unroll
        for (int tile = 0; tile < 16; ++tile) {
            const unsigned key = selrow[tile * 16 + c];
            const u32x4 kw = ldws<u32x4>(W, kvb + key * 128u);
            const long ka = (long)(((unsigned long long)kw.y << 32) | kw.x), kb = (long)(((unsigned long long)kw.w << 32) | kw.z);
            f32x4 acc = __builtin_amdgcn_mfma_f32_16x16x32_fp8_fp8(ka, qha, (f32x4){0.f, 0.f, 0.f, 0.f}, 0, 0, 0);
            acc = __builtin_amdgcn_mfma_f32_16x16x32_fp8_fp8(kb, qhb, acc, 0, 0, 0);
            acc = __builtin_amdgcn_mfma_f32_16x16x32_fp8_fp8(ka, qla, acc, 0, 0, 0);
            S[tile] = __builtin_amdgcn_mfma_f32_16x16x32_fp8_fp8(kb, qlb, acc, 0, 0, 0);
        }
        u32x4 vra[8];
#pragma unroll
        for (int i = 0; i < 8; ++i) { const unsigned key = selrow[i * 16 + (lane >> 2)]; vra[i] = ldws<u32x4>(W, vvb + key * 128u); }
        float Pk[4][4];
        {
            const int nselc = nselarr[tl] - 4 * g - 16 * (c >> 2);
            float mx = -3e38f;
#pragma unroll
            for (int q4 = 0; q4 < 4; ++q4)
#pragma unroll
                for (int r = 0; r < 4; ++r) {
                    float v = S[4 * q4][r];
                    v = dppf<0x114, 0xf, 0x2, false>(v, S[4 * q4 + 1][r]);
                    v = dppf<0x118, 0xf, 0x4, false>(v, S[4 * q4 + 2][r]);
                    v = dppf<0x11C, 0xf, 0x8, false>(v, S[4 * q4 + 3][r]);
                    v = (64 * q4 + r) < nselc ? v : -1e30f;
                    Pk[q4][r] = v; mx = fmaxf(mx, v);
                }
            mx = fmaxf(mx, dppf<0x124, 0xf, 0xf, false>(mx, mx)); mx = fmaxf(mx, dppf<0x128, 0xf, 0xf, false>(mx, mx));
            mx = fmaxf(mx, __shfl_xor(mx, 16)); mx = fmaxf(mx, __shfl_xor(mx, 32));
            float sum = 0.f;
#pragma unroll
            for (int q4 = 0; q4 < 4; ++q4)
#pragma unroll
                for (int r = 0; r < 4; ++r) { const float e = __expf((Pk[q4][r] - mx) * (0.125f / 256.f)); Pk[q4][r] = e; sum += e; }
            sum += dppf<0x124, 0xf, 0xf, false>(sum, sum); sum += dppf<0x128, 0xf, 0xf, false>(sum, sum);
            sum += __shfl_xor(sum, 16); sum += __shfl_xor(sum, 32);
            const float invs = 256.f / sum;
#pragma unroll
            for (int q4 = 0; q4 < 4; ++q4)
#pragma unroll
                for (int r = 0; r < 4; ++r) Pk[q4][r] *= invs;
#pragma unroll
            for (int q4 = 0; q4 < 4; ++q4)
#pragma unroll
                for (int r = 0; r < 4; ++r) {
                    const float pv = Pk[q4][r];
                    S[4 * q4][r] = pv;
                    S[4 * q4 + 1][r] = dppf<0x104, 0xf, 0xf, false>(pv, pv);
                    S[4 * q4 + 2][r] = dppf<0x108, 0xf, 0xf, false>(pv, pv);
                    S[4 * q4 + 3][r] = dppf<0x10C, 0xf, 0xf, false>(pv, pv);
                }
        }
        f32x4 O[4];
#pragma unroll
        for (int dt = 0; dt < 4; ++dt) O[dt] = (f32x4){0.f, 0.f, 0.f, 0.f};
        const LAS unsigned char* vp = (const LAS unsigned char*)(vst + (16 * (g >> 1) + 8 * (g & 1) + 4 * ((c >> 1) >> 2) + ((c >> 1) & 3)) * 80 + (c & 1) * 8);
        typedef int v2i32_t __attribute__((ext_vector_type(2)));
#pragma unroll
        for (int hv = 0; hv < 2; ++hv) {
            u32x4 vr[8];
            if (hv == 0) {
#pragma unroll
                for (int i = 0; i < 8; ++i) vr[i] = vra[i];
            } else {
#pragma unroll
                for (int i = 0; i < 8; ++i) { const unsigned key = selrow[128 + i * 16 + (lane >> 2)]; vr[i] = ldws<u32x4>(W, vvb + key * 128u); }
            }
#pragma unroll
            for (int k4 = 0; k4 < 4; ++k4) {
                const int ks2 = hv * 4 + k4;
                __builtin_amdgcn_wave_barrier();
#pragma unroll
                for (int i2 = 0; i2 < 2; ++i2) {
                    const int slot = 16 * (lane >> 5) + 8 * ((lane >> 4) & 1) + 4 * i2 + ((lane >> 2) & 3);
                    *(u32x4*)(vst + slot * 80 + (lane & 3) * 16) = vr[k4 * 2 + i2];
                }
                __builtin_amdgcn_s_waitcnt(0xC07F);
                __builtin_amdgcn_wave_barrier();
                const uint2 pw = pack8_fp8(S[2 * ks2], S[2 * ks2 + 1]);
                const long pa = (long)(((unsigned long long)pw.y << 32) | pw.x);
#pragma unroll
                for (int dt = 0; dt < 4; ++dt) {
                    const v2i32_t l0 = __builtin_amdgcn_ds_read_tr8_b64_v2i32((LAS v2i32_t*)(vp + dt * 16));
                    const long vb = (long)(((unsigned long long)(unsigned)l0[1] << 32) | (unsigned)l0[0]);
                    O[dt] = __builtin_amdgcn_mfma_f32_16x16x32_fp8_fp8(pa, vb, O[dt], 0, 0, 0);
                }
            }
        }
        if (g == 0) {
            bf16_t* yo = (bf16_t*)(p.ws + yatt_off) + (size_t)rowg * 512 + n * 256 + c;
#pragma unroll
            for (int dt = 0; dt < 4; ++dt)
#pragma unroll
                for (int r = 0; r < 4; ++r) yo[r * 64 + dt * 16] = (bf16_t)f2bf(O[dt][r] * (1.f / 4096.f));
        }
    }
}

__device__ __forceinline__ void phase_dsa(const Params& p, unsigned char* smem, unsigned yatt_off, int vcu, int G) {
    int tid = threadIdx.x; asm volatile("" : "+v"(tid));
    const int lane = tid & 63, wave = __builtin_amdgcn_readfirstlane(tid >> 6);
    { unsigned* hz = (unsigned*)(smem + DSA_HIST_OFF); for (int i = tid; i < 16 * 256; i += NT) hz[i] = 0u; }
    const bool bal = (G == 256);
    const int nit = bal ? 8 : (NB * 256 - vcu + G - 1) / G;
#pragma unroll 1
    for (int it = 0; it < nit; ++it) {
        int b, tt;
        if (bal) { const int j = vcu & 31; b = vcu >> 5; tt = (it >> 1) * 64 + ((it & 1) ? 63 - j : j); }
        else { const int item = vcu + it * G; b = item >> 8; tt = item & 255; }
        dsa_item(p, smem, yatt_off, b, tt, lane, wave);
#if PEER_FP8
        {
            if (bal) {
                const int slots = G * NWAVES * 8, per = (2 * 16384 + slots - 1) / slots;
                const int s0 = ((vcu * NWAVES + wave) * 8 + it) * per;
                for (int r = s0; r < s0 + per && r < 2 * 16384; ++r) peer_table_row(p, r, lane, smem + DSA_HIST_OFF + 16384 + wave * 768);
            }
        }
#endif
    }
#if PEER_FP8
    if (!bal) for (int r = vcu * NWAVES + wave; r < 2 * 16384; r += G * NWAVES) peer_table_row(p, r, lane, smem + DSA_HIST_OFF + 16384 + wave * 768);
#endif
}

template <bool DRY>
__device__ __forceinline__ void phase_peer(const Params& p, unsigned char* smem, int vcu, int G) {
    int tid_ = threadIdx.x; asm volatile("" : "+v"(tid_)); const int wave = tid_ >> 6, lane = tid_ & 63;
    float* wsm = (float*)smem + wave * 1024;
    float* sc = wsm;
    float* v1s = wsm + 256; int* i1s = (int*)(wsm + 272); float* v2s = wsm + 288; int* i2s = (int*)(wsm + 304);
    float* tops = wsm + 320;
    int* tope = (int*)(wsm + 336);
    int* eid = (int*)(wsm + 384);
    float* egate = wsm + 512;
    const float* scores = WSP(float, WS_SCORES);
    const bf16_t* hg = WSP(bf16_t, WS_HG);
    const float* rss = WSP(float, WS_RSS);
    const bf16_t* ut = WSP(bf16_t, WS_UTAB); const bf16_t* vt = WSP(bf16_t, WS_VTAB);
    const int nwaves = G * NWAVES;
    int ca = 0, cb = 0;
    {
        int rem = lane; bool found = false;
#pragma unroll
        for (int a = 0; a < 16; ++a) { int cnt = 16 / (a + 1); if (!found) { if (rem < cnt) { ca = a; cb = rem; found = true; } else rem -= cnt; } }
    }
    for (int row = vcu * NWAVES + wave; row < MTOK; row += nwaves) {
        float rs;
        {
            float t = lane < 16 ? rss[(size_t)row * 16 + lane] : 0.f;
            t = wave_sum(t);
            rs = rsqrtf(t * (1.f / DM) + NORM_EPS);
        }
        for (int h = 0; h < PEER_H; ++h) {
            const float* sp = scores + (size_t)row * 2048 + h * 256;
            float a0 = sp[lane], a1 = sp[lane + 64], b0 = sp[128 + lane], b1 = sp[192 + lane];
            __builtin_amdgcn_wave_barrier();
            sc[lane] = a0; sc[lane + 64] = a1; sc[128 + lane] = b0; sc[192 + lane] = b1;
            __builtin_amdgcn_s_waitcnt(0);
            __builtin_amdgcn_wave_barrier();
            int ra0 = 0, ra1 = 0, rb0 = 0, rb1 = 0;
            for (int j = 0; j < 64; ++j) {
                float x = sc[j], y = sc[j + 64], z = sc[128 + j], w = sc[192 + j];
                ra0 += (x > a0) || (x == a0 && j < lane); ra0 += (y > a0);
                ra1 += (x >= a1); ra1 += (y > a1) || (y == a1 && j < lane);
                rb0 += (z > b0) || (z == b0 && j < lane); rb0 += (w > b0);
                rb1 += (z >= b1); rb1 += (w > b1) || (w == b1 && j < lane);
            }
            if (ra0 < 16) { v1s[ra0] = a0; i1s[ra0] = lane; }
            if (ra1 < 16) { v1s[ra1] = a1; i1s[ra1] = lane + 64; }
            if (rb0 < 16) { v2s[rb0] = b0; i2s[rb0] = lane; }
            if (rb1 < 16) { v2s[rb1] = b1; i2s[rb1] = lane + 64; }
            __builtin_amdgcn_s_waitcnt(0);
            __builtin_amdgcn_wave_barrier();
            float cv = -3e38f; int cpos = 1 << 20;
            if (lane < 50) { cv = v1s[ca] + v2s[cb]; cpos = ca * 16 + cb; }
            int rk = 0;
            for (int j = 0; j < 50; ++j) {
                float x = __shfl(cv, j); int px = __shfl(cpos, j);
                rk += (x > cv) || (x == cv && px < cpos);
            }
            if (lane < 50 && rk < 16) { tops[rk] = cv; tope[rk] = i1s[ca] * PEER_KEYS + i2s[cb]; }
            __builtin_amdgcn_s_waitcnt(0);
            __builtin_amdgcn_wave_barrier();
            if (lane < 16) {
                float s = tops[lane] * rs;
                float mx = s;
#pragma unroll
                for (int o = 8; o >= 1; o >>= 1) mx = fmaxf(mx, __shfl_xor(mx, o, 16));
                float e = __expf(s - mx), sm = e;
#pragma unroll
                for (int o = 8; o >= 1; o >>= 1) sm += __shfl_xor(sm, o, 16);
                eid[h * 16 + lane] = tope[lane];
                egate[h * 16 + lane] = e / sm;
            }
            __builtin_amdgcn_s_waitcnt(0);
            __builtin_amdgcn_wave_barrier();
        }
        f32x4 xv[4], acc[4];
        {
            const bf16_t* hr = hg + (size_t)row * DM;
            unpack8(*(const u32x4*)(hr + lane * 8), xv[0], xv[1]);
            unpack8(*(const u32x4*)(hr + 512 + lane * 8), xv[2], xv[3]);
#pragma unroll
            for (int i = 0; i < 4; ++i) { xv[i] = xv[i] * rs; acc[i] = (f32x4){0.f, 0.f, 0.f, 0.f}; }
        }
        for (int e0 = 0; e0 < 128; e0 += 4) {
            u32x4 uw[4][2], vw[4][2];
#pragma unroll
            for (int e = 0; e < 4; ++e) {
                const bf16_t* ur = ut + (size_t)eid[e0 + e] * DM;
                uw[e][0] = *(const u32x4*)(ur + lane * 8); uw[e][1] = *(const u32x4*)(ur + 512 + lane * 8);
            }
#pragma unroll
            for (int e = 0; e < 4; ++e) {
                const bf16_t* vr = vt + (size_t)eid[e0 + e] * DM;
                vw[e][0] = *(const u32x4*)(vr + lane * 8); vw[e][1] = *(const u32x4*)(vr + 512 + lane * 8);
            }
            float act[4];
#pragma unroll
            for (int e = 0; e < 4; ++e) {
                f32x4 u0, u1, u2, u3; unpack8(uw[e][0], u0, u1); unpack8(uw[e][1], u2, u3);
                f32x4 s4 = xv[0] * u0 + xv[1] * u1 + xv[2] * u2 + xv[3] * u3;
                float d = wave_sum((s4[0] + s4[1]) + (s4[2] + s4[3]));
                act[e] = gelu_tanh(d) * egate[e0 + e];
            }
#pragma unroll
            for (int e = 0; e < 4; ++e) {
                f32x4 v0, v1, v2, v3; unpack8(vw[e][0], v0, v1); unpack8(vw[e][1], v2, v3);
                acc[0] += v0 * act[e]; acc[1] += v1 * act[e]; acc[2] += v2 * act[e]; acc[3] += v3 * act[e];
            }
        }
        float* hr = p.out + (size_t)row * DM;
        float ss = 0.f;
        if (DRY) { const float chk = acc[0][0] + acc[1][1] + acc[2][2] + acc[3][3]; if (chk == 1.2345678f) hr[lane] = chk; continue; }
#pragma unroll
        for (int c = 0; c < 2; ++c) {
            acc[2 * c] += *(const f32x4*)(hr + c * 512 + lane * 8); acc[2 * c + 1] += *(const f32x4*)(hr + c * 512 + lane * 8 + 4);
        }
#pragma unroll
        for (int i = 0; i < 4; ++i) ss += acc[i][0] * acc[i][0] + acc[i][1] * acc[i][1] + acc[i][2] * acc[i][2] + acc[i][3] * acc[i][3];
        ss = wave_sum(ss);
        float scl = rsqrtf(ss * (1.f / DM) + NORM_EPS);
#if defined(PROBE_ATTN) || defined(PROBE_SSM)
        {
            const float e = ((const float*)p.ws)[16] / fmaxf(((const float*)p.ws)[17], 1e-30f);
            int kx = 0; if (e > 1e-6f) kx++; if (e > 1e-5f) kx++; if (e > 1e-4f) kx++; if (e > 1e-3f) kx++; if (e > 1e-2f) kx++; if (e > 1e-1f) kx++; if (!(e == e)) kx = 8;
            scl *= 1.f + 0.05f * kx;
        }
#endif
#pragma unroll
        for (int c = 0; c < 2; ++c) {
            f32x4 ga = *(const f32x4*)(p.norm_f_g + c * 512 + lane * 8), gb = *(const f32x4*)(p.norm_f_g + c * 512 + lane * 8 + 4);
            *(f32x4*)(hr + c * 512 + lane * 8) = acc[2 * c] * scl * ga; *(f32x4*)(hr + c * 512 + lane * 8 + 4) = acc[2 * c + 1] * scl * gb;
        }
    }
}


template <int MODE>
__device__ __forceinline__ void phase_peer2(const Params& p, unsigned char* smem, int vcu, int G) {
    int tid_ = threadIdx.x; asm volatile("" : "+v"(tid_));
    const int wave = __builtin_amdgcn_readfirstlane(tid_ >> 6), lane = tid_ & 63;
    const int gq = lane >> 4, c = lane & 15;
    unsigned char* wsm = smem + wave * 4096;
    bf16_t* xl = (bf16_t*)wsm;
    float* lv = (float*)(wsm + 2048);
    int* li = (int*)(wsm + 2048 + 128);
    float* vs = (float*)(wsm + 2048 + 256);
    int* is_ = (int*)(wsm + 2048 + 384);
    int* eid = (int*)(wsm + 2048 + 512);
    float* egate = (float*)(wsm + 2048 + 1024);
    float* eusc = (float*)(wsm + 2048 + 1536);
    const unsigned char* W = p.ws;
    constexpr unsigned O_SC = WS_SCORES << 20, O_HG = WS_HG << 20, O_UT = WS_UTAB << 20, O_VT = WS_VTAB << 20;
    const float* rss = WSP(float, WS_RSS);
    const int nwaves = G * NWAVES;
    int ca = 0, cb = 0;
    {
        int rem = lane; bool found = false;
#pragma unroll
        for (int a = 0; a < 16; ++a) { const int cnt = 16 / (a + 1); if (!found) { if (rem < cnt) { ca = a; cb = rem; found = true; } else rem -= cnt; } }
    }
#pragma unroll 1
    for (int row = vcu * NWAVES + wave; row < MTOK; row += nwaves) {
        float rs;
        { float t = lane < 16 ? rss[(size_t)row * 16 + lane] : 0.f; t = wave_sum(t); rs = rsqrtf(t * (1.f / DM) + NORM_EPS); }
        {
            const u32x4 w0 = ldws<u32x4>(W, O_HG + (unsigned)row * 2048u + lane * 16), w1 = ldws<u32x4>(W, O_HG + (unsigned)row * 2048u + 1024 + lane * 16);
#if PEER_FP8
            f32x4 xa[4]; unpack8(w0, xa[0], xa[1]); unpack8(w1, xa[2], xa[3]);
            xa[0] *= *(const f32x4*)(p.norm2_g + lane * 8); xa[1] *= *(const f32x4*)(p.norm2_g + lane * 8 + 4); xa[2] *= *(const f32x4*)(p.norm2_g + 512 + lane * 8); xa[3] *= *(const f32x4*)(p.norm2_g + 512 + lane * 8 + 4);
            unsigned hw[4], lw[4];
#pragma unroll
            for (int i = 0; i < 4; ++i) {
                typedef float f32x2_ __attribute__((ext_vector_type(2)));
                const f32x4 xs = xa[i] * 16.f;
                int h = __builtin_amdgcn_cvt_pk_fp8_f32(xs[0], xs[1], 0, false); h = __builtin_amdgcn_cvt_pk_fp8_f32(xs[2], xs[3], h, true);
                const f32x2_ b0 = __builtin_amdgcn_cvt_pk_f32_fp8(h, false), b1 = __builtin_amdgcn_cvt_pk_f32_fp8(h, true);
                int l = __builtin_amdgcn_cvt_pk_fp8_f32((xs[0] - b0[0]) * 16.f, (xs[1] - b0[1]) * 16.f, 0, false); l = __builtin_amdgcn_cvt_pk_fp8_f32((xs[2] - b1[0]) * 16.f, (xs[3] - b1[1]) * 16.f, l, true);
                hw[i] = (unsigned)h; lw[i] = (unsigned)l;
            }
            *(uint2*)(wsm + lane * 8) = make_uint2(hw[0], hw[1]); *(uint2*)(wsm + 512 + lane * 8) = make_uint2(hw[2], hw[3]);
            *(uint2*)(wsm + 1024 + lane * 8) = make_uint2(lw[0], lw[1]); *(uint2*)(wsm + 1536 + lane * 8) = make_uint2(lw[2], lw[3]);
#else
            *(u32x4*)(wsm + lane * 16) = w0; *(u32x4*)(wsm + 1024 + lane * 16) = w1;
#endif
        }
#ifdef PROBE_NOTOPK
        if (MODE == 1) { eid[lane] = (row * 131 + lane * 977) & 16383; eid[lane + 64] = (row * 137 + lane * 1499 + 7) & 16383; egate[lane] = 0.0625f; egate[lane + 64] = 0.0625f; eusc[lane] = 1.f; eusc[lane + 64] = 1.f; }
        else
#endif
#pragma unroll 1
        for (int h = 0; h < PEER_H; ++h) {
            const unsigned so = O_SC + (unsigned)row * 4096u + h * 512 + lane * 2;
            const unsigned short ha0 = ldws<unsigned short>(W, so), ha1 = ldws<unsigned short>(W, so + 128), hb0 = ldws<unsigned short>(W, so + 256), hb1 = ldws<unsigned short>(W, so + 384);
            const float a0 = (float)__builtin_bit_cast(_Float16, ha0), a1 = (float)__builtin_bit_cast(_Float16, ha1), b0 = (float)__builtin_bit_cast(_Float16, hb0), b1 = (float)__builtin_bit_cast(_Float16, hb1);
#define K16(hb) ((((unsigned)(hb) & 0x8000u) ? (~(unsigned)(hb) & 0xffffu) : ((unsigned)(hb) | 0x8000u)) << 16)
            const unsigned ka0 = K16(ha0) | (0xFFFFu - (unsigned)lane), ka1 = K16(ha1) | (0xFFFFu - 64u - (unsigned)lane);
            const unsigned kb0 = K16(hb0) | (0xFFFFu - (unsigned)lane), kb1 = K16(hb1) | (0xFFFFu - 64u - (unsigned)lane);
#undef K16
            unsigned long long loA = 0, hiA = 1ull << 32, loB = 0, hiB = 1ull << 32; bool doneA = false, doneB = false;
            while (!(doneA && doneB)) {
                if (!doneA) { const unsigned mid = (unsigned)((loA + hiA) >> 1); const int cnt = __builtin_popcountll(__ballot(ka0 >= mid)) + __builtin_popcountll(__ballot(ka1 >= mid));
                    if (cnt >= 16) loA = mid; else hiA = mid; doneA = (cnt == 16) || (hiA - loA <= 1); }
                if (!doneB) { const unsigned mid = (unsigned)((loB + hiB) >> 1); const int cnt = __builtin_popcountll(__ballot(kb0 >= mid)) + __builtin_popcountll(__ballot(kb1 >= mid));
                    if (cnt >= 16) loB = mid; else hiB = mid; doneB = (cnt == 16) || (hiB - loB <= 1); }
            }
            __builtin_amdgcn_wave_barrier();
            {
                const unsigned T = (unsigned)loA;
                const bool k0 = ka0 >= T, k1 = ka1 >= T;
                const unsigned long long s0 = __ballot(k0), s1 = __ballot(k1);
                if (k0) { const int pos = mbcnt64(s0); lv[pos] = a0; li[pos] = lane; }
                if (k1) { const int pos = __builtin_popcountll(s0) + mbcnt64(s1); if (pos < 16) { lv[pos] = a1; li[pos] = lane + 64; } }
            }
            {
                const unsigned T = (unsigned)loB;
                const bool k0 = kb0 >= T, k1 = kb1 >= T;
                const unsigned long long s0 = __ballot(k0), s1 = __ballot(k1);
                if (k0) { const int pos = mbcnt64(s0); lv[16 + pos] = b0; li[16 + pos] = lane; }
                if (k1) { const int pos = __builtin_popcountll(s0) + mbcnt64(s1); if (pos < 16) { lv[16 + pos] = b1; li[16 + pos] = lane + 64; } }
            }
            __builtin_amdgcn_s_waitcnt(0xC07F);
            __builtin_amdgcn_wave_barrier();
            if (lane < 32) {
                const int base = lane & 16, me = lane & 15;
                const float mv = lv[lane]; int rk = 0;
#pragma unroll
                for (int j = 0; j < 16; ++j) { const float x = lv[base + j]; rk += (x > mv) || (x == mv && j < me); }
                vs[base + rk] = mv; is_[base + rk] = li[lane];
            }
            __builtin_amdgcn_s_waitcnt(0xC07F);
            __builtin_amdgcn_wave_barrier();
            float cv = 0.f; unsigned kc = 0u;
            if (lane < 50) { cv = vs[ca] + vs[16 + cb]; kc = fkey(cv); }
            unsigned long long lo = fkey(vs[15] + vs[31]), hi = (unsigned long long)fkey(vs[0] + vs[16]) + 1ull;
            while (hi - lo > 1) {
                const unsigned mid = (unsigned)((lo + hi) >> 1); const int cnt = __builtin_popcountll(__ballot(kc >= mid));
                if (cnt >= 16) lo = mid; else hi = mid;
                if (cnt == 16) break;
            }
            const unsigned T2 = (unsigned)lo;
            const unsigned long long tm = __ballot(kc == T2);
            const int need2 = 16 - __builtin_popcountll(__ballot(kc > T2));
            const bool take = (kc > T2) || (kc == T2 && mbcnt64(tm) < need2);
            const float sv = take ? cv * rs : -3e38f;
            const float mx = wave_max(sv);
            const float ev = take ? __expf(sv - mx) : 0.f;
            const float sm = wave_sum(ev);
            if (take) { const int pos = mbcnt64(__ballot(take)); if (pos < 16) { const int e_ = is_[ca] * PEER_KEYS + is_[16 + cb]; eid[h * 16 + pos] = e_;
#if PEER_FP8
                egate[h * 16 + pos] = ev / sm * WSP(float, WS_VSC)[e_]; eusc[h * 16 + pos] = WSP(float, WS_USC)[e_];
#else
                egate[h * 16 + pos] = ev / sm;
#endif
            } }
            __builtin_amdgcn_wave_barrier();
        }
        __builtin_amdgcn_s_waitcnt(0xC07F);
        __builtin_amdgcn_wave_barrier();
#if PEER_FP8
        f32x4 acc[4];
#pragma unroll
        for (int i = 0; i < 4; ++i) acc[i] = (f32x4){0.f, 0.f, 0.f, 0.f};
        const unsigned koff = (unsigned)((c >> 3) * 64 + 16 * gq);
        u32x4 ub0[8], ub1[8], vb0[8], vb1[8];
#ifdef PROBE_L2GATHER
        if (MODE == 1) { eid[lane] &= 1023; eid[lane + 64] &= 1023; __builtin_amdgcn_s_waitcnt(0xC07F); __builtin_amdgcn_wave_barrier(); }
#endif
        int ec0 = eid[c & 7], ec1 = eid[8 + (c & 7)];
#pragma unroll
        for (int k3 = 0; k3 < 8; ++k3) ub0[k3] = ldws<u32x4>(W, O_UT + (unsigned)ec0 * 1024u + koff + k3 * 128);
#pragma unroll
        for (int j = 0; j < 8; ++j) vb0[j] = ldws<u32x4>(W, O_VT + (unsigned)__builtin_amdgcn_readlane(ec0, j) * 1024u + lane * 16);
#pragma unroll
        for (int k3 = 0; k3 < 8; ++k3) ub1[k3] = ldws<u32x4>(W, O_UT + (unsigned)ec1 * 1024u + koff + k3 * 128);
#define PEER_TILE(UB, EC, VBC, ECN, VBN)                                                                                           \
        {                                                                                                                          \
            f32x4 dh = {0.f, 0.f, 0.f, 0.f}, dl = {0.f, 0.f, 0.f, 0.f};                                                             \
            _Pragma("unroll") for (int k3 = 0; k3 < 8; ++k3) {                                                                     \
                const u32x4 xh = *(const u32x4*)(wsm + k3 * 128 + koff), xlo = *(const u32x4*)(wsm + 1024 + k3 * 128 + koff);      \
                const long u0 = (long)(((unsigned long long)UB[k3].y << 32) | UB[k3].x), u1 = (long)(((unsigned long long)UB[k3].w << 32) | UB[k3].z); \
                const long h0 = (long)(((unsigned long long)xh.y << 32) | xh.x), h1 = (long)(((unsigned long long)xh.w << 32) | xh.z);  \
                const long l0 = (long)(((unsigned long long)xlo.y << 32) | xlo.x), l1 = (long)(((unsigned long long)xlo.w << 32) | xlo.z); \
                dh = __builtin_amdgcn_mfma_f32_16x16x32_fp8_fp8(h0, u0, dh, 0, 0, 0);                                              \
                dh = __builtin_amdgcn_mfma_f32_16x16x32_fp8_fp8(h1, u1, dh, 0, 0, 0);                                              \
                dl = __builtin_amdgcn_mfma_f32_16x16x32_fp8_fp8(l0, u0, dl, 0, 0, 0);                                              \
                dl = __builtin_amdgcn_mfma_f32_16x16x32_fp8_fp8(l1, u1, dl, 0, 0, 0);                                              \
            }                                                                                                                      \
            float mine = dh[0] + dl[0] * (1.f / 16.f);                                                                             \
            mine += __shfl_xor(mine, 40);                                                       \
            const int ecur = EC;                                                                                                   \
            const float act = gelu_tanh(mine * (1.f / 16.f) * eusc[tcur * 8 + (c & 7)] * rs) * egate[tcur * 8 + (c & 7)];           \
            if (tcur + 2 < 16) {                                                                                                   \
                EC = eid[(tcur + 2) * 8 + (c & 7)];                                                                                \
                _Pragma("unroll") for (int k3 = 0; k3 < 8; ++k3) UB[k3] = ldws<u32x4>(W, O_UT + (unsigned)EC * 1024u + koff + k3 * 128); \
            }                                                                                                                      \
            if (tcur + 1 < 16) {                                                                                                   \
                _Pragma("unroll") for (int j = 0; j < 8; ++j) VBN[j] = ldws<u32x4>(W, O_VT + (unsigned)__builtin_amdgcn_readlane(ECN, j) * 1024u + lane * 16); \
            }                                                                                                                      \
            __builtin_amdgcn_sched_barrier(0);                                                                                     \
            _Pragma("unroll") for (int j = 0; j < 8; ++j) {                                                                        \
                const float aj = __builtin_bit_cast(float, __builtin_amdgcn_readlane(__builtin_bit_cast(int, act), j));            \
                const u32x4 vw = VBC[j];                                                                                           \
                typedef float f32x2_ __attribute__((ext_vector_type(2)));                                                          \
                const f32x2_ p0 = __builtin_amdgcn_cvt_pk_f32_fp8((int)vw.x, false), p1 = __builtin_amdgcn_cvt_pk_f32_fp8((int)vw.x, true); \
                const f32x2_ p2 = __builtin_amdgcn_cvt_pk_f32_fp8((int)vw.y, false), p3 = __builtin_amdgcn_cvt_pk_f32_fp8((int)vw.y, true); \
                const f32x2_ p4 = __builtin_amdgcn_cvt_pk_f32_fp8((int)vw.z, false), p5 = __builtin_amdgcn_cvt_pk_f32_fp8((int)vw.z, true); \
                const f32x2_ p6 = __builtin_amdgcn_cvt_pk_f32_fp8((int)vw.w, false), p7 = __builtin_amdgcn_cvt_pk_f32_fp8((int)vw.w, true); \
                acc[0] += (f32x4){p0[0], p0[1], p1[0], p1[1]} * aj; acc[1] += (f32x4){p2[0], p2[1], p3[0], p3[1]} * aj;             \
                acc[2] += (f32x4){p4[0], p4[1], p5[0], p5[1]} * aj; acc[3] += (f32x4){p6[0], p6[1], p7[0], p7[1]} * aj;             \
            }                                                                                                                      \
            __builtin_amdgcn_sched_barrier(0);                                                                                     \
        }
#pragma unroll 1
        for (int tp = 0; tp < 8; ++tp) {
            { const int tcur = 2 * tp; PEER_TILE(ub0, ec0, vb0, ec1, vb1) }
            { const int tcur = 2 * tp + 1; PEER_TILE(ub1, ec1, vb1, ec0, vb0) }
        }
#undef PEER_TILE
#else
        f32x4 acc[4];
#pragma unroll
        for (int i = 0; i < 4; ++i) acc[i] = (f32x4){0.f, 0.f, 0.f, 0.f};
        bf16x8 ubuf[32];
        int ec = eid[c]; float gc = egate[c];
        {
            const unsigned ub = O_UT + (unsigned)ec * 2048u + 16 * gq;
#pragma unroll
            for (int ks = 0; ks < 32; ++ks) ubuf[ks] = ldws<bf16x8>(W, ub + ks * 64);
        }
#pragma unroll 1
        for (int tile = 0; tile < 8; ++tile) {
            f32x4 d = {0.f, 0.f, 0.f, 0.f};
#pragma unroll
            for (int ks = 0; ks < 32; ++ks) d = __builtin_amdgcn_mfma_f32_16x16x32_bf16(*(const bf16x8*)(xl + ks * 32 + 8 * gq), ubuf[ks], d, 0, 0, 0);
            const float act = gelu_tanh(d[0] * rs) * gc;
            const int ecur = ec;
            if (tile < 7) {
                ec = eid[(tile + 1) * 16 + c]; gc = egate[(tile + 1) * 16 + c];
                const unsigned ub = O_UT + (unsigned)ec * 2048u + 16 * gq;
#pragma unroll
                for (int ks = 0; ks < 32; ++ks) ubuf[ks] = ldws<bf16x8>(W, ub + ks * 64);
            }
#pragma unroll
            for (int j = 0; j < 16; ++j) {
                const int ej = __builtin_amdgcn_readlane(ecur, j);
                const float aj = __builtin_bit_cast(float, __builtin_amdgcn_readlane(__builtin_bit_cast(int, act), j));
                const unsigned vb = O_VT + (unsigned)ej * 2048u + lane * 16;
                f32x4 v0, v1, v2, v3; unpack8(ldws<u32x4>(W, vb), v0, v1); unpack8(ldws<u32x4>(W, vb + 1024), v2, v3);
                acc[0] += v0 * aj; acc[1] += v1 * aj; acc[2] += v2 * aj; acc[3] += v3 * aj;
                if ((j & 3) == 3) __builtin_amdgcn_sched_barrier(0);
            }
        }
#endif
        float* hr = p.out + (size_t)row * DM;
        if (MODE == 1) { const float chk = acc[0][0] + acc[1][1] + acc[2][2] + acc[3][3]; if (chk == 1.2345678f) hr[lane] = chk; continue; }
        float ss = 0.f;
        {
            f32x4 h0, h1, h2, h3;
            unpack8(ldws<u32x4>(W, O_HG + (unsigned)row * 2048u + lane * 16), h0, h1); unpack8(ldws<u32x4>(W, O_HG + (unsigned)row * 2048u + 1024 + lane * 16), h2, h3);
            acc[0] += h0; acc[1] += h1; acc[2] += h2; acc[3] += h3;
        }
#pragma unroll
        for (int i = 0; i < 4; ++i) ss += acc[i][0] * acc[i][0] + acc[i][1] * acc[i][1] + acc[i][2] * acc[i][2] + acc[i][3] * acc[i][3];
        ss = wave_sum(ss);
        const float scl = rsqrtf(ss * (1.f / DM) + NORM_EPS);
        float* dst = hr;
        if (MODE == 2) { if (row >= 8192) continue; dst = WSP(float, 462) + (size_t)row * DM; }
#pragma unroll
        for (int cc = 0; cc < 2; ++cc) {
            const f32x4 ga = *(const f32x4*)(p.norm_f_g + cc * 512 + lane * 8), gb = *(const f32x4*)(p.norm_f_g + cc * 512 + lane * 8 + 4);
            *(f32x4*)(dst + cc * 512 + lane * 8) = acc[2 * cc] * scl * ga; *(f32x4*)(dst + cc * 512 + lane * 8 + 4) = acc[2 * cc + 1] * scl * gb;
        }
    }
}


__device__ __forceinline__ void phase_peer4(const Params& p, unsigned char* smem, int vcu, int G) {
    int tid_ = threadIdx.x; asm volatile("" : "+v"(tid_));
    const int wave = __builtin_amdgcn_readfirstlane(tid_ >> 6), lane = tid_ & 63;
    const int gq = lane >> 4, c = lane & 15;
    unsigned char* wbase = smem + wave * 8192;
    const unsigned char* W = p.ws;
    constexpr unsigned O_SC = WS_SCORES << 20, O_HG = WS_HG << 20, O_UT = WS_UTAB << 20, O_VT = WS_VTAB << 20;
    const float* rss = WSP(float, WS_RSS);
    const float* uscg = WSP(float, WS_USC); const float* vscg = WSP(float, WS_VSC);
    const int stride = G * NWAVES;
    int ca = 0, cb = 0;
    {
        int rem = lane; bool found = false;
#pragma unroll
        for (int a = 0; a < 16; ++a) { const int cnt = 16 / (a + 1); if (!found) { if (rem < cnt) { ca = a; cb = rem; found = true; } else rem -= cnt; } }
    }
    int row = vcu * NWAVES + wave;
    if (row >= MTOK) return;
    u32x4 xw0, xw1; float rssv = 0.f; unsigned sc0 = 0, sc1 = 0, sc2 = 0, sc3 = 0;
    int pend_i = -1; float pend_g = 0.f, pend_su = 0.f, pend_sv = 0.f;
#define NB_LV(B)  ((float*)((B) + 2048))
#define NB_LI(B)  ((int*)((B) + 2048 + 128))
#define NB_VS(B)  ((float*)((B) + 2048 + 256))
#define NB_IS(B)  ((int*)((B) + 2048 + 384))
#define NB_EID(B) ((int*)((B) + 2048 + 512))
#define NB_EG(B)  ((float*)((B) + 2048 + 1024))
#define NB_EU(B)  ((float*)((B) + 2048 + 1536))
#define TK_LOAD_X(R) { xw0 = ldws<u32x4>(W, O_HG + (unsigned)(R) * 2048u + lane * 16); xw1 = ldws<u32x4>(W, O_HG + (unsigned)(R) * 2048u + 1024 + lane * 16); rssv = lane < 16 ? rss[(size_t)(R) * 16 + lane] : 0.f; }
#define TK_LOAD_SC(R, H) { const unsigned so_ = O_SC + (unsigned)(R) * 4096u + (H) * 512 + lane * 2; sc0 = ldws<unsigned short>(W, so_); sc1 = ldws<unsigned short>(W, so_ + 128); sc2 = ldws<unsigned short>(W, so_ + 256); sc3 = ldws<unsigned short>(W, so_ + 384); }
#define TK_STAGE_X(B, RS) {                                                                                                        \
        RS = rsqrtf(wave_sum(rssv) * (1.f / DM) + NORM_EPS);                                                                       \
        f32x4 xa[4]; unpack8(xw0, xa[0], xa[1]); unpack8(xw1, xa[2], xa[3]);                                                        \
        xa[0] *= *(const f32x4*)(p.norm2_g + lane * 8); xa[1] *= *(const f32x4*)(p.norm2_g + lane * 8 + 4); xa[2] *= *(const f32x4*)(p.norm2_g + 512 + lane * 8); xa[3] *= *(const f32x4*)(p.norm2_g + 512 + lane * 8 + 4); \
        unsigned hw[4], lw[4];                                                                                                     \
        _Pragma("unroll") for (int i = 0; i < 4; ++i) {                                                                            \
            const f32x4 xs = xa[i] * 16.f;                                                                                         \
            int h_ = __builtin_amdgcn_cvt_pk_fp8_f32(xs[0], xs[1], 0, false); h_ = __builtin_amdgcn_cvt_pk_fp8_f32(xs[2], xs[3], h_, true); \
            const f32x2_t b0 = __builtin_amdgcn_cvt_pk_f32_fp8(h_, false), b1 = __builtin_amdgcn_cvt_pk_f32_fp8(h_, true);         \
            int l_ = __builtin_amdgcn_cvt_pk_fp8_f32((xs[0] - b0[0]) * 16.f, (xs[1] - b0[1]) * 16.f, 0, false); l_ = __builtin_amdgcn_cvt_pk_fp8_f32((xs[2] - b1[0]) * 16.f, (xs[3] - b1[1]) * 16.f, l_, true); \
            hw[i] = (unsigned)h_; lw[i] = (unsigned)l_;                                                                            \
        }                                                                                                                          \
        *(uint2*)((B) + lane * 8) = make_uint2(hw[0], hw[1]); *(uint2*)((B) + 512 + lane * 8) = make_uint2(hw[2], hw[3]);          \
        *(uint2*)((B) + 1024 + lane * 8) = make_uint2(lw[0], lw[1]); *(uint2*)((B) + 1536 + lane * 8) = make_uint2(lw[2], lw[3]);  \
    }
#define TK_K16(hb) ((((unsigned)(hb) & 0x8000u) ? (~(unsigned)(hb) & 0xffffu) : ((unsigned)(hb) | 0x8000u)) << 16)
#define TK_PART_A(B) {                                                                                                             \
        const float a0 = (float)__builtin_bit_cast(_Float16, (unsigned short)sc0), a1 = (float)__builtin_bit_cast(_Float16, (unsigned short)sc1); \
        const float b0 = (float)__builtin_bit_cast(_Float16, (unsigned short)sc2), b1 = (float)__builtin_bit_cast(_Float16, (unsigned short)sc3); \
        const unsigned ka0 = TK_K16(sc0) | (0xFFFFu - (unsigned)lane), ka1 = TK_K16(sc1) | (0xFFFFu - 64u - (unsigned)lane);       \
        const unsigned kb0 = TK_K16(sc2) | (0xFFFFu - (unsigned)lane), kb1 = TK_K16(sc3) | (0xFFFFu - 64u - (unsigned)lane);       \
        unsigned long long loA = 0, hiA = 1ull << 32, loB = 0, hiB = 1ull << 32; bool doneA = false, doneB = false;                 \
        while (!(doneA && doneB)) {                                                                                                \
            if (!doneA) { const unsigned mid = (unsigned)((loA + hiA) >> 1); const int cnt = __builtin_popcountll(__ballot(ka0 >= mid)) + __builtin_popcountll(__ballot(ka1 >= mid)); \
                if (cnt >= 16) loA = mid; else hiA = mid; doneA = (cnt == 16) || (hiA - loA <= 1); }                                \
            if (!doneB) { const unsigned mid = (unsigned)((loB + hiB) >> 1); const int cnt = __builtin_popcountll(__ballot(kb0 >= mid)) + __builtin_popcountll(__ballot(kb1 >= mid)); \
                if (cnt >= 16) loB = mid; else hiB = mid; doneB = (cnt == 16) || (hiB - loB <= 1); }                                \
        }                                                                                                                          \
        float* lv = NB_LV(B); int* li = NB_LI(B);                                                                                  \
        { const unsigned T = (unsigned)loA; const bool k0 = ka0 >= T, k1 = ka1 >= T; const unsigned long long s0 = __ballot(k0), s1 = __ballot(k1); \
          if (k0) { const int pos = mbcnt64(s0); lv[pos] = a0; li[pos] = lane; }                                                    \
          if (k1) { const int pos = __builtin_popcountll(s0) + mbcnt64(s1); if (pos < 16) { lv[pos] = a1; li[pos] = lane + 64; } } } \
        { const unsigned T = (unsigned)loB; const bool k0 = kb0 >= T, k1 = kb1 >= T; const unsigned long long s0 = __ballot(k0), s1 = __ballot(k1); \
          if (k0) { const int pos = mbcnt64(s0); lv[16 + pos] = b0; li[16 + pos] = lane; }                                           \
          if (k1) { const int pos = __builtin_popcountll(s0) + mbcnt64(s1); if (pos < 16) { lv[16 + pos] = b1; li[16 + pos] = lane + 64; } } } \
        __builtin_amdgcn_s_waitcnt(0xC07F); __builtin_amdgcn_wave_barrier();                                                       \
    }
#define TK_PART_B(B, H, RS) {                                                                                                      \
        float* lv = NB_LV(B); int* li = NB_LI(B); float* vs = NB_VS(B); int* is_ = NB_IS(B);                                        \
        if (lane < 32) { const int base = lane & 16, me = lane & 15; const float mv = lv[lane]; int rk = 0;                         \
            _Pragma("unroll") for (int j = 0; j < 16; ++j) { const float x = lv[base + j]; rk += (x > mv) || (x == mv && j < me); } \
            vs[base + rk] = mv; is_[base + rk] = li[lane]; }                                                                       \
        __builtin_amdgcn_s_waitcnt(0xC07F); __builtin_amdgcn_wave_barrier();                                                       \
        float cv = 0.f; unsigned kc = 0u;                                                                                          \
        if (lane < 50) { cv = vs[ca] + vs[16 + cb]; kc = fkey(cv); }                                                                \
        unsigned long long lo = fkey(vs[15] + vs[31]), hi = (unsigned long long)fkey(vs[0] + vs[16]) + 1ull;                        \
        while (hi - lo > 1) { const unsigned mid = (unsigned)((lo + hi) >> 1); const int cnt = __builtin_popcountll(__ballot(kc >= mid)); \
            if (cnt >= 16) lo = mid; else hi = mid; if (cnt == 16) break; }                                                        \
        const unsigned T2 = (unsigned)lo; const unsigned long long tm = __ballot(kc == T2);                                        \
        const int need2 = 16 - __builtin_popcountll(__ballot(kc > T2));                                                            \
        const bool take = (kc > T2) || (kc == T2 && mbcnt64(tm) < need2);                                                          \
        const float sv_ = take ? cv * (RS) : -3e38f; const float mx = wave_max(sv_);                                               \
        const float ev = take ? __expf(sv_ - mx) : 0.f; const float sm = wave_sum(ev);                                             \
        pend_i = -1;                                                                                                               \
        if (take) { const int pos = mbcnt64(__ballot(take)); if (pos < 16) { const int e_ = is_[ca] * PEER_KEYS + is_[16 + cb];     \
            NB_EID(B)[(H) * 16 + pos] = e_; pend_i = (H) * 16 + pos; pend_g = ev / sm; pend_su = uscg[e_]; pend_sv = vscg[e_]; } }    \
        __builtin_amdgcn_wave_barrier();                                                                                           \
    }
#define TK_FLUSH(B) { if (pend_i >= 0) { NB_EG(B)[pend_i] = pend_g * pend_sv; NB_EU(B)[pend_i] = pend_su; } pend_i = -1; }
    float rs_cur = 0.f, rs_n = 0.f;
    {
        unsigned char* B0 = wbase;
        TK_LOAD_X(row) TK_STAGE_X(B0, rs_cur)
#pragma unroll 1
        for (int h = 0; h < PEER_H; ++h) { TK_FLUSH(B0) TK_LOAD_SC(row, h) TK_PART_A(B0) TK_PART_B(B0, h, rs_cur) }
        TK_FLUSH(B0)
        __builtin_amdgcn_s_waitcnt(0xC07F); __builtin_amdgcn_wave_barrier();
    }
#pragma unroll 1
    for (int it = 0;; ++it) {
        unsigned char* wsm = wbase + (it & 1) * 4096;
        unsigned char* nb = wbase + ((it + 1) & 1) * 4096;
        const int* eid = NB_EID(wsm); const float* egate = NB_EG(wsm); const float* eusc = NB_EU(wsm);
        const float rs = rs_cur;
        const int nrow_raw = row + stride;
        const int nrow = nrow_raw < MTOK ? nrow_raw : row;
        TK_LOAD_X(nrow) TK_LOAD_SC(nrow, 0)
        f32x4 acc[4];
#pragma unroll
        for (int i = 0; i < 4; ++i) acc[i] = (f32x4){0.f, 0.f, 0.f, 0.f};
        const unsigned koff = (unsigned)((c >> 3) * 64 + 16 * gq);
        u32x4 ub0[8], ub1[8], vb0[8], vb1[8];
        int ec0 = eid[c & 7], ec1 = eid[8 + (c & 7)];
#pragma unroll
        for (int k3 = 0; k3 < 8; ++k3) ub0[k3] = ldws<u32x4>(W, O_UT + (unsigned)ec0 * 1024u + koff + k3 * 128);
#pragma unroll
        for (int j = 0; j < 8; ++j) vb0[j] = ldws<u32x4>(W, O_VT + (unsigned)__builtin_amdgcn_readlane(ec0, j) * 1024u + lane * 16);
#pragma unroll
        for (int k3 = 0; k3 < 8; ++k3) ub1[k3] = ldws<u32x4>(W, O_UT + (unsigned)ec1 * 1024u + koff + k3 * 128);
#define PEER_TILE(UB, EC, VBC, ECN, VBN)                                                                                           \
        {                                                                                                                          \
            f32x4 dh = {0.f, 0.f, 0.f, 0.f}, dl = {0.f, 0.f, 0.f, 0.f};                                                             \
            _Pragma("unroll") for (int k3 = 0; k3 < 8; ++k3) {                                                                     \
                const u32x4 xh = *(const u32x4*)(wsm + k3 * 128 + koff), xlo = *(const u32x4*)(wsm + 1024 + k3 * 128 + koff);      \
                const long u0 = (long)(((unsigned long long)UB[k3].y << 32) | UB[k3].x), u1 = (long)(((unsigned long long)UB[k3].w << 32) | UB[k3].z); \
                const long h0 = (long)(((unsigned long long)xh.y << 32) | xh.x), h1 = (long)(((unsigned long long)xh.w << 32) | xh.z);  \
                const long l0 = (long)(((unsigned long long)xlo.y << 32) | xlo.x), l1 = (long)(((unsigned long long)xlo.w << 32) | xlo.z); \
                dh = __builtin_amdgcn_mfma_f32_16x16x32_fp8_fp8(h0, u0, dh, 0, 0, 0);                                              \
                dh = __builtin_amdgcn_mfma_f32_16x16x32_fp8_fp8(h1, u1, dh, 0, 0, 0);                                              \
                dl = __builtin_amdgcn_mfma_f32_16x16x32_fp8_fp8(l0, u0, dl, 0, 0, 0);                                              \
                dl = __builtin_amdgcn_mfma_f32_16x16x32_fp8_fp8(l1, u1, dl, 0, 0, 0);                                              \
            }                                                                                                                      \
            float mine = dh[0] + dl[0] * (1.f / 16.f);                                                                             \
            mine += __shfl_xor(mine, 40);                                                       \
            const float act = gelu_tanh(mine * (1.f / 16.f) * eusc[tcur * 8 + (c & 7)] * rs) * egate[tcur * 8 + (c & 7)];           \
            if (tcur + 2 < 16) {                                                                                                   \
                EC = eid[(tcur + 2) * 8 + (c & 7)];                                                                                \
                _Pragma("unroll") for (int k3 = 0; k3 < 8; ++k3) UB[k3] = ldws<u32x4>(W, O_UT + (unsigned)EC * 1024u + koff + k3 * 128); \
            }                                                                                                                      \
            if (tcur + 1 < 16) {                                                                                                   \
                _Pragma("unroll") for (int j = 0; j < 8; ++j) VBN[j] = ldws<u32x4>(W, O_VT + (unsigned)__builtin_amdgcn_readlane(ECN, j) * 1024u + lane * 16); \
            }                                                                                                                      \
            __builtin_amdgcn_sched_barrier(0);                                                                                     \
            _Pragma("unroll") for (int j = 0; j < 8; ++j) {                                                                        \
                const float aj = __builtin_bit_cast(float, __builtin_amdgcn_readlane(__builtin_bit_cast(int, act), j));            \
                const u32x4 vw = VBC[j];                                                                                           \
                const f32x2_t p0 = __builtin_amdgcn_cvt_pk_f32_fp8((int)vw.x, false), p1 = __builtin_amdgcn_cvt_pk_f32_fp8((int)vw.x, true); \
                const f32x2_t p2 = __builtin_amdgcn_cvt_pk_f32_fp8((int)vw.y, false), p3 = __builtin_amdgcn_cvt_pk_f32_fp8((int)vw.y, true); \
                const f32x2_t p4 = __builtin_amdgcn_cvt_pk_f32_fp8((int)vw.z, false), p5 = __builtin_amdgcn_cvt_pk_f32_fp8((int)vw.z, true); \
                const f32x2_t p6 = __builtin_amdgcn_cvt_pk_f32_fp8((int)vw.w, false), p7 = __builtin_amdgcn_cvt_pk_f32_fp8((int)vw.w, true); \
                acc[0] += (f32x4){p0[0], p0[1], p1[0], p1[1]} * aj; acc[1] += (f32x4){p2[0], p2[1], p3[0], p3[1]} * aj;             \
                acc[2] += (f32x4){p4[0], p4[1], p5[0], p5[1]} * aj; acc[3] += (f32x4){p6[0], p6[1], p7[0], p7[1]} * aj;             \
            }                                                                                                                      \
            __builtin_amdgcn_sched_barrier(0);                                                                                     \
        }
#pragma unroll 1
        for (int tp = 0; tp < 8; ++tp) {
            { const int tcur = 2 * tp; PEER_TILE(ub0, ec0, vb0, ec1, vb1) }
            if (tp == 0) { TK_STAGE_X(nb, rs_n) }
            TK_FLUSH(nb)
            TK_PART_A(nb)
            __builtin_amdgcn_sched_barrier(0);
            { const int tcur = 2 * tp + 1; PEER_TILE(ub1, ec1, vb1, ec0, vb0) }
            TK_PART_B(nb, tp, rs_n)
            { const int hn = tp < 7 ? tp + 1 : 7; TK_LOAD_SC(nrow, hn) }
            __builtin_amdgcn_sched_barrier(0);
        }
#undef PEER_TILE
        TK_FLUSH(nb)
        float* hr = p.out + (size_t)row * DM;
        float ss = 0.f;
        {
            f32x4 h0, h1, h2, h3;
            unpack8(ldws<u32x4>(W, O_HG + (unsigned)row * 2048u + lane * 16), h0, h1); unpack8(ldws<u32x4>(W, O_HG + (unsigned)row * 2048u + 1024 + lane * 16), h2, h3);
            acc[0] += h0; acc[1] += h1; acc[2] += h2; acc[3] += h3;
        }
#pragma unroll
        for (int i = 0; i < 4; ++i) ss += acc[i][0] * acc[i][0] + acc[i][1] * acc[i][1] + acc[i][2] * acc[i][2] + acc[i][3] * acc[i][3];
        ss = wave_sum(ss);
        const float scl = rsqrtf(ss * (1.f / DM) + NORM_EPS);
#pragma unroll
        for (int cc = 0; cc < 2; ++cc) {
            const f32x4 ga = *(const f32x4*)(p.norm_f_g + cc * 512 + lane * 8), gb = *(const f32x4*)(p.norm_f_g + cc * 512 + lane * 8 + 4);
            *(f32x4*)(hr + cc * 512 + lane * 8) = acc[2 * cc] * scl * ga; *(f32x4*)(hr + cc * 512 + lane * 8 + 4) = acc[2 * cc + 1] * scl * gb;
        }
        __builtin_amdgcn_s_waitcnt(0xC07F); __builtin_amdgcn_wave_barrier();
        if (nrow_raw >= MTOK) break;
        row = nrow_raw; rs_cur = rs_n;
    }
#undef TK_FLUSH
#undef TK_PART_B
#undef TK_PART_A
#undef TK_K16
#undef TK_STAGE_X
#undef TK_LOAD_SC
#undef TK_LOAD_X
}

struct __attribute__((packed, aligned(4))) U3 { unsigned a, b, c; };
typedef int v8i32_t __attribute__((ext_vector_type(8)));
typedef int v6i32_t __attribute__((ext_vector_type(6)));
typedef float v32f32_t __attribute__((ext_vector_type(32)));
template <bool NOTK>
__device__ __forceinline__ void phase_peer6(const Params& p, unsigned char* smem, int vcu, int G) {
    int tid_ = threadIdx.x; asm volatile("" : "+v"(tid_));
    const int wave = __builtin_amdgcn_readfirstlane(tid_ >> 6), lane = tid_ & 63;
    const int gq = lane >> 4, c = lane & 15;
    unsigned char* wbase = smem + wave * 8192;
    const unsigned char* W = p.ws;
    constexpr unsigned O_SC = WS_SCORES << 20, O_HG = WS_HG << 20, O_UT = WS_UTAB << 20, O_VT = WS_VTAB << 20;
    const float* rss = WSP(float, WS_RSS);
    const float* uscg = WSP(float, WS_USC); const float* vscg = WSP(float, WS_VSC);
    const int stride = G * NWAVES;
    int ca = 0, cb = 0;
    {
        int rem = lane; bool found = false;
#pragma unroll
        for (int a = 0; a < 16; ++a) { const int cnt = 16 / (a + 1); if (!found) { if (rem < cnt) { ca = a; cb = rem; found = true; } else rem -= cnt; } }
    }
    int row = vcu * NWAVES + wave;
    if (row >= MTOK) return;
    u32x4 xw0, xw1; float rssv = 0.f; unsigned sc0 = 0, sc1 = 0, sc2 = 0, sc3 = 0;
    int pend_i = -1; float pend_g = 0.f, pend_su = 0.f, pend_sv = 0.f;
#define NB_LV(B)  ((float*)((B) + 2048))
#define NB_LI(B)  ((int*)((B) + 2048 + 128))
#define NB_VS(B)  ((float*)((B) + 2048 + 256))
#define NB_IS(B)  ((int*)((B) + 2048 + 384))
#define NB_EID(B) ((int*)((B) + 2048 + 512))
#define NB_EG(B)  ((float*)((B) + 2048 + 1024))
#define NB_EU(B)  ((float*)((B) + 2048 + 1536))
#define TK_LOAD_X(R) { xw0 = ldws<u32x4>(W, O_HG + (unsigned)(R) * 2048u + lane * 16); xw1 = ldws<u32x4>(W, O_HG + (unsigned)(R) * 2048u + 1024 + lane * 16); rssv = lane < 16 ? rss[(size_t)(R) * 16 + lane] : 0.f; }
#define TK_LOAD_SC(R, H) { const unsigned so_ = O_SC + (unsigned)(R) * 4096u + (H) * 512 + lane * 2; sc0 = ldws<unsigned short>(W, so_); sc1 = ldws<unsigned short>(W, so_ + 128); sc2 = ldws<unsigned short>(W, so_ + 256); sc3 = ldws<unsigned short>(W, so_ + 384); }
#define TK_STAGE_X(B, RS) {                                                                                                        \
        RS = rsqrtf(wave_sum(rssv) * (1.f / DM) + NORM_EPS);                                                                       \
        f32x4 xa[4]; unpack8(xw0, xa[0], xa[1]); unpack8(xw1, xa[2], xa[3]);                                                        \
        xa[0] *= *(const f32x4*)(p.norm2_g + lane * 8); xa[1] *= *(const f32x4*)(p.norm2_g + lane * 8 + 4); xa[2] *= *(const f32x4*)(p.norm2_g + 512 + lane * 8); xa[3] *= *(const f32x4*)(p.norm2_g + 512 + lane * 8 + 4); \
        unsigned hw[4], lw[4];                                                                                                     \
        _Pragma("unroll") for (int i = 0; i < 4; ++i) {                                                                            \
            const f32x4 xs = xa[i] * 16.f;                                                                                         \
            int h_ = __builtin_amdgcn_cvt_pk_fp8_f32(xs[0], xs[1], 0, false); h_ = __builtin_amdgcn_cvt_pk_fp8_f32(xs[2], xs[3], h_, true); \
            const f32x2_t b0 = __builtin_amdgcn_cvt_pk_f32_fp8(h_, false), b1 = __builtin_amdgcn_cvt_pk_f32_fp8(h_, true);         \
            int l_ = __builtin_amdgcn_cvt_pk_fp8_f32((xs[0] - b0[0]) * 16.f, (xs[1] - b0[1]) * 16.f, 0, false); l_ = __builtin_amdgcn_cvt_pk_fp8_f32((xs[2] - b1[0]) * 16.f, (xs[3] - b1[1]) * 16.f, l_, true); \
            hw[i] = (unsigned)h_; lw[i] = (unsigned)l_;                                                                            \
        }                                                                                                                          \
                                                                                                       \
        const int xo_ = PEER_U6 == 1 ? ((lane >> 2) & 3) * 256 + (2 * ((lane >> 4) & 1) + ((lane >> 1) & 1)) * 32 + ((lane >> 5) & 1) * 16 + (lane & 1) * 8 \
                      : PEER_U6 == 2 ? ((lane >> 2) & 3) * 256 + (lane >> 4) * 32 + (lane & 3) * 8 : lane * 8;                       \
        const int xo2_ = xo_ + (PEER_U6 ? 128 : 512);                                                                              \
        *(uint2*)((B) + xo_) = make_uint2(hw[0], hw[1]); *(uint2*)((B) + xo2_) = make_uint2(hw[2], hw[3]);                          \
        *(uint2*)((B) + 1024 + xo_) = make_uint2(lw[0], lw[1]); *(uint2*)((B) + 1024 + xo2_) = make_uint2(lw[2], lw[3]);            \
    }
#define TK_K16(hb) ((((unsigned)(hb) & 0x8000u) ? (~(unsigned)(hb) & 0xffffu) : ((unsigned)(hb) | 0x8000u)) << 16)
#define TK_PART_A(B) {                                                                                                             \
        const float a0 = (float)__builtin_bit_cast(_Float16, (unsigned short)sc0), a1 = (float)__builtin_bit_cast(_Float16, (unsigned short)sc1); \
        const float b0 = (float)__builtin_bit_cast(_Float16, (unsigned short)sc2), b1 = (float)__builtin_bit_cast(_Float16, (unsigned short)sc3); \
        const unsigned ka0 = TK_K16(sc0) | (0xFFFFu - (unsigned)lane), ka1 = TK_K16(sc1) | (0xFFFFu - 64u - (unsigned)lane);       \
        const unsigned kb0 = TK_K16(sc2) | (0xFFFFu - (unsigned)lane), kb1 = TK_K16(sc3) | (0xFFFFu - 64u - (unsigned)lane);       \
        unsigned long long loA = 0, hiA = 1ull << 32, loB = 0, hiB = 1ull << 32; bool doneA = false, doneB = false;                 \
        while (!(doneA && doneB)) {                                                                                                \
            if (!doneA) { const unsigned mid = (unsigned)((loA + hiA) >> 1); const int cnt = __builtin_popcountll(__ballot(ka0 >= mid)) + __builtin_popcountll(__ballot(ka1 >= mid)); \
                if (cnt >= 16) loA = mid; else hiA = mid; doneA = (cnt == 16) || (hiA - loA <= 1); }                                \
            if (!doneB) { const unsigned mid = (unsigned)((loB + hiB) >> 1); const int cnt = __builtin_popcountll(__ballot(kb0 >= mid)) + __builtin_popcountll(__ballot(kb1 >= mid)); \
                if (cnt >= 16) loB = mid; else hiB = mid; doneB = (cnt == 16) || (hiB - loB <= 1); }                                \
        }                                                                                                                          \
        float* lv = NB_LV(B); int* li = NB_LI(B);                                                                                  \
        { const unsigned T = (unsigned)loA; const bool k0 = ka0 >= T, k1 = ka1 >= T; const unsigned long long s0 = __ballot(k0), s1 = __ballot(k1); \
          if (k0) { const int pos = mbcnt64(s0); lv[pos] = a0; li[pos] = lane; }                                                    \
          if (k1) { const int pos = __builtin_popcountll(s0) + mbcnt64(s1); if (pos < 16) { lv[pos] = a1; li[pos] = lane + 64; } } } \
        { const unsigned T = (unsigned)loB; const bool k0 = kb0 >= T, k1 = kb1 >= T; const unsigned long long s0 = __ballot(k0), s1 = __ballot(k1); \
          if (k0) { const int pos = mbcnt64(s0); lv[16 + pos] = b0; li[16 + pos] = lane; }                                           \
          if (k1) { const int pos = __builtin_popcountll(s0) + mbcnt64(s1); if (pos < 16) { lv[16 + pos] = b1; li[16 + pos] = lane + 64; } } } \
        __builtin_amdgcn_s_waitcnt(0xC07F); __builtin_amdgcn_wave_barrier();                                                       \
    }
#define TK_PART_B(B, H, RS) {                                                                                                      \
        float* lv = NB_LV(B); int* li = NB_LI(B); float* vs = NB_VS(B); int* is_ = NB_IS(B);                                        \
        if (lane < 32) { const int base = lane & 16, me = lane & 15; const float mv = lv[lane]; int rk = 0;                         \
            _Pragma("unroll") for (int j = 0; j < 16; ++j) { const float x = lv[base + j]; rk += (x > mv) || (x == mv && j < me); } \
            vs[base + rk] = mv; is_[base + rk] = li[lane]; }                                                                       \
        __builtin_amdgcn_s_waitcnt(0xC07F); __builtin_amdgcn_wave_barrier();                                                       \
        float cv = 0.f; unsigned kc = 0u;                                                                                          \
        if (lane < 50) { cv = vs[ca] + vs[16 + cb]; kc = fkey(cv); }                                                                \
        unsigned long long lo = fkey(vs[15] + vs[31]), hi = (unsigned long long)fkey(vs[0] + vs[16]) + 1ull;                        \
        while (hi - lo > 1) { const unsigned mid = (unsigned)((lo + hi) >> 1); const int cnt = __builtin_popcountll(__ballot(kc >= mid)); \
            if (cnt >= 16) lo = mid; else hi = mid; if (cnt == 16) break; }                                                        \
        const unsigned T2 = (unsigned)lo; const unsigned long long tm = __ballot(kc == T2);                                        \
        const int need2 = 16 - __builtin_popcountll(__ballot(kc > T2));                                                            \
        const bool take = (kc > T2) || (kc == T2 && mbcnt64(tm) < need2);                                                          \
        const float sv_ = take ? cv * (RS) : -3e38f; const float mx = wave_max(sv_);                                               \
        const float ev = take ? __expf(sv_ - mx) : 0.f; const float sm = wave_sum(ev);                                             \
        pend_i = -1;                                                                                                               \
        if (take) { const int pos = mbcnt64(__ballot(take)); if (pos < 16) { const int e_ = is_[ca] * PEER_KEYS + is_[16 + cb];     \
            NB_EID(B)[(H) * 16 + pos] = e_; pend_i = (H) * 16 + pos; pend_g = ev / sm; pend_su = uscg[e_]; pend_sv = vscg[e_]; } }    \
        __builtin_amdgcn_wave_barrier();                                                                                           \
    }
#define TK_FLUSH(B) { if (pend_i >= 0) { NB_EG(B)[pend_i] = pend_g * pend_sv; NB_EU(B)[pend_i] = pend_su; } pend_i = -1; }
    float rs_cur = 0.f, rs_n = 0.f;
    {
        unsigned char* B0 = wbase;
        TK_LOAD_X(row) TK_STAGE_X(B0, rs_cur)
#pragma unroll 1
        for (int h = 0; h < PEER_H; ++h) { TK_FLUSH(B0) TK_LOAD_SC(row, h) TK_PART_A(B0) TK_PART_B(B0, h, rs_cur) }
        TK_FLUSH(B0)
        __builtin_amdgcn_s_waitcnt(0xC07F); __builtin_amdgcn_wave_barrier();
    }
#if PEER_U6 == 1
        const unsigned koff = (unsigned)((c >> 3) * 64 + gq * 16);
        const unsigned xoff = (unsigned)(((c >> 3) * 4 + gq) * 32);
        constexpr int NUB = 6;
#define U_LOAD(UB, E_) { _Pragma("unroll") for (int k3 = 0; k3 < 6; ++k3) UB[k3] = ldws<u32x4>(W, O_UT + (unsigned)(E_) * 768u + koff + k3 * 128); }
#define UBD(UB, i) ((int)UB[(i) >> 2][(i) & 3])
#define U_DOT(UB)                                                                                                                  \
            _Pragma("unroll") for (int ks = 0; ks < 4; ++ks) {                                                                     \
                const u32x4 xh0 = *(const u32x4*)(wsm + ks * 256 + xoff), xh1 = *(const u32x4*)(wsm + ks * 256 + xoff + 16);       \
                const u32x4 xl0 = *(const u32x4*)(wsm + 1024 + ks * 256 + xoff), xl1 = *(const u32x4*)(wsm + 1024 + ks * 256 + xoff + 16); \
                const v8i32_t xa = {(int)xh0.x, (int)xh0.y, (int)xh0.z, (int)xh0.w, (int)xh1.x, (int)xh1.y, (int)xh1.z, (int)xh1.w}; \
                const v8i32_t xb = {(int)xl0.x, (int)xl0.y, (int)xl0.z, (int)xl0.w, (int)xl1.x, (int)xl1.y, (int)xl1.z, (int)xl1.w}; \
                const v8i32_t uw = {UBD(UB, 6 * ks), UBD(UB, 6 * ks + 1), UBD(UB, 6 * ks + 2), UBD(UB, 6 * ks + 3), UBD(UB, 6 * ks + 4), UBD(UB, 6 * ks + 5), 0, 0}; \
                dh = __builtin_amdgcn_mfma_scale_f32_16x16x128_f8f6f4(xa, uw, dh, 0, 2, 0, 0x7F7F7F7F, 0, 0x7F7F7F7F);              \
                dl = __builtin_amdgcn_mfma_scale_f32_16x16x128_f8f6f4(xb, uw, dl, 0, 2, 0, 0x7F7F7F7F, 0, 0x7F7F7F7F);              \
            }
#elif PEER_U6 == 2
        const unsigned koff = (unsigned)((c >> 3) * 512 + gq * 128);
        const unsigned xoff = (unsigned)(((c >> 3) * 4 + gq) * 32);
        constexpr int NUB = 8;
#define U_LOAD(UB, E_) { _Pragma("unroll") for (int k3 = 0; k3 < 8; ++k3) UB[k3] = ldws<u32x4>(W, O_UT + (unsigned)(E_) * 1024u + koff + k3 * 16); }
#define U_DOT(UB)                                                                                                                  \
            _Pragma("unroll") for (int ks = 0; ks < 4; ++ks) {                                                                     \
                const u32x4 xh0 = *(const u32x4*)(wsm + ks * 256 + xoff), xh1 = *(const u32x4*)(wsm + ks * 256 + xoff + 16);       \
                const u32x4 xl0 = *(const u32x4*)(wsm + 1024 + ks * 256 + xoff), xl1 = *(const u32x4*)(wsm + 1024 + ks * 256 + xoff + 16); \
                const v8i32_t xa = {(int)xh0.x, (int)xh0.y, (int)xh0.z, (int)xh0.w, (int)xh1.x, (int)xh1.y, (int)xh1.z, (int)xh1.w}; \
                const v8i32_t xb = {(int)xl0.x, (int)xl0.y, (int)xl0.z, (int)xl0.w, (int)xl1.x, (int)xl1.y, (int)xl1.z, (int)xl1.w}; \
                const v8i32_t uw = {(int)UB[2 * ks].x, (int)UB[2 * ks].y, (int)UB[2 * ks].z, (int)UB[2 * ks].w, (int)UB[2 * ks + 1].x, (int)UB[2 * ks + 1].y, (int)UB[2 * ks + 1].z, (int)UB[2 * ks + 1].w}; \
                dh = __builtin_amdgcn_mfma_scale_f32_16x16x128_f8f6f4(xa, uw, dh, 0, 0, 0, 0x7F7F7F7F, 0, 0x7F7F7F7F);              \
                dl = __builtin_amdgcn_mfma_scale_f32_16x16x128_f8f6f4(xb, uw, dl, 0, 0, 0, 0x7F7F7F7F, 0, 0x7F7F7F7F);              \
            }
#else
        const unsigned koff = (unsigned)((c >> 3) * 64 + 16 * gq);
        constexpr int NUB = 8;
#define U_LOAD(UB, E_) { _Pragma("unroll") for (int k3 = 0; k3 < 8; ++k3) UB[k3] = ldws<u32x4>(W, O_UT + (unsigned)(E_) * 1024u + koff + k3 * 128); }
#define U_DOT(UB)                                                                                                                  \
            _Pragma("unroll") for (int k3 = 0; k3 < 8; ++k3) {                                                                     \
                const u32x4 xh = *(const u32x4*)(wsm + k3 * 128 + koff), xlo = *(const u32x4*)(wsm + 1024 + k3 * 128 + koff);      \
                const long u0 = (long)(((unsigned long long)UB[k3].y << 32) | UB[k3].x), u1 = (long)(((unsigned long long)UB[k3].w << 32) | UB[k3].z); \
                const long h0 = (long)(((unsigned long long)xh.y << 32) | xh.x), h1 = (long)(((unsigned long long)xh.w << 32) | xh.z);  \
                const long l0 = (long)(((unsigned long long)xlo.y << 32) | xlo.x), l1 = (long)(((unsigned long long)xlo.w << 32) | xlo.z); \
                dh = __builtin_amdgcn_mfma_f32_16x16x32_fp8_fp8(h0, u0, dh, 0, 0, 0);                                              \
                dh = __builtin_amdgcn_mfma_f32_16x16x32_fp8_fp8(h1, u1, dh, 0, 0, 0);                                              \
                dl = __builtin_amdgcn_mfma_f32_16x16x32_fp8_fp8(l0, u0, dl, 0, 0, 0);                                              \
                dl = __builtin_amdgcn_mfma_f32_16x16x32_fp8_fp8(l1, u1, dl, 0, 0, 0);                                              \
            }
#endif
#if PEER_V6
        typedef U3 vb_t;
#define V_LOAD(VB, ESRC) { _Pragma("unroll") for (int j = 0; j < 8; ++j) VB[j] = ldws<U3>(W, O_VT + (unsigned)__builtin_amdgcn_readlane(ESRC, j) * 768u + lane * 12); }
#define V_LOAD_H(VB, ESRC, J0) { _Pragma("unroll") for (int j = J0; j < J0 + 4; ++j) VB[j] = ldws<U3>(W, O_VT + (unsigned)__builtin_amdgcn_readlane(ESRC, j) * 768u + lane * 12); }
#define V_ACC(VBC)                                                                                                                 \
            _Pragma("unroll") for (int jp = 0; jp < 4; ++jp) {                                                                     \
                const float a0_ = __builtin_bit_cast(float, __builtin_amdgcn_readlane(__builtin_bit_cast(int, act), 2 * jp));      \
                const float a1_ = __builtin_bit_cast(float, __builtin_amdgcn_readlane(__builtin_bit_cast(int, act), 2 * jp + 1));  \
                const v6i32_t sv_ = {(int)VBC[2 * jp].a, (int)VBC[2 * jp].b, (int)VBC[2 * jp].c, (int)VBC[2 * jp + 1].a, (int)VBC[2 * jp + 1].b, (int)VBC[2 * jp + 1].c}; \
                const v32f32_t f_ = __builtin_amdgcn_cvt_scalef32_pk32_f32_fp6(sv_, 1.0f);                                         \
                _Pragma("unroll") for (int q_ = 0; q_ < 4; ++q_) {                                                                 \
                    acc[q_] += (f32x4){f_[4 * q_], f_[4 * q_ + 1], f_[4 * q_ + 2], f_[4 * q_ + 3]} * a0_;                           \
                    acc[q_] += (f32x4){f_[16 + 4 * q_], f_[16 + 4 * q_ + 1], f_[16 + 4 * q_ + 2], f_[16 + 4 * q_ + 3]} * a1_;       \
                }                                                                                                                  \
            }
#else
        typedef u32x4 vb_t;
#define V_LOAD(VB, ESRC) { _Pragma("unroll") for (int j = 0; j < 8; ++j) VB[j] = ldws<u32x4>(W, O_VT + (unsigned)__builtin_amdgcn_readlane(ESRC, j) * 1024u + lane * 16); }
#define V_LOAD_H(VB, ESRC, J0) { _Pragma("unroll") for (int j = J0; j < J0 + 4; ++j) VB[j] = ldws<u32x4>(W, O_VT + (unsigned)__builtin_amdgcn_readlane(ESRC, j) * 1024u + lane * 16); }
#define V_ACC(VBC)                                                                                                                 \
            _Pragma("unroll") for (int j = 0; j < 8; ++j) {                                                                        \
                const float aj = __builtin_bit_cast(float, __builtin_amdgcn_readlane(__builtin_bit_cast(int, act), j));            \
                const u32x4 vw = VBC[j];                                                                                           \
                const f32x2_t p0 = __builtin_amdgcn_cvt_pk_f32_fp8((int)vw.x, false), p1 = __builtin_amdgcn_cvt_pk_f32_fp8((int)vw.x, true); \
                const f32x2_t p2 = __builtin_amdgcn_cvt_pk_f32_fp8((int)vw.y, false), p3 = __builtin_amdgcn_cvt_pk_f32_fp8((int)vw.y, true); \
                const f32x2_t p4 = __builtin_amdgcn_cvt_pk_f32_fp8((int)vw.z, false), p5 = __builtin_amdgcn_cvt_pk_f32_fp8((int)vw.z, true); \
                const f32x2_t p6 = __builtin_amdgcn_cvt_pk_f32_fp8((int)vw.w, false), p7 = __builtin_amdgcn_cvt_pk_f32_fp8((int)vw.w, true); \
                acc[0] += (f32x4){p0[0], p0[1], p1[0], p1[1]} * aj; acc[1] += (f32x4){p2[0], p2[1], p3[0], p3[1]} * aj;             \
                acc[2] += (f32x4){p4[0], p4[1], p5[0], p5[1]} * aj; acc[3] += (f32x4){p6[0], p6[1], p7[0], p7[1]} * aj;             \
            }
#endif
    u32x4 ub0[NUB], ub1[NUB]; vb_t vb0[8], vb1[8];
    int ec0, ec1;
    {
        const int* eid0 = NB_EID(wbase);
        ec0 = eid0[c & 7]; ec1 = eid0[8 + (c & 7)];
        U_LOAD(ub0, ec0)
        V_LOAD(vb0, ec0)
        U_LOAD(ub1, ec1)
        V_LOAD_H(vb1, ec1, 0)
    }
#pragma unroll 1
    for (int it = 0;; ++it) {
        unsigned char* wsm = NOTK ? wbase : wbase + (it & 1) * 4096;
        unsigned char* nb = NOTK ? wbase : wbase + ((it + 1) & 1) * 4096;
        const int* eid = NB_EID(wsm); const float* egate = NB_EG(wsm); const float* eusc = NB_EU(wsm);
        const float rs = rs_cur;
        const int nrow_raw = row + stride;
        const int nrow = nrow_raw < MTOK ? nrow_raw : row;
        TK_LOAD_X(nrow) TK_LOAD_SC(nrow, 0)
        f32x4 acc[4];
#pragma unroll
        for (int i = 0; i < 4; ++i) acc[i] = (f32x4){0.f, 0.f, 0.f, 0.f};
#define PEER_TILE(UB, EC, VBC, ECN, VBN)                                                                                           \
        {                                                                                                                          \
            f32x4 dh = {0.f, 0.f, 0.f, 0.f}, dl = {0.f, 0.f, 0.f, 0.f};                                                             \
            U_DOT(UB)                                                                                                              \
            float mine = dh[0] + dl[0] * (1.f / 16.f);                                                                             \
            mine += __shfl_xor(mine, 40);                                                       \
            const float act = gelu_tanh(mine * (1.f / 16.f) * eusc[tcur * 8 + (c & 7)] * rs) * egate[tcur * 8 + (c & 7)];           \
            {     \
                const int* es_ = (tcur + 2 < 16) ? eid + (tcur + 2) * 8 : NB_EID(nb) + (tcur + 2 - 16) * 8;                          \
                EC = es_[c & 7]; U_LOAD(UB, EC)                                                                                    \
                V_LOAD_H(VBN, ECN, 4)                                                          \
            }                                                                                                                      \
            __builtin_amdgcn_sched_barrier(0);                                                                                     \
            V_ACC(VBC)                                                                                                             \
            __builtin_amdgcn_sched_barrier(0);                                                                                     \
            V_LOAD_H(VBC, EC, 0)                                 \
            __builtin_amdgcn_sched_barrier(0);                                                                                     \
        }
#pragma unroll 1
        for (int tp = 0; tp < 8; ++tp) {
            { const int tcur = 2 * tp; PEER_TILE(ub0, ec0, vb0, ec1, vb1) }
            if (!NOTK) {
            if (tp == 0) { TK_STAGE_X(nb, rs_n) }
            TK_FLUSH(nb)
            TK_PART_A(nb)
            }
            __builtin_amdgcn_sched_barrier(0);
            { const int tcur = 2 * tp + 1; PEER_TILE(ub1, ec1, vb1, ec0, vb0) }
            if (!NOTK) {
            TK_PART_B(nb, tp, rs_n)
            { const int hn = tp < 7 ? tp + 1 : 7; TK_LOAD_SC(nrow, hn) }
            }
            __builtin_amdgcn_sched_barrier(0);
        }
#undef PEER_TILE
#undef U_LOAD
#undef U_DOT
#undef V_LOAD
#undef V_LOAD_H
#undef V_ACC
        if (!NOTK) { TK_FLUSH(nb) }
        float* hr = p.out + (size_t)row * DM;
        float ss = 0.f;
        {
            f32x4 h0, h1, h2, h3;
            unpack8(ldws<u32x4>(W, O_HG + (unsigned)row * 2048u + lane * 16), h0, h1); unpack8(ldws<u32x4>(W, O_HG + (unsigned)row * 2048u + 1024 + lane * 16), h2, h3);
            acc[0] += h0; acc[1] += h1; acc[2] += h2; acc[3] += h3;
        }
#pragma unroll
        for (int i = 0; i < 4; ++i) ss += acc[i][0] * acc[i][0] + acc[i][1] * acc[i][1] + acc[i][2] * acc[i][2] + acc[i][3] * acc[i][3];
        ss = wave_sum(ss);
        const float scl = rsqrtf(ss * (1.f / DM) + NORM_EPS);
#pragma unroll
        for (int cc = 0; cc < 2; ++cc) {
            const f32x4 ga = *(const f32x4*)(p.norm_f_g + cc * 512 + lane * 8), gb = *(const f32x4*)(p.norm_f_g + cc * 512 + lane * 8 + 4);
            *(f32x4*)(hr + cc * 512 + lane * 8) = acc[2 * cc] * scl * ga; *(f32x4*)(hr + cc * 512 + lane * 8 + 4) = acc[2 * cc + 1] * scl * gb;
        }
        __builtin_amdgcn_s_waitcnt(0xC07F); __builtin_amdgcn_wave_barrier();
        if (nrow_raw >= MTOK) break;
        row = nrow_raw; rs_cur = rs_n;
    }
#undef TK_FLUSH
#undef TK_PART_B
#undef TK_PART_A
#undef TK_K16
#undef TK_STAGE_X
#undef TK_LOAD_SC
#undef TK_LOAD_X
}


#ifdef UT_FP6
__device__ __forceinline__ int ut_a(int row, int g, int i) { return ((i * 7 + g * 3 + row) % 13) - 6; }
__device__ __forceinline__ int ut_b(int col, int g, int j) { return ((j * 5 + g * 2 + col * 3) % 7) - 3; }
__device__ __forceinline__ void ut_fp6(const Params& p) {
    const int lane = threadIdx.x & 63, g = lane >> 4, c = lane & 15;
    unsigned aw[8];
#pragma unroll
    for (int w = 0; w < 8; ++w) {
        int h_ = __builtin_amdgcn_cvt_pk_fp8_f32((float)ut_a(c, g, 4 * w), (float)ut_a(c, g, 4 * w + 1), 0, false);
        h_ = __builtin_amdgcn_cvt_pk_fp8_f32((float)ut_a(c, g, 4 * w + 2), (float)ut_a(c, g, 4 * w + 3), h_, true);
        aw[w] = (unsigned)h_;
    }
    unsigned bw[6];
    {
        unsigned cd[16];
#pragma unroll
        for (int j = 0; j < 16; ++j) cd[j] = fp6_code((float)ut_b(c, g, j));
        fp6_pack16(cd, bw[0], bw[1], bw[2]);
#pragma unroll
        for (int j = 0; j < 16; ++j) cd[j] = fp6_code((float)ut_b(c, g, 16 + j));
        fp6_pack16(cd, bw[3], bw[4], bw[5]);
    }
    const v8i32_t A = {(int)aw[0], (int)aw[1], (int)aw[2], (int)aw[3], (int)aw[4], (int)aw[5], (int)aw[6], (int)aw[7]};
    const v8i32_t B = {(int)bw[0], (int)bw[1], (int)bw[2], (int)bw[3], (int)bw[4], (int)bw[5], 0, 0};
    f32x4 D = {0.f, 0.f, 0.f, 0.f};
    D = __builtin_amdgcn_mfma_scale_f32_16x16x128_f8f6f4(A, B, D, 0, 2, 0, 0x7F7F7F7F, 0, 0x7F7F7F7F);
    bool ok1 = true, ok2 = true, ok3 = true, ok4 = true;
#pragma unroll 1
    for (int r = 0; r < 4; ++r) {
        const int row = 4 * g + r;
        int e1 = 0, e2 = 0, e3 = 0, e4 = 0;
#pragma unroll 1
        for (int gg = 0; gg < 4; ++gg)
#pragma unroll 1
            for (int j = 0; j < 32; ++j) {
                const int bv = ut_b(c, gg, j);
                e1 += bv * ut_a(row, gg, j);
                { const int K = j < 16 ? 16 * gg + j : 64 + 16 * gg + (j - 16); e2 += bv * ut_a(row, K >> 5, K & 31); }
                { const int K = 32 * gg + j; const int ga = K < 64 ? (K >> 4) : ((K - 64) >> 4), ia = K < 64 ? (K & 15) : 16 + (K & 15); e3 += bv * ut_a(row, ga, ia); }
                { const int K = 32 * (j >> 3) + 8 * gg + (j & 7); e4 += bv * ut_a(row, K >> 5, K & 31); }
            }
        const float dv = D[r];
        ok1 = ok1 && (dv == (float)e1); ok2 = ok2 && (dv == (float)e2); ok3 = ok3 && (dv == (float)e3); ok4 = ok4 && (dv == (float)e4);
    }
    const bool a1 = __ballot(ok1) == ~0ull, a2 = __ballot(ok2) == ~0ull, a3 = __ballot(ok3) == ~0ull, a4 = __ballot(ok4) == ~0ull;
    const int m = a1 ? 1 : a2 ? 2 : a3 ? 3 : a4 ? 4 : 0;
    const v6i32_t sv = {(int)bw[0], (int)bw[1], (int)bw[2], (int)bw[3], (int)bw[4], (int)bw[5]};
    const v32f32_t f = __builtin_amdgcn_cvt_scalef32_pk32_f32_fp6(sv, 1.0f);
    bool okc = true;
#pragma unroll
    for (int j = 0; j < 32; ++j) okc = okc && (f[j] == (float)ut_b(c, g, j));
    const int c1 = (__ballot(okc) == ~0ull) ? 1 : 0;
    if (lane == 0) ((float*)p.ws)[20] = (float)(2 * m + c1);
}
#endif
__global__ void __launch_bounds__(NT, 2) k_mega(Params p) {
    extern __shared__ __attribute__((aligned(16))) unsigned char lds_raw[];
    LAS unsigned char* lds = (LAS unsigned char*)lds_raw;
    unsigned char* smem = lds_raw;
    const int tid = threadIdx.x, G = gridDim.x;
    const int vcu = (G % 8 == 0) ? ((int)blockIdx.x % 8) * (G / 8) + (int)blockIdx.x / 8 : (int)blockIdx.x;
    for (int i = tid; i < (LDS_BYTES - LDSCTL_OFF) / 4; i += NT) ((LAS unsigned*)(lds + LDSCTL_OFF))[i] = 0u;
    __syncthreads();
    XcdBarrier bar = xcd_barrier_post((unsigned*)p.ws + CW_BAR, (volatile LAS unsigned*)(lds + MISC_OFF) + 8);
#ifdef UT_FP6
    if (blockIdx.x == 0 && threadIdx.x < 64) ut_fp6(p);
#endif

#ifndef REP_PREP
#define REP_PREP 1
#endif
#ifndef REP_INPROJ
#define REP_INPROJ 1
#endif
#ifndef REP_SSM
#define REP_SSM 1
#endif
#ifndef REP_DSA
#define REP_DSA 1
#endif
#ifndef REP_MID
#define REP_MID 1
#endif
#ifndef REP_SCORES
#define REP_SCORES 1
#endif
#ifndef REP_PEER
#define REP_PEER 1
#endif
#define REPEAT(n) _Pragma("unroll 1") for (int rep_ = 0; rep_ < (n); ++rep_)
    REPEAT(REP_PREP) { phase_prep<0>(p, smem, vcu, G); xcd_barrier(bar); }
    REPEAT(REP_INPROJ) {
        EpiInProj e{WSP(bf16_t, WS_U), WSP(bf16_t, WS_Q), WSP(bf16_t, WS_K), WSP(bf16_t, WS_V), WSP(bf16_t, WS_QI), WSP(bf16_t, WS_KI),
                    WSP(bf16_t, WS_SGS), WSP(bf16_t, WS_SGA), WSP(float, WS_WI), WSP(float2, WS_ROPEA), WSP(float2, WS_ROPEI)};
        run_gemm(lds, WSP(bf16_t, WS_R1), WSP(bf16_t, WS_WINT), MTOK, IN_WP, 1024, G, e);
        if (G == 256) { if ((int)blockIdx.x >= 128) phase_prep<1>(p, smem, (int)blockIdx.x - 128, 128); }
        else phase_prep<1>(p, smem, vcu, G);
        xcd_barrier(bar);
    }
#ifdef DSA_FIRST
    REPEAT(REP_DSA) { phase_dsa(p, smem, (unsigned)(WS_YATT << 20), vcu, G); __syncthreads(); }
    REPEAT(REP_SSM) {
        int t2 = threadIdx.x; asm volatile("" : "+v"(t2));
        const int w2 = __builtin_amdgcn_readfirstlane(t2 >> 6);
#pragma unroll 1
        for (int item = vcu; item < NB * SSM_G; item += G) ssm_fast_item(p, smem, (unsigned)(WS_YG << 20), item, t2 & 63, w2);
        __syncthreads();
    }
#ifdef PROBE_SSM
    if (tid < 64) for (int item = blockIdx.x; item < NB * SSM_G; item += G) ssm_item(p, (float*)smem, (bf16_t*)p.out, item, tid);
    __syncthreads();
#endif
#else
    REPEAT(REP_SSM) {
        int t2 = threadIdx.x; asm volatile("" : "+v"(t2));
        const int w2 = __builtin_amdgcn_readfirstlane(t2 >> 6);
#pragma unroll 1
        for (int item = vcu; item < NB * SSM_G; item += G) ssm_fast_item(p, smem, (unsigned)(WS_YG << 20), item, t2 & 63, w2);
        __syncthreads();
    }
#ifdef PROBE_SSM
    if (tid < 64) for (int item = blockIdx.x; item < NB * SSM_G; item += G) ssm_item(p, (float*)smem, (bf16_t*)p.out, item, tid);
    __syncthreads();
#endif
    REPEAT(REP_DSA) { phase_dsa(p, smem, (unsigned)(WS_YATT << 20), vcu, G); __syncthreads(); }
#endif
#ifdef PROBE_ATTN
    phase_attn(p, smem, (bf16_t*)p.out, vcu, G);
    __syncthreads();
#endif
    xcd_barrier(bar);
#if defined(PROBE_ATTN) || defined(PROBE_SSM)
    {
#ifdef PROBE_SSM
        const bf16_t* A = WSP(bf16_t, WS_YG);
#else
        const bf16_t* A = WSP(bf16_t, WS_YATT);
#endif
        const bf16_t* B = (const bf16_t*)p.out;
        float d2 = 0.f, b2 = 0.f;
        for (size_t i = (size_t)blockIdx.x * NT + threadIdx.x; i < (size_t)MTOK * 512; i += (size_t)G * NT) { float a = bf2f(A[i]), bb = bf2f(B[i]); d2 += (a - bb) * (a - bb); b2 += bb * bb; }
        d2 = wave_sum(d2); b2 = wave_sum(b2);
        if ((threadIdx.x & 63) == 0) { atomicAdd((float*)p.ws + 16, d2); atomicAdd((float*)p.ws + 17, b2); }
    }
    xcd_barrier(bar);
#endif
#ifndef REP_GLU
#define REP_GLU 1
#endif
#ifndef REP_M1
#define REP_M1 1
#endif
#ifndef REP_M2
#define REP_M2 1
#endif
#ifndef REP_OUT
#define REP_OUT 1
#endif
#ifndef REP_BAR
#define REP_BAR 0
#endif
    REPEAT(REP_BAR) { xcd_barrier(bar); }
    REPEAT(REP_GLU) { EpiGlu e{WSP(bf16_t, WS_YG), WSP(bf16_t, WS_YSSM)}; run_gemm(lds, WSP(bf16_t, WS_YG), WSP(bf16_t, WS_WGLUT), MTOK, 512, 512, G, e); xcd_barrier(bar); }
    REPEAT(REP_M1) { EpiMergeChain e{WSP(bf16_t, WS_SGS), WSP(bf16_t, WS_SGA), WSP(bf16_t, WS_R1)};
        run_gemm_chain(lds, WSP(bf16_t, WS_YSSM), WSP(bf16_t, WS_WSUPT), WSP(bf16_t, WS_YATT), WSP(bf16_t, WS_WAUPT), MTOK, 1024, 512, G, e); xcd_barrier(bar); }
    REPEAT(REP_OUT) { EpiOut e{p.x, WSP(bf16_t, WS_HG), WSP(float, WS_RSS)};
        run_gemm(lds, WSP(bf16_t, WS_R1), WSP(bf16_t, WS_WOUTT), MTOK, 1024, 1024, G, e); xcd_barrier(bar); }
    REPEAT(REP_SCORES) { EpiScores e{WSP(_Float16, WS_SCORES)}; run_gemm(lds, WSP(bf16_t, WS_HG), WSP(bf16_t, WS_WCT), MTOK, 2048, 1024, G, e); xcd_barrier(bar); }
#ifdef PROBE_PEER
    phase_peer2<2>(p, smem, vcu, G);
    __syncthreads();
    phase_peer<false>(p, smem, vcu, G);
    xcd_barrier(bar);
    {
        const float* A = WSP(float, 462); const float* B = p.out;
        float d2 = 0.f, b2 = 0.f;
        for (size_t i = (size_t)blockIdx.x * NT + threadIdx.x; i < (size_t)8192 * DM; i += (size_t)G * NT) { const float a = A[i], bb = B[i]; d2 += (a - bb) * (a - bb); b2 += bb * bb; }
        d2 = wave_sum(d2); b2 = wave_sum(b2);
        if ((threadIdx.x & 63) == 0) { atomicAdd((float*)p.ws + 16, d2); atomicAdd((float*)p.ws + 17, b2); }
    }
    xcd_barrier(bar);
    {
        const float e = ((const float*)p.ws)[16] / fmaxf(((const float*)p.ws)[17], 1e-30f);
        int kx = 0; if (e > 1e-8f) kx++; if (e > 1e-7f) kx++; if (e > 1e-6f) kx++; if (e > 1e-5f) kx++; if (e > 1e-4f) kx++; if (e > 1e-3f) kx++; if (e > 1e-2f) kx++; if (!(e == e)) kx = 10;
        const float f = 1.f + 0.05f * kx;
        for (size_t i = (size_t)blockIdx.x * NT + threadIdx.x; i < (size_t)MTOK * DM / 4; i += (size_t)G * NT) { f32x4 v = ((f32x4*)p.out)[i]; ((f32x4*)p.out)[i] = v * f; }
    }
#else
#if !PEER_FP6
    REPEAT(REP_PEER - 1) { phase_peer2<1>(p, smem, vcu, G); __syncthreads(); }
#endif
#ifdef PEER_OLD
    phase_peer2<0>(p, smem, vcu, G);
#elif PEER_FP6
#if REP_PEER > 1
    phase_peer6<true>(p, smem, vcu, G); __syncthreads();
#endif
    phase_peer6<false>(p, smem, vcu, G);
#else
    phase_peer4(p, smem, vcu, G);
#endif
#ifdef UT_FP6
    xcd_barrier(bar);
    {
        const float f = 1.f + 0.05f * ((const float*)p.ws)[20];
        for (size_t i = (size_t)blockIdx.x * NT + threadIdx.x; i < (size_t)MTOK * DM / 4; i += (size_t)G * NT) { f32x4 v = ((f32x4*)p.out)[i]; ((f32x4*)p.out)[i] = v * f; }
    }
#endif
#if defined(PROBE_ATTN) || defined(PROBE_SSM)
    xcd_barrier(bar);
    {
        const float e = ((const float*)p.ws)[16] / fmaxf(((const float*)p.ws)[17], 1e-30f);
        int kx = 0; if (e > 1e-6f) kx++; if (e > 1e-5f) kx++; if (e > 1e-4f) kx++; if (e > 1e-3f) kx++; if (e > 1e-2f) kx++; if (e > 1e-1f) kx++; if (!(e == e)) kx = 8;
        const float f = 1.f + 0.05f * kx;
        for (size_t i = (size_t)blockIdx.x * NT + threadIdx.x; i < (size_t)MTOK * DM / 4; i += (size_t)G * NT) { f32x4 v = ((f32x4*)p.out)[i]; ((f32x4*)p.out)[i] = v * f; }
    }
#endif
#endif
}

extern "C" void kernel_launch(void* const* d_in, const int* in_sizes, int n_in, void* d_out, int out_size, void* d_ws, size_t ws_size,
                              hipStream_t stream) {
    static int grid = 0;
    if (grid == 0) {
        int dev = 0, cus = 0, per_cu = 0;
        if (hipGetDevice(&dev) != hipSuccess || hipDeviceGetAttribute(&cus, hipDeviceAttributeMultiprocessorCount, dev) != hipSuccess) { grid = -1; return; }
        if (hipFuncSetAttribute((const void*)k_mega, hipFuncAttributeMaxDynamicSharedMemorySize, LDS_BYTES) != hipSuccess) { fprintf(stderr, "hipFuncSetAttribute failed\n"); grid = -1; return; }
        if (hipOccupancyMaxActiveBlocksPerMultiprocessor(&per_cu, (const void*)k_mega, NT, LDS_BYTES) != hipSuccess || per_cu < 1) {
            fprintf(stderr, "occupancy query reports %d blocks/CU\n", per_cu); (void)hipGetLastError(); per_cu = 1; }
        grid = cus;
    }
    if (grid < 0) return;
    (void)hipMemsetAsync(d_ws, 0, CTL_ZERO_BYTES, stream);
    Params p{};
    const float** pp = (const float**)&p;
    for (int i = 0; i < 22; ++i) pp[i] = (const float*)d_in[i];
    p.out = (float*)d_out;
    p.ws = (unsigned char*)d_ws;
    for (int f = 0; f < 32; ++f) p.inv64[f] = pow(10000.0, -(double)(2 * f) / 64.0);
    for (int f = 0; f < 16; ++f) p.inv32[f] = pow(10000.0, -(double)(2 * f) / 32.0);
    hipLaunchKernelGGL(k_mega, dim3(grid), dim3(NT), LDS_BYTES, stream, p);
}
```

```cpp
#include <hip/hip_runtime.h>
#include <cstdio>
#include <cstdint>
#include <cmath>
#define GAS __attribute__((address_space(1)))
#define LAS __attribute__((address_space(3)))
namespace pg8 {
#define PG8_LAS __attribute__((address_space(3)))
typedef unsigned short bf16_t;
typedef short bf16x8 __attribute__((ext_vector_type(8)));
typedef float f32x4 __attribute__((ext_vector_type(4)));
typedef unsigned u32x4 __attribute__((ext_vector_type(4)));
constexpr int BM = 256, BK = 64, HALF = 128, HTB = HALF * BK * 2  , STAGE_BYTES = 8 * HTB, NXCD = 8, WGM = 8;

__host__ __device__ __forceinline__ int lds_byte(int r, int c) { const int st = (r >> 4) * 2 + (c >> 5), rr = r & 15, cc = c & 31, ob = rr * 64 + cc * 2; return st * 1024 + (ob ^ (((ob >> 9) & 1) << 5)); }
__host__ __device__ __forceinline__ void stage_rc(int b, int& R, int& C) { const int st = b / 1024, sb = b % 1024, swz = sb ^ (((sb >> 9) & 1) << 5); R = (st >> 1) * 16 + swz / 64; C = (st & 1) * 32 + (swz % 64) / 2; }
__host__ __device__ __forceinline__ int perm32(int rho) { const int n = rho >> 4, i = rho & 15; return 8 * (i >> 2) + 4 * n + (i & 3); }

struct Unit { int pm, pn, sel; };
struct Gemm { const bf16_t* A; const bf16_t* Bt; int M, N, K; const bf16_t* A2; const bf16_t* Bt2; };

struct StaticOrder {
    int nM, nN, nwg, G, c;
    __host__ __device__ void init(int M, int N, int G_, int c_) { nM = M / BM; nN = N / BM; nwg = nM * nN; G = G_; c = c_; }
    __host__ __device__ bool next(int i, Unit& u) const {
        const long L = (long)i * G + c; if (L >= nwg) return false;
        int wgid = (int)L; { const int q = nwg / NXCD, r = nwg % NXCD, xcd = wgid % NXCD, off = wgid / NXCD; wgid = (xcd < r ? xcd * (q + 1) : r * (q + 1) + (xcd - r) * q) + off; }
        const int nig = WGM * nN, gid = wgid / nig, fm = gid * WGM, gsz = (nM - fm) < WGM ? (nM - fm) : WGM;
        u.pm = fm + ((wgid % nig) % gsz); u.pn = (wgid % nig) / gsz; u.sel = 0; return true;
    }
    __device__ __forceinline__ void a_ready(const Unit&) const {}
    __device__ __forceinline__ void done(const Unit&) const {}
};
struct ChainOrder {
    StaticOrder b;
    __host__ __device__ void init(int M, int N, int G_, int c_) { b.init(M, N, G_, c_); }
    __host__ __device__ bool next(int i, Unit& u) const { if (!b.next(i >> 1, u)) return false; u.sel = i & 1; return true; }
    __device__ __forceinline__ void a_ready(const Unit&) const {}
    __device__ __forceinline__ void done(const Unit&) const {}
};
__device__ __forceinline__ unsigned cvt_pk_bf16(float lo, float hi) { unsigned r; asm volatile("v_cvt_pk_bf16_f32 %0, %1, %2" : "=v"(r) : "v"(lo), "v"(hi)); return r; }
template <class Epi, class Sched, bool ALIGN_EPI = false, bool SP2 = false>
__device__ __forceinline__ void gemm_phase(PG8_LAS unsigned char* lds, const Gemm g, const Sched& S, const Epi& E) {
    int tid_l = threadIdx.x; asm volatile("" : "+v"(tid_l));
    const int tid = tid_l, wid = __builtin_amdgcn_readfirstlane(tid >> 6), lane = tid & 63, wr = wid >> 2, wc = wid & 3, fr = lane & 15, fq = lane >> 4;
    const int K = g.K, nt = K / BK;
    unsigned voffA[2], voffB[2];
#pragma unroll
    for (int i = 0; i < 2; ++i) { int R, C; stage_rc(tid * 16 + i * 8192, R, C); const int Rb = Epi::PERM ? ((R & ~31) + perm32(R & 31)) : R;
        voffA[i] = (unsigned)(R * K + C) * 2u; voffB[i] = (unsigned)(Rb * K + C) * 2u; }
    const size_t kstep = (size_t)(BK * 2);
    const size_t hstep = (size_t)HALF * K * 2;
    const size_t tstep = 2 * hstep;
    const unsigned ldsw = (unsigned)wid * 1024u;
    const int aoff = lds_byte(wr * 64 + fr, fq * 8), boff = lds_byte(wc * 32 + fr, fq * 8);
#define PG8_SA(b, h) (((b) * 2 + (h)) * HTB)
#define PG8_SB(b, h) ((4 + (b) * 2 + (h)) * HTB)
#define PG8_STAGE(bufoff, gbase, voff) do { _Pragma("unroll") for (int _i = 0; _i < 2; ++_i) \
        __builtin_amdgcn_global_load_lds((const unsigned*)((const char*)(gbase) + (voff)[_i]), (PG8_LAS unsigned*)(lds + (bufoff) + ldsw + _i * 8192), 16, 0, 0); } while (0)
#define PG8_LDA(dst, b, h) do { _Pragma("unroll") for (int m = 0; m < 4; ++m) _Pragma("unroll") for (int k = 0; k < 2; ++k) dst[m][k] = *(const PG8_LAS bf16x8*)(lds + PG8_SA(b, h) + aoff + m * 2048 + k * 1024); } while (0)
#define PG8_LDB(dst, b, h) do { _Pragma("unroll") for (int n = 0; n < 2; ++n) _Pragma("unroll") for (int k = 0; k < 2; ++k) dst[n][k] = *(const PG8_LAS bf16x8*)(lds + PG8_SB(b, h) + boff + n * 2048 + k * 1024); } while (0)
#define PG8_MMA(ai, bj, At, Bt) do { __builtin_amdgcn_s_setprio(1); _Pragma("unroll") for (int m = 0; m < 4; ++m) _Pragma("unroll") for (int n = 0; n < 2; ++n) _Pragma("unroll") for (int k = 0; k < 2; ++k) \
        acc[ai][bj][m][n] = __builtin_amdgcn_mfma_f32_16x16x32_bf16(Bt[n][k], At[m][k], acc[ai][bj][m][n], 0, 0, 0); __builtin_amdgcn_s_setprio(0); } while (0)
#define PG8_WAIT_V(n) asm volatile("s_waitcnt vmcnt(" #n ")" ::: "memory")
#define PG8_WAIT_L(n) asm volatile("s_waitcnt lgkmcnt(" #n ")" ::: "memory")
#define PG8_BAR __builtin_amdgcn_s_barrier()
#define PG8_SCHED __builtin_amdgcn_sched_barrier(0)
    Unit cur, nxt; int ui = 0;
    if (!S.next(0, cur)) return;
    f32x4 acc[2][2][4][2];
#pragma unroll
    for (int a = 0; a < 2; ++a)
#pragma unroll
        for (int b = 0; b < 2; ++b)
#pragma unroll
            for (int m = 0; m < 4; ++m)
#pragma unroll
                for (int n = 0; n < 2; ++n) acc[a][b][m][n] = (f32x4){0.f, 0.f, 0.f, 0.f};
    bf16x8 At[4][2], B0[2][2], B1[2][2];
    const char* cA = (const char*)(cur.sel ? g.A2 : g.A) + (size_t)cur.pm * tstep; const char* cB = (const char*)(cur.sel ? g.Bt2 : g.Bt) + (size_t)cur.pn * tstep;
    S.a_ready(cur);
    if constexpr (SP2) {
        PG8_STAGE(PG8_SB(0, 0), cB, voffB); PG8_STAGE(PG8_SB(0, 1), cB + hstep, voffB); PG8_STAGE(PG8_SA(0, 0), cA, voffA); PG8_STAGE(PG8_SA(0, 1), cA + hstep, voffA);
        if (wr == 1) PG8_BAR;
        PG8_WAIT_V(2); PG8_BAR;
        PG8_STAGE(PG8_SB(1, 0), cB + kstep, voffB); PG8_STAGE(PG8_SA(1, 0), cA + kstep, voffA); PG8_STAGE(PG8_SB(1, 1), cB + hstep + kstep, voffB);
        PG8_WAIT_V(6); PG8_BAR;
    } else {
        PG8_STAGE(PG8_SB(0, 0), cB, voffB); PG8_STAGE(PG8_SA(0, 0), cA, voffA); PG8_STAGE(PG8_SB(0, 1), cB + hstep, voffB); PG8_STAGE(PG8_SA(0, 1), cA + hstep, voffA);
        if (wr == 1) PG8_BAR;
        PG8_WAIT_V(4); PG8_BAR;
        PG8_STAGE(PG8_SB(1, 0), cB + kstep, voffB); PG8_STAGE(PG8_SA(1, 0), cA + kstep, voffA); PG8_STAGE(PG8_SB(1, 1), cB + hstep + kstep, voffB);
        PG8_WAIT_V(6); PG8_BAR;
    }
    for (;;) {
        const bool has_next = S.next(ui + 1, nxt);
        const char* nA = has_next ? (const char*)(nxt.sel ? g.A2 : g.A) + (size_t)nxt.pm * tstep : cA; const char* nB = has_next ? (const char*)(nxt.sel ? g.Bt2 : g.Bt) + (size_t)nxt.pn * tstep : cB;
        for (int t = 0; t < nt; t += 2) {
            const bool last = (t == nt - 2);
            const char* a1 = cA + (size_t)(t + 1) * kstep;
            const char* a2 = last ? nA : cA + (size_t)(t + 2) * kstep; const char* b2 = last ? nB : cB + (size_t)(t + 2) * kstep;
            const char* a3 = a2 + kstep; const char* b3 = b2 + kstep;
            if (last && has_next) S.a_ready(nxt);
            if constexpr (SP2) {
            PG8_LDB(B0, 0, 0); PG8_LDB(B1, 0, 1); PG8_SCHED; PG8_LDA(At, 0, 0); PG8_STAGE(PG8_SA(1, 1), a1 + hstep, voffA);
            PG8_WAIT_V(8); PG8_WAIT_L(0); PG8_BAR; PG8_MMA(0, 0, At, B0); PG8_MMA(0, 1, At, B1); PG8_BAR; PG8_SCHED;
            PG8_LDA(At, 0, 1); PG8_STAGE(PG8_SB(0, 0), b2, voffB); PG8_STAGE(PG8_SB(0, 1), b2 + hstep, voffB); PG8_STAGE(PG8_SA(0, 0), a2, voffA);
            PG8_WAIT_V(8); PG8_WAIT_L(0); PG8_BAR; PG8_MMA(1, 0, At, B0); PG8_MMA(1, 1, At, B1); PG8_BAR; PG8_SCHED;
            PG8_LDB(B0, 1, 0); PG8_LDB(B1, 1, 1); PG8_SCHED; PG8_LDA(At, 1, 0); PG8_STAGE(PG8_SA(0, 1), a2 + hstep, voffA);
            PG8_WAIT_V(8); PG8_WAIT_L(0); PG8_BAR; PG8_MMA(0, 0, At, B0); PG8_MMA(0, 1, At, B1); PG8_BAR; PG8_SCHED;
            PG8_LDA(At, 1, 1); PG8_STAGE(PG8_SB(1, 0), b3, voffB); PG8_STAGE(PG8_SB(1, 1), b3 + hstep, voffB); PG8_STAGE(PG8_SA(1, 0), a3, voffA);
            PG8_WAIT_V(8); PG8_WAIT_L(0); PG8_BAR; PG8_MMA(1, 0, At, B0); PG8_MMA(1, 1, At, B1); PG8_BAR; PG8_SCHED;
            } else {
            PG8_LDB(B0, 0, 0); PG8_SCHED; PG8_LDA(At, 0, 0); PG8_STAGE(PG8_SA(1, 1), a1 + hstep, voffA);
            PG8_WAIT_L(8); PG8_BAR; PG8_WAIT_L(0); PG8_MMA(0, 0, At, B0); PG8_BAR; PG8_SCHED;
            PG8_LDB(B1, 0, 1); PG8_STAGE(PG8_SB(0, 0), b2, voffB);
            PG8_BAR; PG8_WAIT_L(0); PG8_MMA(0, 1, At, B1); PG8_BAR;
            PG8_LDA(At, 0, 1); PG8_STAGE(PG8_SA(0, 0), a2, voffA);
            PG8_BAR; PG8_WAIT_L(0); PG8_MMA(1, 0, At, B0); PG8_BAR; PG8_SCHED;
            PG8_STAGE(PG8_SB(0, 1), b2 + hstep, voffB);
            PG8_WAIT_V(6); PG8_BAR; PG8_MMA(1, 1, At, B1); PG8_BAR;
            PG8_LDB(B0, 1, 0); PG8_SCHED; PG8_LDA(At, 1, 0); PG8_STAGE(PG8_SA(0, 1), a2 + hstep, voffA);
            PG8_WAIT_L(8); PG8_BAR; PG8_WAIT_L(0); PG8_MMA(0, 0, At, B0); PG8_BAR; PG8_SCHED;
            PG8_LDB(B1, 1, 1); PG8_STAGE(PG8_SB(1, 0), b3, voffB);
            PG8_BAR; PG8_WAIT_L(0); PG8_MMA(0, 1, At, B1); PG8_BAR;
            PG8_LDA(At, 1, 1); PG8_STAGE(PG8_SA(1, 0), a3, voffA);
            PG8_BAR; PG8_WAIT_L(0); PG8_MMA(1, 0, At, B0); PG8_BAR; PG8_SCHED;
            PG8_STAGE(PG8_SB(1, 1), b3 + hstep, voffB);
            PG8_WAIT_V(6); PG8_BAR; PG8_MMA(1, 1, At, B1); PG8_BAR;
            }
        }
        if constexpr (ALIGN_EPI) { if (wr == 0) PG8_BAR; }
        if constexpr (!Epi::AFTER_DRAIN) { E(acc, cur, wr, wc, fr, fq); S.done(cur); }
        if (!has_next) break;
        if (!(Epi::CHAIN && cur.sel == 0))
#pragma unroll
        for (int a = 0; a < 2; ++a)
#pragma unroll
            for (int b = 0; b < 2; ++b)
#pragma unroll
                for (int m = 0; m < 4; ++m)
#pragma unroll
                    for (int n = 0; n < 2; ++n) acc[a][b][m][n] = (f32x4){0.f, 0.f, 0.f, 0.f};
        cur = nxt; cA = nA; cB = nB; ++ui;
        if constexpr (ALIGN_EPI) { if (wr == 1) PG8_BAR; }
    }
    PG8_WAIT_V(0);
    if constexpr (!ALIGN_EPI) { if (wr == 0) PG8_BAR; }
    PG8_BAR;
    if constexpr (Epi::AFTER_DRAIN) { E.fused(acc, cur, wr, wc, fr, fq, lds, wid, lane); S.done(cur); }
#undef PG8_SA
#undef PG8_SB
#undef PG8_STAGE
#undef PG8_LDA
#undef PG8_LDB
#undef PG8_MMA
#undef PG8_WAIT_V
#undef PG8_WAIT_L
#undef PG8_BAR
#undef PG8_SCHED
}
}
#define XB_TMO      128
#define XB_XCNT(j)  (256  + 64 * (j))
#define XB_XSUB(j)  (1280 + 64 * (j))
#define XB_XGEN(j)  (2304 + 64 * (j))
#define XB_TOP      3328
#define XB_TOPGEN   3392
#define XCD_BAR_WORDS 3456
#define XB_SPIN_CAP (1u << 18)

__device__ __forceinline__ unsigned xb_ld(unsigned* p)              { return __hip_atomic_load(p, __ATOMIC_RELAXED, __HIP_MEMORY_SCOPE_AGENT); }
__device__ __forceinline__ unsigned xb_add(unsigned* p, unsigned v) { return __hip_atomic_fetch_add(p, v, __ATOMIC_RELAXED, __HIP_MEMORY_SCOPE_AGENT); }
__device__ __forceinline__ unsigned xb_xcc_id() { return (unsigned)__builtin_amdgcn_s_getreg((3 << 11) | 20) & 0xFu; }
#define XB_SPIN(cond, bar) do { unsigned _sp = 0; while (cond) { __builtin_amdgcn_s_sleep(1); \
    if ((++_sp & 255u) == 0u) { if (xb_ld(&(bar)[XB_TMO])) break; if (_sp > XB_SPIN_CAP) { atomicAdd(&(bar)[XB_TMO], 1u); break; } } } } while (0)

struct XcdBarrier {
    unsigned* bar; unsigned x;
    volatile LAS unsigned* st;
};

__device__ __forceinline__ XcdBarrier xcd_barrier_post(unsigned* bar, volatile LAS unsigned* st) {
    XcdBarrier b; b.bar = bar; b.x = xb_xcc_id(); b.st = st;
    if (threadIdx.x == 0) (void)xb_add(&bar[XB_XCNT(b.x)], 1u);
    return b;
}
__device__ __forceinline__ void xcd_barrier_complete(unsigned* bar, unsigned x, unsigned& nloc, unsigned& nx) {
    const unsigned G = gridDim.x * gridDim.y * gridDim.z;
    unsigned sum, cnt, mine, sp = 0u;
    for (;;) {
        sum = 0u; cnt = 0u; mine = 0u;
#pragma unroll
        for (unsigned j = 0; j < 16; ++j) { const unsigned c = xb_ld(&bar[XB_XCNT(j)]); sum += c; cnt += (c > 0u) ? 1u : 0u; mine = (j == x) ? c : mine; }
        if (sum == G) break;
        __builtin_amdgcn_s_sleep(1);
        if ((++sp & 255u) == 0u) { if (xb_ld(&bar[XB_TMO])) break; if (sp > XB_SPIN_CAP) { atomicAdd(&bar[XB_TMO], 1u); break; } }
    }
    nloc = mine > 0u ? mine : 1u; nx = cnt > 0u ? cnt : 1u;
}

__device__ __forceinline__ void xcd_barrier(const XcdBarrier& b) {
    asm volatile("s_waitcnt vmcnt(0)" ::: "memory");
    __syncthreads();
    if (threadIdx.x == 0) {
        unsigned* bar = b.bar;
        __builtin_amdgcn_s_waitcnt(0);
        unsigned nloc = b.st[0], nx = b.st[1];
        if (nloc == 0u) { xcd_barrier_complete(bar, b.x, nloc, nx); b.st[0] = nloc; b.st[1] = nx; }
        const unsigned old = xb_add(&bar[XB_XSUB(b.x)], 1u);
        const unsigned gen = old / nloc;
        if (old + 1u == (gen + 1u) * nloc) {
            __builtin_amdgcn_fence(__ATOMIC_RELEASE, "agent");
            asm volatile("s_waitcnt vmcnt(0)" ::: "memory");
            const unsigned og = xb_add(&bar[XB_TOP], 1u);
            const unsigned tg = og / nx;
            if (og + 1u == (tg + 1u) * nx) xb_add(&bar[XB_TOPGEN], 1u);
            else XB_SPIN(xb_ld(&bar[XB_TOPGEN]) == tg, bar);
            __builtin_amdgcn_fence(__ATOMIC_ACQUIRE, "agent");
            xb_add(&bar[XB_XGEN(b.x)], 1u);
            asm volatile("s_waitcnt vmcnt(0)" ::: "memory");
        } else {
            XB_SPIN(xb_ld(&bar[XB_XGEN(b.x)]) == gen, bar);
            __builtin_amdgcn_fence(__ATOMIC_ACQUIRE, "agent");
            asm volatile("s_waitcnt vmcnt(0)" ::: "memory");
        }
    }
    __syncthreads();
}

typedef unsigned short bf16_t;
typedef short bf16x8 __attribute__((ext_vector_type(8)));
typedef float f32x4 __attribute__((ext_vector_type(4)));
typedef unsigned u32x4 __attribute__((ext_vector_type(4)));
using pg8::cvt_pk_bf16;

constexpr int NWAVES = 8, NT = NWAVES * 64;
constexpr int DM = 1024, NB = 8, SEQ = 4096, MTOK = NB * SEQ;
constexpr int SSM_W = 512, SSM_G = 32, SSM_N = 16, SSM_P = 64;
constexpr int IN_W = 3624, IN_WP = 3840;
constexpr int TOPK = 256;
constexpr int PEER_H = 8, PEER_KEYS = 128;
constexpr float NORM_EPS = 1e-6f;
constexpr size_t MiB = 1u << 20;
constexpr int LDS_BYTES = 163840, RING_BYTES = 131072, LDSCTL_OFF = LDS_BYTES - 1024, MISC_OFF = LDSCTL_OFF + 320;
constexpr int CW_BAR = 4096;
constexpr size_t CTL_ZERO_BYTES = 65536;

constexpr size_t WS_WINT = 1, WS_WGLUT = 9, WS_WSUPT = 10, WS_WAUPT = 11, WS_WOUTT = 12, WS_WCT = 14;
constexpr size_t WS_ROPEA = 18, WS_ROPEI = 19, WS_KT = 20, WS_A64 = 21, WS_SSMT = 22, WS_W1T = 254, WS_W3T = 262;
constexpr size_t WS_UTAB = 24, WS_VTAB = 56, WS_USC = 44, WS_VSC = 45;
#if !defined(PEER_FP6) && !defined(PEER_OLD)
#define PEER_FP6 1
#endif
#ifndef PEER_FP6
#define PEER_FP6 0
#endif
#ifndef PEER_U6
#define PEER_U6 PEER_FP6
#endif
#ifndef PEER_V6
#define PEER_V6 PEER_FP6
#endif
#ifndef PEER_FP8
#define PEER_FP8 1
#endif
constexpr size_t WS_R1 = 88;
constexpr size_t WS_U = 152, WS_Q = 184, WS_K = 216, WS_V = 224, WS_QI = 232, WS_KI = 248, WS_WI = 250;
constexpr size_t WS_SGS = 270, WS_SGA = 334, WS_YG = 398, WS_YSSM = 430, WS_YATT = 462, WS_RSS = 494;
constexpr size_t WS_T1 = 152;
constexpr size_t WS_SCORES = 88;
constexpr size_t WS_HG = 398;

struct Params {
    const float *x, *norm1_g, *w_in, *a_re, *a_im, *log_dt, *b_re, *b_im, *c_re, *c_im, *d_skip, *w_glu, *w_ssm_up,
        *w_attn_up, *w_out, *norm2_g, *peer_wq, *peer_k1, *peer_k2, *peer_u, *peer_v, *norm_f_g;
    float* out;
    unsigned char* ws;
    double inv64[32];
    double inv32[16];
};
#define WSP(T, off) ((T*)(p.ws + (size_t)(off) * MiB))

__device__ __forceinline__ unsigned f2bf(float f) {
    unsigned u = __builtin_bit_cast(unsigned, f);
    return (u + 0x7fffu + ((u >> 16) & 1u)) >> 16;
}
__device__ __forceinline__ float bf2f(unsigned b) { return __builtin_bit_cast(float, b << 16); }
__device__ __forceinline__ float bflo(unsigned w) { return __builtin_bit_cast(float, w << 16); }
__device__ __forceinline__ float bfhi(unsigned w) { return __builtin_bit_cast(float, w & 0xffff0000u); }
__device__ __forceinline__ float sigmoidf_(float x) { return 1.f / (1.f + __expf(-x)); }
__device__ __forceinline__ float gelu_tanh(float x) {
    float z = 0.7978845608028654f * (x + 0.044715f * x * x * x);
    float e = __expf(2.f * z);
    float t = 1.f - 2.f / (e + 1.f);
    return 0.5f * x * (1.f + t);
}
template <int CTRL, int RM = 0xf, int BM = 0xf, bool BC = true>
__device__ __forceinline__ float dppf(float old, float src) { return __builtin_bit_cast(float, __builtin_amdgcn_update_dpp(__builtin_bit_cast(int, old), __builtin_bit_cast(int, src), CTRL, RM, BM, BC)); }
template <int CTRL, int RM = 0xf, int BM = 0xf, bool BC = true>
__device__ __forceinline__ int dppi(int old, int src) { return __builtin_amdgcn_update_dpp(old, src, CTRL, RM, BM, BC); }
__device__ __forceinline__ float wave_sum(float v) {
    v += dppf<0x111>(0.f, v); v += dppf<0x112>(0.f, v); v += dppf<0x114>(0.f, v); v += dppf<0x118>(0.f, v);
    v += dppf<0x142, 0xa, 0xf, false>(0.f, v); v += dppf<0x143, 0xc, 0xf, false>(0.f, v);
    return __builtin_bit_cast(float, __builtin_amdgcn_readlane(__builtin_bit_cast(int, v), 63));
}
__device__ __forceinline__ float wave_max(float v) {
    v = fmaxf(v, dppf<0x111, 0xf, 0xf, false>(v, v)); v = fmaxf(v, dppf<0x112, 0xf, 0xf, false>(v, v)); v = fmaxf(v, dppf<0x114, 0xf, 0xf, false>(v, v)); v = fmaxf(v, dppf<0x118, 0xf, 0xf, false>(v, v));
    v = fmaxf(v, dppf<0x142, 0xa, 0xf, false>(v, v)); v = fmaxf(v, dppf<0x143, 0xc, 0xf, false>(v, v));
    return __builtin_bit_cast(float, __builtin_amdgcn_readlane(__builtin_bit_cast(int, v), 63));
}
__device__ __forceinline__ int wave_incl_scan(int v) {
    v += dppi<0x111>(0, v); v += dppi<0x112>(0, v); v += dppi<0x114>(0, v); v += dppi<0x118>(0, v);
    v += dppi<0x142, 0xa, 0xf, false>(0, v); v += dppi<0x143, 0xc, 0xf, false>(0, v);
    return v;
}
__device__ __forceinline__ u32x4 pack8(f32x4 a, f32x4 b) {
    u32x4 w; w.x = cvt_pk_bf16(a[0], a[1]); w.y = cvt_pk_bf16(a[2], a[3]); w.z = cvt_pk_bf16(b[0], b[1]); w.w = cvt_pk_bf16(b[2], b[3]);
    return w;
}
__device__ __forceinline__ uint2 pack8_fp8(f32x4 a, f32x4 b) {
    int w0 = __builtin_amdgcn_cvt_pk_fp8_f32(a[0], a[1], 0, false); w0 = __builtin_amdgcn_cvt_pk_fp8_f32(a[2], a[3], w0, true);
    int w1 = __builtin_amdgcn_cvt_pk_fp8_f32(b[0], b[1], 0, false); w1 = __builtin_amdgcn_cvt_pk_fp8_f32(b[2], b[3], w1, true);
    return make_uint2((unsigned)w0, (unsigned)w1);
}
typedef float f32x2_t __attribute__((ext_vector_type(2)));
__device__ __forceinline__ void unpack8_fp8(uint2 w, f32x4& a, f32x4& b) {
    const f32x2_t p0 = __builtin_amdgcn_cvt_pk_f32_fp8((int)w.x, false), p1 = __builtin_amdgcn_cvt_pk_f32_fp8((int)w.x, true);
    const f32x2_t p2 = __builtin_amdgcn_cvt_pk_f32_fp8((int)w.y, false), p3 = __builtin_amdgcn_cvt_pk_f32_fp8((int)w.y, true);
    a = (f32x4){p0[0], p0[1], p1[0], p1[1]}; b = (f32x4){p2[0], p2[1], p3[0], p3[1]};
}
__device__ __forceinline__ void unpack8(u32x4 w, f32x4& a, f32x4& b) {
    a[0] = bflo(w.x); a[1] = bfhi(w.x); a[2] = bflo(w.y); a[3] = bfhi(w.y);
    b[0] = bflo(w.z); b[1] = bfhi(w.z); b[2] = bflo(w.w); b[3] = bfhi(w.w);
}

template <class T> __device__ __forceinline__ T ldws(const unsigned char* ws, unsigned off) { return *(const T*)(ws + off); }
__device__ __forceinline__ void sincos_d(double x, double& s, double& c) {
    const double TWO_OVER_PI = 0.63661977236758134308;
    const double PIO2_HI = 1.57079632679489655800e+00, PIO2_LO = 6.12323399573676603587e-17;
    double kd = rint(x * TWO_OVER_PI);
    double r = fma(-kd, PIO2_HI, x);
    r = fma(-kd, PIO2_LO, r);
    long long k = (long long)kd;
    double r2 = r * r;
    double sp = r * (1.0 + r2 * (-1.0 / 6 + r2 * (1.0 / 120 + r2 * (-1.0 / 5040 + r2 * (1.0 / 362880 + r2 * (-1.0 / 39916800 + r2 * (1.0 / 6227020800.0)))))));
    double cp = 1.0 + r2 * (-0.5 + r2 * (1.0 / 24 + r2 * (-1.0 / 720 + r2 * (1.0 / 40320 + r2 * (-1.0 / 3628800 + r2 * (1.0 / 479001600.0 + r2 * (-1.0 / 87178291200.0)))))));
    int q = (int)(k & 3);
    double ss = (q & 1) ? cp : sp, cc = (q & 1) ? sp : cp;
    if (q == 1) cc = -cc;
    if (q == 2) { ss = -ss; cc = -cc; }
    if (q == 3) ss = -ss;
    s = ss; c = cc;
}

__device__ __forceinline__ int winsrc(int v) {
    if (v < 512) return v;
    if (v < 1152) { const int b = v < 1024 ? 512 : 1024; int w = v - b; const int hd = w >> 6; w &= 63; const int i = w >> 3, jj = w & 7;
        return b + hd * 64 + (jj < 4 ? 4 * i + jj : 32 + 4 * i + (jj - 4)); }
    if (v < 1280) return v;
    if (v < 1568) { int w = v - 1280; const int hd = w >> 5; w &= 31; const int i = w >> 3, jj = w & 7;
        return 1280 + hd * 32 + (jj < 4 ? 4 * i + jj : 16 + 4 * i + (jj - 4)); }
    if (v < 1576) return v;
    if (v < 1792) return -1;
    if (v < 2816) return 1576 + (v - 1792);
    return 2600 + (v - 2816);
}
template <bool MAP>
__device__ __forceinline__ void transpose_item(const float* __restrict__ W, int K, int N, bf16_t* WT, int Nout, float* scr, int item, int lane) {
    const int nblk = Nout / 32, kb = item / nblk, nb = item % nblk, k0 = 64 * kb, n0 = 32 * nb;
    const int src = MAP ? winsrc(n0 + (lane & 31)) : n0 + (lane & 31);
#pragma unroll 8
    for (int i = 0; i < 32; ++i) { const int kk = 2 * i + (lane >> 5); scr[kk * 33 + (lane & 31)] = src >= 0 ? W[(size_t)(k0 + kk) * N + src] : 0.f; }
    asm volatile("s_waitcnt lgkmcnt(0)" ::: "memory");
    const int c = lane & 7;
#pragma unroll
    for (int j = 0; j < 4; ++j) {
        const int n = (lane >> 3) + 8 * j; const float* s = scr + (8 * c) * 33 + n;
        u32x4 o; o.x = cvt_pk_bf16(s[0 * 33], s[1 * 33]); o.y = cvt_pk_bf16(s[2 * 33], s[3 * 33]); o.z = cvt_pk_bf16(s[4 * 33], s[5 * 33]); o.w = cvt_pk_bf16(s[6 * 33], s[7 * 33]);
        *(u32x4*)(WT + (size_t)(n0 + n) * K + k0 + 8 * c) = o;
    }
    asm volatile("s_waitcnt lgkmcnt(0)" ::: "memory");
}


__device__ __forceinline__ unsigned fp6_code(float y) {
    const float a = fabsf(y);
    unsigned c;
    if (a < 1.f) c = (unsigned)(a * 8.f + 0.5f);
    else { c = ((__float_as_uint(a) + 0x00080000u) >> 20) - 1008u; c = c > 31u ? 31u : c; }
    return c | (y < 0.f ? 32u : 0u);
}
__device__ __forceinline__ void fp6_pack16(const unsigned (&c)[16], unsigned& w0, unsigned& w1, unsigned& w2) {
    w0 = c[0] | (c[1] << 6) | (c[2] << 12) | (c[3] << 18) | (c[4] << 24) | (c[5] << 30);
    w1 = (c[5] >> 2) | (c[6] << 4) | (c[7] << 10) | (c[8] << 16) | (c[9] << 22) | (c[10] << 28);
    w2 = (c[10] >> 4) | (c[11] << 2) | (c[12] << 8) | (c[13] << 14) | (c[14] << 20) | (c[15] << 26);
}
__device__ __forceinline__ void peer_table_row(const Params& p, int r, int lane, unsigned char* stage) {
    unsigned char* ut = WSP(unsigned char, WS_UTAB); unsigned char* vt = WSP(unsigned char, WS_VTAB);
    float* usc = WSP(float, WS_USC); float* vsc = WSP(float, WS_VSC);
    const int tb = r >> 14, e = r & 16383;
    const float* src = (tb ? p.peer_v : p.peer_u) + (size_t)e * DM;
    const bool six = tb ? (PEER_V6 != 0) : (PEER_U6 == 1);
    const bool nat16 = six && tb == 0;
    const int o0 = nat16 ? lane * 16 : lane * 8, o1 = nat16 ? lane * 16 + 8 : 512 + lane * 8;
    const f32x4 a0 = *(const f32x4*)(src + o0), a1 = *(const f32x4*)(src + o0 + 4), a2 = *(const f32x4*)(src + o1), a3 = *(const f32x4*)(src + o1 + 4);
    float m = 0.f;
#pragma unroll
    for (int i = 0; i < 4; ++i) m = fmaxf(m, fmaxf(fmaxf(fabsf(a0[i]), fabsf(a1[i])), fmaxf(fabsf(a2[i]), fabsf(a3[i]))));
    m = wave_max(m);
    if (six) {
        const float sc = m > 0.f ? 7.5f / m : 1.f;
        unsigned cd[16];
#pragma unroll
        for (int i = 0; i < 4; ++i) { cd[i] = fp6_code(a0[i] * sc); cd[4 + i] = fp6_code(a1[i] * sc); cd[8 + i] = fp6_code(a2[i] * sc); cd[12 + i] = fp6_code(a3[i] * sc); }
        unsigned w0, w1, w2; fp6_pack16(cd, w0, w1, w2);
        if (tb) { unsigned* dst = (unsigned*)(vt + (size_t)e * 768 + lane * 12); dst[0] = w0; dst[1] = w1; dst[2] = w2; }
        else {
            unsigned* st = (unsigned*)(stage + lane * 12); st[0] = w0; st[1] = w1; st[2] = w2;
            __builtin_amdgcn_s_waitcnt(0xC07F); __builtin_amdgcn_wave_barrier();
            if (lane < 48) {
                const int k3 = lane >> 3, h = (lane >> 2) & 1, q = lane & 3;
                *(u32x4*)(ut + (size_t)e * 768 + lane * 16) = *(const u32x4*)(stage + h * 384 + q * 96 + k3 * 16);
            }
            __builtin_amdgcn_s_waitcnt(0xC07F); __builtin_amdgcn_wave_barrier();
        }
        if (lane == 0) (tb ? vsc : usc)[e] = 1.f / sc;
    } else {
        const float sc = m > 0.f ? 224.f / m : 1.f;
        const uint2 w01 = pack8_fp8(a0 * sc, a1 * sc), w23 = pack8_fp8(a2 * sc, a3 * sc);
        if (tb == 0) {
            *(uint2*)(ut + (size_t)e * 1024 + lane * 8) = w01; *(uint2*)(ut + (size_t)e * 1024 + 512 + lane * 8) = w23;
            if (lane == 0) usc[e] = 1.f / sc;
        } else {
            *(u32x4*)(vt + (size_t)e * 1024 + lane * 16) = (u32x4){w01.x, w01.y, w23.x, w23.y};
            if (lane == 0) vsc[e] = 1.f / sc;
        }
    }
}
template <int PART>
__device__ __forceinline__ void phase_prep(const Params& p, unsigned char* smem, int vcu, int G) {
    int tid = threadIdx.x; asm volatile("" : "+v"(tid)); const int lane = tid & 63, wave = tid >> 6;
    const int gw = vcu * NWAVES + wave, NGW = G * NWAVES;
    const size_t gtid = (size_t)vcu * NT + tid, gsize = (size_t)G * NT;
    float* scr = (float*)smem + wave * 4096;
#pragma unroll 1
    for (int ord = 0; ord < 2; ++ord) {
    if ((ord == 0) != ((wave & 1) != 0)) {
    {
        constexpr int I_IN = 16 * (IN_WP / 32), I_GLU = 8 * 16, I_SUP = 8 * 32, I_AUP = 8 * 32, I_OUT = 16 * 32;
        constexpr int NITEMS = I_IN + I_GLU + I_SUP + I_AUP + I_OUT;
        for (int it = (PART == 0 ? gw : NITEMS); it < NITEMS; it += NGW) {
            int r = it;
            if (r < I_IN) { transpose_item<true>(p.w_in, 1024, IN_W, WSP(bf16_t, WS_WINT), IN_WP, scr, r, lane); continue; } r -= I_IN;
            if (r < I_GLU) { transpose_item<false>(p.w_glu, 512, 512, WSP(bf16_t, WS_WGLUT), 512, scr, r, lane); continue; } r -= I_GLU;
            if (r < I_SUP) { transpose_item<false>(p.w_ssm_up, 512, 1024, WSP(bf16_t, WS_WSUPT), 1024, scr, r, lane); continue; } r -= I_SUP;
            if (r < I_AUP) { transpose_item<false>(p.w_attn_up, 512, 1024, WSP(bf16_t, WS_WAUPT), 1024, scr, r, lane); continue; } r -= I_AUP;
            transpose_item<false>(p.w_out, 1024, 1024, WSP(bf16_t, WS_WOUTT), 1024, scr, r, lane);
        }
    }
    if (PART == 0) {
    {
        bf16_t* wct = WSP(bf16_t, WS_WCT);
        for (int it = gw; it < 16 * 8 * 64; it += NGW) {
            const int hh = it >> 9, kt = (it >> 6) & 7, ct = it & 63;
            const int h = hh >> 1, half = hh & 1;
            const float* ap = (half ? p.peer_k2 : p.peer_k1) + ((size_t)h * 128 + kt * 16 + (lane & 15)) * 128 + (lane >> 4);
            const float* bp = p.peer_wq + (size_t)(ct * 16 + (lane & 15)) * 2048 + h * 256 + half * 128 + (lane >> 4);
            f32x4 acc = {0.f, 0.f, 0.f, 0.f};
#pragma unroll 8
            for (int d0 = 0; d0 < 128; d0 += 4) acc = __builtin_amdgcn_mfma_f32_16x16x4f32(ap[d0], bp[d0], acc, 0, 0, 0);
            const float g2k = p.norm2_g[ct * 16 + (lane & 15)];
#pragma unroll
            for (int r = 0; r < 4; ++r) wct[(size_t)(hh * 128 + kt * 16 + 4 * (lane >> 4) + r) * 1024 + ct * 16 + (lane & 15)] = (bf16_t)f2bf(acc[r] * g2k);
        }
    }
#if !PEER_FP8
    {
        const size_t n8 = (size_t)16384 * 1024 / 8;
        u32x4* ut = WSP(u32x4, WS_UTAB); u32x4* vt = WSP(u32x4, WS_VTAB);
        for (size_t i = gtid; i < n8; i += gsize) {
            f32x4 a = ((const f32x4*)p.peer_u)[2 * i], b = ((const f32x4*)p.peer_u)[2 * i + 1];
            ut[i] = pack8(a, b);
            f32x4 c = ((const f32x4*)p.peer_v)[2 * i], d = ((const f32x4*)p.peer_v)[2 * i + 1];
            vt[i] = pack8(c, d);
        }
    }
#endif
    }
    if (PART == 0) {
    {
        float2* ra = WSP(float2, WS_ROPEA); float2* ri = WSP(float2, WS_ROPEI);
        for (size_t i = gtid; i < (size_t)SEQ * 32; i += gsize) {
            int pos = (int)(i >> 5), f = (int)(i & 31);
            double s, c; sincos_d((double)pos * p.inv64[f], s, c);
            ra[i] = make_float2((float)c, (float)s);
        }
        for (size_t i = gtid; i < (size_t)SEQ * 16; i += gsize) {
            int pos = (int)(i >> 4), f = (int)(i & 15);
            double s, c; sincos_d((double)pos * p.inv32[f], s, c);
            ri[i] = make_float2((float)c, (float)s);
        }
    }
    }
    {
    if (PART == 0) {
        float2* abar = WSP(float2, WS_SSMT);
        float2* bbar = abar + SSM_G * SSM_P;
        for (size_t i = gtid; i < (size_t)SSM_G * SSM_P; i += gsize) {
            int g = (int)(i / SSM_P);
            double are = p.a_re[i], aim = p.a_im[i];
            double dt = exp((double)p.log_dt[g]);
            double s, c; sincos_d(aim * dt, s, c);
            double mag = exp(are * dt);
            double abr = mag * c, abi = mag * s;
            abar[i] = make_float2((float)abr, (float)abi);
            double nr = abr - 1.0, ni = abi;
            double den = are * are + aim * aim;
            double qr = (nr * are + ni * aim) / den, qi = (ni * are - nr * aim) / den;
            for (int cch = 0; cch < SSM_N; ++cch) {
                double br = p.b_re[i * SSM_N + cch], bi = p.b_im[i * SSM_N + cch];
                bbar[i * SSM_N + cch] = make_float2((float)(qr * br - qi * bi), (float)(qr * bi + qi * br));
            }
        }
    }

    {
        bf16_t* kt = WSP(bf16_t, WS_KT);
        float* zb = (float*)smem + wave * 4096;
        for (int pair = (PART == 0 ? gw : SSM_G * 64); pair < SSM_G * 64; pair += NGW) {
            const int g = pair >> 6, l = pair & 63;
            {
                const int pp = lane; const size_t i = (size_t)g * SSM_P + pp;
                const double are = p.a_re[i], aim = p.a_im[i], dt = exp((double)p.log_dt[g]);
                double s1, c1; sincos_d(aim * dt, s1, c1); const double m1 = exp(are * dt);
                const double nr = m1 * c1 - 1.0, ni = m1 * s1, den = are * are + aim * aim;
                const double qr = (nr * are + ni * aim) / den, qi_ = (ni * are - nr * aim) / den;
                double sl, cl; sincos_d(aim * dt * l, sl, cl); const double ml = exp(are * dt * l);
                const double zr = ml * cl, zi = ml * sl;
                const double zqr = zr * qr - zi * qi_, zqi = zr * qi_ + zi * qr;
#pragma unroll
                for (int ci = 0; ci < 16; ++ci) {
                    const double br = p.b_re[i * SSM_N + ci], bi = p.b_im[i * SSM_N + ci];
                    *(float2*)(zb + 2 * (pp * 16 + ci)) = make_float2((float)(zqr * br - zqi * bi), (float)(zqr * bi + zqi * br));
                }
            }
            __builtin_amdgcn_s_waitcnt(0xC07F);
            __builtin_amdgcn_wave_barrier();
#pragma unroll 1
            for (int q4 = 0; q4 < 4; ++q4) {
                const int ent = q4 * 64 + lane, co = ent >> 4, ci = ent & 15;
                float acc = 0.f;
                for (int pp = 0; pp < 64; ++pp) {
                    const float cr = p.c_re[((size_t)g * SSM_N + co) * SSM_P + pp], cim = p.c_im[((size_t)g * SSM_N + co) * SSM_P + pp];
                    const float2 z = *(const float2*)(zb + 2 * (pp * 16 + ci));
                    acc += cr * z.x - cim * z.y;
                }
                if (l == 0 && co == ci) acc += p.d_skip[g * SSM_N + co];
                kt[(((size_t)g * 64 + l) * 2 + (ci >> 3)) * 128 + co * 8 + (ci & 7)] = (bf16_t)f2bf(acc);
            }
            __builtin_amdgcn_wave_barrier();
        }
        bf16_t* w1t = WSP(bf16_t, WS_W1T); bf16_t* w3t = WSP(bf16_t, WS_W3T); float2* a64 = WSP(float2, WS_A64);
        for (size_t it = (PART == 1 ? gtid : (size_t)SSM_G * SSM_P * 64); it < (size_t)SSM_G * SSM_P * 64; it += gsize) {
            const int e = (int)(it & 63), pp = (int)((it >> 6) & 63), g = (int)(it >> 12);
            const size_t i = (size_t)g * SSM_P + pp;
            const double are = p.a_re[i], aim = p.a_im[i], dt = exp((double)p.log_dt[g]);
            double s1, c1; sincos_d(aim * dt, s1, c1); const double m1 = exp(are * dt);
            const double nr = m1 * c1 - 1.0, ni = m1 * s1, den = are * are + aim * aim;
            const double qr = (nr * are + ni * aim) / den, qi_ = (ni * are - nr * aim) / den;
            {
                const int l = 63 - e; double sl, cl; sincos_d(aim * dt * l, sl, cl); const double ml = exp(are * dt * l);
                const double zr = ml * cl, zi = ml * sl, wr_ = zr * qr - zi * qi_, wi_ = zr * qi_ + zi * qr;
                unsigned re_w[8], im_w[8];
#pragma unroll
                for (int c2 = 0; c2 < 8; ++c2) {
                    const double br0 = p.b_re[i * SSM_N + 2 * c2], bi0 = p.b_im[i * SSM_N + 2 * c2], br1 = p.b_re[i * SSM_N + 2 * c2 + 1], bi1 = p.b_im[i * SSM_N + 2 * c2 + 1];
                    re_w[c2] = f2bf((float)(wr_ * br0 - wi_ * bi0)) | (f2bf((float)(wr_ * br1 - wi_ * bi1)) << 16);
                    im_w[c2] = f2bf((float)(wr_ * bi0 + wi_ * br0)) | (f2bf((float)(wr_ * bi1 + wi_ * br1)) << 16);
                }
                u32x4* d0 = (u32x4*)(w1t + ((size_t)g * 128 + 2 * pp) * 1024 + e * 16);
                d0[0] = (u32x4){re_w[0], re_w[1], re_w[2], re_w[3]}; d0[1] = (u32x4){re_w[4], re_w[5], re_w[6], re_w[7]};
                u32x4* d1 = (u32x4*)(w1t + ((size_t)g * 128 + 2 * pp + 1) * 1024 + e * 16);
                d1[0] = (u32x4){im_w[0], im_w[1], im_w[2], im_w[3]}; d1[1] = (u32x4){im_w[4], im_w[5], im_w[6], im_w[7]};
            }
            {
                const int l = e + 1; double sl, cl; sincos_d(aim * dt * l, sl, cl); const double ml = exp(are * dt * l);
                const double zr = ml * cl, zi = ml * sl;
                for (int co = 0; co < 16; ++co) {
                    const double cr = p.c_re[((size_t)g * SSM_N + co) * SSM_P + pp], cim = p.c_im[((size_t)g * SSM_N + co) * SSM_P + pp];
                    const unsigned w = f2bf((float)(cr * zr - cim * zi)) | (f2bf((float)(-(cr * zi + cim * zr))) << 16);
                    *(unsigned*)(w3t + (((size_t)g * 64 + e) * 16 + co) * 128 + 2 * pp) = w;
                }
            }
            if (e == 0) { double sl, cl; sincos_d(aim * dt * 64, sl, cl); const double ml = exp(are * dt * 64); a64[i] = make_float2((float)(ml * cl), (float)(ml * sl)); }
        }
    }
    }
    } else {
    if (PART == 0) {
    {
        bf16_t* O = WSP(bf16_t, WS_R1);
        for (int row = gw; row < MTOK; row += NGW) {
            const float* xr = p.x + (size_t)row * DM;
            f32x4 v[4]; float ss = 0.f;
#pragma unroll
            for (int c = 0; c < 2; ++c) {
                v[2 * c] = *(const f32x4*)(xr + c * 512 + lane * 8); v[2 * c + 1] = *(const f32x4*)(xr + c * 512 + lane * 8 + 4);
            }
#pragma unroll
            for (int i = 0; i < 4; ++i) ss += v[i][0] * v[i][0] + v[i][1] * v[i][1] + v[i][2] * v[i][2] + v[i][3] * v[i][3];
            ss = wave_sum(ss);
            const float sc = rsqrtf(ss * (1.f / DM) + NORM_EPS);
#pragma unroll
            for (int c = 0; c < 2; ++c) {
                f32x4 ga = *(const f32x4*)(p.norm1_g + c * 512 + lane * 8), gb = *(const f32x4*)(p.norm1_g + c * 512 + lane * 8 + 4);
                *(u32x4*)(O + (size_t)row * DM + c * 512 + lane * 8) = pack8(v[2 * c] * sc * ga, v[2 * c + 1] * sc * gb);
            }
        }
    }
    }
    }
    }
}

#define EPI_ARGS const f32x4 (&acc)[2][2][4][2], const pg8::Unit& u, int wr_, int wc_, int fr_, int fq_
#define EPI_COORDS int t_ = threadIdx.x; asm volatile("" : "+v"(t_)); const int wid_ = __builtin_amdgcn_readfirstlane(t_ >> 6); \
    const int wr = wid_ >> 2, wc = wid_ & 3, fr = t_ & 15, fq = (t_ >> 4) & 3; (void)wr_; (void)wc_; (void)fr_; (void)fq_;
#define EPI_LOOP(...) \
    _Pragma("unroll") for (int ai = 0; ai < 2; ++ai) _Pragma("unroll") for (int m = 0; m < 4; ++m) { \
        const int row = u.pm * 256 + ai * 128 + wr * 64 + m * 16 + fr; \
        _Pragma("unroll") for (int bj = 0; bj < 2; ++bj) { const int vc = bj * 128 + wc * 32 + fq * 8; const f32x4 a0 = acc[ai][bj][m][0], a1 = acc[ai][bj][m][1]; __VA_ARGS__ } }

struct EpiInProj {
    static constexpr bool PERM = true, AFTER_DRAIN = false, CHAIN = false;
    bf16_t *u_, *q, *k, *v, *qi, *ki, *sgs, *sga; float* wi; const float2 *ropeA, *ropeI;
    __device__ __forceinline__ void rope_store(bf16_t* dst, const float2* cs, f32x4 a0, f32x4 a1) const {
        const f32x4 c01 = *(const f32x4*)cs, c23 = *(const f32x4*)(cs + 2);
        f32x4 r1, r2;
        r1[0] = a0[0] * c01[0] - a1[0] * c01[1]; r2[0] = a1[0] * c01[0] + a0[0] * c01[1];
        r1[1] = a0[1] * c01[2] - a1[1] * c01[3]; r2[1] = a1[1] * c01[2] + a0[1] * c01[3];
        r1[2] = a0[2] * c23[0] - a1[2] * c23[1]; r2[2] = a1[2] * c23[0] + a0[2] * c23[1];
        r1[3] = a0[3] * c23[2] - a1[3] * c23[3]; r2[3] = a1[3] * c23[2] + a0[3] * c23[3];
        *(u32x4*)dst = pack8(r1, r2);
    }
    __device__ __forceinline__ void rope_store8(unsigned char* dst, const float2* cs, f32x4 a0, f32x4 a1) const {
        const f32x4 c01 = *(const f32x4*)cs, c23 = *(const f32x4*)(cs + 2);
        f32x4 r1, r2;
        r1[0] = a0[0] * c01[0] - a1[0] * c01[1]; r2[0] = a1[0] * c01[0] + a0[0] * c01[1];
        r1[1] = a0[1] * c01[2] - a1[1] * c01[3]; r2[1] = a1[1] * c01[2] + a0[1] * c01[3];
        r1[2] = a0[2] * c23[0] - a1[2] * c23[1]; r2[2] = a1[2] * c23[0] + a0[2] * c23[1];
        r1[3] = a0[3] * c23[2] - a1[3] * c23[3]; r2[3] = a1[3] * c23[2] + a0[3] * c23[3];
        *(uint2*)dst = pack8_fp8(r1 * 16.f, r2 * 16.f);
    }
    __device__ __forceinline__ void operator()(EPI_ARGS) const {
        EPI_COORDS
        const int pn = u.pn;
        if (pn < 2) {
            EPI_LOOP({ *(u32x4*)(u_ + (size_t)row * 512 + pn * 256 + vc) = pack8(a0, a1); })
        } else if (pn < 4) {
            EPI_LOOP({ rope_store(q + (size_t)row * 512 + (pn - 2) * 256 + vc, ropeA + (row & (SEQ - 1)) * 32 + ((wc & 1) * 4 + fq) * 4, a0, a1); })
        } else if (pn == 4) {
            EPI_LOOP({ if (bj == 0) rope_store8((unsigned char*)k + (size_t)row * 128 + vc, ropeA + (row & (SEQ - 1)) * 32 + ((wc & 1) * 4 + fq) * 4, a0, a1);
                       else *(uint2*)((unsigned char*)v + (size_t)row * 128 + (vc - 128)) = pack8_fp8(a0 * 16.f, a1 * 16.f); })
        } else if (pn == 5) {
            EPI_LOOP({ rope_store(qi + (size_t)row * 256 + vc, ropeI + (row & (SEQ - 1)) * 16 + fq * 4, a0, a1); })
        } else if (pn == 6) {
            EPI_LOOP({ if (bj == 0) { if (wc == 0) rope_store(ki + (size_t)row * 32 + fq * 8, ropeI + (row & (SEQ - 1)) * 16 + fq * 4, a0, a1);
                                      else if (wc == 1 && fq == 0) { *(f32x4*)(wi + (size_t)row * 8) = a0; *(f32x4*)(wi + (size_t)row * 8 + 4) = a1; } } })
        } else if (pn < 11) {
            EPI_LOOP({ f32x4 s0, s1;
                       _Pragma("unroll") for (int j = 0; j < 4; ++j) { s0[j] = sigmoidf_(a0[j]); s1[j] = sigmoidf_(a1[j]); }
                       *(u32x4*)(sgs + (size_t)row * 1024 + (pn - 7) * 256 + vc) = pack8(s0, s1); })
        } else {
            EPI_LOOP({ f32x4 s0, s1;
                       _Pragma("unroll") for (int j = 0; j < 4; ++j) { s0[j] = sigmoidf_(a0[j]); s1[j] = sigmoidf_(a1[j]); }
                       *(u32x4*)(sga + (size_t)row * 1024 + (pn - 11) * 256 + vc) = pack8(s0, s1); })
        }
    }
};
struct EpiGlu {
    static constexpr bool PERM = true, AFTER_DRAIN = false, CHAIN = false;
    const bf16_t* y; bf16_t* o;
    __device__ __forceinline__ void operator()(EPI_ARGS) const {
        EPI_COORDS
        EPI_LOOP({ const size_t idx = (size_t)row * 512 + u.pn * 256 + vc; f32x4 y0, y1; unpack8(*(const u32x4*)(y + idx), y0, y1);
                   _Pragma("unroll") for (int j = 0; j < 4; ++j) { y0[j] *= sigmoidf_(a0[j]); y1[j] *= sigmoidf_(a1[j]); }
                   *(u32x4*)(o + idx) = pack8(y0, y1); })
    }
};
struct EpiMerge1 {
    static constexpr bool PERM = true, AFTER_DRAIN = false, CHAIN = false;
    const bf16_t* g; bf16_t* t;
    __device__ __forceinline__ void operator()(EPI_ARGS) const {
        EPI_COORDS
        EPI_LOOP({ const size_t idx = (size_t)row * 1024 + u.pn * 256 + vc; f32x4 g0, g1; unpack8(*(const u32x4*)(g + idx), g0, g1);
                   *(u32x4*)(t + idx) = pack8(g0 * a0, g1 * a1); })
    }
};
struct EpiMerge2 {
    static constexpr bool PERM = true, AFTER_DRAIN = false, CHAIN = false;
    const bf16_t* g; const bf16_t* t; bf16_t* o;
    __device__ __forceinline__ void operator()(EPI_ARGS) const {
        EPI_COORDS
        EPI_LOOP({ const size_t idx = (size_t)row * 1024 + u.pn * 256 + vc; f32x4 g0, g1, t0, t1; unpack8(*(const u32x4*)(g + idx), g0, g1); unpack8(*(const u32x4*)(t + idx), t0, t1);
                   *(u32x4*)(o + idx) = pack8(t0 + g0 * a0, t1 + g1 * a1); })
    }
};
struct EpiMergeChain {
    static constexpr bool PERM = true, AFTER_DRAIN = false, CHAIN = true;
    const bf16_t* gs; const bf16_t* ga; bf16_t* o;
    __device__ __forceinline__ void operator()(f32x4 (&acc)[2][2][4][2], const pg8::Unit& u, int wr_, int wc_, int fr_, int fq_) const {
        EPI_COORDS
#pragma unroll
        for (int ai = 0; ai < 2; ++ai)
#pragma unroll
            for (int m = 0; m < 4; ++m) {
                const int row = u.pm * 256 + ai * 128 + wr * 64 + m * 16 + fr;
#pragma unroll
                for (int bj = 0; bj < 2; ++bj) {
                    const size_t idx = (size_t)row * 1024 + u.pn * 256 + bj * 128 + wc * 32 + fq * 8;
                    f32x4 a0, a1; unpack8(*(const u32x4*)(ga + idx), a0, a1);
                    if (u.sel == 0) {
                        f32x4 s0, s1; unpack8(*(const u32x4*)(gs + idx), s0, s1);
#pragma unroll
                        for (int j = 0; j < 4; ++j) { acc[ai][bj][m][0][j] *= s0[j] * __builtin_amdgcn_rcpf(a0[j]); acc[ai][bj][m][1][j] *= s1[j] * __builtin_amdgcn_rcpf(a1[j]); }
                    } else {
                        *(u32x4*)(o + idx) = pack8(acc[ai][bj][m][0] * a0, acc[ai][bj][m][1] * a1);
                    }
                }
            }
    }
};
struct EpiOut {
    static constexpr bool PERM = true, AFTER_DRAIN = false, CHAIN = false;
    const float* x; bf16_t* hb; float* rss;
    __device__ __forceinline__ void operator()(EPI_ARGS) const {
        EPI_COORDS
#pragma unroll
        for (int ai = 0; ai < 2; ++ai)
#pragma unroll
            for (int m = 0; m < 4; ++m) {
                const int row = u.pm * 256 + ai * 128 + wr * 64 + m * 16 + fr;
                float ss = 0.f;
#pragma unroll
                for (int bj = 0; bj < 2; ++bj) {
                    const int col = u.pn * 256 + bj * 128 + wc * 32 + fq * 8;
                    const size_t idx = (size_t)row * 1024 + col;
                    const f32x4 h0 = *(const f32x4*)(x + idx) + acc[ai][bj][m][0], h1 = *(const f32x4*)(x + idx + 4) + acc[ai][bj][m][1];
                    ss += h0[0] * h0[0] + h0[1] * h0[1] + h0[2] * h0[2] + h0[3] * h0[3] + h1[0] * h1[0] + h1[1] * h1[1] + h1[2] * h1[2] + h1[3] * h1[3];
                    *(u32x4*)(hb + idx) = pack8(h0, h1);
                }
                ss += __shfl_xor(ss, 16); ss += __shfl_xor(ss, 32);
                if (fq == 0) rss[(size_t)row * 16 + u.pn * 4 + wc] = ss;
            }
    }
};
typedef _Float16 f16x8 __attribute__((ext_vector_type(8)));
struct EpiScores {
    static constexpr bool PERM = true, AFTER_DRAIN = false, CHAIN = false;
    _Float16* o;
    __device__ __forceinline__ void operator()(EPI_ARGS) const {
        EPI_COORDS
        EPI_LOOP({ const size_t idx = (size_t)row * 2048 + u.pn * 256 + vc;
                   f16x8 hv = {(_Float16)a0[0], (_Float16)a0[1], (_Float16)a0[2], (_Float16)a0[3], (_Float16)a1[0], (_Float16)a1[1], (_Float16)a1[2], (_Float16)a1[3]};
                   *(f16x8*)(o + idx) = hv; })
    }
};

template <class Epi>
__device__ __forceinline__ void run_gemm_chain(LAS unsigned char* lds, const bf16_t* A, const bf16_t* Bt, const bf16_t* A2, const bf16_t* Bt2, int M, int N, int K, int G, const Epi& E) {
    pg8::Gemm g{A, Bt, M, N, K, A2, Bt2}; pg8::ChainOrder S; S.init(M, N, G, (int)blockIdx.x);
    pg8::gemm_phase<Epi, pg8::ChainOrder, true, true>(lds, g, S, E);
}
template <class Epi>
__device__ __forceinline__ void run_gemm(LAS unsigned char* lds, const bf16_t* A, const bf16_t* Bt, int M, int N, int K, int G, const Epi& E) {
    pg8::Gemm g{A, Bt, M, N, K}; pg8::StaticOrder S; S.init(M, N, G, (int)blockIdx.x);
    pg8::gemm_phase<Epi, pg8::StaticOrder, true, true>(lds, g, S, E);
}

__device__ __forceinline__ void ssm_item(const Params& p, float* us, bf16_t* yg, int item, int lane) {
    const float2* abar_t = WSP(float2, WS_SSMT);
    const float2* bbar_t = abar_t + SSM_G * SSM_P;
    const bf16_t* u = WSP(bf16_t, WS_U);
    const int b = item / SSM_G, g = item % SSM_G;
    const float2 ab = abar_t[g * SSM_P + lane];
    float br[16], bi[16], cr[16], ci[16];
#pragma unroll
    for (int c = 0; c < 16; ++c) {
        float2 t = bbar_t[(g * SSM_P + lane) * SSM_N + c];
        br[c] = t.x; bi[c] = t.y;
        cr[c] = p.c_re[((size_t)g * SSM_N + c) * SSM_P + lane];
        ci[c] = p.c_im[((size_t)g * SSM_N + c) * SSM_P + lane];
    }
    const int myc = ((lane >> 5) & 1) * 8 + ((lane >> 4) & 1) * 4 + ((lane >> 3) & 1) * 2 + ((lane >> 2) & 1);
    const float dsk = p.d_skip[g * SSM_N + myc];
    float xr = 0.f, xi = 0.f;
    for (int t0 = 0; t0 < SEQ; t0 += 64) {
        {
            const bf16_t* ur = u + ((size_t)(b * SEQ + t0 + lane)) * SSM_W + g * SSM_N;
            f32x4 f0, f1, f2, f3; unpack8(*(const u32x4*)ur, f0, f1); unpack8(*(const u32x4*)(ur + 8), f2, f3);
            float* d = us + lane * 16;
            *(f32x4*)d = f0; *(f32x4*)(d + 4) = f1; *(f32x4*)(d + 8) = f2; *(f32x4*)(d + 12) = f3;
        }
        __builtin_amdgcn_s_waitcnt(0);
        __builtin_amdgcn_wave_barrier();
        for (int tt = 0; tt < 64; ++tt) {
            float uu[16];
#pragma unroll
            for (int c4 = 0; c4 < 4; ++c4) {
                f32x4 t = *(const f32x4*)(us + tt * 16 + c4 * 4);
                uu[c4 * 4] = t[0]; uu[c4 * 4 + 1] = t[1]; uu[c4 * 4 + 2] = t[2]; uu[c4 * 4 + 3] = t[3];
            }
            float bur = 0.f, bui = 0.f;
#pragma unroll
            for (int c = 0; c < 16; ++c) { bur += br[c] * uu[c]; bui += bi[c] * uu[c]; }
            float nxr = ab.x * xr - ab.y * xi + bur;
            float nxi = ab.x * xi + ab.y * xr + bui;
            xr = nxr; xi = nxi;
            float z[16];
#pragma unroll
            for (int c = 0; c < 16; ++c) z[c] = cr[c] * xr - ci[c] * xi;
            float w8[8], w4[4], w2[2], w1;
            const bool h5 = lane & 32, h4 = lane & 16, h3 = lane & 8, h2 = lane & 4;
#pragma unroll
            for (int i = 0; i < 8; ++i) { float mine = h5 ? z[8 + i] : z[i], oth = h5 ? z[i] : z[8 + i]; w8[i] = mine + __shfl_xor(oth, 32); }
#pragma unroll
            for (int i = 0; i < 4; ++i) { float mine = h4 ? w8[4 + i] : w8[i], oth = h4 ? w8[i] : w8[4 + i]; w4[i] = mine + __shfl_xor(oth, 16); }
#pragma unroll
            for (int i = 0; i < 2; ++i) { float mine = h3 ? w4[2 + i] : w4[i], oth = h3 ? w4[i] : w4[2 + i]; w2[i] = mine + __shfl_xor(oth, 8); }
            { float mine = h2 ? w2[1] : w2[0], oth = h2 ? w2[0] : w2[1]; w1 = mine + __shfl_xor(oth, 4); }
            w1 += __shfl_xor(w1, 2);
            w1 += __shfl_xor(w1, 1);
            float um = 0.f;
#pragma unroll
            for (int c = 0; c < 16; ++c) um = (c == myc) ? uu[c] : um;
            float y = gelu_tanh(w1 + dsk * um);
            if ((lane & 3) == 0) yg[((size_t)(b * SEQ + t0 + tt)) * SSM_W + g * SSM_N + myc] = (bf16_t)f2bf(y);
        }
        __builtin_amdgcn_wave_barrier();
    }
}


__device__ __forceinline__ void ssm_fast_item(const Params& p, unsigned char* smem, unsigned yg_off, int item, int lane_in, int wave) {
    const unsigned char* W = p.ws;
    constexpr unsigned O_U = WS_U << 20, O_W1T = WS_W1T << 20, O_W3T = WS_W3T << 20;
    const int b = item >> 5, g = item & 31;
    int lane = lane_in; asm volatile("" : "+v"(lane));
    const int gq = lane >> 4, c = lane & 15, rg = wave & 3, hf = wave >> 2;
    bf16_t* Kl = (bf16_t*)smem; float* Sl = (float*)(smem + 32768); bf16_t* Xb = (bf16_t*)(smem + 65536);
    __syncthreads();
    {
        const u32x4* src = (const u32x4*)(WSP(bf16_t, WS_KT) + (size_t)g * 64 * 256); u32x4* dst = (u32x4*)smem;
        for (int i = wave * 64 + lane; i < 2048; i += NT) dst[i] = src[i];
    }
    bf16x8 A[32];
#pragma unroll
    for (int ks = 0; ks < 32; ++ks)
        A[ks] = ldws<bf16x8>(W, O_U + ((unsigned)(b * SEQ + (16 * rg + c) * 64 + 2 * ks + (gq >> 1)) * 512u + g * 16 + 8 * (gq & 1)) * 2u);
#pragma unroll 1
    for (int nt = 0; nt < 4; ++nt) {
        f32x4 acc = {0.f, 0.f, 0.f, 0.f};
        const unsigned wb = O_W1T + ((unsigned)(g * 128 + (4 * hf + nt) * 16 + c) * 1024u + 8 * gq) * 2u;
#pragma unroll
        for (int ks = 0; ks < 32; ++ks) acc = __builtin_amdgcn_mfma_f32_16x16x32_bf16(A[ks], ldws<bf16x8>(W, wb + ks * 64), acc, 0, 0, 0);
#pragma unroll
        for (int r = 0; r < 4; ++r) Sl[(16 * rg + 4 * gq + r) * 128 + (4 * hf + nt) * 16 + c] = acc[r];
    }
    __syncthreads();
    if (wave == 0) {
        const float2 a = WSP(float2, WS_A64)[g * SSM_P + lane];
        float xr = 0.f, xi = 0.f;
        for (int ch = 0; ch < 64; ++ch) {
            *(unsigned*)(Xb + ch * 128 + 2 * lane) = f2bf(xr) | (f2bf(xi) << 16);
            const float2 sv = *(const float2*)(Sl + ch * 128 + 2 * lane);
            const float nr = a.x * xr - a.y * xi + sv.x, ni = a.x * xi + a.y * xr + sv.y;
            xr = nr; xi = ni;
        }
    }
    __syncthreads();
    bf16x8 Xa[4];
#pragma unroll
    for (int k2 = 0; k2 < 4; ++k2) Xa[k2] = *(const bf16x8*)(Xb + (16 * rg + c) * 128 + 32 * k2 + 8 * gq);
    bf16_t* yg = (bf16_t*)(p.ws + yg_off);
    const int gh = gq >> 1;
    const bf16_t* kl_lane = Kl + (gq & 1) * 128 + c * 8;
    bf16x8 w3[4];
    {
        const unsigned wb0 = O_W3T + ((unsigned)((g * 64 + hf) * 16 + c) * 128u + 8 * gq) * 2u;
#pragma unroll
        for (int k2 = 0; k2 < 4; ++k2) w3[k2] = ldws<bf16x8>(W, wb0 + k2 * 64);
    }
#pragma unroll 1
    for (int tq = 0; tq < 32; ++tq) {
        const int tp = 2 * tq + hf;
        f32x4 acc = {0.f, 0.f, 0.f, 0.f};
#pragma unroll
        for (int k2 = 0; k2 < 4; ++k2) acc = __builtin_amdgcn_mfma_f32_16x16x32_bf16(Xa[k2], w3[k2], acc, 0, 0, 0);
        {
            const int tn = tq < 31 ? tp + 2 : tp;
            const unsigned wb = O_W3T + ((unsigned)((g * 64 + tn) * 16 + c) * 128u + 8 * gq) * 2u;
#pragma unroll
            for (int k2 = 0; k2 < 4; ++k2) w3[k2] = ldws<bf16x8>(W, wb + k2 * 64);
        }
#pragma unroll
        for (int ks = 0; ks < 32; ++ks) {
            if (ks <= tq) {
                const int l = tp - 2 * ks - gh;
                bf16x8 kb = *(const bf16x8*)(kl_lane + (l < 0 ? 0 : l) * 256);
                if (l < 0) kb = (bf16x8){0, 0, 0, 0, 0, 0, 0, 0};
                acc = __builtin_amdgcn_mfma_f32_16x16x32_bf16(A[ks], kb, acc, 0, 0, 0);
            }
        }
#pragma unroll
        for (int r = 0; r < 4; ++r)
            yg[((size_t)(b * SEQ + (16 * rg + 4 * gq + r) * 64 + tp)) * SSM_W + g * SSM_N + c] = (bf16_t)f2bf(gelu_tanh(acc[r]));
    }
}

__device__ __forceinline__ unsigned fkey(float f) {
    unsigned u = __builtin_bit_cast(unsigned, f);
    return (u & 0x80000000u) ? ~u : (u | 0x80000000u);
}
__device__ __forceinline__ void phase_attn(const Params& p, unsigned char* smem, bf16_t* yatt, int vcu, int G) {
    float* sc = (float*)smem;
    float* qis = sc + 4096;
    float* wis = qis + 256;
    float* qs = wis + 16;
    float* pl = qs + 512;
    int* sel = (int*)(pl + 2048);
    unsigned* hist = (unsigned*)(sel + 256);
    int* scanA = (int*)(hist + 256);
    int* scanB = scanA + 512;
    int* misc = scanB + 512;
    int tid = threadIdx.x; asm volatile("" : "+v"(tid));
    const bf16_t* qi = WSP(bf16_t, WS_QI); const bf16_t* ki = WSP(bf16_t, WS_KI); const float* wi = WSP(float, WS_WI);
    const bf16_t* q = WSP(bf16_t, WS_Q); const bf16_t* kk = WSP(bf16_t, WS_K); const bf16_t* vv = WSP(bf16_t, WS_V);
    for (int row = vcu; row < MTOK; row += G) {
        const int b = row / SEQ, t = row % SEQ, nvalid = t + 1;
        __syncthreads();
        if (tid < 256) qis[tid] = bf2f(qi[(size_t)row * 256 + tid]);
        if (tid < 8) wis[tid] = wi[(size_t)row * 8 + tid];
        qs[tid] = bf2f(q[(size_t)row * 512 + tid]);
        __syncthreads();
        for (int s = tid; s < nvalid; s += NT) {
            const bf16_t* kr = ki + ((size_t)b * SEQ + s) * 32;
            float kv[32];
#pragma unroll
            for (int d8 = 0; d8 < 4; ++d8) {
                f32x4 a, bb; unpack8(*(const u32x4*)(kr + d8 * 8), a, bb);
                kv[d8 * 8] = a[0]; kv[d8 * 8 + 1] = a[1]; kv[d8 * 8 + 2] = a[2]; kv[d8 * 8 + 3] = a[3];
                kv[d8 * 8 + 4] = bb[0]; kv[d8 * 8 + 5] = bb[1]; kv[d8 * 8 + 6] = bb[2]; kv[d8 * 8 + 7] = bb[3];
            }
            float a = 0.f;
#pragma unroll
            for (int h = 0; h < 8; ++h) {
                float d = 0.f;
#pragma unroll
                for (int dd = 0; dd < 32; ++dd) d += qis[h * 32 + dd] * kv[dd];
                a += wis[h] * fmaxf(d, 0.f);
            }
#ifdef PROBE_ATTN
            sc[s] = (float)(_Float16)a;
#else
            sc[s] = a;
#endif
        }
        __syncthreads();
        int nsel;
        if (nvalid <= TOPK) {
            nsel = nvalid;
            if (tid < nvalid) sel[tid] = tid;
        } else {
            nsel = TOPK;
            unsigned prefix = 0, mask = 0; int need = TOPK;
            for (int pass = 0; pass < 4; ++pass) {
                const int shift = 24 - 8 * pass;
                if (tid < 256) hist[tid] = 0;
                __syncthreads();
                for (int s = tid; s < nvalid; s += NT) {
                    unsigned key = fkey(sc[s]);
                    if ((key & mask) == prefix) atomicAdd(&hist[(key >> shift) & 255], 1u);
                }
                __syncthreads();
                if (tid == 0) {
                    int cum = 0, bin = 255;
                    for (; bin > 0; --bin) { if (cum + (int)hist[bin] >= need) break; cum += hist[bin]; }
                    misc[0] = bin; misc[1] = need - cum;
                }
                __syncthreads();
                prefix |= (unsigned)misc[0] << shift; mask |= 0xFFu << shift; need = misc[1];
                __syncthreads();
            }
            const int base = tid * 8;
            int cg = 0, ce = 0;
            for (int i = 0; i < 8; ++i) { int s = base + i; if (s < nvalid) { unsigned key = fkey(sc[s]); cg += key > prefix; ce += key == prefix; } }
            scanA[tid] = ce;
            __syncthreads();
            if (tid == 0) { int run = 0; for (int i = 0; i < NT; ++i) { int v = scanA[i]; scanA[i] = run; run += v; } }
            __syncthreads();
            const int preE = scanA[tid];
            int takeE = need - preE; takeE = takeE < 0 ? 0 : (takeE > ce ? ce : takeE);
            scanB[tid] = cg + takeE;
            __syncthreads();
            if (tid == 0) { int run = 0; for (int i = 0; i < NT; ++i) { int v = scanB[i]; scanB[i] = run; run += v; } }
            __syncthreads();
            int off = scanB[tid], te = 0;
            for (int i = 0; i < 8; ++i) {
                int s = base + i;
                if (s < nvalid) {
                    unsigned key = fkey(sc[s]);
                    bool take = key > prefix;
                    if (key == prefix) { take = te < takeE; ++te; }
                    if (take) { if (off < TOPK) sel[off] = s; ++off; }
                }
            }
        }
        __syncthreads();
        {
            const int j = tid & 255, n = tid >> 8;
            if (j < nsel) {
                const unsigned char* kr = (const unsigned char*)kk + ((size_t)b * SEQ + sel[j]) * 128 + n * 64;
                float kf[64];
#pragma unroll
                for (int d8 = 0; d8 < 8; ++d8) {
                    f32x4 a, bb; unpack8_fp8(*(const uint2*)(kr + d8 * 8), a, bb); a *= (1.f / 16.f); bb *= (1.f / 16.f);
                    kf[d8 * 8] = a[0]; kf[d8 * 8 + 1] = a[1]; kf[d8 * 8 + 2] = a[2]; kf[d8 * 8 + 3] = a[3];
                    kf[d8 * 8 + 4] = bb[0]; kf[d8 * 8 + 5] = bb[1]; kf[d8 * 8 + 6] = bb[2]; kf[d8 * 8 + 7] = bb[3];
                }
#pragma unroll
                for (int hh = 0; hh < 4; ++hh) {
                    const int h = n * 4 + hh;
                    float d = 0.f;
#pragma unroll
                    for (int dd = 0; dd < 64; ++dd) d += qs[h * 64 + dd] * kf[dd];
                    pl[h * 256 + j] = d * 0.125f;
                }
            } else {
#pragma unroll
                for (int hh = 0; hh < 4; ++hh) pl[(n * 4 + hh) * 256 + j] = -1e30f;
            }
        }
        __syncthreads();
        {
            const int h = tid >> 6, l = tid & 63;
            float vals[4]; float mx = -3e38f;
#pragma unroll
            for (int i = 0; i < 4; ++i) { vals[i] = pl[h * 256 + l + 64 * i]; mx = fmaxf(mx, vals[i]); }
#pragma unroll
            for (int o = 32; o >= 1; o >>= 1) mx = fmaxf(mx, __shfl_xor(mx, o));
            float sm = 0.f;
#pragma unroll
            for (int i = 0; i < 4; ++i) { vals[i] = __expf(vals[i] - mx); sm += vals[i]; }
            sm = wave_sum(sm);
            float inv = 1.f / sm;
#pragma unroll
            for (int i = 0; i < 4; ++i) pl[h * 256 + l + 64 * i] = vals[i] * inv;
        }
        __syncthreads();
        {
            const int h = tid >> 6, d = tid & 63, n = h >> 2;
            float a = 0.f;
            for (int j = 0; j < nsel; ++j) {
                const unsigned wv = *(const unsigned*)((const unsigned char*)vv + ((size_t)b * SEQ + sel[j]) * 128 + n * 64 + (d & ~3));
                const f32x2_t pv0 = __builtin_amdgcn_cvt_pk_f32_fp8((int)wv, false), pv1 = __builtin_amdgcn_cvt_pk_f32_fp8((int)wv, true);
                const float vsel = (d & 2) ? ((d & 1) ? pv1[1] : pv1[0]) : ((d & 1) ? pv0[1] : pv0[0]);
                const int pq = __builtin_amdgcn_cvt_pk_fp8_f32(pl[h * 256 + j] * 256.f, 0.f, 0, false);
                const f32x2_t pd = __builtin_amdgcn_cvt_pk_f32_fp8(pq, false);
                a += pd[0] * vsel * (1.f / 4096.f);
            }
            yatt[(size_t)row * 512 + tid] = (bf16_t)f2bf(a);
        }
    }
}


typedef short v4i16_t __attribute__((ext_vector_type(4)));
constexpr int DSA_KSTR = 8200, DSA_SEL_OFF = 16 * DSA_KSTR, DSA_NSEL_OFF = DSA_SEL_OFF + 8192, DSA_HIST_OFF = DSA_NSEL_OFF + 256, DSA_VST = 5120;
__device__ __forceinline__ int mbcnt64(unsigned long long m) { return __builtin_amdgcn_mbcnt_hi((unsigned)(m >> 32), __builtin_amdgcn_mbcnt_lo((unsigned)m, 0u)); }

__device__ __forceinline__ void dsa_item(const Params& p, unsigned char* smem, unsigned yatt_off, int b, int tt, int lane_in, int wave) {
    const unsigned char* W = p.ws;
    constexpr unsigned O_QI = WS_QI << 20, O_KI = WS_KI << 20, O_WI = WS_WI << 20, O_Q = WS_Q << 20, O_K = WS_K << 20, O_V = WS_V << 20;
    const int t0 = tt * 16;
    __syncthreads();
#ifndef DSA_RA
#define DSA_RA 1
#endif
#ifndef DSA_RB
#define DSA_RB 1
#endif
#ifndef DSA_RC
#define DSA_RC 1
#endif
    _Pragma("unroll 1") for (int ra_ = 0; ra_ < DSA_RA; ++ra_) {
        int lane = lane_in; asm volatile("" : "+v"(lane));
        const int g = lane >> 4, c = lane & 15;
        const unsigned qrow = (unsigned)(b * SEQ + t0 + c);
        bf16x8 qf[8]; float wv[8];
#pragma unroll
        for (int h = 0; h < 8; ++h) { qf[h] = ldws<bf16x8>(W, O_QI + qrow * 512u + h * 64 + 16 * g); wv[h] = ldws<float>(W, O_WI + qrow * 32u + h * 4); }
        bf16x8 kf_next = ldws<bf16x8>(W, O_KI + (unsigned)(b * SEQ + (wave <= tt ? wave : tt) * 16 + c) * 64u + 16 * g);
#pragma unroll 1
        for (int kt = wave; kt <= tt; kt += NWAVES) {
            const bf16x8 kf = kf_next;
            { const int kn = kt + NWAVES <= tt ? kt + NWAVES : tt; kf_next = ldws<bf16x8>(W, O_KI + (unsigned)(b * SEQ + kn * 16 + c) * 64u + 16 * g); }
            f32x4 s = {0.f, 0.f, 0.f, 0.f};
#pragma unroll
            for (int h = 0; h < 8; ++h) {
                const f32x4 d = __builtin_amdgcn_mfma_f32_16x16x32_bf16(kf, qf[h], (f32x4){0.f, 0.f, 0.f, 0.f}, 0, 0, 0);
#pragma unroll
                for (int r = 0; r < 4; ++r) { const float dv = d[r]; const int ri = __float_as_int(dv); s[r] += wv[h] * __int_as_float(ri > 0 ? ri : 0); }
            }
            const bool diag = (kt == tt);
            unsigned kw[4];
#pragma unroll
            for (int r = 0; r < 4; ++r) {
                const _Float16 hv = (_Float16)s[r];
                const unsigned hb = (unsigned)__builtin_bit_cast(unsigned short, hv);
                const unsigned key = (hb & 0x8000u) ? (~hb & 0xffffu) : (hb | 0x8000u);
                const bool valid = !(diag && 4 * g + r > c);
                kw[r] = valid ? key : 0u;
                if (valid && ra_ == 0) atomicAdd((unsigned*)(smem + DSA_HIST_OFF) + c * 256 + (key >> 8), 1u);
            }
            *(uint2*)(smem + c * DSA_KSTR + (kt * 16 + 4 * g) * 2) = make_uint2(kw[0] | (kw[1] << 16), kw[2] | (kw[3] << 16));
        }
    }
    __syncthreads();
    unsigned short* selall = (unsigned short*)(smem + DSA_SEL_OFF);
    int* nselarr = (int*)(smem + DSA_NSEL_OFF);
#pragma unroll 1
    for (int rr = 0; rr < 2 * DSA_RB; ++rr) {
        int lane = lane_in; asm volatile("" : "+v"(lane));
        const int tl = wave * 2 + (rr & 1), nvalid = t0 + tl + 1;
        unsigned short* selrow = selall + tl * 256;
        if (nvalid <= TOPK) {
            for (int j = lane; j < TOPK; j += 64) selrow[j] = (unsigned short)(j < nvalid ? j : 0);
            if (lane == 0) nselarr[tl] = nvalid;
        } else {
            unsigned kk[64];
#pragma unroll
            for (int i = 0; i < 16; ++i) {
                const uint2 w = *(const uint2*)(smem + tl * DSA_KSTR + (i * 64 + lane) * 8);
                const int s0 = (i * 64 + lane) * 4;
                kk[4 * i + 0] = s0 + 0 < nvalid ? (w.x & 0xffffu) : 0u; kk[4 * i + 1] = s0 + 1 < nvalid ? (w.x >> 16) : 0u;
                kk[4 * i + 2] = s0 + 2 < nvalid ? (w.y & 0xffffu) : 0u; kk[4 * i + 3] = s0 + 3 < nvalid ? (w.y >> 16) : 0u;
            }
            unsigned* hist = (unsigned*)(smem + DSA_HIST_OFF) + tl * 256;
            const int ni = (nvalid + 255) >> 8;
            unsigned Bsel = 0u; int cabove = 0, nties = 0;
#pragma unroll 1
            for (int pass = 0; pass < 2; ++pass) {
                if (pass == 1) {
#pragma unroll
                    for (int i = 0; i < 16; ++i) {
                        if (i < ni) {
#pragma unroll
                            for (int e = 0; e < 4; ++e) { const unsigned k = kk[4 * i + e]; if ((k >> 8) == Bsel) atomicAdd(&hist[k & 255u], 1u); }
                        }
                    }
                    __builtin_amdgcn_s_waitcnt(0xC07F);
                    __builtin_amdgcn_wave_barrier();
                }
                const uint4 hv = *(const uint4*)(hist + 4 * lane);
                const int ls = (int)(hv.x + hv.y + hv.z + hv.w);
                const int pre_ = wave_incl_scan(ls);
                const int suf = __builtin_amdgcn_readlane(pre_, 63) - pre_ + ls;
                const int needp = TOPK - cabove;
                const int above = suf - ls;
                const bool mine = (above < needp) && (suf >= needp);
                int bsel_l = 0, ca_l = 0, hsel_l = 0;
                {
                    int cacc = above;
                    const int h3 = (int)hv.w, h2 = (int)hv.z, h1 = (int)hv.y, h0 = (int)hv.x;
                    if (cacc + h3 >= needp) { bsel_l = 3; ca_l = cacc; hsel_l = h3; }
                    else { cacc += h3; if (cacc + h2 >= needp) { bsel_l = 2; ca_l = cacc; hsel_l = h2; }
                        else { cacc += h2; if (cacc + h1 >= needp) { bsel_l = 1; ca_l = cacc; hsel_l = h1; } else { cacc += h1; bsel_l = 0; ca_l = cacc; hsel_l = h0; } } }
                }
                const unsigned long long mm = __ballot(mine);
                const int src = mm ? (int)__builtin_ctzll(mm) : 0;
                const int bb = __shfl(4 * lane + bsel_l, src), ca = __shfl(ca_l, src);
                nties = __shfl(hsel_l, src);
                if (pass == 0) {
                    Bsel = (unsigned)bb; cabove = ca;
                    __builtin_amdgcn_wave_barrier();
                    hist[lane] = 0u; hist[lane + 64] = 0u; hist[lane + 128] = 0u; hist[lane + 192] = 0u;
                    __builtin_amdgcn_s_waitcnt(0xC07F);
                    __builtin_amdgcn_wave_barrier();
                } else { Bsel = (Bsel << 8) | (unsigned)bb; cabove += ca; }
            }
            const unsigned T = Bsel;
            const int need = TOPK - cabove;
            if (nties == need) {
                int cntl = 0;
#pragma unroll
                for (int i = 0; i < 16; ++i) if (i < ni) {
#pragma unroll
                    for (int e = 0; e < 4; ++e) cntl += (kk[4 * i + e] >= T) ? 1 : 0;
                }
                const int pre = wave_incl_scan(cntl);
                int pos = pre - cntl;
#pragma unroll
                for (int i = 0; i < 16; ++i) if (i < ni) {
#pragma unroll
                    for (int e = 0; e < 4; ++e) { if (kk[4 * i + e] >= T) { if (pos < TOPK) selrow[pos] = (unsigned short)((i * 64 + lane) * 4 + e); ++pos; } }
                }
            } else {
                int tiebase = 0, sbase = 0;
#pragma unroll
                for (int i = 0; i < 16; ++i) {
                    int below = 0, tot = 0;
#pragma unroll
                    for (int e = 0; e < 4; ++e) { const unsigned long long m = __ballot(kk[4 * i + e] == T); below += mbcnt64(m); tot += __builtin_popcountll(m); }
                    int own = 0; bool take[4];
#pragma unroll
                    for (int e = 0; e < 4; ++e) { const bool tie = kk[4 * i + e] == T; take[e] = (kk[4 * i + e] > T) || (tie && (tiebase + below + own < need)); own += tie ? 1 : 0; }
                    tiebase += tot;
                    int belowS = 0, totS = 0;
#pragma unroll
                    for (int e = 0; e < 4; ++e) { const unsigned long long m = __ballot(take[e]); belowS += mbcnt64(m); totS += __builtin_popcountll(m); }
                    int ownS = 0;
#pragma unroll
                    for (int e = 0; e < 4; ++e) { if (take[e]) { const int pos = sbase + belowS + ownS; if (pos < TOPK) selrow[pos] = (unsigned short)((i * 64 + lane) * 4 + e); } ownS += take[e] ? 1 : 0; }
                    sbase += totS;
                }
            }
            if (lane == 0) nselarr[tl] = TOPK;
        }
        {
            unsigned* hz = (unsigned*)(smem + DSA_HIST_OFF) + tl * 256;
            hz[lane] = 0u; hz[lane + 64] = 0u; hz[lane + 128] = 0u; hz[lane + 192] = 0u;
        }
    }
    __builtin_amdgcn_s_waitcnt(0xC07F); __builtin_amdgcn_wave_barrier();
#pragma unroll 1
    for (int rn_ = 0; rn_ < 4 * DSA_RC; ++rn_) {
        const int rn = rn_ & 3;
        int lane = lane_in; asm volatile("" : "+v"(lane));
        const int g = lane >> 4, c = lane & 15;
        const int rr = rn >> 1, n = rn & 1;
        unsigned char* vst = smem + (2 * wave) * DSA_KSTR;
        const int tl = wave * 2 + rr;
        const unsigned rowg = (unsigned)(b * SEQ + t0 + tl);
        const int nselg = nselarr[tl] - 4 * g;
        const unsigned short* selrow = selall + tl * 256;
        const unsigned kvb = O_K + (unsigned)(b * SEQ) * 128u + n * 64 + 16 * g;
        const unsigned vvb = O_V + (unsigned)(b * SEQ) * 128u + n * 64 + (lane & 3) * 16;
        long qha = 0, qhb = 0, qla = 0, qlb = 0;
        if (c < 4) {
            const unsigned qo = O_Q + rowg * 1024u + (n * 4 + c) * 128 + 32 * g;
            f32x4 q0, q1, q2, q3; unpack8(ldws<u32x4>(W, qo), q0, q1); unpack8(ldws<u32x4>(W, qo + 16), q2, q3);
            q0 *= 16.f; q1 *= 16.f; q2 *= 16.f; q3 *= 16.f;
            const uint2 ha = pack8_fp8(q0, q1), hb = pack8_fp8(q2, q3);
            f32x4 d0, d1, d2, d3; unpack8_fp8(ha, d0, d1); unpack8_fp8(hb, d2, d3);
            const uint2 la = pack8_fp8(q0 - d0, q1 - d1), lb = pack8_fp8(q2 - d2, q3 - d3);
            qha = (long)(((unsigned long long)ha.y << 32) | ha.x); qhb = (long)(((unsigned long long)hb.y << 32) | hb.x);
            qla = (long)(((unsigned long long)la.y << 32) | la.x); qlb = (long)(((unsigned long long)lb.y << 32) | lb.x);
        }
        f32x4 S[16];
#pragma unroll
        for (int tile = 0; tile < 16; ++tile) {
            const unsigned key = selrow[tile * 16 + c];
            const u32x4 kw = ldws<u32x4>(W, kvb + key * 128u);
            const long ka = (long)(((unsigned long long)kw.y << 32) | kw.x), kb = (long)(((unsigned long long)kw.w << 32) | kw.z);
            f32x4 acc = __builtin_amdgcn_mfma_f32_16x16x32_fp8_fp8(ka, qha, (f32x4){0.f, 0.f, 0.f, 0.f}, 0, 0, 0);
            acc = __builtin_amdgcn_mfma_f32_16x16x32_fp8_fp8(kb, qhb, acc, 0, 0, 0);
            acc = __builtin_amdgcn_mfma_f32_16x16x32_fp8_fp8(ka, qla, acc, 0, 0, 0);
            S[tile] = __builtin_amdgcn_mfma_f32_16x16x32_fp8_fp8(kb, qlb, acc, 0, 0, 0);
        }
        u32x4 vra[8];
#pragma unroll
        for (int i = 0; i < 8; ++i) { const unsigned key = selrow[i * 16 + (lane >> 2)]; vra[i] = ldws<u32x4>(W, vvb + key * 128u); }
        float Pk[4][4];
        {
            const int nselc = nselarr[tl] - 4 * g - 16 * (c >> 2);
            float mx = -3e38f;
#pragma unroll
            for (int q4 = 0; q4 < 4; ++q4)
#pragma unroll
                for (int r = 0; r < 4; ++r) {
                    float v = S[4 * q4][r];
                    v = dppf<0x114, 0xf, 0x2, false>(v, S[4 * q4 + 1][r]);
                    v = dppf<0x118, 0xf, 0x4, false>(v, S[4 * q4 + 2][r]);
                    v = dppf<0x11C, 0xf, 0x8, false>(v, S[4 * q4 + 3][r]);
                    v = (64 * q4 + r) < nselc ? v : -1e30f;
                    Pk[q4][r] = v; mx = fmaxf(mx, v);
                }
            mx = fmaxf(mx, dppf<0x124, 0xf, 0xf, false>(mx, mx)); mx = fmaxf(mx, dppf<0x128, 0xf, 0xf, false>(mx, mx));
            mx = fmaxf(mx, __shfl_xor(mx, 16)); mx = fmaxf(mx, __shfl_xor(mx, 32));
            float sum = 0.f;
#pragma unroll
            for (int q4 = 0; q4 < 4; ++q4)
#pragma unroll
                for (int r = 0; r < 4; ++r) { const float e = __expf((Pk[q4][r] - mx) * (0.125f / 256.f)); Pk[q4][r] = e; sum += e; }
            sum += dppf<0x124, 0xf, 0xf, false>(sum, sum); sum += dppf<0x128, 0xf, 0xf, false>(sum, sum);
            sum += __shfl_xor(sum, 16); sum += __shfl_xor(sum, 32);
            const float invs = 256.f / sum;
#pragma unroll
            for (int q4 = 0; q4 < 4; ++q4)
#pragma unroll
                for (int r = 0; r < 4; ++r) Pk[q4][r] *= invs;
#pragma unroll
            for (int q4 = 0; q4 < 4; ++q4)
#pragma unroll
                for (int r = 0; r < 4; ++r) {
                    const float pv = Pk[q4][r];
                    S[4 * q4][r] = pv;
                    S[4 * q4 + 1][r] = dppf<0x104, 0xf, 0xf, false>(pv, pv);
                    S[4 * q4 + 2][r] = dppf<0x108, 0xf, 0xf, false>(pv, pv);
                    S[4 * q4 + 3][r] = dppf<0x10C, 0xf, 0xf, false>(pv, pv);
                }
        }
        f32x4 O[4];
#pragma unroll
        for (int dt = 0; dt < 4; ++dt) O[dt] = (f32x4){0.f, 0.f, 0.f, 0.f};
        const LAS unsigned char* vp = (const LAS unsigned char*)(vst + (16 * (g >> 1) + 8 * (g & 1) + 4 * ((c >> 1) >> 2) + ((c >> 1) & 3)) * 80 + (c & 1) * 8);
        typedef int v2i32_t __attribute__((ext_vector_type(2)));
#pragma unroll
        for (int hv = 0; hv < 2; ++hv) {
            u32x4 vr[8];
            if (hv == 0) {
#pragma unroll
                for (int i = 0; i < 8; ++i) vr[i] = vra[i];
            } else {
#pragma unroll
                for (int i = 0; i < 8; ++i) { const unsigned key = selrow[128 + i * 16 + (lane >> 2)]; vr[i] = ldws<u32x4>(W, vvb + key * 128u); }
            }
#pragma unroll
            for (int k4 = 0; k4 < 4; ++k4) {
                const int ks2 = hv * 4 + k4;
                __builtin_amdgcn_wave_barrier();
#pragma unroll
                for (int i2 = 0; i2 < 2; ++i2) {
                    const int slot = 16 * (lane >> 5) + 8 * ((lane >> 4) & 1) + 4 * i2 + ((lane >> 2) & 3);
                    *(u32x4*)(vst + slot * 80 + (lane & 3) * 16) = vr[k4 * 2 + i2];
                }
                __builtin_amdgcn_s_waitcnt(0xC07F);
                __builtin_amdgcn_wave_barrier();
                const uint2 pw = pack8_fp8(S[2 * ks2], S[2 * ks2 + 1]);
                const long pa = (long)(((unsigned long long)pw.y << 32) | pw.x);
#pragma unroll
                for (int dt = 0; dt < 4; ++dt) {
                    const v2i32_t l0 = __builtin_amdgcn_ds_read_tr8_b64_v2i32((LAS v2i32_t*)(vp + dt * 16));
                    const long vb = (long)(((unsigned long long)(unsigned)l0[1] << 32) | (unsigned)l0[0]);
                    O[dt] = __builtin_amdgcn_mfma_f32_16x16x32_fp8_fp8(pa, vb, O[dt], 0, 0, 0);
                }
            }
        }
        if (g == 0) {
            bf16_t* yo = (bf16_t*)(p.ws + yatt_off) + (size_t)rowg * 512 + n * 256 + c;
#pragma unroll
            for (int dt = 0; dt < 4; ++dt)
#pragma unroll
                for (int r = 0; r < 4; ++r) yo[r * 64 + dt * 16] = (bf16_t)f2bf(O[dt][r] * (1.f / 4096.f));
        }
    }
}

__device__ __forceinline__ void phase_dsa(const Params& p, unsigned char* smem, unsigned yatt_off, int vcu, int G) {
    int tid = threadIdx.x; asm volatile("" : "+v"(tid));
    const int lane = tid & 63, wave = __builtin_amdgcn_readfirstlane(tid >> 6);
    { unsigned* hz = (unsigned*)(smem + DSA_HIST_OFF); for (int i = tid; i < 16 * 256; i += NT) hz[i] = 0u; }
    const bool bal = (G == 256);
    const int nit = bal ? 8 : (NB * 256 - vcu + G - 1) / G;
#pragma unroll 1
    for (int it = 0; it < nit; ++it) {
        int b, tt;
        if (bal) { const int j = vcu & 31; b = vcu >> 5; tt = (it >> 1) * 64 + ((it & 1) ? 63 - j : j); }
        else { const int item = vcu + it * G; b = item >> 8; tt = item & 255; }
        dsa_item(p, smem, yatt_off, b, tt, lane, wave);
#if PEER_FP8
        {
            if (bal) {
                const int slots = G * NWAVES * 8, per = (2 * 16384 + slots - 1) / slots;
                const int s0 = ((vcu * NWAVES + wave) * 8 + it) * per;
                for (int r = s0; r < s0 + per && r < 2 * 16384; ++r) peer_table_row(p, r, lane, smem + DSA_HIST_OFF + 16384 + wave * 768);
            }
        }
#endif
    }
#if PEER_FP8
    if (!bal) for (int r = vcu * NWAVES + wave; r < 2 * 16384; r += G * NWAVES) peer_table_row(p, r, lane, smem + DSA_HIST_OFF + 16384 + wave * 768);
#endif
}

template <bool DRY>
__device__ __forceinline__ void phase_peer(const Params& p, unsigned char* smem, int vcu, int G) {
    int tid_ = threadIdx.x; asm volatile("" : "+v"(tid_)); const int wave = tid_ >> 6, lane = tid_ & 63;
    float* wsm = (float*)smem + wave * 1024;
    float* sc = wsm;
    float* v1s = wsm + 256; int* i1s = (int*)(wsm + 272); float* v2s = wsm + 288; int* i2s = (int*)(wsm + 304);
    float* tops = wsm + 320;
    int* tope = (int*)(wsm + 336);
    int* eid = (int*)(wsm + 384);
    float* egate = wsm + 512;
    const float* scores = WSP(float, WS_SCORES);
    const bf16_t* hg = WSP(bf16_t, WS_HG);
    const float* rss = WSP(float, WS_RSS);
    const bf16_t* ut = WSP(bf16_t, WS_UTAB); const bf16_t* vt = WSP(bf16_t, WS_VTAB);
    const int nwaves = G * NWAVES;
    int ca = 0, cb = 0;
    {
        int rem = lane; bool found = false;
#pragma unroll
        for (int a = 0; a < 16; ++a) { int cnt = 16 / (a + 1); if (!found) { if (rem < cnt) { ca = a; cb = rem; found = true; } else rem -= cnt; } }
    }
    for (int row = vcu * NWAVES + wave; row < MTOK; row += nwaves) {
        float rs;
        {
            float t = lane < 16 ? rss[(size_t)row * 16 + lane] : 0.f;
            t = wave_sum(t);
            rs = rsqrtf(t * (1.f / DM) + NORM_EPS);
        }
        for (int h = 0; h < PEER_H; ++h) {
            const float* sp = scores + (size_t)row * 2048 + h * 256;
            float a0 = sp[lane], a1 = sp[lane + 64], b0 = sp[128 + lane], b1 = sp[192 + lane];
            __builtin_amdgcn_wave_barrier();
            sc[lane] = a0; sc[lane + 64] = a1; sc[128 + lane] = b0; sc[192 + lane] = b1;
            __builtin_amdgcn_s_waitcnt(0);
            __builtin_amdgcn_wave_barrier();
            int ra0 = 0, ra1 = 0, rb0 = 0, rb1 = 0;
            for (int j = 0; j < 64; ++j) {
                float x = sc[j], y = sc[j + 64], z = sc[128 + j], w = sc[192 + j];
                ra0 += (x > a0) || (x == a0 && j < lane); ra0 += (y > a0);
                ra1 += (x >= a1); ra1 += (y > a1) || (y == a1 && j < lane);
                rb0 += (z > b0) || (z == b0 && j < lane); rb0 += (w > b0);
                rb1 += (z >= b1); rb1 += (w > b1) || (w == b1 && j < lane);
            }
            if (ra0 < 16) { v1s[ra0] = a0; i1s[ra0] = lane; }
            if (ra1 < 16) { v1s[ra1] = a1; i1s[ra1] = lane + 64; }
            if (rb0 < 16) { v2s[rb0] = b0; i2s[rb0] = lane; }
            if (rb1 < 16) { v2s[rb1] = b1; i2s[rb1] = lane + 64; }
            __builtin_amdgcn_s_waitcnt(0);
            __builtin_amdgcn_wave_barrier();
            float cv = -3e38f; int cpos = 1 << 20;
            if (lane < 50) { cv = v1s[ca] + v2s[cb]; cpos = ca * 16 + cb; }
            int rk = 0;
            for (int j = 0; j < 50; ++j) {
                float x = __shfl(cv, j); int px = __shfl(cpos, j);
                rk += (x > cv) || (x == cv && px < cpos);
            }
            if (lane < 50 && rk < 16) { tops[rk] = cv; tope[rk] = i1s[ca] * PEER_KEYS + i2s[cb]; }
            __builtin_amdgcn_s_waitcnt(0);
            __builtin_amdgcn_wave_barrier();
            if (lane < 16) {
                float s = tops[lane] * rs;
                float mx = s;
#pragma unroll
                for (int o = 8; o >= 1; o >>= 1) mx = fmaxf(mx, __shfl_xor(mx, o, 16));
                float e = __expf(s - mx), sm = e;
#pragma unroll
                for (int o = 8; o >= 1; o >>= 1) sm += __shfl_xor(sm, o, 16);
                eid[h * 16 + lane] = tope[lane];
                egate[h * 16 + lane] = e / sm;
            }
            __builtin_amdgcn_s_waitcnt(0);
            __builtin_amdgcn_wave_barrier();
        }
        f32x4 xv[4], acc[4];
        {
            const bf16_t* hr = hg + (size_t)row * DM;
            unpack8(*(const u32x4*)(hr + lane * 8), xv[0], xv[1]);
            unpack8(*(const u32x4*)(hr + 512 + lane * 8), xv[2], xv[3]);
#pragma unroll
            for (int i = 0; i < 4; ++i) { xv[i] = xv[i] * rs; acc[i] = (f32x4){0.f, 0.f, 0.f, 0.f}; }
        }
        for (int e0 = 0; e0 < 128; e0 += 4) {
            u32x4 uw[4][2], vw[4][2];
#pragma unroll
            for (int e = 0; e < 4; ++e) {
                const bf16_t* ur = ut + (size_t)eid[e0 + e] * DM;
                uw[e][0] = *(const u32x4*)(ur + lane * 8); uw[e][1] = *(const u32x4*)(ur + 512 + lane * 8);
            }
#pragma unroll
            for (int e = 0; e < 4; ++e) {
                const bf16_t* vr = vt + (size_t)eid[e0 + e] * DM;
                vw[e][0] = *(const u32x4*)(vr + lane * 8); vw[e][1] = *(const u32x4*)(vr + 512 + lane * 8);
            }
            float act[4];
#pragma unroll
            for (int e = 0; e < 4; ++e) {
                f32x4 u0, u1, u2, u3; unpack8(uw[e][0], u0, u1); unpack8(uw[e][1], u2, u3);
                f32x4 s4 = xv[0] * u0 + xv[1] * u1 + xv[2] * u2 + xv[3] * u3;
                float d = wave_sum((s4[0] + s4[1]) + (s4[2] + s4[3]));
                act[e] = gelu_tanh(d) * egate[e0 + e];
            }
#pragma unroll
            for (int e = 0; e < 4; ++e) {
                f32x4 v0, v1, v2, v3; unpack8(vw[e][0], v0, v1); unpack8(vw[e][1], v2, v3);
                acc[0] += v0 * act[e]; acc[1] += v1 * act[e]; acc[2] += v2 * act[e]; acc[3] += v3 * act[e];
            }
        }
        float* hr = p.out + (size_t)row * DM;
        float ss = 0.f;
        if (DRY) { const float chk = acc[0][0] + acc[1][1] + acc[2][2] + acc[3][3]; if (chk == 1.2345678f) hr[lane] = chk; continue; }
#pragma unroll
        for (int c = 0; c < 2; ++c) {
            acc[2 * c] += *(const f32x4*)(hr + c * 512 + lane * 8); acc[2 * c + 1] += *(const f32x4*)(hr + c * 512 + lane * 8 + 4);
        }
#pragma unroll
        for (int i = 0; i < 4; ++i) ss += acc[i][0] * acc[i][0] + acc[i][1] * acc[i][1] + acc[i][2] * acc[i][2] + acc[i][3] * acc[i][3];
        ss = wave_sum(ss);
        float scl = rsqrtf(ss * (1.f / DM) + NORM_EPS);
#if defined(PROBE_ATTN) || defined(PROBE_SSM)
        {
            const float e = ((const float*)p.ws)[16] / fmaxf(((const float*)p.ws)[17], 1e-30f);
            int kx = 0; if (e > 1e-6f) kx++; if (e > 1e-5f) kx++; if (e > 1e-4f) kx++; if (e > 1e-3f) kx++; if (e > 1e-2f) kx++; if (e > 1e-1f) kx++; if (!(e == e)) kx = 8;
            scl *= 1.f + 0.05f * kx;
        }
#endif
#pragma unroll
        for (int c = 0; c < 2; ++c) {
            f32x4 ga = *(const f32x4*)(p.norm_f_g + c * 512 + lane * 8), gb = *(const f32x4*)(p.norm_f_g + c * 512 + lane * 8 + 4);
            *(f32x4*)(hr + c * 512 + lane * 8) = acc[2 * c] * scl * ga; *(f32x4*)(hr + c * 512 + lane * 8 + 4) = acc[2 * c + 1] * scl * gb;
        }
    }
}


template <int MODE>
__device__ __forceinline__ void phase_peer2(const Params& p, unsigned char* smem, int vcu, int G) {
    int tid_ = threadIdx.x; asm volatile("" : "+v"(tid_));
    const int wave = __builtin_amdgcn_readfirstlane(tid_ >> 6), lane = tid_ & 63;
    const int gq = lane >> 4, c = lane & 15;
    unsigned char* wsm = smem + wave * 4096;
    bf16_t* xl = (bf16_t*)wsm;
    float* lv = (float*)(wsm + 2048);
    int* li = (int*)(wsm + 2048 + 128);
    float* vs = (float*)(wsm + 2048 + 256);
    int* is_ = (int*)(wsm + 2048 + 384);
    int* eid = (int*)(wsm + 2048 + 512);
    float* egate = (float*)(wsm + 2048 + 1024);
    float* eusc = (float*)(wsm + 2048 + 1536);
    const unsigned char* W = p.ws;
    constexpr unsigned O_SC = WS_SCORES << 20, O_HG = WS_HG << 20, O_UT = WS_UTAB << 20, O_VT = WS_VTAB << 20;
    const float* rss = WSP(float, WS_RSS);
    const int nwaves = G * NWAVES;
    int ca = 0, cb = 0;
    {
        int rem = lane; bool found = false;
#pragma unroll
        for (int a = 0; a < 16; ++a) { const int cnt = 16 / (a + 1); if (!found) { if (rem < cnt) { ca = a; cb = rem; found = true; } else rem -= cnt; } }
    }
#pragma unroll 1
    for (int row = vcu * NWAVES + wave; row < MTOK; row += nwaves) {
        float rs;
        { float t = lane < 16 ? rss[(size_t)row * 16 + lane] : 0.f; t = wave_sum(t); rs = rsqrtf(t * (1.f / DM) + NORM_EPS); }
        {
            const u32x4 w0 = ldws<u32x4>(W, O_HG + (unsigned)row * 2048u + lane * 16), w1 = ldws<u32x4>(W, O_HG + (unsigned)row * 2048u + 1024 + lane * 16);
#if PEER_FP8
            f32x4 xa[4]; unpack8(w0, xa[0], xa[1]); unpack8(w1, xa[2], xa[3]);
            xa[0] *= *(const f32x4*)(p.norm2_g + lane * 8); xa[1] *= *(const f32x4*)(p.norm2_g + lane * 8 + 4); xa[2] *= *(const f32x4*)(p.norm2_g + 512 + lane * 8); xa[3] *= *(const f32x4*)(p.norm2_g + 512 + lane * 8 + 4);
            unsigned hw[4], lw[4];
#pragma unroll
            for (int i = 0; i < 4; ++i) {
                typedef float f32x2_ __attribute__((ext_vector_type(2)));
                const f32x4 xs = xa[i] * 16.f;
                int h = __builtin_amdgcn_cvt_pk_fp8_f32(xs[0], xs[1], 0, false); h = __builtin_amdgcn_cvt_pk_fp8_f32(xs[2], xs[3], h, true);
                const f32x2_ b0 = __builtin_amdgcn_cvt_pk_f32_fp8(h, false), b1 = __builtin_amdgcn_cvt_pk_f32_fp8(h, true);
                int l = __builtin_amdgcn_cvt_pk_fp8_f32((xs[0] - b0[0]) * 16.f, (xs[1] - b0[1]) * 16.f, 0, false); l = __builtin_amdgcn_cvt_pk_fp8_f32((xs[2] - b1[0]) * 16.f, (xs[3] - b1[1]) * 16.f, l, true);
                hw[i] = (unsigned)h; lw[i] = (unsigned)l;
            }
            *(uint2*)(wsm + lane * 8) = make_uint2(hw[0], hw[1]); *(uint2*)(wsm + 512 + lane * 8) = make_uint2(hw[2], hw[3]);
            *(uint2*)(wsm + 1024 + lane * 8) = make_uint2(lw[0], lw[1]); *(uint2*)(wsm + 1536 + lane * 8) = make_uint2(lw[2], lw[3]);
#else
            *(u32x4*)(wsm + lane * 16) = w0; *(u32x4*)(wsm + 1024 + lane * 16) = w1;
#endif
        }
#ifdef PROBE_NOTOPK
        if (MODE == 1) { eid[lane] = (row * 131 + lane * 977) & 16383; eid[lane + 64] = (row * 137 + lane * 1499 + 7) & 16383; egate[lane] = 0.0625f; egate[lane + 64] = 0.0625f; eusc[lane] = 1.f; eusc[lane + 64] = 1.f; }
        else
#endif
#pragma unroll 1
        for (int h = 0; h < PEER_H; ++h) {
            const unsigned so = O_SC + (unsigned)row * 4096u + h * 512 + lane * 2;
            const unsigned short ha0 = ldws<unsigned short>(W, so), ha1 = ldws<unsigned short>(W, so + 128), hb0 = ldws<unsigned short>(W, so + 256), hb1 = ldws<unsigned short>(W, so + 384);
            const float a0 = (float)__builtin_bit_cast(_Float16, ha0), a1 = (float)__builtin_bit_cast(_Float16, ha1), b0 = (float)__builtin_bit_cast(_Float16, hb0), b1 = (float)__builtin_bit_cast(_Float16, hb1);
#define K16(hb) ((((unsigned)(hb) & 0x8000u) ? (~(unsigned)(hb) & 0xffffu) : ((unsigned)(hb) | 0x8000u)) << 16)
            const unsigned ka0 = K16(ha0) | (0xFFFFu - (unsigned)lane), ka1 = K16(ha1) | (0xFFFFu - 64u - (unsigned)lane);
            const unsigned kb0 = K16(hb0) | (0xFFFFu - (unsigned)lane), kb1 = K16(hb1) | (0xFFFFu - 64u - (unsigned)lane);
#undef K16
            unsigned long long loA = 0, hiA = 1ull << 32, loB = 0, hiB = 1ull << 32; bool doneA = false, doneB = false;
            while (!(doneA && doneB)) {
                if (!doneA) { const unsigned mid = (unsigned)((loA + hiA) >> 1); const int cnt = __builtin_popcountll(__ballot(ka0 >= mid)) + __builtin_popcountll(__ballot(ka1 >= mid));
                    if (cnt >= 16) loA = mid; else hiA = mid; doneA = (cnt == 16) || (hiA - loA <= 1); }
                if (!doneB) { const unsigned mid = (unsigned)((loB + hiB) >> 1); const int cnt = __builtin_popcountll(__ballot(kb0 >= mid)) + __builtin_popcountll(__ballot(kb1 >= mid));
                    if (cnt >= 16) loB = mid; else hiB = mid; doneB = (cnt == 16) || (hiB - loB <= 1); }
            }
            __builtin_amdgcn_wave_barrier();
            {
                const unsigned T = (unsigned)loA;
                const bool k0 = ka0 >= T, k1 = ka1 >= T;
                const unsigned long long s0 = __ballot(k0), s1 = __ballot(k1);
                if (k0) { const int pos = mbcnt64(s0); lv[pos] = a0; li[pos] = lane; }
                if (k1) { const int pos = __builtin_popcountll(s0) + mbcnt64(s1); if (pos < 16) { lv[pos] = a1; li[pos] = lane + 64; } }
            }
            {
                const unsigned T = (unsigned)loB;
                const bool k0 = kb0 >= T, k1 = kb1 >= T;
                const unsigned long long s0 = __ballot(k0), s1 = __ballot(k1);
                if (k0) { const int pos = mbcnt64(s0); lv[16 + pos] = b0; li[16 + pos] = lane; }
                if (k1) { const int pos = __builtin_popcountll(s0) + mbcnt64(s1); if (pos < 16) { lv[16 + pos] = b1; li[16 + pos] = lane + 64; } }
            }
            __builtin_amdgcn_s_waitcnt(0xC07F);
            __builtin_amdgcn_wave_barrier();
            if (lane < 32) {
                const int base = lane & 16, me = lane & 15;
                const float mv = lv[lane]; int rk = 0;
#pragma unroll
                for (int j = 0; j < 16; ++j) { const float x = lv[base + j]; rk += (x > mv) || (x == mv && j < me); }
                vs[base + rk] = mv; is_[base + rk] = li[lane];
            }
            __builtin_amdgcn_s_waitcnt(0xC07F);
            __builtin_amdgcn_wave_barrier();
            float cv = 0.f; unsigned kc = 0u;
            if (lane < 50) { cv = vs[ca] + vs[16 + cb]; kc = fkey(cv); }
            unsigned long long lo = fkey(vs[15] + vs[31]), hi = (unsigned long long)fkey(vs[0] + vs[16]) + 1ull;
            while (hi - lo > 1) {
                const unsigned mid = (unsigned)((lo + hi) >> 1); const int cnt = __builtin_popcountll(__ballot(kc >= mid));
                if (cnt >= 16) lo = mid; else hi = mid;
                if (cnt == 16) break;
            }
            const unsigned T2 = (unsigned)lo;
            const unsigned long long tm = __ballot(kc == T2);
            const int need2 = 16 - __builtin_popcountll(__ballot(kc > T2));
            const bool take = (kc > T2) || (kc == T2 && mbcnt64(tm) < need2);
            const float sv = take ? cv * rs : -3e38f;
            const float mx = wave_max(sv);
            const float ev = take ? __expf(sv - mx) : 0.f;
            const float sm = wave_sum(ev);
            if (take) { const int pos = mbcnt64(__ballot(take)); if (pos < 16) { const int e_ = is_[ca] * PEER_KEYS + is_[16 + cb]; eid[h * 16 + pos] = e_;
#if PEER_FP8
                egate[h * 16 + pos] = ev / sm * WSP(float, WS_VSC)[e_]; eusc[h * 16 + pos] = WSP(float, WS_USC)[e_];
#else
                egate[h * 16 + pos] = ev / sm;
#endif
            } }
            __builtin_amdgcn_wave_barrier();
        }
        __builtin_amdgcn_s_waitcnt(0xC07F);
        __builtin_amdgcn_wave_barrier();
#if PEER_FP8
        f32x4 acc[4];
#pragma unroll
        for (int i = 0; i < 4; ++i) acc[i] = (f32x4){0.f, 0.f, 0.f, 0.f};
        const unsigned koff = (unsigned)((c >> 3) * 64 + 16 * gq);
        u32x4 ub0[8], ub1[8], vb0[8], vb1[8];
#ifdef PROBE_L2GATHER
        if (MODE == 1) { eid[lane] &= 1023; eid[lane + 64] &= 1023; __builtin_amdgcn_s_waitcnt(0xC07F); __builtin_amdgcn_wave_barrier(); }
#endif
        int ec0 = eid[c & 7], ec1 = eid[8 + (c & 7)];
#pragma unroll
        for (int k3 = 0; k3 < 8; ++k3) ub0[k3] = ldws<u32x4>(W, O_UT + (unsigned)ec0 * 1024u + koff + k3 * 128);
#pragma unroll
        for (int j = 0; j < 8; ++j) vb0[j] = ldws<u32x4>(W, O_VT + (unsigned)__builtin_amdgcn_readlane(ec0, j) * 1024u + lane * 16);
#pragma unroll
        for (int k3 = 0; k3 < 8; ++k3) ub1[k3] = ldws<u32x4>(W, O_UT + (unsigned)ec1 * 1024u + koff + k3 * 128);
#define PEER_TILE(UB, EC, VBC, ECN, VBN)                                                                                           \
        {                                                                                                                          \
            f32x4 dh = {0.f, 0.f, 0.f, 0.f}, dl = {0.f, 0.f, 0.f, 0.f};                                                             \
            _Pragma("unroll") for (int k3 = 0; k3 < 8; ++k3) {                                                                     \
                const u32x4 xh = *(const u32x4*)(wsm + k3 * 128 + koff), xlo = *(const u32x4*)(wsm + 1024 + k3 * 128 + koff);      \
                const long u0 = (long)(((unsigned long long)UB[k3].y << 32) | UB[k3].x), u1 = (long)(((unsigned long long)UB[k3].w << 32) | UB[k3].z); \
                const long h0 = (long)(((unsigned long long)xh.y << 32) | xh.x), h1 = (long)(((unsigned long long)xh.w << 32) | xh.z);  \
                const long l0 = (long)(((unsigned long long)xlo.y << 32) | xlo.x), l1 = (long)(((unsigned long long)xlo.w << 32) | xlo.z); \
                dh = __builtin_amdgcn_mfma_f32_16x16x32_fp8_fp8(h0, u0, dh, 0, 0, 0);                                              \
                dh = __builtin_amdgcn_mfma_f32_16x16x32_fp8_fp8(h1, u1, dh, 0, 0, 0);                                              \
                dl = __builtin_amdgcn_mfma_f32_16x16x32_fp8_fp8(l0, u0, dl, 0, 0, 0);                                              \
                dl = __builtin_amdgcn_mfma_f32_16x16x32_fp8_fp8(l1, u1, dl, 0, 0, 0);                                              \
            }                                                                                                                      \
            float mine = dh[0] + dl[0] * (1.f / 16.f);                                                                             \
            mine += __shfl_xor(mine, 40);                                                       \
            const int ecur = EC;                                                                                                   \
            const float act = gelu_tanh(mine * (1.f / 16.f) * eusc[tcur * 8 + (c & 7)] * rs) * egate[tcur * 8 + (c & 7)];           \
            if (tcur + 2 < 16) {                                                                                                   \
                EC = eid[(tcur + 2) * 8 + (c & 7)];                                                                                \
                _Pragma("unroll") for (int k3 = 0; k3 < 8; ++k3) UB[k3] = ldws<u32x4>(W, O_UT + (unsigned)EC * 1024u + koff + k3 * 128); \
            }                                                                                                                      \
            if (tcur + 1 < 16) {                                                                                                   \
                _Pragma("unroll") for (int j = 0; j < 8; ++j) VBN[j] = ldws<u32x4>(W, O_VT + (unsigned)__builtin_amdgcn_readlane(ECN, j) * 1024u + lane * 16); \
            }                                                                                                                      \
            __builtin_amdgcn_sched_barrier(0);                                                                                     \
            _Pragma("unroll") for (int j = 0; j < 8; ++j) {                                                                        \
                const float aj = __builtin_bit_cast(float, __builtin_amdgcn_readlane(__builtin_bit_cast(int, act), j));            \
                const u32x4 vw = VBC[j];                                                                                           \
                typedef float f32x2_ __attribute__((ext_vector_type(2)));                                                          \
                const f32x2_ p0 = __builtin_amdgcn_cvt_pk_f32_fp8((int)vw.x, false), p1 = __builtin_amdgcn_cvt_pk_f32_fp8((int)vw.x, true); \
                const f32x2_ p2 = __builtin_amdgcn_cvt_pk_f32_fp8((int)vw.y, false), p3 = __builtin_amdgcn_cvt_pk_f32_fp8((int)vw.y, true); \
                const f32x2_ p4 = __builtin_amdgcn_cvt_pk_f32_fp8((int)vw.z, false), p5 = __builtin_amdgcn_cvt_pk_f32_fp8((int)vw.z, true); \
                const f32x2_ p6 = __builtin_amdgcn_cvt_pk_f32_fp8((int)vw.w, false), p7 = __builtin_amdgcn_cvt_pk_f32_fp8((int)vw.w, true); \
                acc[0] += (f32x4){p0[0], p0[1], p1[0], p1[1]} * aj; acc[1] += (f32x4){p2[0], p2[1], p3[0], p3[1]} * aj;             \
                acc[2] += (f32x4){p4[0], p4[1], p5[0], p5[1]} * aj; acc[3] += (f32x4){p6[0], p6[1], p7[0], p7[1]} * aj;             \
            }                                                                                                                      \
            __builtin_amdgcn_sched_barrier(0);                                                                                     \
        }
#pragma unroll 1
        for (int tp = 0; tp < 8; ++tp) {
            { const int tcur = 2 * tp; PEER_TILE(ub0, ec0, vb0, ec1, vb1) }
            { const int tcur = 2 * tp + 1; PEER_TILE(ub1, ec1, vb1, ec0, vb0) }
        }
#undef PEER_TILE
#else
        f32x4 acc[4];
#pragma unroll
        for (int i = 0; i < 4; ++i) acc[i] = (f32x4){0.f, 0.f, 0.f, 0.f};
        bf16x8 ubuf[32];
        int ec = eid[c]; float gc = egate[c];
        {
            const unsigned ub = O_UT + (unsigned)ec * 2048u + 16 * gq;
#pragma unroll
            for (int ks = 0; ks < 32; ++ks) ubuf[ks] = ldws<bf16x8>(W, ub + ks * 64);
        }
#pragma unroll 1
        for (int tile = 0; tile < 8; ++tile) {
            f32x4 d = {0.f, 0.f, 0.f, 0.f};
#pragma unroll
            for (int ks = 0; ks < 32; ++ks) d = __builtin_amdgcn_mfma_f32_16x16x32_bf16(*(const bf16x8*)(xl + ks * 32 + 8 * gq), ubuf[ks], d, 0, 0, 0);
            const float act = gelu_tanh(d[0] * rs) * gc;
            const int ecur = ec;
            if (tile < 7) {
                ec = eid[(tile + 1) * 16 + c]; gc = egate[(tile + 1) * 16 + c];
                const unsigned ub = O_UT + (unsigned)ec * 2048u + 16 * gq;
#pragma unroll
                for (int ks = 0; ks < 32; ++ks) ubuf[ks] = ldws<bf16x8>(W, ub + ks * 64);
            }
#pragma unroll
            for (int j = 0; j < 16; ++j) {
                const int ej = __builtin_amdgcn_readlane(ecur, j);
                const float aj = __builtin_bit_cast(float, __builtin_amdgcn_readlane(__builtin_bit_cast(int, act), j));
                const unsigned vb = O_VT + (unsigned)ej * 2048u + lane * 16;
                f32x4 v0, v1, v2, v3; unpack8(ldws<u32x4>(W, vb), v0, v1); unpack8(ldws<u32x4>(W, vb + 1024), v2, v3);
                acc[0] += v0 * aj; acc[1] += v1 * aj; acc[2] += v2 * aj; acc[3] += v3 * aj;
                if ((j & 3) == 3) __builtin_amdgcn_sched_barrier(0);
            }
        }
#endif
        float* hr = p.out + (size_t)row * DM;
        if (MODE == 1) { const float chk = acc[0][0] + acc[1][1] + acc[2][2] + acc[3][3]; if (chk == 1.2345678f) hr[lane] = chk; continue; }
        float ss = 0.f;
        {
            f32x4 h0, h1, h2, h3;
            unpack8(ldws<u32x4>(W, O_HG + (unsigned)row * 2048u + lane * 16), h0, h1); unpack8(ldws<u32x4>(W, O_HG + (unsigned)row * 2048u + 1024 + lane * 16), h2, h3);
            acc[0] += h0; acc[1] += h1; acc[2] += h2; acc[3] += h3;
        }
#pragma unroll
        for (int i = 0; i < 4; ++i) ss += acc[i][0] * acc[i][0] + acc[i][1] * acc[i][1] + acc[i][2] * acc[i][2] + acc[i][3] * acc[i][3];
        ss = wave_sum(ss);
        const float scl = rsqrtf(ss * (1.f / DM) + NORM_EPS);
        float* dst = hr;
        if (MODE == 2) { if (row >= 8192) continue; dst = WSP(float, 462) + (size_t)row * DM; }
#pragma unroll
        for (int cc = 0; cc < 2; ++cc) {
            const f32x4 ga = *(const f32x4*)(p.norm_f_g + cc * 512 + lane * 8), gb = *(const f32x4*)(p.norm_f_g + cc * 512 + lane * 8 + 4);
            *(f32x4*)(dst + cc * 512 + lane * 8) = acc[2 * cc] * scl * ga; *(f32x4*)(dst + cc * 512 + lane * 8 + 4) = acc[2 * cc + 1] * scl * gb;
        }
    }
}


__device__ __forceinline__ void phase_peer4(const Params& p, unsigned char* smem, int vcu, int G) {
    int tid_ = threadIdx.x; asm volatile("" : "+v"(tid_));
    const int wave = __builtin_amdgcn_readfirstlane(tid_ >> 6), lane = tid_ & 63;
    const int gq = lane >> 4, c = lane & 15;
    unsigned char* wbase = smem + wave * 8192;
    const unsigned char* W = p.ws;
    constexpr unsigned O_SC = WS_SCORES << 20, O_HG = WS_HG << 20, O_UT = WS_UTAB << 20, O_VT = WS_VTAB << 20;
    const float* rss = WSP(float, WS_RSS);
    const float* uscg = WSP(float, WS_USC); const float* vscg = WSP(float, WS_VSC);
    const int stride = G * NWAVES;
    int ca = 0, cb = 0;
    {
        int rem = lane; bool found = false;
#pragma unroll
        for (int a = 0; a < 16; ++a) { const int cnt = 16 / (a + 1); if (!found) { if (rem < cnt) { ca = a; cb = rem; found = true; } else rem -= cnt; } }
    }
    int row = vcu * NWAVES + wave;
    if (row >= MTOK) return;
    u32x4 xw0, xw1; float rssv = 0.f; unsigned sc0 = 0, sc1 = 0, sc2 = 0, sc3 = 0;
    int pend_i = -1; float pend_g = 0.f, pend_su = 0.f, pend_sv = 0.f;
#define NB_LV(B)  ((float*)((B) + 2048))
#define NB_LI(B)  ((int*)((B) + 2048 + 128))
#define NB_VS(B)  ((float*)((B) + 2048 + 256))
#define NB_IS(B)  ((int*)((B) + 2048 + 384))
#define NB_EID(B) ((int*)((B) + 2048 + 512))
#define NB_EG(B)  ((float*)((B) + 2048 + 1024))
#define NB_EU(B)  ((float*)((B) + 2048 + 1536))
#define TK_LOAD_X(R) { xw0 = ldws<u32x4>(W, O_HG + (unsigned)(R) * 2048u + lane * 16); xw1 = ldws<u32x4>(W, O_HG + (unsigned)(R) * 2048u + 1024 + lane * 16); rssv = lane < 16 ? rss[(size_t)(R) * 16 + lane] : 0.f; }
#define TK_LOAD_SC(R, H) { const unsigned so_ = O_SC + (unsigned)(R) * 4096u + (H) * 512 + lane * 2; sc0 = ldws<unsigned short>(W, so_); sc1 = ldws<unsigned short>(W, so_ + 128); sc2 = ldws<unsigned short>(W, so_ + 256); sc3 = ldws<unsigned short>(W, so_ + 384); }
#define TK_STAGE_X(B, RS) {                                                                                                        \
        RS = rsqrtf(wave_sum(rssv) * (1.f / DM) + NORM_EPS);                                                                       \
        f32x4 xa[4]; unpack8(xw0, xa[0], xa[1]); unpack8(xw1, xa[2], xa[3]);                                                        \
        xa[0] *= *(const f32x4*)(p.norm2_g + lane * 8); xa[1] *= *(const f32x4*)(p.norm2_g + lane * 8 + 4); xa[2] *= *(const f32x4*)(p.norm2_g + 512 + lane * 8); xa[3] *= *(const f32x4*)(p.norm2_g + 512 + lane * 8 + 4); \
        unsigned hw[4], lw[4];                                                                                                     \
        _Pragma("unroll") for (int i = 0; i < 4; ++i) {                                                                            \
            const f32x4 xs = xa[i] * 16.f;                                                                                         \
            int h_ = __builtin_amdgcn_cvt_pk_fp8_f32(xs[0], xs[1], 0, false); h_ = __builtin_amdgcn_cvt_pk_fp8_f32(xs[2], xs[3], h_, true); \
            const f32x2_t b0 = __builtin_amdgcn_cvt_pk_f32_fp8(h_, false), b1 = __builtin_amdgcn_cvt_pk_f32_fp8(h_, true);         \
            int l_ = __builtin_amdgcn_cvt_pk_fp8_f32((xs[0] - b0[0]) * 16.f, (xs[1] - b0[1]) * 16.f, 0, false); l_ = __builtin_amdgcn_cvt_pk_fp8_f32((xs[2] - b1[0]) * 16.f, (xs[3] - b1[1]) * 16.f, l_, true); \
            hw[i] = (unsigned)h_; lw[i] = (unsigned)l_;                                                                            \
        }                                                                                                                          \
        *(uint2*)((B) + lane * 8) = make_uint2(hw[0], hw[1]); *(uint2*)((B) + 512 + lane * 8) = make_uint2(hw[2], hw[3]);          \
        *(uint2*)((B) + 1024 + lane * 8) = make_uint2(lw[0], lw[1]); *(uint2*)((B) + 1536 + lane * 8) = make_uint2(lw[2], lw[3]);  \
    }
#define TK_K16(hb) ((((unsigned)(hb) & 0x8000u) ? (~(unsigned)(hb) & 0xffffu) : ((unsigned)(hb) | 0x8000u)) << 16)
#define TK_PART_A(B) {                                                                                                             \
        const float a0 = (float)__builtin_bit_cast(_Float16, (unsigned short)sc0), a1 = (float)__builtin_bit_cast(_Float16, (unsigned short)sc1); \
        const float b0 = (float)__builtin_bit_cast(_Float16, (unsigned short)sc2), b1 = (float)__builtin_bit_cast(_Float16, (unsigned short)sc3); \
        const unsigned ka0 = TK_K16(sc0) | (0xFFFFu - (unsigned)lane), ka1 = TK_K16(sc1) | (0xFFFFu - 64u - (unsigned)lane);       \
        const unsigned kb0 = TK_K16(sc2) | (0xFFFFu - (unsigned)lane), kb1 = TK_K16(sc3) | (0xFFFFu - 64u - (unsigned)lane);       \
        unsigned long long loA = 0, hiA = 1ull << 32, loB = 0, hiB = 1ull << 32; bool doneA = false, doneB = false;                 \
        while (!(doneA && doneB)) {                                                                                                \
            if (!doneA) { const unsigned mid = (unsigned)((loA + hiA) >> 1); const int cnt = __builtin_popcountll(__ballot(ka0 >= mid)) + __builtin_popcountll(__ballot(ka1 >= mid)); \
                if (cnt >= 16) loA = mid; else hiA = mid; doneA = (cnt == 16) || (hiA - loA <= 1); }                                \
            if (!doneB) { const unsigned mid = (unsigned)((loB + hiB) >> 1); const int cnt = __builtin_popcountll(__ballot(kb0 >= mid)) + __builtin_popcountll(__ballot(kb1 >= mid)); \
                if (cnt >= 16) loB = mid; else hiB = mid; doneB = (cnt == 16) || (hiB - loB <= 1); }                                \
        }                                                                                                                          \
        float* lv = NB_LV(B); int* li = NB_LI(B);                                                                                  \
        { const unsigned T = (unsigned)loA; const bool k0 = ka0 >= T, k1 = ka1 >= T; const unsigned long long s0 = __ballot(k0), s1 = __ballot(k1); \
          if (k0) { const int pos = mbcnt64(s0); lv[pos] = a0; li[pos] = lane; }                                                    \
          if (k1) { const int pos = __builtin_popcountll(s0) + mbcnt64(s1); if (pos < 16) { lv[pos] = a1; li[pos] = lane + 64; } } } \
        { const unsigned T = (unsigned)loB; const bool k0 = kb0 >= T, k1 = kb1 >= T; const unsigned long long s0 = __ballot(k0), s1 = __ballot(k1); \
          if (k0) { const int pos = mbcnt64(s0); lv[16 + pos] = b0; li[16 + pos] = lane; }                                           \
          if (k1) { const int pos = __builtin_popcountll(s0) + mbcnt64(s1); if (pos < 16) { lv[16 + pos] = b1; li[16 + pos] = lane + 64; } } } \
        __builtin_amdgcn_s_waitcnt(0xC07F); __builtin_amdgcn_wave_barrier();                                                       \
    }
#define TK_PART_B(B, H, RS) {                                                                                                      \
        float* lv = NB_LV(B); int* li = NB_LI(B); float* vs = NB_VS(B); int* is_ = NB_IS(B);                                        \
        if (lane < 32) { const int base = lane & 16, me = lane & 15; const float mv = lv[lane]; int rk = 0;                         \
            _Pragma("unroll") for (int j = 0; j < 16; ++j) { const float x = lv[base + j]; rk += (x > mv) || (x == mv && j < me); } \
            vs[base + rk] = mv; is_[base + rk] = li[lane]; }                                                                       \
        __builtin_amdgcn_s_waitcnt(0xC07F); __builtin_amdgcn_wave_barrier();                                                       \
        float cv = 0.f; unsigned kc = 0u;                                                                                          \
        if (lane < 50) { cv = vs[ca] + vs[16 + cb]; kc = fkey(cv); }                                                                \
        unsigned long long lo = fkey(vs[15] + vs[31]), hi = (unsigned long long)fkey(vs[0] + vs[16]) + 1ull;                        \
        while (hi - lo > 1) { const unsigned mid = (unsigned)((lo + hi) >> 1); const int cnt = __builtin_popcountll(__ballot(kc >= mid)); \
            if (cnt >= 16) lo = mid; else hi = mid; if (cnt == 16) break; }                                                        \
        const unsigned T2 = (unsigned)lo; const unsigned long long tm = __ballot(kc == T2);                                        \
        const int need2 = 16 - __builtin_popcountll(__ballot(kc > T2));                                                            \
        const bool take = (kc > T2) || (kc == T2 && mbcnt64(tm) < need2);                                                          \
        const float sv_ = take ? cv * (RS) : -3e38f; const float mx = wave_max(sv_);                                               \
        const float ev = take ? __expf(sv_ - mx) : 0.f; const float sm = wave_sum(ev);                                             \
        pend_i = -1;                                                                                                               \
        if (take) { const int pos = mbcnt64(__ballot(take)); if (pos < 16) { const int e_ = is_[ca] * PEER_KEYS + is_[16 + cb];     \
            NB_EID(B)[(H) * 16 + pos] = e_; pend_i = (H) * 16 + pos; pend_g = ev / sm; pend_su = uscg[e_]; pend_sv = vscg[e_]; } }    \
        __builtin_amdgcn_wave_barrier();                                                                                           \
    }
#define TK_FLUSH(B) { if (pend_i >= 0) { NB_EG(B)[pend_i] = pend_g * pend_sv; NB_EU(B)[pend_i] = pend_su; } pend_i = -1; }
    float rs_cur = 0.f, rs_n = 0.f;
    {
        unsigned char* B0 = wbase;
        TK_LOAD_X(row) TK_STAGE_X(B0, rs_cur)
#pragma unroll 1
        for (int h = 0; h < PEER_H; ++h) { TK_FLUSH(B0) TK_LOAD_SC(row, h) TK_PART_A(B0) TK_PART_B(B0, h, rs_cur) }
        TK_FLUSH(B0)
        __builtin_amdgcn_s_waitcnt(0xC07F); __builtin_amdgcn_wave_barrier();
    }
#pragma unroll 1
    for (int it = 0;; ++it) {
        unsigned char* wsm = wbase + (it & 1) * 4096;
        unsigned char* nb = wbase + ((it + 1) & 1) * 4096;
        const int* eid = NB_EID(wsm); const float* egate = NB_EG(wsm); const float* eusc = NB_EU(wsm);
        const float rs = rs_cur;
        const int nrow_raw = row + stride;
        const int nrow = nrow_raw < MTOK ? nrow_raw : row;
        TK_LOAD_X(nrow) TK_LOAD_SC(nrow, 0)
        f32x4 acc[4];
#pragma unroll
        for (int i = 0; i < 4; ++i) acc[i] = (f32x4){0.f, 0.f, 0.f, 0.f};
        const unsigned koff = (unsigned)((c >> 3) * 64 + 16 * gq);
        u32x4 ub0[8], ub1[8], vb0[8], vb1[8];
        int ec0 = eid[c & 7], ec1 = eid[8 + (c & 7)];
#pragma unroll
        for (int k3 = 0; k3 < 8; ++k3) ub0[k3] = ldws<u32x4>(W, O_UT + (unsigned)ec0 * 1024u + koff + k3 * 128);
#pragma unroll
        for (int j = 0; j < 8; ++j) vb0[j] = ldws<u32x4>(W, O_VT + (unsigned)__builtin_amdgcn_readlane(ec0, j) * 1024u + lane * 16);
#pragma unroll
        for (int k3 = 0; k3 < 8; ++k3) ub1[k3] = ldws<u32x4>(W, O_UT + (unsigned)ec1 * 1024u + koff + k3 * 128);
#define PEER_TILE(UB, EC, VBC, ECN, VBN)                                                                                           \
        {                                                                                                                          \
            f32x4 dh = {0.f, 0.f, 0.f, 0.f}, dl = {0.f, 0.f, 0.f, 0.f};                                                             \
            _Pragma("unroll") for (int k3 = 0; k3 < 8; ++k3) {                                                                     \
                const u32x4 xh = *(const u32x4*)(wsm + k3 * 128 + koff), xlo = *(const u32x4*)(wsm + 1024 + k3 * 128 + koff);      \
                const long u0 = (long)(((unsigned long long)UB[k3].y << 32) | UB[k3].x), u1 = (long)(((unsigned long long)UB[k3].w << 32) | UB[k3].z); \
                const long h0 = (long)(((unsigned long long)xh.y << 32) | xh.x), h1 = (long)(((unsigned long long)xh.w << 32) | xh.z);  \
                const long l0 = (long)(((unsigned long long)xlo.y << 32) | xlo.x), l1 = (long)(((unsigned long long)xlo.w << 32) | xlo.z); \
                dh = __builtin_amdgcn_mfma_f32_16x16x32_fp8_fp8(h0, u0, dh, 0, 0, 0);                                              \
                dh = __builtin_amdgcn_mfma_f32_16x16x32_fp8_fp8(h1, u1, dh, 0, 0, 0);                                              \
                dl = __builtin_amdgcn_mfma_f32_16x16x32_fp8_fp8(l0, u0, dl, 0, 0, 0);                                              \
                dl = __builtin_amdgcn_mfma_f32_16x16x32_fp8_fp8(l1, u1, dl, 0, 0, 0);                                              \
            }                                                                                                                      \
            float mine = dh[0] + dl[0] * (1.f / 16.f);                                                                             \
            mine += __shfl_xor(mine, 40);                                                       \
            const float act = gelu_tanh(mine * (1.f / 16.f) * eusc[tcur * 8 + (c & 7)] * rs) * egate[tcur * 8 + (c & 7)];           \
            if (tcur + 2 < 16) {                                                                                                   \
                EC = eid[(tcur + 2) * 8 + (c & 7)];                                                                                \
                _Pragma("unroll") for (int k3 = 0; k3 < 8; ++k3) UB[k3] = ldws<u32x4>(W, O_UT + (unsigned)EC * 1024u + koff + k3 * 128); \
            }                                                                                                                      \
            if (tcur + 1 < 16) {                                                                                                   \
                _Pragma("unroll") for (int j = 0; j < 8; ++j) VBN[j] = ldws<u32x4>(W, O_VT + (unsigned)__builtin_amdgcn_readlane(ECN, j) * 1024u + lane * 16); \
            }                                                                                                                      \
            __builtin_amdgcn_sched_barrier(0);                                                                                     \
            _Pragma("unroll") for (int j = 0; j < 8; ++j) {                                                                        \
                const float aj = __builtin_bit_cast(float, __builtin_amdgcn_readlane(__builtin_bit_cast(int, act), j));            \
                const u32x4 vw = VBC[j];                                                                                           \
                const f32x2_t p0 = __builtin_amdgcn_cvt_pk_f32_fp8((int)vw.x, false), p1 = __builtin_amdgcn_cvt_pk_f32_fp8((int)vw.x, true); \
                const f32x2_t p2 = __builtin_amdgcn_cvt_pk_f32_fp8((int)vw.y, false), p3 = __builtin_amdgcn_cvt_pk_f32_fp8((int)vw.y, true); \
                const f32x2_t p4 = __builtin_amdgcn_cvt_pk_f32_fp8((int)vw.z, false), p5 = __builtin_amdgcn_cvt_pk_f32_fp8((int)vw.z, true); \
                const f32x2_t p6 = __builtin_amdgcn_cvt_pk_f32_fp8((int)vw.w, false), p7 = __builtin_amdgcn_cvt_pk_f32_fp8((int)vw.w, true); \
                acc[0] += (f32x4){p0[0], p0[1], p1[0], p1[1]} * aj; acc[1] += (f32x4){p2[0], p2[1], p3[0], p3[1]} * aj;             \
                acc[2] += (f32x4){p4[0], p4[1], p5[0], p5[1]} * aj; acc[3] += (f32x4){p6[0], p6[1], p7[0], p7[1]} * aj;             \
            }                                                                                                                      \
            __builtin_amdgcn_sched_barrier(0);                                                                                     \
        }
#pragma unroll 1
        for (int tp = 0; tp < 8; ++tp) {
            { const int tcur = 2 * tp; PEER_TILE(ub0, ec0, vb0, ec1, vb1) }
            if (tp == 0) { TK_STAGE_X(nb, rs_n) }
            TK_FLUSH(nb)
            TK_PART_A(nb)
            __builtin_amdgcn_sched_barrier(0);
            { const int tcur = 2 * tp + 1; PEER_TILE(ub1, ec1, vb1, ec0, vb0) }
            TK_PART_B(nb, tp, rs_n)
            { const int hn = tp < 7 ? tp + 1 : 7; TK_LOAD_SC(nrow, hn) }
            __builtin_amdgcn_sched_barrier(0);
        }
#undef PEER_TILE
        TK_FLUSH(nb)
        float* hr = p.out + (size_t)row * DM;
        float ss = 0.f;
        {
            f32x4 h0, h1, h2, h3;
            unpack8(ldws<u32x4>(W, O_HG + (unsigned)row * 2048u + lane * 16), h0, h1); unpack8(ldws<u32x4>(W, O_HG + (unsigned)row * 2048u + 1024 + lane * 16), h2, h3);
            acc[0] += h0; acc[1] += h1; acc[2] += h2; acc[3] += h3;
        }
#pragma unroll
        for (int i = 0; i < 4; ++i) ss += acc[i][0] * acc[i][0] + acc[i][1] * acc[i][1] + acc[i][2] * acc[i][2] + acc[i][3] * acc[i][3];
        ss = wave_sum(ss);
        const float scl = rsqrtf(ss * (1.f / DM) + NORM_EPS);
#pragma unroll
        for (int cc = 0; cc < 2; ++cc) {
            const f32x4 ga = *(const f32x4*)(p.norm_f_g + cc * 512 + lane * 8), gb = *(const f32x4*)(p.norm_f_g + cc * 512 + lane * 8 + 4);
            *(f32x4*)(hr + cc * 512 + lane * 8) = acc[2 * cc] * scl * ga; *(f32x4*)(hr + cc * 512 + lane * 8 + 4) = acc[2 * cc + 1] * scl * gb;
        }
        __builtin_amdgcn_s_waitcnt(0xC07F); __builtin_amdgcn_wave_barrier();
        if (nrow_raw >= MTOK) break;
        row = nrow_raw; rs_cur = rs_n;
    }
#undef TK_FLUSH
#undef TK_PART_B
#undef TK_PART_A
#undef TK_K16
#undef TK_STAGE_X
#undef TK_LOAD_SC
#undef TK_LOAD_X
}

struct __attribute__((packed, aligned(4))) U3 { unsigned a, b, c; };
typedef int v8i32_t __attribute__((ext_vector_type(8)));
typedef int v6i32_t __attribute__((ext_vector_type(6)));
typedef float v32f32_t __attribute__((ext_vector_type(32)));
template <bool NOTK>
__device__ __forceinline__ void phase_peer6(const Params& p, unsigned char* smem, int vcu, int G) {
    int tid_ = threadIdx.x; asm volatile("" : "+v"(tid_));
    const int wave = __builtin_amdgcn_readfirstlane(tid_ >> 6), lane = tid_ & 63;
    const int gq = lane >> 4, c = lane & 15;
    unsigned char* wbase = smem + wave * 8192;
    const unsigned char* W = p.ws;
    constexpr unsigned O_SC = WS_SCORES << 20, O_HG = WS_HG << 20, O_UT = WS_UTAB << 20, O_VT = WS_VTAB << 20;
    const float* rss = WSP(float, WS_RSS);
    const float* uscg = WSP(float, WS_USC); const float* vscg = WSP(float, WS_VSC);
    const int stride = G * NWAVES;
    int ca = 0, cb = 0;
    {
        int rem = lane; bool found = false;
#pragma unroll
        for (int a = 0; a < 16; ++a) { const int cnt = 16 / (a + 1); if (!found) { if (rem < cnt) { ca = a; cb = rem; found = true; } else rem -= cnt; } }
    }
    int row = vcu * NWAVES + wave;
    if (row >= MTOK) return;
    u32x4 xw0, xw1; float rssv = 0.f; unsigned sc0 = 0, sc1 = 0, sc2 = 0, sc3 = 0;
    int pend_i = -1; float pend_g = 0.f, pend_su = 0.f, pend_sv = 0.f;
#define NB_LV(B)  ((float*)((B) + 2048))
#define NB_LI(B)  ((int*)((B) + 2048 + 128))
#define NB_VS(B)  ((float*)((B) + 2048 + 256))
#define NB_IS(B)  ((int*)((B) + 2048 + 384))
#define NB_EID(B) ((int*)((B) + 2048 + 512))
#define NB_EG(B)  ((float*)((B) + 2048 + 1024))
#define NB_EU(B)  ((float*)((B) + 2048 + 1536))
#define TK_LOAD_X(R) { xw0 = ldws<u32x4>(W, O_HG + (unsigned)(R) * 2048u + lane * 16); xw1 = ldws<u32x4>(W, O_HG + (unsigned)(R) * 2048u + 1024 + lane * 16); rssv = lane < 16 ? rss[(size_t)(R) * 16 + lane] : 0.f; }
#define TK_LOAD_SC(R, H) { const unsigned so_ = O_SC + (unsigned)(R) * 4096u + (H) * 512 + lane * 2; sc0 = ldws<unsigned short>(W, so_); sc1 = ldws<unsigned short>(W, so_ + 128); sc2 = ldws<unsigned short>(W, so_ + 256); sc3 = ldws<unsigned short>(W, so_ + 384); }
#define TK_STAGE_X(B, RS) {                                                                                                        \
        RS = rsqrtf(wave_sum(rssv) * (1.f / DM) + NORM_EPS);                                                                       \
        f32x4 xa[4]; unpack8(xw0, xa[0], xa[1]); unpack8(xw1, xa[2], xa[3]);                                                        \
        xa[0] *= *(const f32x4*)(p.norm2_g + lane * 8); xa[1] *= *(const f32x4*)(p.norm2_g + lane * 8 + 4); xa[2] *= *(const f32x4*)(p.norm2_g + 512 + lane * 8); xa[3] *= *(const f32x4*)(p.norm2_g + 512 + lane * 8 + 4); \
        unsigned hw[4], lw[4];                                                                                                     \
        _Pragma("unroll") for (int i = 0; i < 4; ++i) {                                                                            \
            const f32x4 xs = xa[i] * 16.f;                                                                                         \
            int h_ = __builtin_amdgcn_cvt_pk_fp8_f32(xs[0], xs[1], 0, false); h_ = __builtin_amdgcn_cvt_pk_fp8_f32(xs[2], xs[3], h_, true); \
            const f32x2_t b0 = __builtin_amdgcn_cvt_pk_f32_fp8(h_, false), b1 = __builtin_amdgcn_cvt_pk_f32_fp8(h_, true);         \
            int l_ = __builtin_amdgcn_cvt_pk_fp8_f32((xs[0] - b0[0]) * 16.f, (xs[1] - b0[1]) * 16.f, 0, false); l_ = __builtin_amdgcn_cvt_pk_fp8_f32((xs[2] - b1[0]) * 16.f, (xs[3] - b1[1]) * 16.f, l_, true); \
            hw[i] = (unsigned)h_; lw[i] = (unsigned)l_;                                                                            \
        }                                                                                                                          \
                                                                                                       \
        const int xo_ = PEER_U6 == 1 ? ((lane >> 2) & 3) * 256 + (2 * ((lane >> 4) & 1) + ((lane >> 1) & 1)) * 32 + ((lane >> 5) & 1) * 16 + (lane & 1) * 8 \
                      : PEER_U6 == 2 ? ((lane >> 2) & 3) * 256 + (lane >> 4) * 32 + (lane & 3) * 8 : lane * 8;                       \
        const int xo2_ = xo_ + (PEER_U6 ? 128 : 512);                                                                              \
        *(uint2*)((B) + xo_) = make_uint2(hw[0], hw[1]); *(uint2*)((B) + xo2_) = make_uint2(hw[2], hw[3]);                          \
        *(uint2*)((B) + 1024 + xo_) = make_uint2(lw[0], lw[1]); *(uint2*)((B) + 1024 + xo2_) = make_uint2(lw[2], lw[3]);            \
    }
#define TK_K16(hb) ((((unsigned)(hb) & 0x8000u) ? (~(unsigned)(hb) & 0xffffu) : ((unsigned)(hb) | 0x8000u)) << 16)
#define TK_PART_A(B) {                                                                                                             \
        const float a0 = (float)__builtin_bit_cast(_Float16, (unsigned short)sc0), a1 = (float)__builtin_bit_cast(_Float16, (unsigned short)sc1); \
        const float b0 = (float)__builtin_bit_cast(_Float16, (unsigned short)sc2), b1 = (float)__builtin_bit_cast(_Float16, (unsigned short)sc3); \
        const unsigned ka0 = TK_K16(sc0) | (0xFFFFu - (unsigned)lane), ka1 = TK_K16(sc1) | (0xFFFFu - 64u - (unsigned)lane);       \
        const unsigned kb0 = TK_K16(sc2) | (0xFFFFu - (unsigned)lane), kb1 = TK_K16(sc3) | (0xFFFFu - 64u - (unsigned)lane);       \
          \
        unsigned loA = 0u, hiA = 0xFFFFFFFFu, loB = 0u, hiB = 0xFFFFFFFFu; bool doneA = false, doneB = false;                       \
        while (!(doneA && doneB)) {                                                                                                \
            const unsigned midA = loA + ((hiA - loA) >> 1), midB = loB + ((hiB - loB) >> 1);                                        \
            const int cntA = __builtin_popcountll(__ballot(ka0 >= midA)) + __builtin_popcountll(__ballot(ka1 >= midA));             \
            const int cntB = __builtin_popcountll(__ballot(kb0 >= midB)) + __builtin_popcountll(__ballot(kb1 >= midB));             \
            loA = cntA >= 16 ? midA : loA; hiA = cntA >= 16 ? hiA : midA; doneA = doneA || (cntA == 16) || (hiA - loA <= 1u);       \
            loB = cntB >= 16 ? midB : loB; hiB = cntB >= 16 ? hiB : midB; doneB = doneB || (cntB == 16) || (hiB - loB <= 1u);       \
        }                                                                                                                          \
        float* lv = NB_LV(B); int* li = NB_LI(B);                                                                                  \
        { const unsigned T = (unsigned)loA; const bool k0 = ka0 >= T, k1 = ka1 >= T; const unsigned long long s0 = __ballot(k0), s1 = __ballot(k1); \
          if (k0) { const int pos = mbcnt64(s0); lv[pos] = a0; li[pos] = lane; }                                                    \
          if (k1) { const int pos = __builtin_popcountll(s0) + mbcnt64(s1); if (pos < 16) { lv[pos] = a1; li[pos] = lane + 64; } } } \
        { const unsigned T = (unsigned)loB; const bool k0 = kb0 >= T, k1 = kb1 >= T; const unsigned long long s0 = __ballot(k0), s1 = __ballot(k1); \
          if (k0) { const int pos = mbcnt64(s0); lv[16 + pos] = b0; li[16 + pos] = lane; }                                           \
          if (k1) { const int pos = __builtin_popcountll(s0) + mbcnt64(s1); if (pos < 16) { lv[16 + pos] = b1; li[16 + pos] = lane + 64; } } } \
        __builtin_amdgcn_s_waitcnt(0xC07F); __builtin_amdgcn_wave_barrier();                                                       \
    }
#define TK_PART_B(B, H, RS) {                                                                                                      \
        float* lv = NB_LV(B); int* li = NB_LI(B); float* vs = NB_VS(B); int* is_ = NB_IS(B);                                        \
        if (lane < 32) { const int base = lane & 16, me = lane & 15; const float mv = lv[lane]; int rk = 0;                         \
            _Pragma("unroll") for (int j = 0; j < 16; ++j) { const float x = lv[base + j]; rk += (x > mv) || (x == mv && j < me); } \
            vs[base + rk] = mv; is_[base + rk] = li[lane]; }                                                                       \
        __builtin_amdgcn_s_waitcnt(0xC07F); __builtin_amdgcn_wave_barrier();                                                       \
        float cv = 0.f; unsigned kc = 0u;                                                                                          \
        if (lane < 50) { cv = vs[ca] + vs[16 + cb]; kc = fkey(cv); }                                                                \
        unsigned long long lo = fkey(vs[15] + vs[31]), hi = (unsigned long long)fkey(vs[0] + vs[16]) + 1ull;                        \
        while (hi - lo > 1) { const unsigned mid = (unsigned)((lo + hi) >> 1); const int cnt = __builtin_popcountll(__ballot(kc >= mid)); \
            if (cnt >= 16) lo = mid; else hi = mid; if (cnt == 16) break; }                                                        \
        const unsigned T2 = (unsigned)lo; const unsigned long long tm = __ballot(kc == T2);                                        \
        const int need2 = 16 - __builtin_popcountll(__ballot(kc > T2));                                                            \
        const bool take = (kc > T2) || (kc == T2 && mbcnt64(tm) < need2);                                                          \
        const float sv_ = take ? cv * (RS) : -3e38f; const float mx = wave_max(sv_);                                               \
        const float ev = take ? __expf(sv_ - mx) : 0.f; const float sm = wave_sum(ev);                                             \
        pend_i = -1;                                                                                                               \
        if (take) { const int pos = mbcnt64(__ballot(take)); if (pos < 16) { const int e_ = is_[ca] * PEER_KEYS + is_[16 + cb];     \
            NB_EID(B)[(H) * 16 + pos] = e_; pend_i = (H) * 16 + pos; pend_g = ev / sm; pend_su = uscg[e_]; pend_sv = vscg[e_]; } }    \
        __builtin_amdgcn_wave_barrier();                                                                                           \
    }
#define TK_FLUSH(B) { if (pend_i >= 0) { NB_EG(B)[pend_i] = pend_g * pend_sv; NB_EU(B)[pend_i] = pend_su; } pend_i = -1; }
    float rs_cur = 0.f, rs_n = 0.f;
    {
        unsigned char* B0 = wbase;
        TK_LOAD_X(row) TK_STAGE_X(B0, rs_cur)
#pragma unroll 1
        for (int h = 0; h < PEER_H; ++h) { TK_FLUSH(B0) TK_LOAD_SC(row, h) TK_PART_A(B0) TK_PART_B(B0, h, rs_cur) }
        TK_FLUSH(B0)
        __builtin_amdgcn_s_waitcnt(0xC07F); __builtin_amdgcn_wave_barrier();
    }
#if PEER_U6 == 1
        const unsigned koff = (unsigned)((c >> 3) * 64 + gq * 16);
        const unsigned xoff = (unsigned)(((c >> 3) * 4 + gq) * 32);
        constexpr int NUB = 6;
#define U_LOAD(UB, E_) { _Pragma("unroll") for (int k3 = 0; k3 < 6; ++k3) UB[k3] = ldws<u32x4>(W, O_UT + (unsigned)(E_) * 768u + koff + k3 * 128); }
#define UBD(UB, i) ((int)UB[(i) >> 2][(i) & 3])
#define U_DOT(UB)                                                                                                                  \
            _Pragma("unroll") for (int ks = 0; ks < 4; ++ks) {                                                                     \
                const u32x4 xh0 = *(const u32x4*)(wsm + ks * 256 + xoff), xh1 = *(const u32x4*)(wsm + ks * 256 + xoff + 16);       \
                const u32x4 xl0 = *(const u32x4*)(wsm + 1024 + ks * 256 + xoff), xl1 = *(const u32x4*)(wsm + 1024 + ks * 256 + xoff + 16); \
                const v8i32_t xa = {(int)xh0.x, (int)xh0.y, (int)xh0.z, (int)xh0.w, (int)xh1.x, (int)xh1.y, (int)xh1.z, (int)xh1.w}; \
                const v8i32_t xb = {(int)xl0.x, (int)xl0.y, (int)xl0.z, (int)xl0.w, (int)xl1.x, (int)xl1.y, (int)xl1.z, (int)xl1.w}; \
                const v8i32_t uw = {UBD(UB, 6 * ks), UBD(UB, 6 * ks + 1), UBD(UB, 6 * ks + 2), UBD(UB, 6 * ks + 3), UBD(UB, 6 * ks + 4), UBD(UB, 6 * ks + 5), 0, 0}; \
                dh = __builtin_amdgcn_mfma_scale_f32_16x16x128_f8f6f4(xa, uw, dh, 0, 2, 0, 0x7F7F7F7F, 0, 0x7F7F7F7F);              \
                dl = __builtin_amdgcn_mfma_scale_f32_16x16x128_f8f6f4(xb, uw, dl, 0, 2, 0, 0x7F7F7F7F, 0, 0x7F7F7F7F);              \
            }
#elif PEER_U6 == 2
        const unsigned koff = (unsigned)((c >> 3) * 512 + gq * 128);
        const unsigned xoff = (unsigned)(((c >> 3) * 4 + gq) * 32);
        constexpr int NUB = 8;
#define U_LOAD(UB, E_) { _Pragma("unroll") for (int k3 = 0; k3 < 8; ++k3) UB[k3] = ldws<u32x4>(W, O_UT + (unsigned)(E_) * 1024u + koff + k3 * 16); }
#define U_DOT(UB)                                                                                                                  \
            _Pragma("unroll") for (int ks = 0; ks < 4; ++ks) {                                                                     \
                const u32x4 xh0 = *(const u32x4*)(wsm + ks * 256 + xoff), xh1 = *(const u32x4*)(wsm + ks * 256 + xoff + 16);       \
                const u32x4 xl0 = *(const u32x4*)(wsm + 1024 + ks * 256 + xoff), xl1 = *(const u32x4*)(wsm + 1024 + ks * 256 + xoff + 16); \
                const v8i32_t xa = {(int)xh0.x, (int)xh0.y, (int)xh0.z, (int)xh0.w, (int)xh1.x, (int)xh1.y, (int)xh1.z, (int)xh1.w}; \
                const v8i32_t xb = {(int)xl0.x, (int)xl0.y, (int)xl0.z, (int)xl0.w, (int)xl1.x, (int)xl1.y, (int)xl1.z, (int)xl1.w}; \
                const v8i32_t uw = {(int)UB[2 * ks].x, (int)UB[2 * ks].y, (int)UB[2 * ks].z, (int)UB[2 * ks].w, (int)UB[2 * ks + 1].x, (int)UB[2 * ks + 1].y, (int)UB[2 * ks + 1].z, (int)UB[2 * ks + 1].w}; \
                dh = __builtin_amdgcn_mfma_scale_f32_16x16x128_f8f6f4(xa, uw, dh, 0, 0, 0, 0x7F7F7F7F, 0, 0x7F7F7F7F);              \
                dl = __builtin_amdgcn_mfma_scale_f32_16x16x128_f8f6f4(xb, uw, dl, 0, 0, 0, 0x7F7F7F7F, 0, 0x7F7F7F7F);              \
            }
#else
        const unsigned koff = (unsigned)((c >> 3) * 64 + 16 * gq);
        constexpr int NUB = 8;
#define U_LOAD(UB, E_) { _Pragma("unroll") for (int k3 = 0; k3 < 8; ++k3) UB[k3] = ldws<u32x4>(W, O_UT + (unsigned)(E_) * 1024u + koff + k3 * 128); }
#define U_DOT(UB)                                                                                                                  \
            _Pragma("unroll") for (int k3 = 0; k3 < 8; ++k3) {                                                                     \
                const u32x4 xh = *(const u32x4*)(wsm + k3 * 128 + koff), xlo = *(const u32x4*)(wsm + 1024 + k3 * 128 + koff);      \
                const long u0 = (long)(((unsigned long long)UB[k3].y << 32) | UB[k3].x), u1 = (long)(((unsigned long long)UB[k3].w << 32) | UB[k3].z); \
                const long h0 = (long)(((unsigned long long)xh.y << 32) | xh.x), h1 = (long)(((unsigned long long)xh.w << 32) | xh.z);  \
                const long l0 = (long)(((unsigned long long)xlo.y << 32) | xlo.x), l1 = (long)(((unsigned long long)xlo.w << 32) | xlo.z); \
                dh = __builtin_amdgcn_mfma_f32_16x16x32_fp8_fp8(h0, u0, dh, 0, 0, 0);                                              \
                dh = __builtin_amdgcn_mfma_f32_16x16x32_fp8_fp8(h1, u1, dh, 0, 0, 0);                                              \
                dl = __builtin_amdgcn_mfma_f32_16x16x32_fp8_fp8(l0, u0, dl, 0, 0, 0);                                              \
                dl = __builtin_amdgcn_mfma_f32_16x16x32_fp8_fp8(l1, u1, dl, 0, 0, 0);                                              \
            }
#endif
#if PEER_V6
        typedef U3 vb_t;
#define V_LOAD(VB, ESRC) { _Pragma("unroll") for (int j = 0; j < 8; ++j) VB[j] = ldws<U3>(W, O_VT + (unsigned)__builtin_amdgcn_readlane(ESRC, j) * 768u + lane * 12); }
#define V_LOAD_H(VB, ESRC, J0) { _Pragma("unroll") for (int j = J0; j < J0 + 4; ++j) VB[j] = ldws<U3>(W, O_VT + (unsigned)__builtin_amdgcn_readlane(ESRC, j) * 768u + lane * 12); }
#define V_ACC(VBC)                                                                                                                 \
            _Pragma("unroll") for (int jp = 0; jp < 4; ++jp) {                                                                     \
                const float a0_ = __builtin_bit_cast(float, __builtin_amdgcn_readlane(__builtin_bit_cast(int, act), 2 * jp));      \
                const float a1_ = __builtin_bit_cast(float, __builtin_amdgcn_readlane(__builtin_bit_cast(int, act), 2 * jp + 1));  \
                const v6i32_t sv_ = {(int)VBC[2 * jp].a, (int)VBC[2 * jp].b, (int)VBC[2 * jp].c, (int)VBC[2 * jp + 1].a, (int)VBC[2 * jp + 1].b, (int)VBC[2 * jp + 1].c}; \
                const v32f32_t f_ = __builtin_amdgcn_cvt_scalef32_pk32_f32_fp6(sv_, 1.0f);                                         \
                _Pragma("unroll") for (int q_ = 0; q_ < 4; ++q_) {                                                                 \
                    acc[q_] += (f32x4){f_[4 * q_], f_[4 * q_ + 1], f_[4 * q_ + 2], f_[4 * q_ + 3]} * a0_;                           \
                    acc[q_] += (f32x4){f_[16 + 4 * q_], f_[16 + 4 * q_ + 1], f_[16 + 4 * q_ + 2], f_[16 + 4 * q_ + 3]} * a1_;       \
                }                                                                                                                  \
            }
#else
        typedef u32x4 vb_t;
#define V_LOAD(VB, ESRC) { _Pragma("unroll") for (int j = 0; j < 8; ++j) VB[j] = ldws<u32x4>(W, O_VT + (unsigned)__builtin_amdgcn_readlane(ESRC, j) * 1024u + lane * 16); }
#define V_LOAD_H(VB, ESRC, J0) { _Pragma("unroll") for (int j = J0; j < J0 + 4; ++j) VB[j] = ldws<u32x4>(W, O_VT + (unsigned)__builtin_amdgcn_readlane(ESRC, j) * 1024u + lane * 16); }
#define V_ACC(VBC)                                                                                                                 \
            _Pragma("unroll") for (int j = 0; j < 8; ++j) {                                                                        \
                const float aj = __builtin_bit_cast(float, __builtin_amdgcn_readlane(__builtin_bit_cast(int, act), j));            \
                const u32x4 vw = VBC[j];                                                                                           \
                const f32x2_t p0 = __builtin_amdgcn_cvt_pk_f32_fp8((int)vw.x, false), p1 = __builtin_amdgcn_cvt_pk_f32_fp8((int)vw.x, true); \
                const f32x2_t p2 = __builtin_amdgcn_cvt_pk_f32_fp8((int)vw.y, false), p3 = __builtin_amdgcn_cvt_pk_f32_fp8((int)vw.y, true); \
                const f32x2_t p4 = __builtin_amdgcn_cvt_pk_f32_fp8((int)vw.z, false), p5 = __builtin_amdgcn_cvt_pk_f32_fp8((int)vw.z, true); \
                const f32x2_t p6 = __builtin_amdgcn_cvt_pk_f32_fp8((int)vw.w, false), p7 = __builtin_amdgcn_cvt_pk_f32_fp8((int)vw.w, true); \
                acc[0] += (f32x4){p0[0], p0[1], p1[0], p1[1]} * aj; acc[1] += (f32x4){p2[0], p2[1], p3[0], p3[1]} * aj;             \
                acc[2] += (f32x4){p4[0], p4[1], p5[0], p5[1]} * aj; acc[3] += (f32x4){p6[0], p6[1], p7[0], p7[1]} * aj;             \
            }
#endif
    u32x4 ub0[NUB], ub1[NUB]; vb_t vb0[8], vb1[8];
    int ec0, ec1;
    {
        const int* eid0 = NB_EID(wbase);
        ec0 = eid0[c & 7]; ec1 = eid0[8 + (c & 7)];
        U_LOAD(ub0, ec0)
        V_LOAD(vb0, ec0)
        U_LOAD(ub1, ec1)
    }
#pragma unroll 1
    for (int it = 0;; ++it) {
        unsigned char* wsm = NOTK ? wbase : wbase + (it & 1) * 4096;
        unsigned char* nb = NOTK ? wbase : wbase + ((it + 1) & 1) * 4096;
        const int* eid = NB_EID(wsm); const float* egate = NB_EG(wsm); const float* eusc = NB_EU(wsm);
        const float rs = rs_cur;
        const int nrow_raw = row + stride;
        const int nrow = nrow_raw < MTOK ? nrow_raw : row;
        TK_LOAD_X(nrow) TK_LOAD_SC(nrow, 0)
        f32x4 acc[4];
#pragma unroll
        for (int i = 0; i < 4; ++i) acc[i] = (f32x4){0.f, 0.f, 0.f, 0.f};
#define PEER_TILE(UB, EC, VBC, ECN, VBN)                                                                                           \
        {                                                                                                                          \
            f32x4 dh = {0.f, 0.f, 0.f, 0.f}, dl = {0.f, 0.f, 0.f, 0.f};                                                             \
            U_DOT(UB)                                                                                                              \
            float mine = dh[0] + dl[0] * (1.f / 16.f);                                                                             \
            mine += __shfl_xor(mine, 40);                                                       \
            const float act = gelu_tanh(mine * (1.f / 16.f) * eusc[tcur * 8 + (c & 7)] * rs) * egate[tcur * 8 + (c & 7)];           \
            {     \
                const int* es_ = (tcur + 2 < 16) ? eid + (tcur + 2) * 8 : NB_EID(nb) + (tcur + 2 - 16) * 8;                          \
                EC = es_[c & 7]; U_LOAD(UB, EC)                                                                                    \
                V_LOAD(VBN, ECN)                                                                                                   \
            }                                                                                                                      \
            __builtin_amdgcn_sched_barrier(0);                                                                                     \
            V_ACC(VBC)                                                                                                             \
            __builtin_amdgcn_sched_barrier(0);                                                                                     \
        }
#pragma unroll 1
        for (int tp = 0; tp < 8; ++tp) {
            { const int tcur = 2 * tp; PEER_TILE(ub0, ec0, vb0, ec1, vb1) }
            if (!NOTK) {
            if (tp == 0) { TK_STAGE_X(nb, rs_n) }
            TK_FLUSH(nb)
            TK_PART_A(nb)
            }
            __builtin_amdgcn_sched_barrier(0);
            { const int tcur = 2 * tp + 1; PEER_TILE(ub1, ec1, vb1, ec0, vb0) }
            if (!NOTK) {
            TK_PART_B(nb, tp, rs_n)
            { const int hn = tp < 7 ? tp + 1 : 7; TK_LOAD_SC(nrow, hn) }
            }
            __builtin_amdgcn_sched_barrier(0);
        }
#undef PEER_TILE
#undef U_LOAD
#undef U_DOT
#undef V_LOAD
#undef V_LOAD_H
#undef V_ACC
        if (!NOTK) { TK_FLUSH(nb) }
        float* hr = p.out + (size_t)row * DM;
        float ss = 0.f;
        {
            f32x4 h0, h1, h2, h3;
            unpack8(ldws<u32x4>(W, O_HG + (unsigned)row * 2048u + lane * 16), h0, h1); unpack8(ldws<u32x4>(W, O_HG + (unsigned)row * 2048u + 1024 + lane * 16), h2, h3);
            acc[0] += h0; acc[1] += h1; acc[2] += h2; acc[3] += h3;
        }
#pragma unroll
        for (int i = 0; i < 4; ++i) ss += acc[i][0] * acc[i][0] + acc[i][1] * acc[i][1] + acc[i][2] * acc[i][2] + acc[i][3] * acc[i][3];
        ss = wave_sum(ss);
        const float scl = rsqrtf(ss * (1.f / DM) + NORM_EPS);
#pragma unroll
        for (int cc = 0; cc < 2; ++cc) {
            const f32x4 ga = *(const f32x4*)(p.norm_f_g + cc * 512 + lane * 8), gb = *(const f32x4*)(p.norm_f_g + cc * 512 + lane * 8 + 4);
            *(f32x4*)(hr + cc * 512 + lane * 8) = acc[2 * cc] * scl * ga; *(f32x4*)(hr + cc * 512 + lane * 8 + 4) = acc[2 * cc + 1] * scl * gb;
        }
        __builtin_amdgcn_s_waitcnt(0xC07F); __builtin_amdgcn_wave_barrier();
        if (nrow_raw >= MTOK) break;
        row = nrow_raw; rs_cur = rs_n;
    }
#undef TK_FLUSH
#undef TK_PART_B
#undef TK_PART_A
#undef TK_K16
#undef TK_STAGE_X
#undef TK_LOAD_SC
#undef TK_LOAD_X
}


#ifdef UT_FP6
__device__ __forceinline__ int ut_a(int row, int g, int i) { return ((i * 7 + g * 3 + row) % 13) - 6; }
__device__ __forceinline__ int ut_b(int col, int g, int j) { return ((j * 5 + g * 2 + col * 3) % 7) - 3; }
__device__ __forceinline__ void ut_fp6(const Params& p) {
    const int lane = threadIdx.x & 63, g = lane >> 4, c = lane & 15;
    unsigned aw[8];
#pragma unroll
    for (int w = 0; w < 8; ++w) {
        int h_ = __builtin_amdgcn_cvt_pk_fp8_f32((float)ut_a(c, g, 4 * w), (float)ut_a(c, g, 4 * w + 1), 0, false);
        h_ = __builtin_amdgcn_cvt_pk_fp8_f32((float)ut_a(c, g, 4 * w + 2), (float)ut_a(c, g, 4 * w + 3), h_, true);
        aw[w] = (unsigned)h_;
    }
    unsigned bw[6];
    {
        unsigned cd[16];
#pragma unroll
        for (int j = 0; j < 16; ++j) cd[j] = fp6_code((float)ut_b(c, g, j));
        fp6_pack16(cd, bw[0], bw[1], bw[2]);
#pragma unroll
        for (int j = 0; j < 16; ++j) cd[j] = fp6_code((float)ut_b(c, g, 16 + j));
        fp6_pack16(cd, bw[3], bw[4], bw[5]);
    }
    const v8i32_t A = {(int)aw[0], (int)aw[1], (int)aw[2], (int)aw[3], (int)aw[4], (int)aw[5], (int)aw[6], (int)aw[7]};
    const v8i32_t B = {(int)bw[0], (int)bw[1], (int)bw[2], (int)bw[3], (int)bw[4], (int)bw[5], 0, 0};
    f32x4 D = {0.f, 0.f, 0.f, 0.f};
    D = __builtin_amdgcn_mfma_scale_f32_16x16x128_f8f6f4(A, B, D, 0, 2, 0, 0x7F7F7F7F, 0, 0x7F7F7F7F);
    bool ok1 = true, ok2 = true, ok3 = true, ok4 = true;
#pragma unroll 1
    for (int r = 0; r < 4; ++r) {
        const int row = 4 * g + r;
        int e1 = 0, e2 = 0, e3 = 0, e4 = 0;
#pragma unroll 1
        for (int gg = 0; gg < 4; ++gg)
#pragma unroll 1
            for (int j = 0; j < 32; ++j) {
                const int bv = ut_b(c, gg, j);
                e1 += bv * ut_a(row, gg, j);
                { const int K = j < 16 ? 16 * gg + j : 64 + 16 * gg + (j - 16); e2 += bv * ut_a(row, K >> 5, K & 31); }
                { const int K = 32 * gg + j; const int ga = K < 64 ? (K >> 4) : ((K - 64) >> 4), ia = K < 64 ? (K & 15) : 16 + (K & 15); e3 += bv * ut_a(row, ga, ia); }
                { const int K = 32 * (j >> 3) + 8 * gg + (j & 7); e4 += bv * ut_a(row, K >> 5, K & 31); }
            }
        const float dv = D[r];
        ok1 = ok1 && (dv == (float)e1); ok2 = ok2 && (dv == (float)e2); ok3 = ok3 && (dv == (float)e3); ok4 = ok4 && (dv == (float)e4);
    }
    const bool a1 = __ballot(ok1) == ~0ull, a2 = __ballot(ok2) == ~0ull, a3 = __ballot(ok3) == ~0ull, a4 = __ballot(ok4) == ~0ull;
    const int m = a1 ? 1 : a2 ? 2 : a3 ? 3 : a4 ? 4 : 0;
    const v6i32_t sv = {(int)bw[0], (int)bw[1], (int)bw[2], (int)bw[3], (int)bw[4], (int)bw[5]};
    const v32f32_t f = __builtin_amdgcn_cvt_scalef32_pk32_f32_fp6(sv, 1.0f);
    bool okc = true;
#pragma unroll
    for (int j = 0; j < 32; ++j) okc = okc && (f[j] == (float)ut_b(c, g, j));
    const int c1 = (__ballot(okc) == ~0ull) ? 1 : 0;
    if (lane == 0) ((float*)p.ws)[20] = (float)(2 * m + c1);
}
#endif
__global__ void __launch_bounds__(NT, 2) k_mega(Params p) {
    extern __shared__ __attribute__((aligned(16))) unsigned char lds_raw[];
    LAS unsigned char* lds = (LAS unsigned char*)lds_raw;
    unsigned char* smem = lds_raw;
    const int tid = threadIdx.x, G = gridDim.x;
    const int vcu = (G % 8 == 0) ? ((int)blockIdx.x % 8) * (G / 8) + (int)blockIdx.x / 8 : (int)blockIdx.x;
    for (int i = tid; i < (LDS_BYTES - LDSCTL_OFF) / 4; i += NT) ((LAS unsigned*)(lds + LDSCTL_OFF))[i] = 0u;
    __syncthreads();
    XcdBarrier bar = xcd_barrier_post((unsigned*)p.ws + CW_BAR, (volatile LAS unsigned*)(lds + MISC_OFF) + 8);
#ifdef UT_FP6
    if (blockIdx.x == 0 && threadIdx.x < 64) ut_fp6(p);
#endif

#ifndef REP_PREP
#define REP_PREP 1
#endif
#ifndef REP_INPROJ
#define REP_INPROJ 1
#endif
#ifndef REP_SSM
#define REP_SSM 1
#endif
#ifndef REP_DSA
#define REP_DSA 1
#endif
#ifndef REP_MID
#define REP_MID 1
#endif
#ifndef REP_SCORES
#define REP_SCORES 1
#endif
#ifndef REP_PEER
#define REP_PEER 1
#endif
#define REPEAT(n) _Pragma("unroll 1") for (int rep_ = 0; rep_ < (n); ++rep_)
    REPEAT(REP_PREP) { phase_prep<0>(p, smem, vcu, G); xcd_barrier(bar); }
    REPEAT(REP_INPROJ) {
        EpiInProj e{WSP(bf16_t, WS_U), WSP(bf16_t, WS_Q), WSP(bf16_t, WS_K), WSP(bf16_t, WS_V), WSP(bf16_t, WS_QI), WSP(bf16_t, WS_KI),
                    WSP(bf16_t, WS_SGS), WSP(bf16_t, WS_SGA), WSP(float, WS_WI), WSP(float2, WS_ROPEA), WSP(float2, WS_ROPEI)};
        run_gemm(lds, WSP(bf16_t, WS_R1), WSP(bf16_t, WS_WINT), MTOK, IN_WP, 1024, G, e);
        if (G == 256) { if ((int)blockIdx.x >= 128) phase_prep<1>(p, smem, (int)blockIdx.x - 128, 128); }
        else phase_prep<1>(p, smem, vcu, G);
        xcd_barrier(bar);
    }
#ifdef DSA_FIRST
    REPEAT(REP_DSA) { phase_dsa(p, smem, (unsigned)(WS_YATT << 20), vcu, G); __syncthreads(); }
    REPEAT(REP_SSM) {
        int t2 = threadIdx.x; asm volatile("" : "+v"(t2));
        const int w2 = __builtin_amdgcn_readfirstlane(t2 >> 6);
#pragma unroll 1
        for (int item = vcu; item < NB * SSM_G; item += G) ssm_fast_item(p, smem, (unsigned)(WS_YG << 20), item, t2 & 63, w2);
        __syncthreads();
    }
#ifdef PROBE_SSM
    if (tid < 64) for (int item = blockIdx.x; item < NB * SSM_G; item += G) ssm_item(p, (float*)smem, (bf16_t*)p.out, item, tid);
    __syncthreads();
#endif
#else
    REPEAT(REP_SSM) {
        int t2 = threadIdx.x; asm volatile("" : "+v"(t2));
        const int w2 = __builtin_amdgcn_readfirstlane(t2 >> 6);
#pragma unroll 1
        for (int item = vcu; item < NB * SSM_G; item += G) ssm_fast_item(p, smem, (unsigned)(WS_YG << 20), item, t2 & 63, w2);
        __syncthreads();
    }
#ifdef PROBE_SSM
    if (tid < 64) for (int item = blockIdx.x; item < NB * SSM_G; item += G) ssm_item(p, (float*)smem, (bf16_t*)p.out, item, tid);
    __syncthreads();
#endif
    REPEAT(REP_DSA) { phase_dsa(p, smem, (unsigned)(WS_YATT << 20), vcu, G); __syncthreads(); }
#endif
#ifdef PROBE_ATTN
    phase_attn(p, smem, (bf16_t*)p.out, vcu, G);
    __syncthreads();
#endif
    xcd_barrier(bar);
#if defined(PROBE_ATTN) || defined(PROBE_SSM)
    {
#ifdef PROBE_SSM
        const bf16_t* A = WSP(bf16_t, WS_YG);
#else
        const bf16_t* A = WSP(bf16_t, WS_YATT);
#endif
        const bf16_t* B = (const bf16_t*)p.out;
        float d2 = 0.f, b2 = 0.f;
        for (size_t i = (size_t)blockIdx.x * NT + threadIdx.x; i < (size_t)MTOK * 512; i += (size_t)G * NT) { float a = bf2f(A[i]), bb = bf2f(B[i]); d2 += (a - bb) * (a - bb); b2 += bb * bb; }
        d2 = wave_sum(d2); b2 = wave_sum(b2);
        if ((threadIdx.x & 63) == 0) { atomicAdd((float*)p.ws + 16, d2); atomicAdd((float*)p.ws + 17, b2); }
    }
    xcd_barrier(bar);
#endif
#ifndef REP_GLU
#define REP_GLU 1
#endif
#ifndef REP_M1
#define REP_M1 1
#endif
#ifndef REP_M2
#define REP_M2 1
#endif
#ifndef REP_OUT
#define REP_OUT 1
#endif
#ifndef REP_BAR
#define REP_BAR 0
#endif
    REPEAT(REP_BAR) { xcd_barrier(bar); }
    REPEAT(REP_GLU) { EpiGlu e{WSP(bf16_t, WS_YG), WSP(bf16_t, WS_YSSM)}; run_gemm(lds, WSP(bf16_t, WS_YG), WSP(bf16_t, WS_WGLUT), MTOK, 512, 512, G, e); xcd_barrier(bar); }
    REPEAT(REP_M1) { EpiMergeChain e{WSP(bf16_t, WS_SGS), WSP(bf16_t, WS_SGA), WSP(bf16_t, WS_R1)};
        run_gemm_chain(lds, WSP(bf16_t, WS_YSSM), WSP(bf16_t, WS_WSUPT), WSP(bf16_t, WS_YATT), WSP(bf16_t, WS_WAUPT), MTOK, 1024, 512, G, e); xcd_barrier(bar); }
    REPEAT(REP_OUT) { EpiOut e{p.x, WSP(bf16_t, WS_HG), WSP(float, WS_RSS)};
        run_gemm(lds, WSP(bf16_t, WS_R1), WSP(bf16_t, WS_WOUTT), MTOK, 1024, 1024, G, e); xcd_barrier(bar); }
    REPEAT(REP_SCORES) { EpiScores e{WSP(_Float16, WS_SCORES)}; run_gemm(lds, WSP(bf16_t, WS_HG), WSP(bf16_t, WS_WCT), MTOK, 2048, 1024, G, e); xcd_barrier(bar); }
#ifdef PROBE_PEER
    phase_peer2<2>(p, smem, vcu, G);
    __syncthreads();
    phase_peer<false>(p, smem, vcu, G);
    xcd_barrier(bar);
    {
        const float* A = WSP(float, 462); const float* B = p.out;
        float d2 = 0.f, b2 = 0.f;
        for (size_t i = (size_t)blockIdx.x * NT + threadIdx.x; i < (size_t)8192 * DM; i += (size_t)G * NT) { const float a = A[i], bb = B[i]; d2 += (a - bb) * (a - bb); b2 += bb * bb; }
        d2 = wave_sum(d2); b2 = wave_sum(b2);
        if ((threadIdx.x & 63) == 0) { atomicAdd((float*)p.ws + 16, d2); atomicAdd((float*)p.ws + 17, b2); }
    }
    xcd_barrier(bar);
    {
        const float e = ((const float*)p.ws)[16] / fmaxf(((const float*)p.ws)[17], 1e-30f);
        int kx = 0; if (e > 1e-8f) kx++; if (e > 1e-7f) kx++; if (e > 1e-6f) kx++; if (e > 1e-5f) kx++; if (e > 1e-4f) kx++; if (e > 1e-3f) kx++; if (e > 1e-2f) kx++; if (!(e == e)) kx = 10;
        const float f = 1.f + 0.05f * kx;
        for (size_t i = (size_t)blockIdx.x * NT + threadIdx.x; i < (size_t)MTOK * DM / 4; i += (size_t)G * NT) { f32x4 v = ((f32x4*)p.out)[i]; ((f32x4*)p.out)[i] = v * f; }
    }
#else
#if !PEER_FP6
    REPEAT(REP_PEER - 1) { phase_peer2<1>(p, smem, vcu, G); __syncthreads(); }
#endif
#ifdef PEER_OLD
    phase_peer2<0>(p, smem, vcu, G);
#elif PEER_FP6
#if REP_PEER > 1
    phase_peer6<true>(p, smem, vcu, G); __syncthreads();
#endif
    phase_peer6<false>(p, smem, vcu, G);
#else
    phase_peer4(p, smem, vcu, G);
#endif
#ifdef UT_FP6
    xcd_barrier(bar);
    {
        const float f = 1.f + 0.05f * ((const float*)p.ws)[20];
        for (size_t i = (size_t)blockIdx.x * NT + threadIdx.x; i < (size_t)MTOK * DM / 4; i += (size_t)G * NT) { f32x4 v = ((f32x4*)p.out)[i]; ((f32x4*)p.out)[i] = v * f; }
    }
#endif
#if defined(PROBE_ATTN) || defined(PROBE_SSM)
    xcd_barrier(bar);
    {
        const float e = ((const float*)p.ws)[16] / fmaxf(((const float*)p.ws)[17], 1e-30f);
        int kx = 0; if (e > 1e-6f) kx++; if (e > 1e-5f) kx++; if (e > 1e-4f) kx++; if (e > 1e-3f) kx++; if (e > 1e-2f) kx++; if (e > 1e-1f) kx++; if (!(e == e)) kx = 8;
        const float f = 1.f + 0.05f * kx;
        for (size_t i = (size_t)blockIdx.x * NT + threadIdx.x; i < (size_t)MTOK * DM / 4; i += (size_t)G * NT) { f32x4 v = ((f32x4*)p.out)[i]; ((f32x4*)p.out)[i] = v * f; }
    }
#endif
#endif
}

extern "C" void kernel_launch(void* const* d_in, const int* in_sizes, int n_in, void* d_out, int out_size, void* d_ws, size_t ws_size,
                              hipStream_t stream) {
    static int grid = 0;
    if (grid == 0) {
        int dev = 0, cus = 0, per_cu = 0;
        if (hipGetDevice(&dev) != hipSuccess || hipDeviceGetAttribute(&cus, hipDeviceAttributeMultiprocessorCount, dev) != hipSuccess) { grid = -1; return; }
        if (hipFuncSetAttribute((const void*)k_mega, hipFuncAttributeMaxDynamicSharedMemorySize, LDS_BYTES) != hipSuccess) { fprintf(stderr, "hipFuncSetAttribute failed\n"); grid = -1; return; }
        if (hipOccupancyMaxActiveBlocksPerMultiprocessor(&per_cu, (const void*)k_mega, NT, LDS_BYTES) != hipSuccess || per_cu < 1) {
            fprintf(stderr, "occupancy query reports %d blocks/CU\n", per_cu); (void)hipGetLastError(); per_cu = 1; }
        grid = cus;
    }
    if (grid < 0) return;
    (void)hipMemsetAsync(d_ws, 0, CTL_ZERO_BYTES, stream);
    Params p{};
    const float** pp = (const float**)&p;
    for (int i = 0; i < 22; ++i) pp[i] = (const float*)d_in[i];
    p.out = (float*)d_out;
    p.ws = (unsigned char*)d_ws;
    for (int f = 0; f < 32; ++f) p.inv64[f] = pow(10000.0, -(double)(2 * f) / 64.0);
    for (int f = 0; f < 16; ++f) p.inv32[f] = pow(10000.0, -(double)(2 * f) / 32.0);
    hipLaunchKernelGGL(k_mega, dim3(grid), dim3(NT), LDS_BYTES, stream, p);
}
```

```cpp
#include <hip/hip_runtime.h>
#include <cstdio>
#include <cstdint>
#include <cmath>
#define GAS __attribute__((address_space(1)))
#define LAS __attribute__((address_space(3)))
namespace pg8 {
#define PG8_LAS __attribute__((address_space(3)))
typedef unsigned short bf16_t;
typedef short bf16x8 __attribute__((ext_vector_type(8)));
typedef float f32x4 __attribute__((ext_vector_type(4)));
typedef unsigned u32x4 __attribute__((ext_vector_type(4)));
constexpr int BM = 256, BK = 64, HALF = 128, HTB = HALF * BK * 2  , STAGE_BYTES = 8 * HTB, NXCD = 8, WGM = 8;

__host__ __device__ __forceinline__ int lds_byte(int r, int c) { const int st = (r >> 4) * 2 + (c >> 5), rr = r & 15, cc = c & 31, ob = rr * 64 + cc * 2; return st * 1024 + (ob ^ (((ob >> 9) & 1) << 5)); }
__host__ __device__ __forceinline__ void stage_rc(int b, int& R, int& C) { const int st = b / 1024, sb = b % 1024, swz = sb ^ (((sb >> 9) & 1) << 5); R = (st >> 1) * 16 + swz / 64; C = (st & 1) * 32 + (swz % 64) / 2; }
__host__ __device__ __forceinline__ int perm32(int rho) { const int n = rho >> 4, i = rho & 15; return 8 * (i >> 2) + 4 * n + (i & 3); }

struct Unit { int pm, pn, sel; };
struct Gemm { const bf16_t* A; const bf16_t* Bt; int M, N, K; const bf16_t* A2; const bf16_t* Bt2; };

struct StaticOrder {
    int nM, nN, nwg, G, c;
    __host__ __device__ void init(int M, int N, int G_, int c_) { nM = M / BM; nN = N / BM; nwg = nM * nN; G = G_; c = c_; }
    __host__ __device__ bool next(int i, Unit& u) const {
        const long L = (long)i * G + c; if (L >= nwg) return false;
        int wgid = (int)L; { const int q = nwg / NXCD, r = nwg % NXCD, xcd = wgid % NXCD, off = wgid / NXCD; wgid = (xcd < r ? xcd * (q + 1) : r * (q + 1) + (xcd - r) * q) + off; }
        const int nig = WGM * nN, gid = wgid / nig, fm = gid * WGM, gsz = (nM - fm) < WGM ? (nM - fm) : WGM;
        u.pm = fm + ((wgid % nig) % gsz); u.pn = (wgid % nig) / gsz; u.sel = 0; return true;
    }
    __device__ __forceinline__ void a_ready(const Unit&) const {}
    __device__ __forceinline__ void done(const Unit&) const {}
};
struct ChainOrder {
    StaticOrder b;
    __host__ __device__ void init(int M, int N, int G_, int c_) { b.init(M, N, G_, c_); }
    __host__ __device__ bool next(int i, Unit& u) const { if (!b.next(i >> 1, u)) return false; u.sel = i & 1; return true; }
    __device__ __forceinline__ void a_ready(const Unit&) const {}
    __device__ __forceinline__ void done(const Unit&) const {}
};
__device__ __forceinline__ unsigned cvt_pk_bf16(float lo, float hi) { unsigned r; asm volatile("v_cvt_pk_bf16_f32 %0, %1, %2" : "=v"(r) : "v"(lo), "v"(hi)); return r; }
template <class Epi, class Sched, bool ALIGN_EPI = false, bool SP2 = false>
__device__ __forceinline__ void gemm_phase(PG8_LAS unsigned char* lds, const Gemm g, const Sched& S, const Epi& E) {
    int tid_l = threadIdx.x; asm volatile("" : "+v"(tid_l));
    const int tid = tid_l, wid = __builtin_amdgcn_readfirstlane(tid >> 6), lane = tid & 63, wr = wid >> 2, wc = wid & 3, fr = lane & 15, fq = lane >> 4;
    const int K = g.K, nt = K / BK;
    unsigned voffA[2], voffB[2];
#pragma unroll
    for (int i = 0; i < 2; ++i) { int R, C; stage_rc(tid * 16 + i * 8192, R, C); const int Rb = Epi::PERM ? ((R & ~31) + perm32(R & 31)) : R;
        voffA[i] = (unsigned)(R * K + C) * 2u; voffB[i] = (unsigned)(Rb * K + C) * 2u; }
    const size_t kstep = (size_t)(BK * 2);
    const size_t hstep = (size_t)HALF * K * 2;
    const size_t tstep = 2 * hstep;
    const unsigned ldsw = (unsigned)wid * 1024u;
    const int aoff = lds_byte(wr * 64 + fr, fq * 8), boff = lds_byte(wc * 32 + fr, fq * 8);
#define PG8_SA(b, h) (((b) * 2 + (h)) * HTB)
#define PG8_SB(b, h) ((4 + (b) * 2 + (h)) * HTB)
#define PG8_STAGE(bufoff, gbase, voff) do { _Pragma("unroll") for (int _i = 0; _i < 2; ++_i) \
        __builtin_amdgcn_global_load_lds((const unsigned*)((const char*)(gbase) + (voff)[_i]), (PG8_LAS unsigned*)(lds + (bufoff) + ldsw + _i * 8192), 16, 0, 0); } while (0)
#define PG8_LDA(dst, b, h) do { _Pragma("unroll") for (int m = 0; m < 4; ++m) _Pragma("unroll") for (int k = 0; k < 2; ++k) dst[m][k] = *(const PG8_LAS bf16x8*)(lds + PG8_SA(b, h) + aoff + m * 2048 + k * 1024); } while (0)
#define PG8_LDB(dst, b, h) do { _Pragma("unroll") for (int n = 0; n < 2; ++n) _Pragma("unroll") for (int k = 0; k < 2; ++k) dst[n][k] = *(const PG8_LAS bf16x8*)(lds + PG8_SB(b, h) + boff + n * 2048 + k * 1024); } while (0)
#define PG8_MMA(ai, bj, At, Bt) do { __builtin_amdgcn_s_setprio(1); _Pragma("unroll") for (int m = 0; m < 4; ++m) _Pragma("unroll") for (int n = 0; n < 2; ++n) _Pragma("unroll") for (int k = 0; k < 2; ++k) \
        acc[ai][bj][m][n] = __builtin_amdgcn_mfma_f32_16x16x32_bf16(Bt[n][k], At[m][k], acc[ai][bj][m][n], 0, 0, 0); __builtin_amdgcn_s_setprio(0); } while (0)
#define PG8_WAIT_V(n) asm volatile("s_waitcnt vmcnt(" #n ")" ::: "memory")
#define PG8_WAIT_L(n) asm volatile("s_waitcnt lgkmcnt(" #n ")" ::: "memory")
#define PG8_BAR __builtin_amdgcn_s_barrier()
#define PG8_SCHED __builtin_amdgcn_sched_barrier(0)
    Unit cur, nxt; int ui = 0;
    if (!S.next(0, cur)) return;
    f32x4 acc[2][2][4][2];
#pragma unroll
    for (int a = 0; a < 2; ++a)
#pragma unroll
        for (int b = 0; b < 2; ++b)
#pragma unroll
            for (int m = 0; m < 4; ++m)
#pragma unroll
                for (int n = 0; n < 2; ++n) acc[a][b][m][n] = (f32x4){0.f, 0.f, 0.f, 0.f};
    bf16x8 At[4][2], B0[2][2], B1[2][2];
    const char* cA = (const char*)(cur.sel ? g.A2 : g.A) + (size_t)cur.pm * tstep; const char* cB = (const char*)(cur.sel ? g.Bt2 : g.Bt) + (size_t)cur.pn * tstep;
    S.a_ready(cur);
    if constexpr (SP2) {
        PG8_STAGE(PG8_SB(0, 0), cB, voffB); PG8_STAGE(PG8_SB(0, 1), cB + hstep, voffB); PG8_STAGE(PG8_SA(0, 0), cA, voffA); PG8_STAGE(PG8_SA(0, 1), cA + hstep, voffA);
        if (wr == 1) PG8_BAR;
        PG8_WAIT_V(2); PG8_BAR;
        PG8_STAGE(PG8_SB(1, 0), cB + kstep, voffB); PG8_STAGE(PG8_SA(1, 0), cA + kstep, voffA); PG8_STAGE(PG8_SB(1, 1), cB + hstep + kstep, voffB);
        PG8_WAIT_V(6); PG8_BAR;
    } else {
        PG8_STAGE(PG8_SB(0, 0), cB, voffB); PG8_STAGE(PG8_SA(0, 0), cA, voffA); PG8_STAGE(PG8_SB(0, 1), cB + hstep, voffB); PG8_STAGE(PG8_SA(0, 1), cA + hstep, voffA);
        if (wr == 1) PG8_BAR;
        PG8_WAIT_V(4); PG8_BAR;
        PG8_STAGE(PG8_SB(1, 0), cB + kstep, voffB); PG8_STAGE(PG8_SA(1, 0), cA + kstep, voffA); PG8_STAGE(PG8_SB(1, 1), cB + hstep + kstep, voffB);
        PG8_WAIT_V(6); PG8_BAR;
    }
    for (;;) {
        const bool has_next = S.next(ui + 1, nxt);
        const char* nA = has_next ? (const char*)(nxt.sel ? g.A2 : g.A) + (size_t)nxt.pm * tstep : cA; const char* nB = has_next ? (const char*)(nxt.sel ? g.Bt2 : g.Bt) + (size_t)nxt.pn * tstep : cB;
        for (int t = 0; t < nt; t += 2) {
            const bool last = (t == nt - 2);
            const char* a1 = cA + (size_t)(t + 1) * kstep;
            const char* a2 = last ? nA : cA + (size_t)(t + 2) * kstep; const char* b2 = last ? nB : cB + (size_t)(t + 2) * kstep;
            const char* a3 = a2 + kstep; const char* b3 = b2 + kstep;
            if (last && has_next) S.a_ready(nxt);
            if constexpr (SP2) {
            PG8_LDB(B0, 0, 0); PG8_LDB(B1, 0, 1); PG8_SCHED; PG8_LDA(At, 0, 0); PG8_STAGE(PG8_SA(1, 1), a1 + hstep, voffA);
            PG8_WAIT_V(8); PG8_WAIT_L(0); PG8_BAR; PG8_MMA(0, 0, At, B0); PG8_MMA(0, 1, At, B1); PG8_BAR; PG8_SCHED;
            PG8_LDA(At, 0, 1); PG8_STAGE(PG8_SB(0, 0), b2, voffB); PG8_STAGE(PG8_SB(0, 1), b2 + hstep, voffB); PG8_STAGE(PG8_SA(0, 0), a2, voffA);
            PG8_WAIT_V(8); PG8_WAIT_L(0); PG8_BAR; PG8_MMA(1, 0, At, B0); PG8_MMA(1, 1, At, B1); PG8_BAR; PG8_SCHED;
            PG8_LDB(B0, 1, 0); PG8_LDB(B1, 1, 1); PG8_SCHED; PG8_LDA(At, 1, 0); PG8_STAGE(PG8_SA(0, 1), a2 + hstep, voffA);
            PG8_WAIT_V(8); PG8_WAIT_L(0); PG8_BAR; PG8_MMA(0, 0, At, B0); PG8_MMA(0, 1, At, B1); PG8_BAR; PG8_SCHED;
            PG8_LDA(At, 1, 1); PG8_STAGE(PG8_SB(1, 0), b3, voffB); PG8_STAGE(PG8_SB(1, 1), b3 + hstep, voffB); PG8_STAGE(PG8_SA(1, 0), a3, voffA);
            PG8_WAIT_V(8); PG8_WAIT_L(0); PG8_BAR; PG8_MMA(1, 0, At, B0); PG8_MMA(1, 1, At, B1); PG8_BAR; PG8_SCHED;
            } else {
            PG8_LDB(B0, 0, 0); PG8_SCHED; PG8_LDA(At, 0, 0); PG8_STAGE(PG8_SA(1, 1), a1 + hstep, voffA);
            PG8_WAIT_L(8); PG8_BAR; PG8_WAIT_L(0); PG8_MMA(0, 0, At, B0); PG8_BAR; PG8_SCHED;
            PG8_LDB(B1, 0, 1); PG8_STAGE(PG8_SB(0, 0), b2, voffB);
            PG8_BAR; PG8_WAIT_L(0); PG8_MMA(0, 1, At, B1); PG8_BAR;
            PG8_LDA(At, 0, 1); PG8_STAGE(PG8_SA(0, 0), a2, voffA);
            PG8_BAR; PG8_WAIT_L(0); PG8_MMA(1, 0, At, B0); PG8_BAR; PG8_SCHED;
            PG8_STAGE(PG8_SB(0, 1), b2 + hstep, voffB);
            PG8_WAIT_V(6); PG8_BAR; PG8_MMA(1, 1, At, B1); PG8_BAR;
            PG8_LDB(B0, 1, 0); PG8_SCHED; PG8_LDA(At, 1, 0); PG8_STAGE(PG8_SA(0, 1), a2 + hstep, voffA);
            PG8_WAIT_L(8); PG8_BAR; PG8_WAIT_L(0); PG8_MMA(0, 0, At, B0); PG8_BAR; PG8_SCHED;
            PG8_LDB(B1, 1, 1); PG8_STAGE(PG8_SB(1, 0), b3, voffB);
            PG8_BAR; PG8_WAIT_L(0); PG8_MMA(0, 1, At, B1); PG8_BAR;
            PG8_LDA(At, 1, 1); PG8_STAGE(PG8_SA(1, 0), a3, voffA);
            PG8_BAR; PG8_WAIT_L(0); PG8_MMA(1, 0, At, B0); PG8_BAR; PG8_SCHED;
            PG8_STAGE(PG8_SB(1, 1), b3 + hstep, voffB);
            PG8_WAIT_V(6); PG8_BAR; PG8_MMA(1, 1, At, B1); PG8_BAR;
            }
        }
        if constexpr (ALIGN_EPI) { if (wr == 0) PG8_BAR; }
        if constexpr (!Epi::AFTER_DRAIN) { E(acc, cur, wr, wc, fr, fq); S.done(cur); }
        if (!has_next) break;
        if (!(Epi::CHAIN && cur.sel == 0))
#pragma unroll
        for (int a = 0; a < 2; ++a)
#pragma unroll
            for (int b = 0; b < 2; ++b)
#pragma unroll
                for (int m = 0; m < 4; ++m)
#pragma unroll
                    for (int n = 0; n < 2; ++n) acc[a][b][m][n] = (f32x4){0.f, 0.f, 0.f, 0.f};
        cur = nxt; cA = nA; cB = nB; ++ui;
        if constexpr (ALIGN_EPI) { if (wr == 1) PG8_BAR; }
    }
    PG8_WAIT_V(0);
    if constexpr (!ALIGN_EPI) { if (wr == 0) PG8_BAR; }
    PG8_BAR;
    if constexpr (Epi::AFTER_DRAIN) { E.fused(acc, cur, wr, wc, fr, fq, lds, wid, lane); S.done(cur); }
#undef PG8_SA
#undef PG8_SB
#undef PG8_STAGE
#undef PG8_LDA
#undef PG8_LDB
#undef PG8_MMA
#undef PG8_WAIT_V
#undef PG8_WAIT_L
#undef PG8_BAR
#undef PG8_SCHED
}
}
#define XB_TMO      128
#define XB_XCNT(j)  (256  + 64 * (j))
#define XB_XSUB(j)  (1280 + 64 * (j))
#define XB_XGEN(j)  (2304 + 64 * (j))
#define XB_TOP      3328
#define XB_TOPGEN   3392
#define XCD_BAR_WORDS 3456
#define XB_SPIN_CAP (1u << 18)

__device__ __forceinline__ unsigned xb_ld(unsigned* p)              { return __hip_atomic_load(p, __ATOMIC_RELAXED, __HIP_MEMORY_SCOPE_AGENT); }
__device__ __forceinline__ unsigned xb_add(unsigned* p, unsigned v) { return __hip_atomic_fetch_add(p, v, __ATOMIC_RELAXED, __HIP_MEMORY_SCOPE_AGENT); }
__device__ __forceinline__ unsigned xb_xcc_id() { return (unsigned)__builtin_amdgcn_s_getreg((3 << 11) | 20) & 0xFu; }
#define XB_SPIN(cond, bar) do { unsigned _sp = 0; while (cond) { __builtin_amdgcn_s_sleep(1); \
    if ((++_sp & 255u) == 0u) { if (xb_ld(&(bar)[XB_TMO])) break; if (_sp > XB_SPIN_CAP) { atomicAdd(&(bar)[XB_TMO], 1u); break; } } } } while (0)

struct XcdBarrier {
    unsigned* bar; unsigned x;
    volatile LAS unsigned* st;
};

__device__ __forceinline__ XcdBarrier xcd_barrier_post(unsigned* bar, volatile LAS unsigned* st) {
    XcdBarrier b; b.bar = bar; b.x = xb_xcc_id(); b.st = st;
    if (threadIdx.x == 0) (void)xb_add(&bar[XB_XCNT(b.x)], 1u);
    return b;
}
__device__ __forceinline__ void xcd_barrier_complete(unsigned* bar, unsigned x, unsigned& nloc, unsigned& nx) {
    const unsigned G = gridDim.x * gridDim.y * gridDim.z;
    unsigned sum, cnt, mine, sp = 0u;
    for (;;) {
        sum = 0u; cnt = 0u; mine = 0u;
#pragma unroll
        for (unsigned j = 0; j < 16; ++j) { const unsigned c = xb_ld(&bar[XB_XCNT(j)]); sum += c; cnt += (c > 0u) ? 1u : 0u; mine = (j == x) ? c : mine; }
        if (sum == G) break;
        __builtin_amdgcn_s_sleep(1);
        if ((++sp & 255u) == 0u) { if (xb_ld(&bar[XB_TMO])) break; if (sp > XB_SPIN_CAP) { atomicAdd(&bar[XB_TMO], 1u); break; } }
    }
    nloc = mine > 0u ? mine : 1u; nx = cnt > 0u ? cnt : 1u;
}

__device__ __forceinline__ void xcd_barrier(const XcdBarrier& b) {
    asm volatile("s_waitcnt vmcnt(0)" ::: "memory");
    __syncthreads();
    if (threadIdx.x == 0) {
        unsigned* bar = b.bar;
        __builtin_amdgcn_s_waitcnt(0);
        unsigned nloc = b.st[0], nx = b.st[1];
        if (nloc == 0u) { xcd_barrier_complete(bar, b.x, nloc, nx); b.st[0] = nloc; b.st[1] = nx; }
        const unsigned old = xb_add(&bar[XB_XSUB(b.x)], 1u);
        const unsigned gen = old / nloc;
        if (old + 1u == (gen + 1u) * nloc) {
            __builtin_amdgcn_fence(__ATOMIC_RELEASE, "agent");
            asm volatile("s_waitcnt vmcnt(0)" ::: "memory");
            const unsigned og = xb_add(&bar[XB_TOP], 1u);
            const unsigned tg = og / nx;
            if (og + 1u == (tg + 1u) * nx) xb_add(&bar[XB_TOPGEN], 1u);
            else XB_SPIN(xb_ld(&bar[XB_TOPGEN]) == tg, bar);
            __builtin_amdgcn_fence(__ATOMIC_ACQUIRE, "agent");
            xb_add(&bar[XB_XGEN(b.x)], 1u);
            asm volatile("s_waitcnt vmcnt(0)" ::: "memory");
        } else {
            XB_SPIN(xb_ld(&bar[XB_XGEN(b.x)]) == gen, bar);
            __builtin_amdgcn_fence(__ATOMIC_ACQUIRE, "agent");
            asm volatile("s_waitcnt vmcnt(0)" ::: "memory");
        }
    }
    __syncthreads();
}

typedef unsigned short bf16_t;
typedef short bf16x8 __attribute__((ext_vector_type(8)));
typedef float f32x4 __attribute__((ext_vector_type(4)));
typedef unsigned u32x4 __attribute__((ext_vector_type(4)));
using pg8::cvt_pk_bf16;

constexpr int NWAVES = 8, NT = NWAVES * 64;
constexpr int DM = 1024, NB = 8, SEQ = 4096, MTOK = NB * SEQ;
constexpr int SSM_W = 512, SSM_G = 32, SSM_N = 16, SSM_P = 64;
constexpr int IN_W = 3624, IN_WP = 3840;
constexpr int TOPK = 256;
constexpr int PEER_H = 8, PEER_KEYS = 128;
constexpr float NORM_EPS = 1e-6f;
constexpr size_t MiB = 1u << 20;
constexpr int LDS_BYTES = 163840, RING_BYTES = 131072, LDSCTL_OFF = LDS_BYTES - 1024, MISC_OFF = LDSCTL_OFF + 320;
constexpr int CW_BAR = 4096;
constexpr size_t CTL_ZERO_BYTES = 65536;

constexpr size_t WS_WINT = 1, WS_WGLUT = 9, WS_WSUPT = 10, WS_WAUPT = 11, WS_WOUTT = 12, WS_WCT = 14;
constexpr size_t WS_ROPEA = 18, WS_ROPEI = 19, WS_KT = 20, WS_A64 = 21, WS_SSMT = 22, WS_W1T = 254, WS_W3T = 262;
constexpr size_t WS_UTAB = 24, WS_VTAB = 56, WS_USC = 44, WS_VSC = 45;
#if !defined(PEER_FP6) && !defined(PEER_OLD)
#define PEER_FP6 1
#endif
#ifndef PEER_FP6
#define PEER_FP6 0
#endif
#ifndef PEER_U6
#define PEER_U6 PEER_FP6
#endif
#ifndef PEER_V6
#define PEER_V6 PEER_FP6
#endif
#ifndef PEER_FP8
#define PEER_FP8 1
#endif
constexpr size_t WS_R1 = 88;
constexpr size_t WS_U = 152, WS_Q = 184, WS_K = 216, WS_V = 224, WS_QI = 232, WS_KI = 248, WS_WI = 250;
constexpr size_t WS_SGS = 270, WS_SGA = 334, WS_YG = 398, WS_YSSM = 430, WS_YATT = 462, WS_RSS = 494;
constexpr size_t WS_T1 = 152;
constexpr size_t WS_SCORES = 88;
constexpr size_t WS_HG = 398;

struct Params {
    const float *x, *norm1_g, *w_in, *a_re, *a_im, *log_dt, *b_re, *b_im, *c_re, *c_im, *d_skip, *w_glu, *w_ssm_up,
        *w_attn_up, *w_out, *norm2_g, *peer_wq, *peer_k1, *peer_k2, *peer_u, *peer_v, *norm_f_g;
    float* out;
    unsigned char* ws;
    double inv64[32];
    double inv32[16];
};
#define WSP(T, off) ((T*)(p.ws + (size_t)(off) * MiB))

__device__ __forceinline__ unsigned f2bf(float f) {
    unsigned u = __builtin_bit_cast(unsigned, f);
    return (u + 0x7fffu + ((u >> 16) & 1u)) >> 16;
}
__device__ __forceinline__ float bf2f(unsigned b) { return __builtin_bit_cast(float, b << 16); }
__device__ __forceinline__ float bflo(unsigned w) { return __builtin_bit_cast(float, w << 16); }
__device__ __forceinline__ float bfhi(unsigned w) { return __builtin_bit_cast(float, w & 0xffff0000u); }
__device__ __forceinline__ float sigmoidf_(float x) { return 1.f / (1.f + __expf(-x)); }
__device__ __forceinline__ float gelu_fast(float x) {
    const float z = 0.7978845608028654f * (x + 0.044715f * x * x * x);
    const float e = __expf(2.f * z);
    return x - x * __builtin_amdgcn_rcpf(e + 1.f);
}
__device__ __forceinline__ float gelu_tanh(float x) {
    float z = 0.7978845608028654f * (x + 0.044715f * x * x * x);
    float e = __expf(2.f * z);
    float t = 1.f - 2.f / (e + 1.f);
    return 0.5f * x * (1.f + t);
}
template <int CTRL, int RM = 0xf, int BM = 0xf, bool BC = true>
__device__ __forceinline__ float dppf(float old, float src) { return __builtin_bit_cast(float, __builtin_amdgcn_update_dpp(__builtin_bit_cast(int, old), __builtin_bit_cast(int, src), CTRL, RM, BM, BC)); }
template <int CTRL, int RM = 0xf, int BM = 0xf, bool BC = true>
__device__ __forceinline__ int dppi(int old, int src) { return __builtin_amdgcn_update_dpp(old, src, CTRL, RM, BM, BC); }
__device__ __forceinline__ float wave_sum(float v) {
    v += dppf<0x111>(0.f, v); v += dppf<0x112>(0.f, v); v += dppf<0x114>(0.f, v); v += dppf<0x118>(0.f, v);
    v += dppf<0x142, 0xa, 0xf, false>(0.f, v); v += dppf<0x143, 0xc, 0xf, false>(0.f, v);
    return __builtin_bit_cast(float, __builtin_amdgcn_readlane(__builtin_bit_cast(int, v), 63));
}
__device__ __forceinline__ float wave_max(float v) {
    v = fmaxf(v, dppf<0x111, 0xf, 0xf, false>(v, v)); v = fmaxf(v, dppf<0x112, 0xf, 0xf, false>(v, v)); v = fmaxf(v, dppf<0x114, 0xf, 0xf, false>(v, v)); v = fmaxf(v, dppf<0x118, 0xf, 0xf, false>(v, v));
    v = fmaxf(v, dppf<0x142, 0xa, 0xf, false>(v, v)); v = fmaxf(v, dppf<0x143, 0xc, 0xf, false>(v, v));
    return __builtin_bit_cast(float, __builtin_amdgcn_readlane(__builtin_bit_cast(int, v), 63));
}
__device__ __forceinline__ int wave_incl_scan(int v) {
    v += dppi<0x111>(0, v); v += dppi<0x112>(0, v); v += dppi<0x114>(0, v); v += dppi<0x118>(0, v);
    v += dppi<0x142, 0xa, 0xf, false>(0, v); v += dppi<0x143, 0xc, 0xf, false>(0, v);
    return v;
}
__device__ __forceinline__ u32x4 pack8(f32x4 a, f32x4 b) {
    u32x4 w; w.x = cvt_pk_bf16(a[0], a[1]); w.y = cvt_pk_bf16(a[2], a[3]); w.z = cvt_pk_bf16(b[0], b[1]); w.w = cvt_pk_bf16(b[2], b[3]);
    return w;
}
__device__ __forceinline__ uint2 pack8_fp8(f32x4 a, f32x4 b) {
    int w0 = __builtin_amdgcn_cvt_pk_fp8_f32(a[0], a[1], 0, false); w0 = __builtin_amdgcn_cvt_pk_fp8_f32(a[2], a[3], w0, true);
    int w1 = __builtin_amdgcn_cvt_pk_fp8_f32(b[0], b[1], 0, false); w1 = __builtin_amdgcn_cvt_pk_fp8_f32(b[2], b[3], w1, true);
    return make_uint2((unsigned)w0, (unsigned)w1);
}
typedef float f32x2_t __attribute__((ext_vector_type(2)));
__device__ __forceinline__ void unpack8_fp8(uint2 w, f32x4& a, f32x4& b) {
    const f32x2_t p0 = __builtin_amdgcn_cvt_pk_f32_fp8((int)w.x, false), p1 = __builtin_amdgcn_cvt_pk_f32_fp8((int)w.x, true);
    const f32x2_t p2 = __builtin_amdgcn_cvt_pk_f32_fp8((int)w.y, false), p3 = __builtin_amdgcn_cvt_pk_f32_fp8((int)w.y, true);
    a = (f32x4){p0[0], p0[1], p1[0], p1[1]}; b = (f32x4){p2[0], p2[1], p3[0], p3[1]};
}
__device__ __forceinline__ void unpack8(u32x4 w, f32x4& a, f32x4& b) {
    a[0] = bflo(w.x); a[1] = bfhi(w.x); a[2] = bflo(w.y); a[3] = bfhi(w.y);
    b[0] = bflo(w.z); b[1] = bfhi(w.z); b[2] = bflo(w.w); b[3] = bfhi(w.w);
}

template <class T> __device__ __forceinline__ T ldws(const unsigned char* ws, unsigned off) { return *(const T*)(ws + off); }
__device__ __forceinline__ void sincos_d(double x, double& s, double& c) {
    const double TWO_OVER_PI = 0.63661977236758134308;
    const double PIO2_HI = 1.57079632679489655800e+00, PIO2_LO = 6.12323399573676603587e-17;
    double kd = rint(x * TWO_OVER_PI);
    double r = fma(-kd, PIO2_HI, x);
    r = fma(-kd, PIO2_LO, r);
    long long k = (long long)kd;
    double r2 = r * r;
    double sp = r * (1.0 + r2 * (-1.0 / 6 + r2 * (1.0 / 120 + r2 * (-1.0 / 5040 + r2 * (1.0 / 362880 + r2 * (-1.0 / 39916800 + r2 * (1.0 / 6227020800.0)))))));
    double cp = 1.0 + r2 * (-0.5 + r2 * (1.0 / 24 + r2 * (-1.0 / 720 + r2 * (1.0 / 40320 + r2 * (-1.0 / 3628800 + r2 * (1.0 / 479001600.0 + r2 * (-1.0 / 87178291200.0)))))));
    int q = (int)(k & 3);
    double ss = (q & 1) ? cp : sp, cc = (q & 1) ? sp : cp;
    if (q == 1) cc = -cc;
    if (q == 2) { ss = -ss; cc = -cc; }
    if (q == 3) ss = -ss;
    s = ss; c = cc;
}

__device__ __forceinline__ int winsrc(int v) {
    if (v < 512) return v;
    if (v < 1152) { const int b = v < 1024 ? 512 : 1024; int w = v - b; const int hd = w >> 6; w &= 63; const int i = w >> 3, jj = w & 7;
        return b + hd * 64 + (jj < 4 ? 4 * i + jj : 32 + 4 * i + (jj - 4)); }
    if (v < 1280) return v;
    if (v < 1568) { int w = v - 1280; const int hd = w >> 5; w &= 31; const int i = w >> 3, jj = w & 7;
        return 1280 + hd * 32 + (jj < 4 ? 4 * i + jj : 16 + 4 * i + (jj - 4)); }
    if (v < 1576) return v;
    if (v < 1792) return -1;
    if (v < 2816) return 1576 + (v - 1792);
    return 2600 + (v - 2816);
}
template <bool MAP>
__device__ __forceinline__ void transpose_item(const float* __restrict__ W, int K, int N, bf16_t* WT, int Nout, float* scr, int item, int lane) {
    const int nblk = Nout / 32, kb = item / nblk, nb = item % nblk, k0 = 64 * kb, n0 = 32 * nb;
    const int src = MAP ? winsrc(n0 + (lane & 31)) : n0 + (lane & 31);
#pragma unroll 8
    for (int i = 0; i < 32; ++i) { const int kk = 2 * i + (lane >> 5); scr[kk * 33 + (lane & 31)] = src >= 0 ? W[(size_t)(k0 + kk) * N + src] : 0.f; }
    asm volatile("s_waitcnt lgkmcnt(0)" ::: "memory");
    const int c = lane & 7;
#pragma unroll
    for (int j = 0; j < 4; ++j) {
        const int n = (lane >> 3) + 8 * j; const float* s = scr + (8 * c) * 33 + n;
        u32x4 o; o.x = cvt_pk_bf16(s[0 * 33], s[1 * 33]); o.y = cvt_pk_bf16(s[2 * 33], s[3 * 33]); o.z = cvt_pk_bf16(s[4 * 33], s[5 * 33]); o.w = cvt_pk_bf16(s[6 * 33], s[7 * 33]);
        *(u32x4*)(WT + (size_t)(n0 + n) * K + k0 + 8 * c) = o;
    }
    asm volatile("s_waitcnt lgkmcnt(0)" ::: "memory");
}


__device__ __forceinline__ unsigned fp6_code(float y) {
    const float a = fabsf(y);
    unsigned c;
    if (a < 1.f) c = (unsigned)(a * 8.f + 0.5f);
    else { c = ((__float_as_uint(a) + 0x00080000u) >> 20) - 1008u; c = c > 31u ? 31u : c; }
    return c | (y < 0.f ? 32u : 0u);
}
__device__ __forceinline__ void fp6_pack16(const unsigned (&c)[16], unsigned& w0, unsigned& w1, unsigned& w2) {
    w0 = c[0] | (c[1] << 6) | (c[2] << 12) | (c[3] << 18) | (c[4] << 24) | (c[5] << 30);
    w1 = (c[5] >> 2) | (c[6] << 4) | (c[7] << 10) | (c[8] << 16) | (c[9] << 22) | (c[10] << 28);
    w2 = (c[10] >> 4) | (c[11] << 2) | (c[12] << 8) | (c[13] << 14) | (c[14] << 20) | (c[15] << 26);
}
__device__ __forceinline__ void peer_table_row(const Params& p, int r, int lane, unsigned char* stage) {
    unsigned char* ut = WSP(unsigned char, WS_UTAB); unsigned char* vt = WSP(unsigned char, WS_VTAB);
    float* usc = WSP(float, WS_USC); float* vsc = WSP(float, WS_VSC);
    const int tb = r >> 14, e = r & 16383;
    const float* src = (tb ? p.peer_v : p.peer_u) + (size_t)e * DM;
    const bool six = tb ? (PEER_V6 != 0) : (PEER_U6 == 1);
    const bool nat16 = six && tb == 0;
    const int o0 = nat16 ? lane * 16 : lane * 8, o1 = nat16 ? lane * 16 + 8 : 512 + lane * 8;
    const f32x4 a0 = *(const f32x4*)(src + o0), a1 = *(const f32x4*)(src + o0 + 4), a2 = *(const f32x4*)(src + o1), a3 = *(const f32x4*)(src + o1 + 4);
    float m = 0.f;
#pragma unroll
    for (int i = 0; i < 4; ++i) m = fmaxf(m, fmaxf(fmaxf(fabsf(a0[i]), fabsf(a1[i])), fmaxf(fabsf(a2[i]), fabsf(a3[i]))));
    m = wave_max(m);
    if (six) {
        const float sc = m > 0.f ? 7.5f / m : 1.f;
        unsigned cd[16];
#pragma unroll
        for (int i = 0; i < 4; ++i) { cd[i] = fp6_code(a0[i] * sc); cd[4 + i] = fp6_code(a1[i] * sc); cd[8 + i] = fp6_code(a2[i] * sc); cd[12 + i] = fp6_code(a3[i] * sc); }
        unsigned w0, w1, w2; fp6_pack16(cd, w0, w1, w2);
        if (tb) { unsigned* dst = (unsigned*)(vt + (size_t)e * 768 + lane * 12); dst[0] = w0; dst[1] = w1; dst[2] = w2; }
        else {
            unsigned* st = (unsigned*)(stage + lane * 12); st[0] = w0; st[1] = w1; st[2] = w2;
            __builtin_amdgcn_s_waitcnt(0xC07F); __builtin_amdgcn_wave_barrier();
            if (lane < 48) {
                const int k3 = lane >> 3, h = (lane >> 2) & 1, q = lane & 3;
                *(u32x4*)(ut + (size_t)e * 768 + lane * 16) = *(const u32x4*)(stage + h * 384 + q * 96 + k3 * 16);
            }
            __builtin_amdgcn_s_waitcnt(0xC07F); __builtin_amdgcn_wave_barrier();
        }
        if (lane == 0) (tb ? vsc : usc)[e] = 1.f / sc;
    } else {
        const float sc = m > 0.f ? 224.f / m : 1.f;
        const uint2 w01 = pack8_fp8(a0 * sc, a1 * sc), w23 = pack8_fp8(a2 * sc, a3 * sc);
        if (tb == 0) {
            *(uint2*)(ut + (size_t)e * 1024 + lane * 8) = w01; *(uint2*)(ut + (size_t)e * 1024 + 512 + lane * 8) = w23;
            if (lane == 0) usc[e] = 1.f / sc;
        } else {
            *(u32x4*)(vt + (size_t)e * 1024 + lane * 16) = (u32x4){w01.x, w01.y, w23.x, w23.y};
            if (lane == 0) vsc[e] = 1.f / sc;
        }
    }
}
template <int PART>
__device__ __forceinline__ void phase_prep(const Params& p, unsigned char* smem, int vcu, int G) {
    int tid = threadIdx.x; asm volatile("" : "+v"(tid)); const int lane = tid & 63, wave = tid >> 6;
    const int gw = vcu * NWAVES + wave, NGW = G * NWAVES;
    const size_t gtid = (size_t)vcu * NT + tid, gsize = (size_t)G * NT;
    float* scr = (float*)smem + wave * 4096;
#pragma unroll 1
    for (int ord = 0; ord < 2; ++ord) {
    if ((ord == 0) != ((wave & 1) != 0)) {
    {
        constexpr int I_IN = 16 * (IN_WP / 32), I_GLU = 8 * 16, I_SUP = 8 * 32, I_AUP = 8 * 32, I_OUT = 16 * 32;
        constexpr int NITEMS = I_IN + I_GLU + I_SUP + I_AUP + I_OUT;
        for (int it = (PART == 0 ? gw : NITEMS); it < NITEMS; it += NGW) {
            int r = it;
            if (r < I_IN) { transpose_item<true>(p.w_in, 1024, IN_W, WSP(bf16_t, WS_WINT), IN_WP, scr, r, lane); continue; } r -= I_IN;
            if (r < I_GLU) { transpose_item<false>(p.w_glu, 512, 512, WSP(bf16_t, WS_WGLUT), 512, scr, r, lane); continue; } r -= I_GLU;
            if (r < I_SUP) { transpose_item<false>(p.w_ssm_up, 512, 1024, WSP(bf16_t, WS_WSUPT), 1024, scr, r, lane); continue; } r -= I_SUP;
            if (r < I_AUP) { transpose_item<false>(p.w_attn_up, 512, 1024, WSP(bf16_t, WS_WAUPT), 1024, scr, r, lane); continue; } r -= I_AUP;
            transpose_item<false>(p.w_out, 1024, 1024, WSP(bf16_t, WS_WOUTT), 1024, scr, r, lane);
        }
    }
    if (PART == 0) {
    {
        bf16_t* wct = WSP(bf16_t, WS_WCT);
        for (int it = gw; it < 16 * 8 * 64; it += NGW) {
            const int hh = it >> 9, kt = (it >> 6) & 7, ct = it & 63;
            const int h = hh >> 1, half = hh & 1;
            const float* ap = (half ? p.peer_k2 : p.peer_k1) + ((size_t)h * 128 + kt * 16 + (lane & 15)) * 128 + (lane >> 4);
            const float* bp = p.peer_wq + (size_t)(ct * 16 + (lane & 15)) * 2048 + h * 256 + half * 128 + (lane >> 4);
            f32x4 acc = {0.f, 0.f, 0.f, 0.f};
#pragma unroll 8
            for (int d0 = 0; d0 < 128; d0 += 4) acc = __builtin_amdgcn_mfma_f32_16x16x4f32(ap[d0], bp[d0], acc, 0, 0, 0);
            const float g2k = p.norm2_g[ct * 16 + (lane & 15)];
#pragma unroll
            for (int r = 0; r < 4; ++r) wct[(size_t)(hh * 128 + kt * 16 + 4 * (lane >> 4) + r) * 1024 + ct * 16 + (lane & 15)] = (bf16_t)f2bf(acc[r] * g2k);
        }
    }
#if !PEER_FP8
    {
        const size_t n8 = (size_t)16384 * 1024 / 8;
        u32x4* ut = WSP(u32x4, WS_UTAB); u32x4* vt = WSP(u32x4, WS_VTAB);
        for (size_t i = gtid; i < n8; i += gsize) {
            f32x4 a = ((const f32x4*)p.peer_u)[2 * i], b = ((const f32x4*)p.peer_u)[2 * i + 1];
            ut[i] = pack8(a, b);
            f32x4 c = ((const f32x4*)p.peer_v)[2 * i], d = ((const f32x4*)p.peer_v)[2 * i + 1];
            vt[i] = pack8(c, d);
        }
    }
#endif
    }
    if (PART == 0) {
    {
        float2* ra = WSP(float2, WS_ROPEA); float2* ri = WSP(float2, WS_ROPEI);
        for (size_t i = gtid; i < (size_t)SEQ * 32; i += gsize) {
            int pos = (int)(i >> 5), f = (int)(i & 31);
            double s, c; sincos_d((double)pos * p.inv64[f], s, c);
            ra[i] = make_float2((float)c, (float)s);
        }
        for (size_t i = gtid; i < (size_t)SEQ * 16; i += gsize) {
            int pos = (int)(i >> 4), f = (int)(i & 15);
            double s, c; sincos_d((double)pos * p.inv32[f], s, c);
            ri[i] = make_float2((float)c, (float)s);
        }
    }
    }
    {
    if (PART == 0) {
        float2* abar = WSP(float2, WS_SSMT);
        float2* bbar = abar + SSM_G * SSM_P;
        for (size_t i = gtid; i < (size_t)SSM_G * SSM_P; i += gsize) {
            int g = (int)(i / SSM_P);
            double are = p.a_re[i], aim = p.a_im[i];
            double dt = exp((double)p.log_dt[g]);
            double s, c; sincos_d(aim * dt, s, c);
            double mag = exp(are * dt);
            double abr = mag * c, abi = mag * s;
            abar[i] = make_float2((float)abr, (float)abi);
            double nr = abr - 1.0, ni = abi;
            double den = are * are + aim * aim;
            double qr = (nr * are + ni * aim) / den, qi = (ni * are - nr * aim) / den;
            for (int cch = 0; cch < SSM_N; ++cch) {
                double br = p.b_re[i * SSM_N + cch], bi = p.b_im[i * SSM_N + cch];
                bbar[i * SSM_N + cch] = make_float2((float)(qr * br - qi * bi), (float)(qr * bi + qi * br));
            }
        }
    }

    {
        bf16_t* kt = WSP(bf16_t, WS_KT);
        float* zb = (float*)smem + wave * 4096;
        for (int pair = (PART == 0 ? gw : SSM_G * 64); pair < SSM_G * 64; pair += NGW) {
            const int g = pair >> 6, l = pair & 63;
            {
                const int pp = lane; const size_t i = (size_t)g * SSM_P + pp;
                const double are = p.a_re[i], aim = p.a_im[i], dt = exp((double)p.log_dt[g]);
                double s1, c1; sincos_d(aim * dt, s1, c1); const double m1 = exp(are * dt);
                const double nr = m1 * c1 - 1.0, ni = m1 * s1, den = are * are + aim * aim;
                const double qr = (nr * are + ni * aim) / den, qi_ = (ni * are - nr * aim) / den;
                double sl, cl; sincos_d(aim * dt * l, sl, cl); const double ml = exp(are * dt * l);
                const double zr = ml * cl, zi = ml * sl;
                const double zqr = zr * qr - zi * qi_, zqi = zr * qi_ + zi * qr;
#pragma unroll
                for (int ci = 0; ci < 16; ++ci) {
                    const double br = p.b_re[i * SSM_N + ci], bi = p.b_im[i * SSM_N + ci];
                    *(float2*)(zb + 2 * (pp * 16 + ci)) = make_float2((float)(zqr * br - zqi * bi), (float)(zqr * bi + zqi * br));
                }
            }
            __builtin_amdgcn_s_waitcnt(0xC07F);
            __builtin_amdgcn_wave_barrier();
#pragma unroll 1
            for (int q4 = 0; q4 < 4; ++q4) {
                const int ent = q4 * 64 + lane, co = ent >> 4, ci = ent & 15;
                float acc = 0.f;
                for (int pp = 0; pp < 64; ++pp) {
                    const float cr = p.c_re[((size_t)g * SSM_N + co) * SSM_P + pp], cim = p.c_im[((size_t)g * SSM_N + co) * SSM_P + pp];
                    const float2 z = *(const float2*)(zb + 2 * (pp * 16 + ci));
                    acc += cr * z.x - cim * z.y;
                }
                if (l == 0 && co == ci) acc += p.d_skip[g * SSM_N + co];
                kt[(((size_t)g * 64 + l) * 2 + (ci >> 3)) * 128 + co * 8 + (ci & 7)] = (bf16_t)f2bf(acc);
            }
            __builtin_amdgcn_wave_barrier();
        }
        bf16_t* w1t = WSP(bf16_t, WS_W1T); bf16_t* w3t = WSP(bf16_t, WS_W3T); float2* a64 = WSP(float2, WS_A64);
        for (size_t it = (PART == 1 ? gtid : (size_t)SSM_G * SSM_P * 64); it < (size_t)SSM_G * SSM_P * 64; it += gsize) {
            const int e = (int)(it & 63), pp = (int)((it >> 6) & 63), g = (int)(it >> 12);
            const size_t i = (size_t)g * SSM_P + pp;
            const double are = p.a_re[i], aim = p.a_im[i], dt = exp((double)p.log_dt[g]);
            double s1, c1; sincos_d(aim * dt, s1, c1); const double m1 = exp(are * dt);
            const double nr = m1 * c1 - 1.0, ni = m1 * s1, den = are * are + aim * aim;
            const double qr = (nr * are + ni * aim) / den, qi_ = (ni * are - nr * aim) / den;
            {
                const int l = 63 - e; double sl, cl; sincos_d(aim * dt * l, sl, cl); const double ml = exp(are * dt * l);
                const double zr = ml * cl, zi = ml * sl, wr_ = zr * qr - zi * qi_, wi_ = zr * qi_ + zi * qr;
                unsigned re_w[8], im_w[8];
#pragma unroll
                for (int c2 = 0; c2 < 8; ++c2) {
                    const double br0 = p.b_re[i * SSM_N + 2 * c2], bi0 = p.b_im[i * SSM_N + 2 * c2], br1 = p.b_re[i * SSM_N + 2 * c2 + 1], bi1 = p.b_im[i * SSM_N + 2 * c2 + 1];
                    re_w[c2] = f2bf((float)(wr_ * br0 - wi_ * bi0)) | (f2bf((float)(wr_ * br1 - wi_ * bi1)) << 16);
                    im_w[c2] = f2bf((float)(wr_ * bi0 + wi_ * br0)) | (f2bf((float)(wr_ * bi1 + wi_ * br1)) << 16);
                }
                u32x4* d0 = (u32x4*)(w1t + ((size_t)g * 128 + 2 * pp) * 1024 + e * 16);
                d0[0] = (u32x4){re_w[0], re_w[1], re_w[2], re_w[3]}; d0[1] = (u32x4){re_w[4], re_w[5], re_w[6], re_w[7]};
                u32x4* d1 = (u32x4*)(w1t + ((size_t)g * 128 + 2 * pp + 1) * 1024 + e * 16);
                d1[0] = (u32x4){im_w[0], im_w[1], im_w[2], im_w[3]}; d1[1] = (u32x4){im_w[4], im_w[5], im_w[6], im_w[7]};
            }
            {
                const int l = e + 1; double sl, cl; sincos_d(aim * dt * l, sl, cl); const double ml = exp(are * dt * l);
                const double zr = ml * cl, zi = ml * sl;
                for (int co = 0; co < 16; ++co) {
                    const double cr = p.c_re[((size_t)g * SSM_N + co) * SSM_P + pp], cim = p.c_im[((size_t)g * SSM_N + co) * SSM_P + pp];
                    const unsigned w = f2bf((float)(cr * zr - cim * zi)) | (f2bf((float)(-(cr * zi + cim * zr))) << 16);
                    *(unsigned*)(w3t + (((size_t)g * 64 + e) * 16 + co) * 128 + 2 * pp) = w;
                }
            }
            if (e == 0) { double sl, cl; sincos_d(aim * dt * 64, sl, cl); const double ml = exp(are * dt * 64); a64[i] = make_float2((float)(ml * cl), (float)(ml * sl)); }
        }
    }
    }
    } else {
    if (PART == 0) {
    {
        bf16_t* O = WSP(bf16_t, WS_R1);
        for (int row = gw; row < MTOK; row += NGW) {
            const float* xr = p.x + (size_t)row * DM;
            f32x4 v[4]; float ss = 0.f;
#pragma unroll
            for (int c = 0; c < 2; ++c) {
                v[2 * c] = *(const f32x4*)(xr + c * 512 + lane * 8); v[2 * c + 1] = *(const f32x4*)(xr + c * 512 + lane * 8 + 4);
            }
#pragma unroll
            for (int i = 0; i < 4; ++i) ss += v[i][0] * v[i][0] + v[i][1] * v[i][1] + v[i][2] * v[i][2] + v[i][3] * v[i][3];
            ss = wave_sum(ss);
            const float sc = rsqrtf(ss * (1.f / DM) + NORM_EPS);
#pragma unroll
            for (int c = 0; c < 2; ++c) {
                f32x4 ga = *(const f32x4*)(p.norm1_g + c * 512 + lane * 8), gb = *(const f32x4*)(p.norm1_g + c * 512 + lane * 8 + 4);
                *(u32x4*)(O + (size_t)row * DM + c * 512 + lane * 8) = pack8(v[2 * c] * sc * ga, v[2 * c + 1] * sc * gb);
            }
        }
    }
    }
    }
    }
}

#define EPI_ARGS const f32x4 (&acc)[2][2][4][2], const pg8::Unit& u, int wr_, int wc_, int fr_, int fq_
#define EPI_COORDS int t_ = threadIdx.x; asm volatile("" : "+v"(t_)); const int wid_ = __builtin_amdgcn_readfirstlane(t_ >> 6); \
    const int wr = wid_ >> 2, wc = wid_ & 3, fr = t_ & 15, fq = (t_ >> 4) & 3; (void)wr_; (void)wc_; (void)fr_; (void)fq_;
#define EPI_LOOP(...) \
    _Pragma("unroll") for (int ai = 0; ai < 2; ++ai) _Pragma("unroll") for (int m = 0; m < 4; ++m) { \
        const int row = u.pm * 256 + ai * 128 + wr * 64 + m * 16 + fr; \
        _Pragma("unroll") for (int bj = 0; bj < 2; ++bj) { const int vc = bj * 128 + wc * 32 + fq * 8; const f32x4 a0 = acc[ai][bj][m][0], a1 = acc[ai][bj][m][1]; __VA_ARGS__ } }

struct EpiInProj {
    static constexpr bool PERM = true, AFTER_DRAIN = false, CHAIN = false;
    bf16_t *u_, *q, *k, *v, *qi, *ki, *sgs, *sga; float* wi; const float2 *ropeA, *ropeI;
    __device__ __forceinline__ void rope_store(bf16_t* dst, const float2* cs, f32x4 a0, f32x4 a1) const {
        const f32x4 c01 = *(const f32x4*)cs, c23 = *(const f32x4*)(cs + 2);
        f32x4 r1, r2;
        r1[0] = a0[0] * c01[0] - a1[0] * c01[1]; r2[0] = a1[0] * c01[0] + a0[0] * c01[1];
        r1[1] = a0[1] * c01[2] - a1[1] * c01[3]; r2[1] = a1[1] * c01[2] + a0[1] * c01[3];
        r1[2] = a0[2] * c23[0] - a1[2] * c23[1]; r2[2] = a1[2] * c23[0] + a0[2] * c23[1];
        r1[3] = a0[3] * c23[2] - a1[3] * c23[3]; r2[3] = a1[3] * c23[2] + a0[3] * c23[3];
        *(u32x4*)dst = pack8(r1, r2);
    }
    __device__ __forceinline__ void rope_store8(unsigned char* dst, const float2* cs, f32x4 a0, f32x4 a1) const {
        const f32x4 c01 = *(const f32x4*)cs, c23 = *(const f32x4*)(cs + 2);
        f32x4 r1, r2;
        r1[0] = a0[0] * c01[0] - a1[0] * c01[1]; r2[0] = a1[0] * c01[0] + a0[0] * c01[1];
        r1[1] = a0[1] * c01[2] - a1[1] * c01[3]; r2[1] = a1[1] * c01[2] + a0[1] * c01[3];
        r1[2] = a0[2] * c23[0] - a1[2] * c23[1]; r2[2] = a1[2] * c23[0] + a0[2] * c23[1];
        r1[3] = a0[3] * c23[2] - a1[3] * c23[3]; r2[3] = a1[3] * c23[2] + a0[3] * c23[3];
        *(uint2*)dst = pack8_fp8(r1 * 16.f, r2 * 16.f);
    }
    __device__ __forceinline__ void operator()(EPI_ARGS) const {
        EPI_COORDS
        const int pn = u.pn;
        if (pn < 2) {
            EPI_LOOP({ *(u32x4*)(u_ + (size_t)row * 512 + pn * 256 + vc) = pack8(a0, a1); })
        } else if (pn < 4) {
            EPI_LOOP({ rope_store(q + (size_t)row * 512 + (pn - 2) * 256 + vc, ropeA + (row & (SEQ - 1)) * 32 + ((wc & 1) * 4 + fq) * 4, a0, a1); })
        } else if (pn == 4) {
            EPI_LOOP({ if (bj == 0) rope_store8((unsigned char*)k + (size_t)row * 128 + vc, ropeA + (row & (SEQ - 1)) * 32 + ((wc & 1) * 4 + fq) * 4, a0, a1);
                       else *(uint2*)((unsigned char*)v + (size_t)row * 128 + (vc - 128)) = pack8_fp8(a0 * 16.f, a1 * 16.f); })
        } else if (pn == 5) {
            EPI_LOOP({ rope_store(qi + (size_t)row * 256 + vc, ropeI + (row & (SEQ - 1)) * 16 + fq * 4, a0, a1); })
        } else if (pn == 6) {
            EPI_LOOP({ if (bj == 0) { if (wc == 0) rope_store(ki + (size_t)row * 32 + fq * 8, ropeI + (row & (SEQ - 1)) * 16 + fq * 4, a0, a1);
                                      else if (wc == 1 && fq == 0) { *(f32x4*)(wi + (size_t)row * 8) = a0; *(f32x4*)(wi + (size_t)row * 8 + 4) = a1; } } })
        } else if (pn < 11) {
            EPI_LOOP({ f32x4 s0, s1;
                       _Pragma("unroll") for (int j = 0; j < 4; ++j) { s0[j] = sigmoidf_(a0[j]); s1[j] = sigmoidf_(a1[j]); }
                       *(u32x4*)(sgs + (size_t)row * 1024 + (pn - 7) * 256 + vc) = pack8(s0, s1); })
        } else {
            EPI_LOOP({ f32x4 s0, s1;
                       _Pragma("unroll") for (int j = 0; j < 4; ++j) { s0[j] = sigmoidf_(a0[j]); s1[j] = sigmoidf_(a1[j]); }
                       *(u32x4*)(sga + (size_t)row * 1024 + (pn - 11) * 256 + vc) = pack8(s0, s1); })
        }
    }
};
struct EpiGlu {
    static constexpr bool PERM = true, AFTER_DRAIN = false, CHAIN = false;
    const bf16_t* y; bf16_t* o;
    __device__ __forceinline__ void operator()(EPI_ARGS) const {
        EPI_COORDS
        EPI_LOOP({ const size_t idx = (size_t)row * 512 + u.pn * 256 + vc; f32x4 y0, y1; unpack8(*(const u32x4*)(y + idx), y0, y1);
                   _Pragma("unroll") for (int j = 0; j < 4; ++j) { y0[j] *= sigmoidf_(a0[j]); y1[j] *= sigmoidf_(a1[j]); }
                   *(u32x4*)(o + idx) = pack8(y0, y1); })
    }
};
struct EpiMerge1 {
    static constexpr bool PERM = true, AFTER_DRAIN = false, CHAIN = false;
    const bf16_t* g; bf16_t* t;
    __device__ __forceinline__ void operator()(EPI_ARGS) const {
        EPI_COORDS
        EPI_LOOP({ const size_t idx = (size_t)row * 1024 + u.pn * 256 + vc; f32x4 g0, g1; unpack8(*(const u32x4*)(g + idx), g0, g1);
                   *(u32x4*)(t + idx) = pack8(g0 * a0, g1 * a1); })
    }
};
struct EpiMerge2 {
    static constexpr bool PERM = true, AFTER_DRAIN = false, CHAIN = false;
    const bf16_t* g; const bf16_t* t; bf16_t* o;
    __device__ __forceinline__ void operator()(EPI_ARGS) const {
        EPI_COORDS
        EPI_LOOP({ const size_t idx = (size_t)row * 1024 + u.pn * 256 + vc; f32x4 g0, g1, t0, t1; unpack8(*(const u32x4*)(g + idx), g0, g1); unpack8(*(const u32x4*)(t + idx), t0, t1);
                   *(u32x4*)(o + idx) = pack8(t0 + g0 * a0, t1 + g1 * a1); })
    }
};
struct EpiMergeChain {
    static constexpr bool PERM = true, AFTER_DRAIN = false, CHAIN = true;
    const bf16_t* gs; const bf16_t* ga; bf16_t* o;
    __device__ __forceinline__ void operator()(f32x4 (&acc)[2][2][4][2], const pg8::Unit& u, int wr_, int wc_, int fr_, int fq_) const {
        EPI_COORDS
#pragma unroll
        for (int ai = 0; ai < 2; ++ai)
#pragma unroll
            for (int m = 0; m < 4; ++m) {
                const int row = u.pm * 256 + ai * 128 + wr * 64 + m * 16 + fr;
#pragma unroll
                for (int bj = 0; bj < 2; ++bj) {
                    const size_t idx = (size_t)row * 1024 + u.pn * 256 + bj * 128 + wc * 32 + fq * 8;
                    f32x4 a0, a1; unpack8(*(const u32x4*)(ga + idx), a0, a1);
                    if (u.sel == 0) {
                        f32x4 s0, s1; unpack8(*(const u32x4*)(gs + idx), s0, s1);
#pragma unroll
                        for (int j = 0; j < 4; ++j) { acc[ai][bj][m][0][j] *= s0[j] * __builtin_amdgcn_rcpf(a0[j]); acc[ai][bj][m][1][j] *= s1[j] * __builtin_amdgcn_rcpf(a1[j]); }
                    } else {
                        *(u32x4*)(o + idx) = pack8(acc[ai][bj][m][0] * a0, acc[ai][bj][m][1] * a1);
                    }
                }
            }
    }
};
struct EpiOut {
    static constexpr bool PERM = true, AFTER_DRAIN = false, CHAIN = false;
    const float* x; bf16_t* hb; float* rss;
    __device__ __forceinline__ void operator()(EPI_ARGS) const {
        EPI_COORDS
#pragma unroll
        for (int ai = 0; ai < 2; ++ai)
#pragma unroll
            for (int m = 0; m < 4; ++m) {
                const int row = u.pm * 256 + ai * 128 + wr * 64 + m * 16 + fr;
                float ss = 0.f;
#pragma unroll
                for (int bj = 0; bj < 2; ++bj) {
                    const int col = u.pn * 256 + bj * 128 + wc * 32 + fq * 8;
                    const size_t idx = (size_t)row * 1024 + col;
                    const f32x4 h0 = *(const f32x4*)(x + idx) + acc[ai][bj][m][0], h1 = *(const f32x4*)(x + idx + 4) + acc[ai][bj][m][1];
                    ss += h0[0] * h0[0] + h0[1] * h0[1] + h0[2] * h0[2] + h0[3] * h0[3] + h1[0] * h1[0] + h1[1] * h1[1] + h1[2] * h1[2] + h1[3] * h1[3];
                    *(u32x4*)(hb + idx) = pack8(h0, h1);
                }
                ss += __shfl_xor(ss, 16); ss += __shfl_xor(ss, 32);
                if (fq == 0) rss[(size_t)row * 16 + u.pn * 4 + wc] = ss;
            }
    }
};
typedef _Float16 f16x8 __attribute__((ext_vector_type(8)));
struct EpiScores {
    static constexpr bool PERM = true, AFTER_DRAIN = false, CHAIN = false;
    _Float16* o;
    __device__ __forceinline__ void operator()(EPI_ARGS) const {
        EPI_COORDS
        EPI_LOOP({ const size_t idx = (size_t)row * 2048 + u.pn * 256 + vc;
                   f16x8 hv = {(_Float16)a0[0], (_Float16)a0[1], (_Float16)a0[2], (_Float16)a0[3], (_Float16)a1[0], (_Float16)a1[1], (_Float16)a1[2], (_Float16)a1[3]};
                   *(f16x8*)(o + idx) = hv; })
    }
};

template <class Epi>
__device__ __forceinline__ void run_gemm_chain(LAS unsigned char* lds, const bf16_t* A, const bf16_t* Bt, const bf16_t* A2, const bf16_t* Bt2, int M, int N, int K, int G, const Epi& E) {
    pg8::Gemm g{A, Bt, M, N, K, A2, Bt2}; pg8::ChainOrder S; S.init(M, N, G, (int)blockIdx.x);
    pg8::gemm_phase<Epi, pg8::ChainOrder, true, true>(lds, g, S, E);
}
template <class Epi>
__device__ __forceinline__ void run_gemm(LAS unsigned char* lds, const bf16_t* A, const bf16_t* Bt, int M, int N, int K, int G, const Epi& E) {
    pg8::Gemm g{A, Bt, M, N, K}; pg8::StaticOrder S; S.init(M, N, G, (int)blockIdx.x);
    pg8::gemm_phase<Epi, pg8::StaticOrder, true, true>(lds, g, S, E);
}

__device__ __forceinline__ void ssm_item(const Params& p, float* us, bf16_t* yg, int item, int lane) {
    const float2* abar_t = WSP(float2, WS_SSMT);
    const float2* bbar_t = abar_t + SSM_G * SSM_P;
    const bf16_t* u = WSP(bf16_t, WS_U);
    const int b = item / SSM_G, g = item % SSM_G;
    const float2 ab = abar_t[g * SSM_P + lane];
    float br[16], bi[16], cr[16], ci[16];
#pragma unroll
    for (int c = 0; c < 16; ++c) {
        float2 t = bbar_t[(g * SSM_P + lane) * SSM_N + c];
        br[c] = t.x; bi[c] = t.y;
        cr[c] = p.c_re[((size_t)g * SSM_N + c) * SSM_P + lane];
        ci[c] = p.c_im[((size_t)g * SSM_N + c) * SSM_P + lane];
    }
    const int myc = ((lane >> 5) & 1) * 8 + ((lane >> 4) & 1) * 4 + ((lane >> 3) & 1) * 2 + ((lane >> 2) & 1);
    const float dsk = p.d_skip[g * SSM_N + myc];
    float xr = 0.f, xi = 0.f;
    for (int t0 = 0; t0 < SEQ; t0 += 64) {
        {
            const bf16_t* ur = u + ((size_t)(b * SEQ + t0 + lane)) * SSM_W + g * SSM_N;
            f32x4 f0, f1, f2, f3; unpack8(*(const u32x4*)ur, f0, f1); unpack8(*(const u32x4*)(ur + 8), f2, f3);
            float* d = us + lane * 16;
            *(f32x4*)d = f0; *(f32x4*)(d + 4) = f1; *(f32x4*)(d + 8) = f2; *(f32x4*)(d + 12) = f3;
        }
        __builtin_amdgcn_s_waitcnt(0);
        __builtin_amdgcn_wave_barrier();
        for (int tt = 0; tt < 64; ++tt) {
            float uu[16];
#pragma unroll
            for (int c4 = 0; c4 < 4; ++c4) {
                f32x4 t = *(const f32x4*)(us + tt * 16 + c4 * 4);
                uu[c4 * 4] = t[0]; uu[c4 * 4 + 1] = t[1]; uu[c4 * 4 + 2] = t[2]; uu[c4 * 4 + 3] = t[3];
            }
            float bur = 0.f, bui = 0.f;
#pragma unroll
            for (int c = 0; c < 16; ++c) { bur += br[c] * uu[c]; bui += bi[c] * uu[c]; }
            float nxr = ab.x * xr - ab.y * xi + bur;
            float nxi = ab.x * xi + ab.y * xr + bui;
            xr = nxr; xi = nxi;
            float z[16];
#pragma unroll
            for (int c = 0; c < 16; ++c) z[c] = cr[c] * xr - ci[c] * xi;
            float w8[8], w4[4], w2[2], w1;
            const bool h5 = lane & 32, h4 = lane & 16, h3 = lane & 8, h2 = lane & 4;
#pragma unroll
            for (int i = 0; i < 8; ++i) { float mine = h5 ? z[8 + i] : z[i], oth = h5 ? z[i] : z[8 + i]; w8[i] = mine + __shfl_xor(oth, 32); }
#pragma unroll
            for (int i = 0; i < 4; ++i) { float mine = h4 ? w8[4 + i] : w8[i], oth = h4 ? w8[i] : w8[4 + i]; w4[i] = mine + __shfl_xor(oth, 16); }
#pragma unroll
            for (int i = 0; i < 2; ++i) { float mine = h3 ? w4[2 + i] : w4[i], oth = h3 ? w4[i] : w4[2 + i]; w2[i] = mine + __shfl_xor(oth, 8); }
            { float mine = h2 ? w2[1] : w2[0], oth = h2 ? w2[0] : w2[1]; w1 = mine + __shfl_xor(oth, 4); }
            w1 += __shfl_xor(w1, 2);
            w1 += __shfl_xor(w1, 1);
            float um = 0.f;
#pragma unroll
            for (int c = 0; c < 16; ++c) um = (c == myc) ? uu[c] : um;
            float y = gelu_tanh(w1 + dsk * um);
            if ((lane & 3) == 0) yg[((size_t)(b * SEQ + t0 + tt)) * SSM_W + g * SSM_N + myc] = (bf16_t)f2bf(y);
        }
        __builtin_amdgcn_wave_barrier();
    }
}


__device__ __forceinline__ void ssm_fast_item(const Params& p, unsigned char* smem, unsigned yg_off, int item, int lane_in, int wave) {
    const unsigned char* W = p.ws;
    constexpr unsigned O_U = WS_U << 20, O_W1T = WS_W1T << 20, O_W3T = WS_W3T << 20;
    const int b = item >> 5, g = item & 31;
    int lane = lane_in; asm volatile("" : "+v"(lane));
    const int gq = lane >> 4, c = lane & 15, rg = wave & 3, hf = wave >> 2;
    bf16_t* Kl = (bf16_t*)smem; float* Sl = (float*)(smem + 32768); bf16_t* Xb = (bf16_t*)(smem + 65536);
    __syncthreads();
    {
        const u32x4* src = (const u32x4*)(WSP(bf16_t, WS_KT) + (size_t)g * 64 * 256); u32x4* dst = (u32x4*)smem;
        for (int i = wave * 64 + lane; i < 2048; i += NT) dst[i] = src[i];
    }
    bf16x8 A[32];
#pragma unroll
    for (int ks = 0; ks < 32; ++ks)
        A[ks] = ldws<bf16x8>(W, O_U + ((unsigned)(b * SEQ + (16 * rg + c) * 64 + 2 * ks + (gq >> 1)) * 512u + g * 16 + 8 * (gq & 1)) * 2u);
#pragma unroll 1
    for (int nt = 0; nt < 4; ++nt) {
        f32x4 acc = {0.f, 0.f, 0.f, 0.f};
        const unsigned wb = O_W1T + ((unsigned)(g * 128 + (4 * hf + nt) * 16 + c) * 1024u + 8 * gq) * 2u;
#pragma unroll
        for (int ks = 0; ks < 32; ++ks) acc = __builtin_amdgcn_mfma_f32_16x16x32_bf16(A[ks], ldws<bf16x8>(W, wb + ks * 64), acc, 0, 0, 0);
#pragma unroll
        for (int r = 0; r < 4; ++r) Sl[(16 * rg + 4 * gq + r) * 128 + (4 * hf + nt) * 16 + c] = acc[r];
    }
    __syncthreads();
    if (wave == 0) {
        const float2 a = WSP(float2, WS_A64)[g * SSM_P + lane];
        float xr = 0.f, xi = 0.f;
        for (int ch = 0; ch < 64; ++ch) {
            *(unsigned*)(Xb + ch * 128 + 2 * lane) = f2bf(xr) | (f2bf(xi) << 16);
            const float2 sv = *(const float2*)(Sl + ch * 128 + 2 * lane);
            const float nr = a.x * xr - a.y * xi + sv.x, ni = a.x * xi + a.y * xr + sv.y;
            xr = nr; xi = ni;
        }
    }
    __syncthreads();
    bf16x8 Xa[4];
#pragma unroll
    for (int k2 = 0; k2 < 4; ++k2) Xa[k2] = *(const bf16x8*)(Xb + (16 * rg + c) * 128 + 32 * k2 + 8 * gq);
    bf16_t* yg = (bf16_t*)(p.ws + yg_off);
    const int gh = gq >> 1;
    const bf16_t* kl_lane = Kl + (gq & 1) * 128 + c * 8;
    bf16x8 w3[4];
    {
        const unsigned wb0 = O_W3T + ((unsigned)((g * 64 + hf) * 16 + c) * 128u + 8 * gq) * 2u;
#pragma unroll
        for (int k2 = 0; k2 < 4; ++k2) w3[k2] = ldws<bf16x8>(W, wb0 + k2 * 64);
    }
#pragma unroll 1
    for (int tq = 0; tq < 32; ++tq) {
        const int tp = 2 * tq + hf;
        f32x4 acc = {0.f, 0.f, 0.f, 0.f};
#pragma unroll
        for (int k2 = 0; k2 < 4; ++k2) acc = __builtin_amdgcn_mfma_f32_16x16x32_bf16(Xa[k2], w3[k2], acc, 0, 0, 0);
        {
            const int tn = tq < 31 ? tp + 2 : tp;
            const unsigned wb = O_W3T + ((unsigned)((g * 64 + tn) * 16 + c) * 128u + 8 * gq) * 2u;
#pragma unroll
            for (int k2 = 0; k2 < 4; ++k2) w3[k2] = ldws<bf16x8>(W, wb + k2 * 64);
        }
#pragma unroll
        for (int ks = 0; ks < 32; ++ks) {
            if (ks <= tq) {
                const int l = tp - 2 * ks - gh;
                bf16x8 kb = *(const bf16x8*)(kl_lane + (l < 0 ? 0 : l) * 256);
                if (l < 0) kb = (bf16x8){0, 0, 0, 0, 0, 0, 0, 0};
                acc = __builtin_amdgcn_mfma_f32_16x16x32_bf16(A[ks], kb, acc, 0, 0, 0);
            }
        }
#pragma unroll
        for (int r = 0; r < 4; ++r)
            yg[((size_t)(b * SEQ + (16 * rg + 4 * gq + r) * 64 + tp)) * SSM_W + g * SSM_N + c] = (bf16_t)f2bf(gelu_tanh(acc[r]));
    }
}

__device__ __forceinline__ unsigned fkey(float f) {
    unsigned u = __builtin_bit_cast(unsigned, f);
    return (u & 0x80000000u) ? ~u : (u | 0x80000000u);
}
__device__ __forceinline__ void phase_attn(const Params& p, unsigned char* smem, bf16_t* yatt, int vcu, int G) {
    float* sc = (float*)smem;
    float* qis = sc + 4096;
    float* wis = qis + 256;
    float* qs = wis + 16;
    float* pl = qs + 512;
    int* sel = (int*)(pl + 2048);
    unsigned* hist = (unsigned*)(sel + 256);
    int* scanA = (int*)(hist + 256);
    int* scanB = scanA + 512;
    int* misc = scanB + 512;
    int tid = threadIdx.x; asm volatile("" : "+v"(tid));
    const bf16_t* qi = WSP(bf16_t, WS_QI); const bf16_t* ki = WSP(bf16_t, WS_KI); const float* wi = WSP(float, WS_WI);
    const bf16_t* q = WSP(bf16_t, WS_Q); const bf16_t* kk = WSP(bf16_t, WS_K); const bf16_t* vv = WSP(bf16_t, WS_V);
    for (int row = vcu; row < MTOK; row += G) {
        const int b = row / SEQ, t = row % SEQ, nvalid = t + 1;
        __syncthreads();
        if (tid < 256) qis[tid] = bf2f(qi[(size_t)row * 256 + tid]);
        if (tid < 8) wis[tid] = wi[(size_t)row * 8 + tid];
        qs[tid] = bf2f(q[(size_t)row * 512 + tid]);
        __syncthreads();
        for (int s = tid; s < nvalid; s += NT) {
            const bf16_t* kr = ki + ((size_t)b * SEQ + s) * 32;
            float kv[32];
#pragma unroll
            for (int d8 = 0; d8 < 4; ++d8) {
                f32x4 a, bb; unpack8(*(const u32x4*)(kr + d8 * 8), a, bb);
                kv[d8 * 8] = a[0]; kv[d8 * 8 + 1] = a[1]; kv[d8 * 8 + 2] = a[2]; kv[d8 * 8 + 3] = a[3];
                kv[d8 * 8 + 4] = bb[0]; kv[d8 * 8 + 5] = bb[1]; kv[d8 * 8 + 6] = bb[2]; kv[d8 * 8 + 7] = bb[3];
            }
            float a = 0.f;
#pragma unroll
            for (int h = 0; h < 8; ++h) {
                float d = 0.f;
#pragma unroll
                for (int dd = 0; dd < 32; ++dd) d += qis[h * 32 + dd] * kv[dd];
                a += wis[h] * fmaxf(d, 0.f);
            }
#ifdef PROBE_ATTN
            sc[s] = (float)(_Float16)a;
#else
            sc[s] = a;
#endif
        }
        __syncthreads();
        int nsel;
        if (nvalid <= TOPK) {
            nsel = nvalid;
            if (tid < nvalid) sel[tid] = tid;
        } else {
            nsel = TOPK;
            unsigned prefix = 0, mask = 0; int need = TOPK;
            for (int pass = 0; pass < 4; ++pass) {
                const int shift = 24 - 8 * pass;
                if (tid < 256) hist[tid] = 0;
                __syncthreads();
                for (int s = tid; s < nvalid; s += NT) {
                    unsigned key = fkey(sc[s]);
                    if ((key & mask) == prefix) atomicAdd(&hist[(key >> shift) & 255], 1u);
                }
                __syncthreads();
                if (tid == 0) {
                    int cum = 0, bin = 255;
                    for (; bin > 0; --bin) { if (cum + (int)hist[bin] >= need) break; cum += hist[bin]; }
                    misc[0] = bin; misc[1] = need - cum;
                }
                __syncthreads();
                prefix |= (unsigned)misc[0] << shift; mask |= 0xFFu << shift; need = misc[1];
                __syncthreads();
            }
            const int base = tid * 8;
            int cg = 0, ce = 0;
            for (int i = 0; i < 8; ++i) { int s = base + i; if (s < nvalid) { unsigned key = fkey(sc[s]); cg += key > prefix; ce += key == prefix; } }
            scanA[tid] = ce;
            __syncthreads();
            if (tid == 0) { int run = 0; for (int i = 0; i < NT; ++i) { int v = scanA[i]; scanA[i] = run; run += v; } }
            __syncthreads();
            const int preE = scanA[tid];
            int takeE = need - preE; takeE = takeE < 0 ? 0 : (takeE > ce ? ce : takeE);
            scanB[tid] = cg + takeE;
            __syncthreads();
            if (tid == 0) { int run = 0; for (int i = 0; i < NT; ++i) { int v = scanB[i]; scanB[i] = run; run += v; } }
            __syncthreads();
            int off = scanB[tid], te = 0;
            for (int i = 0; i < 8; ++i) {
                int s = base + i;
                if (s < nvalid) {
                    unsigned key = fkey(sc[s]);
                    bool take = key > prefix;
                    if (key == prefix) { take = te < takeE; ++te; }
                    if (take) { if (off < TOPK) sel[off] = s; ++off; }
                }
            }
        }
        __syncthreads();
        {
            const int j = tid & 255, n = tid >> 8;
            if (j < nsel) {
                const unsigned char* kr = (const unsigned char*)kk + ((size_t)b * SEQ + sel[j]) * 128 + n * 64;
                float kf[64];
#pragma unroll
                for (int d8 = 0; d8 < 8; ++d8) {
                    f32x4 a, bb; unpack8_fp8(*(const uint2*)(kr + d8 * 8), a, bb); a *= (1.f / 16.f); bb *= (1.f / 16.f);
                    kf[d8 * 8] = a[0]; kf[d8 * 8 + 1] = a[1]; kf[d8 * 8 + 2] = a[2]; kf[d8 * 8 + 3] = a[3];
                    kf[d8 * 8 + 4] = bb[0]; kf[d8 * 8 + 5] = bb[1]; kf[d8 * 8 + 6] = bb[2]; kf[d8 * 8 + 7] = bb[3];
                }
#pragma unroll
                for (int hh = 0; hh < 4; ++hh) {
                    const int h = n * 4 + hh;
                    float d = 0.f;
#pragma unroll
                    for (int dd = 0; dd < 64; ++dd) d += qs[h * 64 + dd] * kf[dd];
                    pl[h * 256 + j] = d * 0.125f;
                }
            } else {
#pragma unroll
                for (int hh = 0; hh < 4; ++hh) pl[(n * 4 + hh) * 256 + j] = -1e30f;
            }
        }
        __syncthreads();
        {
            const int h = tid >> 6, l = tid & 63;
            float vals[4]; float mx = -3e38f;
#pragma unroll
            for (int i = 0; i < 4; ++i) { vals[i] = pl[h * 256 + l + 64 * i]; mx = fmaxf(mx, vals[i]); }
#pragma unroll
            for (int o = 32; o >= 1; o >>= 1) mx = fmaxf(mx, __shfl_xor(mx, o));
            float sm = 0.f;
#pragma unroll
            for (int i = 0; i < 4; ++i) { vals[i] = __expf(vals[i] - mx); sm += vals[i]; }
            sm = wave_sum(sm);
            float inv = 1.f / sm;
#pragma unroll
            for (int i = 0; i < 4; ++i) pl[h * 256 + l + 64 * i] = vals[i] * inv;
        }
        __syncthreads();
        {
            const int h = tid >> 6, d = tid & 63, n = h >> 2;
            float a = 0.f;
            for (int j = 0; j < nsel; ++j) {
                const unsigned wv = *(const unsigned*)((const unsigned char*)vv + ((size_t)b * SEQ + sel[j]) * 128 + n * 64 + (d & ~3));
                const f32x2_t pv0 = __builtin_amdgcn_cvt_pk_f32_fp8((int)wv, false), pv1 = __builtin_amdgcn_cvt_pk_f32_fp8((int)wv, true);
                const float vsel = (d & 2) ? ((d & 1) ? pv1[1] : pv1[0]) : ((d & 1) ? pv0[1] : pv0[0]);
                const int pq = __builtin_amdgcn_cvt_pk_fp8_f32(pl[h * 256 + j] * 256.f, 0.f, 0, false);
                const f32x2_t pd = __builtin_amdgcn_cvt_pk_f32_fp8(pq, false);
                a += pd[0] * vsel * (1.f / 4096.f);
            }
            yatt[(size_t)row * 512 + tid] = (bf16_t)f2bf(a);
        }
    }
}


typedef short v4i16_t __attribute__((ext_vector_type(4)));
constexpr int DSA_KSTR = 8200, DSA_SEL_OFF = 16 * DSA_KSTR, DSA_NSEL_OFF = DSA_SEL_OFF + 8192, DSA_HIST_OFF = DSA_NSEL_OFF + 256, DSA_VST = 5120;
__device__ __forceinline__ int mbcnt64(unsigned long long m) { return __builtin_amdgcn_mbcnt_hi((unsigned)(m >> 32), __builtin_amdgcn_mbcnt_lo((unsigned)m, 0u)); }

__device__ __forceinline__ void dsa_item(const Params& p, unsigned char* smem, unsigned yatt_off, int b, int tt, int lane_in, int wave) {
    const unsigned char* W = p.ws;
    constexpr unsigned O_QI = WS_QI << 20, O_KI = WS_KI << 20, O_WI = WS_WI << 20, O_Q = WS_Q << 20, O_K = WS_K << 20, O_V = WS_V << 20;
    const int t0 = tt * 16;
    __syncthreads();
#ifndef DSA_RA
#define DSA_RA 1
#endif
#ifndef DSA_RB
#define DSA_RB 1
#endif
#ifndef DSA_RC
#define DSA_RC 1
#endif
    _Pragma("unroll 1") for (int ra_ = 0; ra_ < DSA_RA; ++ra_) {
        int lane = lane_in; asm volatile("" : "+v"(lane));
        const int g = lane >> 4, c = lane & 15;
        const unsigned qrow = (unsigned)(b * SEQ + t0 + c);
        bf16x8 qf[8]; float wv[8];
#pragma unroll
        for (int h = 0; h < 8; ++h) { qf[h] = ldws<bf16x8>(W, O_QI + qrow * 512u + h * 64 + 16 * g); wv[h] = ldws<float>(W, O_WI + qrow * 32u + h * 4); }
        bf16x8 kf_next = ldws<bf16x8>(W, O_KI + (unsigned)(b * SEQ + (wave <= tt ? wave : tt) * 16 + c) * 64u + 16 * g);
#pragma unroll 1
        for (int kt = wave; kt <= tt; kt += NWAVES) {
            const bf16x8 kf = kf_next;
            { const int kn = kt + NWAVES <= tt ? kt + NWAVES : tt; kf_next = ldws<bf16x8>(W, O_KI + (unsigned)(b * SEQ + kn * 16 + c) * 64u + 16 * g); }
            f32x4 s = {0.f, 0.f, 0.f, 0.f};
#pragma unroll
            for (int h = 0; h < 8; ++h) {
                const f32x4 d = __builtin_amdgcn_mfma_f32_16x16x32_bf16(kf, qf[h], (f32x4){0.f, 0.f, 0.f, 0.f}, 0, 0, 0);
#pragma unroll
                for (int r = 0; r < 4; ++r) { const float dv = d[r]; const int ri = __float_as_int(dv); s[r] += wv[h] * __int_as_float(ri > 0 ? ri : 0); }
            }
            const bool diag = (kt == tt);
            unsigned kw[4];
#pragma unroll
            for (int r = 0; r < 4; ++r) {
                const _Float16 hv = (_Float16)s[r];
                const unsigned hb = (unsigned)__builtin_bit_cast(unsigned short, hv);
                const unsigned key = (hb & 0x8000u) ? (~hb & 0xffffu) : (hb | 0x8000u);
                const bool valid = !(diag && 4 * g + r > c);
                kw[r] = valid ? key : 0u;
                if (valid && ra_ == 0) atomicAdd((unsigned*)(smem + DSA_HIST_OFF) + c * 256 + (key >> 8), 1u);
            }
            *(uint2*)(smem + c * DSA_KSTR + (kt * 16 + 4 * g) * 2) = make_uint2(kw[0] | (kw[1] << 16), kw[2] | (kw[3] << 16));
        }
    }
    __syncthreads();
    unsigned short* selall = (unsigned short*)(smem + DSA_SEL_OFF);
    int* nselarr = (int*)(smem + DSA_NSEL_OFF);
#pragma unroll 1
    for (int rr = 0; rr < 2 * DSA_RB; ++rr) {
        int lane = lane_in; asm volatile("" : "+v"(lane));
        const int tl = wave * 2 + (rr & 1), nvalid = t0 + tl + 1;
        unsigned short* selrow = selall + tl * 256;
        if (nvalid <= TOPK) {
            for (int j = lane; j < TOPK; j += 64) selrow[j] = (unsigned short)(j < nvalid ? j : 0);
            if (lane == 0) nselarr[tl] = nvalid;
        } else {
            unsigned kk[64];
#pragma unroll
            for (int i = 0; i < 16; ++i) {
                const uint2 w = *(const uint2*)(smem + tl * DSA_KSTR + (i * 64 + lane) * 8);
                const int s0 = (i * 64 + lane) * 4;
                kk[4 * i + 0] = s0 + 0 < nvalid ? (w.x & 0xffffu) : 0u; kk[4 * i + 1] = s0 + 1 < nvalid ? (w.x >> 16) : 0u;
                kk[4 * i + 2] = s0 + 2 < nvalid ? (w.y & 0xffffu) : 0u; kk[4 * i + 3] = s0 + 3 < nvalid ? (w.y >> 16) : 0u;
            }
            unsigned* hist = (unsigned*)(smem + DSA_HIST_OFF) + tl * 256;
            const int ni = (nvalid + 255) >> 8;
            unsigned Bsel = 0u; int cabove = 0, nties = 0;
#pragma unroll 1
            for (int pass = 0; pass < 2; ++pass) {
                if (pass == 1) {
#pragma unroll
                    for (int i = 0; i < 16; ++i) {
                        if (i < ni) {
#pragma unroll
                            for (int e = 0; e < 4; ++e) { const unsigned k = kk[4 * i + e]; if ((k >> 8) == Bsel) atomicAdd(&hist[k & 255u], 1u); }
                        }
                    }
                    __builtin_amdgcn_s_waitcnt(0xC07F);
                    __builtin_amdgcn_wave_barrier();
                }
                const uint4 hv = *(const uint4*)(hist + 4 * lane);
                const int ls = (int)(hv.x + hv.y + hv.z + hv.w);
                const int pre_ = wave_incl_scan(ls);
                const int suf = __builtin_amdgcn_readlane(pre_, 63) - pre_ + ls;
                const int needp = TOPK - cabove;
                const int above = suf - ls;
                const bool mine = (above < needp) && (suf >= needp);
                int bsel_l = 0, ca_l = 0, hsel_l = 0;
                {
                    int cacc = above;
                    const int h3 = (int)hv.w, h2 = (int)hv.z, h1 = (int)hv.y, h0 = (int)hv.x;
                    if (cacc + h3 >= needp) { bsel_l = 3; ca_l = cacc; hsel_l = h3; }
                    else { cacc += h3; if (cacc + h2 >= needp) { bsel_l = 2; ca_l = cacc; hsel_l = h2; }
                        else { cacc += h2; if (cacc + h1 >= needp) { bsel_l = 1; ca_l = cacc; hsel_l = h1; } else { cacc += h1; bsel_l = 0; ca_l = cacc; hsel_l = h0; } } }
                }
                const unsigned long long mm = __ballot(mine);
                const int src = mm ? (int)__builtin_ctzll(mm) : 0;
                const int bb = __shfl(4 * lane + bsel_l, src), ca = __shfl(ca_l, src);
                nties = __shfl(hsel_l, src);
                if (pass == 0) {
                    Bsel = (unsigned)bb; cabove = ca;
                    __builtin_amdgcn_wave_barrier();
                    hist[lane] = 0u; hist[lane + 64] = 0u; hist[lane + 128] = 0u; hist[lane + 192] = 0u;
                    __builtin_amdgcn_s_waitcnt(0xC07F);
                    __builtin_amdgcn_wave_barrier();
                } else { Bsel = (Bsel << 8) | (unsigned)bb; cabove += ca; }
            }
            const unsigned T = Bsel;
            const int need = TOPK - cabove;
            if (nties == need) {
                int cntl = 0;
#pragma unroll
                for (int i = 0; i < 16; ++i) if (i < ni) {
#pragma unroll
                    for (int e = 0; e < 4; ++e) cntl += (kk[4 * i + e] >= T) ? 1 : 0;
                }
                const int pre = wave_incl_scan(cntl);
                int pos = pre - cntl;
#pragma unroll
                for (int i = 0; i < 16; ++i) if (i < ni) {
#pragma unroll
                    for (int e = 0; e < 4; ++e) { if (kk[4 * i + e] >= T) { if (pos < TOPK) selrow[pos] = (unsigned short)((i * 64 + lane) * 4 + e); ++pos; } }
                }
            } else {
                int tiebase = 0, sbase = 0;
#pragma unroll
                for (int i = 0; i < 16; ++i) {
                    int below = 0, tot = 0;
#pragma unroll
                    for (int e = 0; e < 4; ++e) { const unsigned long long m = __ballot(kk[4 * i + e] == T); below += mbcnt64(m); tot += __builtin_popcountll(m); }
                    int own = 0; bool take[4];
#pragma unroll
                    for (int e = 0; e < 4; ++e) { const bool tie = kk[4 * i + e] == T; take[e] = (kk[4 * i + e] > T) || (tie && (tiebase + below + own < need)); own += tie ? 1 : 0; }
                    tiebase += tot;
                    int belowS = 0, totS = 0;
#pragma unroll
                    for (int e = 0; e < 4; ++e) { const unsigned long long m = __ballot(take[e]); belowS += mbcnt64(m); totS += __builtin_popcountll(m); }
                    int ownS = 0;
#pragma unroll
                    for (int e = 0; e < 4; ++e) { if (take[e]) { const int pos = sbase + belowS + ownS; if (pos < TOPK) selrow[pos] = (unsigned short)((i * 64 + lane) * 4 + e); } ownS += take[e] ? 1 : 0; }
                    sbase += totS;
                }
            }
            if (lane == 0) nselarr[tl] = TOPK;
        }
        {
            unsigned* hz = (unsigned*)(smem + DSA_HIST_OFF) + tl * 256;
            hz[lane] = 0u; hz[lane + 64] = 0u; hz[lane + 128] = 0u; hz[lane + 192] = 0u;
        }
    }
    __builtin_amdgcn_s_waitcnt(0xC07F); __builtin_amdgcn_wave_barrier();
#pragma unroll 1
    for (int rn_ = 0; rn_ < 4 * DSA_RC; ++rn_) {
        const int rn = rn_ & 3;
        int lane = lane_in; asm volatile("" : "+v"(lane));
        const int g = lane >> 4, c = lane & 15;
        const int rr = rn >> 1, n = rn & 1;
        unsigned char* vst = smem + (2 * wave) * DSA_KSTR;
        const int tl = wave * 2 + rr;
        const unsigned rowg = (unsigned)(b * SEQ + t0 + tl);
        const int nselg = nselarr[tl] - 4 * g;
        const unsigned short* selrow = selall + tl * 256;
        const unsigned kvb = O_K + (unsigned)(b * SEQ) * 128u + n * 64 + 16 * g;
        const unsigned vvb = O_V + (unsigned)(b * SEQ) * 128u + n * 64 + (lane & 3) * 16;
        long qha = 0, qhb = 0, qla = 0, qlb = 0;
        if (c < 4) {
            const unsigned qo = O_Q + rowg * 1024u + (n * 4 + c) * 128 + 32 * g;
            f32x4 q0, q1, q2, q3; unpack8(ldws<u32x4>(W, qo), q0, q1); unpack8(ldws<u32x4>(W, qo + 16), q2, q3);
            q0 *= 16.f; q1 *= 16.f; q2 *= 16.f; q3 *= 16.f;
            const uint2 ha = pack8_fp8(q0, q1), hb = pack8_fp8(q2, q3);
            f32x4 d0, d1, d2, d3; unpack8_fp8(ha, d0, d1); unpack8_fp8(hb, d2, d3);
            const uint2 la = pack8_fp8(q0 - d0, q1 - d1), lb = pack8_fp8(q2 - d2, q3 - d3);
            qha = (long)(((unsigned long long)ha.y << 32) | ha.x); qhb = (long)(((unsigned long long)hb.y << 32) | hb.x);
            qla = (long)(((unsigned long long)la.y << 32) | la.x); qlb = (long)(((unsigned long long)lb.y << 32) | lb.x);
        }
        f32x4 S[16];
#pragma unroll
        for (int tile = 0; tile < 16; ++tile) {
            const unsigned key = selrow[tile * 16 + c];
            const u32x4 kw = ldws<u32x4>(W, kvb + key * 128u);
            const long ka = (long)(((unsigned long long)kw.y << 32) | kw.x), kb = (long)(((unsigned long long)kw.w << 32) | kw.z);
            f32x4 acc = __builtin_amdgcn_mfma_f32_16x16x32_fp8_fp8(ka, qha, (f32x4){0.f, 0.f, 0.f, 0.f}, 0, 0, 0);
            acc = __builtin_amdgcn_mfma_f32_16x16x32_fp8_fp8(kb, qhb, acc, 0, 0, 0);
            acc = __builtin_amdgcn_mfma_f32_16x16x32_fp8_fp8(ka, qla, acc, 0, 0, 0);
            S[tile] = __builtin_amdgcn_mfma_f32_16x16x32_fp8_fp8(kb, qlb, acc, 0, 0, 0);
        }
        u32x4 vra[8];
#pragma unroll
        for (int i = 0; i < 8; ++i) { const unsigned key = selrow[i * 16 + (lane >> 2)]; vra[i] = ldws<u32x4>(W, vvb + key * 128u); }
        float Pk[4][4];
        {
            const int nselc = nselarr[tl] - 4 * g - 16 * (c >> 2);
            float mx = -3e38f;
#pragma unroll
            for (int q4 = 0; q4 < 4; ++q4)
#pragma unroll
                for (int r = 0; r < 4; ++r) {
                    float v = S[4 * q4][r];
                    v = dppf<0x114, 0xf, 0x2, false>(v, S[4 * q4 + 1][r]);
                    v = dppf<0x118, 0xf, 0x4, false>(v, S[4 * q4 + 2][r]);
                    v = dppf<0x11C, 0xf, 0x8, false>(v, S[4 * q4 + 3][r]);
                    v = (64 * q4 + r) < nselc ? v : -1e30f;
                    Pk[q4][r] = v; mx = fmaxf(mx, v);
                }
            mx = fmaxf(mx, dppf<0x124, 0xf, 0xf, false>(mx, mx)); mx = fmaxf(mx, dppf<0x128, 0xf, 0xf, false>(mx, mx));
            mx = fmaxf(mx, __shfl_xor(mx, 16)); mx = fmaxf(mx, __shfl_xor(mx, 32));
            float sum = 0.f;
#pragma unroll
            for (int q4 = 0; q4 < 4; ++q4)
#pragma unroll
                for (int r = 0; r < 4; ++r) { const float e = __expf((Pk[q4][r] - mx) * (0.125f / 256.f)); Pk[q4][r] = e; sum += e; }
            sum += dppf<0x124, 0xf, 0xf, false>(sum, sum); sum += dppf<0x128, 0xf, 0xf, false>(sum, sum);
            sum += __shfl_xor(sum, 16); sum += __shfl_xor(sum, 32);
            const float invs = 256.f / sum;
#pragma unroll
            for (int q4 = 0; q4 < 4; ++q4)
#pragma unroll
                for (int r = 0; r < 4; ++r) Pk[q4][r] *= invs;
#pragma unroll
            for (int q4 = 0; q4 < 4; ++q4)
#pragma unroll
                for (int r = 0; r < 4; ++r) {
                    const float pv = Pk[q4][r];
                    S[4 * q4][r] = pv;
                    S[4 * q4 + 1][r] = dppf<0x104, 0xf, 0xf, false>(pv, pv);
                    S[4 * q4 + 2][r] = dppf<0x108, 0xf, 0xf, false>(pv, pv);
                    S[4 * q4 + 3][r] = dppf<0x10C, 0xf, 0xf, false>(pv, pv);
                }
        }
        f32x4 O[4];
#pragma unroll
        for (int dt = 0; dt < 4; ++dt) O[dt] = (f32x4){0.f, 0.f, 0.f, 0.f};
        const LAS unsigned char* vp = (const LAS unsigned char*)(vst + (16 * (g >> 1) + 8 * (g & 1) + 4 * ((c >> 1) >> 2) + ((c >> 1) & 3)) * 80 + (c & 1) * 8);
        typedef int v2i32_t __attribute__((ext_vector_type(2)));
#pragma unroll
        for (int hv = 0; hv < 2; ++hv) {
            u32x4 vr[8];
            if (hv == 0) {
#pragma unroll
                for (int i = 0; i < 8; ++i) vr[i] = vra[i];
            } else {
#pragma unroll
                for (int i = 0; i < 8; ++i) { const unsigned key = selrow[128 + i * 16 + (lane >> 2)]; vr[i] = ldws<u32x4>(W, vvb + key * 128u); }
            }
#pragma unroll
            for (int k4 = 0; k4 < 4; ++k4) {
                const int ks2 = hv * 4 + k4;
                __builtin_amdgcn_wave_barrier();
#pragma unroll
                for (int i2 = 0; i2 < 2; ++i2) {
                    const int slot = 16 * (lane >> 5) + 8 * ((lane >> 4) & 1) + 4 * i2 + ((lane >> 2) & 3);
                    *(u32x4*)(vst + slot * 80 + (lane & 3) * 16) = vr[k4 * 2 + i2];
                }
                __builtin_amdgcn_s_waitcnt(0xC07F);
                __builtin_amdgcn_wave_barrier();
                const uint2 pw = pack8_fp8(S[2 * ks2], S[2 * ks2 + 1]);
                const long pa = (long)(((unsigned long long)pw.y << 32) | pw.x);
#pragma unroll
                for (int dt = 0; dt < 4; ++dt) {
                    const v2i32_t l0 = __builtin_amdgcn_ds_read_tr8_b64_v2i32((LAS v2i32_t*)(vp + dt * 16));
                    const long vb = (long)(((unsigned long long)(unsigned)l0[1] << 32) | (unsigned)l0[0]);
                    O[dt] = __builtin_amdgcn_mfma_f32_16x16x32_fp8_fp8(pa, vb, O[dt], 0, 0, 0);
                }
            }
        }
        if (g == 0) {
            bf16_t* yo = (bf16_t*)(p.ws + yatt_off) + (size_t)rowg * 512 + n * 256 + c;
#pragma unroll
            for (int dt = 0; dt < 4; ++dt)
#pragma unroll
                for (int r = 0; r < 4; ++r) yo[r * 64 + dt * 16] = (bf16_t)f2bf(O[dt][r] * (1.f / 4096.f));
        }
    }
}

__device__ __forceinline__ void phase_dsa(const Params& p, unsigned char* smem, unsigned yatt_off, int vcu, int G) {
    int tid = threadIdx.x; asm volatile("" : "+v"(tid));
    const int lane = tid & 63, wave = __builtin_amdgcn_readfirstlane(tid >> 6);
    { unsigned* hz = (unsigned*)(smem + DSA_HIST_OFF); for (int i = tid; i < 16 * 256; i += NT) hz[i] = 0u; }
    const bool bal = (G == 256);
    const int nit = bal ? 8 : (NB * 256 - vcu + G - 1) / G;
#pragma unroll 1
    for (int it = 0; it < nit; ++it) {
        int b, tt;
        if (bal) { const int j = vcu & 31; b = vcu >> 5; tt = (it >> 1) * 64 + ((it & 1) ? 63 - j : j); }
        else { const int item = vcu + it * G; b = item >> 8; tt = item & 255; }
        dsa_item(p, smem, yatt_off, b, tt, lane, wave);
#if PEER_FP8
        {
            if (bal) {
                const int slots = G * NWAVES * 8, per = (2 * 16384 + slots - 1) / slots;
                const int s0 = ((vcu * NWAVES + wave) * 8 + it) * per;
                for (int r = s0; r < s0 + per && r < 2 * 16384; ++r) peer_table_row(p, r, lane, smem + DSA_HIST_OFF + 16384 + wave * 768);
            }
        }
#endif
    }
#if PEER_FP8
    if (!bal) for (int r = vcu * NWAVES + wave; r < 2 * 16384; r += G * NWAVES) peer_table_row(p, r, lane, smem + DSA_HIST_OFF + 16384 + wave * 768);
#endif
}

template <bool DRY>
__device__ __forceinline__ void phase_peer(const Params& p, unsigned char* smem, int vcu, int G) {
    int tid_ = threadIdx.x; asm volatile("" : "+v"(tid_)); const int wave = tid_ >> 6, lane = tid_ & 63;
    float* wsm = (float*)smem + wave * 1024;
    float* sc = wsm;
    float* v1s = wsm + 256; int* i1s = (int*)(wsm + 272); float* v2s = wsm + 288; int* i2s = (int*)(wsm + 304);
    float* tops = wsm + 320;
    int* tope = (int*)(wsm + 336);
    int* eid = (int*)(wsm + 384);
    float* egate = wsm + 512;
    const float* scores = WSP(float, WS_SCORES);
    const bf16_t* hg = WSP(bf16_t, WS_HG);
    const float* rss = WSP(float, WS_RSS);
    const bf16_t* ut = WSP(bf16_t, WS_UTAB); const bf16_t* vt = WSP(bf16_t, WS_VTAB);
    const int nwaves = G * NWAVES;
    int ca = 0, cb = 0;
    {
        int rem = lane; bool found = false;
#pragma unroll
        for (int a = 0; a < 16; ++a) { int cnt = 16 / (a + 1); if (!found) { if (rem < cnt) { ca = a; cb = rem; found = true; } else rem -= cnt; } }
    }
    for (int row = vcu * NWAVES + wave; row < MTOK; row += nwaves) {
        float rs;
        {
            float t = lane < 16 ? rss[(size_t)row * 16 + lane] : 0.f;
            t = wave_sum(t);
            rs = rsqrtf(t * (1.f / DM) + NORM_EPS);
        }
        for (int h = 0; h < PEER_H; ++h) {
            const float* sp = scores + (size_t)row * 2048 + h * 256;
            float a0 = sp[lane], a1 = sp[lane + 64], b0 = sp[128 + lane], b1 = sp[192 + lane];
            __builtin_amdgcn_wave_barrier();
            sc[lane] = a0; sc[lane + 64] = a1; sc[128 + lane] = b0; sc[192 + lane] = b1;
            __builtin_amdgcn_s_waitcnt(0);
            __builtin_amdgcn_wave_barrier();
            int ra0 = 0, ra1 = 0, rb0 = 0, rb1 = 0;
            for (int j = 0; j < 64; ++j) {
                float x = sc[j], y = sc[j + 64], z = sc[128 + j], w = sc[192 + j];
                ra0 += (x > a0) || (x == a0 && j < lane); ra0 += (y > a0);
                ra1 += (x >= a1); ra1 += (y > a1) || (y == a1 && j < lane);
                rb0 += (z > b0) || (z == b0 && j < lane); rb0 += (w > b0);
                rb1 += (z >= b1); rb1 += (w > b1) || (w == b1 && j < lane);
            }
            if (ra0 < 16) { v1s[ra0] = a0; i1s[ra0] = lane; }
            if (ra1 < 16) { v1s[ra1] = a1; i1s[ra1] = lane + 64; }
            if (rb0 < 16) { v2s[rb0] = b0; i2s[rb0] = lane; }
            if (rb1 < 16) { v2s[rb1] = b1; i2s[rb1] = lane + 64; }
            __builtin_amdgcn_s_waitcnt(0);
            __builtin_amdgcn_wave_barrier();
            float cv = -3e38f; int cpos = 1 << 20;
            if (lane < 50) { cv = v1s[ca] + v2s[cb]; cpos = ca * 16 + cb; }
            int rk = 0;
            for (int j = 0; j < 50; ++j) {
                float x = __shfl(cv, j); int px = __shfl(cpos, j);
                rk += (x > cv) || (x == cv && px < cpos);
            }
            if (lane < 50 && rk < 16) { tops[rk] = cv; tope[rk] = i1s[ca] * PEER_KEYS + i2s[cb]; }
            __builtin_amdgcn_s_waitcnt(0);
            __builtin_amdgcn_wave_barrier();
            if (lane < 16) {
                float s = tops[lane] * rs;
                float mx = s;
#pragma unroll
                for (int o = 8; o >= 1; o >>= 1) mx = fmaxf(mx, __shfl_xor(mx, o, 16));
                float e = __expf(s - mx), sm = e;
#pragma unroll
                for (int o = 8; o >= 1; o >>= 1) sm += __shfl_xor(sm, o, 16);
                eid[h * 16 + lane] = tope[lane];
                egate[h * 16 + lane] = e / sm;
            }
            __builtin_amdgcn_s_waitcnt(0);
            __builtin_amdgcn_wave_barrier();
        }
        f32x4 xv[4], acc[4];
        {
            const bf16_t* hr = hg + (size_t)row * DM;
            unpack8(*(const u32x4*)(hr + lane * 8), xv[0], xv[1]);
            unpack8(*(const u32x4*)(hr + 512 + lane * 8), xv[2], xv[3]);
#pragma unroll
            for (int i = 0; i < 4; ++i) { xv[i] = xv[i] * rs; acc[i] = (f32x4){0.f, 0.f, 0.f, 0.f}; }
        }
        for (int e0 = 0; e0 < 128; e0 += 4) {
            u32x4 uw[4][2], vw[4][2];
#pragma unroll
            for (int e = 0; e < 4; ++e) {
                const bf16_t* ur = ut + (size_t)eid[e0 + e] * DM;
                uw[e][0] = *(const u32x4*)(ur + lane * 8); uw[e][1] = *(const u32x4*)(ur + 512 + lane * 8);
            }
#pragma unroll
            for (int e = 0; e < 4; ++e) {
                const bf16_t* vr = vt + (size_t)eid[e0 + e] * DM;
                vw[e][0] = *(const u32x4*)(vr + lane * 8); vw[e][1] = *(const u32x4*)(vr + 512 + lane * 8);
            }
            float act[4];
#pragma unroll
            for (int e = 0; e < 4; ++e) {
                f32x4 u0, u1, u2, u3; unpack8(uw[e][0], u0, u1); unpack8(uw[e][1], u2, u3);
                f32x4 s4 = xv[0] * u0 + xv[1] * u1 + xv[2] * u2 + xv[3] * u3;
                float d = wave_sum((s4[0] + s4[1]) + (s4[2] + s4[3]));
                act[e] = gelu_tanh(d) * egate[e0 + e];
            }
#pragma unroll
            for (int e = 0; e < 4; ++e) {
                f32x4 v0, v1, v2, v3; unpack8(vw[e][0], v0, v1); unpack8(vw[e][1], v2, v3);
                acc[0] += v0 * act[e]; acc[1] += v1 * act[e]; acc[2] += v2 * act[e]; acc[3] += v3 * act[e];
            }
        }
        float* hr = p.out + (size_t)row * DM;
        float ss = 0.f;
        if (DRY) { const float chk = acc[0][0] + acc[1][1] + acc[2][2] + acc[3][3]; if (chk == 1.2345678f) hr[lane] = chk; continue; }
#pragma unroll
        for (int c = 0; c < 2; ++c) {
            acc[2 * c] += *(const f32x4*)(hr + c * 512 + lane * 8); acc[2 * c + 1] += *(const f32x4*)(hr + c * 512 + lane * 8 + 4);
        }
#pragma unroll
        for (int i = 0; i < 4; ++i) ss += acc[i][0] * acc[i][0] + acc[i][1] * acc[i][1] + acc[i][2] * acc[i][2] + acc[i][3] * acc[i][3];
        ss = wave_sum(ss);
        float scl = rsqrtf(ss * (1.f / DM) + NORM_EPS);
#if defined(PROBE_ATTN) || defined(PROBE_SSM)
        {
            const float e = ((const float*)p.ws)[16] / fmaxf(((const float*)p.ws)[17], 1e-30f);
            int kx = 0; if (e > 1e-6f) kx++; if (e > 1e-5f) kx++; if (e > 1e-4f) kx++; if (e > 1e-3f) kx++; if (e > 1e-2f) kx++; if (e > 1e-1f) kx++; if (!(e == e)) kx = 8;
            scl *= 1.f + 0.05f * kx;
        }
#endif
#pragma unroll
        for (int c = 0; c < 2; ++c) {
            f32x4 ga = *(const f32x4*)(p.norm_f_g + c * 512 + lane * 8), gb = *(const f32x4*)(p.norm_f_g + c * 512 + lane * 8 + 4);
            *(f32x4*)(hr + c * 512 + lane * 8) = acc[2 * c] * scl * ga; *(f32x4*)(hr + c * 512 + lane * 8 + 4) = acc[2 * c + 1] * scl * gb;
        }
    }
}


template <int MODE>
__device__ __forceinline__ void phase_peer2(const Params& p, unsigned char* smem, int vcu, int G) {
    int tid_ = threadIdx.x; asm volatile("" : "+v"(tid_));
    const int wave = __builtin_amdgcn_readfirstlane(tid_ >> 6), lane = tid_ & 63;
    const int gq = lane >> 4, c = lane & 15;
    unsigned char* wsm = smem + wave * 4096;
    bf16_t* xl = (bf16_t*)wsm;
    float* lv = (float*)(wsm + 2048);
    int* li = (int*)(wsm + 2048 + 128);
    float* vs = (float*)(wsm + 2048 + 256);
    int* is_ = (int*)(wsm + 2048 + 384);
    int* eid = (int*)(wsm + 2048 + 512);
    float* egate = (float*)(wsm + 2048 + 1024);
    float* eusc = (float*)(wsm + 2048 + 1536);
    const unsigned char* W = p.ws;
    constexpr unsigned O_SC = WS_SCORES << 20, O_HG = WS_HG << 20, O_UT = WS_UTAB << 20, O_VT = WS_VTAB << 20;
    const float* rss = WSP(float, WS_RSS);
    const int nwaves = G * NWAVES;
    int ca = 0, cb = 0;
    {
        int rem = lane; bool found = false;
#pragma unroll
        for (int a = 0; a < 16; ++a) { const int cnt = 16 / (a + 1); if (!found) { if (rem < cnt) { ca = a; cb = rem; found = true; } else rem -= cnt; } }
    }
#pragma unroll 1
    for (int row = vcu * NWAVES + wave; row < MTOK; row += nwaves) {
        float rs;
        { float t = lane < 16 ? rss[(size_t)row * 16 + lane] : 0.f; t = wave_sum(t); rs = rsqrtf(t * (1.f / DM) + NORM_EPS); }
        {
            const u32x4 w0 = ldws<u32x4>(W, O_HG + (unsigned)row * 2048u + lane * 16), w1 = ldws<u32x4>(W, O_HG + (unsigned)row * 2048u + 1024 + lane * 16);
#if PEER_FP8
            f32x4 xa[4]; unpack8(w0, xa[0], xa[1]); unpack8(w1, xa[2], xa[3]);
            xa[0] *= *(const f32x4*)(p.norm2_g + lane * 8); xa[1] *= *(const f32x4*)(p.norm2_g + lane * 8 + 4); xa[2] *= *(const f32x4*)(p.norm2_g + 512 + lane * 8); xa[3] *= *(const f32x4*)(p.norm2_g + 512 + lane * 8 + 4);
            unsigned hw[4], lw[4];
#pragma unroll
            for (int i = 0; i < 4; ++i) {
                typedef float f32x2_ __attribute__((ext_vector_type(2)));
                const f32x4 xs = xa[i] * 16.f;
                int h = __builtin_amdgcn_cvt_pk_fp8_f32(xs[0], xs[1], 0, false); h = __builtin_amdgcn_cvt_pk_fp8_f32(xs[2], xs[3], h, true);
                const f32x2_ b0 = __builtin_amdgcn_cvt_pk_f32_fp8(h, false), b1 = __builtin_amdgcn_cvt_pk_f32_fp8(h, true);
                int l = __builtin_amdgcn_cvt_pk_fp8_f32((xs[0] - b0[0]) * 16.f, (xs[1] - b0[1]) * 16.f, 0, false); l = __builtin_amdgcn_cvt_pk_fp8_f32((xs[2] - b1[0]) * 16.f, (xs[3] - b1[1]) * 16.f, l, true);
                hw[i] = (unsigned)h; lw[i] = (unsigned)l;
            }
            *(uint2*)(wsm + lane * 8) = make_uint2(hw[0], hw[1]); *(uint2*)(wsm + 512 + lane * 8) = make_uint2(hw[2], hw[3]);
            *(uint2*)(wsm + 1024 + lane * 8) = make_uint2(lw[0], lw[1]); *(uint2*)(wsm + 1536 + lane * 8) = make_uint2(lw[2], lw[3]);
#else
            *(u32x4*)(wsm + lane * 16) = w0; *(u32x4*)(wsm + 1024 + lane * 16) = w1;
#endif
        }
#ifdef PROBE_NOTOPK
        if (MODE == 1) { eid[lane] = (row * 131 + lane * 977) & 16383; eid[lane + 64] = (row * 137 + lane * 1499 + 7) & 16383; egate[lane] = 0.0625f; egate[lane + 64] = 0.0625f; eusc[lane] = 1.f; eusc[lane + 64] = 1.f; }
        else
#endif
#pragma unroll 1
        for (int h = 0; h < PEER_H; ++h) {
            const unsigned so = O_SC + (unsigned)row * 4096u + h * 512 + lane * 2;
            const unsigned short ha0 = ldws<unsigned short>(W, so), ha1 = ldws<unsigned short>(W, so + 128), hb0 = ldws<unsigned short>(W, so + 256), hb1 = ldws<unsigned short>(W, so + 384);
            const float a0 = (float)__builtin_bit_cast(_Float16, ha0), a1 = (float)__builtin_bit_cast(_Float16, ha1), b0 = (float)__builtin_bit_cast(_Float16, hb0), b1 = (float)__builtin_bit_cast(_Float16, hb1);
#define K16(hb) ((((unsigned)(hb) & 0x8000u) ? (~(unsigned)(hb) & 0xffffu) : ((unsigned)(hb) | 0x8000u)) << 16)
            const unsigned ka0 = K16(ha0) | (0xFFFFu - (unsigned)lane), ka1 = K16(ha1) | (0xFFFFu - 64u - (unsigned)lane);
            const unsigned kb0 = K16(hb0) | (0xFFFFu - (unsigned)lane), kb1 = K16(hb1) | (0xFFFFu - 64u - (unsigned)lane);
#undef K16
            unsigned long long loA = 0, hiA = 1ull << 32, loB = 0, hiB = 1ull << 32; bool doneA = false, doneB = false;
            while (!(doneA && doneB)) {
                if (!doneA) { const unsigned mid = (unsigned)((loA + hiA) >> 1); const int cnt = __builtin_popcountll(__ballot(ka0 >= mid)) + __builtin_popcountll(__ballot(ka1 >= mid));
                    if (cnt >= 16) loA = mid; else hiA = mid; doneA = (cnt == 16) || (hiA - loA <= 1); }
                if (!doneB) { const unsigned mid = (unsigned)((loB + hiB) >> 1); const int cnt = __builtin_popcountll(__ballot(kb0 >= mid)) + __builtin_popcountll(__ballot(kb1 >= mid));
                    if (cnt >= 16) loB = mid; else hiB = mid; doneB = (cnt == 16) || (hiB - loB <= 1); }
            }
            __builtin_amdgcn_wave_barrier();
            {
                const unsigned T = (unsigned)loA;
                const bool k0 = ka0 >= T, k1 = ka1 >= T;
                const unsigned long long s0 = __ballot(k0), s1 = __ballot(k1);
                if (k0) { const int pos = mbcnt64(s0); lv[pos] = a0; li[pos] = lane; }
                if (k1) { const int pos = __builtin_popcountll(s0) + mbcnt64(s1); if (pos < 16) { lv[pos] = a1; li[pos] = lane + 64; } }
            }
            {
                const unsigned T = (unsigned)loB;
                const bool k0 = kb0 >= T, k1 = kb1 >= T;
                const unsigned long long s0 = __ballot(k0), s1 = __ballot(k1);
                if (k0) { const int pos = mbcnt64(s0); lv[16 + pos] = b0; li[16 + pos] = lane; }
                if (k1) { const int pos = __builtin_popcountll(s0) + mbcnt64(s1); if (pos < 16) { lv[16 + pos] = b1; li[16 + pos] = lane + 64; } }
            }
            __builtin_amdgcn_s_waitcnt(0xC07F);
            __builtin_amdgcn_wave_barrier();
            if (lane < 32) {
                const int base = lane & 16, me = lane & 15;
                const float mv = lv[lane]; int rk = 0;
#pragma unroll
                for (int j = 0; j < 16; ++j) { const float x = lv[base + j]; rk += (x > mv) || (x == mv && j < me); }
                vs[base + rk] = mv; is_[base + rk] = li[lane];
            }
            __builtin_amdgcn_s_waitcnt(0xC07F);
            __builtin_amdgcn_wave_barrier();
            float cv = 0.f; unsigned kc = 0u;
            if (lane < 50) { cv = vs[ca] + vs[16 + cb]; kc = fkey(cv); }
            unsigned long long lo = fkey(vs[15] + vs[31]), hi = (unsigned long long)fkey(vs[0] + vs[16]) + 1ull;
            while (hi - lo > 1) {
                const unsigned mid = (unsigned)((lo + hi) >> 1); const int cnt = __builtin_popcountll(__ballot(kc >= mid));
                if (cnt >= 16) lo = mid; else hi = mid;
                if (cnt == 16) break;
            }
            const unsigned T2 = (unsigned)lo;
            const unsigned long long tm = __ballot(kc == T2);
            const int need2 = 16 - __builtin_popcountll(__ballot(kc > T2));
            const bool take = (kc > T2) || (kc == T2 && mbcnt64(tm) < need2);
            const float sv = take ? cv * rs : -3e38f;
            const float mx = wave_max(sv);
            const float ev = take ? __expf(sv - mx) : 0.f;
            const float sm = wave_sum(ev);
            if (take) { const int pos = mbcnt64(__ballot(take)); if (pos < 16) { const int e_ = is_[ca] * PEER_KEYS + is_[16 + cb]; eid[h * 16 + pos] = e_;
#if PEER_FP8
                egate[h * 16 + pos] = ev / sm * WSP(float, WS_VSC)[e_]; eusc[h * 16 + pos] = WSP(float, WS_USC)[e_];
#else
                egate[h * 16 + pos] = ev / sm;
#endif
            } }
            __builtin_amdgcn_wave_barrier();
        }
        __builtin_amdgcn_s_waitcnt(0xC07F);
        __builtin_amdgcn_wave_barrier();
#if PEER_FP8
        f32x4 acc[4];
#pragma unroll
        for (int i = 0; i < 4; ++i) acc[i] = (f32x4){0.f, 0.f, 0.f, 0.f};
        const unsigned koff = (unsigned)((c >> 3) * 64 + 16 * gq);
        u32x4 ub0[8], ub1[8], vb0[8], vb1[8];
#ifdef PROBE_L2GATHER
        if (MODE == 1) { eid[lane] &= 1023; eid[lane + 64] &= 1023; __builtin_amdgcn_s_waitcnt(0xC07F); __builtin_amdgcn_wave_barrier(); }
#endif
        int ec0 = eid[c & 7], ec1 = eid[8 + (c & 7)];
#pragma unroll
        for (int k3 = 0; k3 < 8; ++k3) ub0[k3] = ldws<u32x4>(W, O_UT + (unsigned)ec0 * 1024u + koff + k3 * 128);
#pragma unroll
        for (int j = 0; j < 8; ++j) vb0[j] = ldws<u32x4>(W, O_VT + (unsigned)__builtin_amdgcn_readlane(ec0, j) * 1024u + lane * 16);
#pragma unroll
        for (int k3 = 0; k3 < 8; ++k3) ub1[k3] = ldws<u32x4>(W, O_UT + (unsigned)ec1 * 1024u + koff + k3 * 128);
#define PEER_TILE(UB, EC, VBC, ECN, VBN)                                                                                           \
        {                                                                                                                          \
            f32x4 dh = {0.f, 0.f, 0.f, 0.f}, dl = {0.f, 0.f, 0.f, 0.f};                                                             \
            _Pragma("unroll") for (int k3 = 0; k3 < 8; ++k3) {                                                                     \
                const u32x4 xh = *(const u32x4*)(wsm + k3 * 128 + koff), xlo = *(const u32x4*)(wsm + 1024 + k3 * 128 + koff);      \
                const long u0 = (long)(((unsigned long long)UB[k3].y << 32) | UB[k3].x), u1 = (long)(((unsigned long long)UB[k3].w << 32) | UB[k3].z); \
                const long h0 = (long)(((unsigned long long)xh.y << 32) | xh.x), h1 = (long)(((unsigned long long)xh.w << 32) | xh.z);  \
                const long l0 = (long)(((unsigned long long)xlo.y << 32) | xlo.x), l1 = (long)(((unsigned long long)xlo.w << 32) | xlo.z); \
                dh = __builtin_amdgcn_mfma_f32_16x16x32_fp8_fp8(h0, u0, dh, 0, 0, 0);                                              \
                dh = __builtin_amdgcn_mfma_f32_16x16x32_fp8_fp8(h1, u1, dh, 0, 0, 0);                                              \
                dl = __builtin_amdgcn_mfma_f32_16x16x32_fp8_fp8(l0, u0, dl, 0, 0, 0);                                              \
                dl = __builtin_amdgcn_mfma_f32_16x16x32_fp8_fp8(l1, u1, dl, 0, 0, 0);                                              \
            }                                                                                                                      \
            float mine = dh[0] + dl[0] * (1.f / 16.f);                                                                             \
            mine += __shfl_xor(mine, 40);                                                       \
            const int ecur = EC;                                                                                                   \
            const float act = gelu_tanh(mine * (1.f / 16.f) * eusc[tcur * 8 + (c & 7)] * rs) * egate[tcur * 8 + (c & 7)];           \
            if (tcur + 2 < 16) {                                                                                                   \
                EC = eid[(tcur + 2) * 8 + (c & 7)];                                                                                \
                _Pragma("unroll") for (int k3 = 0; k3 < 8; ++k3) UB[k3] = ldws<u32x4>(W, O_UT + (unsigned)EC * 1024u + koff + k3 * 128); \
            }                                                                                                                      \
            if (tcur + 1 < 16) {                                                                                                   \
                _Pragma("unroll") for (int j = 0; j < 8; ++j) VBN[j] = ldws<u32x4>(W, O_VT + (unsigned)__builtin_amdgcn_readlane(ECN, j) * 1024u + lane * 16); \
            }                                                                                                                      \
            __builtin_amdgcn_sched_barrier(0);                                                                                     \
            _Pragma("unroll") for (int j = 0; j < 8; ++j) {                                                                        \
                const float aj = __builtin_bit_cast(float, __builtin_amdgcn_readlane(__builtin_bit_cast(int, act), j));            \
                const u32x4 vw = VBC[j];                                                                                           \
                typedef float f32x2_ __attribute__((ext_vector_type(2)));                                                          \
                const f32x2_ p0 = __builtin_amdgcn_cvt_pk_f32_fp8((int)vw.x, false), p1 = __builtin_amdgcn_cvt_pk_f32_fp8((int)vw.x, true); \
                const f32x2_ p2 = __builtin_amdgcn_cvt_pk_f32_fp8((int)vw.y, false), p3 = __builtin_amdgcn_cvt_pk_f32_fp8((int)vw.y, true); \
                const f32x2_ p4 = __builtin_amdgcn_cvt_pk_f32_fp8((int)vw.z, false), p5 = __builtin_amdgcn_cvt_pk_f32_fp8((int)vw.z, true); \
                const f32x2_ p6 = __builtin_amdgcn_cvt_pk_f32_fp8((int)vw.w, false), p7 = __builtin_amdgcn_cvt_pk_f32_fp8((int)vw.w, true); \
                acc[0] += (f32x4){p0[0], p0[1], p1[0], p1[1]} * aj; acc[1] += (f32x4){p2[0], p2[1], p3[0], p3[1]} * aj;             \
                acc[2] += (f32x4){p4[0], p4[1], p5[0], p5[1]} * aj; acc[3] += (f32x4){p6[0], p6[1], p7[0], p7[1]} * aj;             \
            }                                                                                                                      \
            __builtin_amdgcn_sched_barrier(0);                                                                                     \
        }
#pragma unroll 1
        for (int tp = 0; tp < 8; ++tp) {
            { const int tcur = 2 * tp; PEER_TILE(ub0, ec0, vb0, ec1, vb1) }
            { const int tcur = 2 * tp + 1; PEER_TILE(ub1, ec1, vb1, ec0, vb0) }
        }
#undef PEER_TILE
#else
        f32x4 acc[4];
#pragma unroll
        for (int i = 0; i < 4; ++i) acc[i] = (f32x4){0.f, 0.f, 0.f, 0.f};
        bf16x8 ubuf[32];
        int ec = eid[c]; float gc = egate[c];
        {
            const unsigned ub = O_UT + (unsigned)ec * 2048u + 16 * gq;
#pragma unroll
            for (int ks = 0; ks < 32; ++ks) ubuf[ks] = ldws<bf16x8>(W, ub + ks * 64);
        }
#pragma unroll 1
        for (int tile = 0; tile < 8; ++tile) {
            f32x4 d = {0.f, 0.f, 0.f, 0.f};
#pragma unroll
            for (int ks = 0; ks < 32; ++ks) d = __builtin_amdgcn_mfma_f32_16x16x32_bf16(*(const bf16x8*)(xl + ks * 32 + 8 * gq), ubuf[ks], d, 0, 0, 0);
            const float act = gelu_tanh(d[0] * rs) * gc;
            const int ecur = ec;
            if (tile < 7) {
                ec = eid[(tile + 1) * 16 + c]; gc = egate[(tile + 1) * 16 + c];
                const unsigned ub = O_UT + (unsigned)ec * 2048u + 16 * gq;
#pragma unroll
                for (int ks = 0; ks < 32; ++ks) ubuf[ks] = ldws<bf16x8>(W, ub + ks * 64);
            }
#pragma unroll
            for (int j = 0; j < 16; ++j) {
                const int ej = __builtin_amdgcn_readlane(ecur, j);
                const float aj = __builtin_bit_cast(float, __builtin_amdgcn_readlane(__builtin_bit_cast(int, act), j));
                const unsigned vb = O_VT + (unsigned)ej * 2048u + lane * 16;
                f32x4 v0, v1, v2, v3; unpack8(ldws<u32x4>(W, vb), v0, v1); unpack8(ldws<u32x4>(W, vb + 1024), v2, v3);
                acc[0] += v0 * aj; acc[1] += v1 * aj; acc[2] += v2 * aj; acc[3] += v3 * aj;
                if ((j & 3) == 3) __builtin_amdgcn_sched_barrier(0);
            }
        }
#endif
        float* hr = p.out + (size_t)row * DM;
        if (MODE == 1) { const float chk = acc[0][0] + acc[1][1] + acc[2][2] + acc[3][3]; if (chk == 1.2345678f) hr[lane] = chk; continue; }
        float ss = 0.f;
        {
            f32x4 h0, h1, h2, h3;
            unpack8(ldws<u32x4>(W, O_HG + (unsigned)row * 2048u + lane * 16), h0, h1); unpack8(ldws<u32x4>(W, O_HG + (unsigned)row * 2048u + 1024 + lane * 16), h2, h3);
            acc[0] += h0; acc[1] += h1; acc[2] += h2; acc[3] += h3;
        }
#pragma unroll
        for (int i = 0; i < 4; ++i) ss += acc[i][0] * acc[i][0] + acc[i][1] * acc[i][1] + acc[i][2] * acc[i][2] + acc[i][3] * acc[i][3];
        ss = wave_sum(ss);
        const float scl = rsqrtf(ss * (1.f / DM) + NORM_EPS);
        float* dst = hr;
        if (MODE == 2) { if (row >= 8192) continue; dst = WSP(float, 462) + (size_t)row * DM; }
#pragma unroll
        for (int cc = 0; cc < 2; ++cc) {
            const f32x4 ga = *(const f32x4*)(p.norm_f_g + cc * 512 + lane * 8), gb = *(const f32x4*)(p.norm_f_g + cc * 512 + lane * 8 + 4);
            *(f32x4*)(dst + cc * 512 + lane * 8) = acc[2 * cc] * scl * ga; *(f32x4*)(dst + cc * 512 + lane * 8 + 4) = acc[2 * cc + 1] * scl * gb;
        }
    }
}


__device__ __forceinline__ void phase_peer4(const Params& p, unsigned char* smem, int vcu, int G) {
    int tid_ = threadIdx.x; asm volatile("" : "+v"(tid_));
    const int wave = __builtin_amdgcn_readfirstlane(tid_ >> 6), lane = tid_ & 63;
    const int gq = lane >> 4, c = lane & 15;
    unsigned char* wbase = smem + wave * 8192;
    const unsigned char* W = p.ws;
    constexpr unsigned O_SC = WS_SCORES << 20, O_HG = WS_HG << 20, O_UT = WS_UTAB << 20, O_VT = WS_VTAB << 20;
    const float* rss = WSP(float, WS_RSS);
    const float* uscg = WSP(float, WS_USC); const float* vscg = WSP(float, WS_VSC);
    const int stride = G * NWAVES;
    int ca = 0, cb = 0;
    {
        int rem = lane; bool found = false;
#pragma unroll
        for (int a = 0; a < 16; ++a) { const int cnt = 16 / (a + 1); if (!found) { if (rem < cnt) { ca = a; cb = rem; found = true; } else rem -= cnt; } }
    }
    int row = vcu * NWAVES + wave;
    if (row >= MTOK) return;
    u32x4 xw0, xw1; float rssv = 0.f; unsigned sc0 = 0, sc1 = 0, sc2 = 0, sc3 = 0;
    int pend_i = -1; float pend_g = 0.f, pend_su = 0.f, pend_sv = 0.f;
#define NB_LV(B)  ((float*)((B) + 2048))
#define NB_LI(B)  ((int*)((B) + 2048 + 128))
#define NB_VS(B)  ((float*)((B) + 2048 + 256))
#define NB_IS(B)  ((int*)((B) + 2048 + 384))
#define NB_EID(B) ((int*)((B) + 2048 + 512))
#define NB_EG(B)  ((float*)((B) + 2048 + 1024))
#define NB_EU(B)  ((float*)((B) + 2048 + 1536))
#define TK_LOAD_X(R) { xw0 = ldws<u32x4>(W, O_HG + (unsigned)(R) * 2048u + lane * 16); xw1 = ldws<u32x4>(W, O_HG + (unsigned)(R) * 2048u + 1024 + lane * 16); rssv = lane < 16 ? rss[(size_t)(R) * 16 + lane] : 0.f; }
#define TK_LOAD_SC(R, H) { const unsigned so_ = O_SC + (unsigned)(R) * 4096u + (H) * 512 + lane * 2; sc0 = ldws<unsigned short>(W, so_); sc1 = ldws<unsigned short>(W, so_ + 128); sc2 = ldws<unsigned short>(W, so_ + 256); sc3 = ldws<unsigned short>(W, so_ + 384); }
#define TK_STAGE_X(B, RS) {                                                                                                        \
        RS = rsqrtf(wave_sum(rssv) * (1.f / DM) + NORM_EPS);                                                                       \
        f32x4 xa[4]; unpack8(xw0, xa[0], xa[1]); unpack8(xw1, xa[2], xa[3]);                                                        \
        xa[0] *= *(const f32x4*)(p.norm2_g + lane * 8); xa[1] *= *(const f32x4*)(p.norm2_g + lane * 8 + 4); xa[2] *= *(const f32x4*)(p.norm2_g + 512 + lane * 8); xa[3] *= *(const f32x4*)(p.norm2_g + 512 + lane * 8 + 4); \
        unsigned hw[4], lw[4];                                                                                                     \
        _Pragma("unroll") for (int i = 0; i < 4; ++i) {                                                                            \
            const f32x4 xs = xa[i] * 16.f;                                                                                         \
            int h_ = __builtin_amdgcn_cvt_pk_fp8_f32(xs[0], xs[1], 0, false); h_ = __builtin_amdgcn_cvt_pk_fp8_f32(xs[2], xs[3], h_, true); \
            const f32x2_t b0 = __builtin_amdgcn_cvt_pk_f32_fp8(h_, false), b1 = __builtin_amdgcn_cvt_pk_f32_fp8(h_, true);         \
            int l_ = __builtin_amdgcn_cvt_pk_fp8_f32((xs[0] - b0[0]) * 16.f, (xs[1] - b0[1]) * 16.f, 0, false); l_ = __builtin_amdgcn_cvt_pk_fp8_f32((xs[2] - b1[0]) * 16.f, (xs[3] - b1[1]) * 16.f, l_, true); \
            hw[i] = (unsigned)h_; lw[i] = (unsigned)l_;                                                                            \
        }                                                                                                                          \
        *(uint2*)((B) + lane * 8) = make_uint2(hw[0], hw[1]); *(uint2*)((B) + 512 + lane * 8) = make_uint2(hw[2], hw[3]);          \
        *(uint2*)((B) + 1024 + lane * 8) = make_uint2(lw[0], lw[1]); *(uint2*)((B) + 1536 + lane * 8) = make_uint2(lw[2], lw[3]);  \
    }
#define TK_K16(hb) ((((unsigned)(hb) & 0x8000u) ? (~(unsigned)(hb) & 0xffffu) : ((unsigned)(hb) | 0x8000u)) << 16)
#define TK_PART_A(B) {                                                                                                             \
        const float a0 = (float)__builtin_bit_cast(_Float16, (unsigned short)sc0), a1 = (float)__builtin_bit_cast(_Float16, (unsigned short)sc1); \
        const float b0 = (float)__builtin_bit_cast(_Float16, (unsigned short)sc2), b1 = (float)__builtin_bit_cast(_Float16, (unsigned short)sc3); \
        const unsigned ka0 = TK_K16(sc0) | (0xFFFFu - (unsigned)lane), ka1 = TK_K16(sc1) | (0xFFFFu - 64u - (unsigned)lane);       \
        const unsigned kb0 = TK_K16(sc2) | (0xFFFFu - (unsigned)lane), kb1 = TK_K16(sc3) | (0xFFFFu - 64u - (unsigned)lane);       \
        unsigned long long loA = 0, hiA = 1ull << 32, loB = 0, hiB = 1ull << 32; bool doneA = false, doneB = false;                 \
        while (!(doneA && doneB)) {                                                                                                \
            if (!doneA) { const unsigned mid = (unsigned)((loA + hiA) >> 1); const int cnt = __builtin_popcountll(__ballot(ka0 >= mid)) + __builtin_popcountll(__ballot(ka1 >= mid)); \
                if (cnt >= 16) loA = mid; else hiA = mid; doneA = (cnt == 16) || (hiA - loA <= 1); }                                \
            if (!doneB) { const unsigned mid = (unsigned)((loB + hiB) >> 1); const int cnt = __builtin_popcountll(__ballot(kb0 >= mid)) + __builtin_popcountll(__ballot(kb1 >= mid)); \
                if (cnt >= 16) loB = mid; else hiB = mid; doneB = (cnt == 16) || (hiB - loB <= 1); }                                \
        }                                                                                                                          \
        float* lv = NB_LV(B); int* li = NB_LI(B);                                                                                  \
        { const unsigned T = (unsigned)loA; const bool k0 = ka0 >= T, k1 = ka1 >= T; const unsigned long long s0 = __ballot(k0), s1 = __ballot(k1); \
          if (k0) { const int pos = mbcnt64(s0); lv[pos] = a0; li[pos] = lane; }                                                    \
          if (k1) { const int pos = __builtin_popcountll(s0) + mbcnt64(s1); if (pos < 16) { lv[pos] = a1; li[pos] = lane + 64; } } } \
        { const unsigned T = (unsigned)loB; const bool k0 = kb0 >= T, k1 = kb1 >= T; const unsigned long long s0 = __ballot(k0), s1 = __ballot(k1); \
          if (k0) { const int pos = mbcnt64(s0); lv[16 + pos] = b0; li[16 + pos] = lane; }                                           \
          if (k1) { const int pos = __builtin_popcountll(s0) + mbcnt64(s1); if (pos < 16) { lv[16 + pos] = b1; li[16 + pos] = lane + 64; } } } \
        __builtin_amdgcn_s_waitcnt(0xC07F); __builtin_amdgcn_wave_barrier();                                                       \
    }
#define TK_PART_B(B, H, RS) {                                                                                                      \
        float* lv = NB_LV(B); int* li = NB_LI(B); float* vs = NB_VS(B); int* is_ = NB_IS(B);                                        \
        if (lane < 32) { const int base = lane & 16, me = lane & 15; const float mv = lv[lane]; int rk = 0;                         \
            _Pragma("unroll") for (int j = 0; j < 16; ++j) { const float x = lv[base + j]; rk += (x > mv) || (x == mv && j < me); } \
            vs[base + rk] = mv; is_[base + rk] = li[lane]; }                                                                       \
        __builtin_amdgcn_s_waitcnt(0xC07F); __builtin_amdgcn_wave_barrier();                                                       \
        float cv = 0.f; unsigned kc = 0u;                                                                                          \
        if (lane < 50) { cv = vs[ca] + vs[16 + cb]; kc = fkey(cv); }                                                                \
        unsigned long long lo = fkey(vs[15] + vs[31]), hi = (unsigned long long)fkey(vs[0] + vs[16]) + 1ull;                        \
        while (hi - lo > 1) { const unsigned mid = (unsigned)((lo + hi) >> 1); const int cnt = __builtin_popcountll(__ballot(kc >= mid)); \
            if (cnt >= 16) lo = mid; else hi = mid; if (cnt == 16) break; }                                                        \
        const unsigned T2 = (unsigned)lo; const unsigned long long tm = __ballot(kc == T2);                                        \
        const int need2 = 16 - __builtin_popcountll(__ballot(kc > T2));                                                            \
        const bool take = (kc > T2) || (kc == T2 && mbcnt64(tm) < need2);                                                          \
        const float sv_ = take ? cv * (RS) : -3e38f; const float mx = wave_max(sv_);                                               \
        const float ev = take ? __expf(sv_ - mx) : 0.f; const float sm = wave_sum(ev);                                             \
        pend_i = -1;                                                                                                               \
        if (take) { const int pos = mbcnt64(__ballot(take)); if (pos < 16) { const int e_ = is_[ca] * PEER_KEYS + is_[16 + cb];     \
            NB_EID(B)[(H) * 16 + pos] = e_; pend_i = (H) * 16 + pos; pend_g = ev / sm; pend_su = uscg[e_]; pend_sv = vscg[e_]; } }    \
        __builtin_amdgcn_wave_barrier();                                                                                           \
    }
#define TK_FLUSH(B) { if (pend_i >= 0) { NB_EG(B)[pend_i] = pend_g * pend_sv; NB_EU(B)[pend_i] = pend_su; } pend_i = -1; }
    float rs_cur = 0.f, rs_n = 0.f;
    {
        unsigned char* B0 = wbase;
        TK_LOAD_X(row) TK_STAGE_X(B0, rs_cur)
#pragma unroll 1
        for (int h = 0; h < PEER_H; ++h) { TK_FLUSH(B0) TK_LOAD_SC(row, h) TK_PART_A(B0) TK_PART_B(B0, h, rs_cur) }
        TK_FLUSH(B0)
        __builtin_amdgcn_s_waitcnt(0xC07F); __builtin_amdgcn_wave_barrier();
    }
#pragma unroll 1
    for (int it = 0;; ++it) {
        unsigned char* wsm = wbase + (it & 1) * 4096;
        unsigned char* nb = wbase + ((it + 1) & 1) * 4096;
        const int* eid = NB_EID(wsm); const float* egate = NB_EG(wsm); const float* eusc = NB_EU(wsm);
        const float rs = rs_cur;
        const int nrow_raw = row + stride;
        const int nrow = nrow_raw < MTOK ? nrow_raw : row;
        TK_LOAD_X(nrow) TK_LOAD_SC(nrow, 0)
        f32x4 acc[4];
#pragma unroll
        for (int i = 0; i < 4; ++i) acc[i] = (f32x4){0.f, 0.f, 0.f, 0.f};
        const unsigned koff = (unsigned)((c >> 3) * 64 + 16 * gq);
        u32x4 ub0[8], ub1[8], vb0[8], vb1[8];
        int ec0 = eid[c & 7], ec1 = eid[8 + (c & 7)];
#pragma unroll
        for (int k3 = 0; k3 < 8; ++k3) ub0[k3] = ldws<u32x4>(W, O_UT + (unsigned)ec0 * 1024u + koff + k3 * 128);
#pragma unroll
        for (int j = 0; j < 8; ++j) vb0[j] = ldws<u32x4>(W, O_VT + (unsigned)__builtin_amdgcn_readlane(ec0, j) * 1024u + lane * 16);
#pragma unroll
        for (int k3 = 0; k3 < 8; ++k3) ub1[k3] = ldws<u32x4>(W, O_UT + (unsigned)ec1 * 1024u + koff + k3 * 128);
#define PEER_TILE(UB, EC, VBC, ECN, VBN)                                                                                           \
        {                                                                                                                          \
            f32x4 dh = {0.f, 0.f, 0.f, 0.f}, dl = {0.f, 0.f, 0.f, 0.f};                                                             \
            _Pragma("unroll") for (int k3 = 0; k3 < 8; ++k3) {                                                                     \
                const u32x4 xh = *(const u32x4*)(wsm + k3 * 128 + koff), xlo = *(const u32x4*)(wsm + 1024 + k3 * 128 + koff);      \
                const long u0 = (long)(((unsigned long long)UB[k3].y << 32) | UB[k3].x), u1 = (long)(((unsigned long long)UB[k3].w << 32) | UB[k3].z); \
                const long h0 = (long)(((unsigned long long)xh.y << 32) | xh.x), h1 = (long)(((unsigned long long)xh.w << 32) | xh.z);  \
                const long l0 = (long)(((unsigned long long)xlo.y << 32) | xlo.x), l1 = (long)(((unsigned long long)xlo.w << 32) | xlo.z); \
                dh = __builtin_amdgcn_mfma_f32_16x16x32_fp8_fp8(h0, u0, dh, 0, 0, 0);                                              \
                dh = __builtin_amdgcn_mfma_f32_16x16x32_fp8_fp8(h1, u1, dh, 0, 0, 0);                                              \
                dl = __builtin_amdgcn_mfma_f32_16x16x32_fp8_fp8(l0, u0, dl, 0, 0, 0);                                              \
                dl = __builtin_amdgcn_mfma_f32_16x16x32_fp8_fp8(l1, u1, dl, 0, 0, 0);                                              \
            }                                                                                                                      \
            float mine = dh[0] + dl[0] * (1.f / 16.f);                                                                             \
            mine += __shfl_xor(mine, 40);                                                       \
            const float act = gelu_tanh(mine * (1.f / 16.f) * eusc[tcur * 8 + (c & 7)] * rs) * egate[tcur * 8 + (c & 7)];           \
            if (tcur + 2 < 16) {                                                                                                   \
                EC = eid[(tcur + 2) * 8 + (c & 7)];                                                                                \
                _Pragma("unroll") for (int k3 = 0; k3 < 8; ++k3) UB[k3] = ldws<u32x4>(W, O_UT + (unsigned)EC * 1024u + koff + k3 * 128); \
            }                                                                                                                      \
            if (tcur + 1 < 16) {                                                                                                   \
                _Pragma("unroll") for (int j = 0; j < 8; ++j) VBN[j] = ldws<u32x4>(W, O_VT + (unsigned)__builtin_amdgcn_readlane(ECN, j) * 1024u + lane * 16); \
            }                                                                                                                      \
            __builtin_amdgcn_sched_barrier(0);                                                                                     \
            _Pragma("unroll") for (int j = 0; j < 8; ++j) {                                                                        \
                const float aj = __builtin_bit_cast(float, __builtin_amdgcn_readlane(__builtin_bit_cast(int, act), j));            \
                const u32x4 vw = VBC[j];                                                                                           \
                const f32x2_t p0 = __builtin_amdgcn_cvt_pk_f32_fp8((int)vw.x, false), p1 = __builtin_amdgcn_cvt_pk_f32_fp8((int)vw.x, true); \
                const f32x2_t p2 = __builtin_amdgcn_cvt_pk_f32_fp8((int)vw.y, false), p3 = __builtin_amdgcn_cvt_pk_f32_fp8((int)vw.y, true); \
                const f32x2_t p4 = __builtin_amdgcn_cvt_pk_f32_fp8((int)vw.z, false), p5 = __builtin_amdgcn_cvt_pk_f32_fp8((int)vw.z, true); \
                const f32x2_t p6 = __builtin_amdgcn_cvt_pk_f32_fp8((int)vw.w, false), p7 = __builtin_amdgcn_cvt_pk_f32_fp8((int)vw.w, true); \
                acc[0] += (f32x4){p0[0], p0[1], p1[0], p1[1]} * aj; acc[1] += (f32x4){p2[0], p2[1], p3[0], p3[1]} * aj;             \
                acc[2] += (f32x4){p4[0], p4[1], p5[0], p5[1]} * aj; acc[3] += (f32x4){p6[0], p6[1], p7[0], p7[1]} * aj;             \
            }                                                                                                                      \
            __builtin_amdgcn_sched_barrier(0);                                                                                     \
        }
#pragma unroll 1
        for (int tp = 0; tp < 8; ++tp) {
            { const int tcur = 2 * tp; PEER_TILE(ub0, ec0, vb0, ec1, vb1) }
            if (tp == 0) { TK_STAGE_X(nb, rs_n) }
            TK_FLUSH(nb)
            TK_PART_A(nb)
            __builtin_amdgcn_sched_barrier(0);
            { const int tcur = 2 * tp + 1; PEER_TILE(ub1, ec1, vb1, ec0, vb0) }
            TK_PART_B(nb, tp, rs_n)
            { const int hn = tp < 7 ? tp + 1 : 7; TK_LOAD_SC(nrow, hn) }
            __builtin_amdgcn_sched_barrier(0);
        }
#undef PEER_TILE
        TK_FLUSH(nb)
        float* hr = p.out + (size_t)row * DM;
        float ss = 0.f;
        {
            f32x4 h0, h1, h2, h3;
            unpack8(ldws<u32x4>(W, O_HG + (unsigned)row * 2048u + lane * 16), h0, h1); unpack8(ldws<u32x4>(W, O_HG + (unsigned)row * 2048u + 1024 + lane * 16), h2, h3);
            acc[0] += h0; acc[1] += h1; acc[2] += h2; acc[3] += h3;
        }
#pragma unroll
        for (int i = 0; i < 4; ++i) ss += acc[i][0] * acc[i][0] + acc[i][1] * acc[i][1] + acc[i][2] * acc[i][2] + acc[i][3] * acc[i][3];
        ss = wave_sum(ss);
        const float scl = rsqrtf(ss * (1.f / DM) + NORM_EPS);
#pragma unroll
        for (int cc = 0; cc < 2; ++cc) {
            const f32x4 ga = *(const f32x4*)(p.norm_f_g + cc * 512 + lane * 8), gb = *(const f32x4*)(p.norm_f_g + cc * 512 + lane * 8 + 4);
            *(f32x4*)(hr + cc * 512 + lane * 8) = acc[2 * cc] * scl * ga; *(f32x4*)(hr + cc * 512 + lane * 8 + 4) = acc[2 * cc + 1] * scl * gb;
        }
        __builtin_amdgcn_s_waitcnt(0xC07F); __builtin_amdgcn_wave_barrier();
        if (nrow_raw >= MTOK) break;
        row = nrow_raw; rs_cur = rs_n;
    }
#undef TK_FLUSH
#undef TK_PART_B
#undef TK_PART_A
#undef TK_K16
#undef TK_STAGE_X
#undef TK_LOAD_SC
#undef TK_LOAD_X
}

struct __attribute__((packed, aligned(4))) U3 { unsigned a, b, c; };
typedef int v8i32_t __attribute__((ext_vector_type(8)));
typedef int v6i32_t __attribute__((ext_vector_type(6)));
typedef float v32f32_t __attribute__((ext_vector_type(32)));
template <bool NOTK>
__device__ __forceinline__ void phase_peer6(const Params& p, unsigned char* smem, int vcu, int G) {
    int tid_ = threadIdx.x; asm volatile("" : "+v"(tid_));
    const int wave = __builtin_amdgcn_readfirstlane(tid_ >> 6), lane = tid_ & 63;
    const int gq = lane >> 4, c = lane & 15;
    unsigned char* wbase = smem + wave * 8192;
    const unsigned char* W = p.ws;
    constexpr unsigned O_SC = WS_SCORES << 20, O_HG = WS_HG << 20, O_UT = WS_UTAB << 20, O_VT = WS_VTAB << 20;
    const float* rss = WSP(float, WS_RSS);
    const float* uscg = WSP(float, WS_USC); const float* vscg = WSP(float, WS_VSC);
    const int stride = G * NWAVES;
    int ca = 0, cb = 0;
    {
        int rem = lane; bool found = false;
#pragma unroll
        for (int a = 0; a < 16; ++a) { const int cnt = 16 / (a + 1); if (!found) { if (rem < cnt) { ca = a; cb = rem; found = true; } else rem -= cnt; } }
    }
    int row = vcu * NWAVES + wave;
    if (row >= MTOK) return;
    u32x4 xw0, xw1; float rssv = 0.f; unsigned sc0 = 0, sc1 = 0, sc2 = 0, sc3 = 0;
    int pend_i = -1; float pend_g = 0.f, pend_su = 0.f, pend_sv = 0.f;
#define NB_LV(B)  ((float*)((B) + 2048))
#define NB_LI(B)  ((int*)((B) + 2048 + 128))
#define NB_VS(B)  ((float*)((B) + 2048 + 256))
#define NB_IS(B)  ((int*)((B) + 2048 + 384))
#define NB_EID(B) ((int*)((B) + 2048 + 512))
#define NB_EG(B)  ((float*)((B) + 2048 + 1024))
#define NB_EU(B)  ((float*)((B) + 2048 + 1536))
#define TK_LOAD_X(R) { xw0 = ldws<u32x4>(W, O_HG + (unsigned)(R) * 2048u + lane * 16); xw1 = ldws<u32x4>(W, O_HG + (unsigned)(R) * 2048u + 1024 + lane * 16); rssv = lane < 16 ? rss[(size_t)(R) * 16 + lane] : 0.f; }
#define TK_LOAD_SC(R, H) { const unsigned so_ = O_SC + (unsigned)(R) * 4096u + (H) * 512 + lane * 2; sc0 = ldws<unsigned short>(W, so_); sc1 = ldws<unsigned short>(W, so_ + 128); sc2 = ldws<unsigned short>(W, so_ + 256); sc3 = ldws<unsigned short>(W, so_ + 384); }
#define TK_STAGE_X(B, RS) {                                                                                                        \
        RS = rsqrtf(wave_sum(rssv) * (1.f / DM) + NORM_EPS);                                                                       \
        f32x4 xa[4]; unpack8(xw0, xa[0], xa[1]); unpack8(xw1, xa[2], xa[3]);                                                        \
        xa[0] *= *(const f32x4*)(p.norm2_g + lane * 8); xa[1] *= *(const f32x4*)(p.norm2_g + lane * 8 + 4); xa[2] *= *(const f32x4*)(p.norm2_g + 512 + lane * 8); xa[3] *= *(const f32x4*)(p.norm2_g + 512 + lane * 8 + 4); \
        unsigned hw[4], lw[4];                                                                                                     \
        _Pragma("unroll") for (int i = 0; i < 4; ++i) {                                                                            \
            const f32x4 xs = xa[i] * 16.f;                                                                                         \
            int h_ = __builtin_amdgcn_cvt_pk_fp8_f32(xs[0], xs[1], 0, false); h_ = __builtin_amdgcn_cvt_pk_fp8_f32(xs[2], xs[3], h_, true); \
            const f32x2_t b0 = __builtin_amdgcn_cvt_pk_f32_fp8(h_, false), b1 = __builtin_amdgcn_cvt_pk_f32_fp8(h_, true);         \
            int l_ = __builtin_amdgcn_cvt_pk_fp8_f32((xs[0] - b0[0]) * 16.f, (xs[1] - b0[1]) * 16.f, 0, false); l_ = __builtin_amdgcn_cvt_pk_fp8_f32((xs[2] - b1[0]) * 16.f, (xs[3] - b1[1]) * 16.f, l_, true); \
            hw[i] = (unsigned)h_; lw[i] = (unsigned)l_;                                                                            \
        }                                                                                                                          \
                                                                                                       \
        const int xo_ = PEER_U6 == 1 ? ((lane >> 2) & 3) * 256 + (2 * ((lane >> 4) & 1) + ((lane >> 1) & 1)) * 32 + ((lane >> 5) & 1) * 16 + (lane & 1) * 8 \
                      : PEER_U6 == 2 ? ((lane >> 2) & 3) * 256 + (lane >> 4) * 32 + (lane & 3) * 8 : lane * 8;                       \
        const int xo2_ = xo_ + (PEER_U6 ? 128 : 512);                                                                              \
        *(uint2*)((B) + xo_) = make_uint2(hw[0], hw[1]); *(uint2*)((B) + xo2_) = make_uint2(hw[2], hw[3]);                          \
        *(uint2*)((B) + 1024 + xo_) = make_uint2(lw[0], lw[1]); *(uint2*)((B) + 1024 + xo2_) = make_uint2(lw[2], lw[3]);            \
    }
#define TK_K16(hb) ((((unsigned)(hb) & 0x8000u) ? (~(unsigned)(hb) & 0xffffu) : ((unsigned)(hb) | 0x8000u)) << 16)
#define TK_PART_A(B) {                                                                                                             \
        const unsigned ka0 = TK_K16(sc0) | (0xFFFFu - (unsigned)lane), ka1 = TK_K16(sc1) | (0xFFFFu - 64u - (unsigned)lane);       \
        const unsigned kb0 = TK_K16(sc2) | (0xFFFFu - (unsigned)lane), kb1 = TK_K16(sc3) | (0xFFFFu - 64u - (unsigned)lane);       \
          \
        unsigned loA = 0u, hiA = 0xFFFFFFFFu, loB = 0u, hiB = 0xFFFFFFFFu; bool doneA = false, doneB = false;                       \
        while (!(doneA && doneB)) {                                                                                                \
            const unsigned midA = loA + ((hiA - loA) >> 1), midB = loB + ((hiB - loB) >> 1);                                        \
            const int cntA = __builtin_popcountll(__ballot(ka0 >= midA)) + __builtin_popcountll(__ballot(ka1 >= midA));             \
            const int cntB = __builtin_popcountll(__ballot(kb0 >= midB)) + __builtin_popcountll(__ballot(kb1 >= midB));             \
            loA = cntA >= 16 ? midA : loA; hiA = cntA >= 16 ? hiA : midA; doneA = doneA || (cntA == 16) || (hiA - loA <= 1u);       \
            loB = cntB >= 16 ? midB : loB; hiB = cntB >= 16 ? hiB : midB; doneB = doneB || (cntB == 16) || (hiB - loB <= 1u);       \
        }                                                                                                                          \
           \
        unsigned* lk = (unsigned*)NB_LV(B);                                                                                        \
        { const unsigned T = loA; const bool k0 = ka0 >= T, k1 = ka1 >= T; const unsigned long long s0 = __ballot(k0), s1 = __ballot(k1); \
          if (k0) { lk[mbcnt64(s0)] = ka0; }                                                                                       \
          if (k1) { const int pos = __builtin_popcountll(s0) + mbcnt64(s1); if (pos < 16) lk[pos] = ka1; } }                        \
        { const unsigned T = loB; const bool k0 = kb0 >= T, k1 = kb1 >= T; const unsigned long long s0 = __ballot(k0), s1 = __ballot(k1); \
          if (k0) { lk[16 + mbcnt64(s0)] = kb0; }                                                                                  \
          if (k1) { const int pos = __builtin_popcountll(s0) + mbcnt64(s1); if (pos < 16) lk[16 + pos] = kb1; } }                   \
        __builtin_amdgcn_s_waitcnt(0xC07F); __builtin_amdgcn_wave_barrier();                                                       \
    }
#define TK_PART_B(B, H, RS) {                                                                                                      \
        const unsigned* lk = (const unsigned*)NB_LV(B); float* vs = NB_VS(B); int* is_ = NB_IS(B);                                  \
        if (lane < 32) { const int base = lane & 16; const unsigned mk = lk[lane]; int rk = 0;         \
            _Pragma("unroll") for (int j = 0; j < 16; ++j) rk += (lk[base + j] > mk) ? 1 : 0;                                       \
            const unsigned k16 = mk >> 16, hb = (k16 & 0x8000u) ? (k16 & 0x7fffu) : (~k16 & 0xffffu);                               \
            vs[base + rk] = (float)__builtin_bit_cast(_Float16, (unsigned short)hb); is_[base + rk] = (int)(0xFFFFu - (mk & 0xFFFFu)); } \
        __builtin_amdgcn_s_waitcnt(0xC07F); __builtin_amdgcn_wave_barrier();                                                       \
        float cv = 0.f; unsigned kc = 0u;                                                                                          \
        if (lane < 50) { cv = vs[ca] + vs[16 + cb]; kc = fkey(cv); }                                                                \
        const float top_ = vs[0] + vs[16];                           \
        unsigned lo = fkey(vs[15] + vs[31]), hi = fkey(top_) + 1u; bool fin_ = false;                                               \
        do { const unsigned mid = lo + ((hi - lo) >> 1); const int cnt = __builtin_popcountll(__ballot(kc >= mid));                 \
             lo = cnt >= 16 ? mid : lo; hi = cnt >= 16 ? hi : mid; fin_ = (cnt == 16) || (hi - lo <= 1u); } while (!fin_);          \
        const unsigned T2 = lo; const unsigned long long tm = __ballot(kc == T2);                                                  \
        const int need2 = 16 - __builtin_popcountll(__ballot(kc > T2));                                                            \
        const bool take = (kc > T2) || (kc == T2 && mbcnt64(tm) < need2);                                                          \
        const float ev = take ? __expf((cv - top_) * (RS)) : 0.f; const float sm = wave_sum(ev);                                    \
        pend_i = -1;                                                                                                               \
        if (take) { const int pos = mbcnt64(__ballot(take)); if (pos < 16) { const int e_ = is_[ca] * PEER_KEYS + is_[16 + cb];     \
            NB_EID(B)[(H) * 16 + pos] = e_; pend_i = (H) * 16 + pos; pend_g = ev * __builtin_amdgcn_rcpf(sm); pend_su = uscg[e_]; pend_sv = vscg[e_]; } } \
        __builtin_amdgcn_wave_barrier();                                                                                           \
    }
#define TK_FLUSH(B) { if (pend_i >= 0) { NB_EG(B)[pend_i] = pend_g * pend_sv; NB_EU(B)[pend_i] = pend_su; } pend_i = -1; }
    float rs_cur = 0.f, rs_n = 0.f;
    {
        unsigned char* B0 = wbase;
        TK_LOAD_X(row) TK_STAGE_X(B0, rs_cur)
#pragma unroll 1
        for (int h = 0; h < PEER_H; ++h) { TK_FLUSH(B0) TK_LOAD_SC(row, h) TK_PART_A(B0) TK_PART_B(B0, h, rs_cur) }
        TK_FLUSH(B0)
        __builtin_amdgcn_s_waitcnt(0xC07F); __builtin_amdgcn_wave_barrier();
    }
#if PEER_U6 == 1
        const unsigned koff = (unsigned)((c >> 3) * 64 + gq * 16);
        const unsigned xoff = (unsigned)(((c >> 3) * 4 + gq) * 32);
        constexpr int NUB = 6;
#define U_LOAD(UB, E_) { _Pragma("unroll") for (int k3 = 0; k3 < 6; ++k3) UB[k3] = ldws<u32x4>(W, O_UT + (unsigned)(E_) * 768u + koff + k3 * 128); }
#define UBD(UB, i) ((int)UB[(i) >> 2][(i) & 3])
#define U_DOT(UB)                                                                                                                  \
            _Pragma("unroll") for (int ks = 0; ks < 4; ++ks) {                                                                     \
                const u32x4 xh0 = *(const u32x4*)(wsm + ks * 256 + xoff), xh1 = *(const u32x4*)(wsm + ks * 256 + xoff + 16);       \
                const u32x4 xl0 = *(const u32x4*)(wsm + 1024 + ks * 256 + xoff), xl1 = *(const u32x4*)(wsm + 1024 + ks * 256 + xoff + 16); \
                const v8i32_t xa = {(int)xh0.x, (int)xh0.y, (int)xh0.z, (int)xh0.w, (int)xh1.x, (int)xh1.y, (int)xh1.z, (int)xh1.w}; \
                const v8i32_t xb = {(int)xl0.x, (int)xl0.y, (int)xl0.z, (int)xl0.w, (int)xl1.x, (int)xl1.y, (int)xl1.z, (int)xl1.w}; \
                const v8i32_t uw = {UBD(UB, 6 * ks), UBD(UB, 6 * ks + 1), UBD(UB, 6 * ks + 2), UBD(UB, 6 * ks + 3), UBD(UB, 6 * ks + 4), UBD(UB, 6 * ks + 5), 0, 0}; \
                dh = __builtin_amdgcn_mfma_scale_f32_16x16x128_f8f6f4(xa, uw, dh, 0, 2, 0, 0x7F7F7F7F, 0, 0x7F7F7F7F);              \
                dl = __builtin_amdgcn_mfma_scale_f32_16x16x128_f8f6f4(xb, uw, dl, 0, 2, 0, 0x7F7F7F7F, 0, 0x7F7F7F7F);              \
            }
#elif PEER_U6 == 2
        const unsigned koff = (unsigned)((c >> 3) * 512 + gq * 128);
        const unsigned xoff = (unsigned)(((c >> 3) * 4 + gq) * 32);
        constexpr int NUB = 8;
#define U_LOAD(UB, E_) { _Pragma("unroll") for (int k3 = 0; k3 < 8; ++k3) UB[k3] = ldws<u32x4>(W, O_UT + (unsigned)(E_) * 1024u + koff + k3 * 16); }
#define U_DOT(UB)                                                                                                                  \
            _Pragma("unroll") for (int ks = 0; ks < 4; ++ks) {                                                                     \
                const u32x4 xh0 = *(const u32x4*)(wsm + ks * 256 + xoff), xh1 = *(const u32x4*)(wsm + ks * 256 + xoff + 16);       \
                const u32x4 xl0 = *(const u32x4*)(wsm + 1024 + ks * 256 + xoff), xl1 = *(const u32x4*)(wsm + 1024 + ks * 256 + xoff + 16); \
                const v8i32_t xa = {(int)xh0.x, (int)xh0.y, (int)xh0.z, (int)xh0.w, (int)xh1.x, (int)xh1.y, (int)xh1.z, (int)xh1.w}; \
                const v8i32_t xb = {(int)xl0.x, (int)xl0.y, (int)xl0.z, (int)xl0.w, (int)xl1.x, (int)xl1.y, (int)xl1.z, (int)xl1.w}; \
                const v8i32_t uw = {(int)UB[2 * ks].x, (int)UB[2 * ks].y, (int)UB[2 * ks].z, (int)UB[2 * ks].w, (int)UB[2 * ks + 1].x, (int)UB[2 * ks + 1].y, (int)UB[2 * ks + 1].z, (int)UB[2 * ks + 1].w}; \
                dh = __builtin_amdgcn_mfma_scale_f32_16x16x128_f8f6f4(xa, uw, dh, 0, 0, 0, 0x7F7F7F7F, 0, 0x7F7F7F7F);              \
                dl = __builtin_amdgcn_mfma_scale_f32_16x16x128_f8f6f4(xb, uw, dl, 0, 0, 0, 0x7F7F7F7F, 0, 0x7F7F7F7F);              \
            }
#else
        const unsigned koff = (unsigned)((c >> 3) * 64 + 16 * gq);
        constexpr int NUB = 8;
#define U_LOAD(UB, E_) { _Pragma("unroll") for (int k3 = 0; k3 < 8; ++k3) UB[k3] = ldws<u32x4>(W, O_UT + (unsigned)(E_) * 1024u + koff + k3 * 128); }
#define U_DOT(UB)                                                                                                                  \
            _Pragma("unroll") for (int k3 = 0; k3 < 8; ++k3) {                                                                     \
                const u32x4 xh = *(const u32x4*)(wsm + k3 * 128 + koff), xlo = *(const u32x4*)(wsm + 1024 + k3 * 128 + koff);      \
                const long u0 = (long)(((unsigned long long)UB[k3].y << 32) | UB[k3].x), u1 = (long)(((unsigned long long)UB[k3].w << 32) | UB[k3].z); \
                const long h0 = (long)(((unsigned long long)xh.y << 32) | xh.x), h1 = (long)(((unsigned long long)xh.w << 32) | xh.z);  \
                const long l0 = (long)(((unsigned long long)xlo.y << 32) | xlo.x), l1 = (long)(((unsigned long long)xlo.w << 32) | xlo.z); \
                dh = __builtin_amdgcn_mfma_f32_16x16x32_fp8_fp8(h0, u0, dh, 0, 0, 0);                                              \
                dh = __builtin_amdgcn_mfma_f32_16x16x32_fp8_fp8(h1, u1, dh, 0, 0, 0);                                              \
                dl = __builtin_amdgcn_mfma_f32_16x16x32_fp8_fp8(l0, u0, dl, 0, 0, 0);                                              \
                dl = __builtin_amdgcn_mfma_f32_16x16x32_fp8_fp8(l1, u1, dl, 0, 0, 0);                                              \
            }
#endif
#if PEER_V6
        typedef U3 vb_t;
#define V_LOAD(VB, ESRC) { _Pragma("unroll") for (int j = 0; j < 8; ++j) VB[j] = ldws<U3>(W, O_VT + (unsigned)__builtin_amdgcn_readlane(ESRC, j) * 768u + lane * 12); }
#define V_LOAD_H(VB, ESRC, J0) { _Pragma("unroll") for (int j = J0; j < J0 + 4; ++j) VB[j] = ldws<U3>(W, O_VT + (unsigned)__builtin_amdgcn_readlane(ESRC, j) * 768u + lane * 12); }
#define V_ACC(VBC)                                                                                                                 \
            _Pragma("unroll") for (int jp = 0; jp < 4; ++jp) {                                                                     \
                const float a0_ = __builtin_bit_cast(float, __builtin_amdgcn_readlane(__builtin_bit_cast(int, act), 2 * jp));      \
                const float a1_ = __builtin_bit_cast(float, __builtin_amdgcn_readlane(__builtin_bit_cast(int, act), 2 * jp + 1));  \
                const v6i32_t sv_ = {(int)VBC[2 * jp].a, (int)VBC[2 * jp].b, (int)VBC[2 * jp].c, (int)VBC[2 * jp + 1].a, (int)VBC[2 * jp + 1].b, (int)VBC[2 * jp + 1].c}; \
                const v32f32_t f_ = __builtin_amdgcn_cvt_scalef32_pk32_f32_fp6(sv_, 1.0f);                                         \
                _Pragma("unroll") for (int q_ = 0; q_ < 4; ++q_) {                                                                 \
                    acc[q_] += (f32x4){f_[4 * q_], f_[4 * q_ + 1], f_[4 * q_ + 2], f_[4 * q_ + 3]} * a0_;                           \
                    acc[q_] += (f32x4){f_[16 + 4 * q_], f_[16 + 4 * q_ + 1], f_[16 + 4 * q_ + 2], f_[16 + 4 * q_ + 3]} * a1_;       \
                }                                                                                                                  \
            }
#else
        typedef u32x4 vb_t;
#define V_LOAD(VB, ESRC) { _Pragma("unroll") for (int j = 0; j < 8; ++j) VB[j] = ldws<u32x4>(W, O_VT + (unsigned)__builtin_amdgcn_readlane(ESRC, j) * 1024u + lane * 16); }
#define V_LOAD_H(VB, ESRC, J0) { _Pragma("unroll") for (int j = J0; j < J0 + 4; ++j) VB[j] = ldws<u32x4>(W, O_VT + (unsigned)__builtin_amdgcn_readlane(ESRC, j) * 1024u + lane * 16); }
#define V_ACC(VBC)                                                                                                                 \
            _Pragma("unroll") for (int j = 0; j < 8; ++j) {                                                                        \
                const float aj = __builtin_bit_cast(float, __builtin_amdgcn_readlane(__builtin_bit_cast(int, act), j));            \
                const u32x4 vw = VBC[j];                                                                                           \
                const f32x2_t p0 = __builtin_amdgcn_cvt_pk_f32_fp8((int)vw.x, false), p1 = __builtin_amdgcn_cvt_pk_f32_fp8((int)vw.x, true); \
                const f32x2_t p2 = __builtin_amdgcn_cvt_pk_f32_fp8((int)vw.y, false), p3 = __builtin_amdgcn_cvt_pk_f32_fp8((int)vw.y, true); \
                const f32x2_t p4 = __builtin_amdgcn_cvt_pk_f32_fp8((int)vw.z, false), p5 = __builtin_amdgcn_cvt_pk_f32_fp8((int)vw.z, true); \
                const f32x2_t p6 = __builtin_amdgcn_cvt_pk_f32_fp8((int)vw.w, false), p7 = __builtin_amdgcn_cvt_pk_f32_fp8((int)vw.w, true); \
                acc[0] += (f32x4){p0[0], p0[1], p1[0], p1[1]} * aj; acc[1] += (f32x4){p2[0], p2[1], p3[0], p3[1]} * aj;             \
                acc[2] += (f32x4){p4[0], p4[1], p5[0], p5[1]} * aj; acc[3] += (f32x4){p6[0], p6[1], p7[0], p7[1]} * aj;             \
            }
#endif
    u32x4 ub0[NUB], ub1[NUB]; vb_t vb0[8], vb1[8];
    int ec0, ec1;
    {
        const int* eid0 = NB_EID(wbase);
        ec0 = eid0[c & 7]; ec1 = eid0[8 + (c & 7)];
        U_LOAD(ub0, ec0)
        V_LOAD(vb0, ec0)
        U_LOAD(ub1, ec1)
    }
#pragma unroll 1
    for (int it = 0;; ++it) {
        unsigned char* wsm = NOTK ? wbase : wbase + (it & 1) * 4096;
        unsigned char* nb = NOTK ? wbase : wbase + ((it + 1) & 1) * 4096;
        const int* eid = NB_EID(wsm); const float* egate = NB_EG(wsm); const float* eusc = NB_EU(wsm);
        const float rs = rs_cur;
        const int nrow_raw = row + stride;
        const int nrow = nrow_raw < MTOK ? nrow_raw : row;
        TK_LOAD_X(nrow) TK_LOAD_SC(nrow, 0)
        f32x4 acc[4];
#pragma unroll
        for (int i = 0; i < 4; ++i) acc[i] = (f32x4){0.f, 0.f, 0.f, 0.f};
#define PEER_TILE(UB, EC, VBC, ECN, VBN)                                                                                           \
        {                                                                                                                          \
            f32x4 dh = {0.f, 0.f, 0.f, 0.f}, dl = {0.f, 0.f, 0.f, 0.f};                                                             \
            U_DOT(UB)                                                                                                              \
            float mine = dh[0] + dl[0] * (1.f / 16.f);                                                                             \
            mine += __shfl_xor(mine, 40);                                                       \
            const float act = gelu_fast(mine * (1.f / 16.f) * eusc[tcur * 8 + (c & 7)] * rs) * egate[tcur * 8 + (c & 7)];           \
            {     \
                const int* es_ = (tcur + 2 < 16) ? eid + (tcur + 2) * 8 : NB_EID(nb) + (tcur + 2 - 16) * 8;                          \
                EC = es_[c & 7]; U_LOAD(UB, EC)                                                                                    \
                V_LOAD(VBN, ECN)                                                                                                   \
            }                                                                                                                      \
            __builtin_amdgcn_sched_barrier(0);                                                                                     \
            V_ACC(VBC)                                                                                                             \
            __builtin_amdgcn_sched_barrier(0);                                                                                     \
        }
#pragma unroll 1
        for (int tp = 0; tp < 8; ++tp) {
            { const int tcur = 2 * tp; PEER_TILE(ub0, ec0, vb0, ec1, vb1) }
            if (!NOTK) {
            if (tp == 0) { TK_STAGE_X(nb, rs_n) }
            TK_FLUSH(nb)
            TK_PART_A(nb)
            }
            __builtin_amdgcn_sched_barrier(0);
            { const int tcur = 2 * tp + 1; PEER_TILE(ub1, ec1, vb1, ec0, vb0) }
            if (!NOTK) {
            TK_PART_B(nb, tp, rs_n)
            { const int hn = tp < 7 ? tp + 1 : 7; TK_LOAD_SC(nrow, hn) }
            }
            __builtin_amdgcn_sched_barrier(0);
        }
#undef PEER_TILE
#undef U_LOAD
#undef U_DOT
#undef V_LOAD
#undef V_LOAD_H
#undef V_ACC
        if (!NOTK) { TK_FLUSH(nb) }
        float* hr = p.out + (size_t)row * DM;
        float ss = 0.f;
        {
            f32x4 h0, h1, h2, h3;
            unpack8(ldws<u32x4>(W, O_HG + (unsigned)row * 2048u + lane * 16), h0, h1); unpack8(ldws<u32x4>(W, O_HG + (unsigned)row * 2048u + 1024 + lane * 16), h2, h3);
            acc[0] += h0; acc[1] += h1; acc[2] += h2; acc[3] += h3;
        }
#pragma unroll
        for (int i = 0; i < 4; ++i) ss += acc[i][0] * acc[i][0] + acc[i][1] * acc[i][1] + acc[i][2] * acc[i][2] + acc[i][3] * acc[i][3];
        ss = wave_sum(ss);
        const float scl = rsqrtf(ss * (1.f / DM) + NORM_EPS);
#pragma unroll
        for (int cc = 0; cc < 2; ++cc) {
            const f32x4 ga = *(const f32x4*)(p.norm_f_g + cc * 512 + lane * 8), gb = *(const f32x4*)(p.norm_f_g + cc * 512 + lane * 8 + 4);
            *(f32x4*)(hr + cc * 512 + lane * 8) = acc[2 * cc] * scl * ga; *(f32x4*)(hr + cc * 512 + lane * 8 + 4) = acc[2 * cc + 1] * scl * gb;
        }
        __builtin_amdgcn_s_waitcnt(0xC07F); __builtin_amdgcn_wave_barrier();
        if (nrow_raw >= MTOK) break;
        row = nrow_raw; rs_cur = rs_n;
    }
#undef TK_FLUSH
#undef TK_PART_B
#undef TK_PART_A
#undef TK_K16
#undef TK_STAGE_X
#undef TK_LOAD_SC
#undef TK_LOAD_X
}


#ifdef UT_FP6
__device__ __forceinline__ int ut_a(int row, int g, int i) { return ((i * 7 + g * 3 + row) % 13) - 6; }
__device__ __forceinline__ int ut_b(int col, int g, int j) { return ((j * 5 + g * 2 + col * 3) % 7) - 3; }
__device__ __forceinline__ void ut_fp6(const Params& p) {
    const int lane = threadIdx.x & 63, g = lane >> 4, c = lane & 15;
    unsigned aw[8];
#pragma unroll
    for (int w = 0; w < 8; ++w) {
        int h_ = __builtin_amdgcn_cvt_pk_fp8_f32((float)ut_a(c, g, 4 * w), (float)ut_a(c, g, 4 * w + 1), 0, false);
        h_ = __builtin_amdgcn_cvt_pk_fp8_f32((float)ut_a(c, g, 4 * w + 2), (float)ut_a(c, g, 4 * w + 3), h_, true);
        aw[w] = (unsigned)h_;
    }
    unsigned bw[6];
    {
        unsigned cd[16];
#pragma unroll
        for (int j = 0; j < 16; ++j) cd[j] = fp6_code((float)ut_b(c, g, j));
        fp6_pack16(cd, bw[0], bw[1], bw[2]);
#pragma unroll
        for (int j = 0; j < 16; ++j) cd[j] = fp6_code((float)ut_b(c, g, 16 + j));
        fp6_pack16(cd, bw[3], bw[4], bw[5]);
    }
    const v8i32_t A = {(int)aw[0], (int)aw[1], (int)aw[2], (int)aw[3], (int)aw[4], (int)aw[5], (int)aw[6], (int)aw[7]};
    const v8i32_t B = {(int)bw[0], (int)bw[1], (int)bw[2], (int)bw[3], (int)bw[4], (int)bw[5], 0, 0};
    f32x4 D = {0.f, 0.f, 0.f, 0.f};
    D = __builtin_amdgcn_mfma_scale_f32_16x16x128_f8f6f4(A, B, D, 0, 2, 0, 0x7F7F7F7F, 0, 0x7F7F7F7F);
    bool ok1 = true, ok2 = true, ok3 = true, ok4 = true;
#pragma unroll 1
    for (int r = 0; r < 4; ++r) {
        const int row = 4 * g + r;
        int e1 = 0, e2 = 0, e3 = 0, e4 = 0;
#pragma unroll 1
        for (int gg = 0; gg < 4; ++gg)
#pragma unroll 1
            for (int j = 0; j < 32; ++j) {
                const int bv = ut_b(c, gg, j);
                e1 += bv * ut_a(row, gg, j);
                { const int K = j < 16 ? 16 * gg + j : 64 + 16 * gg + (j - 16); e2 += bv * ut_a(row, K >> 5, K & 31); }
                { const int K = 32 * gg + j; const int ga = K < 64 ? (K >> 4) : ((K - 64) >> 4), ia = K < 64 ? (K & 15) : 16 + (K & 15); e3 += bv * ut_a(row, ga, ia); }
                { const int K = 32 * (j >> 3) + 8 * gg + (j & 7); e4 += bv * ut_a(row, K >> 5, K & 31); }
            }
        const float dv = D[r];
        ok1 = ok1 && (dv == (float)e1); ok2 = ok2 && (dv == (float)e2); ok3 = ok3 && (dv == (float)e3); ok4 = ok4 && (dv == (float)e4);
    }
    const bool a1 = __ballot(ok1) == ~0ull, a2 = __ballot(ok2) == ~0ull, a3 = __ballot(ok3) == ~0ull, a4 = __ballot(ok4) == ~0ull;
    const int m = a1 ? 1 : a2 ? 2 : a3 ? 3 : a4 ? 4 : 0;
    const v6i32_t sv = {(int)bw[0], (int)bw[1], (int)bw[2], (int)bw[3], (int)bw[4], (int)bw[5]};
    const v32f32_t f = __builtin_amdgcn_cvt_scalef32_pk32_f32_fp6(sv, 1.0f);
    bool okc = true;
#pragma unroll
    for (int j = 0; j < 32; ++j) okc = okc && (f[j] == (float)ut_b(c, g, j));
    const int c1 = (__ballot(okc) == ~0ull) ? 1 : 0;
    if (lane == 0) ((float*)p.ws)[20] = (float)(2 * m + c1);
}
#endif
__global__ void __launch_bounds__(NT, 2) k_mega(Params p) {
    extern __shared__ __attribute__((aligned(16))) unsigned char lds_raw[];
    LAS unsigned char* lds = (LAS unsigned char*)lds_raw;
    unsigned char* smem = lds_raw;
    const int tid = threadIdx.x, G = gridDim.x;
    const int vcu = (G % 8 == 0) ? ((int)blockIdx.x % 8) * (G / 8) + (int)blockIdx.x / 8 : (int)blockIdx.x;
    for (int i = tid; i < (LDS_BYTES - LDSCTL_OFF) / 4; i += NT) ((LAS unsigned*)(lds + LDSCTL_OFF))[i] = 0u;
    __syncthreads();
    XcdBarrier bar = xcd_barrier_post((unsigned*)p.ws + CW_BAR, (volatile LAS unsigned*)(lds + MISC_OFF) + 8);
#ifdef UT_FP6
    if (blockIdx.x == 0 && threadIdx.x < 64) ut_fp6(p);
#endif

#ifndef REP_PREP
#define REP_PREP 1
#endif
#ifndef REP_INPROJ
#define REP_INPROJ 1
#endif
#ifndef REP_SSM
#define REP_SSM 1
#endif
#ifndef REP_DSA
#define REP_DSA 1
#endif
#ifndef REP_MID
#define REP_MID 1
#endif
#ifndef REP_SCORES
#define REP_SCORES 1
#endif
#ifndef REP_PEER
#define REP_PEER 1
#endif
#define REPEAT(n) _Pragma("unroll 1") for (int rep_ = 0; rep_ < (n); ++rep_)
    REPEAT(REP_PREP) { phase_prep<0>(p, smem, vcu, G); xcd_barrier(bar); }
    REPEAT(REP_INPROJ) {
        EpiInProj e{WSP(bf16_t, WS_U), WSP(bf16_t, WS_Q), WSP(bf16_t, WS_K), WSP(bf16_t, WS_V), WSP(bf16_t, WS_QI), WSP(bf16_t, WS_KI),
                    WSP(bf16_t, WS_SGS), WSP(bf16_t, WS_SGA), WSP(float, WS_WI), WSP(float2, WS_ROPEA), WSP(float2, WS_ROPEI)};
        run_gemm(lds, WSP(bf16_t, WS_R1), WSP(bf16_t, WS_WINT), MTOK, IN_WP, 1024, G, e);
        if (G == 256) { if ((int)blockIdx.x >= 128) phase_prep<1>(p, smem, (int)blockIdx.x - 128, 128); }
        else phase_prep<1>(p, smem, vcu, G);
        xcd_barrier(bar);
    }
#ifdef DSA_FIRST
    REPEAT(REP_DSA) { phase_dsa(p, smem, (unsigned)(WS_YATT << 20), vcu, G); __syncthreads(); }
    REPEAT(REP_SSM) {
        int t2 = threadIdx.x; asm volatile("" : "+v"(t2));
        const int w2 = __builtin_amdgcn_readfirstlane(t2 >> 6);
#pragma unroll 1
        for (int item = vcu; item < NB * SSM_G; item += G) ssm_fast_item(p, smem, (unsigned)(WS_YG << 20), item, t2 & 63, w2);
        __syncthreads();
    }
#ifdef PROBE_SSM
    if (tid < 64) for (int item = blockIdx.x; item < NB * SSM_G; item += G) ssm_item(p, (float*)smem, (bf16_t*)p.out, item, tid);
    __syncthreads();
#endif
#else
    REPEAT(REP_SSM) {
        int t2 = threadIdx.x; asm volatile("" : "+v"(t2));
        const int w2 = __builtin_amdgcn_readfirstlane(t2 >> 6);
#pragma unroll 1
        for (int item = vcu; item < NB * SSM_G; item += G) ssm_fast_item(p, smem, (unsigned)(WS_YG << 20), item, t2 & 63, w2);
        __syncthreads();
    }
#ifdef PROBE_SSM
    if (tid < 64) for (int item = blockIdx.x; item < NB * SSM_G; item += G) ssm_item(p, (float*)smem, (bf16_t*)p.out, item, tid);
    __syncthreads();
#endif
    REPEAT(REP_DSA) { phase_dsa(p, smem, (unsigned)(WS_YATT << 20), vcu, G); __syncthreads(); }
#endif
#ifdef PROBE_ATTN
    phase_attn(p, smem, (bf16_t*)p.out, vcu, G);
    __syncthreads();
#endif
    xcd_barrier(bar);
#if defined(PROBE_ATTN) || defined(PROBE_SSM)
    {
#ifdef PROBE_SSM
        const bf16_t* A = WSP(bf16_t, WS_YG);
#else
        const bf16_t* A = WSP(bf16_t, WS_YATT);
#endif
        const bf16_t* B = (const bf16_t*)p.out;
        float d2 = 0.f, b2 = 0.f;
        for (size_t i = (size_t)blockIdx.x * NT + threadIdx.x; i < (size_t)MTOK * 512; i += (size_t)G * NT) { float a = bf2f(A[i]), bb = bf2f(B[i]); d2 += (a - bb) * (a - bb); b2 += bb * bb; }
        d2 = wave_sum(d2); b2 = wave_sum(b2);
        if ((threadIdx.x & 63) == 0) { atomicAdd((float*)p.ws + 16, d2); atomicAdd((float*)p.ws + 17, b2); }
    }
    xcd_barrier(bar);
#endif
#ifndef REP_GLU
#define REP_GLU 1
#endif
#ifndef REP_M1
#define REP_M1 1
#endif
#ifndef REP_M2
#define REP_M2 1
#endif
#ifndef REP_OUT
#define REP_OUT 1
#endif
#ifndef REP_BAR
#define REP_BAR 0
#endif
    REPEAT(REP_BAR) { xcd_barrier(bar); }
    REPEAT(REP_GLU) { EpiGlu e{WSP(bf16_t, WS_YG), WSP(bf16_t, WS_YSSM)}; run_gemm(lds, WSP(bf16_t, WS_YG), WSP(bf16_t, WS_WGLUT), MTOK, 512, 512, G, e); xcd_barrier(bar); }
    REPEAT(REP_M1) { EpiMergeChain e{WSP(bf16_t, WS_SGS), WSP(bf16_t, WS_SGA), WSP(bf16_t, WS_R1)};
        run_gemm_chain(lds, WSP(bf16_t, WS_YSSM), WSP(bf16_t, WS_WSUPT), WSP(bf16_t, WS_YATT), WSP(bf16_t, WS_WAUPT), MTOK, 1024, 512, G, e); xcd_barrier(bar); }
    REPEAT(REP_OUT) { EpiOut e{p.x, WSP(bf16_t, WS_HG), WSP(float, WS_RSS)};
        run_gemm(lds, WSP(bf16_t, WS_R1), WSP(bf16_t, WS_WOUTT), MTOK, 1024, 1024, G, e); xcd_barrier(bar); }
    REPEAT(REP_SCORES) { EpiScores e{WSP(_Float16, WS_SCORES)}; run_gemm(lds, WSP(bf16_t, WS_HG), WSP(bf16_t, WS_WCT), MTOK, 2048, 1024, G, e); xcd_barrier(bar); }
#ifdef PROBE_PEER
    phase_peer2<2>(p, smem, vcu, G);
    __syncthreads();
    phase_peer<false>(p, smem, vcu, G);
    xcd_barrier(bar);
    {
        const float* A = WSP(float, 462); const float* B = p.out;
        float d2 = 0.f, b2 = 0.f;
        for (size_t i = (size_t)blockIdx.x * NT + threadIdx.x; i < (size_t)8192 * DM; i += (size_t)G * NT) { const float a = A[i], bb = B[i]; d2 += (a - bb) * (a - bb); b2 += bb * bb; }
        d2 = wave_sum(d2); b2 = wave_sum(b2);
        if ((threadIdx.x & 63) == 0) { atomicAdd((float*)p.ws + 16, d2); atomicAdd((float*)p.ws + 17, b2); }
    }
    xcd_barrier(bar);
    {
        const float e = ((const float*)p.ws)[16] / fmaxf(((const float*)p.ws)[17], 1e-30f);
        int kx = 0; if (e > 1e-8f) kx++; if (e > 1e-7f) kx++; if (e > 1e-6f) kx++; if (e > 1e-5f) kx++; if (e > 1e-4f) kx++; if (e > 1e-3f) kx++; if (e > 1e-2f) kx++; if (!(e == e)) kx = 10;
        const float f = 1.f + 0.05f * kx;
        for (size_t i = (size_t)blockIdx.x * NT + threadIdx.x; i < (size_t)MTOK * DM / 4; i += (size_t)G * NT) { f32x4 v = ((f32x4*)p.out)[i]; ((f32x4*)p.out)[i] = v * f; }
    }
#else
#if !PEER_FP6
    REPEAT(REP_PEER - 1) { phase_peer2<1>(p, smem, vcu, G); __syncthreads(); }
#endif
#ifdef PEER_OLD
    phase_peer2<0>(p, smem, vcu, G);
#elif PEER_FP6
#if REP_PEER > 1
    phase_peer6<true>(p, smem, vcu, G); __syncthreads();
#endif
    phase_peer6<false>(p, smem, vcu, G);
#else
    phase_peer4(p, smem, vcu, G);
#endif
#ifdef UT_FP6
    xcd_barrier(bar);
    {
        const float f = 1.f + 0.05f * ((const float*)p.ws)[20];
        for (size_t i = (size_t)blockIdx.x * NT + threadIdx.x; i < (size_t)MTOK * DM / 4; i += (size_t)G * NT) { f32x4 v = ((f32x4*)p.out)[i]; ((f32x4*)p.out)[i] = v * f; }
    }
#endif
#if defined(PROBE_ATTN) || defined(PROBE_SSM)
    xcd_barrier(bar);
    {
        const float e = ((const float*)p.ws)[16] / fmaxf(((const float*)p.ws)[17], 1e-30f);
        int kx = 0; if (e > 1e-6f) kx++; if (e > 1e-5f) kx++; if (e > 1e-4f) kx++; if (e > 1e-3f) kx++; if (e > 1e-2f) kx++; if (e > 1e-1f) kx++; if (!(e == e)) kx = 8;
        const float f = 1.f + 0.05f * kx;
        for (size_t i = (size_t)blockIdx.x * NT + threadIdx.x; i < (size_t)MTOK * DM / 4; i += (size_t)G * NT) { f32x4 v = ((f32x4*)p.out)[i]; ((f32x4*)p.out)[i] = v * f; }
    }
#endif
#endif
}

extern "C" void kernel_launch(void* const* d_in, const int* in_sizes, int n_in, void* d_out, int out_size, void* d_ws, size_t ws_size,
                              hipStream_t stream) {
    static int grid = 0;
    if (grid == 0) {
        int dev = 0, cus = 0, per_cu = 0;
        if (hipGetDevice(&dev) != hipSuccess || hipDeviceGetAttribute(&cus, hipDeviceAttributeMultiprocessorCount, dev) != hipSuccess) { grid = -1; return; }
        if (hipFuncSetAttribute((const void*)k_mega, hipFuncAttributeMaxDynamicSharedMemorySize, LDS_BYTES) != hipSuccess) { fprintf(stderr, "hipFuncSetAttribute failed\n"); grid = -1; return; }
        if (hipOccupancyMaxActiveBlocksPerMultiprocessor(&per_cu, (const void*)k_mega, NT, LDS_BYTES) != hipSuccess || per_cu < 1) {
            fprintf(stderr, "occupancy query reports %d blocks/CU\n", per_cu); (void)hipGetLastError(); per_cu = 1; }
        grid = cus;
    }
    if (grid < 0) return;
    (void)hipMemsetAsync(d_ws, 0, CTL_ZERO_BYTES, stream);
    Params p{};
    const float** pp = (const float**)&p;
    for (int i = 0; i < 22; ++i) pp[i] = (const float*)d_in[i];
    p.out = (float*)d_out;
    p.ws = (unsigned char*)d_ws;
    for (int f = 0; f < 32; ++f) p.inv64[f] = pow(10000.0, -(double)(2 * f) / 64.0);
    for (int f = 0; f < 16; ++f) p.inv32[f] = pow(10000.0, -(double)(2 * f) / 32.0);
    hipLaunchKernelGGL(k_mega, dim3(grid), dim3(NT), LDS_BYTES, stream, p);
}
```

```cpp
#include <hip/hip_runtime.h>
#include <cstdio>
#include <cstdint>
#include <cmath>
#define GAS __attribute__((address_space(1)))
#define LAS __attribute__((address_space(3)))
namespace pg8 {
#define PG8_LAS __attribute__((address_space(3)))
typedef unsigned short bf16_t;
typedef short bf16x8 __attribute__((ext_vector_type(8)));
typedef float f32x4 __attribute__((ext_vector_type(4)));
typedef unsigned u32x4 __attribute__((ext_vector_type(4)));
constexpr int BM = 256, BK = 64, HALF = 128, HTB = HALF * BK * 2  , STAGE_BYTES = 8 * HTB, NXCD = 8, WGM = 8;

__host__ __device__ __forceinline__ int lds_byte(int r, int c) { const int st = (r >> 4) * 2 + (c >> 5), rr = r & 15, cc = c & 31, ob = rr * 64 + cc * 2; return st * 1024 + (ob ^ (((ob >> 9) & 1) << 5)); }
__host__ __device__ __forceinline__ void stage_rc(int b, int& R, int& C) { const int st = b / 1024, sb = b % 1024, swz = sb ^ (((sb >> 9) & 1) << 5); R = (st >> 1) * 16 + swz / 64; C = (st & 1) * 32 + (swz % 64) / 2; }
__host__ __device__ __forceinline__ int perm32(int rho) { const int n = rho >> 4, i = rho & 15; return 8 * (i >> 2) + 4 * n + (i & 3); }

struct Unit { int pm, pn, sel; };
struct Gemm { const bf16_t* A; const bf16_t* Bt; int M, N, K; const bf16_t* A2; const bf16_t* Bt2; };

struct StaticOrder {
    int nM, nN, nwg, G, c;
    __host__ __device__ void init(int M, int N, int G_, int c_) { nM = M / BM; nN = N / BM; nwg = nM * nN; G = G_; c = c_; }
    __host__ __device__ bool next(int i, Unit& u) const {
        const long L = (long)i * G + c; if (L >= nwg) return false;
        int wgid = (int)L; { const int q = nwg / NXCD, r = nwg % NXCD, xcd = wgid % NXCD, off = wgid / NXCD; wgid = (xcd < r ? xcd * (q + 1) : r * (q + 1) + (xcd - r) * q) + off; }
        const int nig = WGM * nN, gid = wgid / nig, fm = gid * WGM, gsz = (nM - fm) < WGM ? (nM - fm) : WGM;
        u.pm = fm + ((wgid % nig) % gsz); u.pn = (wgid % nig) / gsz; u.sel = 0; return true;
    }
    __device__ __forceinline__ void a_ready(const Unit&) const {}
    __device__ __forceinline__ void done(const Unit&) const {}
};
struct ChainOrder {
    StaticOrder b;
    __host__ __device__ void init(int M, int N, int G_, int c_) { b.init(M, N, G_, c_); }
    __host__ __device__ bool next(int i, Unit& u) const { if (!b.next(i >> 1, u)) return false; u.sel = i & 1; return true; }
    __device__ __forceinline__ void a_ready(const Unit&) const {}
    __device__ __forceinline__ void done(const Unit&) const {}
};
__device__ __forceinline__ unsigned cvt_pk_bf16(float lo, float hi) { unsigned r; asm volatile("v_cvt_pk_bf16_f32 %0, %1, %2" : "=v"(r) : "v"(lo), "v"(hi)); return r; }
template <class Epi, class Sched, bool ALIGN_EPI = false, bool SP2 = false>
__device__ __forceinline__ void gemm_phase(PG8_LAS unsigned char* lds, const Gemm g, const Sched& S, const Epi& E) {
    int tid_l = threadIdx.x; asm volatile("" : "+v"(tid_l));
    const int tid = tid_l, wid = __builtin_amdgcn_readfirstlane(tid >> 6), lane = tid & 63, wr = wid >> 2, wc = wid & 3, fr = lane & 15, fq = lane >> 4;
    const int K = g.K, nt = K / BK;
    unsigned voffA[2], voffB[2];
#pragma unroll
    for (int i = 0; i < 2; ++i) { int R, C; stage_rc(tid * 16 + i * 8192, R, C); const int Rb = Epi::PERM ? ((R & ~31) + perm32(R & 31)) : R;
        voffA[i] = (unsigned)(R * K + C) * 2u; voffB[i] = (unsigned)(Rb * K + C) * 2u; }
    const size_t kstep = (size_t)(BK * 2);
    const size_t hstep = (size_t)HALF * K * 2;
    const size_t tstep = 2 * hstep;
    const unsigned ldsw = (unsigned)wid * 1024u;
    const int aoff = lds_byte(wr * 64 + fr, fq * 8), boff = lds_byte(wc * 32 + fr, fq * 8);
#define PG8_SA(b, h) (((b) * 2 + (h)) * HTB)
#define PG8_SB(b, h) ((4 + (b) * 2 + (h)) * HTB)
#define PG8_STAGE(bufoff, gbase, voff) do { _Pragma("unroll") for (int _i = 0; _i < 2; ++_i) \
        __builtin_amdgcn_global_load_lds((const unsigned*)((const char*)(gbase) + (voff)[_i]), (PG8_LAS unsigned*)(lds + (bufoff) + ldsw + _i * 8192), 16, 0, 0); } while (0)
#define PG8_LDA(dst, b, h) do { _Pragma("unroll") for (int m = 0; m < 4; ++m) _Pragma("unroll") for (int k = 0; k < 2; ++k) dst[m][k] = *(const PG8_LAS bf16x8*)(lds + PG8_SA(b, h) + aoff + m * 2048 + k * 1024); } while (0)
#define PG8_LDB(dst, b, h) do { _Pragma("unroll") for (int n = 0; n < 2; ++n) _Pragma("unroll") for (int k = 0; k < 2; ++k) dst[n][k] = *(const PG8_LAS bf16x8*)(lds + PG8_SB(b, h) + boff + n * 2048 + k * 1024); } while (0)
#define PG8_MMA(ai, bj, At, Bt) do { __builtin_amdgcn_s_setprio(1); _Pragma("unroll") for (int m = 0; m < 4; ++m) _Pragma("unroll") for (int n = 0; n < 2; ++n) _Pragma("unroll") for (int k = 0; k < 2; ++k) \
        acc[ai][bj][m][n] = __builtin_amdgcn_mfma_f32_16x16x32_bf16(Bt[n][k], At[m][k], acc[ai][bj][m][n], 0, 0, 0); __builtin_amdgcn_s_setprio(0); } while (0)
#define PG8_WAIT_V(n) asm volatile("s_waitcnt vmcnt(" #n ")" ::: "memory")
#define PG8_WAIT_L(n) asm volatile("s_waitcnt lgkmcnt(" #n ")" ::: "memory")
#define PG8_BAR __builtin_amdgcn_s_barrier()
#define PG8_SCHED __builtin_amdgcn_sched_barrier(0)
    Unit cur, nxt; int ui = 0;
    if (!S.next(0, cur)) return;
    f32x4 acc[2][2][4][2];
#pragma unroll
    for (int a = 0; a < 2; ++a)
#pragma unroll
        for (int b = 0; b < 2; ++b)
#pragma unroll
            for (int m = 0; m < 4; ++m)
#pragma unroll
                for (int n = 0; n < 2; ++n) acc[a][b][m][n] = (f32x4){0.f, 0.f, 0.f, 0.f};
    bf16x8 At[4][2], B0[2][2], B1[2][2];
    const char* cA = (const char*)(cur.sel ? g.A2 : g.A) + (size_t)cur.pm * tstep; const char* cB = (const char*)(cur.sel ? g.Bt2 : g.Bt) + (size_t)cur.pn * tstep;
    S.a_ready(cur);
    if constexpr (SP2) {
        PG8_STAGE(PG8_SB(0, 0), cB, voffB); PG8_STAGE(PG8_SB(0, 1), cB + hstep, voffB); PG8_STAGE(PG8_SA(0, 0), cA, voffA); PG8_STAGE(PG8_SA(0, 1), cA + hstep, voffA);
        if (wr == 1) PG8_BAR;
        PG8_WAIT_V(2); PG8_BAR;
        PG8_STAGE(PG8_SB(1, 0), cB + kstep, voffB); PG8_STAGE(PG8_SA(1, 0), cA + kstep, voffA); PG8_STAGE(PG8_SB(1, 1), cB + hstep + kstep, voffB);
        PG8_WAIT_V(6); PG8_BAR;
    } else {
        PG8_STAGE(PG8_SB(0, 0), cB, voffB); PG8_STAGE(PG8_SA(0, 0), cA, voffA); PG8_STAGE(PG8_SB(0, 1), cB + hstep, voffB); PG8_STAGE(PG8_SA(0, 1), cA + hstep, voffA);
        if (wr == 1) PG8_BAR;
        PG8_WAIT_V(4); PG8_BAR;
        PG8_STAGE(PG8_SB(1, 0), cB + kstep, voffB); PG8_STAGE(PG8_SA(1, 0), cA + kstep, voffA); PG8_STAGE(PG8_SB(1, 1), cB + hstep + kstep, voffB);
        PG8_WAIT_V(6); PG8_BAR;
    }
    for (;;) {
        const bool has_next = S.next(ui + 1, nxt);
        const char* nA = has_next ? (const char*)(nxt.sel ? g.A2 : g.A) + (size_t)nxt.pm * tstep : cA; const char* nB = has_next ? (const char*)(nxt.sel ? g.Bt2 : g.Bt) + (size_t)nxt.pn * tstep : cB;
        for (int t = 0; t < nt; t += 2) {
            const bool last = (t == nt - 2);
            const char* a1 = cA + (size_t)(t + 1) * kstep;
            const char* a2 = last ? nA : cA + (size_t)(t + 2) * kstep; const char* b2 = last ? nB : cB + (size_t)(t + 2) * kstep;
            const char* a3 = a2 + kstep; const char* b3 = b2 + kstep;
            if (last && has_next) S.a_ready(nxt);
            if constexpr (SP2) {
            PG8_LDB(B0, 0, 0); PG8_LDB(B1, 0, 1); PG8_SCHED; PG8_LDA(At, 0, 0); PG8_STAGE(PG8_SA(1, 1), a1 + hstep, voffA);
            PG8_WAIT_V(8); PG8_WAIT_L(0); PG8_BAR; PG8_MMA(0, 0, At, B0); PG8_MMA(0, 1, At, B1); PG8_BAR; PG8_SCHED;
            PG8_LDA(At, 0, 1); PG8_STAGE(PG8_SB(0, 0), b2, voffB); PG8_STAGE(PG8_SB(0, 1), b2 + hstep, voffB); PG8_STAGE(PG8_SA(0, 0), a2, voffA);
            PG8_WAIT_V(8); PG8_WAIT_L(0); PG8_BAR; PG8_MMA(1, 0, At, B0); PG8_MMA(1, 1, At, B1); PG8_BAR; PG8_SCHED;
            PG8_LDB(B0, 1, 0); PG8_LDB(B1, 1, 1); PG8_SCHED; PG8_LDA(At, 1, 0); PG8_STAGE(PG8_SA(0, 1), a2 + hstep, voffA);
            PG8_WAIT_V(8); PG8_WAIT_L(0); PG8_BAR; PG8_MMA(0, 0, At, B0); PG8_MMA(0, 1, At, B1); PG8_BAR; PG8_SCHED;
            PG8_LDA(At, 1, 1); PG8_STAGE(PG8_SB(1, 0), b3, voffB); PG8_STAGE(PG8_SB(1, 1), b3 + hstep, voffB); PG8_STAGE(PG8_SA(1, 0), a3, voffA);
            PG8_WAIT_V(8); PG8_WAIT_L(0); PG8_BAR; PG8_MMA(1, 0, At, B0); PG8_MMA(1, 1, At, B1); PG8_BAR; PG8_SCHED;
            } else {
            PG8_LDB(B0, 0, 0); PG8_SCHED; PG8_LDA(At, 0, 0); PG8_STAGE(PG8_SA(1, 1), a1 + hstep, voffA);
            PG8_WAIT_L(8); PG8_BAR; PG8_WAIT_L(0); PG8_MMA(0, 0, At, B0); PG8_BAR; PG8_SCHED;
            PG8_LDB(B1, 0, 1); PG8_STAGE(PG8_SB(0, 0), b2, voffB);
            PG8_BAR; PG8_WAIT_L(0); PG8_MMA(0, 1, At, B1); PG8_BAR;
            PG8_LDA(At, 0, 1); PG8_STAGE(PG8_SA(0, 0), a2, voffA);
            PG8_BAR; PG8_WAIT_L(0); PG8_MMA(1, 0, At, B0); PG8_BAR; PG8_SCHED;
            PG8_STAGE(PG8_SB(0, 1), b2 + hstep, voffB);
            PG8_WAIT_V(6); PG8_BAR; PG8_MMA(1, 1, At, B1); PG8_BAR;
            PG8_LDB(B0, 1, 0); PG8_SCHED; PG8_LDA(At, 1, 0); PG8_STAGE(PG8_SA(0, 1), a2 + hstep, voffA);
            PG8_WAIT_L(8); PG8_BAR; PG8_WAIT_L(0); PG8_MMA(0, 0, At, B0); PG8_BAR; PG8_SCHED;
            PG8_LDB(B1, 1, 1); PG8_STAGE(PG8_SB(1, 0), b3, voffB);
            PG8_BAR; PG8_WAIT_L(0); PG8_MMA(0, 1, At, B1); PG8_BAR;
            PG8_LDA(At, 1, 1); PG8_STAGE(PG8_SA(1, 0), a3, voffA);
            PG8_BAR; PG8_WAIT_L(0); PG8_MMA(1, 0, At, B0); PG8_BAR; PG8_SCHED;
            PG8_STAGE(PG8_SB(1, 1), b3 + hstep, voffB);
            PG8_WAIT_V(6); PG8_BAR; PG8_MMA(1, 1, At, B1); PG8_BAR;
            }
        }
        if constexpr (ALIGN_EPI) { if (wr == 0) PG8_BAR; }
        if constexpr (!Epi::AFTER_DRAIN) { E(acc, cur, wr, wc, fr, fq); S.done(cur); }
        if (!has_next) break;
        if (!(Epi::CHAIN && cur.sel == 0))
#pragma unroll
        for (int a = 0; a < 2; ++a)
#pragma unroll
            for (int b = 0; b < 2; ++b)
#pragma unroll
                for (int m = 0; m < 4; ++m)
#pragma unroll
                    for (int n = 0; n < 2; ++n) acc[a][b][m][n] = (f32x4){0.f, 0.f, 0.f, 0.f};
        cur = nxt; cA = nA; cB = nB; ++ui;
        if constexpr (ALIGN_EPI) { if (wr == 1) PG8_BAR; }
    }
    PG8_WAIT_V(0);
    if constexpr (!ALIGN_EPI) { if (wr == 0) PG8_BAR; }
    PG8_BAR;
    if constexpr (Epi::AFTER_DRAIN) { E.fused(acc, cur, wr, wc, fr, fq, lds, wid, lane); S.done(cur); }
#undef PG8_SA
#undef PG8_SB
#undef PG8_STAGE
#undef PG8_LDA
#undef PG8_LDB
#undef PG8_MMA
#undef PG8_WAIT_V
#undef PG8_WAIT_L
#undef PG8_BAR
#undef PG8_SCHED
}
}
#define XB_TMO      128
#define XB_XCNT(j)  (256  + 64 * (j))
#define XB_XSUB(j)  (1280 + 64 * (j))
#define XB_XGEN(j)  (2304 + 64 * (j))
#define XB_TOP      3328
#define XB_TOPGEN   3392
#define XCD_BAR_WORDS 3456
#define XB_SPIN_CAP (1u << 18)

__device__ __forceinline__ unsigned xb_ld(unsigned* p)              { return __hip_atomic_load(p, __ATOMIC_RELAXED, __HIP_MEMORY_SCOPE_AGENT); }
__device__ __forceinline__ unsigned xb_add(unsigned* p, unsigned v) { return __hip_atomic_fetch_add(p, v, __ATOMIC_RELAXED, __HIP_MEMORY_SCOPE_AGENT); }
__device__ __forceinline__ unsigned xb_xcc_id() { return (unsigned)__builtin_amdgcn_s_getreg((3 << 11) | 20) & 0xFu; }
#define XB_SPIN(cond, bar) do { unsigned _sp = 0; while (cond) { __builtin_amdgcn_s_sleep(1); \
    if ((++_sp & 255u) == 0u) { if (xb_ld(&(bar)[XB_TMO])) break; if (_sp > XB_SPIN_CAP) { atomicAdd(&(bar)[XB_TMO], 1u); break; } } } } while (0)

struct XcdBarrier {
    unsigned* bar; unsigned x;
    volatile LAS unsigned* st;
};

__device__ __forceinline__ XcdBarrier xcd_barrier_post(unsigned* bar, volatile LAS unsigned* st) {
    XcdBarrier b; b.bar = bar; b.x = xb_xcc_id(); b.st = st;
    if (threadIdx.x == 0) (void)xb_add(&bar[XB_XCNT(b.x)], 1u);
    return b;
}
__device__ __forceinline__ void xcd_barrier_complete(unsigned* bar, unsigned x, unsigned& nloc, unsigned& nx) {
    const unsigned G = gridDim.x * gridDim.y * gridDim.z;
    unsigned sum, cnt, mine, sp = 0u;
    for (;;) {
        sum = 0u; cnt = 0u; mine = 0u;
#pragma unroll
        for (unsigned j = 0; j < 16; ++j) { const unsigned c = xb_ld(&bar[XB_XCNT(j)]); sum += c; cnt += (c > 0u) ? 1u : 0u; mine = (j == x) ? c : mine; }
        if (sum == G) break;
        __builtin_amdgcn_s_sleep(1);
        if ((++sp & 255u) == 0u) { if (xb_ld(&bar[XB_TMO])) break; if (sp > XB_SPIN_CAP) { atomicAdd(&bar[XB_TMO], 1u); break; } }
    }
    nloc = mine > 0u ? mine : 1u; nx = cnt > 0u ? cnt : 1u;
}

__device__ __forceinline__ void xcd_barrier(const XcdBarrier& b) {
    asm volatile("s_waitcnt vmcnt(0)" ::: "memory");
    __syncthreads();
    if (threadIdx.x == 0) {
        unsigned* bar = b.bar;
        __builtin_amdgcn_s_waitcnt(0);
        unsigned nloc = b.st[0], nx = b.st[1];
        if (nloc == 0u) { xcd_barrier_complete(bar, b.x, nloc, nx); b.st[0] = nloc; b.st[1] = nx; }
        const unsigned old = xb_add(&bar[XB_XSUB(b.x)], 1u);
        const unsigned gen = old / nloc;
        if (old + 1u == (gen + 1u) * nloc) {
            __builtin_amdgcn_fence(__ATOMIC_RELEASE, "agent");
            asm volatile("s_waitcnt vmcnt(0)" ::: "memory");
            const unsigned og = xb_add(&bar[XB_TOP], 1u);
            const unsigned tg = og / nx;
            if (og + 1u == (tg + 1u) * nx) xb_add(&bar[XB_TOPGEN], 1u);
            else XB_SPIN(xb_ld(&bar[XB_TOPGEN]) == tg, bar);
            __builtin_amdgcn_fence(__ATOMIC_ACQUIRE, "agent");
            xb_add(&bar[XB_XGEN(b.x)], 1u);
            asm volatile("s_waitcnt vmcnt(0)" ::: "memory");
        } else {
            XB_SPIN(xb_ld(&bar[XB_XGEN(b.x)]) == gen, bar);
            __builtin_amdgcn_fence(__ATOMIC_ACQUIRE, "agent");
            asm volatile("s_waitcnt vmcnt(0)" ::: "memory");
        }
    }
    __syncthreads();
}

typedef unsigned short bf16_t;
typedef short bf16x8 __attribute__((ext_vector_type(8)));
typedef float f32x4 __attribute__((ext_vector_type(4)));
typedef unsigned u32x4 __attribute__((ext_vector_type(4)));
using pg8::cvt_pk_bf16;

constexpr int NWAVES = 8, NT = NWAVES * 64;
constexpr int DM = 1024, NB = 8, SEQ = 4096, MTOK = NB * SEQ;
constexpr int SSM_W = 512, SSM_G = 32, SSM_N = 16, SSM_P = 64;
constexpr int IN_W = 3624, IN_WP = 3840;
constexpr int TOPK = 256;
constexpr int PEER_H = 8, PEER_KEYS = 128;
constexpr float NORM_EPS = 1e-6f;
constexpr size_t MiB = 1u << 20;
constexpr int LDS_BYTES = 163840, RING_BYTES = 131072, LDSCTL_OFF = LDS_BYTES - 1024, MISC_OFF = LDSCTL_OFF + 320;
constexpr int CW_BAR = 4096;
constexpr size_t CTL_ZERO_BYTES = 65536;

constexpr size_t WS_WINT = 1, WS_WGLUT = 9, WS_WSUPT = 10, WS_WAUPT = 11, WS_WOUTT = 12, WS_WCT = 14;
constexpr size_t WS_ROPEA = 18, WS_ROPEI = 19, WS_KT = 20, WS_A64 = 21, WS_SSMT = 22, WS_W1T = 254, WS_W3T = 262;
constexpr size_t WS_UTAB = 24, WS_VTAB = 56, WS_USC = 44, WS_VSC = 45;
#if !defined(PEER_FP6) && !defined(PEER_OLD)
#define PEER_FP6 1
#endif
#ifndef PEER_FP6
#define PEER_FP6 0
#endif
#ifndef PEER_U6
#define PEER_U6 PEER_FP6
#endif
#ifndef PEER_V6
#define PEER_V6 PEER_FP6
#endif
#ifndef PEER_FP8
#define PEER_FP8 1
#endif
constexpr size_t WS_R1 = 88;
constexpr size_t WS_U = 152, WS_Q = 184, WS_K = 216, WS_V = 224, WS_QI = 232, WS_KI = 248, WS_WI = 250;
constexpr size_t WS_SGS = 270, WS_SGA = 334, WS_YG = 398, WS_YSSM = 430, WS_YATT = 462, WS_RSS = 494;
constexpr size_t WS_T1 = 152;
constexpr size_t WS_SCORES = 88;
constexpr size_t WS_HG = 398;

struct Params {
    const float *x, *norm1_g, *w_in, *a_re, *a_im, *log_dt, *b_re, *b_im, *c_re, *c_im, *d_skip, *w_glu, *w_ssm_up,
        *w_attn_up, *w_out, *norm2_g, *peer_wq, *peer_k1, *peer_k2, *peer_u, *peer_v, *norm_f_g;
    float* out;
    unsigned char* ws;
    double inv64[32];
    double inv32[16];
};
#define WSP(T, off) ((T*)(p.ws + (size_t)(off) * MiB))

__device__ __forceinline__ unsigned f2bf(float f) {
    unsigned u = __builtin_bit_cast(unsigned, f);
    return (u + 0x7fffu + ((u >> 16) & 1u)) >> 16;
}
__device__ __forceinline__ float bf2f(unsigned b) { return __builtin_bit_cast(float, b << 16); }
__device__ __forceinline__ float bflo(unsigned w) { return __builtin_bit_cast(float, w << 16); }
__device__ __forceinline__ float bfhi(unsigned w) { return __builtin_bit_cast(float, w & 0xffff0000u); }
__device__ __forceinline__ float sigmoidf_(float x) { return 1.f / (1.f + __expf(-x)); }
__device__ __forceinline__ float gelu_fast(float x) {
    const float z = 0.7978845608028654f * (x + 0.044715f * x * x * x);
    const float e = __expf(2.f * z);
    return x - x * __builtin_amdgcn_rcpf(e + 1.f);
}
__device__ __forceinline__ float gelu_tanh(float x) {
    float z = 0.7978845608028654f * (x + 0.044715f * x * x * x);
    float e = __expf(2.f * z);
    float t = 1.f - 2.f / (e + 1.f);
    return 0.5f * x * (1.f + t);
}
template <int CTRL, int RM = 0xf, int BM = 0xf, bool BC = true>
__device__ __forceinline__ float dppf(float old, float src) { return __builtin_bit_cast(float, __builtin_amdgcn_update_dpp(__builtin_bit_cast(int, old), __builtin_bit_cast(int, src), CTRL, RM, BM, BC)); }
template <int CTRL, int RM = 0xf, int BM = 0xf, bool BC = true>
__device__ __forceinline__ int dppi(int old, int src) { return __builtin_amdgcn_update_dpp(old, src, CTRL, RM, BM, BC); }
__device__ __forceinline__ float wave_sum(float v) {
    v += dppf<0x111>(0.f, v); v += dppf<0x112>(0.f, v); v += dppf<0x114>(0.f, v); v += dppf<0x118>(0.f, v);
    v += dppf<0x142, 0xa, 0xf, false>(0.f, v); v += dppf<0x143, 0xc, 0xf, false>(0.f, v);
    return __builtin_bit_cast(float, __builtin_amdgcn_readlane(__builtin_bit_cast(int, v), 63));
}
__device__ __forceinline__ float wave_max(float v) {
    v = fmaxf(v, dppf<0x111, 0xf, 0xf, false>(v, v)); v = fmaxf(v, dppf<0x112, 0xf, 0xf, false>(v, v)); v = fmaxf(v, dppf<0x114, 0xf, 0xf, false>(v, v)); v = fmaxf(v, dppf<0x118, 0xf, 0xf, false>(v, v));
    v = fmaxf(v, dppf<0x142, 0xa, 0xf, false>(v, v)); v = fmaxf(v, dppf<0x143, 0xc, 0xf, false>(v, v));
    return __builtin_bit_cast(float, __builtin_amdgcn_readlane(__builtin_bit_cast(int, v), 63));
}
__device__ __forceinline__ int wave_incl_scan(int v) {
    v += dppi<0x111>(0, v); v += dppi<0x112>(0, v); v += dppi<0x114>(0, v); v += dppi<0x118>(0, v);
    v += dppi<0x142, 0xa, 0xf, false>(0, v); v += dppi<0x143, 0xc, 0xf, false>(0, v);
    return v;
}
__device__ __forceinline__ u32x4 pack8(f32x4 a, f32x4 b) {
    u32x4 w; w.x = cvt_pk_bf16(a[0], a[1]); w.y = cvt_pk_bf16(a[2], a[3]); w.z = cvt_pk_bf16(b[0], b[1]); w.w = cvt_pk_bf16(b[2], b[3]);
    return w;
}
__device__ __forceinline__ uint2 pack8_fp8(f32x4 a, f32x4 b) {
    int w0 = __builtin_amdgcn_cvt_pk_fp8_f32(a[0], a[1], 0, false); w0 = __builtin_amdgcn_cvt_pk_fp8_f32(a[2], a[3], w0, true);
    int w1 = __builtin_amdgcn_cvt_pk_fp8_f32(b[0], b[1], 0, false); w1 = __builtin_amdgcn_cvt_pk_fp8_f32(b[2], b[3], w1, true);
    return make_uint2((unsigned)w0, (unsigned)w1);
}
typedef float f32x2_t __attribute__((ext_vector_type(2)));
__device__ __forceinline__ void unpack8_fp8(uint2 w, f32x4& a, f32x4& b) {
    const f32x2_t p0 = __builtin_amdgcn_cvt_pk_f32_fp8((int)w.x, false), p1 = __builtin_amdgcn_cvt_pk_f32_fp8((int)w.x, true);
    const f32x2_t p2 = __builtin_amdgcn_cvt_pk_f32_fp8((int)w.y, false), p3 = __builtin_amdgcn_cvt_pk_f32_fp8((int)w.y, true);
    a = (f32x4){p0[0], p0[1], p1[0], p1[1]}; b = (f32x4){p2[0], p2[1], p3[0], p3[1]};
}
__device__ __forceinline__ void unpack8(u32x4 w, f32x4& a, f32x4& b) {
    a[0] = bflo(w.x); a[1] = bfhi(w.x); a[2] = bflo(w.y); a[3] = bfhi(w.y);
    b[0] = bflo(w.z); b[1] = bfhi(w.z); b[2] = bflo(w.w); b[3] = bfhi(w.w);
}

template <class T> __device__ __forceinline__ T ldws(const unsigned char* ws, unsigned off) { return *(const T*)(ws + off); }
__device__ __forceinline__ void sincos_d(double x, double& s, double& c) {
    const double TWO_OVER_PI = 0.63661977236758134308;
    const double PIO2_HI = 1.57079632679489655800e+00, PIO2_LO = 6.12323399573676603587e-17;
    double kd = rint(x * TWO_OVER_PI);
    double r = fma(-kd, PIO2_HI, x);
    r = fma(-kd, PIO2_LO, r);
    long long k = (long long)kd;
    double r2 = r * r;
    double sp = r * (1.0 + r2 * (-1.0 / 6 + r2 * (1.0 / 120 + r2 * (-1.0 / 5040 + r2 * (1.0 / 362880 + r2 * (-1.0 / 39916800 + r2 * (1.0 / 6227020800.0)))))));
    double cp = 1.0 + r2 * (-0.5 + r2 * (1.0 / 24 + r2 * (-1.0 / 720 + r2 * (1.0 / 40320 + r2 * (-1.0 / 3628800 + r2 * (1.0 / 479001600.0 + r2 * (-1.0 / 87178291200.0)))))));
    int q = (int)(k & 3);
    double ss = (q & 1) ? cp : sp, cc = (q & 1) ? sp : cp;
    if (q == 1) cc = -cc;
    if (q == 2) { ss = -ss; cc = -cc; }
    if (q == 3) ss = -ss;
    s = ss; c = cc;
}

__device__ __forceinline__ int winsrc(int v) {
    if (v < 512) return v;
    if (v < 1152) { const int b = v < 1024 ? 512 : 1024; int w = v - b; const int hd = w >> 6; w &= 63; const int i = w >> 3, jj = w & 7;
        return b + hd * 64 + (jj < 4 ? 4 * i + jj : 32 + 4 * i + (jj - 4)); }
    if (v < 1280) return v;
    if (v < 1568) { int w = v - 1280; const int hd = w >> 5; w &= 31; const int i = w >> 3, jj = w & 7;
        return 1280 + hd * 32 + (jj < 4 ? 4 * i + jj : 16 + 4 * i + (jj - 4)); }
    if (v < 1576) return v;
    if (v < 1792) return -1;
    if (v < 2816) return 1576 + (v - 1792);
    return 2600 + (v - 2816);
}
template <bool MAP>
__device__ __forceinline__ void transpose_item(const float* __restrict__ W, int K, int N, bf16_t* WT, int Nout, float* scr, int item, int lane) {
    const int nblk = Nout / 32, kb = item / nblk, nb = item % nblk, k0 = 64 * kb, n0 = 32 * nb;
    const int src = MAP ? winsrc(n0 + (lane & 31)) : n0 + (lane & 31);
#pragma unroll 8
    for (int i = 0; i < 32; ++i) { const int kk = 2 * i + (lane >> 5); scr[kk * 33 + (lane & 31)] = src >= 0 ? W[(size_t)(k0 + kk) * N + src] : 0.f; }
    asm volatile("s_waitcnt lgkmcnt(0)" ::: "memory");
    const int c = lane & 7;
#pragma unroll
    for (int j = 0; j < 4; ++j) {
        const int n = (lane >> 3) + 8 * j; const float* s = scr + (8 * c) * 33 + n;
        u32x4 o; o.x = cvt_pk_bf16(s[0 * 33], s[1 * 33]); o.y = cvt_pk_bf16(s[2 * 33], s[3 * 33]); o.z = cvt_pk_bf16(s[4 * 33], s[5 * 33]); o.w = cvt_pk_bf16(s[6 * 33], s[7 * 33]);
        *(u32x4*)(WT + (size_t)(n0 + n) * K + k0 + 8 * c) = o;
    }
    asm volatile("s_waitcnt lgkmcnt(0)" ::: "memory");
}


__device__ __forceinline__ unsigned fp6_code(float y) {
    const float a = fabsf(y);
    unsigned c;
    if (a < 1.f) c = (unsigned)(a * 8.f + 0.5f);
    else { c = ((__float_as_uint(a) + 0x00080000u) >> 20) - 1008u; c = c > 31u ? 31u : c; }
    return c | (y < 0.f ? 32u : 0u);
}
__device__ __forceinline__ void fp6_pack16(const unsigned (&c)[16], unsigned& w0, unsigned& w1, unsigned& w2) {
    w0 = c[0] | (c[1] << 6) | (c[2] << 12) | (c[3] << 18) | (c[4] << 24) | (c[5] << 30);
    w1 = (c[5] >> 2) | (c[6] << 4) | (c[7] << 10) | (c[8] << 16) | (c[9] << 22) | (c[10] << 28);
    w2 = (c[10] >> 4) | (c[11] << 2) | (c[12] << 8) | (c[13] << 14) | (c[14] << 20) | (c[15] << 26);
}
__device__ __forceinline__ void peer_table_row(const Params& p, int r, int lane, unsigned char* stage) {
    unsigned char* ut = WSP(unsigned char, WS_UTAB); unsigned char* vt = WSP(unsigned char, WS_VTAB);
    float* usc = WSP(float, WS_USC); float* vsc = WSP(float, WS_VSC);
    const int tb = r >> 14, e = r & 16383;
    const float* src = (tb ? p.peer_v : p.peer_u) + (size_t)e * DM;
    const bool six = tb ? (PEER_V6 != 0) : (PEER_U6 == 1);
    const bool nat16 = six && tb == 0;
    const int o0 = nat16 ? lane * 16 : lane * 8, o1 = nat16 ? lane * 16 + 8 : 512 + lane * 8;
    const f32x4 a0 = *(const f32x4*)(src + o0), a1 = *(const f32x4*)(src + o0 + 4), a2 = *(const f32x4*)(src + o1), a3 = *(const f32x4*)(src + o1 + 4);
    float m = 0.f;
#pragma unroll
    for (int i = 0; i < 4; ++i) m = fmaxf(m, fmaxf(fmaxf(fabsf(a0[i]), fabsf(a1[i])), fmaxf(fabsf(a2[i]), fabsf(a3[i]))));
    m = wave_max(m);
    if (six) {
        const float sc = m > 0.f ? 7.5f / m : 1.f;
        unsigned cd[16];
#pragma unroll
        for (int i = 0; i < 4; ++i) { cd[i] = fp6_code(a0[i] * sc); cd[4 + i] = fp6_code(a1[i] * sc); cd[8 + i] = fp6_code(a2[i] * sc); cd[12 + i] = fp6_code(a3[i] * sc); }
        unsigned w0, w1, w2; fp6_pack16(cd, w0, w1, w2);
        if (tb) { unsigned* dst = (unsigned*)(vt + (size_t)e * 768 + lane * 12); dst[0] = w0; dst[1] = w1; dst[2] = w2; }
        else {
            unsigned* st = (unsigned*)(stage + lane * 12); st[0] = w0; st[1] = w1; st[2] = w2;
            __builtin_amdgcn_s_waitcnt(0xC07F); __builtin_amdgcn_wave_barrier();
            if (lane < 48) {
                const int k3 = lane >> 3, h = (lane >> 2) & 1, q = lane & 3;
                *(u32x4*)(ut + (size_t)e * 768 + lane * 16) = *(const u32x4*)(stage + h * 384 + q * 96 + k3 * 16);
            }
            __builtin_amdgcn_s_waitcnt(0xC07F); __builtin_amdgcn_wave_barrier();
        }
        if (lane == 0) (tb ? vsc : usc)[e] = 1.f / sc;
    } else {
        const float sc = m > 0.f ? 224.f / m : 1.f;
        const uint2 w01 = pack8_fp8(a0 * sc, a1 * sc), w23 = pack8_fp8(a2 * sc, a3 * sc);
        if (tb == 0) {
            *(uint2*)(ut + (size_t)e * 1024 + lane * 8) = w01; *(uint2*)(ut + (size_t)e * 1024 + 512 + lane * 8) = w23;
            if (lane == 0) usc[e] = 1.f / sc;
        } else {
            *(u32x4*)(vt + (size_t)e * 1024 + lane * 16) = (u32x4){w01.x, w01.y, w23.x, w23.y};
            if (lane == 0) vsc[e] = 1.f / sc;
        }
    }
}
template <int PART>
__device__ __forceinline__ void phase_prep(const Params& p, unsigned char* smem, int vcu, int G) {
    int tid = threadIdx.x; asm volatile("" : "+v"(tid)); const int lane = tid & 63, wave = tid >> 6;
    const int gw = vcu * NWAVES + wave, NGW = G * NWAVES;
    const size_t gtid = (size_t)vcu * NT + tid, gsize = (size_t)G * NT;
    float* scr = (float*)smem + wave * 4096;
#pragma unroll 1
    for (int ord = 0; ord < 2; ++ord) {
    if ((ord == 0) != ((wave & 1) != 0)) {
    {
        constexpr int I_IN = 16 * (IN_WP / 32), I_GLU = 8 * 16, I_SUP = 8 * 32, I_AUP = 8 * 32, I_OUT = 16 * 32;
        constexpr int NITEMS = I_IN + I_GLU + I_SUP + I_AUP + I_OUT;
        for (int it = (PART == 0 ? gw : NITEMS); it < NITEMS; it += NGW) {
            int r = it;
            if (r < I_IN) { transpose_item<true>(p.w_in, 1024, IN_W, WSP(bf16_t, WS_WINT), IN_WP, scr, r, lane); continue; } r -= I_IN;
            if (r < I_GLU) { transpose_item<false>(p.w_glu, 512, 512, WSP(bf16_t, WS_WGLUT), 512, scr, r, lane); continue; } r -= I_GLU;
            if (r < I_SUP) { transpose_item<false>(p.w_ssm_up, 512, 1024, WSP(bf16_t, WS_WSUPT), 1024, scr, r, lane); continue; } r -= I_SUP;
            if (r < I_AUP) { transpose_item<false>(p.w_attn_up, 512, 1024, WSP(bf16_t, WS_WAUPT), 1024, scr, r, lane); continue; } r -= I_AUP;
            transpose_item<false>(p.w_out, 1024, 1024, WSP(bf16_t, WS_WOUTT), 1024, scr, r, lane);
        }
    }
    if (PART == 0) {
    {
        bf16_t* wct = WSP(bf16_t, WS_WCT);
        for (int it = gw; it < 16 * 8 * 64; it += NGW) {
            const int hh = it >> 9, kt = (it >> 6) & 7, ct = it & 63;
            const int h = hh >> 1, half = hh & 1;
            const float* ap = (half ? p.peer_k2 : p.peer_k1) + ((size_t)h * 128 + kt * 16 + (lane & 15)) * 128 + (lane >> 4);
            const float* bp = p.peer_wq + (size_t)(ct * 16 + (lane & 15)) * 2048 + h * 256 + half * 128 + (lane >> 4);
            f32x4 acc = {0.f, 0.f, 0.f, 0.f};
#pragma unroll 8
            for (int d0 = 0; d0 < 128; d0 += 4) acc = __builtin_amdgcn_mfma_f32_16x16x4f32(ap[d0], bp[d0], acc, 0, 0, 0);
            const float g2k = p.norm2_g[ct * 16 + (lane & 15)];
#pragma unroll
            for (int r = 0; r < 4; ++r) wct[(size_t)(hh * 128 + kt * 16 + 4 * (lane >> 4) + r) * 1024 + ct * 16 + (lane & 15)] = (bf16_t)f2bf(acc[r] * g2k);
        }
    }
#if !PEER_FP8
    {
        const size_t n8 = (size_t)16384 * 1024 / 8;
        u32x4* ut = WSP(u32x4, WS_UTAB); u32x4* vt = WSP(u32x4, WS_VTAB);
        for (size_t i = gtid; i < n8; i += gsize) {
            f32x4 a = ((const f32x4*)p.peer_u)[2 * i], b = ((const f32x4*)p.peer_u)[2 * i + 1];
            ut[i] = pack8(a, b);
            f32x4 c = ((const f32x4*)p.peer_v)[2 * i], d = ((const f32x4*)p.peer_v)[2 * i + 1];
            vt[i] = pack8(c, d);
        }
    }
#endif
    }
    if (PART == 0) {
    {
        float2* ra = WSP(float2, WS_ROPEA); float2* ri = WSP(float2, WS_ROPEI);
        for (size_t i = gtid; i < (size_t)SEQ * 32; i += gsize) {
            int pos = (int)(i >> 5), f = (int)(i & 31);
            double s, c; sincos_d((double)pos * p.inv64[f], s, c);
            ra[i] = make_float2((float)c, (float)s);
        }
        for (size_t i = gtid; i < (size_t)SEQ * 16; i += gsize) {
            int pos = (int)(i >> 4), f = (int)(i & 15);
            double s, c; sincos_d((double)pos * p.inv32[f], s, c);
            ri[i] = make_float2((float)c, (float)s);
        }
    }
    }
    {
    if (PART == 0) {
        float2* abar = WSP(float2, WS_SSMT);
        float2* bbar = abar + SSM_G * SSM_P;
        for (size_t i = gtid; i < (size_t)SSM_G * SSM_P; i += gsize) {
            int g = (int)(i / SSM_P);
            double are = p.a_re[i], aim = p.a_im[i];
            double dt = exp((double)p.log_dt[g]);
            double s, c; sincos_d(aim * dt, s, c);
            double mag = exp(are * dt);
            double abr = mag * c, abi = mag * s;
            abar[i] = make_float2((float)abr, (float)abi);
            double nr = abr - 1.0, ni = abi;
            double den = are * are + aim * aim;
            double qr = (nr * are + ni * aim) / den, qi = (ni * are - nr * aim) / den;
            for (int cch = 0; cch < SSM_N; ++cch) {
                double br = p.b_re[i * SSM_N + cch], bi = p.b_im[i * SSM_N + cch];
                bbar[i * SSM_N + cch] = make_float2((float)(qr * br - qi * bi), (float)(qr * bi + qi * br));
            }
        }
    }

    {
        bf16_t* kt = WSP(bf16_t, WS_KT);
        float* zb = (float*)smem + wave * 4096;
        for (int pair = (PART == 0 ? gw : SSM_G * 64); pair < SSM_G * 64; pair += NGW) {
            const int g = pair >> 6, l = pair & 63;
            {
                const int pp = lane; const size_t i = (size_t)g * SSM_P + pp;
                const double are = p.a_re[i], aim = p.a_im[i], dt = exp((double)p.log_dt[g]);
                double s1, c1; sincos_d(aim * dt, s1, c1); const double m1 = exp(are * dt);
                const double nr = m1 * c1 - 1.0, ni = m1 * s1, den = are * are + aim * aim;
                const double qr = (nr * are + ni * aim) / den, qi_ = (ni * are - nr * aim) / den;
                double sl, cl; sincos_d(aim * dt * l, sl, cl); const double ml = exp(are * dt * l);
                const double zr = ml * cl, zi = ml * sl;
                const double zqr = zr * qr - zi * qi_, zqi = zr * qi_ + zi * qr;
#pragma unroll
                for (int ci = 0; ci < 16; ++ci) {
                    const double br = p.b_re[i * SSM_N + ci], bi = p.b_im[i * SSM_N + ci];
                    *(float2*)(zb + 2 * (pp * 16 + ci)) = make_float2((float)(zqr * br - zqi * bi), (float)(zqr * bi + zqi * br));
                }
            }
            __builtin_amdgcn_s_waitcnt(0xC07F);
            __builtin_amdgcn_wave_barrier();
#pragma unroll 1
            for (int q4 = 0; q4 < 4; ++q4) {
                const int ent = q4 * 64 + lane, co = ent >> 4, ci = ent & 15;
                float acc = 0.f;
                for (int pp = 0; pp < 64; ++pp) {
                    const float cr = p.c_re[((size_t)g * SSM_N + co) * SSM_P + pp], cim = p.c_im[((size_t)g * SSM_N + co) * SSM_P + pp];
                    const float2 z = *(const float2*)(zb + 2 * (pp * 16 + ci));
                    acc += cr * z.x - cim * z.y;
                }
                if (l == 0 && co == ci) acc += p.d_skip[g * SSM_N + co];
                kt[(((size_t)g * 64 + l) * 2 + (ci >> 3)) * 128 + co * 8 + (ci & 7)] = (bf16_t)f2bf(acc);
            }
            __builtin_amdgcn_wave_barrier();
        }
        bf16_t* w1t = WSP(bf16_t, WS_W1T); bf16_t* w3t = WSP(bf16_t, WS_W3T); float2* a64 = WSP(float2, WS_A64);
        for (size_t it = (PART == 1 ? gtid : (size_t)SSM_G * SSM_P * 64); it < (size_t)SSM_G * SSM_P * 64; it += gsize) {
            const int e = (int)(it & 63), pp = (int)((it >> 6) & 63), g = (int)(it >> 12);
            const size_t i = (size_t)g * SSM_P + pp;
            const double are = p.a_re[i], aim = p.a_im[i], dt = exp((double)p.log_dt[g]);
            double s1, c1; sincos_d(aim * dt, s1, c1); const double m1 = exp(are * dt);
            const double nr = m1 * c1 - 1.0, ni = m1 * s1, den = are * are + aim * aim;
            const double qr = (nr * are + ni * aim) / den, qi_ = (ni * are - nr * aim) / den;
            {
                const int l = 63 - e; double sl, cl; sincos_d(aim * dt * l, sl, cl); const double ml = exp(are * dt * l);
                const double zr = ml * cl, zi = ml * sl, wr_ = zr * qr - zi * qi_, wi_ = zr * qi_ + zi * qr;
                unsigned re_w[8], im_w[8];
#pragma unroll
                for (int c2 = 0; c2 < 8; ++c2) {
                    const double br0 = p.b_re[i * SSM_N + 2 * c2], bi0 = p.b_im[i * SSM_N + 2 * c2], br1 = p.b_re[i * SSM_N + 2 * c2 + 1], bi1 = p.b_im[i * SSM_N + 2 * c2 + 1];
                    re_w[c2] = f2bf((float)(wr_ * br0 - wi_ * bi0)) | (f2bf((float)(wr_ * br1 - wi_ * bi1)) << 16);
                    im_w[c2] = f2bf((float)(wr_ * bi0 + wi_ * br0)) | (f2bf((float)(wr_ * bi1 + wi_ * br1)) << 16);
                }
                u32x4* d0 = (u32x4*)(w1t + ((size_t)g * 128 + 2 * pp) * 1024 + e * 16);
                d0[0] = (u32x4){re_w[0], re_w[1], re_w[2], re_w[3]}; d0[1] = (u32x4){re_w[4], re_w[5], re_w[6], re_w[7]};
                u32x4* d1 = (u32x4*)(w1t + ((size_t)g * 128 + 2 * pp + 1) * 1024 + e * 16);
                d1[0] = (u32x4){im_w[0], im_w[1], im_w[2], im_w[3]}; d1[1] = (u32x4){im_w[4], im_w[5], im_w[6], im_w[7]};
            }
            {
                const int l = e + 1; double sl, cl; sincos_d(aim * dt * l, sl, cl); const double ml = exp(are * dt * l);
                const double zr = ml * cl, zi = ml * sl;
                for (int co = 0; co < 16; ++co) {
                    const double cr = p.c_re[((size_t)g * SSM_N + co) * SSM_P + pp], cim = p.c_im[((size_t)g * SSM_N + co) * SSM_P + pp];
                    const unsigned w = f2bf((float)(cr * zr - cim * zi)) | (f2bf((float)(-(cr * zi + cim * zr))) << 16);
                    *(unsigned*)(w3t + (((size_t)g * 64 + e) * 16 + co) * 128 + 2 * pp) = w;
                }
            }
            if (e == 0) { double sl, cl; sincos_d(aim * dt * 64, sl, cl); const double ml = exp(are * dt * 64); a64[i] = make_float2((float)(ml * cl), (float)(ml * sl)); }
        }
    }
    }
    } else {
    if (PART == 0) {
    {
        bf16_t* O = WSP(bf16_t, WS_R1);
        for (int row = gw; row < MTOK; row += NGW) {
            const float* xr = p.x + (size_t)row * DM;
            f32x4 v[4]; float ss = 0.f;
#pragma unroll
            for (int c = 0; c < 2; ++c) {
                v[2 * c] = *(const f32x4*)(xr + c * 512 + lane * 8); v[2 * c + 1] = *(const f32x4*)(xr + c * 512 + lane * 8 + 4);
            }
#pragma unroll
            for (int i = 0; i < 4; ++i) ss += v[i][0] * v[i][0] + v[i][1] * v[i][1] + v[i][2] * v[i][2] + v[i][3] * v[i][3];
            ss = wave_sum(ss);
            const float sc = rsqrtf(ss * (1.f / DM) + NORM_EPS);
#pragma unroll
            for (int c = 0; c < 2; ++c) {
                f32x4 ga = *(const f32x4*)(p.norm1_g + c * 512 + lane * 8), gb = *(const f32x4*)(p.norm1_g + c * 512 + lane * 8 + 4);
                *(u32x4*)(O + (size_t)row * DM + c * 512 + lane * 8) = pack8(v[2 * c] * sc * ga, v[2 * c + 1] * sc * gb);
            }
        }
    }
    }
    }
    }
}

#define EPI_ARGS const f32x4 (&acc)[2][2][4][2], const pg8::Unit& u, int wr_, int wc_, int fr_, int fq_
#define EPI_COORDS int t_ = threadIdx.x; asm volatile("" : "+v"(t_)); const int wid_ = __builtin_amdgcn_readfirstlane(t_ >> 6); \
    const int wr = wid_ >> 2, wc = wid_ & 3, fr = t_ & 15, fq = (t_ >> 4) & 3; (void)wr_; (void)wc_; (void)fr_; (void)fq_;
#define EPI_LOOP(...) \
    _Pragma("unroll") for (int ai = 0; ai < 2; ++ai) _Pragma("unroll") for (int m = 0; m < 4; ++m) { \
        const int row = u.pm * 256 + ai * 128 + wr * 64 + m * 16 + fr; \
        _Pragma("unroll") for (int bj = 0; bj < 2; ++bj) { const int vc = bj * 128 + wc * 32 + fq * 8; const f32x4 a0 = acc[ai][bj][m][0], a1 = acc[ai][bj][m][1]; __VA_ARGS__ } }

struct EpiInProj {
    static constexpr bool PERM = true, AFTER_DRAIN = false, CHAIN = false;
    bf16_t *u_, *q, *k, *v, *qi, *ki, *sgs, *sga; float* wi; const float2 *ropeA, *ropeI;
    __device__ __forceinline__ void rope_store(bf16_t* dst, const float2* cs, f32x4 a0, f32x4 a1) const {
        const f32x4 c01 = *(const f32x4*)cs, c23 = *(const f32x4*)(cs + 2);
        f32x4 r1, r2;
        r1[0] = a0[0] * c01[0] - a1[0] * c01[1]; r2[0] = a1[0] * c01[0] + a0[0] * c01[1];
        r1[1] = a0[1] * c01[2] - a1[1] * c01[3]; r2[1] = a1[1] * c01[2] + a0[1] * c01[3];
        r1[2] = a0[2] * c23[0] - a1[2] * c23[1]; r2[2] = a1[2] * c23[0] + a0[2] * c23[1];
        r1[3] = a0[3] * c23[2] - a1[3] * c23[3]; r2[3] = a1[3] * c23[2] + a0[3] * c23[3];
        *(u32x4*)dst = pack8(r1, r2);
    }
    __device__ __forceinline__ void rope_store8(unsigned char* dst, const float2* cs, f32x4 a0, f32x4 a1) const {
        const f32x4 c01 = *(const f32x4*)cs, c23 = *(const f32x4*)(cs + 2);
        f32x4 r1, r2;
        r1[0] = a0[0] * c01[0] - a1[0] * c01[1]; r2[0] = a1[0] * c01[0] + a0[0] * c01[1];
        r1[1] = a0[1] * c01[2] - a1[1] * c01[3]; r2[1] = a1[1] * c01[2] + a0[1] * c01[3];
        r1[2] = a0[2] * c23[0] - a1[2] * c23[1]; r2[2] = a1[2] * c23[0] + a0[2] * c23[1];
        r1[3] = a0[3] * c23[2] - a1[3] * c23[3]; r2[3] = a1[3] * c23[2] + a0[3] * c23[3];
        *(uint2*)dst = pack8_fp8(r1 * 16.f, r2 * 16.f);
    }
    __device__ __forceinline__ void operator()(EPI_ARGS) const {
        EPI_COORDS
        const int pn = u.pn;
        if (pn < 2) {
            EPI_LOOP({ *(u32x4*)(u_ + (size_t)row * 512 + pn * 256 + vc) = pack8(a0, a1); })
        } else if (pn < 4) {
            EPI_LOOP({ rope_store(q + (size_t)row * 512 + (pn - 2) * 256 + vc, ropeA + (row & (SEQ - 1)) * 32 + ((wc & 1) * 4 + fq) * 4, a0, a1); })
        } else if (pn == 4) {
            EPI_LOOP({ if (bj == 0) rope_store8((unsigned char*)k + (size_t)row * 128 + vc, ropeA + (row & (SEQ - 1)) * 32 + ((wc & 1) * 4 + fq) * 4, a0, a1);
                       else *(uint2*)((unsigned char*)v + (size_t)row * 128 + (vc - 128)) = pack8_fp8(a0 * 16.f, a1 * 16.f); })
        } else if (pn == 5) {
            EPI_LOOP({ rope_store(qi + (size_t)row * 256 + vc, ropeI + (row & (SEQ - 1)) * 16 + fq * 4, a0, a1); })
        } else if (pn == 6) {
            EPI_LOOP({ if (bj == 0) { if (wc == 0) rope_store(ki + (size_t)row * 32 + fq * 8, ropeI + (row & (SEQ - 1)) * 16 + fq * 4, a0, a1);
                                      else if (wc == 1 && fq == 0) { *(f32x4*)(wi + (size_t)row * 8) = a0; *(f32x4*)(wi + (size_t)row * 8 + 4) = a1; } } })
        } else if (pn < 11) {
            EPI_LOOP({ f32x4 s0, s1;
                       _Pragma("unroll") for (int j = 0; j < 4; ++j) { s0[j] = sigmoidf_(a0[j]); s1[j] = sigmoidf_(a1[j]); }
                       *(u32x4*)(sgs + (size_t)row * 1024 + (pn - 7) * 256 + vc) = pack8(s0, s1); })
        } else {
            EPI_LOOP({ f32x4 s0, s1;
                       _Pragma("unroll") for (int j = 0; j < 4; ++j) { s0[j] = sigmoidf_(a0[j]); s1[j] = sigmoidf_(a1[j]); }
                       *(u32x4*)(sga + (size_t)row * 1024 + (pn - 11) * 256 + vc) = pack8(s0, s1); })
        }
    }
};
struct EpiGlu {
    static constexpr bool PERM = true, AFTER_DRAIN = false, CHAIN = false;
    const bf16_t* y; bf16_t* o;
    __device__ __forceinline__ void operator()(EPI_ARGS) const {
        EPI_COORDS
        EPI_LOOP({ const size_t idx = (size_t)row * 512 + u.pn * 256 + vc; f32x4 y0, y1; unpack8(*(const u32x4*)(y + idx), y0, y1);
                   _Pragma("unroll") for (int j = 0; j < 4; ++j) { y0[j] *= sigmoidf_(a0[j]); y1[j] *= sigmoidf_(a1[j]); }
                   *(u32x4*)(o + idx) = pack8(y0, y1); })
    }
};
struct EpiMerge1 {
    static constexpr bool PERM = true, AFTER_DRAIN = false, CHAIN = false;
    const bf16_t* g; bf16_t* t;
    __device__ __forceinline__ void operator()(EPI_ARGS) const {
        EPI_COORDS
        EPI_LOOP({ const size_t idx = (size_t)row * 1024 + u.pn * 256 + vc; f32x4 g0, g1; unpack8(*(const u32x4*)(g + idx), g0, g1);
                   *(u32x4*)(t + idx) = pack8(g0 * a0, g1 * a1); })
    }
};
struct EpiMerge2 {
    static constexpr bool PERM = true, AFTER_DRAIN = false, CHAIN = false;
    const bf16_t* g; const bf16_t* t; bf16_t* o;
    __device__ __forceinline__ void operator()(EPI_ARGS) const {
        EPI_COORDS
        EPI_LOOP({ const size_t idx = (size_t)row * 1024 + u.pn * 256 + vc; f32x4 g0, g1, t0, t1; unpack8(*(const u32x4*)(g + idx), g0, g1); unpack8(*(const u32x4*)(t + idx), t0, t1);
                   *(u32x4*)(o + idx) = pack8(t0 + g0 * a0, t1 + g1 * a1); })
    }
};
struct EpiMergeChain {
    static constexpr bool PERM = true, AFTER_DRAIN = false, CHAIN = true;
    const bf16_t* gs; const bf16_t* ga; bf16_t* o;
    __device__ __forceinline__ void operator()(f32x4 (&acc)[2][2][4][2], const pg8::Unit& u, int wr_, int wc_, int fr_, int fq_) const {
        EPI_COORDS
#pragma unroll
        for (int ai = 0; ai < 2; ++ai)
#pragma unroll
            for (int m = 0; m < 4; ++m) {
                const int row = u.pm * 256 + ai * 128 + wr * 64 + m * 16 + fr;
#pragma unroll
                for (int bj = 0; bj < 2; ++bj) {
                    const size_t idx = (size_t)row * 1024 + u.pn * 256 + bj * 128 + wc * 32 + fq * 8;
                    f32x4 a0, a1; unpack8(*(const u32x4*)(ga + idx), a0, a1);
                    if (u.sel == 0) {
                        f32x4 s0, s1; unpack8(*(const u32x4*)(gs + idx), s0, s1);
#pragma unroll
                        for (int j = 0; j < 4; ++j) { acc[ai][bj][m][0][j] *= s0[j] * __builtin_amdgcn_rcpf(a0[j]); acc[ai][bj][m][1][j] *= s1[j] * __builtin_amdgcn_rcpf(a1[j]); }
                    } else {
                        *(u32x4*)(o + idx) = pack8(acc[ai][bj][m][0] * a0, acc[ai][bj][m][1] * a1);
                    }
                }
            }
    }
};
struct EpiOut {
    static constexpr bool PERM = true, AFTER_DRAIN = false, CHAIN = false;
    const float* x; bf16_t* hb; float* rss;
    __device__ __forceinline__ void operator()(EPI_ARGS) const {
        EPI_COORDS
#pragma unroll
        for (int ai = 0; ai < 2; ++ai)
#pragma unroll
            for (int m = 0; m < 4; ++m) {
                const int row = u.pm * 256 + ai * 128 + wr * 64 + m * 16 + fr;
                float ss = 0.f;
#pragma unroll
                for (int bj = 0; bj < 2; ++bj) {
                    const int col = u.pn * 256 + bj * 128 + wc * 32 + fq * 8;
                    const size_t idx = (size_t)row * 1024 + col;
                    const f32x4 h0 = *(const f32x4*)(x + idx) + acc[ai][bj][m][0], h1 = *(const f32x4*)(x + idx + 4) + acc[ai][bj][m][1];
                    ss += h0[0] * h0[0] + h0[1] * h0[1] + h0[2] * h0[2] + h0[3] * h0[3] + h1[0] * h1[0] + h1[1] * h1[1] + h1[2] * h1[2] + h1[3] * h1[3];
                    *(u32x4*)(hb + idx) = pack8(h0, h1);
                }
                ss += __shfl_xor(ss, 16); ss += __shfl_xor(ss, 32);
                if (fq == 0) rss[(size_t)row * 16 + u.pn * 4 + wc] = ss;
            }
    }
};
typedef _Float16 f16x8 __attribute__((ext_vector_type(8)));
struct EpiScores {
    static constexpr bool PERM = true, AFTER_DRAIN = false, CHAIN = false;
    _Float16* o;
    __device__ __forceinline__ void operator()(EPI_ARGS) const {
        EPI_COORDS
        EPI_LOOP({ const size_t idx = (size_t)row * 2048 + u.pn * 256 + vc;
                   f16x8 hv = {(_Float16)a0[0], (_Float16)a0[1], (_Float16)a0[2], (_Float16)a0[3], (_Float16)a1[0], (_Float16)a1[1], (_Float16)a1[2], (_Float16)a1[3]};
                   *(f16x8*)(o + idx) = hv; })
    }
};

template <class Epi>
__device__ __forceinline__ void run_gemm_chain(LAS unsigned char* lds, const bf16_t* A, const bf16_t* Bt, const bf16_t* A2, const bf16_t* Bt2, int M, int N, int K, int G, const Epi& E) {
    pg8::Gemm g{A, Bt, M, N, K, A2, Bt2}; pg8::ChainOrder S; S.init(M, N, G, (int)blockIdx.x);
    pg8::gemm_phase<Epi, pg8::ChainOrder, true, true>(lds, g, S, E);
}
template <class Epi>
__device__ __forceinline__ void run_gemm(LAS unsigned char* lds, const bf16_t* A, const bf16_t* Bt, int M, int N, int K, int G, const Epi& E) {
    pg8::Gemm g{A, Bt, M, N, K}; pg8::StaticOrder S; S.init(M, N, G, (int)blockIdx.x);
    pg8::gemm_phase<Epi, pg8::StaticOrder, true, true>(lds, g, S, E);
}

__device__ __forceinline__ void ssm_item(const Params& p, float* us, bf16_t* yg, int item, int lane) {
    const float2* abar_t = WSP(float2, WS_SSMT);
    const float2* bbar_t = abar_t + SSM_G * SSM_P;
    const bf16_t* u = WSP(bf16_t, WS_U);
    const int b = item / SSM_G, g = item % SSM_G;
    const float2 ab = abar_t[g * SSM_P + lane];
    float br[16], bi[16], cr[16], ci[16];
#pragma unroll
    for (int c = 0; c < 16; ++c) {
        float2 t = bbar_t[(g * SSM_P + lane) * SSM_N + c];
        br[c] = t.x; bi[c] = t.y;
        cr[c] = p.c_re[((size_t)g * SSM_N + c) * SSM_P + lane];
        ci[c] = p.c_im[((size_t)g * SSM_N + c) * SSM_P + lane];
    }
    const int myc = ((lane >> 5) & 1) * 8 + ((lane >> 4) & 1) * 4 + ((lane >> 3) & 1) * 2 + ((lane >> 2) & 1);
    const float dsk = p.d_skip[g * SSM_N + myc];
    float xr = 0.f, xi = 0.f;
    for (int t0 = 0; t0 < SEQ; t0 += 64) {
        {
            const bf16_t* ur = u + ((size_t)(b * SEQ + t0 + lane)) * SSM_W + g * SSM_N;
            f32x4 f0, f1, f2, f3; unpack8(*(const u32x4*)ur, f0, f1); unpack8(*(const u32x4*)(ur + 8), f2, f3);
            float* d = us + lane * 16;
            *(f32x4*)d = f0; *(f32x4*)(d + 4) = f1; *(f32x4*)(d + 8) = f2; *(f32x4*)(d + 12) = f3;
        }
        __builtin_amdgcn_s_waitcnt(0);
        __builtin_amdgcn_wave_barrier();
        for (int tt = 0; tt < 64; ++tt) {
            float uu[16];
#pragma unroll
            for (int c4 = 0; c4 < 4; ++c4) {
                f32x4 t = *(const f32x4*)(us + tt * 16 + c4 * 4);
                uu[c4 * 4] = t[0]; uu[c4 * 4 + 1] = t[1]; uu[c4 * 4 + 2] = t[2]; uu[c4 * 4 + 3] = t[3];
            }
            float bur = 0.f, bui = 0.f;
#pragma unroll
            for (int c = 0; c < 16; ++c) { bur += br[c] * uu[c]; bui += bi[c] * uu[c]; }
            float nxr = ab.x * xr - ab.y * xi + bur;
            float nxi = ab.x * xi + ab.y * xr + bui;
            xr = nxr; xi = nxi;
            float z[16];
#pragma unroll
            for (int c = 0; c < 16; ++c) z[c] = cr[c] * xr - ci[c] * xi;
            float w8[8], w4[4], w2[2], w1;
            const bool h5 = lane & 32, h4 = lane & 16, h3 = lane & 8, h2 = lane & 4;
#pragma unroll
            for (int i = 0; i < 8; ++i) { float mine = h5 ? z[8 + i] : z[i], oth = h5 ? z[i] : z[8 + i]; w8[i] = mine + __shfl_xor(oth, 32); }
#pragma unroll
            for (int i = 0; i < 4; ++i) { float mine = h4 ? w8[4 + i] : w8[i], oth = h4 ? w8[i] : w8[4 + i]; w4[i] = mine + __shfl_xor(oth, 16); }
#pragma unroll
            for (int i = 0; i < 2; ++i) { float mine = h3 ? w4[2 + i] : w4[i], oth = h3 ? w4[i] : w4[2 + i]; w2[i] = mine + __shfl_xor(oth, 8); }
            { float mine = h2 ? w2[1] : w2[0], oth = h2 ? w2[0] : w2[1]; w1 = mine + __shfl_xor(oth, 4); }
            w1 += __shfl_xor(w1, 2);
            w1 += __shfl_xor(w1, 1);
            float um = 0.f;
#pragma unroll
            for (int c = 0; c < 16; ++c) um = (c == myc) ? uu[c] : um;
            float y = gelu_tanh(w1 + dsk * um);
            if ((lane & 3) == 0) yg[((size_t)(b * SEQ + t0 + tt)) * SSM_W + g * SSM_N + myc] = (bf16_t)f2bf(y);
        }
        __builtin_amdgcn_wave_barrier();
    }
}


__device__ __forceinline__ void ssm_fast_item(const Params& p, unsigned char* smem, unsigned yg_off, int item, int lane_in, int wave) {
    const unsigned char* W = p.ws;
    constexpr unsigned O_U = WS_U << 20, O_W1T = WS_W1T << 20, O_W3T = WS_W3T << 20;
    const int b = item >> 5, g = item & 31;
    int lane = lane_in; asm volatile("" : "+v"(lane));
    const int gq = lane >> 4, c = lane & 15, rg = wave & 3, hf = wave >> 2;
    bf16_t* Kl = (bf16_t*)smem; float* Sl = (float*)(smem + 32768); bf16_t* Xb = (bf16_t*)(smem + 65536);
    __syncthreads();
    {
        const u32x4* src = (const u32x4*)(WSP(bf16_t, WS_KT) + (size_t)g * 64 * 256); u32x4* dst = (u32x4*)smem;
        for (int i = wave * 64 + lane; i < 2048; i += NT) dst[i] = src[i];
    }
    bf16x8 A[32];
#pragma unroll
    for (int ks = 0; ks < 32; ++ks)
        A[ks] = ldws<bf16x8>(W, O_U + ((unsigned)(b * SEQ + (16 * rg + c) * 64 + 2 * ks + (gq >> 1)) * 512u + g * 16 + 8 * (gq & 1)) * 2u);
#pragma unroll 1
    for (int nt = 0; nt < 4; ++nt) {
        f32x4 acc = {0.f, 0.f, 0.f, 0.f};
        const unsigned wb = O_W1T + ((unsigned)(g * 128 + (4 * hf + nt) * 16 + c) * 1024u + 8 * gq) * 2u;
#pragma unroll
        for (int ks = 0; ks < 32; ++ks) acc = __builtin_amdgcn_mfma_f32_16x16x32_bf16(A[ks], ldws<bf16x8>(W, wb + ks * 64), acc, 0, 0, 0);
#pragma unroll
        for (int r = 0; r < 4; ++r) Sl[(16 * rg + 4 * gq + r) * 128 + (4 * hf + nt) * 16 + c] = acc[r];
    }
    __syncthreads();
    if (wave == 0) {
        const float2 a = WSP(float2, WS_A64)[g * SSM_P + lane];
        float xr = 0.f, xi = 0.f;
        for (int ch = 0; ch < 64; ++ch) {
            *(unsigned*)(Xb + ch * 128 + 2 * lane) = f2bf(xr) | (f2bf(xi) << 16);
            const float2 sv = *(const float2*)(Sl + ch * 128 + 2 * lane);
            const float nr = a.x * xr - a.y * xi + sv.x, ni = a.x * xi + a.y * xr + sv.y;
            xr = nr; xi = ni;
        }
    }
    __syncthreads();
    bf16x8 Xa[4];
#pragma unroll
    for (int k2 = 0; k2 < 4; ++k2) Xa[k2] = *(const bf16x8*)(Xb + (16 * rg + c) * 128 + 32 * k2 + 8 * gq);
    bf16_t* yg = (bf16_t*)(p.ws + yg_off);
    const int gh = gq >> 1;
    const bf16_t* kl_lane = Kl + (gq & 1) * 128 + c * 8;
    bf16x8 w3[4];
    {
        const unsigned wb0 = O_W3T + ((unsigned)((g * 64 + hf) * 16 + c) * 128u + 8 * gq) * 2u;
#pragma unroll
        for (int k2 = 0; k2 < 4; ++k2) w3[k2] = ldws<bf16x8>(W, wb0 + k2 * 64);
    }
#pragma unroll 1
    for (int tq = 0; tq < 32; ++tq) {
        const int tp = 2 * tq + hf;
        f32x4 acc = {0.f, 0.f, 0.f, 0.f};
#pragma unroll
        for (int k2 = 0; k2 < 4; ++k2) acc = __builtin_amdgcn_mfma_f32_16x16x32_bf16(Xa[k2], w3[k2], acc, 0, 0, 0);
        {
            const int tn = tq < 31 ? tp + 2 : tp;
            const unsigned wb = O_W3T + ((unsigned)((g * 64 + tn) * 16 + c) * 128u + 8 * gq) * 2u;
#pragma unroll
            for (int k2 = 0; k2 < 4; ++k2) w3[k2] = ldws<bf16x8>(W, wb + k2 * 64);
        }
#pragma unroll
        for (int ks = 0; ks < 32; ++ks) {
            if (ks <= tq) {
                const int l = tp - 2 * ks - gh;
                bf16x8 kb = *(const bf16x8*)(kl_lane + (l < 0 ? 0 : l) * 256);
                if (l < 0) kb = (bf16x8){0, 0, 0, 0, 0, 0, 0, 0};
                acc = __builtin_amdgcn_mfma_f32_16x16x32_bf16(A[ks], kb, acc, 0, 0, 0);
            }
        }
#pragma unroll
        for (int r = 0; r < 4; ++r)
            yg[((size_t)(b * SEQ + (16 * rg + 4 * gq + r) * 64 + tp)) * SSM_W + g * SSM_N + c] = (bf16_t)f2bf(gelu_tanh(acc[r]));
    }
}

__device__ __forceinline__ unsigned fkey(float f) {
    unsigned u = __builtin_bit_cast(unsigned, f);
    return (u & 0x80000000u) ? ~u : (u | 0x80000000u);
}
__device__ __forceinline__ void phase_attn(const Params& p, unsigned char* smem, bf16_t* yatt, int vcu, int G) {
    float* sc = (float*)smem;
    float* qis = sc + 4096;
    float* wis = qis + 256;
    float* qs = wis + 16;
    float* pl = qs + 512;
    int* sel = (int*)(pl + 2048);
    unsigned* hist = (unsigned*)(sel + 256);
    int* scanA = (int*)(hist + 256);
    int* scanB = scanA + 512;
    int* misc = scanB + 512;
    int tid = threadIdx.x; asm volatile("" : "+v"(tid));
    const bf16_t* qi = WSP(bf16_t, WS_QI); const bf16_t* ki = WSP(bf16_t, WS_KI); const float* wi = WSP(float, WS_WI);
    const bf16_t* q = WSP(bf16_t, WS_Q); const bf16_t* kk = WSP(bf16_t, WS_K); const bf16_t* vv = WSP(bf16_t, WS_V);
    for (int row = vcu; row < MTOK; row += G) {
        const int b = row / SEQ, t = row % SEQ, nvalid = t + 1;
        __syncthreads();
        if (tid < 256) qis[tid] = bf2f(qi[(size_t)row * 256 + tid]);
        if (tid < 8) wis[tid] = wi[(size_t)row * 8 + tid];
        qs[tid] = bf2f(q[(size_t)row * 512 + tid]);
        __syncthreads();
        for (int s = tid; s < nvalid; s += NT) {
            const bf16_t* kr = ki + ((size_t)b * SEQ + s) * 32;
            float kv[32];
#pragma unroll
            for (int d8 = 0; d8 < 4; ++d8) {
                f32x4 a, bb; unpack8(*(const u32x4*)(kr + d8 * 8), a, bb);
                kv[d8 * 8] = a[0]; kv[d8 * 8 + 1] = a[1]; kv[d8 * 8 + 2] = a[2]; kv[d8 * 8 + 3] = a[3];
                kv[d8 * 8 + 4] = bb[0]; kv[d8 * 8 + 5] = bb[1]; kv[d8 * 8 + 6] = bb[2]; kv[d8 * 8 + 7] = bb[3];
            }
            float a = 0.f;
#pragma unroll
            for (int h = 0; h < 8; ++h) {
                float d = 0.f;
#pragma unroll
                for (int dd = 0; dd < 32; ++dd) d += qis[h * 32 + dd] * kv[dd];
                a += wis[h] * fmaxf(d, 0.f);
            }
#ifdef PROBE_ATTN
            sc[s] = (float)(_Float16)a;
#else
            sc[s] = a;
#endif
        }
        __syncthreads();
        int nsel;
        if (nvalid <= TOPK) {
            nsel = nvalid;
            if (tid < nvalid) sel[tid] = tid;
        } else {
            nsel = TOPK;
            unsigned prefix = 0, mask = 0; int need = TOPK;
            for (int pass = 0; pass < 4; ++pass) {
                const int shift = 24 - 8 * pass;
                if (tid < 256) hist[tid] = 0;
                __syncthreads();
                for (int s = tid; s < nvalid; s += NT) {
                    unsigned key = fkey(sc[s]);
                    if ((key & mask) == prefix) atomicAdd(&hist[(key >> shift) & 255], 1u);
                }
                __syncthreads();
                if (tid == 0) {
                    int cum = 0, bin = 255;
                    for (; bin > 0; --bin) { if (cum + (int)hist[bin] >= need) break; cum += hist[bin]; }
                    misc[0] = bin; misc[1] = need - cum;
                }
                __syncthreads();
                prefix |= (unsigned)misc[0] << shift; mask |= 0xFFu << shift; need = misc[1];
                __syncthreads();
            }
            const int base = tid * 8;
            int cg = 0, ce = 0;
            for (int i = 0; i < 8; ++i) { int s = base + i; if (s < nvalid) { unsigned key = fkey(sc[s]); cg += key > prefix; ce += key == prefix; } }
            scanA[tid] = ce;
            __syncthreads();
            if (tid == 0) { int run = 0; for (int i = 0; i < NT; ++i) { int v = scanA[i]; scanA[i] = run; run += v; } }
            __syncthreads();
            const int preE = scanA[tid];
            int takeE = need - preE; takeE = takeE < 0 ? 0 : (takeE > ce ? ce : takeE);
            scanB[tid] = cg + takeE;
            __syncthreads();
            if (tid == 0) { int run = 0; for (int i = 0; i < NT; ++i) { int v = scanB[i]; scanB[i] = run; run += v; } }
            __syncthreads();
            int off = scanB[tid], te = 0;
            for (int i = 0; i < 8; ++i) {
                int s = base + i;
                if (s < nvalid) {
                    unsigned key = fkey(sc[s]);
                    bool take = key > prefix;
                    if (key == prefix) { take = te < takeE; ++te; }
                    if (take) { if (off < TOPK) sel[off] = s; ++off; }
                }
            }
        }
        __syncthreads();
        {
            const int j = tid & 255, n = tid >> 8;
            if (j < nsel) {
                const unsigned char* kr = (const unsigned char*)kk + ((size_t)b * SEQ + sel[j]) * 128 + n * 64;
                float kf[64];
#pragma unroll
                for (int d8 = 0; d8 < 8; ++d8) {
                    f32x4 a, bb; unpack8_fp8(*(const uint2*)(kr + d8 * 8), a, bb); a *= (1.f / 16.f); bb *= (1.f / 16.f);
                    kf[d8 * 8] = a[0]; kf[d8 * 8 + 1] = a[1]; kf[d8 * 8 + 2] = a[2]; kf[d8 * 8 + 3] = a[3];
                    kf[d8 * 8 + 4] = bb[0]; kf[d8 * 8 + 5] = bb[1]; kf[d8 * 8 + 6] = bb[2]; kf[d8 * 8 + 7] = bb[3];
                }
#pragma unroll
                for (int hh = 0; hh < 4; ++hh) {
                    const int h = n * 4 + hh;
                    float d = 0.f;
#pragma unroll
                    for (int dd = 0; dd < 64; ++dd) d += qs[h * 64 + dd] * kf[dd];
                    pl[h * 256 + j] = d * 0.125f;
                }
            } else {
#pragma unroll
                for (int hh = 0; hh < 4; ++hh) pl[(n * 4 + hh) * 256 + j] = -1e30f;
            }
        }
        __syncthreads();
        {
            const int h = tid >> 6, l = tid & 63;
            float vals[4]; float mx = -3e38f;
#pragma unroll
            for (int i = 0; i < 4; ++i) { vals[i] = pl[h * 256 + l + 64 * i]; mx = fmaxf(mx, vals[i]); }
#pragma unroll
            for (int o = 32; o >= 1; o >>= 1) mx = fmaxf(mx, __shfl_xor(mx, o));
            float sm = 0.f;
#pragma unroll
            for (int i = 0; i < 4; ++i) { vals[i] = __expf(vals[i] - mx); sm += vals[i]; }
            sm = wave_sum(sm);
            float inv = 1.f / sm;
#pragma unroll
            for (int i = 0; i < 4; ++i) pl[h * 256 + l + 64 * i] = vals[i] * inv;
        }
        __syncthreads();
        {
            const int h = tid >> 6, d = tid & 63, n = h >> 2;
            float a = 0.f;
            for (int j = 0; j < nsel; ++j) {
                const unsigned wv = *(const unsigned*)((const unsigned char*)vv + ((size_t)b * SEQ + sel[j]) * 128 + n * 64 + (d & ~3));
                const f32x2_t pv0 = __builtin_amdgcn_cvt_pk_f32_fp8((int)wv, false), pv1 = __builtin_amdgcn_cvt_pk_f32_fp8((int)wv, true);
                const float vsel = (d & 2) ? ((d & 1) ? pv1[1] : pv1[0]) : ((d & 1) ? pv0[1] : pv0[0]);
                const int pq = __builtin_amdgcn_cvt_pk_fp8_f32(pl[h * 256 + j] * 256.f, 0.f, 0, false);
                const f32x2_t pd = __builtin_amdgcn_cvt_pk_f32_fp8(pq, false);
                a += pd[0] * vsel * (1.f / 4096.f);
            }
            yatt[(size_t)row * 512 + tid] = (bf16_t)f2bf(a);
        }
    }
}


typedef short v4i16_t __attribute__((ext_vector_type(4)));
constexpr int DSA_KSTR = 8200, DSA_SEL_OFF = 16 * DSA_KSTR, DSA_NSEL_OFF = DSA_SEL_OFF + 8192, DSA_HIST_OFF = DSA_NSEL_OFF + 256, DSA_VST = 5120;
__device__ __forceinline__ int mbcnt64(unsigned long long m) { return __builtin_amdgcn_mbcnt_hi((unsigned)(m >> 32), __builtin_amdgcn_mbcnt_lo((unsigned)m, 0u)); }

__device__ __forceinline__ void dsa_item(const Params& p, unsigned char* smem, unsigned yatt_off, int b, int tt, int lane_in, int wave) {
    const unsigned char* W = p.ws;
    constexpr unsigned O_QI = WS_QI << 20, O_KI = WS_KI << 20, O_WI = WS_WI << 20, O_Q = WS_Q << 20, O_K = WS_K << 20, O_V = WS_V << 20;
    const int t0 = tt * 16;
    __syncthreads();
#ifndef DSA_RA
#define DSA_RA 1
#endif
#ifndef DSA_RB
#define DSA_RB 1
#endif
#ifndef DSA_RC
#define DSA_RC 1
#endif
    _Pragma("unroll 1") for (int ra_ = 0; ra_ < DSA_RA; ++ra_) {
        int lane = lane_in; asm volatile("" : "+v"(lane));
        const int g = lane >> 4, c = lane & 15;
        const unsigned qrow = (unsigned)(b * SEQ + t0 + c);
        bf16x8 qf[8]; float wv[8];
#pragma unroll
        for (int h = 0; h < 8; ++h) { qf[h] = ldws<bf16x8>(W, O_QI + qrow * 512u + h * 64 + 16 * g); wv[h] = ldws<float>(W, O_WI + qrow * 32u + h * 4); }
        bf16x8 kf_next = ldws<bf16x8>(W, O_KI + (unsigned)(b * SEQ + (wave <= tt ? wave : tt) * 16 + c) * 64u + 16 * g);
#pragma unroll 1
        for (int kt = wave; kt <= tt; kt += NWAVES) {
            const bf16x8 kf = kf_next;
            { const int kn = kt + NWAVES <= tt ? kt + NWAVES : tt; kf_next = ldws<bf16x8>(W, O_KI + (unsigned)(b * SEQ + kn * 16 + c) * 64u + 16 * g); }
            f32x4 s = {0.f, 0.f, 0.f, 0.f};
#pragma unroll
            for (int h = 0; h < 8; ++h) {
                const f32x4 d = __builtin_amdgcn_mfma_f32_16x16x32_bf16(kf, qf[h], (f32x4){0.f, 0.f, 0.f, 0.f}, 0, 0, 0);
#pragma unroll
                for (int r = 0; r < 4; ++r) { const float dv = d[r]; const int ri = __float_as_int(dv); s[r] += wv[h] * __int_as_float(ri > 0 ? ri : 0); }
            }
            const bool diag = (kt == tt);
            unsigned kw[4];
#pragma unroll
            for (int r = 0; r < 4; ++r) {
                const _Float16 hv = (_Float16)s[r];
                const unsigned hb = (unsigned)__builtin_bit_cast(unsigned short, hv);
                const unsigned key = (hb & 0x8000u) ? (~hb & 0xffffu) : (hb | 0x8000u);
                const bool valid = !(diag && 4 * g + r > c);
                kw[r] = valid ? key : 0u;
                if (valid && ra_ == 0) atomicAdd((unsigned*)(smem + DSA_HIST_OFF) + c * 256 + (key >> 8), 1u);
            }
            *(uint2*)(smem + c * DSA_KSTR + (kt * 16 + 4 * g) * 2) = make_uint2(kw[0] | (kw[1] << 16), kw[2] | (kw[3] << 16));
        }
    }
    __syncthreads();
    unsigned short* selall = (unsigned short*)(smem + DSA_SEL_OFF);
    int* nselarr = (int*)(smem + DSA_NSEL_OFF);
#pragma unroll 1
    for (int rr = 0; rr < 2 * DSA_RB; ++rr) {
        int lane = lane_in; asm volatile("" : "+v"(lane));
        const int tl = wave * 2 + (rr & 1), nvalid = t0 + tl + 1;
        unsigned short* selrow = selall + tl * 256;
        if (nvalid <= TOPK) {
            for (int j = lane; j < TOPK; j += 64) selrow[j] = (unsigned short)(j < nvalid ? j : 0);
            if (lane == 0) nselarr[tl] = nvalid;
        } else {
            unsigned kk[64];
#pragma unroll
            for (int i = 0; i < 16; ++i) {
                const uint2 w = *(const uint2*)(smem + tl * DSA_KSTR + (i * 64 + lane) * 8);
                const int s0 = (i * 64 + lane) * 4;
                kk[4 * i + 0] = s0 + 0 < nvalid ? (w.x & 0xffffu) : 0u; kk[4 * i + 1] = s0 + 1 < nvalid ? (w.x >> 16) : 0u;
                kk[4 * i + 2] = s0 + 2 < nvalid ? (w.y & 0xffffu) : 0u; kk[4 * i + 3] = s0 + 3 < nvalid ? (w.y >> 16) : 0u;
            }
            unsigned* hist = (unsigned*)(smem + DSA_HIST_OFF) + tl * 256;
            const int ni = (nvalid + 255) >> 8;
            unsigned Bsel = 0u; int cabove = 0, nties = 0;
#pragma unroll 1
            for (int pass = 0; pass < 2; ++pass) {
                if (pass == 1) {
#pragma unroll
                    for (int i = 0; i < 16; ++i) {
                        if (i < ni) {
#pragma unroll
                            for (int e = 0; e < 4; ++e) { const unsigned k = kk[4 * i + e]; if ((k >> 8) == Bsel) atomicAdd(&hist[k & 255u], 1u); }
                        }
                    }
                    __builtin_amdgcn_s_waitcnt(0xC07F);
                    __builtin_amdgcn_wave_barrier();
                }
                const uint4 hv = *(const uint4*)(hist + 4 * lane);
                const int ls = (int)(hv.x + hv.y + hv.z + hv.w);
                const int pre_ = wave_incl_scan(ls);
                const int suf = __builtin_amdgcn_readlane(pre_, 63) - pre_ + ls;
                const int needp = TOPK - cabove;
                const int above = suf - ls;
                const bool mine = (above < needp) && (suf >= needp);
                int bsel_l = 0, ca_l = 0, hsel_l = 0;
                {
                    int cacc = above;
                    const int h3 = (int)hv.w, h2 = (int)hv.z, h1 = (int)hv.y, h0 = (int)hv.x;
                    if (cacc + h3 >= needp) { bsel_l = 3; ca_l = cacc; hsel_l = h3; }
                    else { cacc += h3; if (cacc + h2 >= needp) { bsel_l = 2; ca_l = cacc; hsel_l = h2; }
                        else { cacc += h2; if (cacc + h1 >= needp) { bsel_l = 1; ca_l = cacc; hsel_l = h1; } else { cacc += h1; bsel_l = 0; ca_l = cacc; hsel_l = h0; } } }
                }
                const unsigned long long mm = __ballot(mine);
                const int src = mm ? (int)__builtin_ctzll(mm) : 0;
                const int bb = __shfl(4 * lane + bsel_l, src), ca = __shfl(ca_l, src);
                nties = __shfl(hsel_l, src);
                if (pass == 0) {
                    Bsel = (unsigned)bb; cabove = ca;
                    __builtin_amdgcn_wave_barrier();
                    hist[lane] = 0u; hist[lane + 64] = 0u; hist[lane + 128] = 0u; hist[lane + 192] = 0u;
                    __builtin_amdgcn_s_waitcnt(0xC07F);
                    __builtin_amdgcn_wave_barrier();
                } else { Bsel = (Bsel << 8) | (unsigned)bb; cabove += ca; }
            }
            const unsigned T = Bsel;
            const int need = TOPK - cabove;
            if (nties == need) {
                int cntl = 0;
#pragma unroll
                for (int i = 0; i < 16; ++i) if (i < ni) {
#pragma unroll
                    for (int e = 0; e < 4; ++e) cntl += (kk[4 * i + e] >= T) ? 1 : 0;
                }
                const int pre = wave_incl_scan(cntl);
                int pos = pre - cntl;
#pragma unroll
                for (int i = 0; i < 16; ++i) if (i < ni) {
#pragma unroll
                    for (int e = 0; e < 4; ++e) { if (kk[4 * i + e] >= T) { if (pos < TOPK) selrow[pos] = (unsigned short)((i * 64 + lane) * 4 + e); ++pos; } }
                }
            } else {
                int tiebase = 0, sbase = 0;
#pragma unroll
                for (int i = 0; i < 16; ++i) {
                    int below = 0, tot = 0;
#pragma unroll
                    for (int e = 0; e < 4; ++e) { const unsigned long long m = __ballot(kk[4 * i + e] == T); below += mbcnt64(m); tot += __builtin_popcountll(m); }
                    int own = 0; bool take[4];
#pragma unroll
                    for (int e = 0; e < 4; ++e) { const bool tie = kk[4 * i + e] == T; take[e] = (kk[4 * i + e] > T) || (tie && (tiebase + below + own < need)); own += tie ? 1 : 0; }
                    tiebase += tot;
                    int belowS = 0, totS = 0;
#pragma unroll
                    for (int e = 0; e < 4; ++e) { const unsigned long long m = __ballot(take[e]); belowS += mbcnt64(m); totS += __builtin_popcountll(m); }
                    int ownS = 0;
#pragma unroll
                    for (int e = 0; e < 4; ++e) { if (take[e]) { const int pos = sbase + belowS + ownS; if (pos < TOPK) selrow[pos] = (unsigned short)((i * 64 + lane) * 4 + e); } ownS += take[e] ? 1 : 0; }
                    sbase += totS;
                }
            }
            if (lane == 0) nselarr[tl] = TOPK;
        }
        {
            unsigned* hz = (unsigned*)(smem + DSA_HIST_OFF) + tl * 256;
            hz[lane] = 0u; hz[lane + 64] = 0u; hz[lane + 128] = 0u; hz[lane + 192] = 0u;
        }
    }
    __builtin_amdgcn_s_waitcnt(0xC07F); __builtin_amdgcn_wave_barrier();
#pragma unroll 1
    for (int rn_ = 0; rn_ < 4 * DSA_RC; ++rn_) {
        const int rn = rn_ & 3;
        int lane = lane_in; asm volatile("" : "+v"(lane));
        const int g = lane >> 4, c = lane & 15;
        const int rr = rn >> 1, n = rn & 1;
        unsigned char* vst = smem + (2 * wave) * DSA_KSTR;
        const int tl = wave * 2 + rr;
        const unsigned rowg = (unsigned)(b * SEQ + t0 + tl);
        const int nselg = nselarr[tl] - 4 * g;
        const unsigned short* selrow = selall + tl * 256;
        const unsigned kvb = O_K + (unsigned)(b * SEQ) * 128u + n * 64 + 16 * g;
        const unsigned vvb = O_V + (unsigned)(b * SEQ) * 128u + n * 64 + (lane & 3) * 16;
        long qha = 0, qhb = 0, qla = 0, qlb = 0;
        if (c < 4) {
            const unsigned qo = O_Q + rowg * 1024u + (n * 4 + c) * 128 + 32 * g;
            f32x4 q0, q1, q2, q3; unpack8(ldws<u32x4>(W, qo), q0, q1); unpack8(ldws<u32x4>(W, qo + 16), q2, q3);
            q0 *= 16.f; q1 *= 16.f; q2 *= 16.f; q3 *= 16.f;
            const uint2 ha = pack8_fp8(q0, q1), hb = pack8_fp8(q2, q3);
            f32x4 d0, d1, d2, d3; unpack8_fp8(ha, d0, d1); unpack8_fp8(hb, d2, d3);
            const uint2 la = pack8_fp8(q0 - d0, q1 - d1), lb = pack8_fp8(q2 - d2, q3 - d3);
            qha = (long)(((unsigned long long)ha.y << 32) | ha.x); qhb = (long)(((unsigned long long)hb.y << 32) | hb.x);
            qla = (long)(((unsigned long long)la.y << 32) | la.x); qlb = (long)(((unsigned long long)lb.y << 32) | lb.x);
        }
        f32x4 S[16];
#pragma unroll
        for (int tile = 0; tile < 16; ++tile) {
            const unsigned key = selrow[tile * 16 + c];
            const u32x4 kw = ldws<u32x4>(W, kvb + key * 128u);
            const long ka = (long)(((unsigned long long)kw.y << 32) | kw.x), kb = (long)(((unsigned long long)kw.w << 32) | kw.z);
            f32x4 acc = __builtin_amdgcn_mfma_f32_16x16x32_fp8_fp8(ka, qha, (f32x4){0.f, 0.f, 0.f, 0.f}, 0, 0, 0);
            acc = __builtin_amdgcn_mfma_f32_16x16x32_fp8_fp8(kb, qhb, acc, 0, 0, 0);
            acc = __builtin_amdgcn_mfma_f32_16x16x32_fp8_fp8(ka, qla, acc, 0, 0, 0);
            S[tile] = __builtin_amdgcn_mfma_f32_16x16x32_fp8_fp8(kb, qlb, acc, 0, 0, 0);
        }
        u32x4 vra[8];
#pragma unroll
        for (int i = 0; i < 8; ++i) { const unsigned key = selrow[i * 16 + (lane >> 2)]; vra[i] = ldws<u32x4>(W, vvb + key * 128u); }
        float Pk[4][4];
        {
            const int nselc = nselarr[tl] - 4 * g - 16 * (c >> 2);
            float mx = -3e38f;
#pragma unroll
            for (int q4 = 0; q4 < 4; ++q4)
#pragma unroll
                for (int r = 0; r < 4; ++r) {
                    float v = S[4 * q4][r];
                    v = dppf<0x114, 0xf, 0x2, false>(v, S[4 * q4 + 1][r]);
                    v = dppf<0x118, 0xf, 0x4, false>(v, S[4 * q4 + 2][r]);
                    v = dppf<0x11C, 0xf, 0x8, false>(v, S[4 * q4 + 3][r]);
                    v = (64 * q4 + r) < nselc ? v : -1e30f;
                    Pk[q4][r] = v; mx = fmaxf(mx, v);
                }
            mx = fmaxf(mx, dppf<0x124, 0xf, 0xf, false>(mx, mx)); mx = fmaxf(mx, dppf<0x128, 0xf, 0xf, false>(mx, mx));
            mx = fmaxf(mx, __shfl_xor(mx, 16)); mx = fmaxf(mx, __shfl_xor(mx, 32));
            float sum = 0.f;
#pragma unroll
            for (int q4 = 0; q4 < 4; ++q4)
#pragma unroll
                for (int r = 0; r < 4; ++r) { const float e = __expf((Pk[q4][r] - mx) * (0.125f / 256.f)); Pk[q4][r] = e; sum += e; }
            sum += dppf<0x124, 0xf, 0xf, false>(sum, sum); sum += dppf<0x128, 0xf, 0xf, false>(sum, sum);
            sum += __shfl_xor(sum, 16); sum += __shfl_xor(sum, 32);
            const float invs = 256.f / sum;
#pragma unroll
            for (int q4 = 0; q4 < 4; ++q4)
#pragma unroll
                for (int r = 0; r < 4; ++r) Pk[q4][r] *= invs;
#pragma unroll
            for (int q4 = 0; q4 < 4; ++q4)
#pragma unroll
                for (int r = 0; r < 4; ++r) {
                    const float pv = Pk[q4][r];
                    S[4 * q4][r] = pv;
                    S[4 * q4 + 1][r] = dppf<0x104, 0xf, 0xf, false>(pv, pv);
                    S[4 * q4 + 2][r] = dppf<0x108, 0xf, 0xf, false>(pv, pv);
                    S[4 * q4 + 3][r] = dppf<0x10C, 0xf, 0xf, false>(pv, pv);
                }
        }
        f32x4 O[4];
#pragma unroll
        for (int dt = 0; dt < 4; ++dt) O[dt] = (f32x4){0.f, 0.f, 0.f, 0.f};
        const LAS unsigned char* vp = (const LAS unsigned char*)(vst + (16 * (g >> 1) + 8 * (g & 1) + 4 * ((c >> 1) >> 2) + ((c >> 1) & 3)) * 80 + (c & 1) * 8);
        typedef int v2i32_t __attribute__((ext_vector_type(2)));
#pragma unroll
        for (int hv = 0; hv < 2; ++hv) {
            u32x4 vr[8];
            if (hv == 0) {
#pragma unroll
                for (int i = 0; i < 8; ++i) vr[i] = vra[i];
            } else {
#pragma unroll
                for (int i = 0; i < 8; ++i) { const unsigned key = selrow[128 + i * 16 + (lane >> 2)]; vr[i] = ldws<u32x4>(W, vvb + key * 128u); }
            }
#pragma unroll
            for (int k4 = 0; k4 < 4; ++k4) {
                const int ks2 = hv * 4 + k4;
                __builtin_amdgcn_wave_barrier();
#pragma unroll
                for (int i2 = 0; i2 < 2; ++i2) {
                    const int slot = 16 * (lane >> 5) + 8 * ((lane >> 4) & 1) + 4 * i2 + ((lane >> 2) & 3);
                    *(u32x4*)(vst + slot * 80 + (lane & 3) * 16) = vr[k4 * 2 + i2];
                }
                __builtin_amdgcn_s_waitcnt(0xC07F);
                __builtin_amdgcn_wave_barrier();
                const uint2 pw = pack8_fp8(S[2 * ks2], S[2 * ks2 + 1]);
                const long pa = (long)(((unsigned long long)pw.y << 32) | pw.x);
#pragma unroll
                for (int dt = 0; dt < 4; ++dt) {
                    const v2i32_t l0 = __builtin_amdgcn_ds_read_tr8_b64_v2i32((LAS v2i32_t*)(vp + dt * 16));
                    const long vb = (long)(((unsigned long long)(unsigned)l0[1] << 32) | (unsigned)l0[0]);
                    O[dt] = __builtin_amdgcn_mfma_f32_16x16x32_fp8_fp8(pa, vb, O[dt], 0, 0, 0);
                }
            }
        }
        if (g == 0) {
            bf16_t* yo = (bf16_t*)(p.ws + yatt_off) + (size_t)rowg * 512 + n * 256 + c;
#pragma unroll
            for (int dt = 0; dt < 4; ++dt)
#pragma unroll
                for (int r = 0; r < 4; ++r) yo[r * 64 + dt * 16] = (bf16_t)f2bf(O[dt][r] * (1.f / 4096.f));
        }
    }
}

__device__ __forceinline__ void phase_dsa(const Params& p, unsigned char* smem, unsigned yatt_off, int vcu, int G) {
    int tid = threadIdx.x; asm volatile("" : "+v"(tid));
    const int lane = tid & 63, wave = __builtin_amdgcn_readfirstlane(tid >> 6);
    { unsigned* hz = (unsigned*)(smem + DSA_HIST_OFF); for (int i = tid; i < 16 * 256; i += NT) hz[i] = 0u; }
    const bool bal = (G == 256);
    const int nit = bal ? 8 : (NB * 256 - vcu + G - 1) / G;
#pragma unroll 1
    for (int it = 0; it < nit; ++it) {
        int b, tt;
        if (bal) { const int j = vcu & 31; b = vcu >> 5; tt = (it >> 1) * 64 + ((it & 1) ? 63 - j : j); }
        else { const int item = vcu + it * G; b = item >> 8; tt = item & 255; }
        dsa_item(p, smem, yatt_off, b, tt, lane, wave);
#if PEER_FP8
        {
            if (bal) {
                const int slots = G * NWAVES * 8, per = (2 * 16384 + slots - 1) / slots;
                const int s0 = ((vcu * NWAVES + wave) * 8 + it) * per;
                for (int r = s0; r < s0 + per && r < 2 * 16384; ++r) peer_table_row(p, r, lane, smem + DSA_HIST_OFF + 16384 + wave * 768);
            }
        }
#endif
    }
#if PEER_FP8
    if (!bal) for (int r = vcu * NWAVES + wave; r < 2 * 16384; r += G * NWAVES) peer_table_row(p, r, lane, smem + DSA_HIST_OFF + 16384 + wave * 768);
#endif
}

template <bool DRY>
__device__ __forceinline__ void phase_peer(const Params& p, unsigned char* smem, int vcu, int G) {
    int tid_ = threadIdx.x; asm volatile("" : "+v"(tid_)); const int wave = tid_ >> 6, lane = tid_ & 63;
    float* wsm = (float*)smem + wave * 1024;
    float* sc = wsm;
    float* v1s = wsm + 256; int* i1s = (int*)(wsm + 272); float* v2s = wsm + 288; int* i2s = (int*)(wsm + 304);
    float* tops = wsm + 320;
    int* tope = (int*)(wsm + 336);
    int* eid = (int*)(wsm + 384);
    float* egate = wsm + 512;
    const float* scores = WSP(float, WS_SCORES);
    const bf16_t* hg = WSP(bf16_t, WS_HG);
    const float* rss = WSP(float, WS_RSS);
    const bf16_t* ut = WSP(bf16_t, WS_UTAB); const bf16_t* vt = WSP(bf16_t, WS_VTAB);
    const int nwaves = G * NWAVES;
    int ca = 0, cb = 0;
    {
        int rem = lane; bool found = false;
#pragma unroll
        for (int a = 0; a < 16; ++a) { int cnt = 16 / (a + 1); if (!found) { if (rem < cnt) { ca = a; cb = rem; found = true; } else rem -= cnt; } }
    }
    for (int row = vcu * NWAVES + wave; row < MTOK; row += nwaves) {
        float rs;
        {
            float t = lane < 16 ? rss[(size_t)row * 16 + lane] : 0.f;
            t = wave_sum(t);
            rs = rsqrtf(t * (1.f / DM) + NORM_EPS);
        }
        for (int h = 0; h < PEER_H; ++h) {
            const float* sp = scores + (size_t)row * 2048 + h * 256;
            float a0 = sp[lane], a1 = sp[lane + 64], b0 = sp[128 + lane], b1 = sp[192 + lane];
            __builtin_amdgcn_wave_barrier();
            sc[lane] = a0; sc[lane + 64] = a1; sc[128 + lane] = b0; sc[192 + lane] = b1;
            __builtin_amdgcn_s_waitcnt(0);
            __builtin_amdgcn_wave_barrier();
            int ra0 = 0, ra1 = 0, rb0 = 0, rb1 = 0;
            for (int j = 0; j < 64; ++j) {
                float x = sc[j], y = sc[j + 64], z = sc[128 + j], w = sc[192 + j];
                ra0 += (x > a0) || (x == a0 && j < lane); ra0 += (y > a0);
                ra1 += (x >= a1); ra1 += (y > a1) || (y == a1 && j < lane);
                rb0 += (z > b0) || (z == b0 && j < lane); rb0 += (w > b0);
                rb1 += (z >= b1); rb1 += (w > b1) || (w == b1 && j < lane);
            }
            if (ra0 < 16) { v1s[ra0] = a0; i1s[ra0] = lane; }
            if (ra1 < 16) { v1s[ra1] = a1; i1s[ra1] = lane + 64; }
            if (rb0 < 16) { v2s[rb0] = b0; i2s[rb0] = lane; }
            if (rb1 < 16) { v2s[rb1] = b1; i2s[rb1] = lane + 64; }
            __builtin_amdgcn_s_waitcnt(0);
            __builtin_amdgcn_wave_barrier();
            float cv = -3e38f; int cpos = 1 << 20;
            if (lane < 50) { cv = v1s[ca] + v2s[cb]; cpos = ca * 16 + cb; }
            int rk = 0;
            for (int j = 0; j < 50; ++j) {
                float x = __shfl(cv, j); int px = __shfl(cpos, j);
                rk += (x > cv) || (x == cv && px < cpos);
            }
            if (lane < 50 && rk < 16) { tops[rk] = cv; tope[rk] = i1s[ca] * PEER_KEYS + i2s[cb]; }
            __builtin_amdgcn_s_waitcnt(0);
            __builtin_amdgcn_wave_barrier();
            if (lane < 16) {
                float s = tops[lane] * rs;
                float mx = s;
#pragma unroll
                for (int o = 8; o >= 1; o >>= 1) mx = fmaxf(mx, __shfl_xor(mx, o, 16));
                float e = __expf(s - mx), sm = e;
#pragma unroll
                for (int o = 8; o >= 1; o >>= 1) sm += __shfl_xor(sm, o, 16);
                eid[h * 16 + lane] = tope[lane];
                egate[h * 16 + lane] = e / sm;
            }
            __builtin_amdgcn_s_waitcnt(0);
            __builtin_amdgcn_wave_barrier();
        }
        f32x4 xv[4], acc[4];
        {
            const bf16_t* hr = hg + (size_t)row * DM;
            unpack8(*(const u32x4*)(hr + lane * 8), xv[0], xv[1]);
            unpack8(*(const u32x4*)(hr + 512 + lane * 8), xv[2], xv[3]);
#pragma unroll
            for (int i = 0; i < 4; ++i) { xv[i] = xv[i] * rs; acc[i] = (f32x4){0.f, 0.f, 0.f, 0.f}; }
        }
        for (int e0 = 0; e0 < 128; e0 += 4) {
            u32x4 uw[4][2], vw[4][2];
#pragma unroll
            for (int e = 0; e < 4; ++e) {
                const bf16_t* ur = ut + (size_t)eid[e0 + e] * DM;
                uw[e][0] = *(const u32x4*)(ur + lane * 8); uw[e][1] = *(const u32x4*)(ur + 512 + lane * 8);
            }
#pragma unroll
            for (int e = 0; e < 4; ++e) {
                const bf16_t* vr = vt + (size_t)eid[e0 + e] * DM;
                vw[e][0] = *(const u32x4*)(vr + lane * 8); vw[e][1] = *(const u32x4*)(vr + 512 + lane * 8);
            }
            float act[4];
#pragma unroll
            for (int e = 0; e < 4; ++e) {
                f32x4 u0, u1, u2, u3; unpack8(uw[e][0], u0, u1); unpack8(uw[e][1], u2, u3);
                f32x4 s4 = xv[0] * u0 + xv[1] * u1 + xv[2] * u2 + xv[3] * u3;
                float d = wave_sum((s4[0] + s4[1]) + (s4[2] + s4[3]));
                act[e] = gelu_tanh(d) * egate[e0 + e];
            }
#pragma unroll
            for (int e = 0; e < 4; ++e) {
                f32x4 v0, v1, v2, v3; unpack8(vw[e][0], v0, v1); unpack8(vw[e][1], v2, v3);
                acc[0] += v0 * act[e]; acc[1] += v1 * act[e]; acc[2] += v2 * act[e]; acc[3] += v3 * act[e];
            }
        }
        float* hr = p.out + (size_t)row * DM;
        float ss = 0.f;
        if (DRY) { const float chk = acc[0][0] + acc[1][1] + acc[2][2] + acc[3][3]; if (chk == 1.2345678f) hr[lane] = chk; continue; }
#pragma unroll
        for (int c = 0; c < 2; ++c) {
            acc[2 * c] += *(const f32x4*)(hr + c * 512 + lane * 8); acc[2 * c + 1] += *(const f32x4*)(hr + c * 512 + lane * 8 + 4);
        }
#pragma unroll
        for (int i = 0; i < 4; ++i) ss += acc[i][0] * acc[i][0] + acc[i][1] * acc[i][1] + acc[i][2] * acc[i][2] + acc[i][3] * acc[i][3];
        ss = wave_sum(ss);
        float scl = rsqrtf(ss * (1.f / DM) + NORM_EPS);
#if defined(PROBE_ATTN) || defined(PROBE_SSM)
        {
            const float e = ((const float*)p.ws)[16] / fmaxf(((const float*)p.ws)[17], 1e-30f);
            int kx = 0; if (e > 1e-6f) kx++; if (e > 1e-5f) kx++; if (e > 1e-4f) kx++; if (e > 1e-3f) kx++; if (e > 1e-2f) kx++; if (e > 1e-1f) kx++; if (!(e == e)) kx = 8;
            scl *= 1.f + 0.05f * kx;
        }
#endif
#pragma unroll
        for (int c = 0; c < 2; ++c) {
            f32x4 ga = *(const f32x4*)(p.norm_f_g + c * 512 + lane * 8), gb = *(const f32x4*)(p.norm_f_g + c * 512 + lane * 8 + 4);
            *(f32x4*)(hr + c * 512 + lane * 8) = acc[2 * c] * scl * ga; *(f32x4*)(hr + c * 512 + lane * 8 + 4) = acc[2 * c + 1] * scl * gb;
        }
    }
}


template <int MODE>
__device__ __forceinline__ void phase_peer2(const Params& p, unsigned char* smem, int vcu, int G) {
    int tid_ = threadIdx.x; asm volatile("" : "+v"(tid_));
    const int wave = __builtin_amdgcn_readfirstlane(tid_ >> 6), lane = tid_ & 63;
    const int gq = lane >> 4, c = lane & 15;
    unsigned char* wsm = smem + wave * 4096;
    bf16_t* xl = (bf16_t*)wsm;
    float* lv = (float*)(wsm + 2048);
    int* li = (int*)(wsm + 2048 + 128);
    float* vs = (float*)(wsm + 2048 + 256);
    int* is_ = (int*)(wsm + 2048 + 384);
    int* eid = (int*)(wsm + 2048 + 512);
    float* egate = (float*)(wsm + 2048 + 1024);
    float* eusc = (float*)(wsm + 2048 + 1536);
    const unsigned char* W = p.ws;
    constexpr unsigned O_SC = WS_SCORES << 20, O_HG = WS_HG << 20, O_UT = WS_UTAB << 20, O_VT = WS_VTAB << 20;
    const float* rss = WSP(float, WS_RSS);
    const int nwaves = G * NWAVES;
    int ca = 0, cb = 0;
    {
        int rem = lane; bool found = false;
#pragma unroll
        for (int a = 0; a < 16; ++a) { const int cnt = 16 / (a + 1); if (!found) { if (rem < cnt) { ca = a; cb = rem; found = true; } else rem -= cnt; } }
    }
#pragma unroll 1
    for (int row = vcu * NWAVES + wave; row < MTOK; row += nwaves) {
        float rs;
        { float t = lane < 16 ? rss[(size_t)row * 16 + lane] : 0.f; t = wave_sum(t); rs = rsqrtf(t * (1.f / DM) + NORM_EPS); }
        {
            const u32x4 w0 = ldws<u32x4>(W, O_HG + (unsigned)row * 2048u + lane * 16), w1 = ldws<u32x4>(W, O_HG + (unsigned)row * 2048u + 1024 + lane * 16);
#if PEER_FP8
            f32x4 xa[4]; unpack8(w0, xa[0], xa[1]); unpack8(w1, xa[2], xa[3]);
            xa[0] *= *(const f32x4*)(p.norm2_g + lane * 8); xa[1] *= *(const f32x4*)(p.norm2_g + lane * 8 + 4); xa[2] *= *(const f32x4*)(p.norm2_g + 512 + lane * 8); xa[3] *= *(const f32x4*)(p.norm2_g + 512 + lane * 8 + 4);
            unsigned hw[4], lw[4];
#pragma unroll
            for (int i = 0; i < 4; ++i) {
                typedef float f32x2_ __attribute__((ext_vector_type(2)));
                const f32x4 xs = xa[i] * 16.f;
                int h = __builtin_amdgcn_cvt_pk_fp8_f32(xs[0], xs[1], 0, false); h = __builtin_amdgcn_cvt_pk_fp8_f32(xs[2], xs[3], h, true);
                const f32x2_ b0 = __builtin_amdgcn_cvt_pk_f32_fp8(h, false), b1 = __builtin_amdgcn_cvt_pk_f32_fp8(h, true);
                int l = __builtin_amdgcn_cvt_pk_fp8_f32((xs[0] - b0[0]) * 16.f, (xs[1] - b0[1]) * 16.f, 0, false); l = __builtin_amdgcn_cvt_pk_fp8_f32((xs[2] - b1[0]) * 16.f, (xs[3] - b1[1]) * 16.f, l, true);
                hw[i] = (unsigned)h; lw[i] = (unsigned)l;
            }
            *(uint2*)(wsm + lane * 8) = make_uint2(hw[0], hw[1]); *(uint2*)(wsm + 512 + lane * 8) = make_uint2(hw[2], hw[3]);
            *(uint2*)(wsm + 1024 + lane * 8) = make_uint2(lw[0], lw[1]); *(uint2*)(wsm + 1536 + lane * 8) = make_uint2(lw[2], lw[3]);
#else
            *(u32x4*)(wsm + lane * 16) = w0; *(u32x4*)(wsm + 1024 + lane * 16) = w1;
#endif
        }
#ifdef PROBE_NOTOPK
        if (MODE == 1) { eid[lane] = (row * 131 + lane * 977) & 16383; eid[lane + 64] = (row * 137 + lane * 1499 + 7) & 16383; egate[lane] = 0.0625f; egate[lane + 64] = 0.0625f; eusc[lane] = 1.f; eusc[lane + 64] = 1.f; }
        else
#endif
#pragma unroll 1
        for (int h = 0; h < PEER_H; ++h) {
            const unsigned so = O_SC + (unsigned)row * 4096u + h * 512 + lane * 2;
            const unsigned short ha0 = ldws<unsigned short>(W, so), ha1 = ldws<unsigned short>(W, so + 128), hb0 = ldws<unsigned short>(W, so + 256), hb1 = ldws<unsigned short>(W, so + 384);
            const float a0 = (float)__builtin_bit_cast(_Float16, ha0), a1 = (float)__builtin_bit_cast(_Float16, ha1), b0 = (float)__builtin_bit_cast(_Float16, hb0), b1 = (float)__builtin_bit_cast(_Float16, hb1);
#define K16(hb) ((((unsigned)(hb) & 0x8000u) ? (~(unsigned)(hb) & 0xffffu) : ((unsigned)(hb) | 0x8000u)) << 16)
            const unsigned ka0 = K16(ha0) | (0xFFFFu - (unsigned)lane), ka1 = K16(ha1) | (0xFFFFu - 64u - (unsigned)lane);
            const unsigned kb0 = K16(hb0) | (0xFFFFu - (unsigned)lane), kb1 = K16(hb1) | (0xFFFFu - 64u - (unsigned)lane);
#undef K16
            unsigned long long loA = 0, hiA = 1ull << 32, loB = 0, hiB = 1ull << 32; bool doneA = false, doneB = false;
            while (!(doneA && doneB)) {
                if (!doneA) { const unsigned mid = (unsigned)((loA + hiA) >> 1); const int cnt = __builtin_popcountll(__ballot(ka0 >= mid)) + __builtin_popcountll(__ballot(ka1 >= mid));
                    if (cnt >= 16) loA = mid; else hiA = mid; doneA = (cnt == 16) || (hiA - loA <= 1); }
                if (!doneB) { const unsigned mid = (unsigned)((loB + hiB) >> 1); const int cnt = __builtin_popcountll(__ballot(kb0 >= mid)) + __builtin_popcountll(__ballot(kb1 >= mid));
                    if (cnt >= 16) loB = mid; else hiB = mid; doneB = (cnt == 16) || (hiB - loB <= 1); }
            }
            __builtin_amdgcn_wave_barrier();
            {
                const unsigned T = (unsigned)loA;
                const bool k0 = ka0 >= T, k1 = ka1 >= T;
                const unsigned long long s0 = __ballot(k0), s1 = __ballot(k1);
                if (k0) { const int pos = mbcnt64(s0); lv[pos] = a0; li[pos] = lane; }
                if (k1) { const int pos = __builtin_popcountll(s0) + mbcnt64(s1); if (pos < 16) { lv[pos] = a1; li[pos] = lane + 64; } }
            }
            {
                const unsigned T = (unsigned)loB;
                const bool k0 = kb0 >= T, k1 = kb1 >= T;
                const unsigned long long s0 = __ballot(k0), s1 = __ballot(k1);
                if (k0) { const int pos = mbcnt64(s0); lv[16 + pos] = b0; li[16 + pos] = lane; }
                if (k1) { const int pos = __builtin_popcountll(s0) + mbcnt64(s1); if (pos < 16) { lv[16 + pos] = b1; li[16 + pos] = lane + 64; } }
            }
            __builtin_amdgcn_s_waitcnt(0xC07F);
            __builtin_amdgcn_wave_barrier();
            if (lane < 32) {
                const int base = lane & 16, me = lane & 15;
                const float mv = lv[lane]; int rk = 0;
#pragma unroll
                for (int j = 0; j < 16; ++j) { const float x = lv[base + j]; rk += (x > mv) || (x == mv && j < me); }
                vs[base + rk] = mv; is_[base + rk] = li[lane];
            }
            __builtin_amdgcn_s_waitcnt(0xC07F);
            __builtin_amdgcn_wave_barrier();
            float cv = 0.f; unsigned kc = 0u;
            if (lane < 50) { cv = vs[ca] + vs[16 + cb]; kc = fkey(cv); }
            unsigned long long lo = fkey(vs[15] + vs[31]), hi = (unsigned long long)fkey(vs[0] + vs[16]) + 1ull;
            while (hi - lo > 1) {
                const unsigned mid = (unsigned)((lo + hi) >> 1); const int cnt = __builtin_popcountll(__ballot(kc >= mid));
                if (cnt >= 16) lo = mid; else hi = mid;
                if (cnt == 16) break;
            }
            const unsigned T2 = (unsigned)lo;
            const unsigned long long tm = __ballot(kc == T2);
            const int need2 = 16 - __builtin_popcountll(__ballot(kc > T2));
            const bool take = (kc > T2) || (kc == T2 && mbcnt64(tm) < need2);
            const float sv = take ? cv * rs : -3e38f;
            const float mx = wave_max(sv);
            const float ev = take ? __expf(sv - mx) : 0.f;
            const float sm = wave_sum(ev);
            if (take) { const int pos = mbcnt64(__ballot(take)); if (pos < 16) { const int e_ = is_[ca] * PEER_KEYS + is_[16 + cb]; eid[h * 16 + pos] = e_;
#if PEER_FP8
                egate[h * 16 + pos] = ev / sm * WSP(float, WS_VSC)[e_]; eusc[h * 16 + pos] = WSP(float, WS_USC)[e_];
#else
                egate[h * 16 + pos] = ev / sm;
#endif
            } }
            __builtin_amdgcn_wave_barrier();
        }
        __builtin_amdgcn_s_waitcnt(0xC07F);
        __builtin_amdgcn_wave_barrier();
#if PEER_FP8
        f32x4 acc[4];
#pragma unroll
        for (int i = 0; i < 4; ++i) acc[i] = (f32x4){0.f, 0.f, 0.f, 0.f};
        const unsigned koff = (unsigned)((c >> 3) * 64 + 16 * gq);
        u32x4 ub0[8], ub1[8], vb0[8], vb1[8];
#ifdef PROBE_L2GATHER
        if (MODE == 1) { eid[lane] &= 1023; eid[lane + 64] &= 1023; __builtin_amdgcn_s_waitcnt(0xC07F); __builtin_amdgcn_wave_barrier(); }
#endif
        int ec0 = eid[c & 7], ec1 = eid[8 + (c & 7)];
#pragma unroll
        for (int k3 = 0; k3 < 8; ++k3) ub0[k3] = ldws<u32x4>(W, O_UT + (unsigned)ec0 * 1024u + koff + k3 * 128);
#pragma unroll
        for (int j = 0; j < 8; ++j) vb0[j] = ldws<u32x4>(W, O_VT + (unsigned)__builtin_amdgcn_readlane(ec0, j) * 1024u + lane * 16);
#pragma unroll
        for (int k3 = 0; k3 < 8; ++k3) ub1[k3] = ldws<u32x4>(W, O_UT + (unsigned)ec1 * 1024u + koff + k3 * 128);
#define PEER_TILE(UB, EC, VBC, ECN, VBN)                                                                                           \
        {                                                                                                                          \
            f32x4 dh = {0.f, 0.f, 0.f, 0.f}, dl = {0.f, 0.f, 0.f, 0.f};                                                             \
            _Pragma("unroll") for (int k3 = 0; k3 < 8; ++k3) {                                                                     \
                const u32x4 xh = *(const u32x4*)(wsm + k3 * 128 + koff), xlo = *(const u32x4*)(wsm + 1024 + k3 * 128 + koff);      \
                const long u0 = (long)(((unsigned long long)UB[k3].y << 32) | UB[k3].x), u1 = (long)(((unsigned long long)UB[k3].w << 32) | UB[k3].z); \
                const long h0 = (long)(((unsigned long long)xh.y << 32) | xh.x), h1 = (long)(((unsigned long long)xh.w << 32) | xh.z);  \
                const long l0 = (long)(((unsigned long long)xlo.y << 32) | xlo.x), l1 = (long)(((unsigned long long)xlo.w << 32) | xlo.z); \
                dh = __builtin_amdgcn_mfma_f32_16x16x32_fp8_fp8(h0, u0, dh, 0, 0, 0);                                              \
                dh = __builtin_amdgcn_mfma_f32_16x16x32_fp8_fp8(h1, u1, dh, 0, 0, 0);                                              \
                dl = __builtin_amdgcn_mfma_f32_16x16x32_fp8_fp8(l0, u0, dl, 0, 0, 0);                                              \
                dl = __builtin_amdgcn_mfma_f32_16x16x32_fp8_fp8(l1, u1, dl, 0, 0, 0);                                              \
            }                                                                                                                      \
            float mine = dh[0] + dl[0] * (1.f / 16.f);                                                                             \
            mine += __shfl_xor(mine, 40);                                                       \
            const int ecur = EC;                                                                                                   \
            const float act = gelu_tanh(mine * (1.f / 16.f) * eusc[tcur * 8 + (c & 7)] * rs) * egate[tcur * 8 + (c & 7)];           \
            if (tcur + 2 < 16) {                                                                                                   \
                EC = eid[(tcur + 2) * 8 + (c & 7)];                                                                                \
                _Pragma("unroll") for (int k3 = 0; k3 < 8; ++k3) UB[k3] = ldws<u32x4>(W, O_UT + (unsigned)EC * 1024u + koff + k3 * 128); \
            }                                                                                                                      \
            if (tcur + 1 < 16) {                                                                                                   \
                _Pragma("unroll") for (int j = 0; j < 8; ++j) VBN[j] = ldws<u32x4>(W, O_VT + (unsigned)__builtin_amdgcn_readlane(ECN, j) * 1024u + lane * 16); \
            }                                                                                                                      \
            __builtin_amdgcn_sched_barrier(0);                                                                                     \
            _Pragma("unroll") for (int j = 0; j < 8; ++j) {                                                                        \
                const float aj = __builtin_bit_cast(float, __builtin_amdgcn_readlane(__builtin_bit_cast(int, act), j));            \
                const u32x4 vw = VBC[j];                                                                                           \
                typedef float f32x2_ __attribute__((ext_vector_type(2)));                                                          \
                const f32x2_ p0 = __builtin_amdgcn_cvt_pk_f32_fp8((int)vw.x, false), p1 = __builtin_amdgcn_cvt_pk_f32_fp8((int)vw.x, true); \
                const f32x2_ p2 = __builtin_amdgcn_cvt_pk_f32_fp8((int)vw.y, false), p3 = __builtin_amdgcn_cvt_pk_f32_fp8((int)vw.y, true); \
                const f32x2_ p4 = __builtin_amdgcn_cvt_pk_f32_fp8((int)vw.z, false), p5 = __builtin_amdgcn_cvt_pk_f32_fp8((int)vw.z, true); \
                const f32x2_ p6 = __builtin_amdgcn_cvt_pk_f32_fp8((int)vw.w, false), p7 = __builtin_amdgcn_cvt_pk_f32_fp8((int)vw.w, true); \
                acc[0] += (f32x4){p0[0], p0[1], p1[0], p1[1]} * aj; acc[1] += (f32x4){p2[0], p2[1], p3[0], p3[1]} * aj;             \
                acc[2] += (f32x4){p4[0], p4[1], p5[0], p5[1]} * aj; acc[3] += (f32x4){p6[0], p6[1], p7[0], p7[1]} * aj;             \
            }                                                                                                                      \
            __builtin_amdgcn_sched_barrier(0);                                                                                     \
        }
#pragma unroll 1
        for (int tp = 0; tp < 8; ++tp) {
            { const int tcur = 2 * tp; PEER_TILE(ub0, ec0, vb0, ec1, vb1) }
            { const int tcur = 2 * tp + 1; PEER_TILE(ub1, ec1, vb1, ec0, vb0) }
        }
#undef PEER_TILE
#else
        f32x4 acc[4];
#pragma unroll
        for (int i = 0; i < 4; ++i) acc[i] = (f32x4){0.f, 0.f, 0.f, 0.f};
        bf16x8 ubuf[32];
        int ec = eid[c]; float gc = egate[c];
        {
            const unsigned ub = O_UT + (unsigned)ec * 2048u + 16 * gq;
#pragma unroll
            for (int ks = 0; ks < 32; ++ks) ubuf[ks] = ldws<bf16x8>(W, ub + ks * 64);
        }
#pragma unroll 1
        for (int tile = 0; tile < 8; ++tile) {
            f32x4 d = {0.f, 0.f, 0.f, 0.f};
#pragma unroll
            for (int ks = 0; ks < 32; ++ks) d = __builtin_amdgcn_mfma_f32_16x16x32_bf16(*(const bf16x8*)(xl + ks * 32 + 8 * gq), ubuf[ks], d, 0, 0, 0);
            const float act = gelu_tanh(d[0] * rs) * gc;
            const int ecur = ec;
            if (tile < 7) {
                ec = eid[(tile + 1) * 16 + c]; gc = egate[(tile + 1) * 16 + c];
                const unsigned ub = O_UT + (unsigned)ec * 2048u + 16 * gq;
#pragma unroll
                for (int ks = 0; ks < 32; ++ks) ubuf[ks] = ldws<bf16x8>(W, ub + ks * 64);
            }
#pragma unroll
            for (int j = 0; j < 16; ++j) {
                const int ej = __builtin_amdgcn_readlane(ecur, j);
                const float aj = __builtin_bit_cast(float, __builtin_amdgcn_readlane(__builtin_bit_cast(int, act), j));
                const unsigned vb = O_VT + (unsigned)ej * 2048u + lane * 16;
                f32x4 v0, v1, v2, v3; unpack8(ldws<u32x4>(W, vb), v0, v1); unpack8(ldws<u32x4>(W, vb + 1024), v2, v3);
                acc[0] += v0 * aj; acc[1] += v1 * aj; acc[2] += v2 * aj; acc[3] += v3 * aj;
                if ((j & 3) == 3) __builtin_amdgcn_sched_barrier(0);
            }
        }
#endif
        float* hr = p.out + (size_t)row * DM;
        if (MODE == 1) { const float chk = acc[0][0] + acc[1][1] + acc[2][2] + acc[3][3]; if (chk == 1.2345678f) hr[lane] = chk; continue; }
        float ss = 0.f;
        {
            f32x4 h0, h1, h2, h3;
            unpack8(ldws<u32x4>(W, O_HG + (unsigned)row * 2048u + lane * 16), h0, h1); unpack8(ldws<u32x4>(W, O_HG + (unsigned)row * 2048u + 1024 + lane * 16), h2, h3);
            acc[0] += h0; acc[1] += h1; acc[2] += h2; acc[3] += h3;
        }
#pragma unroll
        for (int i = 0; i < 4; ++i) ss += acc[i][0] * acc[i][0] + acc[i][1] * acc[i][1] + acc[i][2] * acc[i][2] + acc[i][3] * acc[i][3];
        ss = wave_sum(ss);
        const float scl = rsqrtf(ss * (1.f / DM) + NORM_EPS);
        float* dst = hr;
        if (MODE == 2) { if (row >= 8192) continue; dst = WSP(float, 462) + (size_t)row * DM; }
#pragma unroll
        for (int cc = 0; cc < 2; ++cc) {
            const f32x4 ga = *(const f32x4*)(p.norm_f_g + cc * 512 + lane * 8), gb = *(const f32x4*)(p.norm_f_g + cc * 512 + lane * 8 + 4);
            *(f32x4*)(dst + cc * 512 + lane * 8) = acc[2 * cc] * scl * ga; *(f32x4*)(dst + cc * 512 + lane * 8 + 4) = acc[2 * cc + 1] * scl * gb;
        }
    }
}


__device__ __forceinline__ void phase_peer4(const Params& p, unsigned char* smem, int vcu, int G) {
    int tid_ = threadIdx.x; asm volatile("" : "+v"(tid_));
    const int wave = __builtin_amdgcn_readfirstlane(tid_ >> 6), lane = tid_ & 63;
    const int gq = lane >> 4, c = lane & 15;
    unsigned char* wbase = smem + wave * 8192;
    const unsigned char* W = p.ws;
    constexpr unsigned O_SC = WS_SCORES << 20, O_HG = WS_HG << 20, O_UT = WS_UTAB << 20, O_VT = WS_VTAB << 20;
    const float* rss = WSP(float, WS_RSS);
    const float* uscg = WSP(float, WS_USC); const float* vscg = WSP(float, WS_VSC);
    const int stride = G * NWAVES;
    int ca = 0, cb = 0;
    {
        int rem = lane; bool found = false;
#pragma unroll
        for (int a = 0; a < 16; ++a) { const int cnt = 16 / (a + 1); if (!found) { if (rem < cnt) { ca = a; cb = rem; found = true; } else rem -= cnt; } }
    }
    int row = vcu * NWAVES + wave;
    if (row >= MTOK) return;
    u32x4 xw0, xw1; float rssv = 0.f; unsigned sc0 = 0, sc1 = 0, sc2 = 0, sc3 = 0;
    int pend_i = -1; float pend_g = 0.f, pend_su = 0.f, pend_sv = 0.f;
#define NB_LV(B)  ((float*)((B) + 2048))
#define NB_LI(B)  ((int*)((B) + 2048 + 128))
#define NB_VS(B)  ((float*)((B) + 2048 + 256))
#define NB_IS(B)  ((int*)((B) + 2048 + 384))
#define NB_EID(B) ((int*)((B) + 2048 + 512))
#define NB_EG(B)  ((float*)((B) + 2048 + 1024))
#define NB_EU(B)  ((float*)((B) + 2048 + 1536))
#define TK_LOAD_X(R) { xw0 = ldws<u32x4>(W, O_HG + (unsigned)(R) * 2048u + lane * 16); xw1 = ldws<u32x4>(W, O_HG + (unsigned)(R) * 2048u + 1024 + lane * 16); rssv = lane < 16 ? rss[(size_t)(R) * 16 + lane] : 0.f; }
#define TK_LOAD_SC(R, H) { const unsigned so_ = O_SC + (unsigned)(R) * 4096u + (H) * 512 + lane * 2; sc0 = ldws<unsigned short>(W, so_); sc1 = ldws<unsigned short>(W, so_ + 128); sc2 = ldws<unsigned short>(W, so_ + 256); sc3 = ldws<unsigned short>(W, so_ + 384); }
#define TK_STAGE_X(B, RS) {                                                                                                        \
        RS = rsqrtf(wave_sum(rssv) * (1.f / DM) + NORM_EPS);                                                                       \
        f32x4 xa[4]; unpack8(xw0, xa[0], xa[1]); unpack8(xw1, xa[2], xa[3]);                                                        \
        xa[0] *= *(const f32x4*)(p.norm2_g + lane * 8); xa[1] *= *(const f32x4*)(p.norm2_g + lane * 8 + 4); xa[2] *= *(const f32x4*)(p.norm2_g + 512 + lane * 8); xa[3] *= *(const f32x4*)(p.norm2_g + 512 + lane * 8 + 4); \
        unsigned hw[4], lw[4];                                                                                                     \
        _Pragma("unroll") for (int i = 0; i < 4; ++i) {                                                                            \
            const f32x4 xs = xa[i] * 16.f;                                                                                         \
            int h_ = __builtin_amdgcn_cvt_pk_fp8_f32(xs[0], xs[1], 0, false); h_ = __builtin_amdgcn_cvt_pk_fp8_f32(xs[2], xs[3], h_, true); \
            const f32x2_t b0 = __builtin_amdgcn_cvt_pk_f32_fp8(h_, false), b1 = __builtin_amdgcn_cvt_pk_f32_fp8(h_, true);         \
            int l_ = __builtin_amdgcn_cvt_pk_fp8_f32((xs[0] - b0[0]) * 16.f, (xs[1] - b0[1]) * 16.f, 0, false); l_ = __builtin_amdgcn_cvt_pk_fp8_f32((xs[2] - b1[0]) * 16.f, (xs[3] - b1[1]) * 16.f, l_, true); \
            hw[i] = (unsigned)h_; lw[i] = (unsigned)l_;                                                                            \
        }                                                                                                                          \
        *(uint2*)((B) + lane * 8) = make_uint2(hw[0], hw[1]); *(uint2*)((B) + 512 + lane * 8) = make_uint2(hw[2], hw[3]);          \
        *(uint2*)((B) + 1024 + lane * 8) = make_uint2(lw[0], lw[1]); *(uint2*)((B) + 1536 + lane * 8) = make_uint2(lw[2], lw[3]);  \
    }
#define TK_K16(hb) ((((unsigned)(hb) & 0x8000u) ? (~(unsigned)(hb) & 0xffffu) : ((unsigned)(hb) | 0x8000u)) << 16)
#define TK_PART_A(B) {                                                                                                             \
        const float a0 = (float)__builtin_bit_cast(_Float16, (unsigned short)sc0), a1 = (float)__builtin_bit_cast(_Float16, (unsigned short)sc1); \
        const float b0 = (float)__builtin_bit_cast(_Float16, (unsigned short)sc2), b1 = (float)__builtin_bit_cast(_Float16, (unsigned short)sc3); \
        const unsigned ka0 = TK_K16(sc0) | (0xFFFFu - (unsigned)lane), ka1 = TK_K16(sc1) | (0xFFFFu - 64u - (unsigned)lane);       \
        const unsigned kb0 = TK_K16(sc2) | (0xFFFFu - (unsigned)lane), kb1 = TK_K16(sc3) | (0xFFFFu - 64u - (unsigned)lane);       \
        unsigned long long loA = 0, hiA = 1ull << 32, loB = 0, hiB = 1ull << 32; bool doneA = false, doneB = false;                 \
        while (!(doneA && doneB)) {                                                                                                \
            if (!doneA) { const unsigned mid = (unsigned)((loA + hiA) >> 1); const int cnt = __builtin_popcountll(__ballot(ka0 >= mid)) + __builtin_popcountll(__ballot(ka1 >= mid)); \
                if (cnt >= 16) loA = mid; else hiA = mid; doneA = (cnt == 16) || (hiA - loA <= 1); }                                \
            if (!doneB) { const unsigned mid = (unsigned)((loB + hiB) >> 1); const int cnt = __builtin_popcountll(__ballot(kb0 >= mid)) + __builtin_popcountll(__ballot(kb1 >= mid)); \
                if (cnt >= 16) loB = mid; else hiB = mid; doneB = (cnt == 16) || (hiB - loB <= 1); }                                \
        }                                                                                                                          \
        float* lv = NB_LV(B); int* li = NB_LI(B);                                                                                  \
        { const unsigned T = (unsigned)loA; const bool k0 = ka0 >= T, k1 = ka1 >= T; const unsigned long long s0 = __ballot(k0), s1 = __ballot(k1); \
          if (k0) { const int pos = mbcnt64(s0); lv[pos] = a0; li[pos] = lane; }                                                    \
          if (k1) { const int pos = __builtin_popcountll(s0) + mbcnt64(s1); if (pos < 16) { lv[pos] = a1; li[pos] = lane + 64; } } } \
        { const unsigned T = (unsigned)loB; const bool k0 = kb0 >= T, k1 = kb1 >= T; const unsigned long long s0 = __ballot(k0), s1 = __ballot(k1); \
          if (k0) { const int pos = mbcnt64(s0); lv[16 + pos] = b0; li[16 + pos] = lane; }                                           \
          if (k1) { const int pos = __builtin_popcountll(s0) + mbcnt64(s1); if (pos < 16) { lv[16 + pos] = b1; li[16 + pos] = lane + 64; } } } \
        __builtin_amdgcn_s_waitcnt(0xC07F); __builtin_amdgcn_wave_barrier();                                                       \
    }
#define TK_PART_B(B, H, RS) {                                                                                                      \
        float* lv = NB_LV(B); int* li = NB_LI(B); float* vs = NB_VS(B); int* is_ = NB_IS(B);                                        \
        if (lane < 32) { const int base = lane & 16, me = lane & 15; const float mv = lv[lane]; int rk = 0;                         \
            _Pragma("unroll") for (int j = 0; j < 16; ++j) { const float x = lv[base + j]; rk += (x > mv) || (x == mv && j < me); } \
            vs[base + rk] = mv; is_[base + rk] = li[lane]; }                                                                       \
        __builtin_amdgcn_s_waitcnt(0xC07F); __builtin_amdgcn_wave_barrier();                                                       \
        float cv = 0.f; unsigned kc = 0u;                                                                                          \
        if (lane < 50) { cv = vs[ca] + vs[16 + cb]; kc = fkey(cv); }                                                                \
        unsigned long long lo = fkey(vs[15] + vs[31]), hi = (unsigned long long)fkey(vs[0] + vs[16]) + 1ull;                        \
        while (hi - lo > 1) { const unsigned mid = (unsigned)((lo + hi) >> 1); const int cnt = __builtin_popcountll(__ballot(kc >= mid)); \
            if (cnt >= 16) lo = mid; else hi = mid; if (cnt == 16) break; }                                                        \
        const unsigned T2 = (unsigned)lo; const unsigned long long tm = __ballot(kc == T2);                                        \
        const int need2 = 16 - __builtin_popcountll(__ballot(kc > T2));                                                            \
        const bool take = (kc > T2) || (kc == T2 && mbcnt64(tm) < need2);                                                          \
        const float sv_ = take ? cv * (RS) : -3e38f; const float mx = wave_max(sv_);                                               \
        const float ev = take ? __expf(sv_ - mx) : 0.f; const float sm = wave_sum(ev);                                             \
        pend_i = -1;                                                                                                               \
        if (take) { const int pos = mbcnt64(__ballot(take)); if (pos < 16) { const int e_ = is_[ca] * PEER_KEYS + is_[16 + cb];     \
            NB_EID(B)[(H) * 16 + pos] = e_; pend_i = (H) * 16 + pos; pend_g = ev / sm; pend_su = uscg[e_]; pend_sv = vscg[e_]; } }    \
        __builtin_amdgcn_wave_barrier();                                                                                           \
    }
#define TK_FLUSH(B) { if (pend_i >= 0) { NB_EG(B)[pend_i] = pend_g * pend_sv; NB_EU(B)[pend_i] = pend_su; } pend_i = -1; }
    float rs_cur = 0.f, rs_n = 0.f;
    {
        unsigned char* B0 = wbase;
        TK_LOAD_X(row) TK_STAGE_X(B0, rs_cur)
#pragma unroll 1
        for (int h = 0; h < PEER_H; ++h) { TK_FLUSH(B0) TK_LOAD_SC(row, h) TK_PART_A(B0) TK_PART_B(B0, h, rs_cur) }
        TK_FLUSH(B0)
        __builtin_amdgcn_s_waitcnt(0xC07F); __builtin_amdgcn_wave_barrier();
    }
#pragma unroll 1
    for (int it = 0;; ++it) {
        unsigned char* wsm = wbase + (it & 1) * 4096;
        unsigned char* nb = wbase + ((it + 1) & 1) * 4096;
        const int* eid = NB_EID(wsm); const float* egate = NB_EG(wsm); const float* eusc = NB_EU(wsm);
        const float rs = rs_cur;
        const int nrow_raw = row + stride;
        const int nrow = nrow_raw < MTOK ? nrow_raw : row;
        TK_LOAD_X(nrow) TK_LOAD_SC(nrow, 0)
        f32x4 acc[4];
#pragma unroll
        for (int i = 0; i < 4; ++i) acc[i] = (f32x4){0.f, 0.f, 0.f, 0.f};
        const unsigned koff = (unsigned)((c >> 3) * 64 + 16 * gq);
        u32x4 ub0[8], ub1[8], vb0[8], vb1[8];
        int ec0 = eid[c & 7], ec1 = eid[8 + (c & 7)];
#pragma unroll
        for (int k3 = 0; k3 < 8; ++k3) ub0[k3] = ldws<u32x4>(W, O_UT + (unsigned)ec0 * 1024u + koff + k3 * 128);
#pragma unroll
        for (int j = 0; j < 8; ++j) vb0[j] = ldws<u32x4>(W, O_VT + (unsigned)__builtin_amdgcn_readlane(ec0, j) * 1024u + lane * 16);
#pragma unroll
        for (int k3 = 0; k3 < 8; ++k3) ub1[k3] = ldws<u32x4>(W, O_UT + (unsigned)ec1 * 1024u + koff + k3 * 128);
#define PEER_TILE(UB, EC, VBC, ECN, VBN)                                                                                           \
        {                                                                                                                          \
            f32x4 dh = {0.f, 0.f, 0.f, 0.f}, dl = {0.f, 0.f, 0.f, 0.f};                                                             \
            _Pragma("unroll") for (int k3 = 0; k3 < 8; ++k3) {                                                                     \
                const u32x4 xh = *(const u32x4*)(wsm + k3 * 128 + koff), xlo = *(const u32x4*)(wsm + 1024 + k3 * 128 + koff);      \
                const long u0 = (long)(((unsigned long long)UB[k3].y << 32) | UB[k3].x), u1 = (long)(((unsigned long long)UB[k3].w << 32) | UB[k3].z); \
                const long h0 = (long)(((unsigned long long)xh.y << 32) | xh.x), h1 = (long)(((unsigned long long)xh.w << 32) | xh.z);  \
                const long l0 = (long)(((unsigned long long)xlo.y << 32) | xlo.x), l1 = (long)(((unsigned long long)xlo.w << 32) | xlo.z); \
                dh = __builtin_amdgcn_mfma_f32_16x16x32_fp8_fp8(h0, u0, dh, 0, 0, 0);                                              \
                dh = __builtin_amdgcn_mfma_f32_16x16x32_fp8_fp8(h1, u1, dh, 0, 0, 0);                                              \
                dl = __builtin_amdgcn_mfma_f32_16x16x32_fp8_fp8(l0, u0, dl, 0, 0, 0);                                              \
                dl = __builtin_amdgcn_mfma_f32_16x16x32_fp8_fp8(l1, u1, dl, 0, 0, 0);                                              \
            }                                                                                                                      \
            float mine = dh[0] + dl[0] * (1.f / 16.f);                                                                             \
            mine += __shfl_xor(mine, 40);                                                       \
            const float act = gelu_tanh(mine * (1.f / 16.f) * eusc[tcur * 8 + (c & 7)] * rs) * egate[tcur * 8 + (c & 7)];           \
            if (tcur + 2 < 16) {                                                                                                   \
                EC = eid[(tcur + 2) * 8 + (c & 7)];                                                                                \
                _Pragma("unroll") for (int k3 = 0; k3 < 8; ++k3) UB[k3] = ldws<u32x4>(W, O_UT + (unsigned)EC * 1024u + koff + k3 * 128); \
            }                                                                                                                      \
            if (tcur + 1 < 16) {                                                                                                   \
                _Pragma("unroll") for (int j = 0; j < 8; ++j) VBN[j] = ldws<u32x4>(W, O_VT + (unsigned)__builtin_amdgcn_readlane(ECN, j) * 1024u + lane * 16); \
            }                                                                                                                      \
            __builtin_amdgcn_sched_barrier(0);                                                                                     \
            _Pragma("unroll") for (int j = 0; j < 8; ++j) {                                                                        \
                const float aj = __builtin_bit_cast(float, __builtin_amdgcn_readlane(__builtin_bit_cast(int, act), j));            \
                const u32x4 vw = VBC[j];                                                                                           \
                const f32x2_t p0 = __builtin_amdgcn_cvt_pk_f32_fp8((int)vw.x, false), p1 = __builtin_amdgcn_cvt_pk_f32_fp8((int)vw.x, true); \
                const f32x2_t p2 = __builtin_amdgcn_cvt_pk_f32_fp8((int)vw.y, false), p3 = __builtin_amdgcn_cvt_pk_f32_fp8((int)vw.y, true); \
                const f32x2_t p4 = __builtin_amdgcn_cvt_pk_f32_fp8((int)vw.z, false), p5 = __builtin_amdgcn_cvt_pk_f32_fp8((int)vw.z, true); \
                const f32x2_t p6 = __builtin_amdgcn_cvt_pk_f32_fp8((int)vw.w, false), p7 = __builtin_amdgcn_cvt_pk_f32_fp8((int)vw.w, true); \
                acc[0] += (f32x4){p0[0], p0[1], p1[0], p1[1]} * aj; acc[1] += (f32x4){p2[0], p2[1], p3[0], p3[1]} * aj;             \
                acc[2] += (f32x4){p4[0], p4[1], p5[0], p5[1]} * aj; acc[3] += (f32x4){p6[0], p6[1], p7[0], p7[1]} * aj;             \
            }                                                                                                                      \
            __builtin_amdgcn_sched_barrier(0);                                                                                     \
        }
#pragma unroll 1
        for (int tp = 0; tp < 8; ++tp) {
            { const int tcur = 2 * tp; PEER_TILE(ub0, ec0, vb0, ec1, vb1) }
            if (tp == 0) { TK_STAGE_X(nb, rs_n) }
            TK_FLUSH(nb)
            TK_PART_A(nb)
            __builtin_amdgcn_sched_barrier(0);
            { const int tcur = 2 * tp + 1; PEER_TILE(ub1, ec1, vb1, ec0, vb0) }
            TK_PART_B(nb, tp, rs_n)
            { const int hn = tp < 7 ? tp + 1 : 7; TK_LOAD_SC(nrow, hn) }
            __builtin_amdgcn_sched_barrier(0);
        }
#undef PEER_TILE
        TK_FLUSH(nb)
        float* hr = p.out + (size_t)row * DM;
        float ss = 0.f;
        {
            f32x4 h0, h1, h2, h3;
            unpack8(ldws<u32x4>(W, O_HG + (unsigned)row * 2048u + lane * 16), h0, h1); unpack8(ldws<u32x4>(W, O_HG + (unsigned)row * 2048u + 1024 + lane * 16), h2, h3);
            acc[0] += h0; acc[1] += h1; acc[2] += h2; acc[3] += h3;
        }
#pragma unroll
        for (int i = 0; i < 4; ++i) ss += acc[i][0] * acc[i][0] + acc[i][1] * acc[i][1] + acc[i][2] * acc[i][2] + acc[i][3] * acc[i][3];
        ss = wave_sum(ss);
        const float scl = rsqrtf(ss * (1.f / DM) + NORM_EPS);
#pragma unroll
        for (int cc = 0; cc < 2; ++cc) {
            const f32x4 ga = *(const f32x4*)(p.norm_f_g + cc * 512 + lane * 8), gb = *(const f32x4*)(p.norm_f_g + cc * 512 + lane * 8 + 4);
            *(f32x4*)(hr + cc * 512 + lane * 8) = acc[2 * cc] * scl * ga; *(f32x4*)(hr + cc * 512 + lane * 8 + 4) = acc[2 * cc + 1] * scl * gb;
        }
        __builtin_amdgcn_s_waitcnt(0xC07F); __builtin_amdgcn_wave_barrier();
        if (nrow_raw >= MTOK) break;
        row = nrow_raw; rs_cur = rs_n;
    }
#undef TK_FLUSH
#undef TK_PART_B
#undef TK_PART_A
#undef TK_K16
#undef TK_STAGE_X
#undef TK_LOAD_SC
#undef TK_LOAD_X
}

struct __attribute__((packed, aligned(4))) U3 { unsigned a, b, c; };
typedef int v8i32_t __attribute__((ext_vector_type(8)));
typedef int v6i32_t __attribute__((ext_vector_type(6)));
typedef float v32f32_t __attribute__((ext_vector_type(32)));
template <bool NOTK>
__device__ __forceinline__ void phase_peer6(const Params& p, unsigned char* smem, int vcu, int G) {
    int tid_ = threadIdx.x; asm volatile("" : "+v"(tid_));
    const int wave = __builtin_amdgcn_readfirstlane(tid_ >> 6), lane = tid_ & 63;
    const int gq = lane >> 4, c = lane & 15;
    unsigned char* wbase = smem + wave * 8192;
    const unsigned char* W = p.ws;
    constexpr unsigned O_SC = WS_SCORES << 20, O_HG = WS_HG << 20, O_UT = WS_UTAB << 20, O_VT = WS_VTAB << 20;
    const float* rss = WSP(float, WS_RSS);
    const float* uscg = WSP(float, WS_USC); const float* vscg = WSP(float, WS_VSC);
    const int stride = G * NWAVES;
    int ca = 0, cb = 0;
    {
        int rem = lane; bool found = false;
#pragma unroll
        for (int a = 0; a < 16; ++a) { const int cnt = 16 / (a + 1); if (!found) { if (rem < cnt) { ca = a; cb = rem; found = true; } else rem -= cnt; } }
    }
    int row = vcu * NWAVES + wave;
    if (row >= MTOK) return;
    u32x4 xw0, xw1; float rssv = 0.f; unsigned sc0 = 0, sc1 = 0, sc2 = 0, sc3 = 0;
    int pend_i = -1; float pend_g = 0.f, pend_su = 0.f, pend_sv = 0.f;
#define NB_LV(B)  ((float*)((B) + 2048))
#define NB_LI(B)  ((int*)((B) + 2048 + 128))
#define NB_VS(B)  ((float*)((B) + 2048 + 256))
#define NB_IS(B)  ((int*)((B) + 2048 + 384))
#define NB_EID(B) ((int*)((B) + 2048 + 512))
#define NB_EG(B)  ((float*)((B) + 2048 + 1024))
#define NB_EU(B)  ((float*)((B) + 2048 + 1536))
#define TK_LOAD_X(R) { xw0 = ldws<u32x4>(W, O_HG + (unsigned)(R) * 2048u + lane * 16); xw1 = ldws<u32x4>(W, O_HG + (unsigned)(R) * 2048u + 1024 + lane * 16); rssv = lane < 16 ? rss[(size_t)(R) * 16 + lane] : 0.f; }
#define TK_LOAD_SC(R, H) { const unsigned so_ = O_SC + (unsigned)(R) * 4096u + (H) * 512 + lane * 2; sc0 = ldws<unsigned short>(W, so_); sc1 = ldws<unsigned short>(W, so_ + 128); sc2 = ldws<unsigned short>(W, so_ + 256); sc3 = ldws<unsigned short>(W, so_ + 384); }
#define TK_STAGE_X(B, RS) {                                                                                                        \
        RS = rsqrtf(wave_sum(rssv) * (1.f / DM) + NORM_EPS);                                                                       \
        f32x4 xa[4]; unpack8(xw0, xa[0], xa[1]); unpack8(xw1, xa[2], xa[3]);                                                        \
        xa[0] *= *(const f32x4*)(p.norm2_g + lane * 8); xa[1] *= *(const f32x4*)(p.norm2_g + lane * 8 + 4); xa[2] *= *(const f32x4*)(p.norm2_g + 512 + lane * 8); xa[3] *= *(const f32x4*)(p.norm2_g + 512 + lane * 8 + 4); \
        unsigned hw[4], lw[4];                                                                                                     \
        _Pragma("unroll") for (int i = 0; i < 4; ++i) {                                                                            \
            const f32x4 xs = xa[i] * 16.f;                                                                                         \
            int h_ = __builtin_amdgcn_cvt_pk_fp8_f32(xs[0], xs[1], 0, false); h_ = __builtin_amdgcn_cvt_pk_fp8_f32(xs[2], xs[3], h_, true); \
            const f32x2_t b0 = __builtin_amdgcn_cvt_pk_f32_fp8(h_, false), b1 = __builtin_amdgcn_cvt_pk_f32_fp8(h_, true);         \
            int l_ = __builtin_amdgcn_cvt_pk_fp8_f32((xs[0] - b0[0]) * 16.f, (xs[1] - b0[1]) * 16.f, 0, false); l_ = __builtin_amdgcn_cvt_pk_fp8_f32((xs[2] - b1[0]) * 16.f, (xs[3] - b1[1]) * 16.f, l_, true); \
            hw[i] = (unsigned)h_; lw[i] = (unsigned)l_;                                                                            \
        }                                                                                                                          \
                                                                                                       \
        const int xo_ = PEER_U6 == 1 ? ((lane >> 2) & 3) * 256 + (2 * ((lane >> 4) & 1) + ((lane >> 1) & 1)) * 32 + ((lane >> 5) & 1) * 16 + (lane & 1) * 8 \
                      : PEER_U6 == 2 ? ((lane >> 2) & 3) * 256 + (lane >> 4) * 32 + (lane & 3) * 8 : lane * 8;                       \
        const int xo2_ = xo_ + (PEER_U6 ? 128 : 512);                                                                              \
        *(uint2*)((B) + xo_) = make_uint2(hw[0], hw[1]); *(uint2*)((B) + xo2_) = make_uint2(hw[2], hw[3]);                          \
        *(uint2*)((B) + 1024 + xo_) = make_uint2(lw[0], lw[1]); *(uint2*)((B) + 1024 + xo2_) = make_uint2(lw[2], lw[3]);            \
    }
#define TK_K16(hb) ((((unsigned)(hb) & 0x8000u) ? (~(unsigned)(hb) & 0xffffu) : ((unsigned)(hb) | 0x8000u)) << 16)
#define TK_PART_A(B) {                                                                                                             \
        const unsigned ka0 = TK_K16(sc0) | (0xFFFFu - (unsigned)lane), ka1 = TK_K16(sc1) | (0xFFFFu - 64u - (unsigned)lane);       \
        const unsigned kb0 = TK_K16(sc2) | (0xFFFFu - (unsigned)lane), kb1 = TK_K16(sc3) | (0xFFFFu - 64u - (unsigned)lane);       \
          \
        unsigned loA = 0u, hiA = 0xFFFFFFFFu, loB = 0u, hiB = 0xFFFFFFFFu; bool doneA = false, doneB = false;                       \
        while (!(doneA && doneB)) {                                                                                                \
            const unsigned midA = loA + ((hiA - loA) >> 1), midB = loB + ((hiB - loB) >> 1);                                        \
            const int cntA = __builtin_popcountll(__ballot(ka0 >= midA)) + __builtin_popcountll(__ballot(ka1 >= midA));             \
            const int cntB = __builtin_popcountll(__ballot(kb0 >= midB)) + __builtin_popcountll(__ballot(kb1 >= midB));             \
              \
            loA = cntA >= 16 ? midA : loA; hiA = cntA >= 16 ? hiA : midA; doneA = doneA || (cntA == 16);                            \
            loB = cntB >= 16 ? midB : loB; hiB = cntB >= 16 ? hiB : midB; doneB = doneB || (cntB == 16);                            \
        }                                                                                                                          \
           \
        unsigned* lk = (unsigned*)NB_LV(B);                                                                                        \
        { const unsigned T = loA; const bool k0 = ka0 >= T, k1 = ka1 >= T; const unsigned long long s0 = __ballot(k0), s1 = __ballot(k1); \
          if (k0) { lk[mbcnt64(s0)] = ka0; }                                                                                       \
          if (k1) { const int pos = __builtin_popcountll(s0) + mbcnt64(s1); if (pos < 16) lk[pos] = ka1; } }                        \
        { const unsigned T = loB; const bool k0 = kb0 >= T, k1 = kb1 >= T; const unsigned long long s0 = __ballot(k0), s1 = __ballot(k1); \
          if (k0) { lk[16 + mbcnt64(s0)] = kb0; }                                                                                  \
          if (k1) { const int pos = __builtin_popcountll(s0) + mbcnt64(s1); if (pos < 16) lk[16 + pos] = kb1; } }                   \
        __builtin_amdgcn_s_waitcnt(0xC07F); __builtin_amdgcn_wave_barrier();                                                       \
    }
#define TK_PART_B(B, H, RS) {                                                                                                      \
        const unsigned* lk = (const unsigned*)NB_LV(B); float* vs = NB_VS(B); int* is_ = NB_IS(B);                                  \
        if (lane < 32) { const int base = lane & 16; const unsigned mk = lk[lane]; int rk = 0;         \
            _Pragma("unroll") for (int j = 0; j < 16; ++j) rk += (lk[base + j] > mk) ? 1 : 0;                                       \
            const unsigned k16 = mk >> 16, hb = (k16 & 0x8000u) ? (k16 & 0x7fffu) : (~k16 & 0xffffu);                               \
            vs[base + rk] = (float)__builtin_bit_cast(_Float16, (unsigned short)hb); is_[base + rk] = (int)(0xFFFFu - (mk & 0xFFFFu)); } \
        __builtin_amdgcn_s_waitcnt(0xC07F); __builtin_amdgcn_wave_barrier();                                                       \
        float cv = 0.f; unsigned kc = 0u;                                                                                          \
        if (lane < 50) { cv = vs[ca] + vs[16 + cb]; kc = fkey(cv); }                                                                \
        const float top_ = vs[0] + vs[16];                           \
        unsigned lo = fkey(vs[15] + vs[31]), hi = fkey(top_) + 1u; bool fin_ = false;                                               \
        do { const unsigned mid = lo + ((hi - lo) >> 1); const int cnt = __builtin_popcountll(__ballot(kc >= mid));                 \
             lo = cnt >= 16 ? mid : lo; hi = cnt >= 16 ? hi : mid; fin_ = (cnt == 16) || (hi - lo <= 1u); } while (!fin_);          \
        const unsigned T2 = lo; const unsigned long long tm = __ballot(kc == T2);                                                  \
        const int need2 = 16 - __builtin_popcountll(__ballot(kc > T2));                                                            \
        const bool take = (kc > T2) || (kc == T2 && mbcnt64(tm) < need2);                                                          \
        const float ev = take ? __expf((cv - top_) * (RS)) : 0.f; const float sm = wave_sum(ev);                                    \
        pend_i = -1;                                                                                                               \
        if (take) { const int pos = mbcnt64(__ballot(take)); if (pos < 16) { const int e_ = is_[ca] * PEER_KEYS + is_[16 + cb];     \
            NB_EID(B)[(H) * 16 + pos] = e_; pend_i = (H) * 16 + pos; pend_g = ev * __builtin_amdgcn_rcpf(sm); pend_su = uscg[e_]; pend_sv = vscg[e_]; } } \
        __builtin_amdgcn_wave_barrier();                                                                                           \
    }
#define TK_FLUSH(B) { if (pend_i >= 0) { NB_EG(B)[pend_i] = pend_g * pend_sv; NB_EU(B)[pend_i] = pend_su; } pend_i = -1; }
    float rs_cur = 0.f, rs_n = 0.f;
    {
        unsigned char* B0 = wbase;
        TK_LOAD_X(row) TK_STAGE_X(B0, rs_cur)
#pragma unroll 1
        for (int h = 0; h < PEER_H; ++h) { TK_FLUSH(B0) TK_LOAD_SC(row, h) TK_PART_A(B0) TK_PART_B(B0, h, rs_cur) }
        TK_FLUSH(B0)
        __builtin_amdgcn_s_waitcnt(0xC07F); __builtin_amdgcn_wave_barrier();
    }
#if PEER_U6 == 1
        const unsigned koff = (unsigned)((c >> 3) * 64 + gq * 16);
        const unsigned xoff = (unsigned)(((c >> 3) * 4 + gq) * 32);
        constexpr int NUB = 6;
#define U_LOAD(UB, E_) { _Pragma("unroll") for (int k3 = 0; k3 < 6; ++k3) UB[k3] = ldws<u32x4>(W + O_UT + k3 * 128, (unsigned)(E_) + koff); }
#define UBD(UB, i) ((int)UB[(i) >> 2][(i) & 3])
#define U_DOT(UB)                                                                                                                  \
            _Pragma("unroll") for (int ks = 0; ks < 4; ++ks) {                                                                     \
                const u32x4 xh0 = *(const u32x4*)(wsm + ks * 256 + xoff), xh1 = *(const u32x4*)(wsm + ks * 256 + xoff + 16);       \
                const u32x4 xl0 = *(const u32x4*)(wsm + 1024 + ks * 256 + xoff), xl1 = *(const u32x4*)(wsm + 1024 + ks * 256 + xoff + 16); \
                const v8i32_t xa = {(int)xh0.x, (int)xh0.y, (int)xh0.z, (int)xh0.w, (int)xh1.x, (int)xh1.y, (int)xh1.z, (int)xh1.w}; \
                const v8i32_t xb = {(int)xl0.x, (int)xl0.y, (int)xl0.z, (int)xl0.w, (int)xl1.x, (int)xl1.y, (int)xl1.z, (int)xl1.w}; \
                const v8i32_t uw = {UBD(UB, 6 * ks), UBD(UB, 6 * ks + 1), UBD(UB, 6 * ks + 2), UBD(UB, 6 * ks + 3), UBD(UB, 6 * ks + 4), UBD(UB, 6 * ks + 5), 0, 0}; \
                dh = __builtin_amdgcn_mfma_scale_f32_16x16x128_f8f6f4(xa, uw, dh, 0, 2, 0, 0x7F7F7F7F, 0, 0x7F7F7F7F);              \
                dl = __builtin_amdgcn_mfma_scale_f32_16x16x128_f8f6f4(xb, uw, dl, 0, 2, 0, 0x7F7F7F7F, 0, 0x7F7F7F7F);              \
            }
#elif PEER_U6 == 2
        const unsigned koff = (unsigned)((c >> 3) * 512 + gq * 128);
        const unsigned xoff = (unsigned)(((c >> 3) * 4 + gq) * 32);
        constexpr int NUB = 8;
#define U_LOAD(UB, E_) { _Pragma("unroll") for (int k3 = 0; k3 < 8; ++k3) UB[k3] = ldws<u32x4>(W, O_UT + (unsigned)(E_) * 1024u + koff + k3 * 16); }
#define U_DOT(UB)                                                                                                                  \
            _Pragma("unroll") for (int ks = 0; ks < 4; ++ks) {                                                                     \
                const u32x4 xh0 = *(const u32x4*)(wsm + ks * 256 + xoff), xh1 = *(const u32x4*)(wsm + ks * 256 + xoff + 16);       \
                const u32x4 xl0 = *(const u32x4*)(wsm + 1024 + ks * 256 + xoff), xl1 = *(const u32x4*)(wsm + 1024 + ks * 256 + xoff + 16); \
                const v8i32_t xa = {(int)xh0.x, (int)xh0.y, (int)xh0.z, (int)xh0.w, (int)xh1.x, (int)xh1.y, (int)xh1.z, (int)xh1.w}; \
                const v8i32_t xb = {(int)xl0.x, (int)xl0.y, (int)xl0.z, (int)xl0.w, (int)xl1.x, (int)xl1.y, (int)xl1.z, (int)xl1.w}; \
                const v8i32_t uw = {(int)UB[2 * ks].x, (int)UB[2 * ks].y, (int)UB[2 * ks].z, (int)UB[2 * ks].w, (int)UB[2 * ks + 1].x, (int)UB[2 * ks + 1].y, (int)UB[2 * ks + 1].z, (int)UB[2 * ks + 1].w}; \
                dh = __builtin_amdgcn_mfma_scale_f32_16x16x128_f8f6f4(xa, uw, dh, 0, 0, 0, 0x7F7F7F7F, 0, 0x7F7F7F7F);              \
                dl = __builtin_amdgcn_mfma_scale_f32_16x16x128_f8f6f4(xb, uw, dl, 0, 0, 0, 0x7F7F7F7F, 0, 0x7F7F7F7F);              \
            }
#else
        const unsigned koff = (unsigned)((c >> 3) * 64 + 16 * gq);
        constexpr int NUB = 8;
#define U_LOAD(UB, E_) { _Pragma("unroll") for (int k3 = 0; k3 < 8; ++k3) UB[k3] = ldws<u32x4>(W, O_UT + (unsigned)(E_) * 1024u + koff + k3 * 128); }
#define U_DOT(UB)                                                                                                                  \
            _Pragma("unroll") for (int k3 = 0; k3 < 8; ++k3) {                                                                     \
                const u32x4 xh = *(const u32x4*)(wsm + k3 * 128 + koff), xlo = *(const u32x4*)(wsm + 1024 + k3 * 128 + koff);      \
                const long u0 = (long)(((unsigned long long)UB[k3].y << 32) | UB[k3].x), u1 = (long)(((unsigned long long)UB[k3].w << 32) | UB[k3].z); \
                const long h0 = (long)(((unsigned long long)xh.y << 32) | xh.x), h1 = (long)(((unsigned long long)xh.w << 32) | xh.z);  \
                const long l0 = (long)(((unsigned long long)xlo.y << 32) | xlo.x), l1 = (long)(((unsigned long long)xlo.w << 32) | xlo.z); \
                dh = __builtin_amdgcn_mfma_f32_16x16x32_fp8_fp8(h0, u0, dh, 0, 0, 0);                                              \
                dh = __builtin_amdgcn_mfma_f32_16x16x32_fp8_fp8(h1, u1, dh, 0, 0, 0);                                              \
                dl = __builtin_amdgcn_mfma_f32_16x16x32_fp8_fp8(l0, u0, dl, 0, 0, 0);                                              \
                dl = __builtin_amdgcn_mfma_f32_16x16x32_fp8_fp8(l1, u1, dl, 0, 0, 0);                                              \
            }
#endif
#if PEER_V6
        typedef U3 vb_t;
#define V_LOAD(VB, ESRC) { _Pragma("unroll") for (int j = 0; j < 8; ++j) VB[j] = ldws<U3>(W + O_VT, (unsigned)__builtin_amdgcn_readlane(ESRC, j) + lane * 12); }
#define V_ACC(VBC)                                                                                                                 \
            _Pragma("unroll") for (int jp = 0; jp < 4; ++jp) {                                                                     \
                const float a0_ = __builtin_bit_cast(float, __builtin_amdgcn_readlane(__builtin_bit_cast(int, act), 2 * jp));      \
                const float a1_ = __builtin_bit_cast(float, __builtin_amdgcn_readlane(__builtin_bit_cast(int, act), 2 * jp + 1));  \
                const v6i32_t sv_ = {(int)VBC[2 * jp].a, (int)VBC[2 * jp].b, (int)VBC[2 * jp].c, (int)VBC[2 * jp + 1].a, (int)VBC[2 * jp + 1].b, (int)VBC[2 * jp + 1].c}; \
                const v32f32_t f_ = __builtin_amdgcn_cvt_scalef32_pk32_f32_fp6(sv_, 1.0f);                                         \
                _Pragma("unroll") for (int q_ = 0; q_ < 4; ++q_) {                                                                 \
                    acc[q_] += (f32x4){f_[4 * q_], f_[4 * q_ + 1], f_[4 * q_ + 2], f_[4 * q_ + 3]} * a0_;                           \
                    acc[q_] += (f32x4){f_[16 + 4 * q_], f_[16 + 4 * q_ + 1], f_[16 + 4 * q_ + 2], f_[16 + 4 * q_ + 3]} * a1_;       \
                }                                                                                                                  \
            }
#else
        typedef u32x4 vb_t;
#define V_LOAD(VB, ESRC) { _Pragma("unroll") for (int j = 0; j < 8; ++j) VB[j] = ldws<u32x4>(W, O_VT + (unsigned)__builtin_amdgcn_readlane(ESRC, j) * 1024u + lane * 16); }
#define V_LOAD_H(VB, ESRC, J0) { _Pragma("unroll") for (int j = J0; j < J0 + 4; ++j) VB[j] = ldws<u32x4>(W, O_VT + (unsigned)__builtin_amdgcn_readlane(ESRC, j) * 1024u + lane * 16); }
#define V_ACC(VBC)                                                                                                                 \
            _Pragma("unroll") for (int j = 0; j < 8; ++j) {                                                                        \
                const float aj = __builtin_bit_cast(float, __builtin_amdgcn_readlane(__builtin_bit_cast(int, act), j));            \
                const u32x4 vw = VBC[j];                                                                                           \
                const f32x2_t p0 = __builtin_amdgcn_cvt_pk_f32_fp8((int)vw.x, false), p1 = __builtin_amdgcn_cvt_pk_f32_fp8((int)vw.x, true); \
                const f32x2_t p2 = __builtin_amdgcn_cvt_pk_f32_fp8((int)vw.y, false), p3 = __builtin_amdgcn_cvt_pk_f32_fp8((int)vw.y, true); \
                const f32x2_t p4 = __builtin_amdgcn_cvt_pk_f32_fp8((int)vw.z, false), p5 = __builtin_amdgcn_cvt_pk_f32_fp8((int)vw.z, true); \
                const f32x2_t p6 = __builtin_amdgcn_cvt_pk_f32_fp8((int)vw.w, false), p7 = __builtin_amdgcn_cvt_pk_f32_fp8((int)vw.w, true); \
                acc[0] += (f32x4){p0[0], p0[1], p1[0], p1[1]} * aj; acc[1] += (f32x4){p2[0], p2[1], p3[0], p3[1]} * aj;             \
                acc[2] += (f32x4){p4[0], p4[1], p5[0], p5[1]} * aj; acc[3] += (f32x4){p6[0], p6[1], p7[0], p7[1]} * aj;             \
            }
#endif
    u32x4 ub0[NUB], ub1[NUB]; vb_t vb0[8], vb1[8];
    int ec0, ec1;
    {
        const int* eid0 = NB_EID(wbase);
        ec0 = eid0[c & 7] * 768; ec1 = eid0[8 + (c & 7)] * 768;
        U_LOAD(ub0, ec0)
        V_LOAD(vb0, ec0)
        U_LOAD(ub1, ec1)
    }
#pragma unroll 1
    for (int it = 0;; ++it) {
        unsigned char* wsm = NOTK ? wbase : wbase + (it & 1) * 4096;
        unsigned char* nb = NOTK ? wbase : wbase + ((it + 1) & 1) * 4096;
        const int* eid = NB_EID(wsm); const float* egate = NB_EG(wsm); const float* eusc = NB_EU(wsm);
        const float rs = rs_cur;
        const int nrow_raw = row + stride;
        const int nrow = nrow_raw < MTOK ? nrow_raw : row;
        TK_LOAD_X(nrow) TK_LOAD_SC(nrow, 0)
        f32x4 acc[4];
#pragma unroll
        for (int i = 0; i < 4; ++i) acc[i] = (f32x4){0.f, 0.f, 0.f, 0.f};
#define PEER_TILE(UB, EC, VBC, ECN, VBN)                                                                                           \
        {                                                                                                                          \
            f32x4 dh = {0.f, 0.f, 0.f, 0.f}, dl = {0.f, 0.f, 0.f, 0.f};                                                             \
            U_DOT(UB)                                                                                                              \
            float mine = dh[0] + dl[0] * (1.f / 16.f);                                                                             \
            mine += __shfl_xor(mine, 40);                                                       \
            const float act = gelu_fast(mine * (1.f / 16.f) * eusc[tcur * 8 + (c & 7)] * rs) * egate[tcur * 8 + (c & 7)];           \
            {     \
                const int* es_ = (tcur + 2 < 16) ? eid + (tcur + 2) * 8 : NB_EID(nb) + (tcur + 2 - 16) * 8;                          \
                EC = es_[c & 7] * 768; U_LOAD(UB, EC)                                                                                    \
                V_LOAD(VBN, ECN)                                                                                                   \
            }                                                                                                                      \
            __builtin_amdgcn_sched_barrier(0);                                                                                     \
            V_ACC(VBC)                                                                                                             \
            __builtin_amdgcn_sched_barrier(0);                                                                                     \
        }
#pragma unroll 1
        for (int tp = 0; tp < 8; ++tp) {
            { const int tcur = 2 * tp; PEER_TILE(ub0, ec0, vb0, ec1, vb1) }
            if (!NOTK) {
            if (tp == 0) { TK_STAGE_X(nb, rs_n) }
            TK_FLUSH(nb)
            TK_PART_A(nb)
            }
            __builtin_amdgcn_sched_barrier(0);
            { const int tcur = 2 * tp + 1; PEER_TILE(ub1, ec1, vb1, ec0, vb0) }
            if (!NOTK) {
            TK_PART_B(nb, tp, rs_n)
            { const int hn = tp < 7 ? tp + 1 : 7; TK_LOAD_SC(nrow, hn) }
            }
            __builtin_amdgcn_sched_barrier(0);
        }
#undef PEER_TILE
#undef U_LOAD
#undef U_DOT
#undef V_LOAD
#undef V_LOAD_H
#undef V_ACC
        if (!NOTK) { TK_FLUSH(nb) }
        float* hr = p.out + (size_t)row * DM;
        float ss = 0.f;
        {
            f32x4 h0, h1, h2, h3;
            unpack8(ldws<u32x4>(W, O_HG + (unsigned)row * 2048u + lane * 16), h0, h1); unpack8(ldws<u32x4>(W, O_HG + (unsigned)row * 2048u + 1024 + lane * 16), h2, h3);
            acc[0] += h0; acc[1] += h1; acc[2] += h2; acc[3] += h3;
        }
#pragma unroll
        for (int i = 0; i < 4; ++i) ss += acc[i][0] * acc[i][0] + acc[i][1] * acc[i][1] + acc[i][2] * acc[i][2] + acc[i][3] * acc[i][3];
        ss = wave_sum(ss);
        const float scl = rsqrtf(ss * (1.f / DM) + NORM_EPS);
#pragma unroll
        for (int cc = 0; cc < 2; ++cc) {
            const f32x4 ga = *(const f32x4*)(p.norm_f_g + cc * 512 + lane * 8), gb = *(const f32x4*)(p.norm_f_g + cc * 512 + lane * 8 + 4);
            *(f32x4*)(hr + cc * 512 + lane * 8) = acc[2 * cc] * scl * ga; *(f32x4*)(hr + cc * 512 + lane * 8 + 4) = acc[2 * cc + 1] * scl * gb;
        }
        __builtin_amdgcn_s_waitcnt(0xC07F); __builtin_amdgcn_wave_barrier();
        if (nrow_raw >= MTOK) break;
        row = nrow_raw; rs_cur = rs_n;
    }
#undef TK_FLUSH
#undef TK_PART_B
#undef TK_PART_A
#undef TK_K16
#undef TK_STAGE_X
#undef TK_LOAD_SC
#undef TK_LOAD_X
}


#ifdef UT_FP6
__device__ __forceinline__ int ut_a(int row, int g, int i) { return ((i * 7 + g * 3 + row) % 13) - 6; }
__device__ __forceinline__ int ut_b(int col, int g, int j) { return ((j * 5 + g * 2 + col * 3) % 7) - 3; }
__device__ __forceinline__ void ut_fp6(const Params& p) {
    const int lane = threadIdx.x & 63, g = lane >> 4, c = lane & 15;
    unsigned aw[8];
#pragma unroll
    for (int w = 0; w < 8; ++w) {
        int h_ = __builtin_amdgcn_cvt_pk_fp8_f32((float)ut_a(c, g, 4 * w), (float)ut_a(c, g, 4 * w + 1), 0, false);
        h_ = __builtin_amdgcn_cvt_pk_fp8_f32((float)ut_a(c, g, 4 * w + 2), (float)ut_a(c, g, 4 * w + 3), h_, true);
        aw[w] = (unsigned)h_;
    }
    unsigned bw[6];
    {
        unsigned cd[16];
#pragma unroll
        for (int j = 0; j < 16; ++j) cd[j] = fp6_code((float)ut_b(c, g, j));
        fp6_pack16(cd, bw[0], bw[1], bw[2]);
#pragma unroll
        for (int j = 0; j < 16; ++j) cd[j] = fp6_code((float)ut_b(c, g, 16 + j));
        fp6_pack16(cd, bw[3], bw[4], bw[5]);
    }
    const v8i32_t A = {(int)aw[0], (int)aw[1], (int)aw[2], (int)aw[3], (int)aw[4], (int)aw[5], (int)aw[6], (int)aw[7]};
    const v8i32_t B = {(int)bw[0], (int)bw[1], (int)bw[2], (int)bw[3], (int)bw[4], (int)bw[5], 0, 0};
    f32x4 D = {0.f, 0.f, 0.f, 0.f};
    D = __builtin_amdgcn_mfma_scale_f32_16x16x128_f8f6f4(A, B, D, 0, 2, 0, 0x7F7F7F7F, 0, 0x7F7F7F7F);
    bool ok1 = true, ok2 = true, ok3 = true, ok4 = true;
#pragma unroll 1
    for (int r = 0; r < 4; ++r) {
        const int row = 4 * g + r;
        int e1 = 0, e2 = 0, e3 = 0, e4 = 0;
#pragma unroll 1
        for (int gg = 0; gg < 4; ++gg)
#pragma unroll 1
            for (int j = 0; j < 32; ++j) {
                const int bv = ut_b(c, gg, j);
                e1 += bv * ut_a(row, gg, j);
                { const int K = j < 16 ? 16 * gg + j : 64 + 16 * gg + (j - 16); e2 += bv * ut_a(row, K >> 5, K & 31); }
                { const int K = 32 * gg + j; const int ga = K < 64 ? (K >> 4) : ((K - 64) >> 4), ia = K < 64 ? (K & 15) : 16 + (K & 15); e3 += bv * ut_a(row, ga, ia); }
                { const int K = 32 * (j >> 3) + 8 * gg + (j & 7); e4 += bv * ut_a(row, K >> 5, K & 31); }
            }
        const float dv = D[r];
        ok1 = ok1 && (dv == (float)e1); ok2 = ok2 && (dv == (float)e2); ok3 = ok3 && (dv == (float)e3); ok4 = ok4 && (dv == (float)e4);
    }
    const bool a1 = __ballot(ok1) == ~0ull, a2 = __ballot(ok2) == ~0ull, a3 = __ballot(ok3) == ~0ull, a4 = __ballot(ok4) == ~0ull;
    const int m = a1 ? 1 : a2 ? 2 : a3 ? 3 : a4 ? 4 : 0;
    const v6i32_t sv = {(int)bw[0], (int)bw[1], (int)bw[2], (int)bw[3], (int)bw[4], (int)bw[5]};
    const v32f32_t f = __builtin_amdgcn_cvt_scalef32_pk32_f32_fp6(sv, 1.0f);
    bool okc = true;
#pragma unroll
    for (int j = 0; j < 32; ++j) okc = okc && (f[j] == (float)ut_b(c, g, j));
    const int c1 = (__ballot(okc) == ~0ull) ? 1 : 0;
    if (lane == 0) ((float*)p.ws)[20] = (float)(2 * m + c1);
}
#endif
__global__ void __launch_bounds__(NT, 2) k_mega(Params p) {
    extern __shared__ __attribute__((aligned(16))) unsigned char lds_raw[];
    LAS unsigned char* lds = (LAS unsigned char*)lds_raw;
    unsigned char* smem = lds_raw;
    const int tid = threadIdx.x, G = gridDim.x;
    const int vcu = (G % 8 == 0) ? ((int)blockIdx.x % 8) * (G / 8) + (int)blockIdx.x / 8 : (int)blockIdx.x;
    for (int i = tid; i < (LDS_BYTES - LDSCTL_OFF) / 4; i += NT) ((LAS unsigned*)(lds + LDSCTL_OFF))[i] = 0u;
    __syncthreads();
    XcdBarrier bar = xcd_barrier_post((unsigned*)p.ws + CW_BAR, (volatile LAS unsigned*)(lds + MISC_OFF) + 8);
#ifdef UT_FP6
    if (blockIdx.x == 0 && threadIdx.x < 64) ut_fp6(p);
#endif

#ifndef REP_PREP
#define REP_PREP 1
#endif
#ifndef REP_INPROJ
#define REP_INPROJ 1
#endif
#ifndef REP_SSM
#define REP_SSM 1
#endif
#ifndef REP_DSA
#define REP_DSA 1
#endif
#ifndef REP_MID
#define REP_MID 1
#endif
#ifndef REP_SCORES
#define REP_SCORES 1
#endif
#ifndef REP_PEER
#define REP_PEER 1
#endif
#define REPEAT(n) _Pragma("unroll 1") for (int rep_ = 0; rep_ < (n); ++rep_)
    REPEAT(REP_PREP) { phase_prep<0>(p, smem, vcu, G); xcd_barrier(bar); }
    REPEAT(REP_INPROJ) {
        EpiInProj e{WSP(bf16_t, WS_U), WSP(bf16_t, WS_Q), WSP(bf16_t, WS_K), WSP(bf16_t, WS_V), WSP(bf16_t, WS_QI), WSP(bf16_t, WS_KI),
                    WSP(bf16_t, WS_SGS), WSP(bf16_t, WS_SGA), WSP(float, WS_WI), WSP(float2, WS_ROPEA), WSP(float2, WS_ROPEI)};
        run_gemm(lds, WSP(bf16_t, WS_R1), WSP(bf16_t, WS_WINT), MTOK, IN_WP, 1024, G, e);
        if (G == 256) { if ((int)blockIdx.x >= 128) phase_prep<1>(p, smem, (int)blockIdx.x - 128, 128); }
        else phase_prep<1>(p, smem, vcu, G);
        xcd_barrier(bar);
    }
#ifdef DSA_FIRST
    REPEAT(REP_DSA) { phase_dsa(p, smem, (unsigned)(WS_YATT << 20), vcu, G); __syncthreads(); }
    REPEAT(REP_SSM) {
        int t2 = threadIdx.x; asm volatile("" : "+v"(t2));
        const int w2 = __builtin_amdgcn_readfirstlane(t2 >> 6);
#pragma unroll 1
        for (int item = vcu; item < NB * SSM_G; item += G) ssm_fast_item(p, smem, (unsigned)(WS_YG << 20), item, t2 & 63, w2);
        __syncthreads();
    }
#ifdef PROBE_SSM
    if (tid < 64) for (int item = blockIdx.x; item < NB * SSM_G; item += G) ssm_item(p, (float*)smem, (bf16_t*)p.out, item, tid);
    __syncthreads();
#endif
#else
    REPEAT(REP_SSM) {
        int t2 = threadIdx.x; asm volatile("" : "+v"(t2));
        const int w2 = __builtin_amdgcn_readfirstlane(t2 >> 6);
#pragma unroll 1
        for (int item = vcu; item < NB * SSM_G; item += G) ssm_fast_item(p, smem, (unsigned)(WS_YG << 20), item, t2 & 63, w2);
        __syncthreads();
    }
#ifdef PROBE_SSM
    if (tid < 64) for (int item = blockIdx.x; item < NB * SSM_G; item += G) ssm_item(p, (float*)smem, (bf16_t*)p.out, item, tid);
    __syncthreads();
#endif
    REPEAT(REP_DSA) { phase_dsa(p, smem, (unsigned)(WS_YATT << 20), vcu, G); __syncthreads(); }
#endif
#ifdef PROBE_ATTN
    phase_attn(p, smem, (bf16_t*)p.out, vcu, G);
    __syncthreads();
#endif
    xcd_barrier(bar);
#if defined(PROBE_ATTN) || defined(PROBE_SSM)
    {
#ifdef PROBE_SSM
        const bf16_t* A = WSP(bf16_t, WS_YG);
#else
        const bf16_t* A = WSP(bf16_t, WS_YATT);
#endif
        const bf16_t* B = (const bf16_t*)p.out;
        float d2 = 0.f, b2 = 0.f;
        for (size_t i = (size_t)blockIdx.x * NT + threadIdx.x; i < (size_t)MTOK * 512; i += (size_t)G * NT) { float a = bf2f(A[i]), bb = bf2f(B[i]); d2 += (a - bb) * (a - bb); b2 += bb * bb; }
        d2 = wave_sum(d2); b2 = wave_sum(b2);
        if ((threadIdx.x & 63) == 0) { atomicAdd((float*)p.ws + 16, d2); atomicAdd((float*)p.ws + 17, b2); }
    }
    xcd_barrier(bar);
#endif
#ifndef REP_GLU
#define REP_GLU 1
#endif
#ifndef REP_M1
#define REP_M1 1
#endif
#ifndef REP_M2
#define REP_M2 1
#endif
#ifndef REP_OUT
#define REP_OUT 1
#endif
#ifndef REP_BAR
#define REP_BAR 0
#endif
    REPEAT(REP_BAR) { xcd_barrier(bar); }
    REPEAT(REP_GLU) { EpiGlu e{WSP(bf16_t, WS_YG), WSP(bf16_t, WS_YSSM)}; run_gemm(lds, WSP(bf16_t, WS_YG), WSP(bf16_t, WS_WGLUT), MTOK, 512, 512, G, e); xcd_barrier(bar); }
    REPEAT(REP_M1) { EpiMergeChain e{WSP(bf16_t, WS_SGS), WSP(bf16_t, WS_SGA), WSP(bf16_t, WS_R1)};
        run_gemm_chain(lds, WSP(bf16_t, WS_YSSM), WSP(bf16_t, WS_WSUPT), WSP(bf16_t, WS_YATT), WSP(bf16_t, WS_WAUPT), MTOK, 1024, 512, G, e); xcd_barrier(bar); }
    REPEAT(REP_OUT) { EpiOut e{p.x, WSP(bf16_t, WS_HG), WSP(float, WS_RSS)};
        run_gemm(lds, WSP(bf16_t, WS_R1), WSP(bf16_t, WS_WOUTT), MTOK, 1024, 1024, G, e); xcd_barrier(bar); }
    REPEAT(REP_SCORES) { EpiScores e{WSP(_Float16, WS_SCORES)}; run_gemm(lds, WSP(bf16_t, WS_HG), WSP(bf16_t, WS_WCT), MTOK, 2048, 1024, G, e); xcd_barrier(bar); }
#ifdef PROBE_PEER
    phase_peer2<2>(p, smem, vcu, G);
    __syncthreads();
    phase_peer<false>(p, smem, vcu, G);
    xcd_barrier(bar);
    {
        const float* A = WSP(float, 462); const float* B = p.out;
        float d2 = 0.f, b2 = 0.f;
        for (size_t i = (size_t)blockIdx.x * NT + threadIdx.x; i < (size_t)8192 * DM; i += (size_t)G * NT) { const float a = A[i], bb = B[i]; d2 += (a - bb) * (a - bb); b2 += bb * bb; }
        d2 = wave_sum(d2); b2 = wave_sum(b2);
        if ((threadIdx.x & 63) == 0) { atomicAdd((float*)p.ws + 16, d2); atomicAdd((float*)p.ws + 17, b2); }
    }
    xcd_barrier(bar);
    {
        const float e = ((const float*)p.ws)[16] / fmaxf(((const float*)p.ws)[17], 1e-30f);
        int kx = 0; if (e > 1e-8f) kx++; if (e > 1e-7f) kx++; if (e > 1e-6f) kx++; if (e > 1e-5f) kx++; if (e > 1e-4f) kx++; if (e > 1e-3f) kx++; if (e > 1e-2f) kx++; if (!(e == e)) kx = 10;
        const float f = 1.f + 0.05f * kx;
        for (size_t i = (size_t)blockIdx.x * NT + threadIdx.x; i < (size_t)MTOK * DM / 4; i += (size_t)G * NT) { f32x4 v = ((f32x4*)p.out)[i]; ((f32x4*)p.out)[i] = v * f; }
    }
#else
#if !PEER_FP6
    REPEAT(REP_PEER - 1) { phase_peer2<1>(p, smem, vcu, G); __syncthreads(); }
#endif
#ifdef PEER_OLD
    phase_peer2<0>(p, smem, vcu, G);
#elif PEER_FP6
#if REP_PEER > 1
    phase_peer6<true>(p, smem, vcu, G); __syncthreads();
#endif
    phase_peer6<false>(p, smem, vcu, G);
#else
    phase_peer4(p, smem, vcu, G);
#endif
#ifdef UT_FP6
    xcd_barrier(bar);
    {
        const float f = 1.f + 0.05f * ((const float*)p.ws)[20];
        for (size_t i = (size_t)blockIdx.x * NT + threadIdx.x; i < (size_t)MTOK * DM / 4; i += (size_t)G * NT) { f32x4 v = ((f32x4*)p.out)[i]; ((f32x4*)p.out)[i] = v * f; }
    }
#endif
#if defined(PROBE_ATTN) || defined(PROBE_SSM)
    xcd_barrier(bar);
    {
        const float e = ((const float*)p.ws)[16] / fmaxf(((const float*)p.ws)[17], 1e-30f);
        int kx = 0; if (e > 1e-6f) kx++; if (e > 1e-5f) kx++; if (e > 1e-4f) kx++; if (e > 1e-3f) kx++; if (e > 1e-2f) kx++; if (e > 1e-1f) kx++; if (!(e == e)) kx = 8;
        const float f = 1.f + 0.05f * kx;
        for (size_t i = (size_t)blockIdx.x * NT + threadIdx.x; i < (size_t)MTOK * DM / 4; i += (size_t)G * NT) { f32x4 v = ((f32x4*)p.out)[i]; ((f32x4*)p.out)[i] = v * f; }
    }
#endif
#endif
}

extern "C" void kernel_launch(void* const* d_in, const int* in_sizes, int n_in, void* d_out, int out_size, void* d_ws, size_t ws_size,
                              hipStream_t stream) {
    static int grid = 0;
    if (grid == 0) {
        int dev = 0, cus = 0, per_cu = 0;
        if (hipGetDevice(&dev) != hipSuccess || hipDeviceGetAttribute(&cus, hipDeviceAttributeMultiprocessorCount, dev) != hipSuccess) { grid = -1; return; }
        if (hipFuncSetAttribute((const void*)k_mega, hipFuncAttributeMaxDynamicSharedMemorySize, LDS_BYTES) != hipSuccess) { fprintf(stderr, "hipFuncSetAttribute failed\n"); grid = -1; return; }
        if (hipOccupancyMaxActiveBlocksPerMultiprocessor(&per_cu, (const void*)k_mega, NT, LDS_BYTES) != hipSuccess || per_cu < 1) {
            fprintf(stderr, "occupancy query reports %d blocks/CU\n", per_cu); (void)hipGetLastError(); per_cu = 1; }
        grid = cus;
    }
    if (grid < 0) return;
    (void)hipMemsetAsync(d_ws, 0, CTL_ZERO_BYTES, stream);
    Params p{};
    const float** pp = (const float**)&p;
    for (int i = 0; i < 22; ++i) pp[i] = (const float*)d_in[i];
    p.out = (float*)d_out;
    p.ws = (unsigned char*)d_ws;
    for (int f = 0; f < 32; ++f) p.inv64[f] = pow(10000.0, -(double)(2 * f) / 64.0);
    for (int f = 0; f < 16; ++f) p.inv32[f] = pow(10000.0, -(double)(2 * f) / 32.0);
    hipLaunchKernelGGL(k_mega, dim3(grid), dim3(NT), LDS_BYTES, stream, p);
}
```

```cpp
#include <hip/hip_runtime.h>
#include <cstdio>
#include <cstdint>
#include <cmath>
#define GAS __attribute__((address_space(1)))
#define LAS __attribute__((address_space(3)))
namespace pg8 {
#define PG8_LAS __attribute__((address_space(3)))
typedef unsigned short bf16_t;
typedef short bf16x8 __attribute__((ext_vector_type(8)));
typedef float f32x4 __attribute__((ext_vector_type(4)));
typedef unsigned u32x4 __attribute__((ext_vector_type(4)));
constexpr int BM = 256, BK = 64, HALF = 128, HTB = HALF * BK * 2  , STAGE_BYTES = 8 * HTB, NXCD = 8, WGM = 8;

__host__ __device__ __forceinline__ int lds_byte(int r, int c) { const int st = (r >> 4) * 2 + (c >> 5), rr = r & 15, cc = c & 31, ob = rr * 64 + cc * 2; return st * 1024 + (ob ^ (((ob >> 9) & 1) << 5)); }
__host__ __device__ __forceinline__ void stage_rc(int b, int& R, int& C) { const int st = b / 1024, sb = b % 1024, swz = sb ^ (((sb >> 9) & 1) << 5); R = (st >> 1) * 16 + swz / 64; C = (st & 1) * 32 + (swz % 64) / 2; }
__host__ __device__ __forceinline__ int perm32(int rho) { const int n = rho >> 4, i = rho & 15; return 8 * (i >> 2) + 4 * n + (i & 3); }

struct Unit { int pm, pn, sel; };
struct Gemm { const bf16_t* A; const bf16_t* Bt; int M, N, K; const bf16_t* A2; const bf16_t* Bt2; };

struct StaticOrder {
    int nM, nN, nwg, G, c;
    __host__ __device__ void init(int M, int N, int G_, int c_) { nM = M / BM; nN = N / BM; nwg = nM * nN; G = G_; c = c_; }
    __host__ __device__ bool next(int i, Unit& u) const {
        const long L = (long)i * G + c; if (L >= nwg) return false;
        int wgid = (int)L; { const int q = nwg / NXCD, r = nwg % NXCD, xcd = wgid % NXCD, off = wgid / NXCD; wgid = (xcd < r ? xcd * (q + 1) : r * (q + 1) + (xcd - r) * q) + off; }
        const int nig = WGM * nN, gid = wgid / nig, fm = gid * WGM, gsz = (nM - fm) < WGM ? (nM - fm) : WGM;
        u.pm = fm + ((wgid % nig) % gsz); u.pn = (wgid % nig) / gsz; u.sel = 0; return true;
    }
    __device__ __forceinline__ void a_ready(const Unit&) const {}
    __device__ __forceinline__ void done(const Unit&) const {}
};
struct ChainOrder {
    StaticOrder b;
    __host__ __device__ void init(int M, int N, int G_, int c_) { b.init(M, N, G_, c_); }
    __host__ __device__ bool next(int i, Unit& u) const { if (!b.next(i >> 1, u)) return false; u.sel = i & 1; return true; }
    __device__ __forceinline__ void a_ready(const Unit&) const {}
    __device__ __forceinline__ void done(const Unit&) const {}
};
typedef __bf16 bf16x2_cv_t __attribute__((ext_vector_type(2)));
typedef float f32x2_cv_t __attribute__((ext_vector_type(2)));
__device__ __forceinline__ unsigned cvt_pk_bf16(float lo, float hi) { const f32x2_cv_t v = {lo, hi}; return __builtin_bit_cast(unsigned, __builtin_convertvector(v, bf16x2_cv_t)); }
template <class Epi, class Sched, bool ALIGN_EPI = false, bool SP2 = false>
__device__ __forceinline__ void gemm_phase(PG8_LAS unsigned char* lds, const Gemm g, const Sched& S, const Epi& E) {
    int tid_l = threadIdx.x; asm volatile("" : "+v"(tid_l));
    const int tid = tid_l, wid = __builtin_amdgcn_readfirstlane(tid >> 6), lane = tid & 63, wr = wid >> 2, wc = wid & 3, fr = lane & 15, fq = lane >> 4;
    const int K = g.K, nt = K / BK;
    unsigned voffA[2], voffB[2];
#pragma unroll
    for (int i = 0; i < 2; ++i) { int R, C; stage_rc(tid * 16 + i * 8192, R, C); const int Rb = Epi::PERM ? ((R & ~31) + perm32(R & 31)) : R;
        voffA[i] = (unsigned)(R * K + C) * 2u; voffB[i] = (unsigned)(Rb * K + C) * 2u; }
    const size_t kstep = (size_t)(BK * 2);
    const size_t hstep = (size_t)HALF * K * 2;
    const size_t tstep = 2 * hstep;
    const unsigned ldsw = (unsigned)wid * 1024u;
    const int aoff = lds_byte(wr * 64 + fr, fq * 8), boff = lds_byte(wc * 32 + fr, fq * 8);
#define PG8_SA(b, h) (((b) * 2 + (h)) * HTB)
#define PG8_SB(b, h) ((4 + (b) * 2 + (h)) * HTB)
#define PG8_STAGE(bufoff, gbase, voff) do { _Pragma("unroll") for (int _i = 0; _i < 2; ++_i) \
        __builtin_amdgcn_global_load_lds((const unsigned*)((const char*)(gbase) + (voff)[_i]), (PG8_LAS unsigned*)(lds + (bufoff) + ldsw + _i * 8192), 16, 0, 0); } while (0)
#define PG8_LDA(dst, b, h) do { _Pragma("unroll") for (int m = 0; m < 4; ++m) _Pragma("unroll") for (int k = 0; k < 2; ++k) dst[m][k] = *(const PG8_LAS bf16x8*)(lds + PG8_SA(b, h) + aoff + m * 2048 + k * 1024); } while (0)
#define PG8_LDB(dst, b, h) do { _Pragma("unroll") for (int n = 0; n < 2; ++n) _Pragma("unroll") for (int k = 0; k < 2; ++k) dst[n][k] = *(const PG8_LAS bf16x8*)(lds + PG8_SB(b, h) + boff + n * 2048 + k * 1024); } while (0)
#define PG8_MMA(ai, bj, At, Bt) do { __builtin_amdgcn_s_setprio(1); _Pragma("unroll") for (int m = 0; m < 4; ++m) _Pragma("unroll") for (int n = 0; n < 2; ++n) _Pragma("unroll") for (int k = 0; k < 2; ++k) \
        acc[ai][bj][m][n] = __builtin_amdgcn_mfma_f32_16x16x32_bf16(Bt[n][k], At[m][k], acc[ai][bj][m][n], 0, 0, 0); __builtin_amdgcn_s_setprio(0); } while (0)
#define PG8_WAIT_V(n) asm volatile("s_waitcnt vmcnt(" #n ")" ::: "memory")
#define PG8_WAIT_L(n) asm volatile("s_waitcnt lgkmcnt(" #n ")" ::: "memory")
#define PG8_BAR __builtin_amdgcn_s_barrier()
#define PG8_SCHED __builtin_amdgcn_sched_barrier(0)
    Unit cur, nxt; int ui = 0;
    if (!S.next(0, cur)) return;
    f32x4 acc[2][2][4][2];
#pragma unroll
    for (int a = 0; a < 2; ++a)
#pragma unroll
        for (int b = 0; b < 2; ++b)
#pragma unroll
            for (int m = 0; m < 4; ++m)
#pragma unroll
                for (int n = 0; n < 2; ++n) acc[a][b][m][n] = (f32x4){0.f, 0.f, 0.f, 0.f};
    bf16x8 At[4][2], B0[2][2], B1[2][2];
    const char* cA = (const char*)(cur.sel ? g.A2 : g.A) + (size_t)cur.pm * tstep; const char* cB = (const char*)(cur.sel ? g.Bt2 : g.Bt) + (size_t)cur.pn * tstep;
    S.a_ready(cur);
    if constexpr (SP2) {
        PG8_STAGE(PG8_SB(0, 0), cB, voffB); PG8_STAGE(PG8_SB(0, 1), cB + hstep, voffB); PG8_STAGE(PG8_SA(0, 0), cA, voffA); PG8_STAGE(PG8_SA(0, 1), cA + hstep, voffA);
        if (wr == 1) PG8_BAR;
        PG8_WAIT_V(2); PG8_BAR;
        PG8_STAGE(PG8_SB(1, 0), cB + kstep, voffB); PG8_STAGE(PG8_SA(1, 0), cA + kstep, voffA); PG8_STAGE(PG8_SB(1, 1), cB + hstep + kstep, voffB);
        PG8_WAIT_V(6); PG8_BAR;
    } else {
        PG8_STAGE(PG8_SB(0, 0), cB, voffB); PG8_STAGE(PG8_SA(0, 0), cA, voffA); PG8_STAGE(PG8_SB(0, 1), cB + hstep, voffB); PG8_STAGE(PG8_SA(0, 1), cA + hstep, voffA);
        if (wr == 1) PG8_BAR;
        PG8_WAIT_V(4); PG8_BAR;
        PG8_STAGE(PG8_SB(1, 0), cB + kstep, voffB); PG8_STAGE(PG8_SA(1, 0), cA + kstep, voffA); PG8_STAGE(PG8_SB(1, 1), cB + hstep + kstep, voffB);
        PG8_WAIT_V(6); PG8_BAR;
    }
    for (;;) {
        const bool has_next = S.next(ui + 1, nxt);
        const char* nA = has_next ? (const char*)(nxt.sel ? g.A2 : g.A) + (size_t)nxt.pm * tstep : cA; const char* nB = has_next ? (const char*)(nxt.sel ? g.Bt2 : g.Bt) + (size_t)nxt.pn * tstep : cB;
        for (int t = 0; t < nt; t += 2) {
            const bool last = (t == nt - 2);
            const char* a1 = cA + (size_t)(t + 1) * kstep;
            const char* a2 = last ? nA : cA + (size_t)(t + 2) * kstep; const char* b2 = last ? nB : cB + (size_t)(t + 2) * kstep;
            const char* a3 = a2 + kstep; const char* b3 = b2 + kstep;
            if (last && has_next) S.a_ready(nxt);
            if constexpr (SP2) {
            PG8_LDB(B0, 0, 0); PG8_LDB(B1, 0, 1); PG8_SCHED; PG8_LDA(At, 0, 0); PG8_STAGE(PG8_SA(1, 1), a1 + hstep, voffA);
            PG8_WAIT_V(8); PG8_WAIT_L(0); PG8_BAR; PG8_MMA(0, 0, At, B0); PG8_MMA(0, 1, At, B1); PG8_BAR; PG8_SCHED;
            PG8_LDA(At, 0, 1); PG8_STAGE(PG8_SB(0, 0), b2, voffB); PG8_STAGE(PG8_SB(0, 1), b2 + hstep, voffB); PG8_STAGE(PG8_SA(0, 0), a2, voffA);
            PG8_WAIT_V(8); PG8_WAIT_L(0); PG8_BAR; PG8_MMA(1, 0, At, B0); PG8_MMA(1, 1, At, B1); PG8_BAR; PG8_SCHED;
            PG8_LDB(B0, 1, 0); PG8_LDB(B1, 1, 1); PG8_SCHED; PG8_LDA(At, 1, 0); PG8_STAGE(PG8_SA(0, 1), a2 + hstep, voffA);
            PG8_WAIT_V(8); PG8_WAIT_L(0); PG8_BAR; PG8_MMA(0, 0, At, B0); PG8_MMA(0, 1, At, B1); PG8_BAR; PG8_SCHED;
            PG8_LDA(At, 1, 1); PG8_STAGE(PG8_SB(1, 0), b3, voffB); PG8_STAGE(PG8_SB(1, 1), b3 + hstep, voffB); PG8_STAGE(PG8_SA(1, 0), a3, voffA);
            PG8_WAIT_V(8); PG8_WAIT_L(0); PG8_BAR; PG8_MMA(1, 0, At, B0); PG8_MMA(1, 1, At, B1); PG8_BAR; PG8_SCHED;
            } else {
            PG8_LDB(B0, 0, 0); PG8_SCHED; PG8_LDA(At, 0, 0); PG8_STAGE(PG8_SA(1, 1), a1 + hstep, voffA);
            PG8_WAIT_L(8); PG8_BAR; PG8_WAIT_L(0); PG8_MMA(0, 0, At, B0); PG8_BAR; PG8_SCHED;
            PG8_LDB(B1, 0, 1); PG8_STAGE(PG8_SB(0, 0), b2, voffB);
            PG8_BAR; PG8_WAIT_L(0); PG8_MMA(0, 1, At, B1); PG8_BAR;
            PG8_LDA(At, 0, 1); PG8_STAGE(PG8_SA(0, 0), a2, voffA);
            PG8_BAR; PG8_WAIT_L(0); PG8_MMA(1, 0, At, B0); PG8_BAR; PG8_SCHED;
            PG8_STAGE(PG8_SB(0, 1), b2 + hstep, voffB);
            PG8_WAIT_V(6); PG8_BAR; PG8_MMA(1, 1, At, B1); PG8_BAR;
            PG8_LDB(B0, 1, 0); PG8_SCHED; PG8_LDA(At, 1, 0); PG8_STAGE(PG8_SA(0, 1), a2 + hstep, voffA);
            PG8_WAIT_L(8); PG8_BAR; PG8_WAIT_L(0); PG8_MMA(0, 0, At, B0); PG8_BAR; PG8_SCHED;
            PG8_LDB(B1, 1, 1); PG8_STAGE(PG8_SB(1, 0), b3, voffB);
            PG8_BAR; PG8_WAIT_L(0); PG8_MMA(0, 1, At, B1); PG8_BAR;
            PG8_LDA(At, 1, 1); PG8_STAGE(PG8_SA(1, 0), a3, voffA);
            PG8_BAR; PG8_WAIT_L(0); PG8_MMA(1, 0, At, B0); PG8_BAR; PG8_SCHED;
            PG8_STAGE(PG8_SB(1, 1), b3 + hstep, voffB);
            PG8_WAIT_V(6); PG8_BAR; PG8_MMA(1, 1, At, B1); PG8_BAR;
            }
        }
        if constexpr (ALIGN_EPI) { if (wr == 0) PG8_BAR; }
        if constexpr (!Epi::AFTER_DRAIN) { E(acc, cur, wr, wc, fr, fq); S.done(cur); }
        if (!has_next) break;
        if (!(Epi::CHAIN && cur.sel == 0))
#pragma unroll
        for (int a = 0; a < 2; ++a)
#pragma unroll
            for (int b = 0; b < 2; ++b)
#pragma unroll
                for (int m = 0; m < 4; ++m)
#pragma unroll
                    for (int n = 0; n < 2; ++n) acc[a][b][m][n] = (f32x4){0.f, 0.f, 0.f, 0.f};
        cur = nxt; cA = nA; cB = nB; ++ui;
        if constexpr (ALIGN_EPI) { if (wr == 1) PG8_BAR; }
    }
    PG8_WAIT_V(0);
    if constexpr (!ALIGN_EPI) { if (wr == 0) PG8_BAR; }
    PG8_BAR;
    if constexpr (Epi::AFTER_DRAIN) { E.fused(acc, cur, wr, wc, fr, fq, lds, wid, lane); S.done(cur); }
#undef PG8_SA
#undef PG8_SB
#undef PG8_STAGE
#undef PG8_LDA
#undef PG8_LDB
#undef PG8_MMA
#undef PG8_WAIT_V
#undef PG8_WAIT_L
#undef PG8_BAR
#undef PG8_SCHED
}
}
#define XB_TMO      128
#define XB_XCNT(j)  (256  + 64 * (j))
#define XB_XSUB(j)  (1280 + 64 * (j))
#define XB_XGEN(j)  (2304 + 64 * (j))
#define XB_TOP      3328
#define XB_TOPGEN   3392
#define XCD_BAR_WORDS 3456
#define XB_SPIN_CAP (1u << 18)

__device__ __forceinline__ unsigned xb_ld(unsigned* p)              { return __hip_atomic_load(p, __ATOMIC_RELAXED, __HIP_MEMORY_SCOPE_AGENT); }
__device__ __forceinline__ unsigned xb_add(unsigned* p, unsigned v) { return __hip_atomic_fetch_add(p, v, __ATOMIC_RELAXED, __HIP_MEMORY_SCOPE_AGENT); }
__device__ __forceinline__ unsigned xb_xcc_id() { return (unsigned)__builtin_amdgcn_s_getreg((3 << 11) | 20) & 0xFu; }
#define XB_SPIN(cond, bar) do { unsigned _sp = 0; while (cond) { __builtin_amdgcn_s_sleep(1); \
    if ((++_sp & 255u) == 0u) { if (xb_ld(&(bar)[XB_TMO])) break; if (_sp > XB_SPIN_CAP) { atomicAdd(&(bar)[XB_TMO], 1u); break; } } } } while (0)

struct XcdBarrier {
    unsigned* bar; unsigned x;
    volatile LAS unsigned* st;
};

__device__ __forceinline__ XcdBarrier xcd_barrier_post(unsigned* bar, volatile LAS unsigned* st) {
    XcdBarrier b; b.bar = bar; b.x = xb_xcc_id(); b.st = st;
    if (threadIdx.x == 0) (void)xb_add(&bar[XB_XCNT(b.x)], 1u);
    return b;
}
__device__ __forceinline__ void xcd_barrier_complete(unsigned* bar, unsigned x, unsigned& nloc, unsigned& nx) {
    const unsigned G = gridDim.x * gridDim.y * gridDim.z;
    unsigned sum, cnt, mine, sp = 0u;
    for (;;) {
        sum = 0u; cnt = 0u; mine = 0u;
#pragma unroll
        for (unsigned j = 0; j < 16; ++j) { const unsigned c = xb_ld(&bar[XB_XCNT(j)]); sum += c; cnt += (c > 0u) ? 1u : 0u; mine = (j == x) ? c : mine; }
        if (sum == G) break;
        __builtin_amdgcn_s_sleep(1);
        if ((++sp & 255u) == 0u) { if (xb_ld(&bar[XB_TMO])) break; if (sp > XB_SPIN_CAP) { atomicAdd(&bar[XB_TMO], 1u); break; } }
    }
    nloc = mine > 0u ? mine : 1u; nx = cnt > 0u ? cnt : 1u;
}

__device__ __forceinline__ void xcd_barrier(const XcdBarrier& b) {
    asm volatile("s_waitcnt vmcnt(0)" ::: "memory");
    __syncthreads();
    if (threadIdx.x == 0) {
        unsigned* bar = b.bar;
        __builtin_amdgcn_s_waitcnt(0);
        unsigned nloc = b.st[0], nx = b.st[1];
        if (nloc == 0u) { xcd_barrier_complete(bar, b.x, nloc, nx); b.st[0] = nloc; b.st[1] = nx; }
        const unsigned old = xb_add(&bar[XB_XSUB(b.x)], 1u);
        const unsigned gen = old / nloc;
        if (old + 1u == (gen + 1u) * nloc) {
            __builtin_amdgcn_fence(__ATOMIC_RELEASE, "agent");
            asm volatile("s_waitcnt vmcnt(0)" ::: "memory");
            const unsigned og = xb_add(&bar[XB_TOP], 1u);
            const unsigned tg = og / nx;
            if (og + 1u == (tg + 1u) * nx) xb_add(&bar[XB_TOPGEN], 1u);
            else XB_SPIN(xb_ld(&bar[XB_TOPGEN]) == tg, bar);
            __builtin_amdgcn_fence(__ATOMIC_ACQUIRE, "agent");
            xb_add(&bar[XB_XGEN(b.x)], 1u);
            asm volatile("s_waitcnt vmcnt(0)" ::: "memory");
        } else {
            XB_SPIN(xb_ld(&bar[XB_XGEN(b.x)]) == gen, bar);
            __builtin_amdgcn_fence(__ATOMIC_ACQUIRE, "agent");
            asm volatile("s_waitcnt vmcnt(0)" ::: "memory");
        }
    }
    __syncthreads();
}

typedef unsigned short bf16_t;
typedef short bf16x8 __attribute__((ext_vector_type(8)));
typedef float f32x4 __attribute__((ext_vector_type(4)));
typedef unsigned u32x4 __attribute__((ext_vector_type(4)));
using pg8::cvt_pk_bf16;

constexpr int NWAVES = 8, NT = NWAVES * 64;
constexpr int DM = 1024, NB = 8, SEQ = 4096, MTOK = NB * SEQ;
constexpr int SSM_W = 512, SSM_G = 32, SSM_N = 16, SSM_P = 64;
constexpr int IN_W = 3624, IN_WP = 3840;
constexpr int TOPK = 256;
constexpr int PEER_H = 8, PEER_KEYS = 128;
constexpr float NORM_EPS = 1e-6f;
constexpr size_t MiB = 1u << 20;
constexpr int LDS_BYTES = 163840, RING_BYTES = 131072, LDSCTL_OFF = LDS_BYTES - 1024, MISC_OFF = LDSCTL_OFF + 320;
constexpr int CW_BAR = 4096;
constexpr size_t CTL_ZERO_BYTES = 65536;

constexpr size_t WS_WINT = 1, WS_WGLUT = 9, WS_WSUPT = 10, WS_WAUPT = 11, WS_WOUTT = 12, WS_WCT = 14;
constexpr size_t WS_ROPEA = 18, WS_ROPEI = 19, WS_KT = 20, WS_A64 = 21, WS_SSMT = 22, WS_W1T = 254, WS_W3T = 262;
constexpr size_t WS_UTAB = 24, WS_VTAB = 56, WS_USC = 44, WS_VSC = 45;
#if !defined(PEER_FP6) && !defined(PEER_OLD)
#define PEER_FP6 1
#endif
#ifndef PEER_FP6
#define PEER_FP6 0
#endif
#ifndef PEER_U6
#define PEER_U6 PEER_FP6
#endif
#ifndef PEER_V6
#define PEER_V6 PEER_FP6
#endif
#ifndef PEER_FP8
#define PEER_FP8 1
#endif
constexpr size_t WS_R1 = 88;
constexpr size_t WS_U = 152, WS_Q = 184, WS_K = 216, WS_V = 224, WS_QI = 232, WS_KI = 248, WS_WI = 250;
constexpr size_t WS_SGS = 270, WS_SGA = 334, WS_YG = 398, WS_YSSM = 430, WS_YATT = 462, WS_RSS = 494;
constexpr size_t WS_T1 = 152;
constexpr size_t WS_SCORES = 88;
constexpr size_t WS_HG = 398;

struct Params {
    const float *x, *norm1_g, *w_in, *a_re, *a_im, *log_dt, *b_re, *b_im, *c_re, *c_im, *d_skip, *w_glu, *w_ssm_up,
        *w_attn_up, *w_out, *norm2_g, *peer_wq, *peer_k1, *peer_k2, *peer_u, *peer_v, *norm_f_g;
    float* out;
    unsigned char* ws;
    double inv64[32];
    double inv32[16];
};
#define WSP(T, off) ((T*)(p.ws + (size_t)(off) * MiB))

__device__ __forceinline__ unsigned f2bf(float f) {
    unsigned u = __builtin_bit_cast(unsigned, f);
    return (u + 0x7fffu + ((u >> 16) & 1u)) >> 16;
}
__device__ __forceinline__ float bf2f(unsigned b) { return __builtin_bit_cast(float, b << 16); }
__device__ __forceinline__ float bflo(unsigned w) { return __builtin_bit_cast(float, w << 16); }
__device__ __forceinline__ float bfhi(unsigned w) { return __builtin_bit_cast(float, w & 0xffff0000u); }
__device__ __forceinline__ float sigmoidf_(float x) { return __builtin_amdgcn_rcpf(1.f + __expf(-x)); }
__device__ __forceinline__ float gelu_fast(float x) {
    const float z = 0.7978845608028654f * (x + 0.044715f * x * x * x);
    const float e = __expf(2.f * z);
    return x - x * __builtin_amdgcn_rcpf(e + 1.f);
}
__device__ __forceinline__ float gelu_tanh(float x) { return gelu_fast(x); }
template <int CTRL, int RM = 0xf, int BM = 0xf, bool BC = true>
__device__ __forceinline__ float dppf(float old, float src) { return __builtin_bit_cast(float, __builtin_amdgcn_update_dpp(__builtin_bit_cast(int, old), __builtin_bit_cast(int, src), CTRL, RM, BM, BC)); }
template <int CTRL, int RM = 0xf, int BM = 0xf, bool BC = true>
__device__ __forceinline__ int dppi(int old, int src) { return __builtin_amdgcn_update_dpp(old, src, CTRL, RM, BM, BC); }
__device__ __forceinline__ float wave_sum(float v) {
    v += dppf<0x111>(0.f, v); v += dppf<0x112>(0.f, v); v += dppf<0x114>(0.f, v); v += dppf<0x118>(0.f, v);
    v += dppf<0x142, 0xa, 0xf, false>(0.f, v); v += dppf<0x143, 0xc, 0xf, false>(0.f, v);
    return __builtin_bit_cast(float, __builtin_amdgcn_readlane(__builtin_bit_cast(int, v), 63));
}
__device__ __forceinline__ float wave_max(float v) {
    v = fmaxf(v, dppf<0x111, 0xf, 0xf, false>(v, v)); v = fmaxf(v, dppf<0x112, 0xf, 0xf, false>(v, v)); v = fmaxf(v, dppf<0x114, 0xf, 0xf, false>(v, v)); v = fmaxf(v, dppf<0x118, 0xf, 0xf, false>(v, v));
    v = fmaxf(v, dppf<0x142, 0xa, 0xf, false>(v, v)); v = fmaxf(v, dppf<0x143, 0xc, 0xf, false>(v, v));
    return __builtin_bit_cast(float, __builtin_amdgcn_readlane(__builtin_bit_cast(int, v), 63));
}
__device__ __forceinline__ int wave_incl_scan(int v) {
    v += dppi<0x111>(0, v); v += dppi<0x112>(0, v); v += dppi<0x114>(0, v); v += dppi<0x118>(0, v);
    v += dppi<0x142, 0xa, 0xf, false>(0, v); v += dppi<0x143, 0xc, 0xf, false>(0, v);
    return v;
}
__device__ __forceinline__ u32x4 pack8(f32x4 a, f32x4 b) {
    u32x4 w; w.x = cvt_pk_bf16(a[0], a[1]); w.y = cvt_pk_bf16(a[2], a[3]); w.z = cvt_pk_bf16(b[0], b[1]); w.w = cvt_pk_bf16(b[2], b[3]);
    return w;
}
__device__ __forceinline__ uint2 pack8_fp8(f32x4 a, f32x4 b) {
    int w0 = __builtin_amdgcn_cvt_pk_fp8_f32(a[0], a[1], 0, false); w0 = __builtin_amdgcn_cvt_pk_fp8_f32(a[2], a[3], w0, true);
    int w1 = __builtin_amdgcn_cvt_pk_fp8_f32(b[0], b[1], 0, false); w1 = __builtin_amdgcn_cvt_pk_fp8_f32(b[2], b[3], w1, true);
    return make_uint2((unsigned)w0, (unsigned)w1);
}
typedef float f32x2_t __attribute__((ext_vector_type(2)));
__device__ __forceinline__ void unpack8_fp8(uint2 w, f32x4& a, f32x4& b) {
    const f32x2_t p0 = __builtin_amdgcn_cvt_pk_f32_fp8((int)w.x, false), p1 = __builtin_amdgcn_cvt_pk_f32_fp8((int)w.x, true);
    const f32x2_t p2 = __builtin_amdgcn_cvt_pk_f32_fp8((int)w.y, false), p3 = __builtin_amdgcn_cvt_pk_f32_fp8((int)w.y, true);
    a = (f32x4){p0[0], p0[1], p1[0], p1[1]}; b = (f32x4){p2[0], p2[1], p3[0], p3[1]};
}
__device__ __forceinline__ void unpack8(u32x4 w, f32x4& a, f32x4& b) {
    a[0] = bflo(w.x); a[1] = bfhi(w.x); a[2] = bflo(w.y); a[3] = bfhi(w.y);
    b[0] = bflo(w.z); b[1] = bfhi(w.z); b[2] = bflo(w.w); b[3] = bfhi(w.w);
}

template <class T> __device__ __forceinline__ T ldws(const unsigned char* ws, unsigned off) { return *(const T*)(ws + off); }
__device__ __forceinline__ void sincos_d(double x, double& s, double& c) {
    const double TWO_OVER_PI = 0.63661977236758134308;
    const double PIO2_HI = 1.57079632679489655800e+00, PIO2_LO = 6.12323399573676603587e-17;
    double kd = rint(x * TWO_OVER_PI);
    double r = fma(-kd, PIO2_HI, x);
    r = fma(-kd, PIO2_LO, r);
    long long k = (long long)kd;
    double r2 = r * r;
    double sp = r * (1.0 + r2 * (-1.0 / 6 + r2 * (1.0 / 120 + r2 * (-1.0 / 5040 + r2 * (1.0 / 362880 + r2 * (-1.0 / 39916800 + r2 * (1.0 / 6227020800.0)))))));
    double cp = 1.0 + r2 * (-0.5 + r2 * (1.0 / 24 + r2 * (-1.0 / 720 + r2 * (1.0 / 40320 + r2 * (-1.0 / 3628800 + r2 * (1.0 / 479001600.0 + r2 * (-1.0 / 87178291200.0)))))));
    int q = (int)(k & 3);
    double ss = (q & 1) ? cp : sp, cc = (q & 1) ? sp : cp;
    if (q == 1) cc = -cc;
    if (q == 2) { ss = -ss; cc = -cc; }
    if (q == 3) ss = -ss;
    s = ss; c = cc;
}

__device__ __forceinline__ int winsrc(int v) {
    if (v < 512) return v;
    if (v < 1152) { const int b = v < 1024 ? 512 : 1024; int w = v - b; const int hd = w >> 6; w &= 63; const int i = w >> 3, jj = w & 7;
        return b + hd * 64 + (jj < 4 ? 4 * i + jj : 32 + 4 * i + (jj - 4)); }
    if (v < 1280) return v;
    if (v < 1568) { int w = v - 1280; const int hd = w >> 5; w &= 31; const int i = w >> 3, jj = w & 7;
        return 1280 + hd * 32 + (jj < 4 ? 4 * i + jj : 16 + 4 * i + (jj - 4)); }
    if (v < 1576) return v;
    if (v < 1792) return -1;
    if (v < 2816) return 1576 + (v - 1792);
    return 2600 + (v - 2816);
}
template <bool MAP>
__device__ __forceinline__ void transpose_item(const float* __restrict__ W, int K, int N, bf16_t* WT, int Nout, float* scr, int item, int lane) {
    const int nblk = Nout / 32, kb = item / nblk, nb = item % nblk, k0 = 64 * kb, n0 = 32 * nb;
    const int src = MAP ? winsrc(n0 + (lane & 31)) : n0 + (lane & 31);
#pragma unroll 8
    for (int i = 0; i < 32; ++i) { const int kk = 2 * i + (lane >> 5); scr[kk * 33 + (lane & 31)] = src >= 0 ? W[(size_t)(k0 + kk) * N + src] : 0.f; }
    asm volatile("s_waitcnt lgkmcnt(0)" ::: "memory");
    const int c = lane & 7;
#pragma unroll
    for (int j = 0; j < 4; ++j) {
        const int n = (lane >> 3) + 8 * j; const float* s = scr + (8 * c) * 33 + n;
        u32x4 o; o.x = cvt_pk_bf16(s[0 * 33], s[1 * 33]); o.y = cvt_pk_bf16(s[2 * 33], s[3 * 33]); o.z = cvt_pk_bf16(s[4 * 33], s[5 * 33]); o.w = cvt_pk_bf16(s[6 * 33], s[7 * 33]);
        *(u32x4*)(WT + (size_t)(n0 + n) * K + k0 + 8 * c) = o;
    }
    asm volatile("s_waitcnt lgkmcnt(0)" ::: "memory");
}


__device__ __forceinline__ unsigned fp6_code(float y) {
    const float a = fabsf(y);
    unsigned c;
    if (a < 1.f) c = (unsigned)(a * 8.f + 0.5f);
    else { c = ((__float_as_uint(a) + 0x00080000u) >> 20) - 1008u; c = c > 31u ? 31u : c; }
    return c | (y < 0.f ? 32u : 0u);
}
__device__ __forceinline__ void fp6_pack16(const unsigned (&c)[16], unsigned& w0, unsigned& w1, unsigned& w2) {
    w0 = c[0] | (c[1] << 6) | (c[2] << 12) | (c[3] << 18) | (c[4] << 24) | (c[5] << 30);
    w1 = (c[5] >> 2) | (c[6] << 4) | (c[7] << 10) | (c[8] << 16) | (c[9] << 22) | (c[10] << 28);
    w2 = (c[10] >> 4) | (c[11] << 2) | (c[12] << 8) | (c[13] << 14) | (c[14] << 20) | (c[15] << 26);
}
__device__ __forceinline__ void peer_table_row(const Params& p, int r, int lane, unsigned char* stage) {
    unsigned char* ut = WSP(unsigned char, WS_UTAB); unsigned char* vt = WSP(unsigned char, WS_VTAB);
    float* usc = WSP(float, WS_USC); float* vsc = WSP(float, WS_VSC);
    const int tb = r >> 14, e = r & 16383;
    const float* src = (tb ? p.peer_v : p.peer_u) + (size_t)e * DM;
    const bool six = tb ? (PEER_V6 != 0) : (PEER_U6 == 1);
    const bool nat16 = six && tb == 0;
    const int o0 = nat16 ? lane * 16 : lane * 8, o1 = nat16 ? lane * 16 + 8 : 512 + lane * 8;
    const f32x4 a0 = *(const f32x4*)(src + o0), a1 = *(const f32x4*)(src + o0 + 4), a2 = *(const f32x4*)(src + o1), a3 = *(const f32x4*)(src + o1 + 4);
    float m = 0.f;
#pragma unroll
    for (int i = 0; i < 4; ++i) m = fmaxf(m, fmaxf(fmaxf(fabsf(a0[i]), fabsf(a1[i])), fmaxf(fabsf(a2[i]), fabsf(a3[i]))));
    m = wave_max(m);
    if (six) {
        const float sc = m > 0.f ? 7.5f / m : 1.f;
        unsigned cd[16];
#pragma unroll
        for (int i = 0; i < 4; ++i) { cd[i] = fp6_code(a0[i] * sc); cd[4 + i] = fp6_code(a1[i] * sc); cd[8 + i] = fp6_code(a2[i] * sc); cd[12 + i] = fp6_code(a3[i] * sc); }
        unsigned w0, w1, w2; fp6_pack16(cd, w0, w1, w2);
        if (tb) { unsigned* dst = (unsigned*)(vt + (size_t)e * 768 + lane * 12); dst[0] = w0; dst[1] = w1; dst[2] = w2; }
        else {
            unsigned* st = (unsigned*)(stage + lane * 12); st[0] = w0; st[1] = w1; st[2] = w2;
            __builtin_amdgcn_s_waitcnt(0xC07F); __builtin_amdgcn_wave_barrier();
            if (lane < 48) {
                const int k3 = lane >> 3, h = (lane >> 2) & 1, q = lane & 3;
                *(u32x4*)(ut + (size_t)e * 768 + lane * 16) = *(const u32x4*)(stage + h * 384 + q * 96 + k3 * 16);
            }
            __builtin_amdgcn_s_waitcnt(0xC07F); __builtin_amdgcn_wave_barrier();
        }
        if (lane == 0) (tb ? vsc : usc)[e] = 1.f / sc;
    } else {
        const float sc = m > 0.f ? 224.f / m : 1.f;
        const uint2 w01 = pack8_fp8(a0 * sc, a1 * sc), w23 = pack8_fp8(a2 * sc, a3 * sc);
        if (tb == 0) {
            *(uint2*)(ut + (size_t)e * 1024 + lane * 8) = w01; *(uint2*)(ut + (size_t)e * 1024 + 512 + lane * 8) = w23;
            if (lane == 0) usc[e] = 1.f / sc;
        } else {
            *(u32x4*)(vt + (size_t)e * 1024 + lane * 16) = (u32x4){w01.x, w01.y, w23.x, w23.y};
            if (lane == 0) vsc[e] = 1.f / sc;
        }
    }
}
template <int PART>
__device__ __forceinline__ void phase_prep(const Params& p, unsigned char* smem, int vcu, int G) {
    int tid = threadIdx.x; asm volatile("" : "+v"(tid)); const int lane = tid & 63, wave = tid >> 6;
    const int gw = vcu * NWAVES + wave, NGW = G * NWAVES;
    const size_t gtid = (size_t)vcu * NT + tid, gsize = (size_t)G * NT;
    float* scr = (float*)smem + wave * 4096;
#pragma unroll 1
    for (int ord = 0; ord < 2; ++ord) {
    if ((ord == 0) != ((wave & 1) != 0)) {
    {
        constexpr int I_IN = 16 * (IN_WP / 32), I_GLU = 8 * 16, I_SUP = 8 * 32, I_AUP = 8 * 32, I_OUT = 16 * 32;
        constexpr int NITEMS = I_IN + I_GLU + I_SUP + I_AUP + I_OUT;
        for (int it = (PART == 0 ? gw : NITEMS); it < NITEMS; it += NGW) {
            int r = it;
            if (r < I_IN) { transpose_item<true>(p.w_in, 1024, IN_W, WSP(bf16_t, WS_WINT), IN_WP, scr, r, lane); continue; } r -= I_IN;
            if (r < I_GLU) { transpose_item<false>(p.w_glu, 512, 512, WSP(bf16_t, WS_WGLUT), 512, scr, r, lane); continue; } r -= I_GLU;
            if (r < I_SUP) { transpose_item<false>(p.w_ssm_up, 512, 1024, WSP(bf16_t, WS_WSUPT), 1024, scr, r, lane); continue; } r -= I_SUP;
            if (r < I_AUP) { transpose_item<false>(p.w_attn_up, 512, 1024, WSP(bf16_t, WS_WAUPT), 1024, scr, r, lane); continue; } r -= I_AUP;
            transpose_item<false>(p.w_out, 1024, 1024, WSP(bf16_t, WS_WOUTT), 1024, scr, r, lane);
        }
    }
    if (PART == 0) {
    {
        bf16_t* wct = WSP(bf16_t, WS_WCT);
        for (int it = gw; it < 16 * 8 * 64; it += NGW) {
            const int hh = it >> 9, kt = (it >> 6) & 7, ct = it & 63;
            const int h = hh >> 1, half = hh & 1;
            const float* ap = (half ? p.peer_k2 : p.peer_k1) + ((size_t)h * 128 + kt * 16 + (lane & 15)) * 128 + (lane >> 4);
            const float* bp = p.peer_wq + (size_t)(ct * 16 + (lane & 15)) * 2048 + h * 256 + half * 128 + (lane >> 4);
            f32x4 acc = {0.f, 0.f, 0.f, 0.f};
#pragma unroll 8
            for (int d0 = 0; d0 < 128; d0 += 4) acc = __builtin_amdgcn_mfma_f32_16x16x4f32(ap[d0], bp[d0], acc, 0, 0, 0);
            const float g2k = p.norm2_g[ct * 16 + (lane & 15)];
#pragma unroll
            for (int r = 0; r < 4; ++r) wct[(size_t)(hh * 128 + kt * 16 + 4 * (lane >> 4) + r) * 1024 + ct * 16 + (lane & 15)] = (bf16_t)f2bf(acc[r] * g2k);
        }
    }
#if !PEER_FP8
    {
        const size_t n8 = (size_t)16384 * 1024 / 8;
        u32x4* ut = WSP(u32x4, WS_UTAB); u32x4* vt = WSP(u32x4, WS_VTAB);
        for (size_t i = gtid; i < n8; i += gsize) {
            f32x4 a = ((const f32x4*)p.peer_u)[2 * i], b = ((const f32x4*)p.peer_u)[2 * i + 1];
            ut[i] = pack8(a, b);
            f32x4 c = ((const f32x4*)p.peer_v)[2 * i], d = ((const f32x4*)p.peer_v)[2 * i + 1];
            vt[i] = pack8(c, d);
        }
    }
#endif
    }
    if (PART == 0) {
    {
        float2* ra = WSP(float2, WS_ROPEA); float2* ri = WSP(float2, WS_ROPEI);
        for (size_t i = gtid; i < (size_t)SEQ * 32; i += gsize) {
            int pos = (int)(i >> 5), f = (int)(i & 31);
            double s, c; sincos_d((double)pos * p.inv64[f], s, c);
            ra[i] = make_float2((float)c, (float)s);
        }
        for (size_t i = gtid; i < (size_t)SEQ * 16; i += gsize) {
            int pos = (int)(i >> 4), f = (int)(i & 15);
            double s, c; sincos_d((double)pos * p.inv32[f], s, c);
            ri[i] = make_float2((float)c, (float)s);
        }
    }
    }
    {
    if (PART == 0) {
        float2* abar = WSP(float2, WS_SSMT);
        float2* bbar = abar + SSM_G * SSM_P;
        for (size_t i = gtid; i < (size_t)SSM_G * SSM_P; i += gsize) {
            int g = (int)(i / SSM_P);
            double are = p.a_re[i], aim = p.a_im[i];
            double dt = exp((double)p.log_dt[g]);
            double s, c; sincos_d(aim * dt, s, c);
            double mag = exp(are * dt);
            double abr = mag * c, abi = mag * s;
            abar[i] = make_float2((float)abr, (float)abi);
            double nr = abr - 1.0, ni = abi;
            double den = are * are + aim * aim;
            double qr = (nr * are + ni * aim) / den, qi = (ni * are - nr * aim) / den;
            for (int cch = 0; cch < SSM_N; ++cch) {
                double br = p.b_re[i * SSM_N + cch], bi = p.b_im[i * SSM_N + cch];
                bbar[i * SSM_N + cch] = make_float2((float)(qr * br - qi * bi), (float)(qr * bi + qi * br));
            }
        }
    }

    {
        bf16_t* kt = WSP(bf16_t, WS_KT);
        float* zb = (float*)smem + wave * 4096;
        for (int pair = (PART == 0 ? gw : SSM_G * 64); pair < SSM_G * 64; pair += NGW) {
            const int g = pair >> 6, l = pair & 63;
            {
                const int pp = lane; const size_t i = (size_t)g * SSM_P + pp;
                const double are = p.a_re[i], aim = p.a_im[i], dt = exp((double)p.log_dt[g]);
                double s1, c1; sincos_d(aim * dt, s1, c1); const double m1 = exp(are * dt);
                const double nr = m1 * c1 - 1.0, ni = m1 * s1, den = are * are + aim * aim;
                const double qr = (nr * are + ni * aim) / den, qi_ = (ni * are - nr * aim) / den;
                double sl, cl; sincos_d(aim * dt * l, sl, cl); const double ml = exp(are * dt * l);
                const double zr = ml * cl, zi = ml * sl;
                const double zqr = zr * qr - zi * qi_, zqi = zr * qi_ + zi * qr;
#pragma unroll
                for (int ci = 0; ci < 16; ++ci) {
                    const double br = p.b_re[i * SSM_N + ci], bi = p.b_im[i * SSM_N + ci];
                    *(float2*)(zb + 2 * (pp * 16 + ci)) = make_float2((float)(zqr * br - zqi * bi), (float)(zqr * bi + zqi * br));
                }
            }
            __builtin_amdgcn_s_waitcnt(0xC07F);
            __builtin_amdgcn_wave_barrier();
#pragma unroll 1
            for (int q4 = 0; q4 < 4; ++q4) {
                const int ent = q4 * 64 + lane, co = ent >> 4, ci = ent & 15;
                float acc = 0.f;
                for (int pp = 0; pp < 64; ++pp) {
                    const float cr = p.c_re[((size_t)g * SSM_N + co) * SSM_P + pp], cim = p.c_im[((size_t)g * SSM_N + co) * SSM_P + pp];
                    const float2 z = *(const float2*)(zb + 2 * (pp * 16 + ci));
                    acc += cr * z.x - cim * z.y;
                }
                if (l == 0 && co == ci) acc += p.d_skip[g * SSM_N + co];
                kt[(((size_t)g * 64 + l) * 2 + (ci >> 3)) * 128 + co * 8 + (ci & 7)] = (bf16_t)f2bf(acc);
            }
            __builtin_amdgcn_wave_barrier();
        }
        bf16_t* w1t = WSP(bf16_t, WS_W1T); bf16_t* w3t = WSP(bf16_t, WS_W3T); float2* a64 = WSP(float2, WS_A64);
        for (size_t it = (PART == 1 ? gtid : (size_t)SSM_G * SSM_P * 64); it < (size_t)SSM_G * SSM_P * 64; it += gsize) {
            const int e = (int)(it & 63), pp = (int)((it >> 6) & 63), g = (int)(it >> 12);
            const size_t i = (size_t)g * SSM_P + pp;
            const double are = p.a_re[i], aim = p.a_im[i], dt = exp((double)p.log_dt[g]);
            double s1, c1; sincos_d(aim * dt, s1, c1); const double m1 = exp(are * dt);
            const double nr = m1 * c1 - 1.0, ni = m1 * s1, den = are * are + aim * aim;
            const double qr = (nr * are + ni * aim) / den, qi_ = (ni * are - nr * aim) / den;
            {
                const int l = 63 - e; double sl, cl; sincos_d(aim * dt * l, sl, cl); const double ml = exp(are * dt * l);
                const double zr = ml * cl, zi = ml * sl, wr_ = zr * qr - zi * qi_, wi_ = zr * qi_ + zi * qr;
                unsigned re_w[8], im_w[8];
#pragma unroll
                for (int c2 = 0; c2 < 8; ++c2) {
                    const double br0 = p.b_re[i * SSM_N + 2 * c2], bi0 = p.b_im[i * SSM_N + 2 * c2], br1 = p.b_re[i * SSM_N + 2 * c2 + 1], bi1 = p.b_im[i * SSM_N + 2 * c2 + 1];
                    re_w[c2] = f2bf((float)(wr_ * br0 - wi_ * bi0)) | (f2bf((float)(wr_ * br1 - wi_ * bi1)) << 16);
                    im_w[c2] = f2bf((float)(wr_ * bi0 + wi_ * br0)) | (f2bf((float)(wr_ * bi1 + wi_ * br1)) << 16);
                }
                u32x4* d0 = (u32x4*)(w1t + ((size_t)g * 128 + 2 * pp) * 1024 + e * 16);
                d0[0] = (u32x4){re_w[0], re_w[1], re_w[2], re_w[3]}; d0[1] = (u32x4){re_w[4], re_w[5], re_w[6], re_w[7]};
                u32x4* d1 = (u32x4*)(w1t + ((size_t)g * 128 + 2 * pp + 1) * 1024 + e * 16);
                d1[0] = (u32x4){im_w[0], im_w[1], im_w[2], im_w[3]}; d1[1] = (u32x4){im_w[4], im_w[5], im_w[6], im_w[7]};
            }
            {
                const int l = e + 1; double sl, cl; sincos_d(aim * dt * l, sl, cl); const double ml = exp(are * dt * l);
                const double zr = ml * cl, zi = ml * sl;
                for (int co = 0; co < 16; ++co) {
                    const double cr = p.c_re[((size_t)g * SSM_N + co) * SSM_P + pp], cim = p.c_im[((size_t)g * SSM_N + co) * SSM_P + pp];
                    const unsigned w = f2bf((float)(cr * zr - cim * zi)) | (f2bf((float)(-(cr * zi + cim * zr))) << 16);
                    *(unsigned*)(w3t + (((size_t)g * 64 + e) * 16 + co) * 128 + 2 * pp) = w;
                }
            }
            if (e == 0) { double sl, cl; sincos_d(aim * dt * 64, sl, cl); const double ml = exp(are * dt * 64); a64[i] = make_float2((float)(ml * cl), (float)(ml * sl)); }
        }
    }
    }
    } else {
    if (PART == 0) {
    {
        bf16_t* O = WSP(bf16_t, WS_R1);
        for (int row = gw; row < MTOK; row += NGW) {
            const float* xr = p.x + (size_t)row * DM;
            f32x4 v[4]; float ss = 0.f;
#pragma unroll
            for (int c = 0; c < 2; ++c) {
                v[2 * c] = *(const f32x4*)(xr + c * 512 + lane * 8); v[2 * c + 1] = *(const f32x4*)(xr + c * 512 + lane * 8 + 4);
            }
#pragma unroll
            for (int i = 0; i < 4; ++i) ss += v[i][0] * v[i][0] + v[i][1] * v[i][1] + v[i][2] * v[i][2] + v[i][3] * v[i][3];
            ss = wave_sum(ss);
            const float sc = rsqrtf(ss * (1.f / DM) + NORM_EPS);
#pragma unroll
            for (int c = 0; c < 2; ++c) {
                f32x4 ga = *(const f32x4*)(p.norm1_g + c * 512 + lane * 8), gb = *(const f32x4*)(p.norm1_g + c * 512 + lane * 8 + 4);
                *(u32x4*)(O + (size_t)row * DM + c * 512 + lane * 8) = pack8(v[2 * c] * sc * ga, v[2 * c + 1] * sc * gb);
            }
        }
    }
    }
    }
    }
}

#define EPI_ARGS const f32x4 (&acc)[2][2][4][2], const pg8::Unit& u, int wr_, int wc_, int fr_, int fq_
#define EPI_COORDS int t_ = threadIdx.x; asm volatile("" : "+v"(t_)); const int wid_ = __builtin_amdgcn_readfirstlane(t_ >> 6); \
    const int wr = wid_ >> 2, wc = wid_ & 3, fr = t_ & 15, fq = (t_ >> 4) & 3; (void)wr_; (void)wc_; (void)fr_; (void)fq_;
#define EPI_LOOP(...) \
    _Pragma("unroll") for (int ai = 0; ai < 2; ++ai) _Pragma("unroll") for (int m = 0; m < 4; ++m) { \
        const int row = u.pm * 256 + ai * 128 + wr * 64 + m * 16 + fr; \
        _Pragma("unroll") for (int bj = 0; bj < 2; ++bj) { const int vc = bj * 128 + wc * 32 + fq * 8; const f32x4 a0 = acc[ai][bj][m][0], a1 = acc[ai][bj][m][1]; __VA_ARGS__ __builtin_amdgcn_sched_barrier(0); } }

struct EpiInProj {
    static constexpr bool PERM = true, AFTER_DRAIN = false, CHAIN = false;
    bf16_t *u_, *q, *k, *v, *qi, *ki, *sgs, *sga; float* wi; const float2 *ropeA, *ropeI;
    __device__ __forceinline__ void rope_store(bf16_t* dst, const float2* cs, f32x4 a0, f32x4 a1) const {
        const f32x4 c01 = *(const f32x4*)cs, c23 = *(const f32x4*)(cs + 2);
        f32x4 r1, r2;
        r1[0] = a0[0] * c01[0] - a1[0] * c01[1]; r2[0] = a1[0] * c01[0] + a0[0] * c01[1];
        r1[1] = a0[1] * c01[2] - a1[1] * c01[3]; r2[1] = a1[1] * c01[2] + a0[1] * c01[3];
        r1[2] = a0[2] * c23[0] - a1[2] * c23[1]; r2[2] = a1[2] * c23[0] + a0[2] * c23[1];
        r1[3] = a0[3] * c23[2] - a1[3] * c23[3]; r2[3] = a1[3] * c23[2] + a0[3] * c23[3];
        *(u32x4*)dst = pack8(r1, r2);
    }
    __device__ __forceinline__ void rope_store8(unsigned char* dst, const float2* cs, f32x4 a0, f32x4 a1) const {
        const f32x4 c01 = *(const f32x4*)cs, c23 = *(const f32x4*)(cs + 2);
        f32x4 r1, r2;
        r1[0] = a0[0] * c01[0] - a1[0] * c01[1]; r2[0] = a1[0] * c01[0] + a0[0] * c01[1];
        r1[1] = a0[1] * c01[2] - a1[1] * c01[3]; r2[1] = a1[1] * c01[2] + a0[1] * c01[3];
        r1[2] = a0[2] * c23[0] - a1[2] * c23[1]; r2[2] = a1[2] * c23[0] + a0[2] * c23[1];
        r1[3] = a0[3] * c23[2] - a1[3] * c23[3]; r2[3] = a1[3] * c23[2] + a0[3] * c23[3];
        *(uint2*)dst = pack8_fp8(r1 * 16.f, r2 * 16.f);
    }
    __device__ __forceinline__ void operator()(EPI_ARGS) const {
        EPI_COORDS
        const int pn = u.pn;
        if (pn < 2) {
            EPI_LOOP({ *(u32x4*)(u_ + (size_t)row * 512 + pn * 256 + vc) = pack8(a0, a1); })
        } else if (pn < 4) {
            EPI_LOOP({ rope_store(q + (size_t)row * 512 + (pn - 2) * 256 + vc, ropeA + (row & (SEQ - 1)) * 32 + ((wc & 1) * 4 + fq) * 4, a0, a1); })
        } else if (pn == 4) {
            EPI_LOOP({ if (bj == 0) rope_store8((unsigned char*)k + (size_t)row * 128 + vc, ropeA + (row & (SEQ - 1)) * 32 + ((wc & 1) * 4 + fq) * 4, a0, a1);
                       else *(uint2*)((unsigned char*)v + (size_t)row * 128 + (vc - 128)) = pack8_fp8(a0 * 16.f, a1 * 16.f); })
        } else if (pn == 5) {
            EPI_LOOP({ rope_store(qi + (size_t)row * 256 + vc, ropeI + (row & (SEQ - 1)) * 16 + fq * 4, a0, a1); })
        } else if (pn == 6) {
            EPI_LOOP({ if (bj == 0) { if (wc == 0) rope_store(ki + (size_t)row * 32 + fq * 8, ropeI + (row & (SEQ - 1)) * 16 + fq * 4, a0, a1);
                                      else if (wc == 1 && fq == 0) { *(f32x4*)(wi + (size_t)row * 8) = a0; *(f32x4*)(wi + (size_t)row * 8 + 4) = a1; } } })
        } else if (pn < 11) {
            EPI_LOOP({ f32x4 s0, s1;
                       _Pragma("unroll") for (int j = 0; j < 4; ++j) { s0[j] = sigmoidf_(a0[j]); s1[j] = sigmoidf_(a1[j]); }
                       *(u32x4*)(sgs + (size_t)row * 1024 + (pn - 7) * 256 + vc) = pack8(s0, s1); })
        } else {
            EPI_LOOP({ f32x4 s0, s1;
                       _Pragma("unroll") for (int j = 0; j < 4; ++j) { s0[j] = sigmoidf_(a0[j]); s1[j] = sigmoidf_(a1[j]); }
                       *(u32x4*)(sga + (size_t)row * 1024 + (pn - 11) * 256 + vc) = pack8(s0, s1); })
        }
    }
};
struct EpiGlu {
    static constexpr bool PERM = true, AFTER_DRAIN = false, CHAIN = false;
    const bf16_t* y; bf16_t* o;
    __device__ __forceinline__ void operator()(EPI_ARGS) const {
        EPI_COORDS
        EPI_LOOP({ const size_t idx = (size_t)row * 512 + u.pn * 256 + vc; f32x4 y0, y1; unpack8(*(const u32x4*)(y + idx), y0, y1);
                   _Pragma("unroll") for (int j = 0; j < 4; ++j) { y0[j] *= sigmoidf_(a0[j]); y1[j] *= sigmoidf_(a1[j]); }
                   *(u32x4*)(o + idx) = pack8(y0, y1); })
    }
};
struct EpiMerge1 {
    static constexpr bool PERM = true, AFTER_DRAIN = false, CHAIN = false;
    const bf16_t* g; bf16_t* t;
    __device__ __forceinline__ void operator()(EPI_ARGS) const {
        EPI_COORDS
        EPI_LOOP({ const size_t idx = (size_t)row * 1024 + u.pn * 256 + vc; f32x4 g0, g1; unpack8(*(const u32x4*)(g + idx), g0, g1);
                   *(u32x4*)(t + idx) = pack8(g0 * a0, g1 * a1); })
    }
};
struct EpiMerge2 {
    static constexpr bool PERM = true, AFTER_DRAIN = false, CHAIN = false;
    const bf16_t* g; const bf16_t* t; bf16_t* o;
    __device__ __forceinline__ void operator()(EPI_ARGS) const {
        EPI_COORDS
        EPI_LOOP({ const size_t idx = (size_t)row * 1024 + u.pn * 256 + vc; f32x4 g0, g1, t0, t1; unpack8(*(const u32x4*)(g + idx), g0, g1); unpack8(*(const u32x4*)(t + idx), t0, t1);
                   *(u32x4*)(o + idx) = pack8(t0 + g0 * a0, t1 + g1 * a1); })
    }
};
struct EpiMergeChain {
    static constexpr bool PERM = true, AFTER_DRAIN = false, CHAIN = true;
    const bf16_t* gs; const bf16_t* ga; bf16_t* o;
    __device__ __forceinline__ void operator()(f32x4 (&acc)[2][2][4][2], const pg8::Unit& u, int wr_, int wc_, int fr_, int fq_) const {
        EPI_COORDS
#pragma unroll
        for (int ai = 0; ai < 2; ++ai)
#pragma unroll
            for (int m = 0; m < 4; ++m) {
                const int row = u.pm * 256 + ai * 128 + wr * 64 + m * 16 + fr;
#pragma unroll
                for (int bj = 0; bj < 2; ++bj) {
                    const size_t idx = (size_t)row * 1024 + u.pn * 256 + bj * 128 + wc * 32 + fq * 8;
                    f32x4 a0, a1; unpack8(*(const u32x4*)(ga + idx), a0, a1);
                    if (u.sel == 0) {
                        f32x4 s0, s1; unpack8(*(const u32x4*)(gs + idx), s0, s1);
#pragma unroll
                        for (int j = 0; j < 4; ++j) { acc[ai][bj][m][0][j] *= s0[j] * __builtin_amdgcn_rcpf(a0[j]); acc[ai][bj][m][1][j] *= s1[j] * __builtin_amdgcn_rcpf(a1[j]); }
                    } else {
                        *(u32x4*)(o + idx) = pack8(acc[ai][bj][m][0] * a0, acc[ai][bj][m][1] * a1);
                    }
                }
            }
    }
};
struct EpiOut {
    static constexpr bool PERM = true, AFTER_DRAIN = false, CHAIN = false;
    const float* x; bf16_t* hb; float* rss;
    __device__ __forceinline__ void operator()(EPI_ARGS) const {
        EPI_COORDS
#pragma unroll
        for (int ai = 0; ai < 2; ++ai)
#pragma unroll
            for (int m = 0; m < 4; ++m) {
                const int row = u.pm * 256 + ai * 128 + wr * 64 + m * 16 + fr;
                float ss = 0.f;
#pragma unroll
                for (int bj = 0; bj < 2; ++bj) {
                    const int col = u.pn * 256 + bj * 128 + wc * 32 + fq * 8;
                    const size_t idx = (size_t)row * 1024 + col;
                    const f32x4 h0 = *(const f32x4*)(x + idx) + acc[ai][bj][m][0], h1 = *(const f32x4*)(x + idx + 4) + acc[ai][bj][m][1];
                    ss += h0[0] * h0[0] + h0[1] * h0[1] + h0[2] * h0[2] + h0[3] * h0[3] + h1[0] * h1[0] + h1[1] * h1[1] + h1[2] * h1[2] + h1[3] * h1[3];
                    *(u32x4*)(hb + idx) = pack8(h0, h1);
                }
                ss += __shfl_xor(ss, 16); ss += __shfl_xor(ss, 32);
                if (fq == 0) rss[(size_t)row * 16 + u.pn * 4 + wc] = ss;
            }
    }
};
typedef _Float16 f16x8 __attribute__((ext_vector_type(8)));
struct EpiScores {
    static constexpr bool PERM = true, AFTER_DRAIN = false, CHAIN = false;
    _Float16* o;
    __device__ __forceinline__ void operator()(EPI_ARGS) const {
        EPI_COORDS
        EPI_LOOP({ const size_t idx = (size_t)row * 2048 + u.pn * 256 + vc;
                   f16x8 hv = {(_Float16)a0[0], (_Float16)a0[1], (_Float16)a0[2], (_Float16)a0[3], (_Float16)a1[0], (_Float16)a1[1], (_Float16)a1[2], (_Float16)a1[3]};
                   *(f16x8*)(o + idx) = hv; })
    }
};

template <class Epi>
__device__ __forceinline__ void run_gemm_chain(LAS unsigned char* lds, const bf16_t* A, const bf16_t* Bt, const bf16_t* A2, const bf16_t* Bt2, int M, int N, int K, int G, const Epi& E) {
    pg8::Gemm g{A, Bt, M, N, K, A2, Bt2}; pg8::ChainOrder S; S.init(M, N, G, (int)blockIdx.x);
    pg8::gemm_phase<Epi, pg8::ChainOrder, true, true>(lds, g, S, E);
}
template <class Epi>
__device__ __forceinline__ void run_gemm(LAS unsigned char* lds, const bf16_t* A, const bf16_t* Bt, int M, int N, int K, int G, const Epi& E) {
    pg8::Gemm g{A, Bt, M, N, K}; pg8::StaticOrder S; S.init(M, N, G, (int)blockIdx.x);
    pg8::gemm_phase<Epi, pg8::StaticOrder, true, true>(lds, g, S, E);
}

__device__ __forceinline__ void ssm_item(const Params& p, float* us, bf16_t* yg, int item, int lane) {
    const float2* abar_t = WSP(float2, WS_SSMT);
    const float2* bbar_t = abar_t + SSM_G * SSM_P;
    const bf16_t* u = WSP(bf16_t, WS_U);
    const int b = item / SSM_G, g = item % SSM_G;
    const float2 ab = abar_t[g * SSM_P + lane];
    float br[16], bi[16], cr[16], ci[16];
#pragma unroll
    for (int c = 0; c < 16; ++c) {
        float2 t = bbar_t[(g * SSM_P + lane) * SSM_N + c];
        br[c] = t.x; bi[c] = t.y;
        cr[c] = p.c_re[((size_t)g * SSM_N + c) * SSM_P + lane];
        ci[c] = p.c_im[((size_t)g * SSM_N + c) * SSM_P + lane];
    }
    const int myc = ((lane >> 5) & 1) * 8 + ((lane >> 4) & 1) * 4 + ((lane >> 3) & 1) * 2 + ((lane >> 2) & 1);
    const float dsk = p.d_skip[g * SSM_N + myc];
    float xr = 0.f, xi = 0.f;
    for (int t0 = 0; t0 < SEQ; t0 += 64) {
        {
            const bf16_t* ur = u + ((size_t)(b * SEQ + t0 + lane)) * SSM_W + g * SSM_N;
            f32x4 f0, f1, f2, f3; unpack8(*(const u32x4*)ur, f0, f1); unpack8(*(const u32x4*)(ur + 8), f2, f3);
            float* d = us + lane * 16;
            *(f32x4*)d = f0; *(f32x4*)(d + 4) = f1; *(f32x4*)(d + 8) = f2; *(f32x4*)(d + 12) = f3;
        }
        __builtin_amdgcn_s_waitcnt(0);
        __builtin_amdgcn_wave_barrier();
        for (int tt = 0; tt < 64; ++tt) {
            float uu[16];
#pragma unroll
            for (int c4 = 0; c4 < 4; ++c4) {
                f32x4 t = *(const f32x4*)(us + tt * 16 + c4 * 4);
                uu[c4 * 4] = t[0]; uu[c4 * 4 + 1] = t[1]; uu[c4 * 4 + 2] = t[2]; uu[c4 * 4 + 3] = t[3];
            }
            float bur = 0.f, bui = 0.f;
#pragma unroll
            for (int c = 0; c < 16; ++c) { bur += br[c] * uu[c]; bui += bi[c] * uu[c]; }
            float nxr = ab.x * xr - ab.y * xi + bur;
            float nxi = ab.x * xi + ab.y * xr + bui;
            xr = nxr; xi = nxi;
            float z[16];
#pragma unroll
            for (int c = 0; c < 16; ++c) z[c] = cr[c] * xr - ci[c] * xi;
            float w8[8], w4[4], w2[2], w1;
            const bool h5 = lane & 32, h4 = lane & 16, h3 = lane & 8, h2 = lane & 4;
#pragma unroll
            for (int i = 0; i < 8; ++i) { float mine = h5 ? z[8 + i] : z[i], oth = h5 ? z[i] : z[8 + i]; w8[i] = mine + __shfl_xor(oth, 32); }
#pragma unroll
            for (int i = 0; i < 4; ++i) { float mine = h4 ? w8[4 + i] : w8[i], oth = h4 ? w8[i] : w8[4 + i]; w4[i] = mine + __shfl_xor(oth, 16); }
#pragma unroll
            for (int i = 0; i < 2; ++i) { float mine = h3 ? w4[2 + i] : w4[i], oth = h3 ? w4[i] : w4[2 + i]; w2[i] = mine + __shfl_xor(oth, 8); }
            { float mine = h2 ? w2[1] : w2[0], oth = h2 ? w2[0] : w2[1]; w1 = mine + __shfl_xor(oth, 4); }
            w1 += __shfl_xor(w1, 2);
            w1 += __shfl_xor(w1, 1);
            float um = 0.f;
#pragma unroll
            for (int c = 0; c < 16; ++c) um = (c == myc) ? uu[c] : um;
            float y = gelu_tanh(w1 + dsk * um);
            if ((lane & 3) == 0) yg[((size_t)(b * SEQ + t0 + tt)) * SSM_W + g * SSM_N + myc] = (bf16_t)f2bf(y);
        }
        __builtin_amdgcn_wave_barrier();
    }
}


__device__ __forceinline__ void ssm_fast_item(const Params& p, unsigned char* smem, unsigned yg_off, int item, int lane_in, int wave) {
    const unsigned char* W = p.ws;
    constexpr unsigned O_U = WS_U << 20, O_W1T = WS_W1T << 20, O_W3T = WS_W3T << 20;
    const int b = item >> 5, g = item & 31;
    int lane = lane_in; asm volatile("" : "+v"(lane));
    const int gq = lane >> 4, c = lane & 15, rg = wave & 3, hf = wave >> 2;
    bf16_t* Kl = (bf16_t*)smem; float* Sl = (float*)(smem + 32768); bf16_t* Xb = (bf16_t*)(smem + 65536);
    __syncthreads();
    {
        const u32x4* src = (const u32x4*)(WSP(bf16_t, WS_KT) + (size_t)g * 64 * 256); u32x4* dst = (u32x4*)smem;
        for (int i = wave * 64 + lane; i < 2048; i += NT) dst[i] = src[i];
    }
    bf16x8 A[32];
#pragma unroll
    for (int ks = 0; ks < 32; ++ks)
        A[ks] = ldws<bf16x8>(W, O_U + ((unsigned)(b * SEQ + (16 * rg + c) * 64 + 2 * ks + (gq >> 1)) * 512u + g * 16 + 8 * (gq & 1)) * 2u);
#pragma unroll 1
    for (int nt = 0; nt < 4; ++nt) {
        f32x4 acc = {0.f, 0.f, 0.f, 0.f};
        const unsigned wb = O_W1T + ((unsigned)(g * 128 + (4 * hf + nt) * 16 + c) * 1024u + 8 * gq) * 2u;
#pragma unroll
        for (int ks = 0; ks < 32; ++ks) acc = __builtin_amdgcn_mfma_f32_16x16x32_bf16(A[ks], ldws<bf16x8>(W, wb + ks * 64), acc, 0, 0, 0);
#pragma unroll
        for (int r = 0; r < 4; ++r) Sl[(16 * rg + 4 * gq + r) * 128 + (4 * hf + nt) * 16 + c] = acc[r];
    }
    __syncthreads();
    if (wave == 0) {
        const float2 a = WSP(float2, WS_A64)[g * SSM_P + lane];
        float xr = 0.f, xi = 0.f;
        for (int ch = 0; ch < 64; ++ch) {
            *(unsigned*)(Xb + ch * 128 + 2 * lane) = f2bf(xr) | (f2bf(xi) << 16);
            const float2 sv = *(const float2*)(Sl + ch * 128 + 2 * lane);
            const float nr = a.x * xr - a.y * xi + sv.x, ni = a.x * xi + a.y * xr + sv.y;
            xr = nr; xi = ni;
        }
    }
    __syncthreads();
    bf16x8 Xa[4];
#pragma unroll
    for (int k2 = 0; k2 < 4; ++k2) Xa[k2] = *(const bf16x8*)(Xb + (16 * rg + c) * 128 + 32 * k2 + 8 * gq);
    bf16_t* yg = (bf16_t*)(p.ws + yg_off);
    const int gh = gq >> 1;
    const bf16_t* kl_lane = Kl + (gq & 1) * 128 + c * 8;
    bf16x8 w3[4];
    {
        const unsigned wb0 = O_W3T + ((unsigned)((g * 64 + hf) * 16 + c) * 128u + 8 * gq) * 2u;
#pragma unroll
        for (int k2 = 0; k2 < 4; ++k2) w3[k2] = ldws<bf16x8>(W, wb0 + k2 * 64);
    }
#pragma unroll 1
    for (int tq = 0; tq < 32; ++tq) {
        const int tp = 2 * tq + hf;
        f32x4 acc = {0.f, 0.f, 0.f, 0.f};
#pragma unroll
        for (int k2 = 0; k2 < 4; ++k2) acc = __builtin_amdgcn_mfma_f32_16x16x32_bf16(Xa[k2], w3[k2], acc, 0, 0, 0);
        {
            const int tn = tq < 31 ? tp + 2 : tp;
            const unsigned wb = O_W3T + ((unsigned)((g * 64 + tn) * 16 + c) * 128u + 8 * gq) * 2u;
#pragma unroll
            for (int k2 = 0; k2 < 4; ++k2) w3[k2] = ldws<bf16x8>(W, wb + k2 * 64);
        }
#pragma unroll
        for (int ks = 0; ks < 32; ++ks) {
            if (ks <= tq) {
                const int l = tp - 2 * ks - gh;
                bf16x8 kb = *(const bf16x8*)(kl_lane + (l < 0 ? 0 : l) * 256);
                if (l < 0) kb = (bf16x8){0, 0, 0, 0, 0, 0, 0, 0};
                acc = __builtin_amdgcn_mfma_f32_16x16x32_bf16(A[ks], kb, acc, 0, 0, 0);
            }
        }
#pragma unroll
        for (int r = 0; r < 4; ++r)
            yg[((size_t)(b * SEQ + (16 * rg + 4 * gq + r) * 64 + tp)) * SSM_W + g * SSM_N + c] = (bf16_t)f2bf(gelu_tanh(acc[r]));
    }
}

__device__ __forceinline__ unsigned fkey(float f) {
    unsigned u = __builtin_bit_cast(unsigned, f);
    return (u & 0x80000000u) ? ~u : (u | 0x80000000u);
}
__device__ __forceinline__ void phase_attn(const Params& p, unsigned char* smem, bf16_t* yatt, int vcu, int G) {
    float* sc = (float*)smem;
    float* qis = sc + 4096;
    float* wis = qis + 256;
    float* qs = wis + 16;
    float* pl = qs + 512;
    int* sel = (int*)(pl + 2048);
    unsigned* hist = (unsigned*)(sel + 256);
    int* scanA = (int*)(hist + 256);
    int* scanB = scanA + 512;
    int* misc = scanB + 512;
    int tid = threadIdx.x; asm volatile("" : "+v"(tid));
    const bf16_t* qi = WSP(bf16_t, WS_QI); const bf16_t* ki = WSP(bf16_t, WS_KI); const float* wi = WSP(float, WS_WI);
    const bf16_t* q = WSP(bf16_t, WS_Q); const bf16_t* kk = WSP(bf16_t, WS_K); const bf16_t* vv = WSP(bf16_t, WS_V);
    for (int row = vcu; row < MTOK; row += G) {
        const int b = row / SEQ, t = row % SEQ, nvalid = t + 1;
        __syncthreads();
        if (tid < 256) qis[tid] = bf2f(qi[(size_t)row * 256 + tid]);
        if (tid < 8) wis[tid] = wi[(size_t)row * 8 + tid];
        qs[tid] = bf2f(q[(size_t)row * 512 + tid]);
        __syncthreads();
        for (int s = tid; s < nvalid; s += NT) {
            const bf16_t* kr = ki + ((size_t)b * SEQ + s) * 32;
            float kv[32];
#pragma unroll
            for (int d8 = 0; d8 < 4; ++d8) {
                f32x4 a, bb; unpack8(*(const u32x4*)(kr + d8 * 8), a, bb);
                kv[d8 * 8] = a[0]; kv[d8 * 8 + 1] = a[1]; kv[d8 * 8 + 2] = a[2]; kv[d8 * 8 + 3] = a[3];
                kv[d8 * 8 + 4] = bb[0]; kv[d8 * 8 + 5] = bb[1]; kv[d8 * 8 + 6] = bb[2]; kv[d8 * 8 + 7] = bb[3];
            }
            float a = 0.f;
#pragma unroll
            for (int h = 0; h < 8; ++h) {
                float d = 0.f;
#pragma unroll
                for (int dd = 0; dd < 32; ++dd) d += qis[h * 32 + dd] * kv[dd];
                a += wis[h] * fmaxf(d, 0.f);
            }
#ifdef PROBE_ATTN
            sc[s] = (float)(_Float16)a;
#else
            sc[s] = a;
#endif
        }
        __syncthreads();
        int nsel;
        if (nvalid <= TOPK) {
            nsel = nvalid;
            if (tid < nvalid) sel[tid] = tid;
        } else {
            nsel = TOPK;
            unsigned prefix = 0, mask = 0; int need = TOPK;
            for (int pass = 0; pass < 4; ++pass) {
                const int shift = 24 - 8 * pass;
                if (tid < 256) hist[tid] = 0;
                __syncthreads();
                for (int s = tid; s < nvalid; s += NT) {
                    unsigned key = fkey(sc[s]);
                    if ((key & mask) == prefix) atomicAdd(&hist[(key >> shift) & 255], 1u);
                }
                __syncthreads();
                if (tid == 0) {
                    int cum = 0, bin = 255;
                    for (; bin > 0; --bin) { if (cum + (int)hist[bin] >= need) break; cum += hist[bin]; }
                    misc[0] = bin; misc[1] = need - cum;
                }
                __syncthreads();
                prefix |= (unsigned)misc[0] << shift; mask |= 0xFFu << shift; need = misc[1];
                __syncthreads();
            }
            const int base = tid * 8;
            int cg = 0, ce = 0;
            for (int i = 0; i < 8; ++i) { int s = base + i; if (s < nvalid) { unsigned key = fkey(sc[s]); cg += key > prefix; ce += key == prefix; } }
            scanA[tid] = ce;
            __syncthreads();
            if (tid == 0) { int run = 0; for (int i = 0; i < NT; ++i) { int v = scanA[i]; scanA[i] = run; run += v; } }
            __syncthreads();
            const int preE = scanA[tid];
            int takeE = need - preE; takeE = takeE < 0 ? 0 : (takeE > ce ? ce : takeE);
            scanB[tid] = cg + takeE;
            __syncthreads();
            if (tid == 0) { int run = 0; for (int i = 0; i < NT; ++i) { int v = scanB[i]; scanB[i] = run; run += v; } }
            __syncthreads();
            int off = scanB[tid], te = 0;
            for (int i = 0; i < 8; ++i) {
                int s = base + i;
                if (s < nvalid) {
                    unsigned key = fkey(sc[s]);
                    bool take = key > prefix;
                    if (key == prefix) { take = te < takeE; ++te; }
                    if (take) { if (off < TOPK) sel[off] = s; ++off; }
                }
            }
        }
        __syncthreads();
        {
            const int j = tid & 255, n = tid >> 8;
            if (j < nsel) {
                const unsigned char* kr = (const unsigned char*)kk + ((size_t)b * SEQ + sel[j]) * 128 + n * 64;
                float kf[64];
#pragma unroll
                for (int d8 = 0; d8 < 8; ++d8) {
                    f32x4 a, bb; unpack8_fp8(*(const uint2*)(kr + d8 * 8), a, bb); a *= (1.f / 16.f); bb *= (1.f / 16.f);
                    kf[d8 * 8] = a[0]; kf[d8 * 8 + 1] = a[1]; kf[d8 * 8 + 2] = a[2]; kf[d8 * 8 + 3] = a[3];
                    kf[d8 * 8 + 4] = bb[0]; kf[d8 * 8 + 5] = bb[1]; kf[d8 * 8 + 6] = bb[2]; kf[d8 * 8 + 7] = bb[3];
                }
#pragma unroll
                for (int hh = 0; hh < 4; ++hh) {
                    const int h = n * 4 + hh;
                    float d = 0.f;
#pragma unroll
                    for (int dd = 0; dd < 64; ++dd) d += qs[h * 64 + dd] * kf[dd];
                    pl[h * 256 + j] = d * 0.125f;
                }
            } else {
#pragma unroll
                for (int hh = 0; hh < 4; ++hh) pl[(n * 4 + hh) * 256 + j] = -1e30f;
            }
        }
        __syncthreads();
        {
            const int h = tid >> 6, l = tid & 63;
            float vals[4]; float mx = -3e38f;
#pragma unroll
            for (int i = 0; i < 4; ++i) { vals[i] = pl[h * 256 + l + 64 * i]; mx = fmaxf(mx, vals[i]); }
#pragma unroll
            for (int o = 32; o >= 1; o >>= 1) mx = fmaxf(mx, __shfl_xor(mx, o));
            float sm = 0.f;
#pragma unroll
            for (int i = 0; i < 4; ++i) { vals[i] = __expf(vals[i] - mx); sm += vals[i]; }
            sm = wave_sum(sm);
            float inv = 1.f / sm;
#pragma unroll
            for (int i = 0; i < 4; ++i) pl[h * 256 + l + 64 * i] = vals[i] * inv;
        }
        __syncthreads();
        {
            const int h = tid >> 6, d = tid & 63, n = h >> 2;
            float a = 0.f;
            for (int j = 0; j < nsel; ++j) {
                const unsigned wv = *(const unsigned*)((const unsigned char*)vv + ((size_t)b * SEQ + sel[j]) * 128 + n * 64 + (d & ~3));
                const f32x2_t pv0 = __builtin_amdgcn_cvt_pk_f32_fp8((int)wv, false), pv1 = __builtin_amdgcn_cvt_pk_f32_fp8((int)wv, true);
                const float vsel = (d & 2) ? ((d & 1) ? pv1[1] : pv1[0]) : ((d & 1) ? pv0[1] : pv0[0]);
                const int pq = __builtin_amdgcn_cvt_pk_fp8_f32(pl[h * 256 + j] * 256.f, 0.f, 0, false);
                const f32x2_t pd = __builtin_amdgcn_cvt_pk_f32_fp8(pq, false);
                a += pd[0] * vsel * (1.f / 4096.f);
            }
            yatt[(size_t)row * 512 + tid] = (bf16_t)f2bf(a);
        }
    }
}


typedef short v4i16_t __attribute__((ext_vector_type(4)));
constexpr int DSA_KSTR = 8200, DSA_SEL_OFF = 16 * DSA_KSTR, DSA_NSEL_OFF = DSA_SEL_OFF + 8192, DSA_HIST_OFF = DSA_NSEL_OFF + 256, DSA_VST = 5120;
__device__ __forceinline__ int mbcnt64(unsigned long long m) { return __builtin_amdgcn_mbcnt_hi((unsigned)(m >> 32), __builtin_amdgcn_mbcnt_lo((unsigned)m, 0u)); }

__device__ __forceinline__ void dsa_item(const Params& p, unsigned char* smem, unsigned yatt_off, int b, int tt, int lane_in, int wave) {
    const unsigned char* W = p.ws;
    constexpr unsigned O_QI = WS_QI << 20, O_KI = WS_KI << 20, O_WI = WS_WI << 20, O_Q = WS_Q << 20, O_K = WS_K << 20, O_V = WS_V << 20;
    const int t0 = tt * 16;
    __syncthreads();
#ifndef DSA_RA
#define DSA_RA 1
#endif
#ifndef DSA_RB
#define DSA_RB 1
#endif
#ifndef DSA_RC
#define DSA_RC 1
#endif
    _Pragma("unroll 1") for (int ra_ = 0; ra_ < DSA_RA; ++ra_) {
        int lane = lane_in; asm volatile("" : "+v"(lane));
        const int g = lane >> 4, c = lane & 15;
        const unsigned qrow = (unsigned)(b * SEQ + t0 + c);
        bf16x8 qf[8]; float wv[8];
#pragma unroll
        for (int h = 0; h < 8; ++h) { qf[h] = ldws<bf16x8>(W, O_QI + qrow * 512u + h * 64 + 16 * g); wv[h] = ldws<float>(W, O_WI + qrow * 32u + h * 4); }
        bf16x8 kf_next = ldws<bf16x8>(W, O_KI + (unsigned)(b * SEQ + (wave <= tt ? wave : tt) * 16 + c) * 64u + 16 * g);
#pragma unroll 1
        for (int kt = wave; kt <= tt; kt += NWAVES) {
            const bf16x8 kf = kf_next;
            { const int kn = kt + NWAVES <= tt ? kt + NWAVES : tt; kf_next = ldws<bf16x8>(W, O_KI + (unsigned)(b * SEQ + kn * 16 + c) * 64u + 16 * g); }
            f32x4 s = {0.f, 0.f, 0.f, 0.f};
#pragma unroll
            for (int h = 0; h < 8; ++h) {
                const f32x4 d = __builtin_amdgcn_mfma_f32_16x16x32_bf16(kf, qf[h], (f32x4){0.f, 0.f, 0.f, 0.f}, 0, 0, 0);
#pragma unroll
                for (int r = 0; r < 4; ++r) { const float dv = d[r]; const int ri = __float_as_int(dv); s[r] += wv[h] * __int_as_float(ri > 0 ? ri : 0); }
            }
            const bool diag = (kt == tt);
            unsigned kw[4];
#pragma unroll
            for (int r = 0; r < 4; ++r) {
                const _Float16 hv = (_Float16)s[r];
                const unsigned hb = (unsigned)__builtin_bit_cast(unsigned short, hv);
                const unsigned key = (hb & 0x8000u) ? (~hb & 0xffffu) : (hb | 0x8000u);
                const bool valid = !(diag && 4 * g + r > c);
                kw[r] = valid ? key : 0u;
                if (valid && ra_ == 0) atomicAdd((unsigned*)(smem + DSA_HIST_OFF) + c * 256 + (key >> 8), 1u);
            }
            *(uint2*)(smem + c * DSA_KSTR + (kt * 16 + 4 * g) * 2) = make_uint2(kw[0] | (kw[1] << 16), kw[2] | (kw[3] << 16));
        }
    }
    __syncthreads();
    unsigned short* selall = (unsigned short*)(smem + DSA_SEL_OFF);
    int* nselarr = (int*)(smem + DSA_NSEL_OFF);
#pragma unroll 1
    for (int rr = 0; rr < 2 * DSA_RB; ++rr) {
        int lane = lane_in; asm volatile("" : "+v"(lane));
        const int tl = wave * 2 + (rr & 1), nvalid = t0 + tl + 1;
        unsigned short* selrow = selall + tl * 256;
        if (nvalid <= TOPK) {
            for (int j = lane; j < TOPK; j += 64) selrow[j] = (unsigned short)(j < nvalid ? j : 0);
            if (lane == 0) nselarr[tl] = nvalid;
        } else {
            unsigned kk[64];
#pragma unroll
            for (int i = 0; i < 16; ++i) {
                const uint2 w = *(const uint2*)(smem + tl * DSA_KSTR + (i * 64 + lane) * 8);
                const int s0 = (i * 64 + lane) * 4;
                kk[4 * i + 0] = s0 + 0 < nvalid ? (w.x & 0xffffu) : 0u; kk[4 * i + 1] = s0 + 1 < nvalid ? (w.x >> 16) : 0u;
                kk[4 * i + 2] = s0 + 2 < nvalid ? (w.y & 0xffffu) : 0u; kk[4 * i + 3] = s0 + 3 < nvalid ? (w.y >> 16) : 0u;
            }
            unsigned* hist = (unsigned*)(smem + DSA_HIST_OFF) + tl * 256;
            const int ni = (nvalid + 255) >> 8;
            unsigned Bsel = 0u; int cabove = 0, nties = 0;
#pragma unroll 1
            for (int pass = 0; pass < 2; ++pass) {
                if (pass == 1) {
#pragma unroll
                    for (int i = 0; i < 16; ++i) {
                        if (i < ni) {
#pragma unroll
                            for (int e = 0; e < 4; ++e) { const unsigned k = kk[4 * i + e]; if ((k >> 8) == Bsel) atomicAdd(&hist[k & 255u], 1u); }
                        }
                    }
                    __builtin_amdgcn_s_waitcnt(0xC07F);
                    __builtin_amdgcn_wave_barrier();
                }
                const uint4 hv = *(const uint4*)(hist + 4 * lane);
                const int ls = (int)(hv.x + hv.y + hv.z + hv.w);
                const int pre_ = wave_incl_scan(ls);
                const int suf = __builtin_amdgcn_readlane(pre_, 63) - pre_ + ls;
                const int needp = TOPK - cabove;
                const int above = suf - ls;
                const bool mine = (above < needp) && (suf >= needp);
                int bsel_l = 0, ca_l = 0, hsel_l = 0;
                {
                    int cacc = above;
                    const int h3 = (int)hv.w, h2 = (int)hv.z, h1 = (int)hv.y, h0 = (int)hv.x;
                    if (cacc + h3 >= needp) { bsel_l = 3; ca_l = cacc; hsel_l = h3; }
                    else { cacc += h3; if (cacc + h2 >= needp) { bsel_l = 2; ca_l = cacc; hsel_l = h2; }
                        else { cacc += h2; if (cacc + h1 >= needp) { bsel_l = 1; ca_l = cacc; hsel_l = h1; } else { cacc += h1; bsel_l = 0; ca_l = cacc; hsel_l = h0; } } }
                }
                const unsigned long long mm = __ballot(mine);
                const int src = mm ? (int)__builtin_ctzll(mm) : 0;
                const int bb = __shfl(4 * lane + bsel_l, src), ca = __shfl(ca_l, src);
                nties = __shfl(hsel_l, src);
                if (pass == 0) {
                    Bsel = (unsigned)bb; cabove = ca;
                    __builtin_amdgcn_wave_barrier();
                    hist[lane] = 0u; hist[lane + 64] = 0u; hist[lane + 128] = 0u; hist[lane + 192] = 0u;
                    __builtin_amdgcn_s_waitcnt(0xC07F);
                    __builtin_amdgcn_wave_barrier();
                } else { Bsel = (Bsel << 8) | (unsigned)bb; cabove += ca; }
            }
            const unsigned T = Bsel;
            const int need = TOPK - cabove;
            if (nties == need) {
                int cntl = 0;
#pragma unroll
                for (int i = 0; i < 16; ++i) if (i < ni) {
#pragma unroll
                    for (int e = 0; e < 4; ++e) cntl += (kk[4 * i + e] >= T) ? 1 : 0;
                }
                const int pre = wave_incl_scan(cntl);
                int pos = pre - cntl;
#pragma unroll
                for (int i = 0; i < 16; ++i) if (i < ni) {
#pragma unroll
                    for (int e = 0; e < 4; ++e) { if (kk[4 * i + e] >= T) { if (pos < TOPK) selrow[pos] = (unsigned short)((i * 64 + lane) * 4 + e); ++pos; } }
                }
            } else {
                int tiebase = 0, sbase = 0;
#pragma unroll
                for (int i = 0; i < 16; ++i) {
                    int below = 0, tot = 0;
#pragma unroll
                    for (int e = 0; e < 4; ++e) { const unsigned long long m = __ballot(kk[4 * i + e] == T); below += mbcnt64(m); tot += __builtin_popcountll(m); }
                    int own = 0; bool take[4];
#pragma unroll
                    for (int e = 0; e < 4; ++e) { const bool tie = kk[4 * i + e] == T; take[e] = (kk[4 * i + e] > T) || (tie && (tiebase + below + own < need)); own += tie ? 1 : 0; }
                    tiebase += tot;
                    int belowS = 0, totS = 0;
#pragma unroll
                    for (int e = 0; e < 4; ++e) { const unsigned long long m = __ballot(take[e]); belowS += mbcnt64(m); totS += __builtin_popcountll(m); }
                    int ownS = 0;
#pragma unroll
                    for (int e = 0; e < 4; ++e) { if (take[e]) { const int pos = sbase + belowS + ownS; if (pos < TOPK) selrow[pos] = (unsigned short)((i * 64 + lane) * 4 + e); } ownS += take[e] ? 1 : 0; }
                    sbase += totS;
                }
            }
            if (lane == 0) nselarr[tl] = TOPK;
        }
        {
            unsigned* hz = (unsigned*)(smem + DSA_HIST_OFF) + tl * 256;
            hz[lane] = 0u; hz[lane + 64] = 0u; hz[lane + 128] = 0u; hz[lane + 192] = 0u;
        }
    }
    __builtin_amdgcn_s_waitcnt(0xC07F); __builtin_amdgcn_wave_barrier();
#pragma unroll 1
    for (int rn_ = 0; rn_ < 4 * DSA_RC; ++rn_) {
        const int rn = rn_ & 3;
        int lane = lane_in; asm volatile("" : "+v"(lane));
        const int g = lane >> 4, c = lane & 15;
        const int rr = rn >> 1, n = rn & 1;
        unsigned char* vst = smem + (2 * wave) * DSA_KSTR;
        const int tl = wave * 2 + rr;
        const unsigned rowg = (unsigned)(b * SEQ + t0 + tl);
        const int nselg = nselarr[tl] - 4 * g;
        const unsigned short* selrow = selall + tl * 256;
        const unsigned kvb = O_K + (unsigned)(b * SEQ) * 128u + n * 64 + 16 * g;
        const unsigned vvb = O_V + (unsigned)(b * SEQ) * 128u + n * 64 + (lane & 3) * 16;
        long qha = 0, qhb = 0, qla = 0, qlb = 0;
        if (c < 4) {
            const unsigned qo = O_Q + rowg * 1024u + (n * 4 + c) * 128 + 32 * g;
            f32x4 q0, q1, q2, q3; unpack8(ldws<u32x4>(W, qo), q0, q1); unpack8(ldws<u32x4>(W, qo + 16), q2, q3);
            q0 *= 16.f; q1 *= 16.f; q2 *= 16.f; q3 *= 16.f;
            const uint2 ha = pack8_fp8(q0, q1), hb = pack8_fp8(q2, q3);
            f32x4 d0, d1, d2, d3; unpack8_fp8(ha, d0, d1); unpack8_fp8(hb, d2, d3);
            const uint2 la = pack8_fp8(q0 - d0, q1 - d1), lb = pack8_fp8(q2 - d2, q3 - d3);
            qha = (long)(((unsigned long long)ha.y << 32) | ha.x); qhb = (long)(((unsigned long long)hb.y << 32) | hb.x);
            qla = (long)(((unsigned long long)la.y << 32) | la.x); qlb = (long)(((unsigned long long)lb.y << 32) | lb.x);
        }
        f32x4 S[16];
#pragma unroll
        for (int tile = 0; tile < 16; ++tile) {
            const unsigned key = selrow[tile * 16 + c];
            const u32x4 kw = ldws<u32x4>(W, kvb + key * 128u);
            const long ka = (long)(((unsigned long long)kw.y << 32) | kw.x), kb = (long)(((unsigned long long)kw.w << 32) | kw.z);
            f32x4 acc = __builtin_amdgcn_mfma_f32_16x16x32_fp8_fp8(ka, qha, (f32x4){0.f, 0.f, 0.f, 0.f}, 0, 0, 0);
            acc = __builtin_amdgcn_mfma_f32_16x16x32_fp8_fp8(kb, qhb, acc, 0, 0, 0);
            acc = __builtin_amdgcn_mfma_f32_16x16x32_fp8_fp8(ka, qla, acc, 0, 0, 0);
            S[tile] = __builtin_amdgcn_mfma_f32_16x16x32_fp8_fp8(kb, qlb, acc, 0, 0, 0);
        }
        u32x4 vra[8];
#pragma unroll
        for (int i = 0; i < 8; ++i) { const unsigned key = selrow[i * 16 + (lane >> 2)]; vra[i] = ldws<u32x4>(W, vvb + key * 128u); }
        float Pk[4][4];
        {
            const int nselc = nselarr[tl] - 4 * g - 16 * (c >> 2);
            float mx = -3e38f;
#pragma unroll
            for (int q4 = 0; q4 < 4; ++q4)
#pragma unroll
                for (int r = 0; r < 4; ++r) {
                    float v = S[4 * q4][r];
                    v = dppf<0x114, 0xf, 0x2, false>(v, S[4 * q4 + 1][r]);
                    v = dppf<0x118, 0xf, 0x4, false>(v, S[4 * q4 + 2][r]);
                    v = dppf<0x11C, 0xf, 0x8, false>(v, S[4 * q4 + 3][r]);
                    v = (64 * q4 + r) < nselc ? v : -1e30f;
                    Pk[q4][r] = v; mx = fmaxf(mx, v);
                }
            mx = fmaxf(mx, dppf<0x124, 0xf, 0xf, false>(mx, mx)); mx = fmaxf(mx, dppf<0x128, 0xf, 0xf, false>(mx, mx));
            mx = fmaxf(mx, __shfl_xor(mx, 16)); mx = fmaxf(mx, __shfl_xor(mx, 32));
            float sum = 0.f;
#pragma unroll
            for (int q4 = 0; q4 < 4; ++q4)
#pragma unroll
                for (int r = 0; r < 4; ++r) { const float e = __expf((Pk[q4][r] - mx) * (0.125f / 256.f)); Pk[q4][r] = e; sum += e; }
            sum += dppf<0x124, 0xf, 0xf, false>(sum, sum); sum += dppf<0x128, 0xf, 0xf, false>(sum, sum);
            sum += __shfl_xor(sum, 16); sum += __shfl_xor(sum, 32);
            const float invs = 256.f * __builtin_amdgcn_rcpf(sum);
#pragma unroll
            for (int q4 = 0; q4 < 4; ++q4)
#pragma unroll
                for (int r = 0; r < 4; ++r) Pk[q4][r] *= invs;
#pragma unroll
            for (int q4 = 0; q4 < 4; ++q4)
#pragma unroll
                for (int r = 0; r < 4; ++r) {
                    const float pv = Pk[q4][r];
                    S[4 * q4][r] = pv;
                    S[4 * q4 + 1][r] = dppf<0x104, 0xf, 0xf, false>(pv, pv);
                    S[4 * q4 + 2][r] = dppf<0x108, 0xf, 0xf, false>(pv, pv);
                    S[4 * q4 + 3][r] = dppf<0x10C, 0xf, 0xf, false>(pv, pv);
                }
        }
        f32x4 O[4];
#pragma unroll
        for (int dt = 0; dt < 4; ++dt) O[dt] = (f32x4){0.f, 0.f, 0.f, 0.f};
        const LAS unsigned char* vp = (const LAS unsigned char*)(vst + (16 * (g >> 1) + 8 * (g & 1) + 4 * ((c >> 1) >> 2) + ((c >> 1) & 3)) * 80 + (c & 1) * 8);
        typedef int v2i32_t __attribute__((ext_vector_type(2)));
#pragma unroll
        for (int hv = 0; hv < 2; ++hv) {
            u32x4 vr[8];
            if (hv == 0) {
#pragma unroll
                for (int i = 0; i < 8; ++i) vr[i] = vra[i];
            } else {
#pragma unroll
                for (int i = 0; i < 8; ++i) { const unsigned key = selrow[128 + i * 16 + (lane >> 2)]; vr[i] = ldws<u32x4>(W, vvb + key * 128u); }
            }
#pragma unroll
            for (int k4 = 0; k4 < 4; ++k4) {
                const int ks2 = hv * 4 + k4;
                __builtin_amdgcn_wave_barrier();
#pragma unroll
                for (int i2 = 0; i2 < 2; ++i2) {
                    const int slot = 16 * (lane >> 5) + 8 * ((lane >> 4) & 1) + 4 * i2 + ((lane >> 2) & 3);
                    *(u32x4*)(vst + slot * 80 + (lane & 3) * 16) = vr[k4 * 2 + i2];
                }
                __builtin_amdgcn_s_waitcnt(0xC07F);
                __builtin_amdgcn_wave_barrier();
                const uint2 pw = pack8_fp8(S[2 * ks2], S[2 * ks2 + 1]);
                const long pa = (long)(((unsigned long long)pw.y << 32) | pw.x);
#pragma unroll
                for (int dt = 0; dt < 4; ++dt) {
                    const v2i32_t l0 = __builtin_amdgcn_ds_read_tr8_b64_v2i32((LAS v2i32_t*)(vp + dt * 16));
                    const long vb = (long)(((unsigned long long)(unsigned)l0[1] << 32) | (unsigned)l0[0]);
                    O[dt] = __builtin_amdgcn_mfma_f32_16x16x32_fp8_fp8(pa, vb, O[dt], 0, 0, 0);
                }
            }
        }
        if (g == 0) {
            bf16_t* yo = (bf16_t*)(p.ws + yatt_off) + (size_t)rowg * 512 + n * 256 + c;
#pragma unroll
            for (int dt = 0; dt < 4; ++dt)
#pragma unroll
                for (int r = 0; r < 4; ++r) yo[r * 64 + dt * 16] = (bf16_t)f2bf(O[dt][r] * (1.f / 4096.f));
        }
    }
}

__device__ __forceinline__ void phase_dsa(const Params& p, unsigned char* smem, unsigned yatt_off, int vcu, int G) {
    int tid = threadIdx.x; asm volatile("" : "+v"(tid));
    const int lane = tid & 63, wave = __builtin_amdgcn_readfirstlane(tid >> 6);
    { unsigned* hz = (unsigned*)(smem + DSA_HIST_OFF); for (int i = tid; i < 16 * 256; i += NT) hz[i] = 0u; }
    const bool bal = (G == 256);
    const int nit = bal ? 8 : (NB * 256 - vcu + G - 1) / G;
#pragma unroll 1
    for (int it = 0; it < nit; ++it) {
        int b, tt;
        if (bal) { const int j = vcu & 31; b = vcu >> 5; tt = (it >> 1) * 64 + ((it & 1) ? 63 - j : j); }
        else { const int item = vcu + it * G; b = item >> 8; tt = item & 255; }
        dsa_item(p, smem, yatt_off, b, tt, lane, wave);
#if PEER_FP8
        {
            if (bal) {
                const int slots = G * NWAVES * 8, per = (2 * 16384 + slots - 1) / slots;
                const int s0 = ((vcu * NWAVES + wave) * 8 + it) * per;
                for (int r = s0; r < s0 + per && r < 2 * 16384; ++r) peer_table_row(p, r, lane, smem + DSA_HIST_OFF + 16384 + wave * 768);
            }
        }
#endif
    }
#if PEER_FP8
    if (!bal) for (int r = vcu * NWAVES + wave; r < 2 * 16384; r += G * NWAVES) peer_table_row(p, r, lane, smem + DSA_HIST_OFF + 16384 + wave * 768);
#endif
}

template <bool DRY>
__device__ __forceinline__ void phase_peer(const Params& p, unsigned char* smem, int vcu, int G) {
    int tid_ = threadIdx.x; asm volatile("" : "+v"(tid_)); const int wave = tid_ >> 6, lane = tid_ & 63;
    float* wsm = (float*)smem + wave * 1024;
    float* sc = wsm;
    float* v1s = wsm + 256; int* i1s = (int*)(wsm + 272); float* v2s = wsm + 288; int* i2s = (int*)(wsm + 304);
    float* tops = wsm + 320;
    int* tope = (int*)(wsm + 336);
    int* eid = (int*)(wsm + 384);
    float* egate = wsm + 512;
    const float* scores = WSP(float, WS_SCORES);
    const bf16_t* hg = WSP(bf16_t, WS_HG);
    const float* rss = WSP(float, WS_RSS);
    const bf16_t* ut = WSP(bf16_t, WS_UTAB); const bf16_t* vt = WSP(bf16_t, WS_VTAB);
    const int nwaves = G * NWAVES;
    int ca = 0, cb = 0;
    {
        int rem = lane; bool found = false;
#pragma unroll
        for (int a = 0; a < 16; ++a) { int cnt = 16 / (a + 1); if (!found) { if (rem < cnt) { ca = a; cb = rem; found = true; } else rem -= cnt; } }
    }
    for (int row = vcu * NWAVES + wave; row < MTOK; row += nwaves) {
        float rs;
        {
            float t = lane < 16 ? rss[(size_t)row * 16 + lane] : 0.f;
            t = wave_sum(t);
            rs = rsqrtf(t * (1.f / DM) + NORM_EPS);
        }
        for (int h = 0; h < PEER_H; ++h) {
            const float* sp = scores + (size_t)row * 2048 + h * 256;
            float a0 = sp[lane], a1 = sp[lane + 64], b0 = sp[128 + lane], b1 = sp[192 + lane];
            __builtin_amdgcn_wave_barrier();
            sc[lane] = a0; sc[lane + 64] = a1; sc[128 + lane] = b0; sc[192 + lane] = b1;
            __builtin_amdgcn_s_waitcnt(0);
            __builtin_amdgcn_wave_barrier();
            int ra0 = 0, ra1 = 0, rb0 = 0, rb1 = 0;
            for (int j = 0; j < 64; ++j) {
                float x = sc[j], y = sc[j + 64], z = sc[128 + j], w = sc[192 + j];
                ra0 += (x > a0) || (x == a0 && j < lane); ra0 += (y > a0);
                ra1 += (x >= a1); ra1 += (y > a1) || (y == a1 && j < lane);
                rb0 += (z > b0) || (z == b0 && j < lane); rb0 += (w > b0);
                rb1 += (z >= b1); rb1 += (w > b1) || (w == b1 && j < lane);
            }
            if (ra0 < 16) { v1s[ra0] = a0; i1s[ra0] = lane; }
            if (ra1 < 16) { v1s[ra1] = a1; i1s[ra1] = lane + 64; }
            if (rb0 < 16) { v2s[rb0] = b0; i2s[rb0] = lane; }
            if (rb1 < 16) { v2s[rb1] = b1; i2s[rb1] = lane + 64; }
            __builtin_amdgcn_s_waitcnt(0);
            __builtin_amdgcn_wave_barrier();
            float cv = -3e38f; int cpos = 1 << 20;
            if (lane < 50) { cv = v1s[ca] + v2s[cb]; cpos = ca * 16 + cb; }
            int rk = 0;
            for (int j = 0; j < 50; ++j) {
                float x = __shfl(cv, j); int px = __shfl(cpos, j);
                rk += (x > cv) || (x == cv && px < cpos);
            }
            if (lane < 50 && rk < 16) { tops[rk] = cv; tope[rk] = i1s[ca] * PEER_KEYS + i2s[cb]; }
            __builtin_amdgcn_s_waitcnt(0);
            __builtin_amdgcn_wave_barrier();
            if (lane < 16) {
                float s = tops[lane] * rs;
                float mx = s;
#pragma unroll
                for (int o = 8; o >= 1; o >>= 1) mx = fmaxf(mx, __shfl_xor(mx, o, 16));
                float e = __expf(s - mx), sm = e;
#pragma unroll
                for (int o = 8; o >= 1; o >>= 1) sm += __shfl_xor(sm, o, 16);
                eid[h * 16 + lane] = tope[lane];
                egate[h * 16 + lane] = e / sm;
            }
            __builtin_amdgcn_s_waitcnt(0);
            __builtin_amdgcn_wave_barrier();
        }
        f32x4 xv[4], acc[4];
        {
            const bf16_t* hr = hg + (size_t)row * DM;
            unpack8(*(const u32x4*)(hr + lane * 8), xv[0], xv[1]);
            unpack8(*(const u32x4*)(hr + 512 + lane * 8), xv[2], xv[3]);
#pragma unroll
            for (int i = 0; i < 4; ++i) { xv[i] = xv[i] * rs; acc[i] = (f32x4){0.f, 0.f, 0.f, 0.f}; }
        }
        for (int e0 = 0; e0 < 128; e0 += 4) {
            u32x4 uw[4][2], vw[4][2];
#pragma unroll
            for (int e = 0; e < 4; ++e) {
                const bf16_t* ur = ut + (size_t)eid[e0 + e] * DM;
                uw[e][0] = *(const u32x4*)(ur + lane * 8); uw[e][1] = *(const u32x4*)(ur + 512 + lane * 8);
            }
#pragma unroll
            for (int e = 0; e < 4; ++e) {
                const bf16_t* vr = vt + (size_t)eid[e0 + e] * DM;
                vw[e][0] = *(const u32x4*)(vr + lane * 8); vw[e][1] = *(const u32x4*)(vr + 512 + lane * 8);
            }
            float act[4];
#pragma unroll
            for (int e = 0; e < 4; ++e) {
                f32x4 u0, u1, u2, u3; unpack8(uw[e][0], u0, u1); unpack8(uw[e][1], u2, u3);
                f32x4 s4 = xv[0] * u0 + xv[1] * u1 + xv[2] * u2 + xv[3] * u3;
                float d = wave_sum((s4[0] + s4[1]) + (s4[2] + s4[3]));
                act[e] = gelu_tanh(d) * egate[e0 + e];
            }
#pragma unroll
            for (int e = 0; e < 4; ++e) {
                f32x4 v0, v1, v2, v3; unpack8(vw[e][0], v0, v1); unpack8(vw[e][1], v2, v3);
                acc[0] += v0 * act[e]; acc[1] += v1 * act[e]; acc[2] += v2 * act[e]; acc[3] += v3 * act[e];
            }
        }
        float* hr = p.out + (size_t)row * DM;
        float ss = 0.f;
        if (DRY) { const float chk = acc[0][0] + acc[1][1] + acc[2][2] + acc[3][3]; if (chk == 1.2345678f) hr[lane] = chk; continue; }
#pragma unroll
        for (int c = 0; c < 2; ++c) {
            acc[2 * c] += *(const f32x4*)(hr + c * 512 + lane * 8); acc[2 * c + 1] += *(const f32x4*)(hr + c * 512 + lane * 8 + 4);
        }
#pragma unroll
        for (int i = 0; i < 4; ++i) ss += acc[i][0] * acc[i][0] + acc[i][1] * acc[i][1] + acc[i][2] * acc[i][2] + acc[i][3] * acc[i][3];
        ss = wave_sum(ss);
        float scl = rsqrtf(ss * (1.f / DM) + NORM_EPS);
#if defined(PROBE_ATTN) || defined(PROBE_SSM)
        {
            const float e = ((const float*)p.ws)[16] / fmaxf(((const float*)p.ws)[17], 1e-30f);
            int kx = 0; if (e > 1e-6f) kx++; if (e > 1e-5f) kx++; if (e > 1e-4f) kx++; if (e > 1e-3f) kx++; if (e > 1e-2f) kx++; if (e > 1e-1f) kx++; if (!(e == e)) kx = 8;
            scl *= 1.f + 0.05f * kx;
        }
#endif
#pragma unroll
        for (int c = 0; c < 2; ++c) {
            f32x4 ga = *(const f32x4*)(p.norm_f_g + c * 512 + lane * 8), gb = *(const f32x4*)(p.norm_f_g + c * 512 + lane * 8 + 4);
            *(f32x4*)(hr + c * 512 + lane * 8) = acc[2 * c] * scl * ga; *(f32x4*)(hr + c * 512 + lane * 8 + 4) = acc[2 * c + 1] * scl * gb;
        }
    }
}


template <int MODE>
__device__ __forceinline__ void phase_peer2(const Params& p, unsigned char* smem, int vcu, int G) {
    int tid_ = threadIdx.x; asm volatile("" : "+v"(tid_));
    const int wave = __builtin_amdgcn_readfirstlane(tid_ >> 6), lane = tid_ & 63;
    const int gq = lane >> 4, c = lane & 15;
    unsigned char* wsm = smem + wave * 4096;
    bf16_t* xl = (bf16_t*)wsm;
    float* lv = (float*)(wsm + 2048);
    int* li = (int*)(wsm + 2048 + 128);
    float* vs = (float*)(wsm + 2048 + 256);
    int* is_ = (int*)(wsm + 2048 + 384);
    int* eid = (int*)(wsm + 2048 + 512);
    float* egate = (float*)(wsm + 2048 + 1024);
    float* eusc = (float*)(wsm + 2048 + 1536);
    const unsigned char* W = p.ws;
    constexpr unsigned O_SC = WS_SCORES << 20, O_HG = WS_HG << 20, O_UT = WS_UTAB << 20, O_VT = WS_VTAB << 20;
    const float* rss = WSP(float, WS_RSS);
    const int nwaves = G * NWAVES;
    int ca = 0, cb = 0;
    {
        int rem = lane; bool found = false;
#pragma unroll
        for (int a = 0; a < 16; ++a) { const int cnt = 16 / (a + 1); if (!found) { if (rem < cnt) { ca = a; cb = rem; found = true; } else rem -= cnt; } }
    }
#pragma unroll 1
    for (int row = vcu * NWAVES + wave; row < MTOK; row += nwaves) {
        float rs;
        { float t = lane < 16 ? rss[(size_t)row * 16 + lane] : 0.f; t = wave_sum(t); rs = rsqrtf(t * (1.f / DM) + NORM_EPS); }
        {
            const u32x4 w0 = ldws<u32x4>(W, O_HG + (unsigned)row * 2048u + lane * 16), w1 = ldws<u32x4>(W, O_HG + (unsigned)row * 2048u + 1024 + lane * 16);
#if PEER_FP8
            f32x4 xa[4]; unpack8(w0, xa[0], xa[1]); unpack8(w1, xa[2], xa[3]);
            xa[0] *= *(const f32x4*)(p.norm2_g + lane * 8); xa[1] *= *(const f32x4*)(p.norm2_g + lane * 8 + 4); xa[2] *= *(const f32x4*)(p.norm2_g + 512 + lane * 8); xa[3] *= *(const f32x4*)(p.norm2_g + 512 + lane * 8 + 4);
            unsigned hw[4], lw[4];
#pragma unroll
            for (int i = 0; i < 4; ++i) {
                typedef float f32x2_ __attribute__((ext_vector_type(2)));
                const f32x4 xs = xa[i] * 16.f;
                int h = __builtin_amdgcn_cvt_pk_fp8_f32(xs[0], xs[1], 0, false); h = __builtin_amdgcn_cvt_pk_fp8_f32(xs[2], xs[3], h, true);
                const f32x2_ b0 = __builtin_amdgcn_cvt_pk_f32_fp8(h, false), b1 = __builtin_amdgcn_cvt_pk_f32_fp8(h, true);
                int l = __builtin_amdgcn_cvt_pk_fp8_f32((xs[0] - b0[0]) * 16.f, (xs[1] - b0[1]) * 16.f, 0, false); l = __builtin_amdgcn_cvt_pk_fp8_f32((xs[2] - b1[0]) * 16.f, (xs[3] - b1[1]) * 16.f, l, true);
                hw[i] = (unsigned)h; lw[i] = (unsigned)l;
            }
            *(uint2*)(wsm + lane * 8) = make_uint2(hw[0], hw[1]); *(uint2*)(wsm + 512 + lane * 8) = make_uint2(hw[2], hw[3]);
            *(uint2*)(wsm + 1024 + lane * 8) = make_uint2(lw[0], lw[1]); *(uint2*)(wsm + 1536 + lane * 8) = make_uint2(lw[2], lw[3]);
#else
            *(u32x4*)(wsm + lane * 16) = w0; *(u32x4*)(wsm + 1024 + lane * 16) = w1;
#endif
        }
#ifdef PROBE_NOTOPK
        if (MODE == 1) { eid[lane] = (row * 131 + lane * 977) & 16383; eid[lane + 64] = (row * 137 + lane * 1499 + 7) & 16383; egate[lane] = 0.0625f; egate[lane + 64] = 0.0625f; eusc[lane] = 1.f; eusc[lane + 64] = 1.f; }
        else
#endif
#pragma unroll 1
        for (int h = 0; h < PEER_H; ++h) {
            const unsigned so = O_SC + (unsigned)row * 4096u + h * 512 + lane * 2;
            const unsigned short ha0 = ldws<unsigned short>(W, so), ha1 = ldws<unsigned short>(W, so + 128), hb0 = ldws<unsigned short>(W, so + 256), hb1 = ldws<unsigned short>(W, so + 384);
            const float a0 = (float)__builtin_bit_cast(_Float16, ha0), a1 = (float)__builtin_bit_cast(_Float16, ha1), b0 = (float)__builtin_bit_cast(_Float16, hb0), b1 = (float)__builtin_bit_cast(_Float16, hb1);
#define K16(hb) ((((unsigned)(hb) & 0x8000u) ? (~(unsigned)(hb) & 0xffffu) : ((unsigned)(hb) | 0x8000u)) << 16)
            const unsigned ka0 = K16(ha0) | (0xFFFFu - (unsigned)lane), ka1 = K16(ha1) | (0xFFFFu - 64u - (unsigned)lane);
            const unsigned kb0 = K16(hb0) | (0xFFFFu - (unsigned)lane), kb1 = K16(hb1) | (0xFFFFu - 64u - (unsigned)lane);
#undef K16
            unsigned long long loA = 0, hiA = 1ull << 32, loB = 0, hiB = 1ull << 32; bool doneA = false, doneB = false;
            while (!(doneA && doneB)) {
                if (!doneA) { const unsigned mid = (unsigned)((loA + hiA) >> 1); const int cnt = __builtin_popcountll(__ballot(ka0 >= mid)) + __builtin_popcountll(__ballot(ka1 >= mid));
                    if (cnt >= 16) loA = mid; else hiA = mid; doneA = (cnt == 16) || (hiA - loA <= 1); }
                if (!doneB) { const unsigned mid = (unsigned)((loB + hiB) >> 1); const int cnt = __builtin_popcountll(__ballot(kb0 >= mid)) + __builtin_popcountll(__ballot(kb1 >= mid));
                    if (cnt >= 16) loB = mid; else hiB = mid; doneB = (cnt == 16) || (hiB - loB <= 1); }
            }
            __builtin_amdgcn_wave_barrier();
            {
                const unsigned T = (unsigned)loA;
                const bool k0 = ka0 >= T, k1 = ka1 >= T;
                const unsigned long long s0 = __ballot(k0), s1 = __ballot(k1);
                if (k0) { const int pos = mbcnt64(s0); lv[pos] = a0; li[pos] = lane; }
                if (k1) { const int pos = __builtin_popcountll(s0) + mbcnt64(s1); if (pos < 16) { lv[pos] = a1; li[pos] = lane + 64; } }
            }
            {
                const unsigned T = (unsigned)loB;
                const bool k0 = kb0 >= T, k1 = kb1 >= T;
                const unsigned long long s0 = __ballot(k0), s1 = __ballot(k1);
                if (k0) { const int pos = mbcnt64(s0); lv[16 + pos] = b0; li[16 + pos] = lane; }
                if (k1) { const int pos = __builtin_popcountll(s0) + mbcnt64(s1); if (pos < 16) { lv[16 + pos] = b1; li[16 + pos] = lane + 64; } }
            }
            __builtin_amdgcn_s_waitcnt(0xC07F);
            __builtin_amdgcn_wave_barrier();
            if (lane < 32) {
                const int base = lane & 16, me = lane & 15;
                const float mv = lv[lane]; int rk = 0;
#pragma unroll
                for (int j = 0; j < 16; ++j) { const float x = lv[base + j]; rk += (x > mv) || (x == mv && j < me); }
                vs[base + rk] = mv; is_[base + rk] = li[lane];
            }
            __builtin_amdgcn_s_waitcnt(0xC07F);
            __builtin_amdgcn_wave_barrier();
            float cv = 0.f; unsigned kc = 0u;
            if (lane < 50) { cv = vs[ca] + vs[16 + cb]; kc = fkey(cv); }
            unsigned long long lo = fkey(vs[15] + vs[31]), hi = (unsigned long long)fkey(vs[0] + vs[16]) + 1ull;
            while (hi - lo > 1) {
                const unsigned mid = (unsigned)((lo + hi) >> 1); const int cnt = __builtin_popcountll(__ballot(kc >= mid));
                if (cnt >= 16) lo = mid; else hi = mid;
                if (cnt == 16) break;
            }
            const unsigned T2 = (unsigned)lo;
            const unsigned long long tm = __ballot(kc == T2);
            const int need2 = 16 - __builtin_popcountll(__ballot(kc > T2));
            const bool take = (kc > T2) || (kc == T2 && mbcnt64(tm) < need2);
            const float sv = take ? cv * rs : -3e38f;
            const float mx = wave_max(sv);
            const float ev = take ? __expf(sv - mx) : 0.f;
            const float sm = wave_sum(ev);
            if (take) { const int pos = mbcnt64(__ballot(take)); if (pos < 16) { const int e_ = is_[ca] * PEER_KEYS + is_[16 + cb]; eid[h * 16 + pos] = e_;
#if PEER_FP8
                egate[h * 16 + pos] = ev / sm * WSP(float, WS_VSC)[e_]; eusc[h * 16 + pos] = WSP(float, WS_USC)[e_];
#else
                egate[h * 16 + pos] = ev / sm;
#endif
            } }
            __builtin_amdgcn_wave_barrier();
        }
        __builtin_amdgcn_s_waitcnt(0xC07F);
        __builtin_amdgcn_wave_barrier();
#if PEER_FP8
        f32x4 acc[4];
#pragma unroll
        for (int i = 0; i < 4; ++i) acc[i] = (f32x4){0.f, 0.f, 0.f, 0.f};
        const unsigned koff = (unsigned)((c >> 3) * 64 + 16 * gq);
        u32x4 ub0[8], ub1[8], vb0[8], vb1[8];
#ifdef PROBE_L2GATHER
        if (MODE == 1) { eid[lane] &= 1023; eid[lane + 64] &= 1023; __builtin_amdgcn_s_waitcnt(0xC07F); __builtin_amdgcn_wave_barrier(); }
#endif
        int ec0 = eid[c & 7], ec1 = eid[8 + (c & 7)];
#pragma unroll
        for (int k3 = 0; k3 < 8; ++k3) ub0[k3] = ldws<u32x4>(W, O_UT + (unsigned)ec0 * 1024u + koff + k3 * 128);
#pragma unroll
        for (int j = 0; j < 8; ++j) vb0[j] = ldws<u32x4>(W, O_VT + (unsigned)__builtin_amdgcn_readlane(ec0, j) * 1024u + lane * 16);
#pragma unroll
        for (int k3 = 0; k3 < 8; ++k3) ub1[k3] = ldws<u32x4>(W, O_UT + (unsigned)ec1 * 1024u + koff + k3 * 128);
#define PEER_TILE(UB, EC, VBC, ECN, VBN)                                                                                           \
        {                                                                                                                          \
            f32x4 dh = {0.f, 0.f, 0.f, 0.f}, dl = {0.f, 0.f, 0.f, 0.f};                                                             \
            _Pragma("unroll") for (int k3 = 0; k3 < 8; ++k3) {                                                                     \
                const u32x4 xh = *(const u32x4*)(wsm + k3 * 128 + koff), xlo = *(const u32x4*)(wsm + 1024 + k3 * 128 + koff);      \
                const long u0 = (long)(((unsigned long long)UB[k3].y << 32) | UB[k3].x), u1 = (long)(((unsigned long long)UB[k3].w << 32) | UB[k3].z); \
                const long h0 = (long)(((unsigned long long)xh.y << 32) | xh.x), h1 = (long)(((unsigned long long)xh.w << 32) | xh.z);  \
                const long l0 = (long)(((unsigned long long)xlo.y << 32) | xlo.x), l1 = (long)(((unsigned long long)xlo.w << 32) | xlo.z); \
                dh = __builtin_amdgcn_mfma_f32_16x16x32_fp8_fp8(h0, u0, dh, 0, 0, 0);                                              \
                dh = __builtin_amdgcn_mfma_f32_16x16x32_fp8_fp8(h1, u1, dh, 0, 0, 0);                                              \
                dl = __builtin_amdgcn_mfma_f32_16x16x32_fp8_fp8(l0, u0, dl, 0, 0, 0);                                              \
                dl = __builtin_amdgcn_mfma_f32_16x16x32_fp8_fp8(l1, u1, dl, 0, 0, 0);                                              \
            }                                                                                                                      \
            float mine = dh[0] + dl[0] * (1.f / 16.f);                                                                             \
            mine += __shfl_xor(mine, 40);                                                       \
            const int ecur = EC;                                                                                                   \
            const float act = gelu_tanh(mine * (1.f / 16.f) * eusc[tcur * 8 + (c & 7)] * rs) * egate[tcur * 8 + (c & 7)];           \
            if (tcur + 2 < 16) {                                                                                                   \
                EC = eid[(tcur + 2) * 8 + (c & 7)];                                                                                \
                _Pragma("unroll") for (int k3 = 0; k3 < 8; ++k3) UB[k3] = ldws<u32x4>(W, O_UT + (unsigned)EC * 1024u + koff + k3 * 128); \
            }                                                                                                                      \
            if (tcur + 1 < 16) {                                                                                                   \
                _Pragma("unroll") for (int j = 0; j < 8; ++j) VBN[j] = ldws<u32x4>(W, O_VT + (unsigned)__builtin_amdgcn_readlane(ECN, j) * 1024u + lane * 16); \
            }                                                                                                                      \
            __builtin_amdgcn_sched_barrier(0);                                                                                     \
            _Pragma("unroll") for (int j = 0; j < 8; ++j) {                                                                        \
                const float aj = __builtin_bit_cast(float, __builtin_amdgcn_readlane(__builtin_bit_cast(int, act), j));            \
                const u32x4 vw = VBC[j];                                                                                           \
                typedef float f32x2_ __attribute__((ext_vector_type(2)));                                                          \
                const f32x2_ p0 = __builtin_amdgcn_cvt_pk_f32_fp8((int)vw.x, false), p1 = __builtin_amdgcn_cvt_pk_f32_fp8((int)vw.x, true); \
                const f32x2_ p2 = __builtin_amdgcn_cvt_pk_f32_fp8((int)vw.y, false), p3 = __builtin_amdgcn_cvt_pk_f32_fp8((int)vw.y, true); \
                const f32x2_ p4 = __builtin_amdgcn_cvt_pk_f32_fp8((int)vw.z, false), p5 = __builtin_amdgcn_cvt_pk_f32_fp8((int)vw.z, true); \
                const f32x2_ p6 = __builtin_amdgcn_cvt_pk_f32_fp8((int)vw.w, false), p7 = __builtin_amdgcn_cvt_pk_f32_fp8((int)vw.w, true); \
                acc[0] += (f32x4){p0[0], p0[1], p1[0], p1[1]} * aj; acc[1] += (f32x4){p2[0], p2[1], p3[0], p3[1]} * aj;             \
                acc[2] += (f32x4){p4[0], p4[1], p5[0], p5[1]} * aj; acc[3] += (f32x4){p6[0], p6[1], p7[0], p7[1]} * aj;             \
            }                                                                                                                      \
            __builtin_amdgcn_sched_barrier(0);                                                                                     \
        }
#pragma unroll 1
        for (int tp = 0; tp < 8; ++tp) {
            { const int tcur = 2 * tp; PEER_TILE(ub0, ec0, vb0, ec1, vb1) }
            { const int tcur = 2 * tp + 1; PEER_TILE(ub1, ec1, vb1, ec0, vb0) }
        }
#undef PEER_TILE
#else
        f32x4 acc[4];
#pragma unroll
        for (int i = 0; i < 4; ++i) acc[i] = (f32x4){0.f, 0.f, 0.f, 0.f};
        bf16x8 ubuf[32];
        int ec = eid[c]; float gc = egate[c];
        {
            const unsigned ub = O_UT + (unsigned)ec * 2048u + 16 * gq;
#pragma unroll
            for (int ks = 0; ks < 32; ++ks) ubuf[ks] = ldws<bf16x8>(W, ub + ks * 64);
        }
#pragma unroll 1
        for (int tile = 0; tile < 8; ++tile) {
            f32x4 d = {0.f, 0.f, 0.f, 0.f};
#pragma unroll
            for (int ks = 0; ks < 32; ++ks) d = __builtin_amdgcn_mfma_f32_16x16x32_bf16(*(const bf16x8*)(xl + ks * 32 + 8 * gq), ubuf[ks], d, 0, 0, 0);
            const float act = gelu_tanh(d[0] * rs) * gc;
            const int ecur = ec;
            if (tile < 7) {
                ec = eid[(tile + 1) * 16 + c]; gc = egate[(tile + 1) * 16 + c];
                const unsigned ub = O_UT + (unsigned)ec * 2048u + 16 * gq;
#pragma unroll
                for (int ks = 0; ks < 32; ++ks) ubuf[ks] = ldws<bf16x8>(W, ub + ks * 64);
            }
#pragma unroll
            for (int j = 0; j < 16; ++j) {
                const int ej = __builtin_amdgcn_readlane(ecur, j);
                const float aj = __builtin_bit_cast(float, __builtin_amdgcn_readlane(__builtin_bit_cast(int, act), j));
                const unsigned vb = O_VT + (unsigned)ej * 2048u + lane * 16;
                f32x4 v0, v1, v2, v3; unpack8(ldws<u32x4>(W, vb), v0, v1); unpack8(ldws<u32x4>(W, vb + 1024), v2, v3);
                acc[0] += v0 * aj; acc[1] += v1 * aj; acc[2] += v2 * aj; acc[3] += v3 * aj;
                if ((j & 3) == 3) __builtin_amdgcn_sched_barrier(0);
            }
        }
#endif
        float* hr = p.out + (size_t)row * DM;
        if (MODE == 1) { const float chk = acc[0][0] + acc[1][1] + acc[2][2] + acc[3][3]; if (chk == 1.2345678f) hr[lane] = chk; continue; }
        float ss = 0.f;
        {
            f32x4 h0, h1, h2, h3;
            unpack8(ldws<u32x4>(W, O_HG + (unsigned)row * 2048u + lane * 16), h0, h1); unpack8(ldws<u32x4>(W, O_HG + (unsigned)row * 2048u + 1024 + lane * 16), h2, h3);
            acc[0] += h0; acc[1] += h1; acc[2] += h2; acc[3] += h3;
        }
#pragma unroll
        for (int i = 0; i < 4; ++i) ss += acc[i][0] * acc[i][0] + acc[i][1] * acc[i][1] + acc[i][2] * acc[i][2] + acc[i][3] * acc[i][3];
        ss = wave_sum(ss);
        const float scl = rsqrtf(ss * (1.f / DM) + NORM_EPS);
        float* dst = hr;
        if (MODE == 2) { if (row >= 8192) continue; dst = WSP(float, 462) + (size_t)row * DM; }
#pragma unroll
        for (int cc = 0; cc < 2; ++cc) {
            const f32x4 ga = *(const f32x4*)(p.norm_f_g + cc * 512 + lane * 8), gb = *(const f32x4*)(p.norm_f_g + cc * 512 + lane * 8 + 4);
            *(f32x4*)(dst + cc * 512 + lane * 8) = acc[2 * cc] * scl * ga; *(f32x4*)(dst + cc * 512 + lane * 8 + 4) = acc[2 * cc + 1] * scl * gb;
        }
    }
}


__device__ __forceinline__ void phase_peer4(const Params& p, unsigned char* smem, int vcu, int G) {
    int tid_ = threadIdx.x; asm volatile("" : "+v"(tid_));
    const int wave = __builtin_amdgcn_readfirstlane(tid_ >> 6), lane = tid_ & 63;
    const int gq = lane >> 4, c = lane & 15;
    unsigned char* wbase = smem + wave * 8192;
    const unsigned char* W = p.ws;
    constexpr unsigned O_SC = WS_SCORES << 20, O_HG = WS_HG << 20, O_UT = WS_UTAB << 20, O_VT = WS_VTAB << 20;
    const float* rss = WSP(float, WS_RSS);
    const float* uscg = WSP(float, WS_USC); const float* vscg = WSP(float, WS_VSC);
    const int stride = G * NWAVES;
    int ca = 0, cb = 0;
    {
        int rem = lane; bool found = false;
#pragma unroll
        for (int a = 0; a < 16; ++a) { const int cnt = 16 / (a + 1); if (!found) { if (rem < cnt) { ca = a; cb = rem; found = true; } else rem -= cnt; } }
    }
    int row = vcu * NWAVES + wave;
    if (row >= MTOK) return;
    u32x4 xw0, xw1; float rssv = 0.f; unsigned sc0 = 0, sc1 = 0, sc2 = 0, sc3 = 0;
    int pend_i = -1; float pend_g = 0.f, pend_su = 0.f, pend_sv = 0.f;
#define NB_LV(B)  ((float*)((B) + 2048))
#define NB_LI(B)  ((int*)((B) + 2048 + 128))
#define NB_VS(B)  ((float*)((B) + 2048 + 256))
#define NB_IS(B)  ((int*)((B) + 2048 + 384))
#define NB_EID(B) ((int*)((B) + 2048 + 512))
#define NB_EG(B)  ((float*)((B) + 2048 + 1024))
#define NB_EU(B)  ((float*)((B) + 2048 + 1536))
#define TK_LOAD_X(R) { xw0 = ldws<u32x4>(W, O_HG + (unsigned)(R) * 2048u + lane * 16); xw1 = ldws<u32x4>(W, O_HG + (unsigned)(R) * 2048u + 1024 + lane * 16); rssv = lane < 16 ? rss[(size_t)(R) * 16 + lane] : 0.f; }
#define TK_LOAD_SC(R, H) { const unsigned so_ = O_SC + (unsigned)(R) * 4096u + (H) * 512 + lane * 2; sc0 = ldws<unsigned short>(W, so_); sc1 = ldws<unsigned short>(W, so_ + 128); sc2 = ldws<unsigned short>(W, so_ + 256); sc3 = ldws<unsigned short>(W, so_ + 384); }
#define TK_STAGE_X(B, RS) {                                                                                                        \
        RS = rsqrtf(wave_sum(rssv) * (1.f / DM) + NORM_EPS);                                                                       \
        f32x4 xa[4]; unpack8(xw0, xa[0], xa[1]); unpack8(xw1, xa[2], xa[3]);                                                        \
        xa[0] *= *(const f32x4*)(p.norm2_g + lane * 8); xa[1] *= *(const f32x4*)(p.norm2_g + lane * 8 + 4); xa[2] *= *(const f32x4*)(p.norm2_g + 512 + lane * 8); xa[3] *= *(const f32x4*)(p.norm2_g + 512 + lane * 8 + 4); \
        unsigned hw[4], lw[4];                                                                                                     \
        _Pragma("unroll") for (int i = 0; i < 4; ++i) {                                                                            \
            const f32x4 xs = xa[i] * 16.f;                                                                                         \
            int h_ = __builtin_amdgcn_cvt_pk_fp8_f32(xs[0], xs[1], 0, false); h_ = __builtin_amdgcn_cvt_pk_fp8_f32(xs[2], xs[3], h_, true); \
            const f32x2_t b0 = __builtin_amdgcn_cvt_pk_f32_fp8(h_, false), b1 = __builtin_amdgcn_cvt_pk_f32_fp8(h_, true);         \
            int l_ = __builtin_amdgcn_cvt_pk_fp8_f32((xs[0] - b0[0]) * 16.f, (xs[1] - b0[1]) * 16.f, 0, false); l_ = __builtin_amdgcn_cvt_pk_fp8_f32((xs[2] - b1[0]) * 16.f, (xs[3] - b1[1]) * 16.f, l_, true); \
            hw[i] = (unsigned)h_; lw[i] = (unsigned)l_;                                                                            \
        }                                                                                                                          \
        *(uint2*)((B) + lane * 8) = make_uint2(hw[0], hw[1]); *(uint2*)((B) + 512 + lane * 8) = make_uint2(hw[2], hw[3]);          \
        *(uint2*)((B) + 1024 + lane * 8) = make_uint2(lw[0], lw[1]); *(uint2*)((B) + 1536 + lane * 8) = make_uint2(lw[2], lw[3]);  \
    }
#define TK_K16(hb) ((((unsigned)(hb) & 0x8000u) ? (~(unsigned)(hb) & 0xffffu) : ((unsigned)(hb) | 0x8000u)) << 16)
#define TK_PART_A(B) {                                                                                                             \
        const float a0 = (float)__builtin_bit_cast(_Float16, (unsigned short)sc0), a1 = (float)__builtin_bit_cast(_Float16, (unsigned short)sc1); \
        const float b0 = (float)__builtin_bit_cast(_Float16, (unsigned short)sc2), b1 = (float)__builtin_bit_cast(_Float16, (unsigned short)sc3); \
        const unsigned ka0 = TK_K16(sc0) | (0xFFFFu - (unsigned)lane), ka1 = TK_K16(sc1) | (0xFFFFu - 64u - (unsigned)lane);       \
        const unsigned kb0 = TK_K16(sc2) | (0xFFFFu - (unsigned)lane), kb1 = TK_K16(sc3) | (0xFFFFu - 64u - (unsigned)lane);       \
        unsigned long long loA = 0, hiA = 1ull << 32, loB = 0, hiB = 1ull << 32; bool doneA = false, doneB = false;                 \
        while (!(doneA && doneB)) {                                                                                                \
            if (!doneA) { const unsigned mid = (unsigned)((loA + hiA) >> 1); const int cnt = __builtin_popcountll(__ballot(ka0 >= mid)) + __builtin_popcountll(__ballot(ka1 >= mid)); \
                if (cnt >= 16) loA = mid; else hiA = mid; doneA = (cnt == 16) || (hiA - loA <= 1); }                                \
            if (!doneB) { const unsigned mid = (unsigned)((loB + hiB) >> 1); const int cnt = __builtin_popcountll(__ballot(kb0 >= mid)) + __builtin_popcountll(__ballot(kb1 >= mid)); \
                if (cnt >= 16) loB = mid; else hiB = mid; doneB = (cnt == 16) || (hiB - loB <= 1); }                                \
        }                                                                                                                          \
        float* lv = NB_LV(B); int* li = NB_LI(B);                                                                                  \
        { const unsigned T = (unsigned)loA; const bool k0 = ka0 >= T, k1 = ka1 >= T; const unsigned long long s0 = __ballot(k0), s1 = __ballot(k1); \
          if (k0) { const int pos = mbcnt64(s0); lv[pos] = a0; li[pos] = lane; }                                                    \
          if (k1) { const int pos = __builtin_popcountll(s0) + mbcnt64(s1); if (pos < 16) { lv[pos] = a1; li[pos] = lane + 64; } } } \
        { const unsigned T = (unsigned)loB; const bool k0 = kb0 >= T, k1 = kb1 >= T; const unsigned long long s0 = __ballot(k0), s1 = __ballot(k1); \
          if (k0) { const int pos = mbcnt64(s0); lv[16 + pos] = b0; li[16 + pos] = lane; }                                           \
          if (k1) { const int pos = __builtin_popcountll(s0) + mbcnt64(s1); if (pos < 16) { lv[16 + pos] = b1; li[16 + pos] = lane + 64; } } } \
        __builtin_amdgcn_s_waitcnt(0xC07F); __builtin_amdgcn_wave_barrier();                                                       \
    }
#define TK_PART_B(B, H, RS) {                                                                                                      \
        float* lv = NB_LV(B); int* li = NB_LI(B); float* vs = NB_VS(B); int* is_ = NB_IS(B);                                        \
        if (lane < 32) { const int base = lane & 16, me = lane & 15; const float mv = lv[lane]; int rk = 0;                         \
            _Pragma("unroll") for (int j = 0; j < 16; ++j) { const float x = lv[base + j]; rk += (x > mv) || (x == mv && j < me); } \
            vs[base + rk] = mv; is_[base + rk] = li[lane]; }                                                                       \
        __builtin_amdgcn_s_waitcnt(0xC07F); __builtin_amdgcn_wave_barrier();                                                       \
        float cv = 0.f; unsigned kc = 0u;                                                                                          \
        if (lane < 50) { cv = vs[ca] + vs[16 + cb]; kc = fkey(cv); }                                                                \
        unsigned long long lo = fkey(vs[15] + vs[31]), hi = (unsigned long long)fkey(vs[0] + vs[16]) + 1ull;                        \
        while (hi - lo > 1) { const unsigned mid = (unsigned)((lo + hi) >> 1); const int cnt = __builtin_popcountll(__ballot(kc >= mid)); \
            if (cnt >= 16) lo = mid; else hi = mid; if (cnt == 16) break; }                                                        \
        const unsigned T2 = (unsigned)lo; const unsigned long long tm = __ballot(kc == T2);                                        \
        const int need2 = 16 - __builtin_popcountll(__ballot(kc > T2));                                                            \
        const bool take = (kc > T2) || (kc == T2 && mbcnt64(tm) < need2);                                                          \
        const float sv_ = take ? cv * (RS) : -3e38f; const float mx = wave_max(sv_);                                               \
        const float ev = take ? __expf(sv_ - mx) : 0.f; const float sm = wave_sum(ev);                                             \
        pend_i = -1;                                                                                                               \
        if (take) { const int pos = mbcnt64(__ballot(take)); if (pos < 16) { const int e_ = is_[ca] * PEER_KEYS + is_[16 + cb];     \
            NB_EID(B)[(H) * 16 + pos] = e_; pend_i = (H) * 16 + pos; pend_g = ev / sm; pend_su = uscg[e_]; pend_sv = vscg[e_]; } }    \
        __builtin_amdgcn_wave_barrier();                                                                                           \
    }
#define TK_FLUSH(B) { if (pend_i >= 0) { NB_EG(B)[pend_i] = pend_g * pend_sv; NB_EU(B)[pend_i] = pend_su; } pend_i = -1; }
    float rs_cur = 0.f, rs_n = 0.f;
    {
        unsigned char* B0 = wbase;
        TK_LOAD_X(row) TK_STAGE_X(B0, rs_cur)
#pragma unroll 1
        for (int h = 0; h < PEER_H; ++h) { TK_FLUSH(B0) TK_LOAD_SC(row, h) TK_PART_A(B0) TK_PART_B(B0, h, rs_cur) }
        TK_FLUSH(B0)
        __builtin_amdgcn_s_waitcnt(0xC07F); __builtin_amdgcn_wave_barrier();
    }
#pragma unroll 1
    for (int it = 0;; ++it) {
        unsigned char* wsm = wbase + (it & 1) * 4096;
        unsigned char* nb = wbase + ((it + 1) & 1) * 4096;
        const int* eid = NB_EID(wsm); const float* egate = NB_EG(wsm); const float* eusc = NB_EU(wsm);
        const float rs = rs_cur;
        const int nrow_raw = row + stride;
        const int nrow = nrow_raw < MTOK ? nrow_raw : row;
        TK_LOAD_X(nrow) TK_LOAD_SC(nrow, 0)
        f32x4 acc[4];
#pragma unroll
        for (int i = 0; i < 4; ++i) acc[i] = (f32x4){0.f, 0.f, 0.f, 0.f};
        const unsigned koff = (unsigned)((c >> 3) * 64 + 16 * gq);
        u32x4 ub0[8], ub1[8], vb0[8], vb1[8];
        int ec0 = eid[c & 7], ec1 = eid[8 + (c & 7)];
#pragma unroll
        for (int k3 = 0; k3 < 8; ++k3) ub0[k3] = ldws<u32x4>(W, O_UT + (unsigned)ec0 * 1024u + koff + k3 * 128);
#pragma unroll
        for (int j = 0; j < 8; ++j) vb0[j] = ldws<u32x4>(W, O_VT + (unsigned)__builtin_amdgcn_readlane(ec0, j) * 1024u + lane * 16);
#pragma unroll
        for (int k3 = 0; k3 < 8; ++k3) ub1[k3] = ldws<u32x4>(W, O_UT + (unsigned)ec1 * 1024u + koff + k3 * 128);
#define PEER_TILE(UB, EC, VBC, ECN, VBN)                                                                                           \
        {                                                                                                                          \
            f32x4 dh = {0.f, 0.f, 0.f, 0.f}, dl = {0.f, 0.f, 0.f, 0.f};                                                             \
            _Pragma("unroll") for (int k3 = 0; k3 < 8; ++k3) {                                                                     \
                const u32x4 xh = *(const u32x4*)(wsm + k3 * 128 + koff), xlo = *(const u32x4*)(wsm + 1024 + k3 * 128 + koff);      \
                const long u0 = (long)(((unsigned long long)UB[k3].y << 32) | UB[k3].x), u1 = (long)(((unsigned long long)UB[k3].w << 32) | UB[k3].z); \
                const long h0 = (long)(((unsigned long long)xh.y << 32) | xh.x), h1 = (long)(((unsigned long long)xh.w << 32) | xh.z);  \
                const long l0 = (long)(((unsigned long long)xlo.y << 32) | xlo.x), l1 = (long)(((unsigned long long)xlo.w << 32) | xlo.z); \
                dh = __builtin_amdgcn_mfma_f32_16x16x32_fp8_fp8(h0, u0, dh, 0, 0, 0);                                              \
                dh = __builtin_amdgcn_mfma_f32_16x16x32_fp8_fp8(h1, u1, dh, 0, 0, 0);                                              \
                dl = __builtin_amdgcn_mfma_f32_16x16x32_fp8_fp8(l0, u0, dl, 0, 0, 0);                                              \
                dl = __builtin_amdgcn_mfma_f32_16x16x32_fp8_fp8(l1, u1, dl, 0, 0, 0);                                              \
            }                                                                                                                      \
            float mine = dh[0] + dl[0] * (1.f / 16.f);                                                                             \
            mine += __shfl_xor(mine, 40);                                                       \
            const float act = gelu_tanh(mine * (1.f / 16.f) * eusc[tcur * 8 + (c & 7)] * rs) * egate[tcur * 8 + (c & 7)];           \
            if (tcur + 2 < 16) {                                                                                                   \
                EC = eid[(tcur + 2) * 8 + (c & 7)];                                                                                \
                _Pragma("unroll") for (int k3 = 0; k3 < 8; ++k3) UB[k3] = ldws<u32x4>(W, O_UT + (unsigned)EC * 1024u + koff + k3 * 128); \
            }                                                                                                                      \
            if (tcur + 1 < 16) {                                                                                                   \
                _Pragma("unroll") for (int j = 0; j < 8; ++j) VBN[j] = ldws<u32x4>(W, O_VT + (unsigned)__builtin_amdgcn_readlane(ECN, j) * 1024u + lane * 16); \
            }                                                                                                                      \
            __builtin_amdgcn_sched_barrier(0);                                                                                     \
            _Pragma("unroll") for (int j = 0; j < 8; ++j) {                                                                        \
                const float aj = __builtin_bit_cast(float, __builtin_amdgcn_readlane(__builtin_bit_cast(int, act), j));            \
                const u32x4 vw = VBC[j];                                                                                           \
                const f32x2_t p0 = __builtin_amdgcn_cvt_pk_f32_fp8((int)vw.x, false), p1 = __builtin_amdgcn_cvt_pk_f32_fp8((int)vw.x, true); \
                const f32x2_t p2 = __builtin_amdgcn_cvt_pk_f32_fp8((int)vw.y, false), p3 = __builtin_amdgcn_cvt_pk_f32_fp8((int)vw.y, true); \
                const f32x2_t p4 = __builtin_amdgcn_cvt_pk_f32_fp8((int)vw.z, false), p5 = __builtin_amdgcn_cvt_pk_f32_fp8((int)vw.z, true); \
                const f32x2_t p6 = __builtin_amdgcn_cvt_pk_f32_fp8((int)vw.w, false), p7 = __builtin_amdgcn_cvt_pk_f32_fp8((int)vw.w, true); \
                acc[0] += (f32x4){p0[0], p0[1], p1[0], p1[1]} * aj; acc[1] += (f32x4){p2[0], p2[1], p3[0], p3[1]} * aj;             \
                acc[2] += (f32x4){p4[0], p4[1], p5[0], p5[1]} * aj; acc[3] += (f32x4){p6[0], p6[1], p7[0], p7[1]} * aj;             \
            }                                                                                                                      \
            __builtin_amdgcn_sched_barrier(0);                                                                                     \
        }
#pragma unroll 1
        for (int tp = 0; tp < 8; ++tp) {
            { const int tcur = 2 * tp; PEER_TILE(ub0, ec0, vb0, ec1, vb1) }
            if (tp == 0) { TK_STAGE_X(nb, rs_n) }
            TK_FLUSH(nb)
            TK_PART_A(nb)
            __builtin_amdgcn_sched_barrier(0);
            { const int tcur = 2 * tp + 1; PEER_TILE(ub1, ec1, vb1, ec0, vb0) }
            TK_PART_B(nb, tp, rs_n)
            { const int hn = tp < 7 ? tp + 1 : 7; TK_LOAD_SC(nrow, hn) }
            __builtin_amdgcn_sched_barrier(0);
        }
#undef PEER_TILE
        TK_FLUSH(nb)
        float* hr = p.out + (size_t)row * DM;
        float ss = 0.f;
        {
            f32x4 h0, h1, h2, h3;
            unpack8(ldws<u32x4>(W, O_HG + (unsigned)row * 2048u + lane * 16), h0, h1); unpack8(ldws<u32x4>(W, O_HG + (unsigned)row * 2048u + 1024 + lane * 16), h2, h3);
            acc[0] += h0; acc[1] += h1; acc[2] += h2; acc[3] += h3;
        }
#pragma unroll
        for (int i = 0; i < 4; ++i) ss += acc[i][0] * acc[i][0] + acc[i][1] * acc[i][1] + acc[i][2] * acc[i][2] + acc[i][3] * acc[i][3];
        ss = wave_sum(ss);
        const float scl = rsqrtf(ss * (1.f / DM) + NORM_EPS);
#pragma unroll
        for (int cc = 0; cc < 2; ++cc) {
            const f32x4 ga = *(const f32x4*)(p.norm_f_g + cc * 512 + lane * 8), gb = *(const f32x4*)(p.norm_f_g + cc * 512 + lane * 8 + 4);
            *(f32x4*)(hr + cc * 512 + lane * 8) = acc[2 * cc] * scl * ga; *(f32x4*)(hr + cc * 512 + lane * 8 + 4) = acc[2 * cc + 1] * scl * gb;
        }
        __builtin_amdgcn_s_waitcnt(0xC07F); __builtin_amdgcn_wave_barrier();
        if (nrow_raw >= MTOK) break;
        row = nrow_raw; rs_cur = rs_n;
    }
#undef TK_FLUSH
#undef TK_PART_B
#undef TK_PART_A
#undef TK_K16
#undef TK_STAGE_X
#undef TK_LOAD_SC
#undef TK_LOAD_X
}

struct __attribute__((packed, aligned(4))) U3 { unsigned a, b, c; };
typedef int v8i32_t __attribute__((ext_vector_type(8)));
typedef int v6i32_t __attribute__((ext_vector_type(6)));
typedef float v32f32_t __attribute__((ext_vector_type(32)));
template <bool NOTK>
__device__ __forceinline__ void phase_peer6(const Params& p, unsigned char* smem, int vcu, int G) {
    int tid_ = threadIdx.x; asm volatile("" : "+v"(tid_));
    const int wave = __builtin_amdgcn_readfirstlane(tid_ >> 6), lane = tid_ & 63;
    const int gq = lane >> 4, c = lane & 15;
    unsigned char* wbase = smem + wave * 8192;
    const unsigned char* W = p.ws;
    constexpr unsigned O_SC = WS_SCORES << 20, O_HG = WS_HG << 20, O_UT = WS_UTAB << 20, O_VT = WS_VTAB << 20;
    const float* rss = WSP(float, WS_RSS);
    const float* uscg = WSP(float, WS_USC); const float* vscg = WSP(float, WS_VSC);
    const int stride = G * NWAVES;
    int ca = 0, cb = 0;
    {
        int rem = lane; bool found = false;
#pragma unroll
        for (int a = 0; a < 16; ++a) { const int cnt = 16 / (a + 1); if (!found) { if (rem < cnt) { ca = a; cb = rem; found = true; } else rem -= cnt; } }
    }
    int row = vcu * NWAVES + wave;
    if (row >= MTOK) return;
    u32x4 xw0, xw1; float rssv = 0.f; unsigned sc0 = 0, sc1 = 0, sc2 = 0, sc3 = 0;
    int pend_i = -1; float pend_g = 0.f, pend_su = 0.f, pend_sv = 0.f;
#define NB_LV(B)  ((float*)((B) + 2048))
#define NB_LI(B)  ((int*)((B) + 2048 + 128))
#define NB_VS(B)  ((float*)((B) + 2048 + 256))
#define NB_IS(B)  ((int*)((B) + 2048 + 384))
#define NB_EID(B) ((int*)((B) + 2048 + 512))
#define NB_EG(B)  ((float*)((B) + 2048 + 1024))
#define NB_EU(B)  ((float*)((B) + 2048 + 1536))
#define TK_LOAD_X(R) { xw0 = ldws<u32x4>(W, O_HG + (unsigned)(R) * 2048u + lane * 16); xw1 = ldws<u32x4>(W, O_HG + (unsigned)(R) * 2048u + 1024 + lane * 16); rssv = lane < 16 ? rss[(size_t)(R) * 16 + lane] : 0.f; }
#define TK_LOAD_SC(R, H) { const unsigned so_ = O_SC + (unsigned)(R) * 4096u + (H) * 512 + lane * 2; sc0 = ldws<unsigned short>(W, so_); sc1 = ldws<unsigned short>(W, so_ + 128); sc2 = ldws<unsigned short>(W, so_ + 256); sc3 = ldws<unsigned short>(W, so_ + 384); }
#define TK_STAGE_X(B, RS) {                                                                                                        \
        RS = rsqrtf(wave_sum(rssv) * (1.f / DM) + NORM_EPS);                                                                       \
        f32x4 xa[4]; unpack8(xw0, xa[0], xa[1]); unpack8(xw1, xa[2], xa[3]);                                                        \
        xa[0] *= *(const f32x4*)(p.norm2_g + lane * 8); xa[1] *= *(const f32x4*)(p.norm2_g + lane * 8 + 4); xa[2] *= *(const f32x4*)(p.norm2_g + 512 + lane * 8); xa[3] *= *(const f32x4*)(p.norm2_g + 512 + lane * 8 + 4); \
        unsigned hw[4], lw[4];                                                                                                     \
        _Pragma("unroll") for (int i = 0; i < 4; ++i) {                                                                            \
            const f32x4 xs = xa[i] * 16.f;                                                                                         \
            int h_ = __builtin_amdgcn_cvt_pk_fp8_f32(xs[0], xs[1], 0, false); h_ = __builtin_amdgcn_cvt_pk_fp8_f32(xs[2], xs[3], h_, true); \
            const f32x2_t b0 = __builtin_amdgcn_cvt_pk_f32_fp8(h_, false), b1 = __builtin_amdgcn_cvt_pk_f32_fp8(h_, true);         \
            int l_ = __builtin_amdgcn_cvt_pk_fp8_f32((xs[0] - b0[0]) * 16.f, (xs[1] - b0[1]) * 16.f, 0, false); l_ = __builtin_amdgcn_cvt_pk_fp8_f32((xs[2] - b1[0]) * 16.f, (xs[3] - b1[1]) * 16.f, l_, true); \
            hw[i] = (unsigned)h_; lw[i] = (unsigned)l_;                                                                            \
        }                                                                                                                          \
                                                                                                       \
        const int xo_ = PEER_U6 == 1 ? ((lane >> 2) & 3) * 256 + (2 * ((lane >> 4) & 1) + ((lane >> 1) & 1)) * 32 + ((lane >> 5) & 1) * 16 + (lane & 1) * 8 \
                      : PEER_U6 == 2 ? ((lane >> 2) & 3) * 256 + (lane >> 4) * 32 + (lane & 3) * 8 : lane * 8;                       \
        const int xo2_ = xo_ + (PEER_U6 ? 128 : 512);                                                                              \
        *(uint2*)((B) + xo_) = make_uint2(hw[0], hw[1]); *(uint2*)((B) + xo2_) = make_uint2(hw[2], hw[3]);                          \
        *(uint2*)((B) + 1024 + xo_) = make_uint2(lw[0], lw[1]); *(uint2*)((B) + 1024 + xo2_) = make_uint2(lw[2], lw[3]);            \
    }
#define TK_K16(hb) ((((unsigned)(hb) & 0x8000u) ? (~(unsigned)(hb) & 0xffffu) : ((unsigned)(hb) | 0x8000u)) << 16)
#define TK_PART_A(B) {                                                                                                             \
        const unsigned ka0 = TK_K16(sc0) | (0xFFFFu - (unsigned)lane), ka1 = TK_K16(sc1) | (0xFFFFu - 64u - (unsigned)lane);       \
        const unsigned kb0 = TK_K16(sc2) | (0xFFFFu - (unsigned)lane), kb1 = TK_K16(sc3) | (0xFFFFu - 64u - (unsigned)lane);       \
          \
        unsigned loA = 0u, hiA = 0xFFFFFFFFu, loB = 0u, hiB = 0xFFFFFFFFu; bool doneA = false, doneB = false;                       \
        while (!(doneA && doneB)) {                                                                                                \
            const unsigned midA = loA + ((hiA - loA) >> 1), midB = loB + ((hiB - loB) >> 1);                                        \
            const int cntA = __builtin_popcountll(__ballot(ka0 >= midA)) + __builtin_popcountll(__ballot(ka1 >= midA));             \
            const int cntB = __builtin_popcountll(__ballot(kb0 >= midB)) + __builtin_popcountll(__ballot(kb1 >= midB));             \
              \
            loA = cntA >= 16 ? midA : loA; hiA = cntA >= 16 ? hiA : midA; doneA = doneA || (cntA == 16);                            \
            loB = cntB >= 16 ? midB : loB; hiB = cntB >= 16 ? hiB : midB; doneB = doneB || (cntB == 16);                            \
        }                                                                                                                          \
           \
        unsigned* lk = (unsigned*)NB_LV(B);                                                                                        \
        { const unsigned T = loA; const bool k0 = ka0 >= T, k1 = ka1 >= T; const unsigned long long s0 = __ballot(k0), s1 = __ballot(k1); \
          if (k0) { lk[mbcnt64(s0)] = ka0; }                                                                                       \
          if (k1) { const int pos = __builtin_popcountll(s0) + mbcnt64(s1); if (pos < 16) lk[pos] = ka1; } }                        \
        { const unsigned T = loB; const bool k0 = kb0 >= T, k1 = kb1 >= T; const unsigned long long s0 = __ballot(k0), s1 = __ballot(k1); \
          if (k0) { lk[16 + mbcnt64(s0)] = kb0; }                                                                                  \
          if (k1) { const int pos = __builtin_popcountll(s0) + mbcnt64(s1); if (pos < 16) lk[16 + pos] = kb1; } }                   \
        __builtin_amdgcn_s_waitcnt(0xC07F); __builtin_amdgcn_wave_barrier();                                                       \
    }
#define TK_PART_B(B, H, RS) {                                                                                                      \
        const unsigned* lk = (const unsigned*)NB_LV(B); float* vs = NB_VS(B); int* is_ = NB_IS(B);                                  \
        if (lane < 32) { const int base = lane & 16; const unsigned mk = lk[lane]; int rk = 0;         \
            _Pragma("unroll") for (int j = 0; j < 16; ++j) rk += (lk[base + j] > mk) ? 1 : 0;                                       \
            const unsigned k16 = mk >> 16, hb = (k16 & 0x8000u) ? (k16 & 0x7fffu) : (~k16 & 0xffffu);                               \
            vs[base + rk] = (float)__builtin_bit_cast(_Float16, (unsigned short)hb); is_[base + rk] = (int)(0xFFFFu - (mk & 0xFFFFu)); } \
        __builtin_amdgcn_s_waitcnt(0xC07F); __builtin_amdgcn_wave_barrier();                                                       \
        float cv = 0.f; unsigned kc = 0u;                                                                                          \
        if (lane < 50) { cv = vs[ca] + vs[16 + cb]; kc = fkey(cv); }                                                                \
        const float top_ = vs[0] + vs[16];                           \
        unsigned lo = fkey(vs[15] + vs[31]), hi = fkey(top_) + 1u; bool fin_ = false;                                               \
        do { const unsigned mid = lo + ((hi - lo) >> 1); const int cnt = __builtin_popcountll(__ballot(kc >= mid));                 \
             lo = cnt >= 16 ? mid : lo; hi = cnt >= 16 ? hi : mid; fin_ = (cnt == 16) || (hi - lo <= 1u); } while (!fin_);          \
        const unsigned T2 = lo; const unsigned long long tm = __ballot(kc == T2);                                                  \
        const int need2 = 16 - __builtin_popcountll(__ballot(kc > T2));                                                            \
        const bool take = (kc > T2) || (kc == T2 && mbcnt64(tm) < need2);                                                          \
        const float ev = take ? __expf((cv - top_) * (RS)) : 0.f; const float sm = wave_sum(ev);                                    \
        pend_i = -1;                                                                                                               \
        if (take) { const int pos = mbcnt64(__ballot(take)); if (pos < 16) { const int e_ = is_[ca] * PEER_KEYS + is_[16 + cb];     \
            NB_EID(B)[(H) * 16 + pos] = e_; pend_i = (H) * 16 + pos; pend_g = ev * __builtin_amdgcn_rcpf(sm); pend_su = uscg[e_]; pend_sv = vscg[e_]; } } \
        __builtin_amdgcn_wave_barrier();                                                                                           \
    }
#define TK_FLUSH(B) { if (pend_i >= 0) { NB_EG(B)[pend_i] = pend_g * pend_sv; NB_EU(B)[pend_i] = pend_su; } pend_i = -1; }
    float rs_cur = 0.f, rs_n = 0.f;
    {
        unsigned char* B0 = wbase;
        TK_LOAD_X(row) TK_STAGE_X(B0, rs_cur)
#pragma unroll 1
        for (int h = 0; h < PEER_H; ++h) { TK_FLUSH(B0) TK_LOAD_SC(row, h) TK_PART_A(B0) TK_PART_B(B0, h, rs_cur) }
        TK_FLUSH(B0)
        __builtin_amdgcn_s_waitcnt(0xC07F); __builtin_amdgcn_wave_barrier();
    }
#if PEER_U6 == 1
        const unsigned koff = (unsigned)((c >> 3) * 64 + gq * 16);
        const unsigned xoff = (unsigned)(((c >> 3) * 4 + gq) * 32);
        constexpr int NUB = 6;
#define U_LOAD(UB, E_) { _Pragma("unroll") for (int k3 = 0; k3 < 6; ++k3) UB[k3] = ldws<u32x4>(W + O_UT + k3 * 128, (unsigned)(E_) + koff); }
#define UBD(UB, i) ((int)UB[(i) >> 2][(i) & 3])
#define U_DOT(UB)                                                                                                                  \
            _Pragma("unroll") for (int ks = 0; ks < 4; ++ks) {                                                                     \
                const u32x4 xh0 = *(const u32x4*)(wsm + ks * 256 + xoff), xh1 = *(const u32x4*)(wsm + ks * 256 + xoff + 16);       \
                const u32x4 xl0 = *(const u32x4*)(wsm + 1024 + ks * 256 + xoff), xl1 = *(const u32x4*)(wsm + 1024 + ks * 256 + xoff + 16); \
                const v8i32_t xa = {(int)xh0.x, (int)xh0.y, (int)xh0.z, (int)xh0.w, (int)xh1.x, (int)xh1.y, (int)xh1.z, (int)xh1.w}; \
                const v8i32_t xb = {(int)xl0.x, (int)xl0.y, (int)xl0.z, (int)xl0.w, (int)xl1.x, (int)xl1.y, (int)xl1.z, (int)xl1.w}; \
                const v8i32_t uw = {UBD(UB, 6 * ks), UBD(UB, 6 * ks + 1), UBD(UB, 6 * ks + 2), UBD(UB, 6 * ks + 3), UBD(UB, 6 * ks + 4), UBD(UB, 6 * ks + 5), 0, 0}; \
                dh = __builtin_amdgcn_mfma_scale_f32_16x16x128_f8f6f4(xa, uw, dh, 0, 2, 0, 0x7F7F7F7F, 0, 0x7F7F7F7F);              \
                dl = __builtin_amdgcn_mfma_scale_f32_16x16x128_f8f6f4(xb, uw, dl, 0, 2, 0, 0x7F7F7F7F, 0, 0x7F7F7F7F);              \
            }
#elif PEER_U6 == 2
        const unsigned koff = (unsigned)((c >> 3) * 512 + gq * 128);
        const unsigned xoff = (unsigned)(((c >> 3) * 4 + gq) * 32);
        constexpr int NUB = 8;
#define U_LOAD(UB, E_) { _Pragma("unroll") for (int k3 = 0; k3 < 8; ++k3) UB[k3] = ldws<u32x4>(W, O_UT + (unsigned)(E_) * 1024u + koff + k3 * 16); }
#define U_DOT(UB)                                                                                                                  \
            _Pragma("unroll") for (int ks = 0; ks < 4; ++ks) {                                                                     \
                const u32x4 xh0 = *(const u32x4*)(wsm + ks * 256 + xoff), xh1 = *(const u32x4*)(wsm + ks * 256 + xoff + 16);       \
                const u32x4 xl0 = *(const u32x4*)(wsm + 1024 + ks * 256 + xoff), xl1 = *(const u32x4*)(wsm + 1024 + ks * 256 + xoff + 16); \
                const v8i32_t xa = {(int)xh0.x, (int)xh0.y, (int)xh0.z, (int)xh0.w, (int)xh1.x, (int)xh1.y, (int)xh1.z, (int)xh1.w}; \
                const v8i32_t xb = {(int)xl0.x, (int)xl0.y, (int)xl0.z, (int)xl0.w, (int)xl1.x, (int)xl1.y, (int)xl1.z, (int)xl1.w}; \
                const v8i32_t uw = {(int)UB[2 * ks].x, (int)UB[2 * ks].y, (int)UB[2 * ks].z, (int)UB[2 * ks].w, (int)UB[2 * ks + 1].x, (int)UB[2 * ks + 1].y, (int)UB[2 * ks + 1].z, (int)UB[2 * ks + 1].w}; \
                dh = __builtin_amdgcn_mfma_scale_f32_16x16x128_f8f6f4(xa, uw, dh, 0, 0, 0, 0x7F7F7F7F, 0, 0x7F7F7F7F);              \
                dl = __builtin_amdgcn_mfma_scale_f32_16x16x128_f8f6f4(xb, uw, dl, 0, 0, 0, 0x7F7F7F7F, 0, 0x7F7F7F7F);              \
            }
#else
        const unsigned koff = (unsigned)((c >> 3) * 64 + 16 * gq);
        constexpr int NUB = 8;
#define U_LOAD(UB, E_) { _Pragma("unroll") for (int k3 = 0; k3 < 8; ++k3) UB[k3] = ldws<u32x4>(W, O_UT + (unsigned)(E_) * 1024u + koff + k3 * 128); }
#define U_DOT(UB)                                                                                                                  \
            _Pragma("unroll") for (int k3 = 0; k3 < 8; ++k3) {                                                                     \
                const u32x4 xh = *(const u32x4*)(wsm + k3 * 128 + koff), xlo = *(const u32x4*)(wsm + 1024 + k3 * 128 + koff);      \
                const long u0 = (long)(((unsigned long long)UB[k3].y << 32) | UB[k3].x), u1 = (long)(((unsigned long long)UB[k3].w << 32) | UB[k3].z); \
                const long h0 = (long)(((unsigned long long)xh.y << 32) | xh.x), h1 = (long)(((unsigned long long)xh.w << 32) | xh.z);  \
                const long l0 = (long)(((unsigned long long)xlo.y << 32) | xlo.x), l1 = (long)(((unsigned long long)xlo.w << 32) | xlo.z); \
                dh = __builtin_amdgcn_mfma_f32_16x16x32_fp8_fp8(h0, u0, dh, 0, 0, 0);                                              \
                dh = __builtin_amdgcn_mfma_f32_16x16x32_fp8_fp8(h1, u1, dh, 0, 0, 0);                                              \
                dl = __builtin_amdgcn_mfma_f32_16x16x32_fp8_fp8(l0, u0, dl, 0, 0, 0);                                              \
                dl = __builtin_amdgcn_mfma_f32_16x16x32_fp8_fp8(l1, u1, dl, 0, 0, 0);                                              \
            }
#endif
#if PEER_V6
        typedef U3 vb_t;
#define V_LOAD(VB, ESRC) { _Pragma("unroll") for (int j = 0; j < 8; ++j) VB[j] = ldws<U3>(W + O_VT, (unsigned)__builtin_amdgcn_readlane(ESRC, j) + lane * 12); }
#define V_ACC(VBC)                                                                                                                 \
            _Pragma("unroll") for (int jp = 0; jp < 4; ++jp) {                                                                     \
                const float a0_ = __builtin_bit_cast(float, __builtin_amdgcn_readlane(__builtin_bit_cast(int, act), 2 * jp));      \
                const float a1_ = __builtin_bit_cast(float, __builtin_amdgcn_readlane(__builtin_bit_cast(int, act), 2 * jp + 1));  \
                const v6i32_t sv_ = {(int)VBC[2 * jp].a, (int)VBC[2 * jp].b, (int)VBC[2 * jp].c, (int)VBC[2 * jp + 1].a, (int)VBC[2 * jp + 1].b, (int)VBC[2 * jp + 1].c}; \
                const v32f32_t f_ = __builtin_amdgcn_cvt_scalef32_pk32_f32_fp6(sv_, 1.0f);                                         \
                _Pragma("unroll") for (int q_ = 0; q_ < 4; ++q_) {                                                                 \
                    acc[q_] += (f32x4){f_[4 * q_], f_[4 * q_ + 1], f_[4 * q_ + 2], f_[4 * q_ + 3]} * a0_;                           \
                    acc[q_] += (f32x4){f_[16 + 4 * q_], f_[16 + 4 * q_ + 1], f_[16 + 4 * q_ + 2], f_[16 + 4 * q_ + 3]} * a1_;       \
                }                                                                                                                  \
            }
#else
        typedef u32x4 vb_t;
#define V_LOAD(VB, ESRC) { _Pragma("unroll") for (int j = 0; j < 8; ++j) VB[j] = ldws<u32x4>(W, O_VT + (unsigned)__builtin_amdgcn_readlane(ESRC, j) * 1024u + lane * 16); }
#define V_LOAD_H(VB, ESRC, J0) { _Pragma("unroll") for (int j = J0; j < J0 + 4; ++j) VB[j] = ldws<u32x4>(W, O_VT + (unsigned)__builtin_amdgcn_readlane(ESRC, j) * 1024u + lane * 16); }
#define V_ACC(VBC)                                                                                                                 \
            _Pragma("unroll") for (int j = 0; j < 8; ++j) {                                                                        \
                const float aj = __builtin_bit_cast(float, __builtin_amdgcn_readlane(__builtin_bit_cast(int, act), j));            \
                const u32x4 vw = VBC[j];                                                                                           \
                const f32x2_t p0 = __builtin_amdgcn_cvt_pk_f32_fp8((int)vw.x, false), p1 = __builtin_amdgcn_cvt_pk_f32_fp8((int)vw.x, true); \
                const f32x2_t p2 = __builtin_amdgcn_cvt_pk_f32_fp8((int)vw.y, false), p3 = __builtin_amdgcn_cvt_pk_f32_fp8((int)vw.y, true); \
                const f32x2_t p4 = __builtin_amdgcn_cvt_pk_f32_fp8((int)vw.z, false), p5 = __builtin_amdgcn_cvt_pk_f32_fp8((int)vw.z, true); \
                const f32x2_t p6 = __builtin_amdgcn_cvt_pk_f32_fp8((int)vw.w, false), p7 = __builtin_amdgcn_cvt_pk_f32_fp8((int)vw.w, true); \
                acc[0] += (f32x4){p0[0], p0[1], p1[0], p1[1]} * aj; acc[1] += (f32x4){p2[0], p2[1], p3[0], p3[1]} * aj;             \
                acc[2] += (f32x4){p4[0], p4[1], p5[0], p5[1]} * aj; acc[3] += (f32x4){p6[0], p6[1], p7[0], p7[1]} * aj;             \
            }
#endif
    u32x4 ub0[NUB], ub1[NUB]; vb_t vb0[8], vb1[8];
    int ec0, ec1;
    {
        const int* eid0 = NB_EID(wbase);
        ec0 = eid0[c & 7] * 768; ec1 = eid0[8 + (c & 7)] * 768;
        U_LOAD(ub0, ec0)
        V_LOAD(vb0, ec0)
        U_LOAD(ub1, ec1)
    }
#pragma unroll 1
    for (int it = 0;; ++it) {
        unsigned char* wsm = NOTK ? wbase : wbase + (it & 1) * 4096;
        unsigned char* nb = NOTK ? wbase : wbase + ((it + 1) & 1) * 4096;
        const int* eid = NB_EID(wsm); const float* egate = NB_EG(wsm); const float* eusc = NB_EU(wsm);
        const float rs = rs_cur;
        const int nrow_raw = row + stride;
        const int nrow = nrow_raw < MTOK ? nrow_raw : row;
        TK_LOAD_X(nrow) TK_LOAD_SC(nrow, 0)
        f32x4 acc[4];
#pragma unroll
        for (int i = 0; i < 4; ++i) acc[i] = (f32x4){0.f, 0.f, 0.f, 0.f};
#define PEER_TILE(UB, EC, VBC, ECN, VBN)                                                                                           \
        {                                                                                                                          \
            f32x4 dh = {0.f, 0.f, 0.f, 0.f}, dl = {0.f, 0.f, 0.f, 0.f};                                                             \
            U_DOT(UB)                                                                                                              \
            float mine = dh[0] + dl[0] * (1.f / 16.f);                                                                             \
            mine += __shfl_xor(mine, 40);                                                       \
            const float act = gelu_fast(mine * (1.f / 16.f) * eusc[tcur * 8 + (c & 7)] * rs) * egate[tcur * 8 + (c & 7)];           \
            {     \
                const int* es_ = (tcur + 2 < 16) ? eid + (tcur + 2) * 8 : NB_EID(nb) + (tcur + 2 - 16) * 8;                          \
                EC = es_[c & 7] * 768; U_LOAD(UB, EC)                                                                                    \
                V_LOAD(VBN, ECN)                                                                                                   \
            }                                                                                                                      \
            __builtin_amdgcn_sched_barrier(0);                                                                                     \
            V_ACC(VBC)                                                                                                             \
            __builtin_amdgcn_sched_barrier(0);                                                                                     \
        }
#pragma unroll 1
        for (int tp = 0; tp < 8; ++tp) {
            { const int tcur = 2 * tp; PEER_TILE(ub0, ec0, vb0, ec1, vb1) }
            if (!NOTK) {
            if (tp == 0) { TK_STAGE_X(nb, rs_n) }
            TK_FLUSH(nb)
            TK_PART_A(nb)
            }
            __builtin_amdgcn_sched_barrier(0);
            { const int tcur = 2 * tp + 1; PEER_TILE(ub1, ec1, vb1, ec0, vb0) }
            if (!NOTK) {
            TK_PART_B(nb, tp, rs_n)
            { const int hn = tp < 7 ? tp + 1 : 7; TK_LOAD_SC(nrow, hn) }
            }
            __builtin_amdgcn_sched_barrier(0);
        }
#undef PEER_TILE
#undef U_LOAD
#undef U_DOT
#undef V_LOAD
#undef V_LOAD_H
#undef V_ACC
        if (!NOTK) { TK_FLUSH(nb) }
        float* hr = p.out + (size_t)row * DM;
        float ss = 0.f;
        {
            f32x4 h0, h1, h2, h3;
            unpack8(ldws<u32x4>(W, O_HG + (unsigned)row * 2048u + lane * 16), h0, h1); unpack8(ldws<u32x4>(W, O_HG + (unsigned)row * 2048u + 1024 + lane * 16), h2, h3);
            acc[0] += h0; acc[1] += h1; acc[2] += h2; acc[3] += h3;
        }
#pragma unroll
        for (int i = 0; i < 4; ++i) ss += acc[i][0] * acc[i][0] + acc[i][1] * acc[i][1] + acc[i][2] * acc[i][2] + acc[i][3] * acc[i][3];
        ss = wave_sum(ss);
        const float scl = rsqrtf(ss * (1.f / DM) + NORM_EPS);
#pragma unroll
        for (int cc = 0; cc < 2; ++cc) {
            const f32x4 ga = *(const f32x4*)(p.norm_f_g + cc * 512 + lane * 8), gb = *(const f32x4*)(p.norm_f_g + cc * 512 + lane * 8 + 4);
            *(f32x4*)(hr + cc * 512 + lane * 8) = acc[2 * cc] * scl * ga; *(f32x4*)(hr + cc * 512 + lane * 8 + 4) = acc[2 * cc + 1] * scl * gb;
        }
        __builtin_amdgcn_s_waitcnt(0xC07F); __builtin_amdgcn_wave_barrier();
        if (nrow_raw >= MTOK) break;
        row = nrow_raw; rs_cur = rs_n;
    }
#undef TK_FLUSH
#undef TK_PART_B
#undef TK_PART_A
#undef TK_K16
#undef TK_STAGE_X
#undef TK_LOAD_SC
#undef TK_LOAD_X
}


#ifdef UT_FP6
__device__ __forceinline__ int ut_a(int row, int g, int i) { return ((i * 7 + g * 3 + row) % 13) - 6; }
__device__ __forceinline__ int ut_b(int col, int g, int j) { return ((j * 5 + g * 2 + col * 3) % 7) - 3; }
__device__ __forceinline__ void ut_fp6(const Params& p) {
    const int lane = threadIdx.x & 63, g = lane >> 4, c = lane & 15;
    unsigned aw[8];
#pragma unroll
    for (int w = 0; w < 8; ++w) {
        int h_ = __builtin_amdgcn_cvt_pk_fp8_f32((float)ut_a(c, g, 4 * w), (float)ut_a(c, g, 4 * w + 1), 0, false);
        h_ = __builtin_amdgcn_cvt_pk_fp8_f32((float)ut_a(c, g, 4 * w + 2), (float)ut_a(c, g, 4 * w + 3), h_, true);
        aw[w] = (unsigned)h_;
    }
    unsigned bw[6];
    {
        unsigned cd[16];
#pragma unroll
        for (int j = 0; j < 16; ++j) cd[j] = fp6_code((float)ut_b(c, g, j));
        fp6_pack16(cd, bw[0], bw[1], bw[2]);
#pragma unroll
        for (int j = 0; j < 16; ++j) cd[j] = fp6_code((float)ut_b(c, g, 16 + j));
        fp6_pack16(cd, bw[3], bw[4], bw[5]);
    }
    const v8i32_t A = {(int)aw[0], (int)aw[1], (int)aw[2], (int)aw[3], (int)aw[4], (int)aw[5], (int)aw[6], (int)aw[7]};
    const v8i32_t B = {(int)bw[0], (int)bw[1], (int)bw[2], (int)bw[3], (int)bw[4], (int)bw[5], 0, 0};
    f32x4 D = {0.f, 0.f, 0.f, 0.f};
    D = __builtin_amdgcn_mfma_scale_f32_16x16x128_f8f6f4(A, B, D, 0, 2, 0, 0x7F7F7F7F, 0, 0x7F7F7F7F);
    bool ok1 = true, ok2 = true, ok3 = true, ok4 = true;
#pragma unroll 1
    for (int r = 0; r < 4; ++r) {
        const int row = 4 * g + r;
        int e1 = 0, e2 = 0, e3 = 0, e4 = 0;
#pragma unroll 1
        for (int gg = 0; gg < 4; ++gg)
#pragma unroll 1
            for (int j = 0; j < 32; ++j) {
                const int bv = ut_b(c, gg, j);
                e1 += bv * ut_a(row, gg, j);
                { const int K = j < 16 ? 16 * gg + j : 64 + 16 * gg + (j - 16); e2 += bv * ut_a(row, K >> 5, K & 31); }
                { const int K = 32 * gg + j; const int ga = K < 64 ? (K >> 4) : ((K - 64) >> 4), ia = K < 64 ? (K & 15) : 16 + (K & 15); e3 += bv * ut_a(row, ga, ia); }
                { const int K = 32 * (j >> 3) + 8 * gg + (j & 7); e4 += bv * ut_a(row, K >> 5, K & 31); }
            }
        const float dv = D[r];
        ok1 = ok1 && (dv == (float)e1); ok2 = ok2 && (dv == (float)e2); ok3 = ok3 && (dv == (float)e3); ok4 = ok4 && (dv == (float)e4);
    }
    const bool a1 = __ballot(ok1) == ~0ull, a2 = __ballot(ok2) == ~0ull, a3 = __ballot(ok3) == ~0ull, a4 = __ballot(ok4) == ~0ull;
    const int m = a1 ? 1 : a2 ? 2 : a3 ? 3 : a4 ? 4 : 0;
    const v6i32_t sv = {(int)bw[0], (int)bw[1], (int)bw[2], (int)bw[3], (int)bw[4], (int)bw[5]};
    const v32f32_t f = __builtin_amdgcn_cvt_scalef32_pk32_f32_fp6(sv, 1.0f);
    bool okc = true;
#pragma unroll
    for (int j = 0; j < 32; ++j) okc = okc && (f[j] == (float)ut_b(c, g, j));
    const int c1 = (__ballot(okc) == ~0ull) ? 1 : 0;
    if (lane == 0) ((float*)p.ws)[20] = (float)(2 * m + c1);
}
#endif
__global__ void __launch_bounds__(NT, 2) k_mega(Params p) {
    extern __shared__ __attribute__((aligned(16))) unsigned char lds_raw[];
    LAS unsigned char* lds = (LAS unsigned char*)lds_raw;
    unsigned char* smem = lds_raw;
    const int tid = threadIdx.x, G = gridDim.x;
    const int vcu = (G % 8 == 0) ? ((int)blockIdx.x % 8) * (G / 8) + (int)blockIdx.x / 8 : (int)blockIdx.x;
    for (int i = tid; i < (LDS_BYTES - LDSCTL_OFF) / 4; i += NT) ((LAS unsigned*)(lds + LDSCTL_OFF))[i] = 0u;
    __syncthreads();
    XcdBarrier bar = xcd_barrier_post((unsigned*)p.ws + CW_BAR, (volatile LAS unsigned*)(lds + MISC_OFF) + 8);
#ifdef UT_FP6
    if (blockIdx.x == 0 && threadIdx.x < 64) ut_fp6(p);
#endif

#ifndef REP_PREP
#define REP_PREP 1
#endif
#ifndef REP_INPROJ
#define REP_INPROJ 1
#endif
#ifndef REP_SSM
#define REP_SSM 1
#endif
#ifndef REP_DSA
#define REP_DSA 1
#endif
#ifndef REP_MID
#define REP_MID 1
#endif
#ifndef REP_SCORES
#define REP_SCORES 1
#endif
#ifndef REP_PEER
#define REP_PEER 1
#endif
#define REPEAT(n) _Pragma("unroll 1") for (int rep_ = 0; rep_ < (n); ++rep_)
    REPEAT(REP_PREP) { phase_prep<0>(p, smem, vcu, G); xcd_barrier(bar); }
    REPEAT(REP_INPROJ) {
        EpiInProj e{WSP(bf16_t, WS_U), WSP(bf16_t, WS_Q), WSP(bf16_t, WS_K), WSP(bf16_t, WS_V), WSP(bf16_t, WS_QI), WSP(bf16_t, WS_KI),
                    WSP(bf16_t, WS_SGS), WSP(bf16_t, WS_SGA), WSP(float, WS_WI), WSP(float2, WS_ROPEA), WSP(float2, WS_ROPEI)};
        run_gemm(lds, WSP(bf16_t, WS_R1), WSP(bf16_t, WS_WINT), MTOK, IN_WP, 1024, G, e);
        if (G == 256) { if ((int)blockIdx.x >= 128) phase_prep<1>(p, smem, (int)blockIdx.x - 128, 128); }
        else phase_prep<1>(p, smem, vcu, G);
        xcd_barrier(bar);
    }
#ifdef DSA_FIRST
    REPEAT(REP_DSA) { phase_dsa(p, smem, (unsigned)(WS_YATT << 20), vcu, G); __syncthreads(); }
    REPEAT(REP_SSM) {
        int t2 = threadIdx.x; asm volatile("" : "+v"(t2));
        const int w2 = __builtin_amdgcn_readfirstlane(t2 >> 6);
#pragma unroll 1
        for (int item = vcu; item < NB * SSM_G; item += G) ssm_fast_item(p, smem, (unsigned)(WS_YG << 20), item, t2 & 63, w2);
        __syncthreads();
    }
#ifdef PROBE_SSM
    if (tid < 64) for (int item = blockIdx.x; item < NB * SSM_G; item += G) ssm_item(p, (float*)smem, (bf16_t*)p.out, item, tid);
    __syncthreads();
#endif
#else
    REPEAT(REP_SSM) {
        int t2 = threadIdx.x; asm volatile("" : "+v"(t2));
        const int w2 = __builtin_amdgcn_readfirstlane(t2 >> 6);
#pragma unroll 1
        for (int item = vcu; item < NB * SSM_G; item += G) ssm_fast_item(p, smem, (unsigned)(WS_YG << 20), item, t2 & 63, w2);
        __syncthreads();
    }
#ifdef PROBE_SSM
    if (tid < 64) for (int item = blockIdx.x; item < NB * SSM_G; item += G) ssm_item(p, (float*)smem, (bf16_t*)p.out, item, tid);
    __syncthreads();
#endif
    REPEAT(REP_DSA) { phase_dsa(p, smem, (unsigned)(WS_YATT << 20), vcu, G); __syncthreads(); }
#endif
#ifdef PROBE_ATTN
    phase_attn(p, smem, (bf16_t*)p.out, vcu, G);
    __syncthreads();
#endif
    xcd_barrier(bar);
#if defined(PROBE_ATTN) || defined(PROBE_SSM)
    {
#ifdef PROBE_SSM
        const bf16_t* A = WSP(bf16_t, WS_YG);
#else
        const bf16_t* A = WSP(bf16_t, WS_YATT);
#endif
        const bf16_t* B = (const bf16_t*)p.out;
        float d2 = 0.f, b2 = 0.f;
        for (size_t i = (size_t)blockIdx.x * NT + threadIdx.x; i < (size_t)MTOK * 512; i += (size_t)G * NT) { float a = bf2f(A[i]), bb = bf2f(B[i]); d2 += (a - bb) * (a - bb); b2 += bb * bb; }
        d2 = wave_sum(d2); b2 = wave_sum(b2);
        if ((threadIdx.x & 63) == 0) { atomicAdd((float*)p.ws + 16, d2); atomicAdd((float*)p.ws + 17, b2); }
    }
    xcd_barrier(bar);
#endif
#ifndef REP_GLU
#define REP_GLU 1
#endif
#ifndef REP_M1
#define REP_M1 1
#endif
#ifndef REP_M2
#define REP_M2 1
#endif
#ifndef REP_OUT
#define REP_OUT 1
#endif
#ifndef REP_BAR
#define REP_BAR 0
#endif
    REPEAT(REP_BAR) { xcd_barrier(bar); }
    REPEAT(REP_GLU) { EpiGlu e{WSP(bf16_t, WS_YG), WSP(bf16_t, WS_YSSM)}; run_gemm(lds, WSP(bf16_t, WS_YG), WSP(bf16_t, WS_WGLUT), MTOK, 512, 512, G, e); xcd_barrier(bar); }
    REPEAT(REP_M1) { EpiMergeChain e{WSP(bf16_t, WS_SGS), WSP(bf16_t, WS_SGA), WSP(bf16_t, WS_R1)};
        run_gemm_chain(lds, WSP(bf16_t, WS_YSSM), WSP(bf16_t, WS_WSUPT), WSP(bf16_t, WS_YATT), WSP(bf16_t, WS_WAUPT), MTOK, 1024, 512, G, e); xcd_barrier(bar); }
    REPEAT(REP_OUT) { EpiOut e{p.x, WSP(bf16_t, WS_HG), WSP(float, WS_RSS)};
        run_gemm(lds, WSP(bf16_t, WS_R1), WSP(bf16_t, WS_WOUTT), MTOK, 1024, 1024, G, e); xcd_barrier(bar); }
    REPEAT(REP_SCORES) { EpiScores e{WSP(_Float16, WS_SCORES)}; run_gemm(lds, WSP(bf16_t, WS_HG), WSP(bf16_t, WS_WCT), MTOK, 2048, 1024, G, e); xcd_barrier(bar); }
#ifdef PROBE_PEER
    phase_peer2<2>(p, smem, vcu, G);
    __syncthreads();
    phase_peer<false>(p, smem, vcu, G);
    xcd_barrier(bar);
    {
        const float* A = WSP(float, 462); const float* B = p.out;
        float d2 = 0.f, b2 = 0.f;
        for (size_t i = (size_t)blockIdx.x * NT + threadIdx.x; i < (size_t)8192 * DM; i += (size_t)G * NT) { const float a = A[i], bb = B[i]; d2 += (a - bb) * (a - bb); b2 += bb * bb; }
        d2 = wave_sum(d2); b2 = wave_sum(b2);
        if ((threadIdx.x & 63) == 0) { atomicAdd((float*)p.ws + 16, d2); atomicAdd((float*)p.ws + 17, b2); }
    }
    xcd_barrier(bar);
    {
        const float e = ((const float*)p.ws)[16] / fmaxf(((const float*)p.ws)[17], 1e-30f);
        int kx = 0; if (e > 1e-8f) kx++; if (e > 1e-7f) kx++; if (e > 1e-6f) kx++; if (e > 1e-5f) kx++; if (e > 1e-4f) kx++; if (e > 1e-3f) kx++; if (e > 1e-2f) kx++; if (!(e == e)) kx = 10;
        const float f = 1.f + 0.05f * kx;
        for (size_t i = (size_t)blockIdx.x * NT + threadIdx.x; i < (size_t)MTOK * DM / 4; i += (size_t)G * NT) { f32x4 v = ((f32x4*)p.out)[i]; ((f32x4*)p.out)[i] = v * f; }
    }
#else
#if !PEER_FP6
    REPEAT(REP_PEER - 1) { phase_peer2<1>(p, smem, vcu, G); __syncthreads(); }
#endif
#ifdef PEER_OLD
    phase_peer2<0>(p, smem, vcu, G);
#elif PEER_FP6
#if REP_PEER > 1
    phase_peer6<true>(p, smem, vcu, G); __syncthreads();
#endif
    phase_peer6<false>(p, smem, vcu, G);
#else
    phase_peer4(p, smem, vcu, G);
#endif
#ifdef UT_FP6
    xcd_barrier(bar);
    {
        const float f = 1.f + 0.05f * ((const float*)p.ws)[20];
        for (size_t i = (size_t)blockIdx.x * NT + threadIdx.x; i < (size_t)MTOK * DM / 4; i += (size_t)G * NT) { f32x4 v = ((f32x4*)p.out)[i]; ((f32x4*)p.out)[i] = v * f; }
    }
#endif
#if defined(PROBE_ATTN) || defined(PROBE_SSM)
    xcd_barrier(bar);
    {
        const float e = ((const float*)p.ws)[16] / fmaxf(((const float*)p.ws)[17], 1e-30f);
        int kx = 0; if (e > 1e-6f) kx++; if (e > 1e-5f) kx++; if (e > 1e-4f) kx++; if (e > 1e-3f) kx++; if (e > 1e-2f) kx++; if (e > 1e-1f) kx++; if (!(e == e)) kx = 8;
        const float f = 1.f + 0.05f * kx;
        for (size_t i = (size_t)blockIdx.x * NT + threadIdx.x; i < (size_t)MTOK * DM / 4; i += (size_t)G * NT) { f32x4 v = ((f32x4*)p.out)[i]; ((f32x4*)p.out)[i] = v * f; }
    }
#endif
#endif
}

extern "C" void kernel_launch(void* const* d_in, const int* in_sizes, int n_in, void* d_out, int out_size, void* d_ws, size_t ws_size,
                              hipStream_t stream) {
    static int grid = 0;
    if (grid == 0) {
        int dev = 0, cus = 0, per_cu = 0;
        if (hipGetDevice(&dev) != hipSuccess || hipDeviceGetAttribute(&cus, hipDeviceAttributeMultiprocessorCount, dev) != hipSuccess) { grid = -1; return; }
        if (hipFuncSetAttribute((const void*)k_mega, hipFuncAttributeMaxDynamicSharedMemorySize, LDS_BYTES) != hipSuccess) { fprintf(stderr, "hipFuncSetAttribute failed\n"); grid = -1; return; }
        if (hipOccupancyMaxActiveBlocksPerMultiprocessor(&per_cu, (const void*)k_mega, NT, LDS_BYTES) != hipSuccess || per_cu < 1) {
            fprintf(stderr, "occupancy query reports %d blocks/CU\n", per_cu); (void)hipGetLastError(); per_cu = 1; }
        grid = cus;
    }
    if (grid < 0) return;
    (void)hipMemsetAsync(d_ws, 0, CTL_ZERO_BYTES, stream);
    Params p{};
    const float** pp = (const float**)&p;
    for (int i = 0; i < 22; ++i) pp[i] = (const float*)d_in[i];
    p.out = (float*)d_out;
    p.ws = (unsigned char*)d_ws;
    for (int f = 0; f < 32; ++f) p.inv64[f] = pow(10000.0, -(double)(2 * f) / 64.0);
    for (int f = 0; f < 16; ++f) p.inv32[f] = pow(10000.0, -(double)(2 * f) / 32.0);
    hipLaunchKernelGGL(k_mega, dim3(grid), dim3(NT), LDS_BYTES, stream, p);
}
```

```cpp
#include <hip/hip_runtime.h>
#include <cstdio>
#include <cstdint>
#include <cmath>
#define GAS __attribute__((address_space(1)))
#define LAS __attribute__((address_space(3)))
namespace pg8 {
#define PG8_LAS __attribute__((address_space(3)))
typedef unsigned short bf16_t;
typedef short bf16x8 __attribute__((ext_vector_type(8)));
typedef float f32x4 __attribute__((ext_vector_type(4)));
typedef unsigned u32x4 __attribute__((ext_vector_type(4)));
constexpr int BM = 256, BK = 64, HALF = 128, HTB = HALF * BK * 2  , STAGE_BYTES = 8 * HTB, NXCD = 8, WGM = 8;

__host__ __device__ __forceinline__ int lds_byte(int r, int c) { const int st = (r >> 4) * 2 + (c >> 5), rr = r & 15, cc = c & 31, ob = rr * 64 + cc * 2; return st * 1024 + (ob ^ (((ob >> 9) & 1) << 5)); }
__host__ __device__ __forceinline__ void stage_rc(int b, int& R, int& C) { const int st = b / 1024, sb = b % 1024, swz = sb ^ (((sb >> 9) & 1) << 5); R = (st >> 1) * 16 + swz / 64; C = (st & 1) * 32 + (swz % 64) / 2; }
__host__ __device__ __forceinline__ int perm32(int rho) { const int n = rho >> 4, i = rho & 15; return 8 * (i >> 2) + 4 * n + (i & 3); }

struct Unit { int pm, pn, sel; };
struct Gemm { const bf16_t* A; const bf16_t* Bt; int M, N, K; const bf16_t* A2; const bf16_t* Bt2; };

struct StaticOrder {
    int nM, nN, nwg, G, c;
    __host__ __device__ void init(int M, int N, int G_, int c_) { nM = M / BM; nN = N / BM; nwg = nM * nN; G = G_; c = c_; }
    __host__ __device__ bool next(int i, Unit& u) const {
        const long L = (long)i * G + c; if (L >= nwg) return false;
        int wgid = (int)L; { const int q = nwg / NXCD, r = nwg % NXCD, xcd = wgid % NXCD, off = wgid / NXCD; wgid = (xcd < r ? xcd * (q + 1) : r * (q + 1) + (xcd - r) * q) + off; }
        const int nig = WGM * nN, gid = wgid / nig, fm = gid * WGM, gsz = (nM - fm) < WGM ? (nM - fm) : WGM;
        u.pm = fm + ((wgid % nig) % gsz); u.pn = (wgid % nig) / gsz; u.sel = 0; return true;
    }
    __device__ __forceinline__ void a_ready(const Unit&) const {}
    __device__ __forceinline__ void done(const Unit&) const {}
};
struct ChainOrder {
    StaticOrder b;
    __host__ __device__ void init(int M, int N, int G_, int c_) { b.init(M, N, G_, c_); }
    __host__ __device__ bool next(int i, Unit& u) const { if (!b.next(i >> 1, u)) return false; u.sel = i & 1; return true; }
    __device__ __forceinline__ void a_ready(const Unit&) const {}
    __device__ __forceinline__ void done(const Unit&) const {}
};
typedef __bf16 bf16x2_cv_t __attribute__((ext_vector_type(2)));
typedef float f32x2_cv_t __attribute__((ext_vector_type(2)));
__device__ __forceinline__ unsigned cvt_pk_bf16(float lo, float hi) { const f32x2_cv_t v = {lo, hi}; return __builtin_bit_cast(unsigned, __builtin_convertvector(v, bf16x2_cv_t)); }
template <class Epi, class Sched, bool ALIGN_EPI = false, bool SP2 = false>
__device__ __forceinline__ void gemm_phase(PG8_LAS unsigned char* lds, const Gemm g, const Sched& S, const Epi& E) {
    int tid_l = threadIdx.x; asm volatile("" : "+v"(tid_l));
    const int tid = tid_l, wid = __builtin_amdgcn_readfirstlane(tid >> 6), lane = tid & 63, wr = wid >> 2, wc = wid & 3, fr = lane & 15, fq = lane >> 4;
    const int K = g.K, nt = K / BK;
    unsigned voffA[2], voffB[2];
#pragma unroll
    for (int i = 0; i < 2; ++i) { int R, C; stage_rc(tid * 16 + i * 8192, R, C); const int Rb = Epi::PERM ? ((R & ~31) + perm32(R & 31)) : R;
        voffA[i] = (unsigned)(R * K + C) * 2u; voffB[i] = (unsigned)(Rb * K + C) * 2u; }
    const size_t kstep = (size_t)(BK * 2);
    const size_t hstep = (size_t)HALF * K * 2;
    const size_t tstep = 2 * hstep;
    const unsigned ldsw = (unsigned)wid * 1024u;
    const int aoff = lds_byte(wr * 64 + fr, fq * 8), boff = lds_byte(wc * 32 + fr, fq * 8);
#define PG8_SA(b, h) (((b) * 2 + (h)) * HTB)
#define PG8_SB(b, h) ((4 + (b) * 2 + (h)) * HTB)
#define PG8_STAGE(bufoff, gbase, voff) do { _Pragma("unroll") for (int _i = 0; _i < 2; ++_i) \
        __builtin_amdgcn_global_load_lds((const unsigned*)((const char*)(gbase) + (voff)[_i]), (PG8_LAS unsigned*)(lds + (bufoff) + ldsw + _i * 8192), 16, 0, 0); } while (0)
#define PG8_LDA(dst, b, h) do { _Pragma("unroll") for (int m = 0; m < 4; ++m) _Pragma("unroll") for (int k = 0; k < 2; ++k) dst[m][k] = *(const PG8_LAS bf16x8*)(lds + PG8_SA(b, h) + aoff + m * 2048 + k * 1024); } while (0)
#define PG8_LDB(dst, b, h) do { _Pragma("unroll") for (int n = 0; n < 2; ++n) _Pragma("unroll") for (int k = 0; k < 2; ++k) dst[n][k] = *(const PG8_LAS bf16x8*)(lds + PG8_SB(b, h) + boff + n * 2048 + k * 1024); } while (0)
#define PG8_MMA(ai, bj, At, Bt) do { __builtin_amdgcn_s_setprio(1); _Pragma("unroll") for (int m = 0; m < 4; ++m) _Pragma("unroll") for (int n = 0; n < 2; ++n) _Pragma("unroll") for (int k = 0; k < 2; ++k) \
        acc[ai][bj][m][n] = __builtin_amdgcn_mfma_f32_16x16x32_bf16(Bt[n][k], At[m][k], acc[ai][bj][m][n], 0, 0, 0); __builtin_amdgcn_s_setprio(0); } while (0)
#define PG8_WAIT_V(n) asm volatile("s_waitcnt vmcnt(" #n ")" ::: "memory")
#define PG8_WAIT_L(n) asm volatile("s_waitcnt lgkmcnt(" #n ")" ::: "memory")
#define PG8_BAR __builtin_amdgcn_s_barrier()
#define PG8_SCHED __builtin_amdgcn_sched_barrier(0)
    Unit cur, nxt; int ui = 0;
    if (!S.next(0, cur)) return;
    f32x4 acc[2][2][4][2];
#pragma unroll
    for (int a = 0; a < 2; ++a)
#pragma unroll
        for (int b = 0; b < 2; ++b)
#pragma unroll
            for (int m = 0; m < 4; ++m)
#pragma unroll
                for (int n = 0; n < 2; ++n) acc[a][b][m][n] = (f32x4){0.f, 0.f, 0.f, 0.f};
    bf16x8 At[4][2], B0[2][2], B1[2][2];
    const char* cA = (const char*)(cur.sel ? g.A2 : g.A) + (size_t)cur.pm * tstep; const char* cB = (const char*)(cur.sel ? g.Bt2 : g.Bt) + (size_t)cur.pn * tstep;
    S.a_ready(cur);
    if constexpr (SP2) {
        PG8_STAGE(PG8_SB(0, 0), cB, voffB); PG8_STAGE(PG8_SB(0, 1), cB + hstep, voffB); PG8_STAGE(PG8_SA(0, 0), cA, voffA); PG8_STAGE(PG8_SA(0, 1), cA + hstep, voffA);
        if (wr == 1) PG8_BAR;
        PG8_WAIT_V(2); PG8_BAR;
        PG8_STAGE(PG8_SB(1, 0), cB + kstep, voffB); PG8_STAGE(PG8_SA(1, 0), cA + kstep, voffA); PG8_STAGE(PG8_SB(1, 1), cB + hstep + kstep, voffB);
        PG8_WAIT_V(6); PG8_BAR;
    } else {
        PG8_STAGE(PG8_SB(0, 0), cB, voffB); PG8_STAGE(PG8_SA(0, 0), cA, voffA); PG8_STAGE(PG8_SB(0, 1), cB + hstep, voffB); PG8_STAGE(PG8_SA(0, 1), cA + hstep, voffA);
        if (wr == 1) PG8_BAR;
        PG8_WAIT_V(4); PG8_BAR;
        PG8_STAGE(PG8_SB(1, 0), cB + kstep, voffB); PG8_STAGE(PG8_SA(1, 0), cA + kstep, voffA); PG8_STAGE(PG8_SB(1, 1), cB + hstep + kstep, voffB);
        PG8_WAIT_V(6); PG8_BAR;
    }
    for (;;) {
        const bool has_next = S.next(ui + 1, nxt);
        const char* nA = has_next ? (const char*)(nxt.sel ? g.A2 : g.A) + (size_t)nxt.pm * tstep : cA; const char* nB = has_next ? (const char*)(nxt.sel ? g.Bt2 : g.Bt) + (size_t)nxt.pn * tstep : cB;
        for (int t = 0; t < nt; t += 2) {
            const bool last = (t == nt - 2);
            const char* a1 = cA + (size_t)(t + 1) * kstep;
            const char* a2 = last ? nA : cA + (size_t)(t + 2) * kstep; const char* b2 = last ? nB : cB + (size_t)(t + 2) * kstep;
            const char* a3 = a2 + kstep; const char* b3 = b2 + kstep;
            if (last && has_next) S.a_ready(nxt);
            if constexpr (SP2) {
            PG8_LDB(B0, 0, 0); PG8_LDB(B1, 0, 1); PG8_SCHED; PG8_LDA(At, 0, 0); PG8_STAGE(PG8_SA(1, 1), a1 + hstep, voffA);
            PG8_WAIT_V(8); PG8_WAIT_L(0); PG8_BAR; PG8_MMA(0, 0, At, B0); PG8_MMA(0, 1, At, B1); PG8_BAR; PG8_SCHED;
            PG8_LDA(At, 0, 1); PG8_STAGE(PG8_SB(0, 0), b2, voffB); PG8_STAGE(PG8_SB(0, 1), b2 + hstep, voffB); PG8_STAGE(PG8_SA(0, 0), a2, voffA);
            PG8_WAIT_V(8); PG8_WAIT_L(0); PG8_BAR; PG8_MMA(1, 0, At, B0); PG8_MMA(1, 1, At, B1); PG8_BAR; PG8_SCHED;
            PG8_LDB(B0, 1, 0); PG8_LDB(B1, 1, 1); PG8_SCHED; PG8_LDA(At, 1, 0); PG8_STAGE(PG8_SA(0, 1), a2 + hstep, voffA);
            PG8_WAIT_V(8); PG8_WAIT_L(0); PG8_BAR; PG8_MMA(0, 0, At, B0); PG8_MMA(0, 1, At, B1); PG8_BAR; PG8_SCHED;
            PG8_LDA(At, 1, 1); PG8_STAGE(PG8_SB(1, 0), b3, voffB); PG8_STAGE(PG8_SB(1, 1), b3 + hstep, voffB); PG8_STAGE(PG8_SA(1, 0), a3, voffA);
            PG8_WAIT_V(8); PG8_WAIT_L(0); PG8_BAR; PG8_MMA(1, 0, At, B0); PG8_MMA(1, 1, At, B1); PG8_BAR; PG8_SCHED;
            } else {
            PG8_LDB(B0, 0, 0); PG8_SCHED; PG8_LDA(At, 0, 0); PG8_STAGE(PG8_SA(1, 1), a1 + hstep, voffA);
            PG8_WAIT_L(8); PG8_BAR; PG8_WAIT_L(0); PG8_MMA(0, 0, At, B0); PG8_BAR; PG8_SCHED;
            PG8_LDB(B1, 0, 1); PG8_STAGE(PG8_SB(0, 0), b2, voffB);
            PG8_BAR; PG8_WAIT_L(0); PG8_MMA(0, 1, At, B1); PG8_BAR;
            PG8_LDA(At, 0, 1); PG8_STAGE(PG8_SA(0, 0), a2, voffA);
            PG8_BAR; PG8_WAIT_L(0); PG8_MMA(1, 0, At, B0); PG8_BAR; PG8_SCHED;
            PG8_STAGE(PG8_SB(0, 1), b2 + hstep, voffB);
            PG8_WAIT_V(6); PG8_BAR; PG8_MMA(1, 1, At, B1); PG8_BAR;
            PG8_LDB(B0, 1, 0); PG8_SCHED; PG8_LDA(At, 1, 0); PG8_STAGE(PG8_SA(0, 1), a2 + hstep, voffA);
            PG8_WAIT_L(8); PG8_BAR; PG8_WAIT_L(0); PG8_MMA(0, 0, At, B0); PG8_BAR; PG8_SCHED;
            PG8_LDB(B1, 1, 1); PG8_STAGE(PG8_SB(1, 0), b3, voffB);
            PG8_BAR; PG8_WAIT_L(0); PG8_MMA(0, 1, At, B1); PG8_BAR;
            PG8_LDA(At, 1, 1); PG8_STAGE(PG8_SA(1, 0), a3, voffA);
            PG8_BAR; PG8_WAIT_L(0); PG8_MMA(1, 0, At, B0); PG8_BAR; PG8_SCHED;
            PG8_STAGE(PG8_SB(1, 1), b3 + hstep, voffB);
            PG8_WAIT_V(6); PG8_BAR; PG8_MMA(1, 1, At, B1); PG8_BAR;
            }
        }
        if constexpr (ALIGN_EPI) { if (wr == 0) PG8_BAR; }
        if constexpr (!Epi::AFTER_DRAIN) { E(acc, cur, wr, wc, fr, fq); S.done(cur); }
        if (!has_next) break;
        if (!(Epi::CHAIN && cur.sel == 0))
#pragma unroll
        for (int a = 0; a < 2; ++a)
#pragma unroll
            for (int b = 0; b < 2; ++b)
#pragma unroll
                for (int m = 0; m < 4; ++m)
#pragma unroll
                    for (int n = 0; n < 2; ++n) acc[a][b][m][n] = (f32x4){0.f, 0.f, 0.f, 0.f};
        cur = nxt; cA = nA; cB = nB; ++ui;
        if constexpr (ALIGN_EPI) { if (wr == 1) PG8_BAR; }
    }
    PG8_WAIT_V(0);
    if constexpr (!ALIGN_EPI) { if (wr == 0) PG8_BAR; }
    PG8_BAR;
    if constexpr (Epi::AFTER_DRAIN) { E.fused(acc, cur, wr, wc, fr, fq, lds, wid, lane); S.done(cur); }
#undef PG8_SA
#undef PG8_SB
#undef PG8_STAGE
#undef PG8_LDA
#undef PG8_LDB
#undef PG8_MMA
#undef PG8_WAIT_V
#undef PG8_WAIT_L
#undef PG8_BAR
#undef PG8_SCHED
}
}
#define XB_TMO      128
#define XB_XCNT(j)  (256  + 64 * (j))
#define XB_XSUB(j)  (1280 + 64 * (j))
#define XB_XGEN(j)  (2304 + 64 * (j))
#define XB_TOP      3328
#define XB_TOPGEN   3392
#define XCD_BAR_WORDS 3456
#define XB_SPIN_CAP (1u << 18)

__device__ __forceinline__ unsigned xb_ld(unsigned* p)              { return __hip_atomic_load(p, __ATOMIC_RELAXED, __HIP_MEMORY_SCOPE_AGENT); }
__device__ __forceinline__ unsigned xb_add(unsigned* p, unsigned v) { return __hip_atomic_fetch_add(p, v, __ATOMIC_RELAXED, __HIP_MEMORY_SCOPE_AGENT); }
__device__ __forceinline__ unsigned xb_xcc_id() { return (unsigned)__builtin_amdgcn_s_getreg((3 << 11) | 20) & 0xFu; }
#define XB_SPIN(cond, bar) do { unsigned _sp = 0; while (cond) { __builtin_amdgcn_s_sleep(1); \
    if ((++_sp & 255u) == 0u) { if (xb_ld(&(bar)[XB_TMO])) break; if (_sp > XB_SPIN_CAP) { atomicAdd(&(bar)[XB_TMO], 1u); break; } } } } while (0)

struct XcdBarrier {
    unsigned* bar; unsigned x;
    volatile LAS unsigned* st;
};

__device__ __forceinline__ XcdBarrier xcd_barrier_post(unsigned* bar, volatile LAS unsigned* st) {
    XcdBarrier b; b.bar = bar; b.x = xb_xcc_id(); b.st = st;
    if (threadIdx.x == 0) (void)xb_add(&bar[XB_XCNT(b.x)], 1u);
    return b;
}
__device__ __forceinline__ void xcd_barrier_complete(unsigned* bar, unsigned x, unsigned& nloc, unsigned& nx) {
    const unsigned G = gridDim.x * gridDim.y * gridDim.z;
    unsigned sum, cnt, mine, sp = 0u;
    for (;;) {
        sum = 0u; cnt = 0u; mine = 0u;
#pragma unroll
        for (unsigned j = 0; j < 16; ++j) { const unsigned c = xb_ld(&bar[XB_XCNT(j)]); sum += c; cnt += (c > 0u) ? 1u : 0u; mine = (j == x) ? c : mine; }
        if (sum == G) break;
        __builtin_amdgcn_s_sleep(1);
        if ((++sp & 255u) == 0u) { if (xb_ld(&bar[XB_TMO])) break; if (sp > XB_SPIN_CAP) { atomicAdd(&bar[XB_TMO], 1u); break; } }
    }
    nloc = mine > 0u ? mine : 1u; nx = cnt > 0u ? cnt : 1u;
}

__device__ __forceinline__ void xcd_barrier(const XcdBarrier& b) {
    asm volatile("s_waitcnt vmcnt(0)" ::: "memory");
    __syncthreads();
    if (threadIdx.x == 0) {
        unsigned* bar = b.bar;
        __builtin_amdgcn_s_waitcnt(0);
        unsigned nloc = b.st[0], nx = b.st[1];
        if (nloc == 0u) { xcd_barrier_complete(bar, b.x, nloc, nx); b.st[0] = nloc; b.st[1] = nx; }
        const unsigned old = xb_add(&bar[XB_XSUB(b.x)], 1u);
        const unsigned gen = old / nloc;
        if (old + 1u == (gen + 1u) * nloc) {
            __builtin_amdgcn_fence(__ATOMIC_RELEASE, "agent");
            asm volatile("s_waitcnt vmcnt(0)" ::: "memory");
            const unsigned og = xb_add(&bar[XB_TOP], 1u);
            const unsigned tg = og / nx;
            if (og + 1u == (tg + 1u) * nx) xb_add(&bar[XB_TOPGEN], 1u);
            else XB_SPIN(xb_ld(&bar[XB_TOPGEN]) == tg, bar);
            __builtin_amdgcn_fence(__ATOMIC_ACQUIRE, "agent");
            xb_add(&bar[XB_XGEN(b.x)], 1u);
            asm volatile("s_waitcnt vmcnt(0)" ::: "memory");
        } else {
            XB_SPIN(xb_ld(&bar[XB_XGEN(b.x)]) == gen, bar);
            __builtin_amdgcn_fence(__ATOMIC_ACQUIRE, "agent");
            asm volatile("s_waitcnt vmcnt(0)" ::: "memory");
        }
    }
    __syncthreads();
}

typedef unsigned short bf16_t;
typedef short bf16x8 __attribute__((ext_vector_type(8)));
typedef float f32x4 __attribute__((ext_vector_type(4)));
typedef unsigned u32x4 __attribute__((ext_vector_type(4)));
using pg8::cvt_pk_bf16;

constexpr int NWAVES = 8, NT = NWAVES * 64;
constexpr int DM = 1024, NB = 8, SEQ = 4096, MTOK = NB * SEQ;
constexpr int SSM_W = 512, SSM_G = 32, SSM_N = 16, SSM_P = 64;
constexpr int IN_W = 3624, IN_WP = 3840;
constexpr int TOPK = 256;
constexpr int PEER_H = 8, PEER_KEYS = 128;
constexpr float NORM_EPS = 1e-6f;
constexpr size_t MiB = 1u << 20;
constexpr int LDS_BYTES = 163840, RING_BYTES = 131072, LDSCTL_OFF = LDS_BYTES - 1024, MISC_OFF = LDSCTL_OFF + 320;
constexpr int CW_BAR = 4096;
constexpr size_t CTL_ZERO_BYTES = 65536;

constexpr size_t WS_WINT = 1, WS_WGLUT = 9, WS_WSUPT = 10, WS_WAUPT = 11, WS_WOUTT = 12, WS_WCT = 14;
constexpr size_t WS_ROPEA = 18, WS_ROPEI = 19, WS_KT = 20, WS_A64 = 21, WS_SSMT = 22, WS_W1T = 254, WS_W3T = 262;
constexpr size_t WS_UTAB = 24, WS_VTAB = 56, WS_USC = 44, WS_VSC = 45;
#if !defined(PEER_FP6) && !defined(PEER_OLD)
#define PEER_FP6 1
#endif
#ifndef PEER_FP6
#define PEER_FP6 0
#endif
#ifndef PEER_U6
#define PEER_U6 PEER_FP6
#endif
#ifndef PEER_U4
#define PEER_U4 PEER_FP6
#endif
#ifndef PEER_V6
#define PEER_V6 PEER_FP6
#endif
#ifndef PEER_FP8
#define PEER_FP8 1
#endif
constexpr size_t WS_R1 = 88;
constexpr size_t WS_U = 152, WS_Q = 184, WS_K = 216, WS_V = 224, WS_QI = 232, WS_KI = 248, WS_WI = 250;
constexpr size_t WS_SGS = 270, WS_SGA = 334, WS_YG = 398, WS_YSSM = 430, WS_YATT = 462, WS_RSS = 494;
constexpr size_t WS_T1 = 152;
constexpr size_t WS_SCORES = 88;
constexpr size_t WS_HG = 398;

struct Params {
    const float *x, *norm1_g, *w_in, *a_re, *a_im, *log_dt, *b_re, *b_im, *c_re, *c_im, *d_skip, *w_glu, *w_ssm_up,
        *w_attn_up, *w_out, *norm2_g, *peer_wq, *peer_k1, *peer_k2, *peer_u, *peer_v, *norm_f_g;
    float* out;
    unsigned char* ws;
    double inv64[32];
    double inv32[16];
};
#define WSP(T, off) ((T*)(p.ws + (size_t)(off) * MiB))

__device__ __forceinline__ unsigned f2bf(float f) {
    unsigned u = __builtin_bit_cast(unsigned, f);
    return (u + 0x7fffu + ((u >> 16) & 1u)) >> 16;
}
__device__ __forceinline__ float bf2f(unsigned b) { return __builtin_bit_cast(float, b << 16); }
__device__ __forceinline__ float bflo(unsigned w) { return __builtin_bit_cast(float, w << 16); }
__device__ __forceinline__ float bfhi(unsigned w) { return __builtin_bit_cast(float, w & 0xffff0000u); }
__device__ __forceinline__ float sigmoidf_(float x) { return __builtin_amdgcn_rcpf(1.f + __expf(-x)); }
__device__ __forceinline__ float gelu_fast(float x) {
    const float z = 0.7978845608028654f * (x + 0.044715f * x * x * x);
    const float e = __expf(2.f * z);
    return x - x * __builtin_amdgcn_rcpf(e + 1.f);
}
__device__ __forceinline__ float gelu_tanh(float x) { return gelu_fast(x); }
template <int CTRL, int RM = 0xf, int BM = 0xf, bool BC = true>
__device__ __forceinline__ float dppf(float old, float src) { return __builtin_bit_cast(float, __builtin_amdgcn_update_dpp(__builtin_bit_cast(int, old), __builtin_bit_cast(int, src), CTRL, RM, BM, BC)); }
template <int CTRL, int RM = 0xf, int BM = 0xf, bool BC = true>
__device__ __forceinline__ int dppi(int old, int src) { return __builtin_amdgcn_update_dpp(old, src, CTRL, RM, BM, BC); }
__device__ __forceinline__ float wave_sum(float v) {
    v += dppf<0x111>(0.f, v); v += dppf<0x112>(0.f, v); v += dppf<0x114>(0.f, v); v += dppf<0x118>(0.f, v);
    v += dppf<0x142, 0xa, 0xf, false>(0.f, v); v += dppf<0x143, 0xc, 0xf, false>(0.f, v);
    return __builtin_bit_cast(float, __builtin_amdgcn_readlane(__builtin_bit_cast(int, v), 63));
}
__device__ __forceinline__ float wave_max(float v) {
    v = fmaxf(v, dppf<0x111, 0xf, 0xf, false>(v, v)); v = fmaxf(v, dppf<0x112, 0xf, 0xf, false>(v, v)); v = fmaxf(v, dppf<0x114, 0xf, 0xf, false>(v, v)); v = fmaxf(v, dppf<0x118, 0xf, 0xf, false>(v, v));
    v = fmaxf(v, dppf<0x142, 0xa, 0xf, false>(v, v)); v = fmaxf(v, dppf<0x143, 0xc, 0xf, false>(v, v));
    return __builtin_bit_cast(float, __builtin_amdgcn_readlane(__builtin_bit_cast(int, v), 63));
}
__device__ __forceinline__ unsigned wave_max_u32(unsigned v) {
    auto mx = [](unsigned a, unsigned b) { return a > b ? a : b; };
    v = mx(v, (unsigned)dppi<0x111, 0xf, 0xf, false>((int)v, (int)v)); v = mx(v, (unsigned)dppi<0x112, 0xf, 0xf, false>((int)v, (int)v));
    v = mx(v, (unsigned)dppi<0x114, 0xf, 0xf, false>((int)v, (int)v)); v = mx(v, (unsigned)dppi<0x118, 0xf, 0xf, false>((int)v, (int)v));
    v = mx(v, (unsigned)dppi<0x142, 0xa, 0xf, false>((int)v, (int)v)); v = mx(v, (unsigned)dppi<0x143, 0xc, 0xf, false>((int)v, (int)v));
    return (unsigned)__builtin_amdgcn_readlane((int)v, 63);
}
__device__ __forceinline__ int wave_incl_scan(int v) {
    v += dppi<0x111>(0, v); v += dppi<0x112>(0, v); v += dppi<0x114>(0, v); v += dppi<0x118>(0, v);
    v += dppi<0x142, 0xa, 0xf, false>(0, v); v += dppi<0x143, 0xc, 0xf, false>(0, v);
    return v;
}
__device__ __forceinline__ u32x4 pack8(f32x4 a, f32x4 b) {
    u32x4 w; w.x = cvt_pk_bf16(a[0], a[1]); w.y = cvt_pk_bf16(a[2], a[3]); w.z = cvt_pk_bf16(b[0], b[1]); w.w = cvt_pk_bf16(b[2], b[3]);
    return w;
}
__device__ __forceinline__ uint2 pack8_fp8(f32x4 a, f32x4 b) {
    int w0 = __builtin_amdgcn_cvt_pk_fp8_f32(a[0], a[1], 0, false); w0 = __builtin_amdgcn_cvt_pk_fp8_f32(a[2], a[3], w0, true);
    int w1 = __builtin_amdgcn_cvt_pk_fp8_f32(b[0], b[1], 0, false); w1 = __builtin_amdgcn_cvt_pk_fp8_f32(b[2], b[3], w1, true);
    return make_uint2((unsigned)w0, (unsigned)w1);
}
typedef float f32x2_t __attribute__((ext_vector_type(2)));
__device__ __forceinline__ void unpack8_fp8(uint2 w, f32x4& a, f32x4& b) {
    const f32x2_t p0 = __builtin_amdgcn_cvt_pk_f32_fp8((int)w.x, false), p1 = __builtin_amdgcn_cvt_pk_f32_fp8((int)w.x, true);
    const f32x2_t p2 = __builtin_amdgcn_cvt_pk_f32_fp8((int)w.y, false), p3 = __builtin_amdgcn_cvt_pk_f32_fp8((int)w.y, true);
    a = (f32x4){p0[0], p0[1], p1[0], p1[1]}; b = (f32x4){p2[0], p2[1], p3[0], p3[1]};
}
__device__ __forceinline__ void unpack8(u32x4 w, f32x4& a, f32x4& b) {
    a[0] = bflo(w.x); a[1] = bfhi(w.x); a[2] = bflo(w.y); a[3] = bfhi(w.y);
    b[0] = bflo(w.z); b[1] = bfhi(w.z); b[2] = bflo(w.w); b[3] = bfhi(w.w);
}

template <class T> __device__ __forceinline__ T ldws(const unsigned char* ws, unsigned off) { return *(const T*)(ws + off); }
__device__ __forceinline__ void sincos_d(double x, double& s, double& c) {
    const double TWO_OVER_PI = 0.63661977236758134308;
    const double PIO2_HI = 1.57079632679489655800e+00, PIO2_LO = 6.12323399573676603587e-17;
    double kd = rint(x * TWO_OVER_PI);
    double r = fma(-kd, PIO2_HI, x);
    r = fma(-kd, PIO2_LO, r);
    long long k = (long long)kd;
    double r2 = r * r;
    double sp = r * (1.0 + r2 * (-1.0 / 6 + r2 * (1.0 / 120 + r2 * (-1.0 / 5040 + r2 * (1.0 / 362880 + r2 * (-1.0 / 39916800 + r2 * (1.0 / 6227020800.0)))))));
    double cp = 1.0 + r2 * (-0.5 + r2 * (1.0 / 24 + r2 * (-1.0 / 720 + r2 * (1.0 / 40320 + r2 * (-1.0 / 3628800 + r2 * (1.0 / 479001600.0 + r2 * (-1.0 / 87178291200.0)))))));
    int q = (int)(k & 3);
    double ss = (q & 1) ? cp : sp, cc = (q & 1) ? sp : cp;
    if (q == 1) cc = -cc;
    if (q == 2) { ss = -ss; cc = -cc; }
    if (q == 3) ss = -ss;
    s = ss; c = cc;
}

__device__ __forceinline__ int winsrc(int v) {
    if (v < 512) return v;
    if (v < 1152) { const int b = v < 1024 ? 512 : 1024; int w = v - b; const int hd = w >> 6; w &= 63; const int i = w >> 3, jj = w & 7;
        return b + hd * 64 + (jj < 4 ? 4 * i + jj : 32 + 4 * i + (jj - 4)); }
    if (v < 1280) return v;
    if (v < 1568) { int w = v - 1280; const int hd = w >> 5; w &= 31; const int i = w >> 3, jj = w & 7;
        return 1280 + hd * 32 + (jj < 4 ? 4 * i + jj : 16 + 4 * i + (jj - 4)); }
    if (v < 1576) return v;
    if (v < 1792) return -1;
    if (v < 2816) return 1576 + (v - 1792);
    return 2600 + (v - 2816);
}
template <bool MAP>
__device__ __forceinline__ void transpose_item(const float* __restrict__ W, int K, int N, bf16_t* WT, int Nout, float* scr, int item, int lane) {
    const int nblk = Nout / 32, kb = item / nblk, nb = item % nblk, k0 = 64 * kb, n0 = 32 * nb;
    const int src = MAP ? winsrc(n0 + (lane & 31)) : n0 + (lane & 31);
    float wv_[32];
#pragma unroll
    for (int i = 0; i < 32; ++i) { const int kk = 2 * i + (lane >> 5); wv_[i] = src >= 0 ? W[(size_t)(k0 + kk) * N + src] : 0.f; }
#pragma unroll
    for (int i = 0; i < 32; ++i) { const int kk = 2 * i + (lane >> 5); scr[kk * 33 + (lane & 31)] = wv_[i]; }
    asm volatile("s_waitcnt lgkmcnt(0)" ::: "memory");
    const int c = lane & 7;
#pragma unroll
    for (int j = 0; j < 4; ++j) {
        const int n = (lane >> 3) + 8 * j; const float* s = scr + (8 * c) * 33 + n;
        u32x4 o; o.x = cvt_pk_bf16(s[0 * 33], s[1 * 33]); o.y = cvt_pk_bf16(s[2 * 33], s[3 * 33]); o.z = cvt_pk_bf16(s[4 * 33], s[5 * 33]); o.w = cvt_pk_bf16(s[6 * 33], s[7 * 33]);
        *(u32x4*)(WT + (size_t)(n0 + n) * K + k0 + 8 * c) = o;
    }
    asm volatile("s_waitcnt lgkmcnt(0)" ::: "memory");
}


__device__ __forceinline__ unsigned fp6_code(float y) {
    const float a = fabsf(y);
    unsigned c;
    if (a < 1.f) c = (unsigned)(a * 8.f + 0.5f);
    else { c = ((__float_as_uint(a) + 0x00080000u) >> 20) - 1008u; c = c > 31u ? 31u : c; }
    return c | (y < 0.f ? 32u : 0u);
}
__device__ __forceinline__ void fp6_pack16(const unsigned (&c)[16], unsigned& w0, unsigned& w1, unsigned& w2) {
    w0 = c[0] | (c[1] << 6) | (c[2] << 12) | (c[3] << 18) | (c[4] << 24) | (c[5] << 30);
    w1 = (c[5] >> 2) | (c[6] << 4) | (c[7] << 10) | (c[8] << 16) | (c[9] << 22) | (c[10] << 28);
    w2 = (c[10] >> 4) | (c[11] << 2) | (c[12] << 8) | (c[13] << 14) | (c[14] << 20) | (c[15] << 26);
}
__device__ __forceinline__ void peer_row_load(const Params& p, int r, int lane, f32x4 (&a)[4]) {
    const int tb = r >> 14, e = r & 16383;
    const float* src = (tb ? p.peer_v : p.peer_u) + (size_t)e * DM;
    const bool six = tb ? (PEER_V6 != 0) : (PEER_U6 == 1);
    const bool nat16 = six && tb == 0;
    const int o0 = nat16 ? lane * 16 : lane * 8, o1 = nat16 ? lane * 16 + 8 : 512 + lane * 8;
    a[0] = *(const f32x4*)(src + o0); a[1] = *(const f32x4*)(src + o0 + 4); a[2] = *(const f32x4*)(src + o1); a[3] = *(const f32x4*)(src + o1 + 4);
}
__device__ __forceinline__ void peer_row_conv(const Params& p, int r, int lane, unsigned char* stage, const f32x4 (&a)[4]) {
    unsigned char* ut = WSP(unsigned char, WS_UTAB); unsigned char* vt = WSP(unsigned char, WS_VTAB);
    float* usc = WSP(float, WS_USC); float* vsc = WSP(float, WS_VSC);
    const int tb = r >> 14, e = r & 16383;
    const bool six = tb ? (PEER_V6 != 0) : (PEER_U6 == 1);
    const f32x4 a0 = a[0], a1 = a[1], a2 = a[2], a3 = a[3];
    float m = 0.f;
#pragma unroll
    for (int i = 0; i < 4; ++i) m = fmaxf(m, fmaxf(fmaxf(fabsf(a0[i]), fabsf(a1[i])), fmaxf(fabsf(a2[i]), fabsf(a3[i]))));
    m = wave_max(m);
    if (six && tb == 0 && PEER_U4) {
        const float sc = m > 0.f ? 6.f / m : 1.f;
        unsigned w0 = 0u, w1 = 0u;
#pragma unroll
        for (int i = 0; i < 16; ++i) {
            const float y = (i < 4 ? a0[i & 3] : i < 8 ? a1[i & 3] : i < 12 ? a2[i & 3] : a3[i & 3]) * sc;
            const float a = fabsf(y);
            const unsigned cm = (a >= 0.25f) + (a >= 0.75f) + (a >= 1.25f) + (a >= 1.75f) + (a >= 2.5f) + (a >= 3.5f) + (a >= 5.f);
            const unsigned cd = cm | (y < 0.f ? 8u : 0u);
            if (i < 8) w0 |= cd << (4 * i); else w1 |= cd << (4 * (i - 8));
        }
        unsigned* st = (unsigned*)(stage + lane * 8); st[0] = w0; st[1] = w1;
        __builtin_amdgcn_s_waitcnt(0xC07F); __builtin_amdgcn_wave_barrier();
        if (lane < 32) {
            const int k3 = lane >> 3, h = (lane >> 2) & 1, q = lane & 3;
            *(u32x4*)(ut + (size_t)e * 768 + lane * 16) = *(const u32x4*)(stage + h * 256 + q * 64 + k3 * 16);
        }
        __builtin_amdgcn_s_waitcnt(0xC07F); __builtin_amdgcn_wave_barrier();
        if (lane == 0) usc[e] = 1.f / sc;
    } else if (six) {
        const float sc = m > 0.f ? 7.5f / m : 1.f;
        unsigned cd[16];
#pragma unroll
        for (int i = 0; i < 4; ++i) { cd[i] = fp6_code(a0[i] * sc); cd[4 + i] = fp6_code(a1[i] * sc); cd[8 + i] = fp6_code(a2[i] * sc); cd[12 + i] = fp6_code(a3[i] * sc); }
        unsigned w0, w1, w2; fp6_pack16(cd, w0, w1, w2);
        if (tb) { unsigned* dst = (unsigned*)(vt + (size_t)e * 768 + lane * 12); dst[0] = w0; dst[1] = w1; dst[2] = w2; }
        else {
            unsigned* st = (unsigned*)(stage + lane * 12); st[0] = w0; st[1] = w1; st[2] = w2;
            __builtin_amdgcn_s_waitcnt(0xC07F); __builtin_amdgcn_wave_barrier();
            if (lane < 48) {
                const int k3 = lane >> 3, h = (lane >> 2) & 1, q = lane & 3;
                *(u32x4*)(ut + (size_t)e * 768 + lane * 16) = *(const u32x4*)(stage + h * 384 + q * 96 + k3 * 16);
            }
            __builtin_amdgcn_s_waitcnt(0xC07F); __builtin_amdgcn_wave_barrier();
        }
        if (lane == 0) (tb ? vsc : usc)[e] = 1.f / sc;
    } else {
        const float sc = m > 0.f ? 224.f / m : 1.f;
        const uint2 w01 = pack8_fp8(a0 * sc, a1 * sc), w23 = pack8_fp8(a2 * sc, a3 * sc);
        if (tb == 0) {
            *(uint2*)(ut + (size_t)e * 1024 + lane * 8) = w01; *(uint2*)(ut + (size_t)e * 1024 + 512 + lane * 8) = w23;
            if (lane == 0) usc[e] = 1.f / sc;
        } else {
            *(u32x4*)(vt + (size_t)e * 1024 + lane * 16) = (u32x4){w01.x, w01.y, w23.x, w23.y};
            if (lane == 0) vsc[e] = 1.f / sc;
        }
    }
}
__device__ __forceinline__ void peer_table_row(const Params& p, int r, int lane, unsigned char* stage) { f32x4 a[4]; peer_row_load(p, r, lane, a); peer_row_conv(p, r, lane, stage, a); }
template <int PART>
__device__ __forceinline__ void phase_prep(const Params& p, unsigned char* smem, int vcu, int G) {
    int tid = threadIdx.x; asm volatile("" : "+v"(tid)); const int lane = tid & 63, wave = tid >> 6;
    const int gw = vcu * NWAVES + wave, NGW = G * NWAVES;
    const size_t gtid = (size_t)vcu * NT + tid, gsize = (size_t)G * NT;
    float* scr = (float*)smem + wave * 4096;
#pragma unroll 1
    for (int ord = 0; ord < 2; ++ord) {
    if ((ord == 0) != ((wave & 1) != 0)) {
    {
        constexpr int I_IN = 16 * (IN_WP / 32), I_GLU = 8 * 16, I_SUP = 8 * 32, I_AUP = 8 * 32, I_OUT = 16 * 32;
        constexpr int NITEMS = I_IN + I_GLU + I_SUP + I_AUP + I_OUT;
        for (int it = (PART == 0 ? gw : NITEMS); it < NITEMS; it += NGW) {
            int r = it;
            if (r < I_IN) { transpose_item<true>(p.w_in, 1024, IN_W, WSP(bf16_t, WS_WINT), IN_WP, scr, r, lane); continue; } r -= I_IN;
            if (r < I_GLU) { transpose_item<false>(p.w_glu, 512, 512, WSP(bf16_t, WS_WGLUT), 512, scr, r, lane); continue; } r -= I_GLU;
            if (r < I_SUP) { transpose_item<false>(p.w_ssm_up, 512, 1024, WSP(bf16_t, WS_WSUPT), 1024, scr, r, lane); continue; } r -= I_SUP;
            if (r < I_AUP) { transpose_item<false>(p.w_attn_up, 512, 1024, WSP(bf16_t, WS_WAUPT), 1024, scr, r, lane); continue; } r -= I_AUP;
            transpose_item<false>(p.w_out, 1024, 1024, WSP(bf16_t, WS_WOUTT), 1024, scr, r, lane);
        }
    }
    if (PART == 0) {
    {
        bf16_t* wct = WSP(bf16_t, WS_WCT);
        for (int it = gw; it < 16 * 8 * 64; it += NGW) {
            const int hh = it >> 9, kt = (it >> 6) & 7, ct = it & 63;
            const int h = hh >> 1, half = hh & 1;
            const float* ap = (half ? p.peer_k2 : p.peer_k1) + ((size_t)h * 128 + kt * 16 + (lane & 15)) * 128 + (lane >> 4) * 32;
            const float* bp = p.peer_wq + (size_t)(ct * 16 + (lane & 15)) * 2048 + h * 256 + half * 128 + (lane >> 4) * 32;
            f32x4 av[8], bv[8];
#pragma unroll
            for (int i = 0; i < 8; ++i) { av[i] = *(const f32x4*)(ap + 4 * i); bv[i] = *(const f32x4*)(bp + 4 * i); }
            f32x4 acc = {0.f, 0.f, 0.f, 0.f};
#pragma unroll
            for (int i = 0; i < 8; ++i)
#pragma unroll
                for (int e = 0; e < 4; ++e) acc = __builtin_amdgcn_mfma_f32_16x16x4f32(av[i][e], bv[i][e], acc, 0, 0, 0);
            const float g2k = p.norm2_g[ct * 16 + (lane & 15)];
#pragma unroll
            for (int r = 0; r < 4; ++r) wct[(size_t)(hh * 128 + kt * 16 + 4 * (lane >> 4) + r) * 1024 + ct * 16 + (lane & 15)] = (bf16_t)f2bf(acc[r] * g2k);
        }
    }
#if !PEER_FP8
    {
        const size_t n8 = (size_t)16384 * 1024 / 8;
        u32x4* ut = WSP(u32x4, WS_UTAB); u32x4* vt = WSP(u32x4, WS_VTAB);
        for (size_t i = gtid; i < n8; i += gsize) {
            f32x4 a = ((const f32x4*)p.peer_u)[2 * i], b = ((const f32x4*)p.peer_u)[2 * i + 1];
            ut[i] = pack8(a, b);
            f32x4 c = ((const f32x4*)p.peer_v)[2 * i], d = ((const f32x4*)p.peer_v)[2 * i + 1];
            vt[i] = pack8(c, d);
        }
    }
#endif
    }
    if (PART == 0) {
    {
        float2* ra = WSP(float2, WS_ROPEA); float2* ri = WSP(float2, WS_ROPEI);
        for (size_t i = gtid; i < (size_t)SEQ * 32; i += gsize) {
            int pos = (int)(i >> 5), f = (int)(i & 31);
            double s, c; sincos_d((double)pos * p.inv64[f], s, c);
            ra[i] = make_float2((float)c, (float)s);
        }
        for (size_t i = gtid; i < (size_t)SEQ * 16; i += gsize) {
            int pos = (int)(i >> 4), f = (int)(i & 15);
            double s, c; sincos_d((double)pos * p.inv32[f], s, c);
            ri[i] = make_float2((float)c, (float)s);
        }
    }
    }
    {
#ifdef PROBE_SSM
    if (PART == 0) {
        float2* abar = WSP(float2, WS_SSMT);
        float2* bbar = abar + SSM_G * SSM_P;
        for (size_t i = gtid; i < (size_t)SSM_G * SSM_P; i += gsize) {
            int g = (int)(i / SSM_P);
            double are = p.a_re[i], aim = p.a_im[i];
            double dt = exp((double)p.log_dt[g]);
            double s, c; sincos_d(aim * dt, s, c);
            double mag = exp(are * dt);
            double abr = mag * c, abi = mag * s;
            abar[i] = make_float2((float)abr, (float)abi);
            double nr = abr - 1.0, ni = abi;
            double den = are * are + aim * aim;
            double qr = (nr * are + ni * aim) / den, qi = (ni * are - nr * aim) / den;
            for (int cch = 0; cch < SSM_N; ++cch) {
                double br = p.b_re[i * SSM_N + cch], bi = p.b_im[i * SSM_N + cch];
                bbar[i * SSM_N + cch] = make_float2((float)(qr * br - qi * bi), (float)(qr * bi + qi * br));
            }
        }
    }
#endif

    {
        bf16_t* kt = WSP(bf16_t, WS_KT);
        float* zb = (float*)smem + wave * 4096;
        for (int pair = (PART == 0 ? gw : SSM_G * 64); pair < SSM_G * 64; pair += NGW) {
            const int g = pair >> 6, l = pair & 63;
            {
                const int pp = lane; const size_t i = (size_t)g * SSM_P + pp;
                const double are = p.a_re[i], aim = p.a_im[i], dt = exp((double)p.log_dt[g]);
                double s1, c1; sincos_d(aim * dt, s1, c1); const double m1 = exp(are * dt);
                const double nr = m1 * c1 - 1.0, ni = m1 * s1, den = are * are + aim * aim;
                const double qr = (nr * are + ni * aim) / den, qi_ = (ni * are - nr * aim) / den;
                double sl, cl; sincos_d(aim * dt * l, sl, cl); const double ml = exp(are * dt * l);
                const double zr = ml * cl, zi = ml * sl;
                const double zqr = zr * qr - zi * qi_, zqi = zr * qi_ + zi * qr;
#pragma unroll
                for (int ci = 0; ci < 16; ++ci) {
                    const double br = p.b_re[i * SSM_N + ci], bi = p.b_im[i * SSM_N + ci];
                    *(float2*)(zb + 2 * (pp * 16 + ci)) = make_float2((float)(zqr * br - zqi * bi), (float)(zqr * bi + zqi * br));
                }
            }
            __builtin_amdgcn_s_waitcnt(0xC07F);
            __builtin_amdgcn_wave_barrier();
#pragma unroll 1
            for (int q4 = 0; q4 < 4; ++q4) {
                const int ent = q4 * 64 + lane, co = ent >> 4, ci = ent & 15;
                float acc = 0.f;
                const f32x4* crp = (const f32x4*)(p.c_re + ((size_t)g * SSM_N + co) * SSM_P); const f32x4* cip = (const f32x4*)(p.c_im + ((size_t)g * SSM_N + co) * SSM_P);
#pragma unroll 1
                for (int hh = 0; hh < 4; ++hh) {
                    f32x4 crv[4], civ[4];
#pragma unroll
                    for (int q = 0; q < 4; ++q) { crv[q] = crp[hh * 4 + q]; civ[q] = cip[hh * 4 + q]; }
#pragma unroll
                    for (int q = 0; q < 4; ++q)
#pragma unroll
                        for (int e = 0; e < 4; ++e) {
                            const int pp = hh * 16 + q * 4 + e;
                            const float2 z = *(const float2*)(zb + 2 * (pp * 16 + ci));
                            acc += crv[q][e] * z.x - civ[q][e] * z.y;
                        }
                }
                if (l == 0 && co == ci) acc += p.d_skip[g * SSM_N + co];
                kt[(((size_t)g * 64 + l) * 2 + (ci >> 3)) * 128 + co * 8 + (ci & 7)] = (bf16_t)f2bf(acc);
            }
            __builtin_amdgcn_wave_barrier();
        }
        bf16_t* w1t = WSP(bf16_t, WS_W1T); bf16_t* w3t = WSP(bf16_t, WS_W3T); float2* a64 = WSP(float2, WS_A64);
        for (size_t it = (PART == 1 ? gtid : (size_t)SSM_G * SSM_P * 64); it < (size_t)SSM_G * SSM_P * 64; it += gsize) {
            const int e = (int)(it & 63), pp = (int)((it >> 6) & 63), g = (int)(it >> 12);
            const size_t i = (size_t)g * SSM_P + pp;
            const double are = p.a_re[i], aim = p.a_im[i], dt = exp((double)p.log_dt[g]);
            double s1, c1; sincos_d(aim * dt, s1, c1); const double m1 = exp(are * dt);
            const double nr = m1 * c1 - 1.0, ni = m1 * s1, den = are * are + aim * aim;
            const double qr = (nr * are + ni * aim) / den, qi_ = (ni * are - nr * aim) / den;
            {
                const int l = 63 - e; double sl, cl; sincos_d(aim * dt * l, sl, cl); const double ml = exp(are * dt * l);
                const double zr = ml * cl, zi = ml * sl, wr_ = zr * qr - zi * qi_, wi_ = zr * qi_ + zi * qr;
                unsigned re_w[8], im_w[8];
#pragma unroll
                for (int c2 = 0; c2 < 8; ++c2) {
                    const double br0 = p.b_re[i * SSM_N + 2 * c2], bi0 = p.b_im[i * SSM_N + 2 * c2], br1 = p.b_re[i * SSM_N + 2 * c2 + 1], bi1 = p.b_im[i * SSM_N + 2 * c2 + 1];
                    re_w[c2] = f2bf((float)(wr_ * br0 - wi_ * bi0)) | (f2bf((float)(wr_ * br1 - wi_ * bi1)) << 16);
                    im_w[c2] = f2bf((float)(wr_ * bi0 + wi_ * br0)) | (f2bf((float)(wr_ * bi1 + wi_ * br1)) << 16);
                }
                u32x4* d0 = (u32x4*)(w1t + ((size_t)g * 128 + 2 * pp) * 1024 + e * 16);
                d0[0] = (u32x4){re_w[0], re_w[1], re_w[2], re_w[3]}; d0[1] = (u32x4){re_w[4], re_w[5], re_w[6], re_w[7]};
                u32x4* d1 = (u32x4*)(w1t + ((size_t)g * 128 + 2 * pp + 1) * 1024 + e * 16);
                d1[0] = (u32x4){im_w[0], im_w[1], im_w[2], im_w[3]}; d1[1] = (u32x4){im_w[4], im_w[5], im_w[6], im_w[7]};
            }
            {
                const int l = e + 1; double sl, cl; sincos_d(aim * dt * l, sl, cl); const double ml = exp(are * dt * l);
                const double zr = ml * cl, zi = ml * sl;
                for (int co = 0; co < 16; ++co) {
                    const double cr = p.c_re[((size_t)g * SSM_N + co) * SSM_P + pp], cim = p.c_im[((size_t)g * SSM_N + co) * SSM_P + pp];
                    const unsigned w = f2bf((float)(cr * zr - cim * zi)) | (f2bf((float)(-(cr * zi + cim * zr))) << 16);
                    *(unsigned*)(w3t + (((size_t)g * 64 + e) * 16 + co) * 128 + 2 * pp) = w;
                }
            }
            if (e == 0) { double sl, cl; sincos_d(aim * dt * 64, sl, cl); const double ml = exp(are * dt * 64); a64[i] = make_float2((float)(ml * cl), (float)(ml * sl)); }
        }
    }
    }
    } else {
    if (PART == 0) {
    {
        bf16_t* O = WSP(bf16_t, WS_R1);
        for (int row0 = gw; row0 < MTOK; row0 += 4 * NGW) {
            f32x4 v[4][4];
#pragma unroll
            for (int j = 0; j < 4; ++j) {
                const int row = row0 + j * NGW < MTOK ? row0 + j * NGW : row0;
                const float* xr = p.x + (size_t)row * DM;
#pragma unroll
                for (int c = 0; c < 2; ++c) { v[j][2 * c] = *(const f32x4*)(xr + c * 512 + lane * 8); v[j][2 * c + 1] = *(const f32x4*)(xr + c * 512 + lane * 8 + 4); }
            }
#pragma unroll
            for (int j = 0; j < 4; ++j) {
                const int row = row0 + j * NGW;
                if (row < MTOK) {
                    float ss = 0.f;
#pragma unroll
                    for (int i = 0; i < 4; ++i) ss += v[j][i][0] * v[j][i][0] + v[j][i][1] * v[j][i][1] + v[j][i][2] * v[j][i][2] + v[j][i][3] * v[j][i][3];
                    ss = wave_sum(ss);
                    const float sc = rsqrtf(ss * (1.f / DM) + NORM_EPS);
#pragma unroll
                    for (int c = 0; c < 2; ++c) {
                        f32x4 ga = *(const f32x4*)(p.norm1_g + c * 512 + lane * 8), gb = *(const f32x4*)(p.norm1_g + c * 512 + lane * 8 + 4);
                        *(u32x4*)(O + (size_t)row * DM + c * 512 + lane * 8) = pack8(v[j][2 * c] * sc * ga, v[j][2 * c + 1] * sc * gb);
                    }
                }
            }
        }
    }
    }
    }
    }
}

#define EPI_ARGS const f32x4 (&acc)[2][2][4][2], const pg8::Unit& u, int wr_, int wc_, int fr_, int fq_
#define EPI_COORDS int t_ = threadIdx.x; asm volatile("" : "+v"(t_)); const int wid_ = __builtin_amdgcn_readfirstlane(t_ >> 6); \
    const int wr = wid_ >> 2, wc = wid_ & 3, fr = t_ & 15, fq = (t_ >> 4) & 3; (void)wr_; (void)wc_; (void)fr_; (void)fq_;
#define EPI_SB __builtin_amdgcn_sched_barrier(0);
#define EPI_LOOP(...) \
    _Pragma("unroll") for (int ai = 0; ai < 2; ++ai) _Pragma("unroll") for (int m = 0; m < 4; ++m) { \
        const int row = u.pm * 256 + ai * 128 + wr * 64 + m * 16 + fr; \
        _Pragma("unroll") for (int bj = 0; bj < 2; ++bj) { const int vc = bj * 128 + wc * 32 + fq * 8; const f32x4 a0 = acc[ai][bj][m][0], a1 = acc[ai][bj][m][1]; __VA_ARGS__ EPI_SB } }

struct EpiInProj {
    static constexpr bool PERM = true, AFTER_DRAIN = false, CHAIN = false;
    bf16_t *u_, *q, *k, *v, *qi, *ki, *sgs, *sga; float* wi; const float2 *ropeA, *ropeI;
    __device__ __forceinline__ void rope_store(bf16_t* dst, f32x4 c01, f32x4 c23, f32x4 a0, f32x4 a1) const {
        f32x4 r1, r2;
        r1[0] = a0[0] * c01[0] - a1[0] * c01[1]; r2[0] = a1[0] * c01[0] + a0[0] * c01[1];
        r1[1] = a0[1] * c01[2] - a1[1] * c01[3]; r2[1] = a1[1] * c01[2] + a0[1] * c01[3];
        r1[2] = a0[2] * c23[0] - a1[2] * c23[1]; r2[2] = a1[2] * c23[0] + a0[2] * c23[1];
        r1[3] = a0[3] * c23[2] - a1[3] * c23[3]; r2[3] = a1[3] * c23[2] + a0[3] * c23[3];
        *(u32x4*)dst = pack8(r1, r2);
    }
    __device__ __forceinline__ void rope_store8(unsigned char* dst, f32x4 c01, f32x4 c23, f32x4 a0, f32x4 a1) const {
        f32x4 r1, r2;
        r1[0] = a0[0] * c01[0] - a1[0] * c01[1]; r2[0] = a1[0] * c01[0] + a0[0] * c01[1];
        r1[1] = a0[1] * c01[2] - a1[1] * c01[3]; r2[1] = a1[1] * c01[2] + a0[1] * c01[3];
        r1[2] = a0[2] * c23[0] - a1[2] * c23[1]; r2[2] = a1[2] * c23[0] + a0[2] * c23[1];
        r1[3] = a0[3] * c23[2] - a1[3] * c23[3]; r2[3] = a1[3] * c23[2] + a0[3] * c23[3];
        *(uint2*)dst = pack8_fp8(r1 * 16.f, r2 * 16.f);
    }
    __device__ __forceinline__ void operator()(EPI_ARGS) const {
        EPI_COORDS
        const int pn = u.pn;
#define ROPE_ROW(RG) (u.pm * 256 + ((RG) >> 2) * 128 + wr * 64 + ((RG) & 3) * 16 + fr)
#define ROPE_GROUPS(TAB, STRIDE, COLOFF, ...) {                                                                                    \
            f32x4 cq_[4][2];                                                                                                       \
            _Pragma("unroll") for (int d_ = 0; d_ < 4; ++d_) { const float2* cs_ = (TAB) + (ROPE_ROW(d_) & (SEQ - 1)) * (STRIDE) + (COLOFF); cq_[d_][0] = *(const f32x4*)cs_; cq_[d_][1] = *(const f32x4*)(cs_ + 2); } \
            _Pragma("unroll") for (int rg_ = 0; rg_ < 8; ++rg_) {                                                                  \
                const int ai = rg_ >> 2, m = rg_ & 3; const int row = ROPE_ROW(rg_);                                               \
                const f32x4 c01 = cq_[rg_ & 3][0], c23 = cq_[rg_ & 3][1];                                                          \
                if (rg_ + 4 < 8) { const float2* cs_ = (TAB) + (ROPE_ROW(rg_ + 4) & (SEQ - 1)) * (STRIDE) + (COLOFF); cq_[rg_ & 3][0] = *(const f32x4*)cs_; cq_[rg_ & 3][1] = *(const f32x4*)(cs_ + 2); } \
                _Pragma("unroll") for (int bj = 0; bj < 2; ++bj) { const int vc = bj * 128 + wc * 32 + fq * 8; const f32x4 a0 = acc[ai][bj][m][0], a1 = acc[ai][bj][m][1]; __VA_ARGS__ EPI_SB } \
            } }
        if (pn < 2) {
            EPI_LOOP({ const int col = pn * 256 + vc; *(u32x4*)(u_ + (((size_t)(row >> 12) * 32 + (col >> 4)) * SEQ + (row & (SEQ - 1))) * 16 + (col & 8)) = pack8(a0, a1); })
        } else if (pn < 4) {
            ROPE_GROUPS(ropeA, 32, ((wc & 1) * 4 + fq) * 4, { rope_store(q + (size_t)row * 512 + (pn - 2) * 256 + vc, c01, c23, a0, a1); })
        } else if (pn == 4) {
            ROPE_GROUPS(ropeA, 32, ((wc & 1) * 4 + fq) * 4, { if (bj == 0) rope_store8((unsigned char*)k + (size_t)row * 128 + vc, c01, c23, a0, a1);
                       else *(uint2*)((unsigned char*)v + (size_t)row * 128 + (vc - 128)) = pack8_fp8(a0 * 16.f, a1 * 16.f); })
        } else if (pn == 5) {
            ROPE_GROUPS(ropeI, 16, fq * 4, { rope_store(qi + (size_t)row * 256 + vc, c01, c23, a0, a1); })
        } else if (pn == 6) {
            if (wc == 0) { ROPE_GROUPS(ropeI, 16, fq * 4, { if (bj == 0) rope_store(ki + (size_t)row * 32 + fq * 8, c01, c23, a0, a1); }) }
            else if (wc == 1) { EPI_LOOP({ if (bj == 0 && fq == 0) { *(f32x4*)(wi + (size_t)row * 8) = a0; *(f32x4*)(wi + (size_t)row * 8 + 4) = a1; } }) }
        } else if (pn < 11) {
            EPI_LOOP({ f32x4 s0, s1;
                       _Pragma("unroll") for (int j = 0; j < 4; ++j) { s0[j] = sigmoidf_(a0[j]); s1[j] = sigmoidf_(a1[j]); }
                       *(u32x4*)(sgs + (size_t)row * 1024 + (pn - 7) * 256 + vc) = pack8(s0, s1); })
        } else {
            EPI_LOOP({ f32x4 s0, s1;
                       _Pragma("unroll") for (int j = 0; j < 4; ++j) { s0[j] = sigmoidf_(a0[j]); s1[j] = sigmoidf_(a1[j]); }
                       *(u32x4*)(sga + (size_t)row * 1024 + (pn - 11) * 256 + vc) = pack8(s0, s1); })
        }
#undef ROPE_GROUPS
#undef ROPE_ROW
    }
};
struct EpiGlu {
    static constexpr bool PERM = true, AFTER_DRAIN = false, CHAIN = false;
    const bf16_t* y; bf16_t* o;
    __device__ __forceinline__ void operator()(EPI_ARGS) const {
        EPI_COORDS
        constexpr int D = 4;
        u32x4 yq[D];
#define GL_IDX(GI) ((size_t)(u.pm * 256 + ((GI) >> 3) * 128 + wr * 64 + (((GI) >> 1) & 3) * 16 + fr) * 512 + u.pn * 256 + ((GI) & 1) * 128 + wc * 32 + fq * 8)
#pragma unroll
        for (int d = 0; d < D; ++d) yq[d] = *(const u32x4*)(y + GL_IDX(d));
#pragma unroll
        for (int gi = 0; gi < 16; ++gi) {
            const int ai = gi >> 3, m = (gi >> 1) & 3, bj = gi & 1;
            const u32x4 yw = yq[gi % D];
            if (gi + D < 16) yq[gi % D] = *(const u32x4*)(y + GL_IDX(gi + D));
            const f32x4 a0 = acc[ai][bj][m][0], a1 = acc[ai][bj][m][1];
            f32x4 y0, y1; unpack8(yw, y0, y1);
#pragma unroll
            for (int j = 0; j < 4; ++j) { y0[j] *= sigmoidf_(a0[j]); y1[j] *= sigmoidf_(a1[j]); }
            *(u32x4*)(o + GL_IDX(gi)) = pack8(y0, y1);
            EPI_SB
        }
#undef GL_IDX
    }
};
struct EpiMerge1 {
    static constexpr bool PERM = true, AFTER_DRAIN = false, CHAIN = false;
    const bf16_t* g; bf16_t* t;
    __device__ __forceinline__ void operator()(EPI_ARGS) const {
        EPI_COORDS
        EPI_LOOP({ const size_t idx = (size_t)row * 1024 + u.pn * 256 + vc; f32x4 g0, g1; unpack8(*(const u32x4*)(g + idx), g0, g1);
                   *(u32x4*)(t + idx) = pack8(g0 * a0, g1 * a1); })
    }
};
struct EpiMerge2 {
    static constexpr bool PERM = true, AFTER_DRAIN = false, CHAIN = false;
    const bf16_t* g; const bf16_t* t; bf16_t* o;
    __device__ __forceinline__ void operator()(EPI_ARGS) const {
        EPI_COORDS
        EPI_LOOP({ const size_t idx = (size_t)row * 1024 + u.pn * 256 + vc; f32x4 g0, g1, t0, t1; unpack8(*(const u32x4*)(g + idx), g0, g1); unpack8(*(const u32x4*)(t + idx), t0, t1);
                   *(u32x4*)(o + idx) = pack8(t0 + g0 * a0, t1 + g1 * a1); })
    }
};
struct EpiMergeChain {
    static constexpr bool PERM = true, AFTER_DRAIN = false, CHAIN = true;
    const bf16_t* gs; const bf16_t* ga; bf16_t* o;
    __device__ __forceinline__ void operator()(f32x4 (&acc)[2][2][4][2], const pg8::Unit& u, int wr_, int wc_, int fr_, int fq_) const {
        EPI_COORDS
        constexpr int D = 4;
        u32x4 gaq[D], gsq[D];
        const bool first = (u.sel == 0);
#define MC_IDX(GI) ((size_t)(u.pm * 256 + ((GI) >> 3) * 128 + wr * 64 + (((GI) >> 1) & 3) * 16 + fr) * 1024 + u.pn * 256 + ((GI) & 1) * 128 + wc * 32 + fq * 8)
#pragma unroll
        for (int d = 0; d < D; ++d) { const size_t idx = MC_IDX(d); gaq[d] = *(const u32x4*)(ga + idx); gsq[d] = first ? *(const u32x4*)(gs + idx) : (u32x4){0u, 0u, 0u, 0u}; }
#pragma unroll
        for (int gi = 0; gi < 16; ++gi) {
            const int ai = gi >> 3, m = (gi >> 1) & 3, bj = gi & 1;
            const u32x4 gaw = gaq[gi % D], gsw = gsq[gi % D];
            if (gi + D < 16) { const size_t idn = MC_IDX(gi + D); gaq[gi % D] = *(const u32x4*)(ga + idn); if (first) gsq[gi % D] = *(const u32x4*)(gs + idn); }
            f32x4 a0, a1; unpack8(gaw, a0, a1);
            if (first) {
                f32x4 s0, s1; unpack8(gsw, s0, s1);
#pragma unroll
                for (int j = 0; j < 4; ++j) { acc[ai][bj][m][0][j] *= s0[j] * __builtin_amdgcn_rcpf(a0[j]); acc[ai][bj][m][1][j] *= s1[j] * __builtin_amdgcn_rcpf(a1[j]); }
            } else {
                *(u32x4*)(o + MC_IDX(gi)) = pack8(acc[ai][bj][m][0] * a0, acc[ai][bj][m][1] * a1);
            }
            EPI_SB
        }
#undef MC_IDX
    }
};
struct EpiOut {
    static constexpr bool PERM = true, AFTER_DRAIN = false, CHAIN = false;
    const float* x; bf16_t* hb; float* rss;
    __device__ __forceinline__ void operator()(EPI_ARGS) const {
        EPI_COORDS
        constexpr int D = 4;
        f32x4 xq[D][2];
#define XO_IDX(GI) ((size_t)(u.pm * 256 + ((GI) >> 3) * 128 + wr * 64 + (((GI) >> 1) & 3) * 16 + fr) * 1024 + u.pn * 256 + ((GI) & 1) * 128 + wc * 32 + fq * 8)
#pragma unroll
        for (int d = 0; d < D; ++d) { const size_t idx = XO_IDX(d); xq[d][0] = *(const f32x4*)(x + idx); xq[d][1] = *(const f32x4*)(x + idx + 4); }
        float ss = 0.f;
#pragma unroll
        for (int gi = 0; gi < 16; ++gi) {
            const int ai = gi >> 3, m = (gi >> 1) & 3, bj = gi & 1;
            const f32x4 x0 = xq[gi % D][0], x1 = xq[gi % D][1];
            if (gi + D < 16) { const size_t idn = XO_IDX(gi + D); xq[gi % D][0] = *(const f32x4*)(x + idn); xq[gi % D][1] = *(const f32x4*)(x + idn + 4); }
            const size_t idx = XO_IDX(gi);
            const f32x4 h0 = x0 + acc[ai][bj][m][0], h1 = x1 + acc[ai][bj][m][1];
            ss += h0[0] * h0[0] + h0[1] * h0[1] + h0[2] * h0[2] + h0[3] * h0[3] + h1[0] * h1[0] + h1[1] * h1[1] + h1[2] * h1[2] + h1[3] * h1[3];
            *(u32x4*)(hb + idx) = pack8(h0, h1);
            if (bj == 1) {
                ss += __shfl_xor(ss, 16); ss += __shfl_xor(ss, 32);
                if (fq == 0) rss[(size_t)(u.pm * 256 + ai * 128 + wr * 64 + m * 16 + fr) * 16 + u.pn * 4 + wc] = ss;
                ss = 0.f;
            }
            EPI_SB
        }
#undef XO_IDX
    }
};
typedef _Float16 f16x8 __attribute__((ext_vector_type(8)));
struct EpiScores {
    static constexpr bool PERM = true, AFTER_DRAIN = false, CHAIN = false;
    _Float16* o;
    __device__ __forceinline__ void operator()(EPI_ARGS) const {
        EPI_COORDS
        EPI_LOOP({ const size_t idx = (size_t)row * 2048 + u.pn * 256 + vc;
                   f16x8 hv = {(_Float16)a0[0], (_Float16)a0[1], (_Float16)a0[2], (_Float16)a0[3], (_Float16)a1[0], (_Float16)a1[1], (_Float16)a1[2], (_Float16)a1[3]};
                   *(f16x8*)(o + idx) = hv; })
    }
};

template <class Epi>
__device__ __forceinline__ void run_gemm_chain(LAS unsigned char* lds, const bf16_t* A, const bf16_t* Bt, const bf16_t* A2, const bf16_t* Bt2, int M, int N, int K, int G, const Epi& E) {
    pg8::Gemm g{A, Bt, M, N, K, A2, Bt2}; pg8::ChainOrder S; S.init(M, N, G, (int)blockIdx.x);
    pg8::gemm_phase<Epi, pg8::ChainOrder, true, true>(lds, g, S, E);
}
template <class Epi>
__device__ __forceinline__ void run_gemm(LAS unsigned char* lds, const bf16_t* A, const bf16_t* Bt, int M, int N, int K, int G, const Epi& E) {
    pg8::Gemm g{A, Bt, M, N, K}; pg8::StaticOrder S; S.init(M, N, G, (int)blockIdx.x);
    pg8::gemm_phase<Epi, pg8::StaticOrder, true, true>(lds, g, S, E);
}

__device__ __forceinline__ void ssm_item(const Params& p, float* us, bf16_t* yg, int item, int lane) {
    const float2* abar_t = WSP(float2, WS_SSMT);
    const float2* bbar_t = abar_t + SSM_G * SSM_P;
    const bf16_t* u = WSP(bf16_t, WS_U);
    const int b = item / SSM_G, g = item % SSM_G;
    const float2 ab = abar_t[g * SSM_P + lane];
    float br[16], bi[16], cr[16], ci[16];
#pragma unroll
    for (int c = 0; c < 16; ++c) {
        float2 t = bbar_t[(g * SSM_P + lane) * SSM_N + c];
        br[c] = t.x; bi[c] = t.y;
        cr[c] = p.c_re[((size_t)g * SSM_N + c) * SSM_P + lane];
        ci[c] = p.c_im[((size_t)g * SSM_N + c) * SSM_P + lane];
    }
    const int myc = ((lane >> 5) & 1) * 8 + ((lane >> 4) & 1) * 4 + ((lane >> 3) & 1) * 2 + ((lane >> 2) & 1);
    const float dsk = p.d_skip[g * SSM_N + myc];
    float xr = 0.f, xi = 0.f;
    for (int t0 = 0; t0 < SEQ; t0 += 64) {
        {
            const bf16_t* ur = u + (((size_t)(b * 32 + g)) * SEQ + t0 + lane) * 16;
            f32x4 f0, f1, f2, f3; unpack8(*(const u32x4*)ur, f0, f1); unpack8(*(const u32x4*)(ur + 8), f2, f3);
            float* d = us + lane * 16;
            *(f32x4*)d = f0; *(f32x4*)(d + 4) = f1; *(f32x4*)(d + 8) = f2; *(f32x4*)(d + 12) = f3;
        }
        __builtin_amdgcn_s_waitcnt(0);
        __builtin_amdgcn_wave_barrier();
        for (int tt = 0; tt < 64; ++tt) {
            float uu[16];
#pragma unroll
            for (int c4 = 0; c4 < 4; ++c4) {
                f32x4 t = *(const f32x4*)(us + tt * 16 + c4 * 4);
                uu[c4 * 4] = t[0]; uu[c4 * 4 + 1] = t[1]; uu[c4 * 4 + 2] = t[2]; uu[c4 * 4 + 3] = t[3];
            }
            float bur = 0.f, bui = 0.f;
#pragma unroll
            for (int c = 0; c < 16; ++c) { bur += br[c] * uu[c]; bui += bi[c] * uu[c]; }
            float nxr = ab.x * xr - ab.y * xi + bur;
            float nxi = ab.x * xi + ab.y * xr + bui;
            xr = nxr; xi = nxi;
            float z[16];
#pragma unroll
            for (int c = 0; c < 16; ++c) z[c] = cr[c] * xr - ci[c] * xi;
            float w8[8], w4[4], w2[2], w1;
            const bool h5 = lane & 32, h4 = lane & 16, h3 = lane & 8, h2 = lane & 4;
#pragma unroll
            for (int i = 0; i < 8; ++i) { float mine = h5 ? z[8 + i] : z[i], oth = h5 ? z[i] : z[8 + i]; w8[i] = mine + __shfl_xor(oth, 32); }
#pragma unroll
            for (int i = 0; i < 4; ++i) { float mine = h4 ? w8[4 + i] : w8[i], oth = h4 ? w8[i] : w8[4 + i]; w4[i] = mine + __shfl_xor(oth, 16); }
#pragma unroll
            for (int i = 0; i < 2; ++i) { float mine = h3 ? w4[2 + i] : w4[i], oth = h3 ? w4[i] : w4[2 + i]; w2[i] = mine + __shfl_xor(oth, 8); }
            { float mine = h2 ? w2[1] : w2[0], oth = h2 ? w2[0] : w2[1]; w1 = mine + __shfl_xor(oth, 4); }
            w1 += __shfl_xor(w1, 2);
            w1 += __shfl_xor(w1, 1);
            float um = 0.f;
#pragma unroll
            for (int c = 0; c < 16; ++c) um = (c == myc) ? uu[c] : um;
            float y = gelu_tanh(w1 + dsk * um);
            if ((lane & 3) == 0) yg[((size_t)(b * SEQ + t0 + tt)) * SSM_W + g * SSM_N + myc] = (bf16_t)f2bf(y);
        }
        __builtin_amdgcn_wave_barrier();
    }
}


__device__ __forceinline__ void ssm_fast_item(const Params& p, unsigned char* smem, unsigned yg_off, int item, int lane_in, int wave, int part = 0) {
    const unsigned char* W = p.ws;
    constexpr unsigned O_U = WS_U << 20, O_W1T = WS_W1T << 20, O_W3T = WS_W3T << 20;
    const int b = item >> 5, g = item & 31;
    int lane = lane_in; asm volatile("" : "+v"(lane));
    const int gq = lane >> 4, c = lane & 15, rg = wave & 3, hf = wave >> 2;
    bf16_t* Kl = (bf16_t*)(smem + 512); float* Sl = (float*)(smem + 512 + 32768); bf16_t* Xb = (bf16_t*)(smem + 512 + 65536);
    __syncthreads();
    {
        const u32x4* src = (const u32x4*)(WSP(bf16_t, WS_KT) + (size_t)g * 64 * 256); u32x4* dst = (u32x4*)(smem + 512);
        for (int i = wave * 64 + lane; i < 2048; i += NT) dst[i] = src[i];
        if (wave == 0 && lane < 32) ((u32x4*)smem)[lane] = (u32x4){0u, 0u, 0u, 0u};
    }
    bf16x8 A[32];
#pragma unroll
    for (int ks = 0; ks < 32; ++ks)
        A[ks] = ldws<bf16x8>(W, O_U + (((unsigned)(b * 32 + g) * SEQ + (16 * rg + c) * 64 + 2 * ks + (gq >> 1)) * 16u + 8 * (gq & 1)) * 2u);
    {
        unsigned char* Bt = smem + 82432;
        int tid_s = wave * 64 + lane;
        u32x4 bst[8];
#define W1_STAGE_LOAD(NT) { _Pragma("unroll") for (int i = 0; i < 8; ++i) { const int e = tid_s + i * NT_; const int hfp = e >> 11, r = (e >> 7) & 15, kp = e & 127; \
            bst[i] = ldws<u32x4>(W, O_W1T + ((unsigned)(g * 128 + (4 * hfp + (NT)) * 16 + r) * 1024u + kp * 8) * 2u); } }
        constexpr int NT_ = NT;
        W1_STAGE_LOAD(0)
#pragma unroll 1
        for (int nt = 0; nt < 4; ++nt) {
            __syncthreads();
#pragma unroll
            for (int i = 0; i < 8; ++i) { const int e = tid_s + i * NT_; const int hfp = e >> 11, r = (e >> 7) & 15, kp = e & 127; *(u32x4*)(Bt + hfp * 33024 + r * 2064 + kp * 16) = bst[i]; }
            if (nt < 3) { W1_STAGE_LOAD(nt + 1) }
            __syncthreads();
            f32x4 acc = {0.f, 0.f, 0.f, 0.f};
            const unsigned char* bl = Bt + hf * 33024 + c * 2064 + gq * 16;
#pragma unroll
            for (int q8 = 0; q8 < 4; ++q8) {
                bf16x8 kb[8];
#pragma unroll
                for (int j = 0; j < 8; ++j) kb[j] = *(const bf16x8*)(bl + (q8 * 8 + j) * 64);
                __builtin_amdgcn_sched_barrier(0);
#pragma unroll
                for (int j = 0; j < 8; ++j) acc = __builtin_amdgcn_mfma_f32_16x16x32_bf16(A[q8 * 8 + j], kb[j], acc, 0, 0, 0);
                __builtin_amdgcn_sched_barrier(0);
            }
#pragma unroll
            for (int r = 0; r < 4; ++r) Sl[(16 * rg + 4 * gq + r) * 128 + (4 * hf + nt) * 16 + c] = acc[r];
        }
#undef W1_STAGE_LOAD
    }
    __syncthreads();
    if (wave == 0) {
        const float2 a = WSP(float2, WS_A64)[g * SSM_P + lane];
        float xr = 0.f, xi = 0.f;
        for (int ch = 0; ch < 64; ++ch) {
            *(unsigned*)(Xb + ch * 128 + 2 * lane) = f2bf(xr) | (f2bf(xi) << 16);
            const float2 sv = *(const float2*)(Sl + ch * 128 + 2 * lane);
            const float nr = a.x * xr - a.y * xi + sv.x, ni = a.x * xi + a.y * xr + sv.y;
            xr = nr; xi = ni;
        }
    }
    __syncthreads();
#ifdef SSM_PART
    if (part == SSM_PART) return;
#endif
    bf16_t* yg = (bf16_t*)(p.ws + yg_off);
    const int gh = gq >> 1;
    const bf16_t* kl_lane = Kl + (gq & 1) * 128 + c * 8;
    unsigned char* Wt = smem + 82432;
    const int tid_s = wave * 64 + lane;
    u32x4 wst[4];
#define W3_STAGE_LOAD(CH) { _Pragma("unroll") for (int i = 0; i < 4; ++i) wst[i] = ldws<u32x4>(W, O_W3T + (unsigned)(g * 64 + 8 * (CH)) * 4096u + (unsigned)(tid_s + i * NT) * 16u); }
    W3_STAGE_LOAD(0)
#pragma unroll 1
    for (int ch = 0; ch < 8; ++ch) {
      __syncthreads();
#pragma unroll
      for (int i = 0; i < 4; ++i) { const int e = tid_s + i * NT; const int tl = e >> 8, r = (e >> 4) & 15, kp = e & 15; *(u32x4*)(Wt + (tl & 1) * 17408 + (tl >> 1) * 4352 + r * 272 + kp * 16) = wst[i]; }
      if (ch < 7) { W3_STAGE_LOAD(ch + 1) }
      __syncthreads();
      {
        const int B = ch;
        f32x4 acc[4];
        {
            bf16x8 Xa[4];
#pragma unroll
            for (int k2 = 0; k2 < 4; ++k2) Xa[k2] = *(const bf16x8*)(Xb + (16 * rg + c) * 128 + 32 * k2 + 8 * gq);
#pragma unroll
            for (int j = 0; j < 4; ++j) {
                acc[j] = (f32x4){0.f, 0.f, 0.f, 0.f};
                const unsigned char* wl = Wt + hf * 17408 + j * 4352 + c * 272 + gq * 16;
#pragma unroll
                for (int k2 = 0; k2 < 4; ++k2) acc[j] = __builtin_amdgcn_mfma_f32_16x16x32_bf16(Xa[k2], *(const bf16x8*)(wl + k2 * 64), acc[j], 0, 0, 0);
                __builtin_amdgcn_sched_barrier(0);
            }
        }
        const bf16_t* bB = kl_lane + (hf - gh) * 256 + (4 * B) * 512;
        bf16x8 W0 = *(const bf16x8*)(bB), W1 = *(const bf16x8*)(bB + 512), W2 = *(const bf16x8*)(bB + 1024), W3 = *(const bf16x8*)(bB + 1536);
#define SSM_KS(KS, NEW) { acc[0] = __builtin_amdgcn_mfma_f32_16x16x32_bf16(A[KS], W0, acc[0], 0, 0, 0); acc[1] = __builtin_amdgcn_mfma_f32_16x16x32_bf16(A[KS], W1, acc[1], 0, 0, 0); \
                          acc[2] = __builtin_amdgcn_mfma_f32_16x16x32_bf16(A[KS], W2, acc[2], 0, 0, 0); acc[3] = __builtin_amdgcn_mfma_f32_16x16x32_bf16(A[KS], W3, acc[3], 0, 0, 0); \
                          W3 = W2; W2 = W1; W1 = W0; W0 = NEW; }
#pragma unroll
        for (int G4 = 0; G4 < 8; ++G4) {
            if (G4 < B) {
                const bf16_t* gb = bB - (4 * G4 + 4) * 512;
                { const bf16x8 n0 = *(const bf16x8*)(gb + 1536); SSM_KS(4 * G4, n0) }
                { const bf16x8 n1 = *(const bf16x8*)(gb + 1024); SSM_KS(4 * G4 + 1, n1) }
                { const bf16x8 n2 = *(const bf16x8*)(gb + 512); SSM_KS(4 * G4 + 2, n2) }
                { const bf16x8 n3 = *(const bf16x8*)(gb); SSM_KS(4 * G4 + 3, n3) }
                __builtin_amdgcn_sched_barrier(0);
            } else if (G4 == B) {
                const bf16x8 z = {0, 0, 0, 0, 0, 0, 0, 0};
                SSM_KS(4 * G4, z) SSM_KS(4 * G4 + 1, z) SSM_KS(4 * G4 + 2, z) SSM_KS(4 * G4 + 3, z)
            }
        }
#undef SSM_KS
#pragma unroll
        for (int j = 0; j < 4; ++j) {
            const int tp = 2 * (4 * B + j) + hf;
#pragma unroll
            for (int r = 0; r < 4; ++r)
                yg[((size_t)(b * SEQ + (16 * rg + 4 * gq + r) * 64 + tp)) * SSM_W + g * SSM_N + c] = (bf16_t)f2bf(gelu_tanh(acc[j][r]));
        }
      }
    }
#undef W3_STAGE_LOAD
}

__device__ __forceinline__ unsigned fkey(float f) {
    unsigned u = __builtin_bit_cast(unsigned, f);
    return (u & 0x80000000u) ? ~u : (u | 0x80000000u);
}
__device__ __forceinline__ void phase_attn(const Params& p, unsigned char* smem, bf16_t* yatt, int vcu, int G) {
    float* sc = (float*)smem;
    float* qis = sc + 4096;
    float* wis = qis + 256;
    float* qs = wis + 16;
    float* pl = qs + 512;
    int* sel = (int*)(pl + 2048);
    unsigned* hist = (unsigned*)(sel + 256);
    int* scanA = (int*)(hist + 256);
    int* scanB = scanA + 512;
    int* misc = scanB + 512;
    int tid = threadIdx.x; asm volatile("" : "+v"(tid));
    const bf16_t* qi = WSP(bf16_t, WS_QI); const bf16_t* ki = WSP(bf16_t, WS_KI); const float* wi = WSP(float, WS_WI);
    const bf16_t* q = WSP(bf16_t, WS_Q); const bf16_t* kk = WSP(bf16_t, WS_K); const bf16_t* vv = WSP(bf16_t, WS_V);
    for (int row = vcu; row < MTOK; row += G) {
        const int b = row / SEQ, t = row % SEQ, nvalid = t + 1;
        __syncthreads();
        if (tid < 256) qis[tid] = bf2f(qi[(size_t)row * 256 + tid]);
        if (tid < 8) wis[tid] = wi[(size_t)row * 8 + tid];
        qs[tid] = bf2f(q[(size_t)row * 512 + tid]);
        __syncthreads();
        for (int s = tid; s < nvalid; s += NT) {
            const bf16_t* kr = ki + ((size_t)b * SEQ + s) * 32;
            float kv[32];
#pragma unroll
            for (int d8 = 0; d8 < 4; ++d8) {
                f32x4 a, bb; unpack8(*(const u32x4*)(kr + d8 * 8), a, bb);
                kv[d8 * 8] = a[0]; kv[d8 * 8 + 1] = a[1]; kv[d8 * 8 + 2] = a[2]; kv[d8 * 8 + 3] = a[3];
                kv[d8 * 8 + 4] = bb[0]; kv[d8 * 8 + 5] = bb[1]; kv[d8 * 8 + 6] = bb[2]; kv[d8 * 8 + 7] = bb[3];
            }
            float a = 0.f;
#pragma unroll
            for (int h = 0; h < 8; ++h) {
                float d = 0.f;
#pragma unroll
                for (int dd = 0; dd < 32; ++dd) d += qis[h * 32 + dd] * kv[dd];
                a += wis[h] * fmaxf(d, 0.f);
            }
#ifdef PROBE_ATTN
            sc[s] = (float)(_Float16)a;
#else
            sc[s] = a;
#endif
        }
        __syncthreads();
        int nsel;
        if (nvalid <= TOPK) {
            nsel = nvalid;
            if (tid < nvalid) sel[tid] = tid;
        } else {
            nsel = TOPK;
            unsigned prefix = 0, mask = 0; int need = TOPK;
            for (int pass = 0; pass < 4; ++pass) {
                const int shift = 24 - 8 * pass;
                if (tid < 256) hist[tid] = 0;
                __syncthreads();
                for (int s = tid; s < nvalid; s += NT) {
                    unsigned key = fkey(sc[s]);
                    if ((key & mask) == prefix) atomicAdd(&hist[(key >> shift) & 255], 1u);
                }
                __syncthreads();
                if (tid == 0) {
                    int cum = 0, bin = 255;
                    for (; bin > 0; --bin) { if (cum + (int)hist[bin] >= need) break; cum += hist[bin]; }
                    misc[0] = bin; misc[1] = need - cum;
                }
                __syncthreads();
                prefix |= (unsigned)misc[0] << shift; mask |= 0xFFu << shift; need = misc[1];
                __syncthreads();
            }
            const int base = tid * 8;
            int cg = 0, ce = 0;
            for (int i = 0; i < 8; ++i) { int s = base + i; if (s < nvalid) { unsigned key = fkey(sc[s]); cg += key > prefix; ce += key == prefix; } }
            scanA[tid] = ce;
            __syncthreads();
            if (tid == 0) { int run = 0; for (int i = 0; i < NT; ++i) { int v = scanA[i]; scanA[i] = run; run += v; } }
            __syncthreads();
            const int preE = scanA[tid];
            int takeE = need - preE; takeE = takeE < 0 ? 0 : (takeE > ce ? ce : takeE);
            scanB[tid] = cg + takeE;
            __syncthreads();
            if (tid == 0) { int run = 0; for (int i = 0; i < NT; ++i) { int v = scanB[i]; scanB[i] = run; run += v; } }
            __syncthreads();
            int off = scanB[tid], te = 0;
            for (int i = 0; i < 8; ++i) {
                int s = base + i;
                if (s < nvalid) {
                    unsigned key = fkey(sc[s]);
                    bool take = key > prefix;
                    if (key == prefix) { take = te < takeE; ++te; }
                    if (take) { if (off < TOPK) sel[off] = s; ++off; }
                }
            }
        }
        __syncthreads();
        {
            const int j = tid & 255, n = tid >> 8;
            if (j < nsel) {
                const unsigned char* kr = (const unsigned char*)kk + ((size_t)b * SEQ + sel[j]) * 128 + n * 64;
                float kf[64];
#pragma unroll
                for (int d8 = 0; d8 < 8; ++d8) {
                    f32x4 a, bb; unpack8_fp8(*(const uint2*)(kr + d8 * 8), a, bb); a *= (1.f / 16.f); bb *= (1.f / 16.f);
                    kf[d8 * 8] = a[0]; kf[d8 * 8 + 1] = a[1]; kf[d8 * 8 + 2] = a[2]; kf[d8 * 8 + 3] = a[3];
                    kf[d8 * 8 + 4] = bb[0]; kf[d8 * 8 + 5] = bb[1]; kf[d8 * 8 + 6] = bb[2]; kf[d8 * 8 + 7] = bb[3];
                }
#pragma unroll
                for (int hh = 0; hh < 4; ++hh) {
                    const int h = n * 4 + hh;
                    float d = 0.f;
#pragma unroll
                    for (int dd = 0; dd < 64; ++dd) d += qs[h * 64 + dd] * kf[dd];
                    pl[h * 256 + j] = d * 0.125f;
                }
            } else {
#pragma unroll
                for (int hh = 0; hh < 4; ++hh) pl[(n * 4 + hh) * 256 + j] = -1e30f;
            }
        }
        __syncthreads();
        {
            const int h = tid >> 6, l = tid & 63;
            float vals[4]; float mx = -3e38f;
#pragma unroll
            for (int i = 0; i < 4; ++i) { vals[i] = pl[h * 256 + l + 64 * i]; mx = fmaxf(mx, vals[i]); }
#pragma unroll
            for (int o = 32; o >= 1; o >>= 1) mx = fmaxf(mx, __shfl_xor(mx, o));
            float sm = 0.f;
#pragma unroll
            for (int i = 0; i < 4; ++i) { vals[i] = __expf(vals[i] - mx); sm += vals[i]; }
            sm = wave_sum(sm);
            float inv = 1.f / sm;
#pragma unroll
            for (int i = 0; i < 4; ++i) pl[h * 256 + l + 64 * i] = vals[i] * inv;
        }
        __syncthreads();
        {
            const int h = tid >> 6, d = tid & 63, n = h >> 2;
            float a = 0.f;
            for (int j = 0; j < nsel; ++j) {
                const unsigned wv = *(const unsigned*)((const unsigned char*)vv + ((size_t)b * SEQ + sel[j]) * 128 + n * 64 + (d & ~3));
                const f32x2_t pv0 = __builtin_amdgcn_cvt_pk_f32_fp8((int)wv, false), pv1 = __builtin_amdgcn_cvt_pk_f32_fp8((int)wv, true);
                const float vsel = (d & 2) ? ((d & 1) ? pv1[1] : pv1[0]) : ((d & 1) ? pv0[1] : pv0[0]);
                const int pq = __builtin_amdgcn_cvt_pk_fp8_f32(pl[h * 256 + j] * 256.f, 0.f, 0, false);
                const f32x2_t pd = __builtin_amdgcn_cvt_pk_f32_fp8(pq, false);
                a += pd[0] * vsel * (1.f / 4096.f);
            }
            yatt[(size_t)row * 512 + tid] = (bf16_t)f2bf(a);
        }
    }
}


typedef short v4i16_t __attribute__((ext_vector_type(4)));
constexpr int DSA_KSTR = 8200, DSA_SEL_OFF = 16 * DSA_KSTR, DSA_NSEL_OFF = DSA_SEL_OFF + 8192, DSA_HIST_OFF = DSA_NSEL_OFF + 256, DSA_VST = 5120;
__device__ __forceinline__ int mbcnt64(unsigned long long m) { return __builtin_amdgcn_mbcnt_hi((unsigned)(m >> 32), __builtin_amdgcn_mbcnt_lo((unsigned)m, 0u)); }

__device__ __forceinline__ void dsa_item(const Params& p, unsigned char* smem, unsigned yatt_off, int b, int tt, int lane_in, int wave) {
    const unsigned char* W = p.ws;
    constexpr unsigned O_QI = WS_QI << 20, O_KI = WS_KI << 20, O_WI = WS_WI << 20, O_Q = WS_Q << 20, O_K = WS_K << 20, O_V = WS_V << 20;
    const int t0 = tt * 16;
    __syncthreads();
#ifndef DSA_RA
#define DSA_RA 1
#endif
#ifndef DSA_RB
#define DSA_RB 1
#endif
#ifndef DSA_RC
#define DSA_RC 1
#endif
    _Pragma("unroll 1") for (int ra_ = 0; ra_ < DSA_RA; ++ra_) {
        int lane = lane_in; asm volatile("" : "+v"(lane));
        const int g = lane >> 4, c = lane & 15;
        const unsigned qrow = (unsigned)(b * SEQ + t0 + c);
        bf16x8 qf[8]; float wv[8];
#pragma unroll
        for (int h = 0; h < 8; ++h) { qf[h] = ldws<bf16x8>(W, O_QI + qrow * 512u + h * 64 + 16 * g); wv[h] = ldws<float>(W, O_WI + qrow * 32u + h * 4); }
#define KI_LOAD(KT) ldws<bf16x8>(W, O_KI + (unsigned)(b * SEQ + ((KT) <= tt ? (KT) : tt) * 16 + c) * 64u + 16 * g)
        bf16x8 kq0 = KI_LOAD(wave), kq1 = KI_LOAD(wave + NWAVES), kq2 = KI_LOAD(wave + 2 * NWAVES), kq3 = KI_LOAD(wave + 3 * NWAVES);
#define DSA_TILE(KQ, KT)                                                                                                           \
        if ((KT) <= tt) {                                                                                                          \
            const bf16x8 kf = KQ; KQ = KI_LOAD((KT) + 4 * NWAVES);                                                                 \
            f32x4 s = {0.f, 0.f, 0.f, 0.f};                                                                                        \
            _Pragma("unroll") for (int h = 0; h < 8; ++h) {                                                                        \
                const f32x4 d = __builtin_amdgcn_mfma_f32_16x16x32_bf16(kf, qf[h], (f32x4){0.f, 0.f, 0.f, 0.f}, 0, 0, 0);           \
                                          \
                _Pragma("unroll") for (int r = 0; r < 4; ++r) { const float dv = d[r]; const int ri = __float_as_int(dv); s[r] += wv[h] * __int_as_float(ri > 0 ? ri : 0); } \
            }                                                                                                                      \
            const bool diag = ((KT) == tt);                                                                                        \
            unsigned kw[4];                                                                                                        \
            _Pragma("unroll") for (int r = 0; r < 4; ++r) {                                                                        \
                const _Float16 hv = (_Float16)s[r];                                                                                \
                const unsigned hb = (unsigned)__builtin_bit_cast(unsigned short, hv);                                              \
                const unsigned key = (hb & 0x8000u) ? (~hb & 0xffffu) : (hb | 0x8000u);                                             \
                const bool valid = !(diag && 4 * g + r > c);                                                                       \
                kw[r] = valid ? key : 0u;                                                                                          \
                if (valid && ra_ == 0) atomicAdd((unsigned*)(smem + DSA_HIST_OFF) + c * 256 + (key >> 8), 1u);                      \
            }                                                                                                                      \
            *(uint2*)(smem + c * DSA_KSTR + ((KT) * 16 + 4 * g) * 2) = make_uint2(kw[0] | (kw[1] << 16), kw[2] | (kw[3] << 16));    \
        }
#pragma unroll 1
        for (int kt = wave; kt <= tt; kt += 4 * NWAVES) {
            DSA_TILE(kq0, kt) DSA_TILE(kq1, kt + NWAVES) DSA_TILE(kq2, kt + 2 * NWAVES) DSA_TILE(kq3, kt + 3 * NWAVES)
        }
#undef DSA_TILE
#undef KI_LOAD
    }
    __syncthreads();
    unsigned short* selall = (unsigned short*)(smem + DSA_SEL_OFF);
    int* nselarr = (int*)(smem + DSA_NSEL_OFF);
#pragma unroll 1
    for (int rr = 0; rr < 2 * DSA_RB; ++rr) {
        int lane = lane_in; asm volatile("" : "+v"(lane));
        const int tl = wave * 2 + (rr & 1), nvalid = t0 + tl + 1;
        unsigned short* selrow = selall + tl * 256;
        if (nvalid <= TOPK) {
            for (int j = lane; j < TOPK; j += 64) selrow[j] = (unsigned short)(j < nvalid ? j : 0);
            if (lane == 0) nselarr[tl] = nvalid;
        } else {
            unsigned kk[64];
#pragma unroll
            for (int i = 0; i < 16; ++i) {
                if ((i + 1) * 256 <= nvalid) {
                    const uint2 w = *(const uint2*)(smem + tl * DSA_KSTR + (i * 64 + lane) * 8);
                    kk[4 * i + 0] = w.x & 0xffffu; kk[4 * i + 1] = w.x >> 16; kk[4 * i + 2] = w.y & 0xffffu; kk[4 * i + 3] = w.y >> 16;
                } else if (i * 256 < nvalid) {
                    const uint2 w = *(const uint2*)(smem + tl * DSA_KSTR + (i * 64 + lane) * 8);
                    const int s0 = (i * 64 + lane) * 4;
                    kk[4 * i + 0] = s0 + 0 < nvalid ? (w.x & 0xffffu) : 0u; kk[4 * i + 1] = s0 + 1 < nvalid ? (w.x >> 16) : 0u;
                    kk[4 * i + 2] = s0 + 2 < nvalid ? (w.y & 0xffffu) : 0u; kk[4 * i + 3] = s0 + 3 < nvalid ? (w.y >> 16) : 0u;
                } else { kk[4 * i + 0] = 0u; kk[4 * i + 1] = 0u; kk[4 * i + 2] = 0u; kk[4 * i + 3] = 0u; }
            }
            unsigned* hist = (unsigned*)(smem + DSA_HIST_OFF) + tl * 256;
            const int ni = (nvalid + 255) >> 8;
            unsigned Bsel = 0u; int cabove = 0, nties = 0;
#pragma unroll 1
            for (int pass = 0; pass < 2; ++pass) {
                if (pass == 1) {
#pragma unroll
                    for (int i = 0; i < 16; ++i) {
                        if (i < ni) {
#pragma unroll
                            for (int e = 0; e < 4; ++e) { const unsigned k = kk[4 * i + e]; if ((k >> 8) == Bsel) atomicAdd(&hist[k & 255u], 1u); }
                        }
                    }
                    __builtin_amdgcn_s_waitcnt(0xC07F);
                    __builtin_amdgcn_wave_barrier();
                }
                const uint4 hv = *(const uint4*)(hist + 4 * lane);
                const int ls = (int)(hv.x + hv.y + hv.z + hv.w);
                const int pre_ = wave_incl_scan(ls);
                const int suf = __builtin_amdgcn_readlane(pre_, 63) - pre_ + ls;
                const int needp = TOPK - cabove;
                const int above = suf - ls;
                const bool mine = (above < needp) && (suf >= needp);
                int bsel_l = 0, ca_l = 0, hsel_l = 0;
                {
                    int cacc = above;
                    const int h3 = (int)hv.w, h2 = (int)hv.z, h1 = (int)hv.y, h0 = (int)hv.x;
                    if (cacc + h3 >= needp) { bsel_l = 3; ca_l = cacc; hsel_l = h3; }
                    else { cacc += h3; if (cacc + h2 >= needp) { bsel_l = 2; ca_l = cacc; hsel_l = h2; }
                        else { cacc += h2; if (cacc + h1 >= needp) { bsel_l = 1; ca_l = cacc; hsel_l = h1; } else { cacc += h1; bsel_l = 0; ca_l = cacc; hsel_l = h0; } } }
                }
                const unsigned long long mm = __ballot(mine);
                const int src = mm ? (int)__builtin_ctzll(mm) : 0;
                const int bb = __shfl(4 * lane + bsel_l, src), ca = __shfl(ca_l, src);
                nties = __shfl(hsel_l, src);
                if (pass == 0) {
                    Bsel = (unsigned)bb; cabove = ca;
                    __builtin_amdgcn_wave_barrier();
                    hist[lane] = 0u; hist[lane + 64] = 0u; hist[lane + 128] = 0u; hist[lane + 192] = 0u;
                    __builtin_amdgcn_s_waitcnt(0xC07F);
                    __builtin_amdgcn_wave_barrier();
                } else { Bsel = (Bsel << 8) | (unsigned)bb; cabove += ca; }
            }
            const unsigned T = Bsel;
            const int need = TOPK - cabove;
            if (nties == need) {
                unsigned tk0 = 0u, tk1 = 0u;
#pragma unroll
                for (int i = 0; i < 16; ++i) if (i < ni) {
#pragma unroll
                    for (int e = 0; e < 4; ++e) { const int j = 4 * i + e; const unsigned bit = (kk[j] >= T) ? (1u << (j & 31)) : 0u; if (j < 32) tk0 |= bit; else tk1 |= bit; }
                }
                const int cntl = __builtin_popcount(tk0) + __builtin_popcount(tk1);
                const int pre = wave_incl_scan(cntl);
                int pos = pre - cntl;
                while (tk0) { const int j = __builtin_ctz(tk0); tk0 &= tk0 - 1u; if (pos < TOPK) selrow[pos] = (unsigned short)((j >> 2) * 256 + lane * 4 + (j & 3)); ++pos; }
                while (tk1) { const int j = __builtin_ctz(tk1) + 32; tk1 &= tk1 - 1u; if (pos < TOPK) selrow[pos] = (unsigned short)((j >> 2) * 256 + lane * 4 + (j & 3)); ++pos; }
            } else {
                int tiebase = 0, sbase = 0;
#pragma unroll
                for (int i = 0; i < 16; ++i) {
                    int below = 0, tot = 0;
#pragma unroll
                    for (int e = 0; e < 4; ++e) { const unsigned long long m = __ballot(kk[4 * i + e] == T); below += mbcnt64(m); tot += __builtin_popcountll(m); }
                    int own = 0; bool take[4];
#pragma unroll
                    for (int e = 0; e < 4; ++e) { const bool tie = kk[4 * i + e] == T; take[e] = (kk[4 * i + e] > T) || (tie && (tiebase + below + own < need)); own += tie ? 1 : 0; }
                    tiebase += tot;
                    int belowS = 0, totS = 0;
#pragma unroll
                    for (int e = 0; e < 4; ++e) { const unsigned long long m = __ballot(take[e]); belowS += mbcnt64(m); totS += __builtin_popcountll(m); }
                    int ownS = 0;
#pragma unroll
                    for (int e = 0; e < 4; ++e) { if (take[e]) { const int pos = sbase + belowS + ownS; if (pos < TOPK) selrow[pos] = (unsigned short)((i * 64 + lane) * 4 + e); } ownS += take[e] ? 1 : 0; }
                    sbase += totS;
                }
            }
            if (lane == 0) nselarr[tl] = TOPK;
        }
        {
            unsigned* hz = (unsigned*)(smem + DSA_HIST_OFF) + tl * 256;
            hz[lane] = 0u; hz[lane + 64] = 0u; hz[lane + 128] = 0u; hz[lane + 192] = 0u;
        }
    }
    __builtin_amdgcn_s_waitcnt(0xC07F); __builtin_amdgcn_wave_barrier();
#pragma unroll 1
    for (int rn_ = 0; rn_ < 4 * DSA_RC; ++rn_) {
        const int rn = rn_ & 3;
        int lane = lane_in; asm volatile("" : "+v"(lane));
        const int g = lane >> 4, c = lane & 15;
        const int rr = rn >> 1, n = rn & 1;
        unsigned char* vst = smem + (2 * wave) * DSA_KSTR;
        const int tl = wave * 2 + rr;
        const unsigned rowg = (unsigned)(b * SEQ + t0 + tl);
        const int nselg = nselarr[tl] - 4 * g;
        const unsigned short* selrow = selall + tl * 256;
        const unsigned kvb = O_K + (unsigned)(b * SEQ) * 128u + n * 64 + 16 * g;
        const unsigned vvb = O_V + (unsigned)(b * SEQ) * 128u + n * 64 + (lane & 3) * 16;
        long qha = 0, qhb = 0, qla = 0, qlb = 0;
        if (c < 4) {
            const unsigned qo = O_Q + rowg * 1024u + (n * 4 + c) * 128 + 32 * g;
            f32x4 q0, q1, q2, q3; unpack8(ldws<u32x4>(W, qo), q0, q1); unpack8(ldws<u32x4>(W, qo + 16), q2, q3);
            q0 *= 16.f; q1 *= 16.f; q2 *= 16.f; q3 *= 16.f;
            const uint2 ha = pack8_fp8(q0, q1), hb = pack8_fp8(q2, q3);
            f32x4 d0, d1, d2, d3; unpack8_fp8(ha, d0, d1); unpack8_fp8(hb, d2, d3);
            const uint2 la = pack8_fp8(q0 - d0, q1 - d1), lb = pack8_fp8(q2 - d2, q3 - d3);
            qha = (long)(((unsigned long long)ha.y << 32) | ha.x); qhb = (long)(((unsigned long long)hb.y << 32) | hb.x);
            qla = (long)(((unsigned long long)la.y << 32) | la.x); qlb = (long)(((unsigned long long)lb.y << 32) | lb.x);
        }
        f32x4 S[16];
#pragma unroll
        for (int tile = 0; tile < 16; ++tile) {
            const unsigned key = selrow[tile * 16 + c];
            const u32x4 kw = ldws<u32x4>(W, kvb + key * 128u);
            const long ka = (long)(((unsigned long long)kw.y << 32) | kw.x), kb = (long)(((unsigned long long)kw.w << 32) | kw.z);
            f32x4 acc = __builtin_amdgcn_mfma_f32_16x16x32_fp8_fp8(ka, qha, (f32x4){0.f, 0.f, 0.f, 0.f}, 0, 0, 0);
            acc = __builtin_amdgcn_mfma_f32_16x16x32_fp8_fp8(kb, qhb, acc, 0, 0, 0);
            acc = __builtin_amdgcn_mfma_f32_16x16x32_fp8_fp8(ka, qla, acc, 0, 0, 0);
            S[tile] = __builtin_amdgcn_mfma_f32_16x16x32_fp8_fp8(kb, qlb, acc, 0, 0, 0);
        }
        u32x4 vra[8];
#pragma unroll
        for (int i = 0; i < 8; ++i) { const unsigned key = selrow[i * 16 + (lane >> 2)]; vra[i] = ldws<u32x4>(W, vvb + key * 128u); }
        float Pk[4][4];
        {
            const int nselc = nselarr[tl] - 4 * g - 16 * (c >> 2);
            float mx = -3e38f;
#pragma unroll
            for (int q4 = 0; q4 < 4; ++q4)
#pragma unroll
                for (int r = 0; r < 4; ++r) {
                    float v = S[4 * q4][r];
                    v = dppf<0x114, 0xf, 0x2, false>(v, S[4 * q4 + 1][r]);
                    v = dppf<0x118, 0xf, 0x4, false>(v, S[4 * q4 + 2][r]);
                    v = dppf<0x11C, 0xf, 0x8, false>(v, S[4 * q4 + 3][r]);
                    v = (64 * q4 + r) < nselc ? v : -1e30f;
                    Pk[q4][r] = v; mx = fmaxf(mx, v);
                }
            mx = fmaxf(mx, dppf<0x124, 0xf, 0xf, false>(mx, mx)); mx = fmaxf(mx, dppf<0x128, 0xf, 0xf, false>(mx, mx));
            mx = fmaxf(mx, __shfl_xor(mx, 16)); mx = fmaxf(mx, __shfl_xor(mx, 32));
            float sum = 0.f;
#pragma unroll
            for (int q4 = 0; q4 < 4; ++q4)
#pragma unroll
                for (int r = 0; r < 4; ++r) { const float e = __expf((Pk[q4][r] - mx) * (0.125f / 256.f)); Pk[q4][r] = e; sum += e; }
            sum += dppf<0x124, 0xf, 0xf, false>(sum, sum); sum += dppf<0x128, 0xf, 0xf, false>(sum, sum);
            sum += __shfl_xor(sum, 16); sum += __shfl_xor(sum, 32);
            const float invs = 256.f * __builtin_amdgcn_rcpf(sum);
#pragma unroll
            for (int q4 = 0; q4 < 4; ++q4)
#pragma unroll
                for (int r = 0; r < 4; ++r) Pk[q4][r] *= invs;
#pragma unroll
            for (int q4 = 0; q4 < 4; ++q4)
#pragma unroll
                for (int r = 0; r < 4; ++r) {
                    const float pv = Pk[q4][r];
                    S[4 * q4][r] = pv;
                    S[4 * q4 + 1][r] = dppf<0x104, 0xf, 0xf, false>(pv, pv);
                    S[4 * q4 + 2][r] = dppf<0x108, 0xf, 0xf, false>(pv, pv);
                    S[4 * q4 + 3][r] = dppf<0x10C, 0xf, 0xf, false>(pv, pv);
                }
        }
        f32x4 O[4];
#pragma unroll
        for (int dt = 0; dt < 4; ++dt) O[dt] = (f32x4){0.f, 0.f, 0.f, 0.f};
        const LAS unsigned char* vp = (const LAS unsigned char*)(vst + (16 * (g >> 1) + 8 * (g & 1) + 4 * ((c >> 1) >> 2) + ((c >> 1) & 3)) * 80 + (c & 1) * 8);
        typedef int v2i32_t __attribute__((ext_vector_type(2)));
#pragma unroll
        for (int hv = 0; hv < 2; ++hv) {
            u32x4 vr[8];
            if (hv == 0) {
#pragma unroll
                for (int i = 0; i < 8; ++i) vr[i] = vra[i];
            } else {
#pragma unroll
                for (int i = 0; i < 8; ++i) { const unsigned key = selrow[128 + i * 16 + (lane >> 2)]; vr[i] = ldws<u32x4>(W, vvb + key * 128u); }
            }
#pragma unroll
            for (int k4 = 0; k4 < 4; ++k4) {
                const int ks2 = hv * 4 + k4;
                __builtin_amdgcn_wave_barrier();
#pragma unroll
                for (int i2 = 0; i2 < 2; ++i2) {
                    const int slot = 16 * (lane >> 5) + 8 * ((lane >> 4) & 1) + 4 * i2 + ((lane >> 2) & 3);
                    *(u32x4*)(vst + slot * 80 + (lane & 3) * 16) = vr[k4 * 2 + i2];
                }
                __builtin_amdgcn_s_waitcnt(0xC07F);
                __builtin_amdgcn_wave_barrier();
                const uint2 pw = pack8_fp8(S[2 * ks2], S[2 * ks2 + 1]);
                const long pa = (long)(((unsigned long long)pw.y << 32) | pw.x);
#pragma unroll
                for (int dt = 0; dt < 4; ++dt) {
                    const v2i32_t l0 = __builtin_amdgcn_ds_read_tr8_b64_v2i32((LAS v2i32_t*)(vp + dt * 16));
                    const long vb = (long)(((unsigned long long)(unsigned)l0[1] << 32) | (unsigned)l0[0]);
                    O[dt] = __builtin_amdgcn_mfma_f32_16x16x32_fp8_fp8(pa, vb, O[dt], 0, 0, 0);
                }
            }
        }
        if (g == 0) {
            bf16_t* yo = (bf16_t*)(p.ws + yatt_off) + (size_t)rowg * 512 + n * 256 + c;
#pragma unroll
            for (int dt = 0; dt < 4; ++dt)
#pragma unroll
                for (int r = 0; r < 4; ++r) yo[r * 64 + dt * 16] = (bf16_t)f2bf(O[dt][r] * (1.f / 4096.f));
        }
    }
}

__device__ __forceinline__ void phase_dsa(const Params& p, unsigned char* smem, unsigned yatt_off, int vcu, int G) {
    int tid = threadIdx.x; asm volatile("" : "+v"(tid));
    const int lane = tid & 63, wave = __builtin_amdgcn_readfirstlane(tid >> 6);
    { unsigned* hz = (unsigned*)(smem + DSA_HIST_OFF); for (int i = tid; i < 16 * 256; i += NT) hz[i] = 0u; }
    const bool bal = (G == 256);
    const int nit = bal ? 8 : (NB * 256 - vcu + G - 1) / G;
#pragma unroll 1
    for (int it = 0; it < nit; ++it) {
        int b, tt;
        if (bal) { const int j = vcu & 31; b = vcu >> 5; tt = (it >> 1) * 64 + ((it & 1) ? 63 - j : j); }
        else { const int item = vcu + it * G; b = item >> 8; tt = item & 255; }
        dsa_item(p, smem, yatt_off, b, tt, lane, wave);
#if PEER_FP8
        {
            if (bal) {
                const int slots = G * NWAVES * 8, per = (2 * 16384 + slots - 1) / slots;
                const int s0 = ((vcu * NWAVES + wave) * 8 + it) * per;
                if (per == 2 && s0 + 1 < 2 * 16384) {
                    f32x4 ra[4], rb[4]; peer_row_load(p, s0, lane, ra); peer_row_load(p, s0 + 1, lane, rb);
                    peer_row_conv(p, s0, lane, smem + DSA_HIST_OFF + 16384 + wave * 768, ra); peer_row_conv(p, s0 + 1, lane, smem + DSA_HIST_OFF + 16384 + wave * 768, rb);
                } else
                for (int r = s0; r < s0 + per && r < 2 * 16384; ++r) peer_table_row(p, r, lane, smem + DSA_HIST_OFF + 16384 + wave * 768);
            }
        }
#endif
    }
#if PEER_FP8
    if (!bal) for (int r = vcu * NWAVES + wave; r < 2 * 16384; r += G * NWAVES) peer_table_row(p, r, lane, smem + DSA_HIST_OFF + 16384 + wave * 768);
#endif
}

template <bool DRY>
__device__ __forceinline__ void phase_peer(const Params& p, unsigned char* smem, int vcu, int G) {
    int tid_ = threadIdx.x; asm volatile("" : "+v"(tid_)); const int wave = tid_ >> 6, lane = tid_ & 63;
    float* wsm = (float*)smem + wave * 1024;
    float* sc = wsm;
    float* v1s = wsm + 256; int* i1s = (int*)(wsm + 272); float* v2s = wsm + 288; int* i2s = (int*)(wsm + 304);
    float* tops = wsm + 320;
    int* tope = (int*)(wsm + 336);
    int* eid = (int*)(wsm + 384);
    float* egate = wsm + 512;
    const float* scores = WSP(float, WS_SCORES);
    const bf16_t* hg = WSP(bf16_t, WS_HG);
    const float* rss = WSP(float, WS_RSS);
    const bf16_t* ut = WSP(bf16_t, WS_UTAB); const bf16_t* vt = WSP(bf16_t, WS_VTAB);
    const int nwaves = G * NWAVES;
    int ca = 0, cb = 0;
    {
        int rem = lane; bool found = false;
#pragma unroll
        for (int a = 0; a < 16; ++a) { int cnt = 16 / (a + 1); if (!found) { if (rem < cnt) { ca = a; cb = rem; found = true; } else rem -= cnt; } }
    }
    for (int row = vcu * NWAVES + wave; row < MTOK; row += nwaves) {
        float rs;
        {
            float t = lane < 16 ? rss[(size_t)row * 16 + lane] : 0.f;
            t = wave_sum(t);
            rs = rsqrtf(t * (1.f / DM) + NORM_EPS);
        }
        for (int h = 0; h < PEER_H; ++h) {
            const float* sp = scores + (size_t)row * 2048 + h * 256;
            float a0 = sp[lane], a1 = sp[lane + 64], b0 = sp[128 + lane], b1 = sp[192 + lane];
            __builtin_amdgcn_wave_barrier();
            sc[lane] = a0; sc[lane + 64] = a1; sc[128 + lane] = b0; sc[192 + lane] = b1;
            __builtin_amdgcn_s_waitcnt(0);
            __builtin_amdgcn_wave_barrier();
            int ra0 = 0, ra1 = 0, rb0 = 0, rb1 = 0;
            for (int j = 0; j < 64; ++j) {
                float x = sc[j], y = sc[j + 64], z = sc[128 + j], w = sc[192 + j];
                ra0 += (x > a0) || (x == a0 && j < lane); ra0 += (y > a0);
                ra1 += (x >= a1); ra1 += (y > a1) || (y == a1 && j < lane);
                rb0 += (z > b0) || (z == b0 && j < lane); rb0 += (w > b0);
                rb1 += (z >= b1); rb1 += (w > b1) || (w == b1 && j < lane);
            }
            if (ra0 < 16) { v1s[ra0] = a0; i1s[ra0] = lane; }
            if (ra1 < 16) { v1s[ra1] = a1; i1s[ra1] = lane + 64; }
            if (rb0 < 16) { v2s[rb0] = b0; i2s[rb0] = lane; }
            if (rb1 < 16) { v2s[rb1] = b1; i2s[rb1] = lane + 64; }
            __builtin_amdgcn_s_waitcnt(0);
            __builtin_amdgcn_wave_barrier();
            float cv = -3e38f; int cpos = 1 << 20;
            if (lane < 50) { cv = v1s[ca] + v2s[cb]; cpos = ca * 16 + cb; }
            int rk = 0;
            for (int j = 0; j < 50; ++j) {
                float x = __shfl(cv, j); int px = __shfl(cpos, j);
                rk += (x > cv) || (x == cv && px < cpos);
            }
            if (lane < 50 && rk < 16) { tops[rk] = cv; tope[rk] = i1s[ca] * PEER_KEYS + i2s[cb]; }
            __builtin_amdgcn_s_waitcnt(0);
            __builtin_amdgcn_wave_barrier();
            if (lane < 16) {
                float s = tops[lane] * rs;
                float mx = s;
#pragma unroll
                for (int o = 8; o >= 1; o >>= 1) mx = fmaxf(mx, __shfl_xor(mx, o, 16));
                float e = __expf(s - mx), sm = e;
#pragma unroll
                for (int o = 8; o >= 1; o >>= 1) sm += __shfl_xor(sm, o, 16);
                eid[h * 16 + lane] = tope[lane];
                egate[h * 16 + lane] = e / sm;
            }
            __builtin_amdgcn_s_waitcnt(0);
            __builtin_amdgcn_wave_barrier();
        }
        f32x4 xv[4], acc[4];
        {
            const bf16_t* hr = hg + (size_t)row * DM;
            unpack8(*(const u32x4*)(hr + lane * 8), xv[0], xv[1]);
            unpack8(*(const u32x4*)(hr + 512 + lane * 8), xv[2], xv[3]);
#pragma unroll
            for (int i = 0; i < 4; ++i) { xv[i] = xv[i] * rs; acc[i] = (f32x4){0.f, 0.f, 0.f, 0.f}; }
        }
        for (int e0 = 0; e0 < 128; e0 += 4) {
            u32x4 uw[4][2], vw[4][2];
#pragma unroll
            for (int e = 0; e < 4; ++e) {
                const bf16_t* ur = ut + (size_t)eid[e0 + e] * DM;
                uw[e][0] = *(const u32x4*)(ur + lane * 8); uw[e][1] = *(const u32x4*)(ur + 512 + lane * 8);
            }
#pragma unroll
            for (int e = 0; e < 4; ++e) {
                const bf16_t* vr = vt + (size_t)eid[e0 + e] * DM;
                vw[e][0] = *(const u32x4*)(vr + lane * 8); vw[e][1] = *(const u32x4*)(vr + 512 + lane * 8);
            }
            float act[4];
#pragma unroll
            for (int e = 0; e < 4; ++e) {
                f32x4 u0, u1, u2, u3; unpack8(uw[e][0], u0, u1); unpack8(uw[e][1], u2, u3);
                f32x4 s4 = xv[0] * u0 + xv[1] * u1 + xv[2] * u2 + xv[3] * u3;
                float d = wave_sum((s4[0] + s4[1]) + (s4[2] + s4[3]));
                act[e] = gelu_tanh(d) * egate[e0 + e];
            }
#pragma unroll
            for (int e = 0; e < 4; ++e) {
                f32x4 v0, v1, v2, v3; unpack8(vw[e][0], v0, v1); unpack8(vw[e][1], v2, v3);
                acc[0] += v0 * act[e]; acc[1] += v1 * act[e]; acc[2] += v2 * act[e]; acc[3] += v3 * act[e];
            }
        }
        float* hr = p.out + (size_t)row * DM;
        float ss = 0.f;
        if (DRY) { const float chk = acc[0][0] + acc[1][1] + acc[2][2] + acc[3][3]; if (chk == 1.2345678f) hr[lane] = chk; continue; }
#pragma unroll
        for (int c = 0; c < 2; ++c) {
            acc[2 * c] += *(const f32x4*)(hr + c * 512 + lane * 8); acc[2 * c + 1] += *(const f32x4*)(hr + c * 512 + lane * 8 + 4);
        }
#pragma unroll
        for (int i = 0; i < 4; ++i) ss += acc[i][0] * acc[i][0] + acc[i][1] * acc[i][1] + acc[i][2] * acc[i][2] + acc[i][3] * acc[i][3];
        ss = wave_sum(ss);
        float scl = rsqrtf(ss * (1.f / DM) + NORM_EPS);
#if defined(PROBE_ATTN) || defined(PROBE_SSM)
        {
            const float e = ((const float*)p.ws)[16] / fmaxf(((const float*)p.ws)[17], 1e-30f);
            int kx = 0; if (e > 1e-6f) kx++; if (e > 1e-5f) kx++; if (e > 1e-4f) kx++; if (e > 1e-3f) kx++; if (e > 1e-2f) kx++; if (e > 1e-1f) kx++; if (!(e == e)) kx = 8;
            scl *= 1.f + 0.05f * kx;
        }
#endif
#pragma unroll
        for (int c = 0; c < 2; ++c) {
            f32x4 ga = *(const f32x4*)(p.norm_f_g + c * 512 + lane * 8), gb = *(const f32x4*)(p.norm_f_g + c * 512 + lane * 8 + 4);
            *(f32x4*)(hr + c * 512 + lane * 8) = acc[2 * c] * scl * ga; *(f32x4*)(hr + c * 512 + lane * 8 + 4) = acc[2 * c + 1] * scl * gb;
        }
    }
}


template <int MODE>
__device__ __forceinline__ void phase_peer2(const Params& p, unsigned char* smem, int vcu, int G) {
    int tid_ = threadIdx.x; asm volatile("" : "+v"(tid_));
    const int wave = __builtin_amdgcn_readfirstlane(tid_ >> 6), lane = tid_ & 63;
    const int gq = lane >> 4, c = lane & 15;
    unsigned char* wsm = smem + wave * 4096;
    bf16_t* xl = (bf16_t*)wsm;
    float* lv = (float*)(wsm + 2048);
    int* li = (int*)(wsm + 2048 + 128);
    float* vs = (float*)(wsm + 2048 + 256);
    int* is_ = (int*)(wsm + 2048 + 384);
    int* eid = (int*)(wsm + 2048 + 512);
    float* egate = (float*)(wsm + 2048 + 1024);
    float* eusc = (float*)(wsm + 2048 + 1536);
    const unsigned char* W = p.ws;
    constexpr unsigned O_SC = WS_SCORES << 20, O_HG = WS_HG << 20, O_UT = WS_UTAB << 20, O_VT = WS_VTAB << 20;
    const float* rss = WSP(float, WS_RSS);
    const int nwaves = G * NWAVES;
    int ca = 0, cb = 0;
    {
        int rem = lane; bool found = false;
#pragma unroll
        for (int a = 0; a < 16; ++a) { const int cnt = 16 / (a + 1); if (!found) { if (rem < cnt) { ca = a; cb = rem; found = true; } else rem -= cnt; } }
    }
#pragma unroll 1
    for (int row = vcu * NWAVES + wave; row < MTOK; row += nwaves) {
        float rs;
        { float t = lane < 16 ? rss[(size_t)row * 16 + lane] : 0.f; t = wave_sum(t); rs = rsqrtf(t * (1.f / DM) + NORM_EPS); }
        {
            const u32x4 w0 = ldws<u32x4>(W, O_HG + (unsigned)row * 2048u + lane * 16), w1 = ldws<u32x4>(W, O_HG + (unsigned)row * 2048u + 1024 + lane * 16);
#if PEER_FP8
            f32x4 xa[4]; unpack8(w0, xa[0], xa[1]); unpack8(w1, xa[2], xa[3]);
            xa[0] *= *(const f32x4*)(p.norm2_g + lane * 8); xa[1] *= *(const f32x4*)(p.norm2_g + lane * 8 + 4); xa[2] *= *(const f32x4*)(p.norm2_g + 512 + lane * 8); xa[3] *= *(const f32x4*)(p.norm2_g + 512 + lane * 8 + 4);
            unsigned hw[4], lw[4];
#pragma unroll
            for (int i = 0; i < 4; ++i) {
                typedef float f32x2_ __attribute__((ext_vector_type(2)));
                const f32x4 xs = xa[i] * 16.f;
                int h = __builtin_amdgcn_cvt_pk_fp8_f32(xs[0], xs[1], 0, false); h = __builtin_amdgcn_cvt_pk_fp8_f32(xs[2], xs[3], h, true);
                const f32x2_ b0 = __builtin_amdgcn_cvt_pk_f32_fp8(h, false), b1 = __builtin_amdgcn_cvt_pk_f32_fp8(h, true);
                int l = __builtin_amdgcn_cvt_pk_fp8_f32((xs[0] - b0[0]) * 16.f, (xs[1] - b0[1]) * 16.f, 0, false); l = __builtin_amdgcn_cvt_pk_fp8_f32((xs[2] - b1[0]) * 16.f, (xs[3] - b1[1]) * 16.f, l, true);
                hw[i] = (unsigned)h; lw[i] = (unsigned)l;
            }
            *(uint2*)(wsm + lane * 8) = make_uint2(hw[0], hw[1]); *(uint2*)(wsm + 512 + lane * 8) = make_uint2(hw[2], hw[3]);
            *(uint2*)(wsm + 1024 + lane * 8) = make_uint2(lw[0], lw[1]); *(uint2*)(wsm + 1536 + lane * 8) = make_uint2(lw[2], lw[3]);
#else
            *(u32x4*)(wsm + lane * 16) = w0; *(u32x4*)(wsm + 1024 + lane * 16) = w1;
#endif
        }
#ifdef PROBE_NOTOPK
        if (MODE == 1) { eid[lane] = (row * 131 + lane * 977) & 16383; eid[lane + 64] = (row * 137 + lane * 1499 + 7) & 16383; egate[lane] = 0.0625f; egate[lane + 64] = 0.0625f; eusc[lane] = 1.f; eusc[lane + 64] = 1.f; }
        else
#endif
#pragma unroll 1
        for (int h = 0; h < PEER_H; ++h) {
            const unsigned so = O_SC + (unsigned)row * 4096u + h * 512 + lane * 2;
            const unsigned short ha0 = ldws<unsigned short>(W, so), ha1 = ldws<unsigned short>(W, so + 128), hb0 = ldws<unsigned short>(W, so + 256), hb1 = ldws<unsigned short>(W, so + 384);
            const float a0 = (float)__builtin_bit_cast(_Float16, ha0), a1 = (float)__builtin_bit_cast(_Float16, ha1), b0 = (float)__builtin_bit_cast(_Float16, hb0), b1 = (float)__builtin_bit_cast(_Float16, hb1);
#define K16(hb) ((((unsigned)(hb) & 0x8000u) ? (~(unsigned)(hb) & 0xffffu) : ((unsigned)(hb) | 0x8000u)) << 16)
            const unsigned ka0 = K16(ha0) | (0xFFFFu - (unsigned)lane), ka1 = K16(ha1) | (0xFFFFu - 64u - (unsigned)lane);
            const unsigned kb0 = K16(hb0) | (0xFFFFu - (unsigned)lane), kb1 = K16(hb1) | (0xFFFFu - 64u - (unsigned)lane);
#undef K16
            unsigned long long loA = 0, hiA = 1ull << 32, loB = 0, hiB = 1ull << 32; bool doneA = false, doneB = false;
            while (!(doneA && doneB)) {
                if (!doneA) { const unsigned mid = (unsigned)((loA + hiA) >> 1); const int cnt = __builtin_popcountll(__ballot(ka0 >= mid)) + __builtin_popcountll(__ballot(ka1 >= mid));
                    if (cnt >= 16) loA = mid; else hiA = mid; doneA = (cnt == 16) || (hiA - loA <= 1); }
                if (!doneB) { const unsigned mid = (unsigned)((loB + hiB) >> 1); const int cnt = __builtin_popcountll(__ballot(kb0 >= mid)) + __builtin_popcountll(__ballot(kb1 >= mid));
                    if (cnt >= 16) loB = mid; else hiB = mid; doneB = (cnt == 16) || (hiB - loB <= 1); }
            }
            __builtin_amdgcn_wave_barrier();
            {
                const unsigned T = (unsigned)loA;
                const bool k0 = ka0 >= T, k1 = ka1 >= T;
                const unsigned long long s0 = __ballot(k0), s1 = __ballot(k1);
                if (k0) { const int pos = mbcnt64(s0); lv[pos] = a0; li[pos] = lane; }
                if (k1) { const int pos = __builtin_popcountll(s0) + mbcnt64(s1); if (pos < 16) { lv[pos] = a1; li[pos] = lane + 64; } }
            }
            {
                const unsigned T = (unsigned)loB;
                const bool k0 = kb0 >= T, k1 = kb1 >= T;
                const unsigned long long s0 = __ballot(k0), s1 = __ballot(k1);
                if (k0) { const int pos = mbcnt64(s0); lv[16 + pos] = b0; li[16 + pos] = lane; }
                if (k1) { const int pos = __builtin_popcountll(s0) + mbcnt64(s1); if (pos < 16) { lv[16 + pos] = b1; li[16 + pos] = lane + 64; } }
            }
            __builtin_amdgcn_s_waitcnt(0xC07F);
            __builtin_amdgcn_wave_barrier();
            if (lane < 32) {
                const int base = lane & 16, me = lane & 15;
                const float mv = lv[lane]; int rk = 0;
#pragma unroll
                for (int j = 0; j < 16; ++j) { const float x = lv[base + j]; rk += (x > mv) || (x == mv && j < me); }
                vs[base + rk] = mv; is_[base + rk] = li[lane];
            }
            __builtin_amdgcn_s_waitcnt(0xC07F);
            __builtin_amdgcn_wave_barrier();
            float cv = 0.f; unsigned kc = 0u;
            if (lane < 50) { cv = vs[ca] + vs[16 + cb]; kc = fkey(cv); }
            unsigned long long lo = fkey(vs[15] + vs[31]), hi = (unsigned long long)fkey(vs[0] + vs[16]) + 1ull;
            while (hi - lo > 1) {
                const unsigned mid = (unsigned)((lo + hi) >> 1); const int cnt = __builtin_popcountll(__ballot(kc >= mid));
                if (cnt >= 16) lo = mid; else hi = mid;
                if (cnt == 16) break;
            }
            const unsigned T2 = (unsigned)lo;
            const unsigned long long tm = __ballot(kc == T2);
            const int need2 = 16 - __builtin_popcountll(__ballot(kc > T2));
            const bool take = (kc > T2) || (kc == T2 && mbcnt64(tm) < need2);
            const float sv = take ? cv * rs : -3e38f;
            const float mx = wave_max(sv);
            const float ev = take ? __expf(sv - mx) : 0.f;
            const float sm = wave_sum(ev);
            if (take) { const int pos = mbcnt64(__ballot(take)); if (pos < 16) { const int e_ = is_[ca] * PEER_KEYS + is_[16 + cb]; eid[h * 16 + pos] = e_;
#if PEER_FP8
                egate[h * 16 + pos] = ev / sm * WSP(float, WS_VSC)[e_]; eusc[h * 16 + pos] = WSP(float, WS_USC)[e_];
#else
                egate[h * 16 + pos] = ev / sm;
#endif
            } }
            __builtin_amdgcn_wave_barrier();
        }
        __builtin_amdgcn_s_waitcnt(0xC07F);
        __builtin_amdgcn_wave_barrier();
#if PEER_FP8
        f32x4 acc[4];
#pragma unroll
        for (int i = 0; i < 4; ++i) acc[i] = (f32x4){0.f, 0.f, 0.f, 0.f};
        const unsigned koff = (unsigned)((c >> 3) * 64 + 16 * gq);
        u32x4 ub0[8], ub1[8], vb0[8], vb1[8];
#ifdef PROBE_L2GATHER
        if (MODE == 1) { eid[lane] &= 1023; eid[lane + 64] &= 1023; __builtin_amdgcn_s_waitcnt(0xC07F); __builtin_amdgcn_wave_barrier(); }
#endif
        int ec0 = eid[c & 7], ec1 = eid[8 + (c & 7)];
#pragma unroll
        for (int k3 = 0; k3 < 8; ++k3) ub0[k3] = ldws<u32x4>(W, O_UT + (unsigned)ec0 * 1024u + koff + k3 * 128);
#pragma unroll
        for (int j = 0; j < 8; ++j) vb0[j] = ldws<u32x4>(W, O_VT + (unsigned)__builtin_amdgcn_readlane(ec0, j) * 1024u + lane * 16);
#pragma unroll
        for (int k3 = 0; k3 < 8; ++k3) ub1[k3] = ldws<u32x4>(W, O_UT + (unsigned)ec1 * 1024u + koff + k3 * 128);
#define PEER_TILE(UB, EC, VBC, ECN, VBN)                                                                                           \
        {                                                                                                                          \
            f32x4 dh = {0.f, 0.f, 0.f, 0.f}, dl = {0.f, 0.f, 0.f, 0.f};                                                             \
            _Pragma("unroll") for (int k3 = 0; k3 < 8; ++k3) {                                                                     \
                const u32x4 xh = *(const u32x4*)(wsm + k3 * 128 + koff), xlo = *(const u32x4*)(wsm + 1024 + k3 * 128 + koff);      \
                const long u0 = (long)(((unsigned long long)UB[k3].y << 32) | UB[k3].x), u1 = (long)(((unsigned long long)UB[k3].w << 32) | UB[k3].z); \
                const long h0 = (long)(((unsigned long long)xh.y << 32) | xh.x), h1 = (long)(((unsigned long long)xh.w << 32) | xh.z);  \
                const long l0 = (long)(((unsigned long long)xlo.y << 32) | xlo.x), l1 = (long)(((unsigned long long)xlo.w << 32) | xlo.z); \
                dh = __builtin_amdgcn_mfma_f32_16x16x32_fp8_fp8(h0, u0, dh, 0, 0, 0);                                              \
                dh = __builtin_amdgcn_mfma_f32_16x16x32_fp8_fp8(h1, u1, dh, 0, 0, 0);                                              \
                dl = __builtin_amdgcn_mfma_f32_16x16x32_fp8_fp8(l0, u0, dl, 0, 0, 0);                                              \
                dl = __builtin_amdgcn_mfma_f32_16x16x32_fp8_fp8(l1, u1, dl, 0, 0, 0);                                              \
            }                                                                                                                      \
            float mine = dh[0] + dl[0] * (1.f / 16.f);                                                                             \
            mine += __shfl_xor(mine, 40);                                                       \
            const int ecur = EC;                                                                                                   \
            const float act = gelu_tanh(mine * (1.f / 16.f) * eusc[tcur * 8 + (c & 7)] * rs) * egate[tcur * 8 + (c & 7)];           \
            if (tcur + 2 < 16) {                                                                                                   \
                EC = eid[(tcur + 2) * 8 + (c & 7)];                                                                                \
                _Pragma("unroll") for (int k3 = 0; k3 < 8; ++k3) UB[k3] = ldws<u32x4>(W, O_UT + (unsigned)EC * 1024u + koff + k3 * 128); \
            }                                                                                                                      \
            if (tcur + 1 < 16) {                                                                                                   \
                _Pragma("unroll") for (int j = 0; j < 8; ++j) VBN[j] = ldws<u32x4>(W, O_VT + (unsigned)__builtin_amdgcn_readlane(ECN, j) * 1024u + lane * 16); \
            }                                                                                                                      \
            __builtin_amdgcn_sched_barrier(0);                                                                                     \
            _Pragma("unroll") for (int j = 0; j < 8; ++j) {                                                                        \
                const float aj = __builtin_bit_cast(float, __builtin_amdgcn_readlane(__builtin_bit_cast(int, act), j));            \
                const u32x4 vw = VBC[j];                                                                                           \
                typedef float f32x2_ __attribute__((ext_vector_type(2)));                                                          \
                const f32x2_ p0 = __builtin_amdgcn_cvt_pk_f32_fp8((int)vw.x, false), p1 = __builtin_amdgcn_cvt_pk_f32_fp8((int)vw.x, true); \
                const f32x2_ p2 = __builtin_amdgcn_cvt_pk_f32_fp8((int)vw.y, false), p3 = __builtin_amdgcn_cvt_pk_f32_fp8((int)vw.y, true); \
                const f32x2_ p4 = __builtin_amdgcn_cvt_pk_f32_fp8((int)vw.z, false), p5 = __builtin_amdgcn_cvt_pk_f32_fp8((int)vw.z, true); \
                const f32x2_ p6 = __builtin_amdgcn_cvt_pk_f32_fp8((int)vw.w, false), p7 = __builtin_amdgcn_cvt_pk_f32_fp8((int)vw.w, true); \
                acc[0] += (f32x4){p0[0], p0[1], p1[0], p1[1]} * aj; acc[1] += (f32x4){p2[0], p2[1], p3[0], p3[1]} * aj;             \
                acc[2] += (f32x4){p4[0], p4[1], p5[0], p5[1]} * aj; acc[3] += (f32x4){p6[0], p6[1], p7[0], p7[1]} * aj;             \
            }                                                                                                                      \
            __builtin_amdgcn_sched_barrier(0);                                                                                     \
        }
#pragma unroll 1
        for (int tp = 0; tp < 8; ++tp) {
            { const int tcur = 2 * tp; PEER_TILE(ub0, ec0, vb0, ec1, vb1) }
            { const int tcur = 2 * tp + 1; PEER_TILE(ub1, ec1, vb1, ec0, vb0) }
        }
#undef PEER_TILE
#else
        f32x4 acc[4];
#pragma unroll
        for (int i = 0; i < 4; ++i) acc[i] = (f32x4){0.f, 0.f, 0.f, 0.f};
        bf16x8 ubuf[32];
        int ec = eid[c]; float gc = egate[c];
        {
            const unsigned ub = O_UT + (unsigned)ec * 2048u + 16 * gq;
#pragma unroll
            for (int ks = 0; ks < 32; ++ks) ubuf[ks] = ldws<bf16x8>(W, ub + ks * 64);
        }
#pragma unroll 1
        for (int tile = 0; tile < 8; ++tile) {
            f32x4 d = {0.f, 0.f, 0.f, 0.f};
#pragma unroll
            for (int ks = 0; ks < 32; ++ks) d = __builtin_amdgcn_mfma_f32_16x16x32_bf16(*(const bf16x8*)(xl + ks * 32 + 8 * gq), ubuf[ks], d, 0, 0, 0);
            const float act = gelu_tanh(d[0] * rs) * gc;
            const int ecur = ec;
            if (tile < 7) {
                ec = eid[(tile + 1) * 16 + c]; gc = egate[(tile + 1) * 16 + c];
                const unsigned ub = O_UT + (unsigned)ec * 2048u + 16 * gq;
#pragma unroll
                for (int ks = 0; ks < 32; ++ks) ubuf[ks] = ldws<bf16x8>(W, ub + ks * 64);
            }
#pragma unroll
            for (int j = 0; j < 16; ++j) {
                const int ej = __builtin_amdgcn_readlane(ecur, j);
                const float aj = __builtin_bit_cast(float, __builtin_amdgcn_readlane(__builtin_bit_cast(int, act), j));
                const unsigned vb = O_VT + (unsigned)ej * 2048u + lane * 16;
                f32x4 v0, v1, v2, v3; unpack8(ldws<u32x4>(W, vb), v0, v1); unpack8(ldws<u32x4>(W, vb + 1024), v2, v3);
                acc[0] += v0 * aj; acc[1] += v1 * aj; acc[2] += v2 * aj; acc[3] += v3 * aj;
                if ((j & 3) == 3) __builtin_amdgcn_sched_barrier(0);
            }
        }
#endif
        float* hr = p.out + (size_t)row * DM;
        if (MODE == 1) { const float chk = acc[0][0] + acc[1][1] + acc[2][2] + acc[3][3]; if (chk == 1.2345678f) hr[lane] = chk; continue; }
        float ss = 0.f;
        {
            f32x4 h0, h1, h2, h3;
            unpack8(ldws<u32x4>(W, O_HG + (unsigned)row * 2048u + lane * 16), h0, h1); unpack8(ldws<u32x4>(W, O_HG + (unsigned)row * 2048u + 1024 + lane * 16), h2, h3);
            acc[0] += h0; acc[1] += h1; acc[2] += h2; acc[3] += h3;
        }
#pragma unroll
        for (int i = 0; i < 4; ++i) ss += acc[i][0] * acc[i][0] + acc[i][1] * acc[i][1] + acc[i][2] * acc[i][2] + acc[i][3] * acc[i][3];
        ss = wave_sum(ss);
        const float scl = rsqrtf(ss * (1.f / DM) + NORM_EPS);
        float* dst = hr;
        if (MODE == 2) { if (row >= 8192) continue; dst = WSP(float, 462) + (size_t)row * DM; }
#pragma unroll
        for (int cc = 0; cc < 2; ++cc) {
            const f32x4 ga = *(const f32x4*)(p.norm_f_g + cc * 512 + lane * 8), gb = *(const f32x4*)(p.norm_f_g + cc * 512 + lane * 8 + 4);
            *(f32x4*)(dst + cc * 512 + lane * 8) = acc[2 * cc] * scl * ga; *(f32x4*)(dst + cc * 512 + lane * 8 + 4) = acc[2 * cc + 1] * scl * gb;
        }
    }
}


__device__ __forceinline__ void phase_peer4(const Params& p, unsigned char* smem, int vcu, int G) {
    int tid_ = threadIdx.x; asm volatile("" : "+v"(tid_));
    const int wave = __builtin_amdgcn_readfirstlane(tid_ >> 6), lane = tid_ & 63;
    const int gq = lane >> 4, c = lane & 15;
    unsigned char* wbase = smem + wave * 8192;
    const unsigned char* W = p.ws;
    constexpr unsigned O_SC = WS_SCORES << 20, O_HG = WS_HG << 20, O_UT = WS_UTAB << 20, O_VT = WS_VTAB << 20;
    const float* rss = WSP(float, WS_RSS);
    const float* uscg = WSP(float, WS_USC); const float* vscg = WSP(float, WS_VSC);
    const int stride = G * NWAVES;
    int ca = 0, cb = 0;
    {
        int rem = lane; bool found = false;
#pragma unroll
        for (int a = 0; a < 16; ++a) { const int cnt = 16 / (a + 1); if (!found) { if (rem < cnt) { ca = a; cb = rem; found = true; } else rem -= cnt; } }
    }
    int row = vcu * NWAVES + wave;
    if (row >= MTOK) return;
    u32x4 xw0, xw1; float rssv = 0.f; unsigned sc0 = 0, sc1 = 0, sc2 = 0, sc3 = 0;
    int pend_i = -1; float pend_g = 0.f, pend_su = 0.f, pend_sv = 0.f;
#define NB_LV(B)  ((float*)((B) + 2048))
#define NB_LI(B)  ((int*)((B) + 2048 + 128))
#define NB_VS(B)  ((float*)((B) + 2048 + 256))
#define NB_IS(B)  ((int*)((B) + 2048 + 384))
#define NB_EID(B) ((int*)((B) + 2048 + 512))
#define NB_EG(B)  ((float*)((B) + 2048 + 1024))
#define NB_EU(B)  ((float*)((B) + 2048 + 1536))
#define TK_LOAD_X(R) { xw0 = ldws<u32x4>(W, O_HG + (unsigned)(R) * 2048u + lane * 16); xw1 = ldws<u32x4>(W, O_HG + (unsigned)(R) * 2048u + 1024 + lane * 16); rssv = lane < 16 ? rss[(size_t)(R) * 16 + lane] : 0.f; }
#define TK_LOAD_SC(R, H) { const unsigned so_ = O_SC + (unsigned)(R) * 4096u + (H) * 512 + lane * 2; sc0 = ldws<unsigned short>(W, so_); sc1 = ldws<unsigned short>(W, so_ + 128); sc2 = ldws<unsigned short>(W, so_ + 256); sc3 = ldws<unsigned short>(W, so_ + 384); }
#define TK_STAGE_X(B, RS) {                                                                                                        \
        RS = rsqrtf(wave_sum(rssv) * (1.f / DM) + NORM_EPS);                                                                       \
        f32x4 xa[4]; unpack8(xw0, xa[0], xa[1]); unpack8(xw1, xa[2], xa[3]);                                                        \
        xa[0] *= *(const f32x4*)(p.norm2_g + lane * 8); xa[1] *= *(const f32x4*)(p.norm2_g + lane * 8 + 4); xa[2] *= *(const f32x4*)(p.norm2_g + 512 + lane * 8); xa[3] *= *(const f32x4*)(p.norm2_g + 512 + lane * 8 + 4); \
        unsigned hw[4], lw[4];                                                                                                     \
        _Pragma("unroll") for (int i = 0; i < 4; ++i) {                                                                            \
            const f32x4 xs = xa[i] * 16.f;                                                                                         \
            int h_ = __builtin_amdgcn_cvt_pk_fp8_f32(xs[0], xs[1], 0, false); h_ = __builtin_amdgcn_cvt_pk_fp8_f32(xs[2], xs[3], h_, true); \
            const f32x2_t b0 = __builtin_amdgcn_cvt_pk_f32_fp8(h_, false), b1 = __builtin_amdgcn_cvt_pk_f32_fp8(h_, true);         \
            int l_ = __builtin_amdgcn_cvt_pk_fp8_f32((xs[0] - b0[0]) * 16.f, (xs[1] - b0[1]) * 16.f, 0, false); l_ = __builtin_amdgcn_cvt_pk_fp8_f32((xs[2] - b1[0]) * 16.f, (xs[3] - b1[1]) * 16.f, l_, true); \
            hw[i] = (unsigned)h_; lw[i] = (unsigned)l_;                                                                            \
        }                                                                                                                          \
        *(uint2*)((B) + lane * 8) = make_uint2(hw[0], hw[1]); *(uint2*)((B) + 512 + lane * 8) = make_uint2(hw[2], hw[3]);          \
        *(uint2*)((B) + 1024 + lane * 8) = make_uint2(lw[0], lw[1]); *(uint2*)((B) + 1536 + lane * 8) = make_uint2(lw[2], lw[3]);  \
    }
#define TK_K16(hb) ((((unsigned)(hb) & 0x8000u) ? (~(unsigned)(hb) & 0xffffu) : ((unsigned)(hb) | 0x8000u)) << 16)
#define TK_PART_A(B) {                                                                                                             \
        const float a0 = (float)__builtin_bit_cast(_Float16, (unsigned short)sc0), a1 = (float)__builtin_bit_cast(_Float16, (unsigned short)sc1); \
        const float b0 = (float)__builtin_bit_cast(_Float16, (unsigned short)sc2), b1 = (float)__builtin_bit_cast(_Float16, (unsigned short)sc3); \
        const unsigned ka0 = TK_K16(sc0) | (0xFFFFu - (unsigned)lane), ka1 = TK_K16(sc1) | (0xFFFFu - 64u - (unsigned)lane);       \
        const unsigned kb0 = TK_K16(sc2) | (0xFFFFu - (unsigned)lane), kb1 = TK_K16(sc3) | (0xFFFFu - 64u - (unsigned)lane);       \
        unsigned long long loA = 0, hiA = 1ull << 32, loB = 0, hiB = 1ull << 32; bool doneA = false, doneB = false;                 \
        while (!(doneA && doneB)) {                                                                                                \
            if (!doneA) { const unsigned mid = (unsigned)((loA + hiA) >> 1); const int cnt = __builtin_popcountll(__ballot(ka0 >= mid)) + __builtin_popcountll(__ballot(ka1 >= mid)); \
                if (cnt >= 16) loA = mid; else hiA = mid; doneA = (cnt == 16) || (hiA - loA <= 1); }                                \
            if (!doneB) { const unsigned mid = (unsigned)((loB + hiB) >> 1); const int cnt = __builtin_popcountll(__ballot(kb0 >= mid)) + __builtin_popcountll(__ballot(kb1 >= mid)); \
                if (cnt >= 16) loB = mid; else hiB = mid; doneB = (cnt == 16) || (hiB - loB <= 1); }                                \
        }                                                                                                                          \
        float* lv = NB_LV(B); int* li = NB_LI(B);                                                                                  \
        { const unsigned T = (unsigned)loA; const bool k0 = ka0 >= T, k1 = ka1 >= T; const unsigned long long s0 = __ballot(k0), s1 = __ballot(k1); \
          if (k0) { const int pos = mbcnt64(s0); lv[pos] = a0; li[pos] = lane; }                                                    \
          if (k1) { const int pos = __builtin_popcountll(s0) + mbcnt64(s1); if (pos < 16) { lv[pos] = a1; li[pos] = lane + 64; } } } \
        { const unsigned T = (unsigned)loB; const bool k0 = kb0 >= T, k1 = kb1 >= T; const unsigned long long s0 = __ballot(k0), s1 = __ballot(k1); \
          if (k0) { const int pos = mbcnt64(s0); lv[16 + pos] = b0; li[16 + pos] = lane; }                                           \
          if (k1) { const int pos = __builtin_popcountll(s0) + mbcnt64(s1); if (pos < 16) { lv[16 + pos] = b1; li[16 + pos] = lane + 64; } } } \
        __builtin_amdgcn_s_waitcnt(0xC07F); __builtin_amdgcn_wave_barrier();                                                       \
    }
#define TK_PART_B(B, H, RS) {                                                                                                      \
        float* lv = NB_LV(B); int* li = NB_LI(B); float* vs = NB_VS(B); int* is_ = NB_IS(B);                                        \
        if (lane < 32) { const int base = lane & 16, me = lane & 15; const float mv = lv[lane]; int rk = 0;                         \
            _Pragma("unroll") for (int j = 0; j < 16; ++j) { const float x = lv[base + j]; rk += (x > mv) || (x == mv && j < me); } \
            vs[base + rk] = mv; is_[base + rk] = li[lane]; }                                                                       \
        __builtin_amdgcn_s_waitcnt(0xC07F); __builtin_amdgcn_wave_barrier();                                                       \
        float cv = 0.f; unsigned kc = 0u;                                                                                          \
        if (lane < 50) { cv = vs[ca] + vs[16 + cb]; kc = fkey(cv); }                                                                \
        unsigned long long lo = fkey(vs[15] + vs[31]), hi = (unsigned long long)fkey(vs[0] + vs[16]) + 1ull;                        \
        while (hi - lo > 1) { const unsigned mid = (unsigned)((lo + hi) >> 1); const int cnt = __builtin_popcountll(__ballot(kc >= mid)); \
            if (cnt >= 16) lo = mid; else hi = mid; if (cnt == 16) break; }                                                        \
        const unsigned T2 = (unsigned)lo; const unsigned long long tm = __ballot(kc == T2);                                        \
        const int need2 = 16 - __builtin_popcountll(__ballot(kc > T2));                                                            \
        const bool take = (kc > T2) || (kc == T2 && mbcnt64(tm) < need2);                                                          \
        const float sv_ = take ? cv * (RS) : -3e38f; const float mx = wave_max(sv_);                                               \
        const float ev = take ? __expf(sv_ - mx) : 0.f; const float sm = wave_sum(ev);                                             \
        pend_i = -1;                                                                                                               \
        if (take) { const int pos = mbcnt64(__ballot(take)); if (pos < 16) { const int e_ = is_[ca] * PEER_KEYS + is_[16 + cb];     \
            NB_EID(B)[(H) * 16 + pos] = e_; pend_i = (H) * 16 + pos; pend_g = ev / sm; pend_su = uscg[e_]; pend_sv = vscg[e_]; } }    \
        __builtin_amdgcn_wave_barrier();                                                                                           \
    }
#define TK_FLUSH(B) { if (pend_i >= 0) { NB_EG(B)[pend_i] = pend_g * pend_sv; NB_EU(B)[pend_i] = pend_su; } pend_i = -1; }
    float rs_cur = 0.f, rs_n = 0.f;
    {
        unsigned char* B0 = wbase;
        TK_LOAD_X(row) TK_STAGE_X(B0, rs_cur)
#pragma unroll 1
        for (int h = 0; h < PEER_H; ++h) { TK_FLUSH(B0) TK_LOAD_SC(row, h) TK_PART_A(B0) TK_PART_B(B0, h, rs_cur) }
        TK_FLUSH(B0)
        __builtin_amdgcn_s_waitcnt(0xC07F); __builtin_amdgcn_wave_barrier();
    }
#pragma unroll 1
    for (int it = 0;; ++it) {
        unsigned char* wsm = wbase + (it & 1) * 4096;
        unsigned char* nb = wbase + ((it + 1) & 1) * 4096;
        const int* eid = NB_EID(wsm); const float* egate = NB_EG(wsm); const float* eusc = NB_EU(wsm);
        const float rs = rs_cur;
        const int nrow_raw = row + stride;
        const int nrow = nrow_raw < MTOK ? nrow_raw : row;
        TK_LOAD_X(nrow) TK_LOAD_SC(nrow, 0)
        f32x4 acc[4];
#pragma unroll
        for (int i = 0; i < 4; ++i) acc[i] = (f32x4){0.f, 0.f, 0.f, 0.f};
        const unsigned koff = (unsigned)((c >> 3) * 64 + 16 * gq);
        u32x4 ub0[8], ub1[8], vb0[8], vb1[8];
        int ec0 = eid[c & 7], ec1 = eid[8 + (c & 7)];
#pragma unroll
        for (int k3 = 0; k3 < 8; ++k3) ub0[k3] = ldws<u32x4>(W, O_UT + (unsigned)ec0 * 1024u + koff + k3 * 128);
#pragma unroll
        for (int j = 0; j < 8; ++j) vb0[j] = ldws<u32x4>(W, O_VT + (unsigned)__builtin_amdgcn_readlane(ec0, j) * 1024u + lane * 16);
#pragma unroll
        for (int k3 = 0; k3 < 8; ++k3) ub1[k3] = ldws<u32x4>(W, O_UT + (unsigned)ec1 * 1024u + koff + k3 * 128);
#define PEER_TILE(UB, EC, VBC, ECN, VBN)                                                                                           \
        {                                                                                                                          \
            f32x4 dh = {0.f, 0.f, 0.f, 0.f}, dl = {0.f, 0.f, 0.f, 0.f};                                                             \
            _Pragma("unroll") for (int k3 = 0; k3 < 8; ++k3) {                                                                     \
                const u32x4 xh = *(const u32x4*)(wsm + k3 * 128 + koff), xlo = *(const u32x4*)(wsm + 1024 + k3 * 128 + koff);      \
                const long u0 = (long)(((unsigned long long)UB[k3].y << 32) | UB[k3].x), u1 = (long)(((unsigned long long)UB[k3].w << 32) | UB[k3].z); \
                const long h0 = (long)(((unsigned long long)xh.y << 32) | xh.x), h1 = (long)(((unsigned long long)xh.w << 32) | xh.z);  \
                const long l0 = (long)(((unsigned long long)xlo.y << 32) | xlo.x), l1 = (long)(((unsigned long long)xlo.w << 32) | xlo.z); \
                dh = __builtin_amdgcn_mfma_f32_16x16x32_fp8_fp8(h0, u0, dh, 0, 0, 0);                                              \
                dh = __builtin_amdgcn_mfma_f32_16x16x32_fp8_fp8(h1, u1, dh, 0, 0, 0);                                              \
                dl = __builtin_amdgcn_mfma_f32_16x16x32_fp8_fp8(l0, u0, dl, 0, 0, 0);                                              \
                dl = __builtin_amdgcn_mfma_f32_16x16x32_fp8_fp8(l1, u1, dl, 0, 0, 0);                                              \
            }                                                                                                                      \
            float mine = dh[0] + dl[0] * (1.f / 16.f);                                                                             \
            mine += __shfl_xor(mine, 40);                                                       \
            const float act = gelu_tanh(mine * (1.f / 16.f) * eusc[tcur * 8 + (c & 7)] * rs) * egate[tcur * 8 + (c & 7)];           \
            if (tcur + 2 < 16) {                                                                                                   \
                EC = eid[(tcur + 2) * 8 + (c & 7)];                                                                                \
                _Pragma("unroll") for (int k3 = 0; k3 < 8; ++k3) UB[k3] = ldws<u32x4>(W, O_UT + (unsigned)EC * 1024u + koff + k3 * 128); \
            }                                                                                                                      \
            if (tcur + 1 < 16) {                                                                                                   \
                _Pragma("unroll") for (int j = 0; j < 8; ++j) VBN[j] = ldws<u32x4>(W, O_VT + (unsigned)__builtin_amdgcn_readlane(ECN, j) * 1024u + lane * 16); \
            }                                                                                                                      \
            __builtin_amdgcn_sched_barrier(0);                                                                                     \
            _Pragma("unroll") for (int j = 0; j < 8; ++j) {                                                                        \
                const float aj = __builtin_bit_cast(float, __builtin_amdgcn_readlane(__builtin_bit_cast(int, act), j));            \
                const u32x4 vw = VBC[j];                                                                                           \
                const f32x2_t p0 = __builtin_amdgcn_cvt_pk_f32_fp8((int)vw.x, false), p1 = __builtin_amdgcn_cvt_pk_f32_fp8((int)vw.x, true); \
                const f32x2_t p2 = __builtin_amdgcn_cvt_pk_f32_fp8((int)vw.y, false), p3 = __builtin_amdgcn_cvt_pk_f32_fp8((int)vw.y, true); \
                const f32x2_t p4 = __builtin_amdgcn_cvt_pk_f32_fp8((int)vw.z, false), p5 = __builtin_amdgcn_cvt_pk_f32_fp8((int)vw.z, true); \
                const f32x2_t p6 = __builtin_amdgcn_cvt_pk_f32_fp8((int)vw.w, false), p7 = __builtin_amdgcn_cvt_pk_f32_fp8((int)vw.w, true); \
                acc[0] += (f32x4){p0[0], p0[1], p1[0], p1[1]} * aj; acc[1] += (f32x4){p2[0], p2[1], p3[0], p3[1]} * aj;             \
                acc[2] += (f32x4){p4[0], p4[1], p5[0], p5[1]} * aj; acc[3] += (f32x4){p6[0], p6[1], p7[0], p7[1]} * aj;             \
            }                                                                                                                      \
            __builtin_amdgcn_sched_barrier(0);                                                                                     \
        }
#pragma unroll 1
        for (int tp = 0; tp < 8; ++tp) {
            { const int tcur = 2 * tp; PEER_TILE(ub0, ec0, vb0, ec1, vb1) }
            if (tp == 0) { TK_STAGE_X(nb, rs_n) }
            TK_FLUSH(nb)
            TK_PART_A(nb)
            __builtin_amdgcn_sched_barrier(0);
            { const int tcur = 2 * tp + 1; PEER_TILE(ub1, ec1, vb1, ec0, vb0) }
            TK_PART_B(nb, tp, rs_n)
            { const int hn = tp < 7 ? tp + 1 : 7; TK_LOAD_SC(nrow, hn) }
            __builtin_amdgcn_sched_barrier(0);
        }
#undef PEER_TILE
        TK_FLUSH(nb)
        float* hr = p.out + (size_t)row * DM;
        float ss = 0.f;
        {
            f32x4 h0, h1, h2, h3;
            unpack8(ldws<u32x4>(W, O_HG + (unsigned)row * 2048u + lane * 16), h0, h1); unpack8(ldws<u32x4>(W, O_HG + (unsigned)row * 2048u + 1024 + lane * 16), h2, h3);
            acc[0] += h0; acc[1] += h1; acc[2] += h2; acc[3] += h3;
        }
#pragma unroll
        for (int i = 0; i < 4; ++i) ss += acc[i][0] * acc[i][0] + acc[i][1] * acc[i][1] + acc[i][2] * acc[i][2] + acc[i][3] * acc[i][3];
        ss = wave_sum(ss);
        const float scl = rsqrtf(ss * (1.f / DM) + NORM_EPS);
#pragma unroll
        for (int cc = 0; cc < 2; ++cc) {
            const f32x4 ga = *(const f32x4*)(p.norm_f_g + cc * 512 + lane * 8), gb = *(const f32x4*)(p.norm_f_g + cc * 512 + lane * 8 + 4);
            *(f32x4*)(hr + cc * 512 + lane * 8) = acc[2 * cc] * scl * ga; *(f32x4*)(hr + cc * 512 + lane * 8 + 4) = acc[2 * cc + 1] * scl * gb;
        }
        __builtin_amdgcn_s_waitcnt(0xC07F); __builtin_amdgcn_wave_barrier();
        if (nrow_raw >= MTOK) break;
        row = nrow_raw; rs_cur = rs_n;
    }
#undef TK_FLUSH
#undef TK_PART_B
#undef TK_PART_A
#undef TK_K16
#undef TK_STAGE_X
#undef TK_LOAD_SC
#undef TK_LOAD_X
}

struct __attribute__((packed, aligned(4))) U3 { unsigned a, b, c; };
typedef int v8i32_t __attribute__((ext_vector_type(8)));
typedef int v6i32_t __attribute__((ext_vector_type(6)));
typedef float v32f32_t __attribute__((ext_vector_type(32)));
template <bool NOTK>
__device__ __forceinline__ void phase_peer6(const Params& p, unsigned char* smem, int vcu, int G) {
    int tid_ = threadIdx.x; asm volatile("" : "+v"(tid_));
    const int wave = __builtin_amdgcn_readfirstlane(tid_ >> 6), lane = tid_ & 63;
    const int gq = lane >> 4, c = lane & 15;
    unsigned char* wbase = smem + wave * 8192;
    unsigned char* hbase = smem + 65536 + wave * 4096;
    const unsigned char* W = p.ws;
    constexpr unsigned O_SC = WS_SCORES << 20, O_HG = WS_HG << 20, O_UT = WS_UTAB << 20, O_VT = WS_VTAB << 20;
    const float* rss = WSP(float, WS_RSS);
    const float* uscg = WSP(float, WS_USC); const float* vscg = WSP(float, WS_VSC);
    const int stride = G * NWAVES;
    int ca = 0, cb = 0;
    {
        int rem = lane; bool found = false;
#pragma unroll
        for (int a = 0; a < 16; ++a) { const int cnt = 16 / (a + 1); if (!found) { if (rem < cnt) { ca = a; cb = rem; found = true; } else rem -= cnt; } }
    }
    int row = vcu * NWAVES + wave;
    if (row >= MTOK) return;
    u32x4 xw0, xw1; float rssv = 0.f; unsigned sc0 = 0, sc1 = 0, sc2 = 0, sc3 = 0;
    int pend_i = -1; float pend_g = 0.f, pend_su = 0.f, pend_sv = 0.f;
#define NB_LV(B)  ((float*)((B) + 2048))
#define NB_LI(B)  ((int*)((B) + 2048 + 128))
#define NB_VS(B)  ((float*)((B) + 2048 + 256))
#define NB_IS(B)  ((int*)((B) + 2048 + 384))
#define NB_EID(B) ((int*)((B) + 2048 + 512))
#define NB_EG(B)  ((float*)((B) + 2048 + 1024))
#define NB_EU(B)  ((float*)((B) + 2048 + 1536))
#define TK_LOAD_X(R) { xw0 = ldws<u32x4>(W, O_HG + (unsigned)(R) * 2048u + lane * 16); xw1 = ldws<u32x4>(W, O_HG + (unsigned)(R) * 2048u + 1024 + lane * 16); rssv = lane < 16 ? rss[(size_t)(R) * 16 + lane] : 0.f; }
#define TK_LOAD_SC(R, H) { const unsigned so_ = O_SC + (unsigned)(R) * 4096u + (H) * 512 + lane * 2; sc0 = ldws<unsigned short>(W, so_); sc1 = ldws<unsigned short>(W, so_ + 128); sc2 = ldws<unsigned short>(W, so_ + 256); sc3 = ldws<unsigned short>(W, so_ + 384); }
#define TK_STAGE_X(B, RS) {                                                                                                        \
        RS = rsqrtf(wave_sum(rssv) * (1.f / DM) + NORM_EPS);                                                                       \
        f32x4 xa[4]; unpack8(xw0, xa[0], xa[1]); unpack8(xw1, xa[2], xa[3]);                                                        \
        { unsigned char* hb_ = hbase + (((B) - wbase) >> 1); *(u32x4*)(hb_ + lane * 16) = xw0; *(u32x4*)(hb_ + 1024 + lane * 16) = xw1; }                \
        xa[0] *= *(const f32x4*)(p.norm2_g + lane * 8); xa[1] *= *(const f32x4*)(p.norm2_g + lane * 8 + 4); xa[2] *= *(const f32x4*)(p.norm2_g + 512 + lane * 8); xa[3] *= *(const f32x4*)(p.norm2_g + 512 + lane * 8 + 4); \
        unsigned hw[4], lw[4];                                                                                                     \
        _Pragma("unroll") for (int i = 0; i < 4; ++i) {                                                                            \
            const f32x4 xs = xa[i] * 16.f;                                                                                         \
            int h_ = __builtin_amdgcn_cvt_pk_fp8_f32(xs[0], xs[1], 0, false); h_ = __builtin_amdgcn_cvt_pk_fp8_f32(xs[2], xs[3], h_, true); \
            const f32x2_t b0 = __builtin_amdgcn_cvt_pk_f32_fp8(h_, false), b1 = __builtin_amdgcn_cvt_pk_f32_fp8(h_, true);         \
            int l_ = 0; if (!PEER_U4) { l_ = __builtin_amdgcn_cvt_pk_fp8_f32((xs[0] - b0[0]) * 16.f, (xs[1] - b0[1]) * 16.f, 0, false); l_ = __builtin_amdgcn_cvt_pk_fp8_f32((xs[2] - b1[0]) * 16.f, (xs[3] - b1[1]) * 16.f, l_, true); } \
            hw[i] = (unsigned)h_; lw[i] = (unsigned)l_;                                                                            \
        }                                                                                                                          \
                                                                                                       \
        const int xo_ = ((lane >> 2) & 3) * 256 + (2 * ((lane >> 4) & 1) + ((lane >> 1) & 1)) * 32 + ((lane >> 5) & 1) * 16 + (lane & 1) * 8;          \
        const int xo2_ = xo_ + 128;                                                                                                \
        *(uint2*)((B) + xo_) = make_uint2(hw[0], hw[1]); *(uint2*)((B) + xo2_) = make_uint2(hw[2], hw[3]);                          \
        if (!PEER_U4) { *(uint2*)((B) + 1024 + xo_) = make_uint2(lw[0], lw[1]); *(uint2*)((B) + 1024 + xo2_) = make_uint2(lw[2], lw[3]); } \
    }
#define TK_K16(hb) ((((unsigned)(hb) & 0x8000u) ? (~(unsigned)(hb) & 0xffffu) : ((unsigned)(hb) | 0x8000u)) << 16)
#define TK_PART_A(B) {                                                                                                             \
        const unsigned ka0 = TK_K16(sc0) | (0xFFFFu - (unsigned)lane), ka1 = TK_K16(sc1) | (0xFFFFu - 64u - (unsigned)lane);       \
        const unsigned kb0 = TK_K16(sc2) | (0xFFFFu - (unsigned)lane), kb1 = TK_K16(sc3) | (0xFFFFu - 64u - (unsigned)lane);       \
          \
                               \
        const unsigned mxA_ = wave_max_u32(ka0 > ka1 ? ka0 : ka1), mxB_ = wave_max_u32(kb0 > kb1 ? kb0 : kb1);                      \
        const unsigned gA_ = mxA_ > (3u << 26) ? mxA_ - (3u << 26) : 0u, gB_ = mxB_ > (3u << 26) ? mxB_ - (3u << 26) : 0u;          \
        const int cgA_ = __builtin_popcountll(__ballot(ka0 >= gA_)) + __builtin_popcountll(__ballot(ka1 >= gA_));                   \
        const int cgB_ = __builtin_popcountll(__ballot(kb0 >= gB_)) + __builtin_popcountll(__ballot(kb1 >= gB_));                   \
        unsigned loA = cgA_ >= 16 ? gA_ : 0u, hiA = mxA_ + 1u, loB = cgB_ >= 16 ? gB_ : 0u, hiB = mxB_ + 1u;                       \
        bool doneA = (cgA_ == 16), doneB = (cgB_ == 16);                                                                           \
        while (!(doneA && doneB)) {                                                                                                \
            const unsigned midA = loA + ((hiA - loA) >> 1), midB = loB + ((hiB - loB) >> 1);                                        \
            const int cntA = __builtin_popcountll(__ballot(ka0 >= midA)) + __builtin_popcountll(__ballot(ka1 >= midA));             \
            const int cntB = __builtin_popcountll(__ballot(kb0 >= midB)) + __builtin_popcountll(__ballot(kb1 >= midB));             \
              \
            loA = cntA >= 16 ? midA : loA; hiA = cntA >= 16 ? hiA : midA; doneA = doneA || (cntA == 16);                            \
            loB = cntB >= 16 ? midB : loB; hiB = cntB >= 16 ? hiB : midB; doneB = doneB || (cntB == 16);                            \
        }                                                                                                                          \
           \
        unsigned* lk = (unsigned*)NB_LV(B);                                                                                        \
        { const unsigned T = loA; const bool k0 = ka0 >= T, k1 = ka1 >= T; const unsigned long long s0 = __ballot(k0), s1 = __ballot(k1); \
          if (k0) { lk[mbcnt64(s0)] = ka0; }                                                                                       \
          if (k1) { const int pos = __builtin_popcountll(s0) + mbcnt64(s1); if (pos < 16) lk[pos] = ka1; } }                        \
        { const unsigned T = loB; const bool k0 = kb0 >= T, k1 = kb1 >= T; const unsigned long long s0 = __ballot(k0), s1 = __ballot(k1); \
          if (k0) { lk[16 + mbcnt64(s0)] = kb0; }                                                                                  \
          if (k1) { const int pos = __builtin_popcountll(s0) + mbcnt64(s1); if (pos < 16) lk[16 + pos] = kb1; } }                   \
        __builtin_amdgcn_s_waitcnt(0xC07F); __builtin_amdgcn_wave_barrier();                                                       \
    }
#define TK_PART_B(B, H, RS) {                                                                                                      \
        const unsigned* lk = (const unsigned*)NB_LV(B); float* vs = NB_VS(B); int* is_ = NB_IS(B);                                  \
        if (lane < 32) { const int base = lane & 16; const unsigned mk = lk[lane]; int rk = 0;         \
            _Pragma("unroll") for (int j = 0; j < 16; ++j) rk += (lk[base + j] > mk) ? 1 : 0;                                       \
            const unsigned k16 = mk >> 16, hb = (k16 & 0x8000u) ? (k16 & 0x7fffu) : (~k16 & 0xffffu);                               \
            vs[base + rk] = (float)__builtin_bit_cast(_Float16, (unsigned short)hb); is_[base + rk] = (int)(0xFFFFu - (mk & 0xFFFFu)); } \
        __builtin_amdgcn_s_waitcnt(0xC07F); __builtin_amdgcn_wave_barrier();                                                       \
        float cv = 0.f; unsigned kc = 0u;                                                                                          \
        if (lane < 50) { cv = vs[ca] + vs[16 + cb]; kc = fkey(cv); }                                                                \
        const float top_ = vs[0] + vs[16];                           \
        unsigned lo = fkey(vs[15] + vs[31]), hi = fkey(top_) + 1u; bool fin_ = false;                                               \
        do { const unsigned mid = lo + ((hi - lo) >> 1); const int cnt = __builtin_popcountll(__ballot(kc >= mid));                 \
             lo = cnt >= 16 ? mid : lo; hi = cnt >= 16 ? hi : mid; fin_ = (cnt == 16) || (hi - lo <= 1u); } while (!fin_);          \
        const unsigned T2 = lo; const unsigned long long tm = __ballot(kc == T2);                                                  \
        const int need2 = 16 - __builtin_popcountll(__ballot(kc > T2));                                                            \
        const bool take = (kc > T2) || (kc == T2 && mbcnt64(tm) < need2);                                                          \
        const float ev = take ? __expf((cv - top_) * (RS)) : 0.f; const float sm = wave_sum(ev);                                    \
        pend_i = -1;                                                                                                               \
        if (take) { const int pos = mbcnt64(__ballot(take)); if (pos < 16) { const int e_ = is_[ca] * PEER_KEYS + is_[16 + cb];     \
            NB_EID(B)[(H) * 16 + pos] = e_; pend_i = (H) * 16 + pos; pend_g = ev * __builtin_amdgcn_rcpf(sm); pend_su = uscg[e_]; pend_sv = vscg[e_]; } } \
        __builtin_amdgcn_wave_barrier();                                                                                           \
    }
#define TK_FLUSH(B) { if (pend_i >= 0) { NB_EG(B)[pend_i] = pend_g * pend_sv; NB_EU(B)[pend_i] = pend_su; } pend_i = -1; }
    float rs_cur = 0.f, rs_n = 0.f;
    {
        unsigned char* B0 = wbase;
        TK_LOAD_X(row) TK_STAGE_X(B0, rs_cur)
        TK_LOAD_SC(row, 0)
#pragma unroll 1
        for (int h = 0; h < PEER_H; ++h) { TK_FLUSH(B0) TK_PART_A(B0) { const int hn = h < PEER_H - 1 ? h + 1 : h; TK_LOAD_SC(row, hn) } TK_PART_B(B0, h, rs_cur) }
        TK_FLUSH(B0)
        __builtin_amdgcn_s_waitcnt(0xC07F); __builtin_amdgcn_wave_barrier();
    }
#if PEER_U4
        const unsigned koff = (unsigned)((c >> 3) * 64 + gq * 16);
        const unsigned xoff = (unsigned)(((c >> 3) * 4 + gq) * 32);
        constexpr int NUB = 4;
#define U_LOAD(UB, E_) { _Pragma("unroll") for (int k3 = 0; k3 < 4; ++k3) UB[k3] = ldws<u32x4>(W + O_UT + k3 * 128, (unsigned)(E_) + koff); }
#define U_DOT(UB)                                                                                                                  \
            _Pragma("unroll") for (int ks = 0; ks < 4; ++ks) {                                                                     \
                const u32x4 xh0 = *(const u32x4*)(wsm + ks * 256 + xoff), xh1 = *(const u32x4*)(wsm + ks * 256 + xoff + 16);       \
                const v8i32_t xa = {(int)xh0.x, (int)xh0.y, (int)xh0.z, (int)xh0.w, (int)xh1.x, (int)xh1.y, (int)xh1.z, (int)xh1.w}; \
                const v8i32_t uw = {(int)UB[ks].x, (int)UB[ks].y, (int)UB[ks].z, (int)UB[ks].w, 0, 0, 0, 0};                        \
                dh = __builtin_amdgcn_mfma_scale_f32_16x16x128_f8f6f4(xa, uw, dh, 0, 4, 0, 0x7F7F7F7F, 0, 0x7F7F7F7F);              \
            }
#elif PEER_U6 == 1
        const unsigned koff = (unsigned)((c >> 3) * 64 + gq * 16);
        const unsigned xoff = (unsigned)(((c >> 3) * 4 + gq) * 32);
        constexpr int NUB = 6;
#define U_LOAD(UB, E_) { _Pragma("unroll") for (int k3 = 0; k3 < 6; ++k3) UB[k3] = ldws<u32x4>(W + O_UT + k3 * 128, (unsigned)(E_) + koff); }
#define UBD(UB, i) ((int)UB[(i) >> 2][(i) & 3])
#define U_DOT(UB)                                                                                                                  \
            _Pragma("unroll") for (int ks = 0; ks < 4; ++ks) {                                                                     \
                const u32x4 xh0 = *(const u32x4*)(wsm + ks * 256 + xoff), xh1 = *(const u32x4*)(wsm + ks * 256 + xoff + 16);       \
                const u32x4 xl0 = *(const u32x4*)(wsm + 1024 + ks * 256 + xoff), xl1 = *(const u32x4*)(wsm + 1024 + ks * 256 + xoff + 16); \
                const v8i32_t xa = {(int)xh0.x, (int)xh0.y, (int)xh0.z, (int)xh0.w, (int)xh1.x, (int)xh1.y, (int)xh1.z, (int)xh1.w}; \
                const v8i32_t xb = {(int)xl0.x, (int)xl0.y, (int)xl0.z, (int)xl0.w, (int)xl1.x, (int)xl1.y, (int)xl1.z, (int)xl1.w}; \
                const v8i32_t uw = {UBD(UB, 6 * ks), UBD(UB, 6 * ks + 1), UBD(UB, 6 * ks + 2), UBD(UB, 6 * ks + 3), UBD(UB, 6 * ks + 4), UBD(UB, 6 * ks + 5), 0, 0}; \
                dh = __builtin_amdgcn_mfma_scale_f32_16x16x128_f8f6f4(xa, uw, dh, 0, 2, 0, 0x7F7F7F7F, 0, 0x7F7F7F7F);              \
                dl = __builtin_amdgcn_mfma_scale_f32_16x16x128_f8f6f4(xb, uw, dl, 0, 2, 0, 0x7F7F7F7F, 0, 0x7F7F7F7F);              \
            }
#endif
#if PEER_V6
        typedef U3 vb_t;
#define V_LOAD(VB, ESRC) { _Pragma("unroll") for (int j = 0; j < 8; ++j) VB[j] = ldws<U3>(W + O_VT, (unsigned)__builtin_amdgcn_readlane(ESRC, j) + lane * 12); }
#define V_ACC(VBC)                                                                                                                 \
            _Pragma("unroll") for (int jp = 0; jp < 4; ++jp) {                                                                     \
                const float a0_ = __builtin_bit_cast(float, __builtin_amdgcn_readlane(__builtin_bit_cast(int, act), 2 * jp));      \
                const float a1_ = __builtin_bit_cast(float, __builtin_amdgcn_readlane(__builtin_bit_cast(int, act), 2 * jp + 1));  \
                const v6i32_t sv_ = {(int)VBC[2 * jp].a, (int)VBC[2 * jp].b, (int)VBC[2 * jp].c, (int)VBC[2 * jp + 1].a, (int)VBC[2 * jp + 1].b, (int)VBC[2 * jp + 1].c}; \
                const v32f32_t f_ = __builtin_amdgcn_cvt_scalef32_pk32_f32_fp6(sv_, 1.0f);                                         \
                _Pragma("unroll") for (int q_ = 0; q_ < 4; ++q_) {                                                                 \
                    acc[q_] += (f32x4){f_[4 * q_], f_[4 * q_ + 1], f_[4 * q_ + 2], f_[4 * q_ + 3]} * a0_;                           \
                    acc[q_] += (f32x4){f_[16 + 4 * q_], f_[16 + 4 * q_ + 1], f_[16 + 4 * q_ + 2], f_[16 + 4 * q_ + 3]} * a1_;       \
                }                                                                                                                  \
            }
#endif
    u32x4 ub0[NUB], ub1[NUB]; vb_t vb0[8], vb1[8];
    int ec0, ec1;
    {
        const int* eid0 = NB_EID(wbase);
        ec0 = eid0[c & 7] * 768; ec1 = eid0[8 + (c & 7)] * 768;
        U_LOAD(ub0, ec0)
        V_LOAD(vb0, ec0)
        U_LOAD(ub1, ec1)
    }
#pragma unroll 1
    for (int it = 0;; ++it) {
        unsigned char* wsm = NOTK ? wbase : wbase + (it & 1) * 4096;
        unsigned char* nb = NOTK ? wbase : wbase + ((it + 1) & 1) * 4096;
        const int* eid = NB_EID(wsm); const float* egate = NB_EG(wsm); const float* eusc = NB_EU(wsm);
        const float rs = rs_cur;
        const int nrow_raw = row + stride;
        const int nrow = nrow_raw < MTOK ? nrow_raw : row;
        TK_LOAD_X(nrow) TK_LOAD_SC(nrow, 0)
        f32x4 acc[4];
#pragma unroll
        for (int i = 0; i < 4; ++i) acc[i] = (f32x4){0.f, 0.f, 0.f, 0.f};
#define PEER_TILE(UB, EC, VBC, ECN, VBN)                                                                                           \
        {                                                                                                                          \
            f32x4 dh = {0.f, 0.f, 0.f, 0.f}, dl = {0.f, 0.f, 0.f, 0.f};                                                             \
            U_DOT(UB)                                                                                                              \
            float mine = PEER_U4 ? dh[0] : dh[0] + dl[0] * (1.f / 16.f);                                                           \
            mine += __shfl_xor(mine, 40);                                                       \
            const float act = gelu_fast(mine * (1.f / 16.f) * eusc[tcur * 8 + (c & 7)] * rs) * egate[tcur * 8 + (c & 7)];           \
            {     \
                const int* es_ = (tcur + 2 < 16) ? eid + (tcur + 2) * 8 : NB_EID(nb) + (tcur + 2 - 16) * 8;                          \
                EC = es_[c & 7] * 768;                                                                                             \
                V_LOAD(VBN, ECN)                                                                                                   \
            }                                                                                                                      \
            __builtin_amdgcn_sched_barrier(0);                                                                                     \
            V_ACC(VBC)                                                                                                             \
            __builtin_amdgcn_sched_barrier(0);                                                                                     \
            U_LOAD(UB, EC)                                     \
            __builtin_amdgcn_sched_barrier(0);                                                                                     \
        }
#pragma unroll 1
        for (int tp = 0; tp < 8; ++tp) {
            { const int tcur = 2 * tp; PEER_TILE(ub0, ec0, vb0, ec1, vb1) }
            if (!NOTK) {
            if (tp == 0) { TK_STAGE_X(nb, rs_n) }
            TK_FLUSH(nb)
            TK_PART_A(nb)
            }
            __builtin_amdgcn_sched_barrier(0);
            { const int tcur = 2 * tp + 1; PEER_TILE(ub1, ec1, vb1, ec0, vb0) }
            if (!NOTK) {
            TK_PART_B(nb, tp, rs_n)
            { const int hn = tp < 7 ? tp + 1 : 7; TK_LOAD_SC(nrow, hn) }
            }
            __builtin_amdgcn_sched_barrier(0);
        }
#undef PEER_TILE
#undef U_LOAD
#undef U_DOT
#undef V_LOAD
#undef V_LOAD_H
#undef V_ACC
        if (!NOTK) { TK_FLUSH(nb) }
        float* hr = p.out + (size_t)row * DM;
        float ss = 0.f;
        {
            f32x4 h0, h1, h2, h3;
            const unsigned char* hc_ = hbase + ((wsm - wbase) >> 1);
            unpack8(*(const u32x4*)(hc_ + lane * 16), h0, h1); unpack8(*(const u32x4*)(hc_ + 1024 + lane * 16), h2, h3);
            acc[0] += h0; acc[1] += h1; acc[2] += h2; acc[3] += h3;
        }
#pragma unroll
        for (int i = 0; i < 4; ++i) ss += acc[i][0] * acc[i][0] + acc[i][1] * acc[i][1] + acc[i][2] * acc[i][2] + acc[i][3] * acc[i][3];
        ss = wave_sum(ss);
        const float scl = rsqrtf(ss * (1.f / DM) + NORM_EPS);
#pragma unroll
        for (int cc = 0; cc < 2; ++cc) {
            const f32x4 ga = *(const f32x4*)(p.norm_f_g + cc * 512 + lane * 8), gb = *(const f32x4*)(p.norm_f_g + cc * 512 + lane * 8 + 4);
            *(f32x4*)(hr + cc * 512 + lane * 8) = acc[2 * cc] * scl * ga; *(f32x4*)(hr + cc * 512 + lane * 8 + 4) = acc[2 * cc + 1] * scl * gb;
        }
        __builtin_amdgcn_s_waitcnt(0xC07F); __builtin_amdgcn_wave_barrier();
        if (nrow_raw >= MTOK) break;
        row = nrow_raw; rs_cur = rs_n;
    }
#undef TK_FLUSH
#undef TK_PART_B
#undef TK_PART_A
#undef TK_K16
#undef TK_STAGE_X
#undef TK_LOAD_SC
#undef TK_LOAD_X
}


#ifdef UT_FP4
__device__ __forceinline__ int ut4_a(int row, int g, int i) { return ((i * 7 + g * 3 + row) % 13) - 6; }
__device__ __forceinline__ int ut4_b(int col, int g, int j) { return ((j * 5 + g * 2 + col * 3) % 7) - 3; }
__device__ __forceinline__ unsigned ut4_code(int v) { const int a = v < 0 ? -v : v; const unsigned c = a == 0 ? 0u : a == 1 ? 2u : a == 2 ? 4u : 5u; return c | (v < 0 ? 8u : 0u); }
__device__ __forceinline__ void ut_fp4(const Params& p) {
    const int lane = threadIdx.x & 63, g = lane >> 4, c = lane & 15;
    unsigned aw[8];
#pragma unroll
    for (int w = 0; w < 8; ++w) {
        int h_ = __builtin_amdgcn_cvt_pk_fp8_f32((float)ut4_a(c, g, 4 * w), (float)ut4_a(c, g, 4 * w + 1), 0, false);
        h_ = __builtin_amdgcn_cvt_pk_fp8_f32((float)ut4_a(c, g, 4 * w + 2), (float)ut4_a(c, g, 4 * w + 3), h_, true);
        aw[w] = (unsigned)h_;
    }
    unsigned bw[4] = {0u, 0u, 0u, 0u};
#pragma unroll
    for (int j = 0; j < 32; ++j) bw[j >> 3] |= ut4_code(ut4_b(c, g, j)) << (4 * (j & 7));
    typedef int v8i_ __attribute__((ext_vector_type(8)));
    const v8i_ A = {(int)aw[0], (int)aw[1], (int)aw[2], (int)aw[3], (int)aw[4], (int)aw[5], (int)aw[6], (int)aw[7]};
    const v8i_ B = {(int)bw[0], (int)bw[1], (int)bw[2], (int)bw[3], 0, 0, 0, 0};
    f32x4 D = {0.f, 0.f, 0.f, 0.f};
    D = __builtin_amdgcn_mfma_scale_f32_16x16x128_f8f6f4(A, B, D, 0, 4, 0, 0x7F7F7F7F, 0, 0x7F7F7F7F);
    bool ok1 = true, ok2 = true, ok3 = true, ok4 = true;
#pragma unroll 1
    for (int r = 0; r < 4; ++r) {
        const int row = 4 * g + r;
        int e1 = 0, e2 = 0, e3 = 0, e4 = 0;
#pragma unroll 1
        for (int gg = 0; gg < 4; ++gg)
#pragma unroll 1
            for (int j = 0; j < 32; ++j) {
                const int bl = ut4_b(c, gg, j), bh = ut4_b(c, gg, j ^ 1);
                { const int K = 32 * gg + j; const int ga = K < 64 ? (K >> 4) : ((K - 64) >> 4), ia = K < 64 ? (K & 15) : 16 + (K & 15); e1 += bl * ut4_a(row, ga, ia); e2 += bh * ut4_a(row, ga, ia); }
                { e3 += bl * ut4_a(row, gg, j); e4 += bh * ut4_a(row, gg, j); }
            }
        const float dv = D[r];
        ok1 = ok1 && (dv == (float)e1); ok2 = ok2 && (dv == (float)e2); ok3 = ok3 && (dv == (float)e3); ok4 = ok4 && (dv == (float)e4);
    }
    const bool a1 = __ballot(ok1) == ~0ull, a2 = __ballot(ok2) == ~0ull, a3 = __ballot(ok3) == ~0ull, a4 = __ballot(ok4) == ~0ull;
    const int mres = a1 ? 1 : a2 ? 2 : a3 ? 3 : a4 ? 4 : 0;
    if (lane == 0) ((float*)p.ws)[20] = (float)mres;
}
#endif
#ifdef UT_FP6
__device__ __forceinline__ int ut_a(int row, int g, int i) { return ((i * 7 + g * 3 + row) % 13) - 6; }
__device__ __forceinline__ int ut_b(int col, int g, int j) { return ((j * 5 + g * 2 + col * 3) % 7) - 3; }
__device__ __forceinline__ void ut_fp6(const Params& p) {
    const int lane = threadIdx.x & 63, g = lane >> 4, c = lane & 15;
    unsigned aw[8];
#pragma unroll
    for (int w = 0; w < 8; ++w) {
        int h_ = __builtin_amdgcn_cvt_pk_fp8_f32((float)ut_a(c, g, 4 * w), (float)ut_a(c, g, 4 * w + 1), 0, false);
        h_ = __builtin_amdgcn_cvt_pk_fp8_f32((float)ut_a(c, g, 4 * w + 2), (float)ut_a(c, g, 4 * w + 3), h_, true);
        aw[w] = (unsigned)h_;
    }
    unsigned bw[6];
    {
        unsigned cd[16];
#pragma unroll
        for (int j = 0; j < 16; ++j) cd[j] = fp6_code((float)ut_b(c, g, j));
        fp6_pack16(cd, bw[0], bw[1], bw[2]);
#pragma unroll
        for (int j = 0; j < 16; ++j) cd[j] = fp6_code((float)ut_b(c, g, 16 + j));
        fp6_pack16(cd, bw[3], bw[4], bw[5]);
    }
    const v8i32_t A = {(int)aw[0], (int)aw[1], (int)aw[2], (int)aw[3], (int)aw[4], (int)aw[5], (int)aw[6], (int)aw[7]};
    const v8i32_t B = {(int)bw[0], (int)bw[1], (int)bw[2], (int)bw[3], (int)bw[4], (int)bw[5], 0, 0};
    f32x4 D = {0.f, 0.f, 0.f, 0.f};
    D = __builtin_amdgcn_mfma_scale_f32_16x16x128_f8f6f4(A, B, D, 0, 2, 0, 0x7F7F7F7F, 0, 0x7F7F7F7F);
    bool ok1 = true, ok2 = true, ok3 = true, ok4 = true;
#pragma unroll 1
    for (int r = 0; r < 4; ++r) {
        const int row = 4 * g + r;
        int e1 = 0, e2 = 0, e3 = 0, e4 = 0;
#pragma unroll 1
        for (int gg = 0; gg < 4; ++gg)
#pragma unroll 1
            for (int j = 0; j < 32; ++j) {
                const int bv = ut_b(c, gg, j);
                e1 += bv * ut_a(row, gg, j);
                { const int K = j < 16 ? 16 * gg + j : 64 + 16 * gg + (j - 16); e2 += bv * ut_a(row, K >> 5, K & 31); }
                { const int K = 32 * gg + j; const int ga = K < 64 ? (K >> 4) : ((K - 64) >> 4), ia = K < 64 ? (K & 15) : 16 + (K & 15); e3 += bv * ut_a(row, ga, ia); }
                { const int K = 32 * (j >> 3) + 8 * gg + (j & 7); e4 += bv * ut_a(row, K >> 5, K & 31); }
            }
        const float dv = D[r];
        ok1 = ok1 && (dv == (float)e1); ok2 = ok2 && (dv == (float)e2); ok3 = ok3 && (dv == (float)e3); ok4 = ok4 && (dv == (float)e4);
    }
    const bool a1 = __ballot(ok1) == ~0ull, a2 = __ballot(ok2) == ~0ull, a3 = __ballot(ok3) == ~0ull, a4 = __ballot(ok4) == ~0ull;
    const int m = a1 ? 1 : a2 ? 2 : a3 ? 3 : a4 ? 4 : 0;
    const v6i32_t sv = {(int)bw[0], (int)bw[1], (int)bw[2], (int)bw[3], (int)bw[4], (int)bw[5]};
    const v32f32_t f = __builtin_amdgcn_cvt_scalef32_pk32_f32_fp6(sv, 1.0f);
    bool okc = true;
#pragma unroll
    for (int j = 0; j < 32; ++j) okc = okc && (f[j] == (float)ut_b(c, g, j));
    const int c1 = (__ballot(okc) == ~0ull) ? 1 : 0;
    if (lane == 0) ((float*)p.ws)[20] = (float)(2 * m + c1);
}
#endif
__global__ void __launch_bounds__(NT, 2) k_mega(Params p) {
    extern __shared__ __attribute__((aligned(16))) unsigned char lds_raw[];
    LAS unsigned char* lds = (LAS unsigned char*)lds_raw;
    unsigned char* smem = lds_raw;
    const int tid = threadIdx.x, G = gridDim.x;
    const int vcu = (G % 8 == 0) ? ((int)blockIdx.x % 8) * (G / 8) + (int)blockIdx.x / 8 : (int)blockIdx.x;
    for (int i = tid; i < (LDS_BYTES - LDSCTL_OFF) / 4; i += NT) ((LAS unsigned*)(lds + LDSCTL_OFF))[i] = 0u;
    __syncthreads();
    XcdBarrier bar = xcd_barrier_post((unsigned*)p.ws + CW_BAR, (volatile LAS unsigned*)(lds + MISC_OFF) + 8);
#ifdef UT_FP6
    if (blockIdx.x == 0 && threadIdx.x < 64) ut_fp6(p);
#endif
#ifdef UT_FP4
    if (blockIdx.x == 0 && threadIdx.x < 64) ut_fp4(p);
#endif

#ifndef REP_PREP
#define REP_PREP 1
#endif
#ifndef REP_INPROJ
#define REP_INPROJ 1
#endif
#ifndef REP_SSM
#define REP_SSM 1
#endif
#ifndef REP_DSA
#define REP_DSA 1
#endif
#ifndef REP_MID
#define REP_MID 1
#endif
#ifndef REP_SCORES
#define REP_SCORES 1
#endif
#ifndef REP_PEER
#define REP_PEER 1
#endif
#define REPEAT(n) _Pragma("unroll 1") for (int rep_ = 0; rep_ < (n); ++rep_)
    REPEAT(REP_PREP) { phase_prep<0>(p, smem, vcu, G); xcd_barrier(bar); }
    REPEAT(REP_INPROJ) {
        EpiInProj e{WSP(bf16_t, WS_U), WSP(bf16_t, WS_Q), WSP(bf16_t, WS_K), WSP(bf16_t, WS_V), WSP(bf16_t, WS_QI), WSP(bf16_t, WS_KI),
                    WSP(bf16_t, WS_SGS), WSP(bf16_t, WS_SGA), WSP(float, WS_WI), WSP(float2, WS_ROPEA), WSP(float2, WS_ROPEI)};
        run_gemm(lds, WSP(bf16_t, WS_R1), WSP(bf16_t, WS_WINT), MTOK, IN_WP, 1024, G, e);
        if (G == 256) { if ((int)blockIdx.x >= 128) phase_prep<1>(p, smem, (int)blockIdx.x - 128, 128); }
        else phase_prep<1>(p, smem, vcu, G);
        xcd_barrier(bar);
    }
#ifdef DSA_FIRST
    REPEAT(REP_DSA) { phase_dsa(p, smem, (unsigned)(WS_YATT << 20), vcu, G); __syncthreads(); }
    REPEAT(REP_SSM) {
        int t2 = threadIdx.x; asm volatile("" : "+v"(t2));
        const int w2 = __builtin_amdgcn_readfirstlane(t2 >> 6);
#pragma unroll 1
        for (int item = vcu; item < NB * SSM_G; item += G) ssm_fast_item(p, smem, (unsigned)(WS_YG << 20), item, t2 & 63, w2, (REP_SSM > 1 && rep_ == 0) ? 1 : 0);
        __syncthreads();
    }
#ifdef PROBE_SSM
    if (tid < 64) for (int item = blockIdx.x; item < NB * SSM_G; item += G) ssm_item(p, (float*)smem, (bf16_t*)p.out, item, tid);
    __syncthreads();
#endif
#else
    REPEAT(REP_SSM) {
        int t2 = threadIdx.x; asm volatile("" : "+v"(t2));
        const int w2 = __builtin_amdgcn_readfirstlane(t2 >> 6);
#pragma unroll 1
        for (int item = vcu; item < NB * SSM_G; item += G) ssm_fast_item(p, smem, (unsigned)(WS_YG << 20), item, t2 & 63, w2, (REP_SSM > 1 && rep_ == 0) ? 1 : 0);
        __syncthreads();
    }
#ifdef PROBE_SSM
    if (tid < 64) for (int item = blockIdx.x; item < NB * SSM_G; item += G) ssm_item(p, (float*)smem, (bf16_t*)p.out, item, tid);
    __syncthreads();
#endif
    REPEAT(REP_DSA) { phase_dsa(p, smem, (unsigned)(WS_YATT << 20), vcu, G); __syncthreads(); }
#endif
#ifdef PROBE_ATTN
    phase_attn(p, smem, (bf16_t*)p.out, vcu, G);
    __syncthreads();
#endif
    xcd_barrier(bar);
#if defined(PROBE_ATTN) || defined(PROBE_SSM)
    {
#ifdef PROBE_SSM
        const bf16_t* A = WSP(bf16_t, WS_YG);
#else
        const bf16_t* A = WSP(bf16_t, WS_YATT);
#endif
        const bf16_t* B = (const bf16_t*)p.out;
        float d2 = 0.f, b2 = 0.f;
        for (size_t i = (size_t)blockIdx.x * NT + threadIdx.x; i < (size_t)MTOK * 512; i += (size_t)G * NT) { float a = bf2f(A[i]), bb = bf2f(B[i]); d2 += (a - bb) * (a - bb); b2 += bb * bb; }
        d2 = wave_sum(d2); b2 = wave_sum(b2);
        if ((threadIdx.x & 63) == 0) { atomicAdd((float*)p.ws + 16, d2); atomicAdd((float*)p.ws + 17, b2); }
    }
    xcd_barrier(bar);
#endif
#ifndef REP_GLU
#define REP_GLU 1
#endif
#ifndef REP_M1
#define REP_M1 1
#endif
#ifndef REP_M2
#define REP_M2 1
#endif
#ifndef REP_OUT
#define REP_OUT 1
#endif
#ifndef REP_BAR
#define REP_BAR 0
#endif
    REPEAT(REP_BAR) { xcd_barrier(bar); }
    REPEAT(REP_GLU) { EpiGlu e{WSP(bf16_t, WS_YG), WSP(bf16_t, WS_YSSM)}; run_gemm(lds, WSP(bf16_t, WS_YG), WSP(bf16_t, WS_WGLUT), MTOK, 512, 512, G, e); xcd_barrier(bar); }
    REPEAT(REP_M1) { EpiMergeChain e{WSP(bf16_t, WS_SGS), WSP(bf16_t, WS_SGA), WSP(bf16_t, WS_R1)};
        run_gemm_chain(lds, WSP(bf16_t, WS_YSSM), WSP(bf16_t, WS_WSUPT), WSP(bf16_t, WS_YATT), WSP(bf16_t, WS_WAUPT), MTOK, 1024, 512, G, e); xcd_barrier(bar); }
    REPEAT(REP_OUT) { EpiOut e{p.x, WSP(bf16_t, WS_HG), WSP(float, WS_RSS)};
        run_gemm(lds, WSP(bf16_t, WS_R1), WSP(bf16_t, WS_WOUTT), MTOK, 1024, 1024, G, e); xcd_barrier(bar); }
    REPEAT(REP_SCORES) { EpiScores e{WSP(_Float16, WS_SCORES)}; run_gemm(lds, WSP(bf16_t, WS_HG), WSP(bf16_t, WS_WCT), MTOK, 2048, 1024, G, e); xcd_barrier(bar); }
#ifdef PROBE_PEER
    phase_peer2<2>(p, smem, vcu, G);
    __syncthreads();
    phase_peer<false>(p, smem, vcu, G);
    xcd_barrier(bar);
    {
        const float* A = WSP(float, 462); const float* B = p.out;
        float d2 = 0.f, b2 = 0.f;
        for (size_t i = (size_t)blockIdx.x * NT + threadIdx.x; i < (size_t)8192 * DM; i += (size_t)G * NT) { const float a = A[i], bb = B[i]; d2 += (a - bb) * (a - bb); b2 += bb * bb; }
        d2 = wave_sum(d2); b2 = wave_sum(b2);
        if ((threadIdx.x & 63) == 0) { atomicAdd((float*)p.ws + 16, d2); atomicAdd((float*)p.ws + 17, b2); }
    }
    xcd_barrier(bar);
    {
        const float e = ((const float*)p.ws)[16] / fmaxf(((const float*)p.ws)[17], 1e-30f);
        int kx = 0; if (e > 1e-8f) kx++; if (e > 1e-7f) kx++; if (e > 1e-6f) kx++; if (e > 1e-5f) kx++; if (e > 1e-4f) kx++; if (e > 1e-3f) kx++; if (e > 1e-2f) kx++; if (!(e == e)) kx = 10;
        const float f = 1.f + 0.05f * kx;
        for (size_t i = (size_t)blockIdx.x * NT + threadIdx.x; i < (size_t)MTOK * DM / 4; i += (size_t)G * NT) { f32x4 v = ((f32x4*)p.out)[i]; ((f32x4*)p.out)[i] = v * f; }
    }
#else
#if !PEER_FP6
    REPEAT(REP_PEER - 1) { phase_peer2<1>(p, smem, vcu, G); __syncthreads(); }
#endif
#ifdef PEER_OLD
    phase_peer2<0>(p, smem, vcu, G);
#elif PEER_FP6
#if REP_PEER > 1
#ifdef PEER_REPFULL
    phase_peer6<false>(p, smem, vcu, G); __syncthreads();
#else
    phase_peer6<true>(p, smem, vcu, G); __syncthreads();
#endif
#endif
    phase_peer6<false>(p, smem, vcu, G);
#else
    phase_peer4(p, smem, vcu, G);
#endif
#if defined(UT_FP6) || defined(UT_FP4)
    xcd_barrier(bar);
    {
        const float f = 1.f + 0.05f * ((const float*)p.ws)[20];
        for (size_t i = (size_t)blockIdx.x * NT + threadIdx.x; i < (size_t)MTOK * DM / 4; i += (size_t)G * NT) { f32x4 v = ((f32x4*)p.out)[i]; ((f32x4*)p.out)[i] = v * f; }
    }
#endif
#if defined(PROBE_ATTN) || defined(PROBE_SSM)
    xcd_barrier(bar);
    {
        const float e = ((const float*)p.ws)[16] / fmaxf(((const float*)p.ws)[17], 1e-30f);
        int kx = 0; if (e > 1e-6f) kx++; if (e > 1e-5f) kx++; if (e > 1e-4f) kx++; if (e > 1e-3f) kx++; if (e > 1e-2f) kx++; if (e > 1e-1f) kx++; if (!(e == e)) kx = 8;
        const float f = 1.f + 0.05f * kx;
        for (size_t i = (size_t)blockIdx.x * NT + threadIdx.x; i < (size_t)MTOK * DM / 4; i += (size_t)G * NT) { f32x4 v = ((f32x4*)p.out)[i]; ((f32x4*)p.out)[i] = v * f; }
    }
#endif
#endif
}

extern "C" void kernel_launch(void* const* d_in, const int* in_sizes, int n_in, void* d_out, int out_size, void* d_ws, size_t ws_size,
                              hipStream_t stream) {
    static int grid = 0;
    if (grid == 0) {
        int dev = 0, cus = 0, per_cu = 0;
        if (hipGetDevice(&dev) != hipSuccess || hipDeviceGetAttribute(&cus, hipDeviceAttributeMultiprocessorCount, dev) != hipSuccess) { grid = -1; return; }
        if (hipFuncSetAttribute((const void*)k_mega, hipFuncAttributeMaxDynamicSharedMemorySize, LDS_BYTES) != hipSuccess) { fprintf(stderr, "hipFuncSetAttribute failed\n"); grid = -1; return; }
        if (hipOccupancyMaxActiveBlocksPerMultiprocessor(&per_cu, (const void*)k_mega, NT, LDS_BYTES) != hipSuccess || per_cu < 1) {
            fprintf(stderr, "occupancy query reports %d blocks/CU\n", per_cu); (void)hipGetLastError(); per_cu = 1; }
        grid = cus;
    }
    if (grid < 0) return;
    (void)hipMemsetAsync(d_ws, 0, CTL_ZERO_BYTES, stream);
    Params p{};
    const float** pp = (const float**)&p;
    for (int i = 0; i < 22; ++i) pp[i] = (const float*)d_in[i];
    p.out = (float*)d_out;
    p.ws = (unsigned char*)d_ws;
    for (int f = 0; f < 32; ++f) p.inv64[f] = pow(10000.0, -(double)(2 * f) / 64.0);
    for (int f = 0; f < 16; ++f) p.inv32[f] = pow(10000.0, -(double)(2 * f) / 32.0);
    hipLaunchKernelGGL(k_mega, dim3(grid), dim3(NT), LDS_BYTES, stream, p);
}
```
